# Optimizing an MI355X kernel written in HIP

```python
import math
import jax, jax.numpy as jnp
from jax import lax
import numpy as np

D_MODEL = 1024
BATCH = 8
SEQ = 2048
DEPTH = 2
DEC_BATCH = 128
DEC_SEQ = 8
PAST_LEN = 16384
PAGE_SIZE = 128

RET_HEADS = 8
RET_DK = 64
RET_DV = 128
RET_QK = RET_HEADS * RET_DK
RET_V = RET_HEADS * RET_DV
RET_CHUNK = 128
ROPE_BASE = 10000.0
D_RNN = 1024
RNN_BLOCKS = 16
RNN_BS = D_RNN // RNN_BLOCKS
CONV_W = 4
RG_C = 8.0
IN_SIZES = (RET_QK, RET_QK, RET_V, RET_V, D_RNN, D_RNN, D_MODEL, D_MODEL)
N_IN = sum(IN_SIZES)
PEER_HEADS = 8
N_KEYS = 128
N_EXPERTS = N_KEYS * N_KEYS
PEER_DKEY = 256
PEER_TOPK = 16
PEER_BLOCK = 256
EPS = 1e-6

kernel_name = 'hybrid_retention_rglru_peer_step'


def rmsnorm(x, g):
    xf = x.astype(jnp.float32)
    y = xf * lax.rsqrt(jnp.mean(xf * xf, axis=-1, keepdims=True) + EPS)
    return (y * g.astype(jnp.float32)).astype(x.dtype)


def rotary(x, pos):
    half = x.shape[-1] // 2
    freq = ROPE_BASE ** (-jnp.arange(half, dtype=jnp.float32) / half)
    ang = pos[:, None] * freq[None, :]
    cos = jnp.cos(ang)[None, :, None, :]
    sin = jnp.sin(ang)[None, :, None, :]
    x1, x2 = x[..., :half], x[..., half:]
    return jnp.concatenate([x1 * cos - x2 * sin, x1 * sin + x2 * cos], axis=-1)


def retention(q, k, v, r0):
    b, t = q.shape[0], q.shape[1]
    c = RET_CHUNK if t % RET_CHUNK == 0 else t
    nc = t // c
    log_g = jnp.log1p(-(2.0 ** (-5.0 - jnp.arange(RET_HEADS, dtype=jnp.float32))))
    idx = jnp.arange(c, dtype=jnp.float32)
    diff = idx[:, None] - idx[None, :]
    mask = jnp.where(diff[None] >= 0, jnp.exp(jnp.maximum(diff, 0.0)[None] * log_g[:, None, None]), 0.0)
    qc = q.reshape(b, nc, c, RET_HEADS, RET_DK)
    kc = k.reshape(b, nc, c, RET_HEADS, RET_DK)
    vc = v.reshape(b, nc, c, RET_HEADS, RET_DV)
    s = jnp.einsum('bnjhd,bnmhd->bnhjm', qc, kc) * mask
    intra = jnp.einsum('bnhjm,bnmhe->bnjhe', s, vc)
    k_w = jnp.exp((c - 1 - idx)[:, None] * log_g[None, :])
    kv = jnp.einsum('bnmhd,bnmhe,mh->nbhde', kc, vc, k_w)
    g_c = jnp.exp(c * log_g)[None, :, None, None]

    def step(r, kv_n):
        return g_c * r + kv_n, r

    r_last, r_prev = lax.scan(step, r0, kv)
    q_w = jnp.exp((idx + 1.0)[:, None] * log_g[None, :])
    cross = jnp.einsum('bnjhd,nbhde,jh->bnjhe', qc, r_prev, q_w)
    o = (intra + cross).reshape(b, t, RET_HEADS, RET_DV)
    return o, r_last


def rglru_branch(xr, buf, h0, conv_w, conv_b, wa, ba, wx, bx, lam):
    b, t = xr.shape[0], xr.shape[1]
    f32 = jnp.float32
    xcat = jnp.concatenate([buf.astype(f32), xr], axis=1)
    cw = conv_w.astype(f32)
    xc = conv_b.astype(f32)[None, None, :]
    for w in range(CONV_W):
        xc = xc + xcat[:, w:w + t] * cw[w]
    new_buf = xcat[:, -(CONV_W - 1):]
    xb = xc.reshape(b, t, RNN_BLOCKS, RNN_BS)
    r = jax.nn.sigmoid(jnp.einsum('btnc,ncd->btnd', xb, wa.astype(f32)).reshape(b, t, D_RNN) + ba.astype(f32))
    i = jax.nn.sigmoid(jnp.einsum('btnc,ncd->btnd', xb, wx.astype(f32)).reshape(b, t, D_RNN) + bx.astype(f32))
    log_a = -RG_C * r * jax.nn.softplus(-lam.astype(f32))
    a = jnp.exp(log_a)
    u = jnp.sqrt(-jnp.expm1(2.0 * log_a)) * (i * xc)
    u = u.at[:, 0].add(a[:, 0] * h0)

    def comb(left, right):
        a1, b1 = left
        a2, b2 = right
        return a1 * a2, a2 * b1 + b2

    _, h = lax.associative_scan(comb, (a, u), axis=1)
    return h, h[:, -1], new_buf


def peer(xn, wq, keys, u_tab, v_tab):
    f32 = jnp.float32
    shp = xn.shape
    xf = xn.reshape(-1, D_MODEL)
    n = xf.shape[0]
    q = (xf @ wq).astype(f32).reshape(n, PEER_HEADS, 2, PEER_DKEY // 2)
    s = jnp.einsum('nhpd,hpkd->nhpk', q, keys.astype(f32))
    top_s, top_i = lax.top_k(s, PEER_TOPK)
    cand = top_s[:, :, 0, :, None] + top_s[:, :, 1, None, :]
    best_s, best_c = lax.top_k(cand.reshape(n, PEER_HEADS, PEER_TOPK * PEER_TOPK), PEER_TOPK)
    i1 = jnp.take_along_axis(top_i[:, :, 0], best_c // PEER_TOPK, axis=-1)
    i2 = jnp.take_along_axis(top_i[:, :, 1], best_c % PEER_TOPK, axis=-1)
    eidx = (i1 * N_KEYS + i2).reshape(n, PEER_HEADS * PEER_TOPK)
    gate = jax.nn.softmax(best_s, axis=-1).reshape(n, PEER_HEADS * PEER_TOPK)
    blk = min(PEER_BLOCK, n)
    nb = -(-n // blk)
    pad = nb * blk - n
    xp = jnp.pad(xf, ((0, pad), (0, 0))).reshape(nb, blk, D_MODEL)
    ep = jnp.pad(eidx, ((0, pad), (0, 0))).reshape(nb, blk, PEER_HEADS * PEER_TOPK)
    gp = jnp.pad(gate, ((0, pad), (0, 0))).reshape(nb, blk, PEER_HEADS * PEER_TOPK)

    def block(args):
        xb, eb, gb = args
        u = jnp.take(u_tab, eb, axis=0)
        hid = jax.nn.gelu(jnp.einsum('nd,nkd->nk', xb, u).astype(f32)) * gb
        v = jnp.take(v_tab, eb, axis=0)
        return jnp.einsum('nk,nkd->nd', hid.astype(xb.dtype), v)

    out = lax.map(block, (xp, ep, gp)).reshape(nb * blk, D_MODEL)[:n]
    return out.reshape(shp)


def trunk(x, r0, h0, buf0, pos0, norm1_g, norm2_g, normf_g, w_in, ret_gn_g, w_ret_out, conv_w, conv_b,
          rg_wa, rg_ba, rg_wx, rg_bx, rg_lambda, w_rnn_out, w_o, peer_wq, peer_keys, peer_u, peer_v):
    f32 = jnp.float32
    b, t = x.shape[0], x.shape[1]
    pos = pos0 + jnp.arange(t, dtype=f32)
    splits = np.cumsum(IN_SIZES)[:-1].tolist()
    new_r, new_h, new_buf = [], [], []
    for l in range(DEPTH):
        xn = rmsnorm(x, norm1_g[l])
        p = xn @ w_in[l]
        q, k, v, g_ret, xr, g_rnn, ga, gb = jnp.split(p, splits, axis=-1)
        qh = rotary(q.reshape(b, t, RET_HEADS, RET_DK).astype(f32), pos)
        kh = rotary(k.reshape(b, t, RET_HEADS, RET_DK).astype(f32), pos) * (RET_DK ** -0.5)
        vh = v.reshape(b, t, RET_HEADS, RET_DV).astype(f32)
        o, r_l = retention(qh, kh, vh, r0[l].astype(f32))
        mu = jnp.mean(o, axis=-1, keepdims=True)
        var = jnp.mean(jnp.square(o - mu), axis=-1, keepdims=True)
        o = ((o - mu) * lax.rsqrt(var + EPS)).reshape(b, t, RET_V) * ret_gn_g[l].astype(f32)
        ret_out = (jax.nn.silu(g_ret.astype(f32)) * o).astype(x.dtype) @ w_ret_out[l]
        h, h_l, buf_l = rglru_branch(xr.astype(f32), buf0[l], h0[l].astype(f32), conv_w[l], conv_b[l],
                                     rg_wa[l], rg_ba[l], rg_wx[l], rg_bx[l], rg_lambda[l])
        rnn_out = (h * jax.nn.gelu(g_rnn.astype(f32))).astype(x.dtype) @ w_rnn_out[l]
        merged = jax.nn.sigmoid(ga) * ret_out + jax.nn.sigmoid(gb) * rnn_out
        x = x + merged @ w_o[l]
        x = x + peer(rmsnorm(x, norm2_g[l]), peer_wq[l], peer_keys[l], peer_u[l], peer_v[l])
        new_r.append(r_l.astype(x.dtype))
        new_h.append(h_l.astype(x.dtype))
        new_buf.append(buf_l.astype(x.dtype))
    y = rmsnorm(x, normf_g)
    return y, jnp.stack(new_r), jnp.stack(new_h), jnp.stack(new_buf)


def setup_inputs(seed: int = 0) -> dict:
    key = jax.random.key(seed)
    ks = jax.random.split(key, 32)
    nrm = jax.random.normal
    f32 = jnp.float32
    lam_u = jax.random.uniform(ks[17], (DEPTH, D_RNN), f32, 0.9, 0.999)
    a_base = lam_u ** (1.0 / RG_C)
    rg_lambda = jnp.log(a_base) - jnp.log1p(-a_base)
    return {
        'x_prompt': nrm(ks[0], (BATCH, SEQ, D_MODEL), f32),
        'x_sample': nrm(ks[1], (DEC_BATCH, DEC_SEQ, D_MODEL), f32),
        'state_ret': 0.5 * nrm(ks[2], (DEPTH, DEC_BATCH, RET_HEADS, RET_DK, RET_DV), f32),
        'state_rnn': 0.5 * nrm(ks[3], (DEPTH, DEC_BATCH, D_RNN), f32),
        'state_conv': nrm(ks[4], (DEPTH, DEC_BATCH, CONV_W - 1, D_RNN), f32),
        'norm1_g': 1.0 + 0.05 * nrm(ks[5], (DEPTH, D_MODEL), f32),
        'norm2_g': 1.0 + 0.05 * nrm(ks[6], (DEPTH, D_MODEL), f32),
        'normf_g': 1.0 + 0.05 * nrm(ks[7], (D_MODEL,), f32),
        'w_in': nrm(ks[8], (DEPTH, D_MODEL, N_IN), f32) * D_MODEL ** -0.5,
        'ret_gn_g': 1.0 + 0.05 * nrm(ks[9], (DEPTH, RET_V), f32),
        'w_ret_out': nrm(ks[10], (DEPTH, RET_V, D_MODEL), f32) * RET_V ** -0.5,
        'conv_w': nrm(ks[11], (DEPTH, CONV_W, D_RNN), f32) * CONV_W ** -0.5,
        'conv_b': 0.01 * nrm(ks[12], (DEPTH, D_RNN), f32),
        'rg_wa': nrm(ks[13], (DEPTH, RNN_BLOCKS, RNN_BS, RNN_BS), f32) * RNN_BS ** -0.5,
        'rg_ba': 0.01 * nrm(ks[14], (DEPTH, D_RNN), f32),
        'rg_wx': nrm(ks[15], (DEPTH, RNN_BLOCKS, RNN_BS, RNN_BS), f32) * RNN_BS ** -0.5,
        'rg_bx': 0.01 * nrm(ks[16], (DEPTH, D_RNN), f32),
        'rg_lambda': rg_lambda,
        'w_rnn_out': nrm(ks[18], (DEPTH, D_RNN, D_MODEL), f32) * D_RNN ** -0.5,
        'w_o': nrm(ks[19], (DEPTH, D_MODEL, D_MODEL), f32) * D_MODEL ** -0.5,
        'peer_wq': nrm(ks[20], (DEPTH, D_MODEL, PEER_HEADS * PEER_DKEY), f32) * D_MODEL ** -0.5,
        'peer_keys': nrm(ks[21], (DEPTH, PEER_HEADS, 2, N_KEYS, PEER_DKEY // 2), f32) * (PEER_DKEY // 2) ** -0.5,
        'peer_u': nrm(ks[22], (DEPTH, N_EXPERTS, D_MODEL), f32) * D_MODEL ** -0.5,
        'peer_v': nrm(ks[23], (DEPTH, N_EXPERTS, D_MODEL), f32) * (PEER_HEADS * PEER_TOPK) ** -0.5,
    }


def reference(x_prompt, x_sample, state_ret, state_rnn, state_conv, norm1_g, norm2_g, normf_g, w_in,
              ret_gn_g, w_ret_out, conv_w, conv_b, rg_wa, rg_ba, rg_wx, rg_bx, rg_lambda, w_rnn_out, w_o,
              peer_wq, peer_keys, peer_u, peer_v):
    bp = x_prompt.shape[0]
    dt = x_prompt.dtype
    zr = jnp.zeros((DEPTH, bp, RET_HEADS, RET_DK, RET_DV), dt)
    zh = jnp.zeros((DEPTH, bp, D_RNN), dt)
    zc = jnp.zeros((DEPTH, bp, CONV_W - 1, D_RNN), dt)
    y_prompt, sr_p, sh_p, sc_p = trunk(x_prompt, zr, zh, zc, 0, norm1_g, norm2_g, normf_g, w_in, ret_gn_g,
                                       w_ret_out, conv_w, conv_b, rg_wa, rg_ba, rg_wx, rg_bx, rg_lambda,
                                       w_rnn_out, w_o, peer_wq, peer_keys, peer_u, peer_v)
    y_sample, sr_s, sh_s, sc_s = trunk(x_sample, state_ret, state_rnn, state_conv, PAST_LEN, norm1_g, norm2_g,
                                       normf_g, w_in, ret_gn_g, w_ret_out, conv_w, conv_b, rg_wa, rg_ba, rg_wx,
                                       rg_bx, rg_lambda, w_rnn_out, w_o, peer_wq, peer_keys, peer_u, peer_v)
    return (y_prompt, y_sample, sr_p, sh_p, sc_p, sr_s, sh_s, sc_s)
```

```cpp
#include <hip/hip_runtime.h>
#include <cstdio>
#include <cstdint>

#define LAS __attribute__((address_space(3)))
#define GAS __attribute__((address_space(1)))
typedef unsigned short bf16_t;
typedef short bf16x8 __attribute__((ext_vector_type(8)));
typedef float f32x2 __attribute__((ext_vector_type(2)));
typedef float f32x4 __attribute__((ext_vector_type(4)));
typedef float f32x16 __attribute__((ext_vector_type(16)));
typedef unsigned u32x2 __attribute__((ext_vector_type(2)));
typedef unsigned u32x4 __attribute__((ext_vector_type(4)));
typedef LAS unsigned char* ldsp_t;

#ifndef MK_N_LAUNCHES
#define MK_N_LAUNCHES 0
#endif

constexpr int DM = 1024, NIN = 7168, M_P = 16384, M_S = 1024, MTOT = 17408, DEPTH = 2;
constexpr int SEQ = 2048, NBATCH = 8, DECB = 128, DECT = 8, PAST = 16384;
constexpr int HR = 8, DK = 64, DV = 128, CH = 128;
constexpr int NBLK = 16, BS = 64;
constexpr int PH = 8, NKEY = 128, NEXP = 16384, TOPK = 16, HK = 128;
constexpr float EPS = 1e-6f;
constexpr int LDP = 7168;
constexpr int PC_Q = 0, PC_K = 512, PC_V = 1024, PC_GR = 2048, PC_XR = 3072, PC_GN = 4096, PC_GA = 5120, PC_GB = 6144;
constexpr int PC_MRG = 0, PC_ARET = 1024, PC_ARNN = 4096, PC_QP = 2048;

constexpr size_t MiB = 1u << 20;
constexpr size_t WS_CTL = 0, CTL_ZERO_BYTES = 1 * MiB;
constexpr size_t WS_ROT = 1 * MiB;
constexpr size_t WS_RSS = 2 * MiB;
constexpr size_t WS_RSS2 = 2 * MiB + 128 * 1024;
constexpr size_t WS_RSSP = 2 * MiB + 256 * 1024;
constexpr size_t WS_EIDX = 4 * MiB;
constexpr size_t WS_GATE = 13 * MiB;
constexpr size_t WS_KEYS = 22 * MiB;
constexpr size_t WS_WG = 23 * MiB;
constexpr size_t WS_WIN = 24 * MiB;
constexpr size_t WS_WMIX = 52 * MiB;
constexpr size_t WS_WQ = 64 * MiB;
constexpr size_t WS_XB = 72 * MiB;
constexpr size_t WS_P = 106 * MiB;
constexpr size_t WS_TAB = 344 * MiB;
constexpr size_t WS_END = 472 * MiB;
static_assert(WS_P + (size_t)MTOT * LDP * 2 <= WS_TAB, "ws map");

constexpr size_t O_Y = 0, O_SRP = 17825792, O_SHP = 18874368, O_SCP = 18890752, O_SRS = 18939904, O_SHS = 35717120, O_SCS = 35979264, O_END = 36765696;

constexpr int CW_BAR = 4096;
constexpr int CW_QUEUE = 16384;

constexpr int RING_BYTES = 131072;
constexpr int LDS_BYTES = 155648;
constexpr int MISC_OFF = 153600;
constexpr int NWAVES = 8, NTHREADS = 512;

#define LDS_WAIT() asm volatile("s_waitcnt lgkmcnt(0)" ::: "memory")
#define VM_WAIT() asm volatile("s_waitcnt vmcnt(0)" ::: "memory")
#define RLX_AGENT __ATOMIC_RELAXED, __HIP_MEMORY_SCOPE_AGENT

__device__ __forceinline__ unsigned f2bf(float f) { unsigned u = __builtin_bit_cast(unsigned, f); return (u + 0x7fffu + ((u >> 16) & 1u)) >> 16; }
__device__ __forceinline__ unsigned pk2(float lo, float hi) { return f2bf(lo) | (f2bf(hi) << 16); }
__device__ __forceinline__ float bflo(unsigned w) { return __builtin_bit_cast(float, w << 16); }
__device__ __forceinline__ float bfhi(unsigned w) { return __builtin_bit_cast(float, w & 0xffff0000u); }
__device__ __forceinline__ float bf1(bf16_t h) { return __builtin_bit_cast(float, (unsigned)h << 16); }
__device__ __forceinline__ float sigmoidf_(float x) { return __builtin_amdgcn_rcpf(1.0f + __expf(-x)); }
__device__ __forceinline__ float siluf_(float x) { return x * sigmoidf_(x); }
__device__ __forceinline__ float geluf_(float x) { return x * sigmoidf_(1.5957691216057308f * (x + 0.044715f * x * x * x)); }
__device__ __forceinline__ float logg_of(int h) { return log1pf(-exp2f((float)(-5 - h))); }

namespace pg8 {
constexpr int BM = 256, BK = 64, HALF = 128, HTB = HALF * BK * 2, STAGE_BYTES = 8 * HTB, NXCD = 8, WGM = 8;
__host__ __device__ __forceinline__ int lds_byte(int r, int c) { const int st = (r >> 4) * 2 + (c >> 5), rr = r & 15, cc = c & 31, ob = rr * 64 + cc * 2; return st * 1024 + (ob ^ (((ob >> 9) & 1) << 5)); }
__host__ __device__ __forceinline__ void stage_rc(int b, int& R, int& C) { const int st = b / 1024, sb = b % 1024, swz = sb ^ (((sb >> 9) & 1) << 5); R = (st >> 1) * 16 + swz / 64; C = (st & 1) * 32 + (swz % 64) / 2; }
__host__ __device__ __forceinline__ int perm32(int rho) { const int n = rho >> 4, i = rho & 15; return 8 * (i >> 2) + 4 * n + (i & 3); }

struct Unit { int pm, pn, half; };
struct Gemm { const bf16_t* A; const bf16_t* Bt; int lda, K; size_t aoff2, boff2; };

struct StaticOrder {
    int nM, nN, nwg, G, c, pairs;
    __device__ void init(int M, int N, int G_, int c_, int pairs_) { nM = M / BM; nN = N / BM; nwg = nM * nN; G = G_; c = c_; pairs = pairs_; }
    __device__ bool next(int i, Unit& u) const {
        const int it = (pairs == 2) ? (i >> 1) : i;
        const long L = (long)it * G + c; if (L >= nwg) return false;
        int wgid = (int)L; { const int q = nwg / NXCD, r = nwg % NXCD, xcd = wgid % NXCD, off = wgid / NXCD; wgid = (xcd < r ? xcd * (q + 1) : r * (q + 1) + (xcd - r) * q) + off; }
        const int nig = WGM * nN, gid = wgid / nig, fm = gid * WGM, gsz = (nM - fm) < WGM ? (nM - fm) : WGM;
        u.pm = fm + ((wgid % nig) % gsz); u.pn = (wgid % nig) / gsz; u.half = (pairs == 2) ? (i & 1) : 0; return true;
    }
};

template <class Epi, class Sched, bool ALIGN_EPI>
__device__ __forceinline__ void gemm_phase(ldsp_t lds, const Gemm g, const Sched& S, const Epi& E, const int tid) {
    const int wid = __builtin_amdgcn_readfirstlane(tid >> 6), lane = tid & 63, wr = wid >> 2, wc = wid & 3, fr = lane & 15, fq = lane >> 4;
    const int K = g.K, nt = K / BK;
    unsigned voffA[2], voffB[2];
#pragma unroll
    for (int i = 0; i < 2; ++i) { int R, C; stage_rc(tid * 16 + i * 8192, R, C); const int Rb = Epi::PERM ? ((R & ~31) + perm32(R & 31)) : R;
        voffA[i] = (unsigned)(R * g.lda + C) * 2u; voffB[i] = (unsigned)(Rb * K + C) * 2u; }
    const size_t kstep = (size_t)(BK * 2);
    const size_t hstepA = (size_t)HALF * g.lda * 2, hstepB = (size_t)HALF * K * 2;
    const size_t tstepA = 2 * hstepA, tstepB = 2 * hstepB;
    const unsigned ldsw = (unsigned)wid * 1024u;
    const int aoff = lds_byte(wr * 64 + fr, fq * 8), boff = lds_byte(wc * 32 + fr, fq * 8);
#define PG8_SA(b, h) (((b) * 2 + (h)) * HTB)
#define PG8_SB(b, h) ((4 + (b) * 2 + (h)) * HTB)
#define PG8_STAGE(bufoff, gbase, voff) do { _Pragma("unroll") for (int _i = 0; _i < 2; ++_i) \
        __builtin_amdgcn_global_load_lds((const unsigned*)((const char*)(gbase) + (voff)[_i]), (LAS unsigned*)(lds + (bufoff) + ldsw + _i * 8192), 16, 0, 0); } while (0)
#define PG8_LDA(dst, b, h) do { _Pragma("unroll") for (int m = 0; m < 4; ++m) _Pragma("unroll") for (int k = 0; k < 2; ++k) dst[m][k] = *(const LAS bf16x8*)(lds + PG8_SA(b, h) + aoff + m * 2048 + k * 1024); } while (0)
#define PG8_LDB(dst, b, h) do { _Pragma("unroll") for (int n = 0; n < 2; ++n) _Pragma("unroll") for (int k = 0; k < 2; ++k) dst[n][k] = *(const LAS bf16x8*)(lds + PG8_SB(b, h) + boff + n * 2048 + k * 1024); } while (0)
#define PG8_MMA(ai, bj, At, Bt) do { __builtin_amdgcn_s_setprio(1); _Pragma("unroll") for (int m = 0; m < 4; ++m) _Pragma("unroll") for (int n = 0; n < 2; ++n) _Pragma("unroll") for (int k = 0; k < 2; ++k) \
        acc[ai][bj][m][n] = __builtin_amdgcn_mfma_f32_16x16x32_bf16(Bt[n][k], At[m][k], acc[ai][bj][m][n], 0, 0, 0); __builtin_amdgcn_s_setprio(0); } while (0)
#define PG8_WAIT_V(n) asm volatile("s_waitcnt vmcnt(" #n ")" ::: "memory")
#define PG8_WAIT_L(n) asm volatile("s_waitcnt lgkmcnt(" #n ")" ::: "memory")
#define PG8_BAR __builtin_amdgcn_s_barrier()
#define PG8_SCHED __builtin_amdgcn_sched_barrier(0)
    Unit cur, nxt; int ui = 0;
    if (!S.next(0, cur)) return;
    f32x4 acc[2][2][4][2];
#pragma unroll
    for (int a = 0; a < 2; ++a)
#pragma unroll
        for (int b = 0; b < 2; ++b)
#pragma unroll
            for (int m = 0; m < 4; ++m)
#pragma unroll
                for (int n = 0; n < 2; ++n) acc[a][b][m][n] = (f32x4){0.f, 0.f, 0.f, 0.f};
    bf16x8 At[4][2], B0[2][2], B1[2][2];
    const char* cA = (const char*)g.A + (size_t)cur.pm * tstepA + (cur.half ? g.aoff2 : 0); const char* cB = (const char*)g.Bt + (size_t)cur.pn * tstepB + (cur.half ? g.boff2 : 0);
    PG8_STAGE(PG8_SB(0, 0), cB, voffB); PG8_STAGE(PG8_SB(0, 1), cB + hstepB, voffB); PG8_STAGE(PG8_SA(0, 0), cA, voffA); PG8_STAGE(PG8_SA(0, 1), cA + hstepA, voffA);
    if (wr == 1) PG8_BAR;
    PG8_WAIT_V(2); PG8_BAR;
    PG8_STAGE(PG8_SB(1, 0), cB + kstep, voffB); PG8_STAGE(PG8_SA(1, 0), cA + kstep, voffA); PG8_STAGE(PG8_SB(1, 1), cB + hstepB + kstep, voffB);
    PG8_WAIT_V(6); PG8_BAR;
    for (;;) {
        const bool has_next = S.next(ui + 1, nxt);
        const char* nA = has_next ? (const char*)g.A + (size_t)nxt.pm * tstepA + (nxt.half ? g.aoff2 : 0) : cA;
        const char* nB = has_next ? (const char*)g.Bt + (size_t)nxt.pn * tstepB + (nxt.half ? g.boff2 : 0) : cB;
        for (int t = 0; t < nt; t += 2) {
            const bool last = (t == nt - 2);
            const char* a1 = cA + (size_t)(t + 1) * kstep;
            const char* a2 = last ? nA : cA + (size_t)(t + 2) * kstep; const char* b2 = last ? nB : cB + (size_t)(t + 2) * kstep;
            const char* a3 = a2 + kstep; const char* b3 = b2 + kstep;
            PG8_LDB(B0, 0, 0); PG8_LDB(B1, 0, 1); PG8_SCHED; PG8_LDA(At, 0, 0); PG8_STAGE(PG8_SA(1, 1), a1 + hstepA, voffA);
            PG8_WAIT_V(8); PG8_WAIT_L(0); PG8_BAR; PG8_MMA(0, 0, At, B0); PG8_MMA(0, 1, At, B1); PG8_BAR; PG8_SCHED;
            PG8_LDA(At, 0, 1); PG8_STAGE(PG8_SB(0, 0), b2, voffB); PG8_STAGE(PG8_SB(0, 1), b2 + hstepB, voffB); PG8_STAGE(PG8_SA(0, 0), a2, voffA);
            PG8_WAIT_V(8); PG8_WAIT_L(0); PG8_BAR; PG8_MMA(1, 0, At, B0); PG8_MMA(1, 1, At, B1); PG8_BAR; PG8_SCHED;
            PG8_LDB(B0, 1, 0); PG8_LDB(B1, 1, 1); PG8_SCHED; PG8_LDA(At, 1, 0); PG8_STAGE(PG8_SA(0, 1), a2 + hstepA, voffA);
            PG8_WAIT_V(8); PG8_WAIT_L(0); PG8_BAR; PG8_MMA(0, 0, At, B0); PG8_MMA(0, 1, At, B1); PG8_BAR; PG8_SCHED;
            PG8_LDA(At, 1, 1); PG8_STAGE(PG8_SB(1, 0), b3, voffB); PG8_STAGE(PG8_SB(1, 1), b3 + hstepB, voffB); PG8_STAGE(PG8_SA(1, 0), a3, voffA);
            PG8_WAIT_V(8); PG8_WAIT_L(0); PG8_BAR; PG8_MMA(1, 0, At, B0); PG8_MMA(1, 1, At, B1); PG8_BAR; PG8_SCHED;
        }
        if constexpr (ALIGN_EPI) { if (wr == 0) PG8_BAR; }
        E(acc, cur, wr, wc, fr, fq);
        if (!has_next) break;
#pragma unroll
        for (int a = 0; a < 2; ++a)
#pragma unroll
            for (int b = 0; b < 2; ++b)
#pragma unroll
                for (int m = 0; m < 4; ++m)
#pragma unroll
                    for (int n = 0; n < 2; ++n) acc[a][b][m][n] = (f32x4){0.f, 0.f, 0.f, 0.f};
        cur = nxt; cA = nA; cB = nB; ++ui;
        if constexpr (ALIGN_EPI) { if (wr == 1) PG8_BAR; }
    }
    PG8_WAIT_V(0);
    if constexpr (!ALIGN_EPI) { if (wr == 0) PG8_BAR; }
    PG8_BAR;
#undef PG8_SA
#undef PG8_SB
#undef PG8_STAGE
#undef PG8_LDA
#undef PG8_LDB
#undef PG8_MMA
#undef PG8_WAIT_V
#undef PG8_WAIT_L
#undef PG8_BAR
#undef PG8_SCHED
}
}

typedef GAS unsigned gu32;
#define XB_TMO      128
#define XB_XCNT(j)  (256  + 64 * (j))
#define XB_XSUB(j)  (1280 + 64 * (j))
#define XB_XGEN(j)  (2304 + 64 * (j))
#define XB_TOP      3328
#define XB_TOPGEN   3392
#define XCD_BAR_WORDS 3456
#define XB_SPIN_CAP (1u << 18)
__device__ __forceinline__ unsigned xb_ld(unsigned* p)              { return __hip_atomic_load(p, __ATOMIC_RELAXED, __HIP_MEMORY_SCOPE_AGENT); }
__device__ __forceinline__ unsigned xb_add(unsigned* p, unsigned v) { return __hip_atomic_fetch_add(p, v, __ATOMIC_RELAXED, __HIP_MEMORY_SCOPE_AGENT); }
__device__ __forceinline__ unsigned xb_xcc_id() { return (unsigned)__builtin_amdgcn_s_getreg((3 << 11) | 20) & 0xFu; }
#define XB_SPIN(cond, bar) do { unsigned _sp = 0; while (cond) { __builtin_amdgcn_s_sleep(1); \
    if ((++_sp & 255u) == 0u) { if (xb_ld(&(bar)[XB_TMO])) break; if (_sp > XB_SPIN_CAP) { atomicAdd(&(bar)[XB_TMO], 1u); break; } } } } while (0)
struct XcdBarrier { unsigned* bar; unsigned x; volatile LAS unsigned* st; };
__device__ __forceinline__ XcdBarrier xcd_barrier_post(unsigned* bar, volatile LAS unsigned* st) {
    XcdBarrier b; b.bar = bar; b.x = xb_xcc_id(); b.st = st;
    if (threadIdx.x == 0) (void)xb_add(&bar[XB_XCNT(b.x)], 1u);
    return b;
}
__device__ __forceinline__ void xcd_barrier_complete(unsigned* bar, unsigned x, unsigned& nloc, unsigned& nx) {
    const unsigned G = gridDim.x * gridDim.y * gridDim.z;
    unsigned sum, cnt, mine, sp = 0u;
    for (;;) {
        sum = 0u; cnt = 0u; mine = 0u;
#pragma unroll
        for (unsigned j = 0; j < 16; ++j) { const unsigned c = xb_ld(&bar[XB_XCNT(j)]); sum += c; cnt += (c > 0u) ? 1u : 0u; mine = (j == x) ? c : mine; }
        if (sum == G) break;
        __builtin_amdgcn_s_sleep(1);
        if ((++sp & 255u) == 0u) { if (xb_ld(&bar[XB_TMO])) break; if (sp > XB_SPIN_CAP) { atomicAdd(&bar[XB_TMO], 1u); break; } }
    }
    nloc = mine > 0u ? mine : 1u; nx = cnt > 0u ? cnt : 1u;
}
__device__ __forceinline__ void xcd_barrier(const XcdBarrier& b) {
    asm volatile("s_waitcnt vmcnt(0)" ::: "memory");
    __syncthreads();
    if (threadIdx.x == 0) {
        unsigned* bar = b.bar;
        __builtin_amdgcn_s_waitcnt(0);
        unsigned nloc = b.st[0], nx = b.st[1];
        if (nloc == 0u) { xcd_barrier_complete(bar, b.x, nloc, nx); b.st[0] = nloc; b.st[1] = nx; }
        const unsigned old = xb_add(&bar[XB_XSUB(b.x)], 1u);
        const unsigned gen = old / nloc;
        if (old + 1u == (gen + 1u) * nloc) {
            __builtin_amdgcn_fence(__ATOMIC_RELEASE, "agent");
            asm volatile("s_waitcnt vmcnt(0)" ::: "memory");
            const unsigned og = xb_add(&bar[XB_TOP], 1u);
            const unsigned tg = og / nx;
            if (og + 1u == (tg + 1u) * nx) xb_add(&bar[XB_TOPGEN], 1u);
            else XB_SPIN(xb_ld(&bar[XB_TOPGEN]) == tg, bar);
            __builtin_amdgcn_fence(__ATOMIC_ACQUIRE, "agent");
            xb_add(&bar[XB_XGEN(b.x)], 1u);
            asm volatile("s_waitcnt vmcnt(0)" ::: "memory");
        } else {
            XB_SPIN(xb_ld(&bar[XB_XGEN(b.x)]) == gen, bar);
            __builtin_amdgcn_fence(__ATOMIC_ACQUIRE, "agent");
            asm volatile("s_waitcnt vmcnt(0)" ::: "memory");
        }
    }
    __syncthreads();
}

struct Frame {
    ldsp_t lds;
    volatile LAS unsigned* MISC;
    unsigned* ctl;
    int tid, lane, wave, vcu, G;
    const float* const* in;
    unsigned char* ws;
    float* out;
};
struct Args { const float* in[24]; float* out; unsigned char* ws; int ph_lo, ph_hi; };

__device__ __forceinline__ float wave_sum(float v) {
#pragma unroll
    for (int o = 1; o < 64; o <<= 1) v += __shfl_xor(v, o);
    return v;
}

__device__ __forceinline__ void p0_transpose_item(const float* W, int K, int N, bf16_t* WT, int ldk, const float* rowscale, float colscale, bool qkperm, LAS float* scr, int item, int lane) {
    const int nblk = N / 32, kb = item / nblk, nb = item % nblk, k0 = 64 * kb, n0 = 32 * nb;
    int srcn = n0 + (lane & 31);
    if (qkperm) { const int p = srcn & 63; srcn = (srcn & ~63) + ((p & 1) ? 32 + (p >> 1) : (p >> 1)); }
#pragma unroll 8
    for (int i = 0; i < 32; ++i) { const int kk = 2 * i + (lane >> 5); float v = W[(size_t)(k0 + kk) * N + srcn] * colscale; if (rowscale) v *= rowscale[k0 + kk]; scr[kk * 33 + (lane & 31)] = v; }
    LDS_WAIT(); asm volatile("" ::: "memory");
    const int c = lane & 7;
#pragma unroll
    for (int j = 0; j < 4; ++j) { const int n = (lane >> 3) + 8 * j; const LAS float* s = scr + (8 * c) * 33 + n;
        u32x4 o; o.x = pk2(s[0 * 33], s[1 * 33]); o.y = pk2(s[2 * 33], s[3 * 33]); o.z = pk2(s[4 * 33], s[5 * 33]); o.w = pk2(s[6 * 33], s[7 * 33]);
        *(u32x4*)(WT + (size_t)(n0 + n) * ldk + k0 + 8 * c) = o; }
    LDS_WAIT(); asm volatile("" ::: "memory");
}

__device__ __forceinline__ void p0_xrow(const float* xrow, bf16_t* orow, float* rss, int lane) {
    const f32x4* xr = (const f32x4*)xrow + lane;
    f32x4 v[4]; float s = 0.f;
#pragma unroll
    for (int j = 0; j < 4; ++j) { v[j] = xr[64 * j]; s += (v[j].x * v[j].x + v[j].y * v[j].y) + (v[j].z * v[j].z + v[j].w * v[j].w); }
    s = wave_sum(s);
    u32x2* o8 = (u32x2*)orow + lane;
#pragma unroll
    for (int j = 0; j < 4; ++j) { u32x2 w; w.x = pk2(v[j].x, v[j].y); w.y = pk2(v[j].z, v[j].w); o8[64 * j] = w; }
    if (lane == 0) *rss = s;
}

__device__ __forceinline__ void p0_tabrow(const float* row, bf16_t* img, int e, int lane) {
    const f32x4* xr = (const f32x4*)row + lane;
#pragma unroll
    for (int j = 0; j < 4; ++j) { const f32x4 v = xr[64 * j]; const int col = 256 * j + 4 * lane, s = col >> 6, w = col & 63;
        u32x2 o; o.x = pk2(v.x, v.y); o.y = pk2(v.z, v.w);
        *(u32x2*)(img + ((size_t)s * NEXP + e) * 64 + w) = o; }
}

__device__ __forceinline__ void p0_prologue(const Args& a, Frame& F) {
    unsigned char* ws = a.ws;
    LAS float* scr = (LAS float*)(F.lds + F.wave * 16384);
    const int gw = F.vcu * NWAVES + F.wave, NGW = F.G * NWAVES, lane = F.lane;
    constexpr int I_IN = (DM / 64) * (NIN / 32), I_SQ = (DM / 64) * (DM / 32), I_Q = (DM / 64) * (2048 / 32), I_G = 2;
    constexpr int PER_L = I_IN + 3 * I_SQ + I_Q + 32 * I_G;
    for (int it = gw; it < DEPTH * PER_L; it += NGW) {
        const int l = it / PER_L; int r = it % PER_L;
        if (r < I_IN) { const int nb = r % (NIN / 32), n0 = nb * 32; const int seg = n0 >> 9;
            p0_transpose_item(a.in[8] + (size_t)l * DM * NIN, DM, NIN, (bf16_t*)(ws + WS_WIN) + (size_t)l * NIN * DM, DM, a.in[5] + l * DM, seg == 1 ? 0.125f : 1.0f, seg <= 1, scr, r, lane); continue; }
        r -= I_IN;
        if (r < I_SQ) { p0_transpose_item(a.in[10] + (size_t)l * DM * DM, DM, DM, (bf16_t*)(ws + WS_WMIX + (size_t)l * 6 * MiB), DM, a.in[9] + l * DM, 1.0f, false, scr, r, lane); continue; }
        r -= I_SQ;
        if (r < I_SQ) { p0_transpose_item(a.in[18] + (size_t)l * DM * DM, DM, DM, (bf16_t*)(ws + WS_WMIX + (size_t)l * 6 * MiB + 2 * MiB), DM, nullptr, 1.0f, false, scr, r, lane); continue; }
        r -= I_SQ;
        if (r < I_SQ) { p0_transpose_item(a.in[19] + (size_t)l * DM * DM, DM, DM, (bf16_t*)(ws + WS_WMIX + (size_t)l * 6 * MiB + 4 * MiB), DM, nullptr, 1.0f, false, scr, r, lane); continue; }
        r -= I_SQ;
        if (r < I_Q) { p0_transpose_item(a.in[20] + (size_t)l * DM * 2048, DM, 2048, (bf16_t*)(ws + WS_WQ) + (size_t)l * 2048 * DM, DM, a.in[6] + l * DM, 1.0f, false, scr, r, lane); continue; }
        r -= I_Q;
        { const int mat = r >> 1, sub = r & 1, nb = mat >> 1, gsel = mat & 1;
          const float* W = (gsel ? a.in[15] : a.in[13]) + ((size_t)l * NBLK + nb) * BS * BS;
          bf16_t* WT = (bf16_t*)(ws + WS_WG) + (((size_t)l * NBLK + nb) * 2 + gsel) * BS * BS;
          p0_transpose_item(W, BS, BS, WT, BS, nullptr, 1.0f, false, scr, sub, lane); }
    }
    { const float* ksrc = a.in[21]; bf16_t* kdst = (bf16_t*)(ws + WS_KEYS); const int n4 = DEPTH * PH * 2 * NKEY * HK / 4;
      for (int i = gw * 64 + lane; i < n4; i += NGW * 64) { const f32x4 v = ((const f32x4*)ksrc)[i]; u32x2 o; o.x = pk2(v.x, v.y); o.y = pk2(v.z, v.w); ((u32x2*)kdst)[i] = o; } }
    for (int m = gw; m < MTOT; m += NGW) {
        const float* xr = m < M_P ? a.in[0] + (size_t)m * DM : a.in[1] + (size_t)(m - M_P) * DM;
        p0_xrow(xr, (bf16_t*)(ws + WS_XB) + (size_t)m * DM, (float*)(ws + WS_RSS) + m, lane);
    }
    { float* rot = (float*)(ws + WS_ROT);
      for (int i = gw * 64 + lane; i < 2056 * 32; i += NGW * 64) {
          const int pi = i >> 5, fi = i & 31; const double pos = pi < 2048 ? (double)pi : (double)(PAST + pi - 2048);
          const double f8[8] = {1.0, 0.7498942093324559, 0.5623413251903491, 0.4216965034285822, 0.31622776601683794, 0.23713737056616552, 0.1778279410038923, 0.1333521432163324};
          double fr = 1.0; switch (fi >> 3) { case 1: fr = 0.1; break; case 2: fr = 0.01; break; case 3: fr = 0.001; break; default: break; }
          double fsel = f8[0];
#pragma unroll
          for (int q = 1; q < 8; ++q) fsel = ((fi & 7) == q) ? f8[q] : fsel;
          const double ang = pos * (fr * fsel);
          const double n = __builtin_rint(ang * 0.15915494309189535);
          double rr = __builtin_fma(-n, 6.283185307179586, ang); rr = __builtin_fma(-n, 2.4492935982947064e-16, rr);
          const float rf = (float)rr;
          rot[(size_t)pi * 64 + fi] = cosf(rf); rot[(size_t)pi * 64 + 32 + fi] = sinf(rf);
      } }
    for (int r = gw; r < DEPTH * 2 * NEXP; r += NGW) {
        const int l = r / (2 * NEXP), t = (r / NEXP) & 1, e = r % NEXP;
        const float* src = (t ? a.in[23] : a.in[22]) + ((size_t)l * NEXP + e) * DM;
        bf16_t* img = (bf16_t*)(ws + WS_TAB + ((size_t)l * 2 + t) * 32 * MiB);
        p0_tabrow(src, img, e, lane);
    }
}

namespace pg8 {
struct EpiIn {
    static constexpr bool PERM = true;
    bf16_t* P; const float* rss; const float* rot;
    __device__ __forceinline__ void operator()(const f32x4 (&acc)[2][2][4][2], const Unit& u, int wr, int wc, int fr, int fq) const {
        const int seg = u.pn < 4 ? (u.pn >> 1) : (u.pn >> 2) + 1;
        const int row0 = u.pm * BM + wr * 64 + fr;
        if (seg <= 1) {
            float lg[2];
#pragma unroll
            for (int bj = 0; bj < 2; ++bj) { const int hh = 4 * (u.pn & 1) + 2 * bj + (wc >> 1); lg[bj] = logg_of(hh); }
            const int i0 = 16 * (wc & 1) + 4 * fq;
#pragma unroll
            for (int ai = 0; ai < 2; ++ai)
#pragma unroll
                for (int m = 0; m < 4; ++m) {
                    const int row = row0 + ai * HALF + m * 16;
                    const float rstd = rsqrtf(rss[row] * (1.0f / DM) + EPS);
                    const int pi = row < M_P ? (row & (SEQ - 1)) : SEQ + ((row - M_P) & (DECT - 1));
                    const float jj1 = (float)((row < M_P ? (row & (CH - 1)) : ((row - M_P) & (DECT - 1))) + 1);
                    const f32x4 c4 = *(const f32x4*)(rot + (size_t)pi * 64 + i0), s4 = *(const f32x4*)(rot + (size_t)pi * 64 + 32 + i0);
#pragma unroll
                    for (int bj = 0; bj < 2; ++bj) {
                        const int hh = 4 * (u.pn & 1) + 2 * bj + (wc >> 1);
                        const float f = __expf(seg == 0 ? jj1 * lg[bj] : -jj1 * lg[bj]) * rstd;
                        const f32x4 v0 = acc[ai][bj][m][0], v1 = acc[ai][bj][m][1];
                        const f32x4 x1 = (f32x4){v0[0], v0[2], v1[0], v1[2]}, x2 = (f32x4){v0[1], v0[3], v1[1], v1[3]};
                        const f32x4 o1 = (x1 * c4 - x2 * s4) * f, o2 = (x1 * s4 + x2 * c4) * f;
                        bf16_t* dst = P + (size_t)row * LDP + seg * 512 + hh * 64 + i0;
                        u32x2 w1, w2; w1.x = pk2(o1[0], o1[1]); w1.y = pk2(o1[2], o1[3]); w2.x = pk2(o2[0], o2[1]); w2.y = pk2(o2[2], o2[3]);
                        *(u32x2*)dst = w1; *(u32x2*)(dst + 32) = w2;
                    }
                    asm volatile("" ::: "memory");
                }
        } else {
            const int col0 = u.pn * BM + wc * 32 + 8 * fq;
#pragma unroll
            for (int ai = 0; ai < 2; ++ai)
#pragma unroll
                for (int m = 0; m < 4; ++m) {
                    const int row = row0 + ai * HALF + m * 16;
                    const float rstd = rsqrtf(rss[row] * (1.0f / DM) + EPS);
                    bf16_t* rowp = P + (size_t)row * LDP + col0;
#pragma unroll
                    for (int bj = 0; bj < 2; ++bj) {
                        f32x4 v0 = acc[ai][bj][m][0] * rstd, v1 = acc[ai][bj][m][1] * rstd;
                        if (seg == 3) {
#pragma unroll
                            for (int j = 0; j < 4; ++j) { v0[j] = siluf_(v0[j]); v1[j] = siluf_(v1[j]); }
                        } else if (seg == 5) {
#pragma unroll
                            for (int j = 0; j < 4; ++j) { v0[j] = geluf_(v0[j]); v1[j] = geluf_(v1[j]); }
                        } else if (seg >= 6) {
#pragma unroll
                            for (int j = 0; j < 4; ++j) { v0[j] = sigmoidf_(v0[j]); v1[j] = sigmoidf_(v1[j]); }
                        }
                        u32x4 w; w.x = pk2(v0[0], v0[1]); w.y = pk2(v0[2], v0[3]); w.z = pk2(v1[0], v1[1]); w.w = pk2(v1[2], v1[3]);
                        *(u32x4*)(rowp + bj * HALF) = w;
                    }
                    asm volatile("" ::: "memory");
                }
        }
    }
};

struct EpiMerge {
    static constexpr bool PERM = true;
    bf16_t* P;
    __device__ __forceinline__ void operator()(const f32x4 (&acc)[2][2][4][2], const Unit& u, int wr, int wc, int fr, int fq) const {
        const int row0 = u.pm * BM + wr * 64 + fr, col0 = u.pn * BM + wc * 32 + 8 * fq;
        const int gc = u.half ? PC_GB : PC_GA;
#pragma unroll
        for (int ai = 0; ai < 2; ++ai)
#pragma unroll
            for (int m = 0; m < 4; ++m) {
                bf16_t* rowp = P + (size_t)(row0 + ai * HALF + m * 16) * LDP;
#pragma unroll
                for (int bj = 0; bj < 2; ++bj) {
                    const int c = col0 + bj * HALF;
                    const u32x4 g = *(const u32x4*)(rowp + gc + c);
                    f32x4 v0 = acc[ai][bj][m][0], v1 = acc[ai][bj][m][1];
                    v0[0] *= bflo(g.x); v0[1] *= bfhi(g.x); v0[2] *= bflo(g.y); v0[3] *= bfhi(g.y);
                    v1[0] *= bflo(g.z); v1[1] *= bfhi(g.z); v1[2] *= bflo(g.w); v1[3] *= bfhi(g.w);
                    if (u.half) { const u32x4 p = *(const u32x4*)(rowp + PC_MRG + c);
                        v0[0] += bflo(p.x); v0[1] += bfhi(p.x); v0[2] += bflo(p.y); v0[3] += bfhi(p.y);
                        v1[0] += bflo(p.z); v1[1] += bfhi(p.z); v1[2] += bflo(p.w); v1[3] += bfhi(p.w); }
                    u32x4 w; w.x = pk2(v0[0], v0[1]); w.y = pk2(v0[2], v0[3]); w.z = pk2(v1[0], v1[1]); w.w = pk2(v1[2], v1[3]);
                    *(u32x4*)(rowp + PC_MRG + c) = w;
                }
                asm volatile("" ::: "memory");
            }
    }
};

struct EpiWo {
    static constexpr bool PERM = false;
    const float* xp; const float* xs;
    float* X; bf16_t* XB; float* rssp;
    __device__ __forceinline__ void operator()(const f32x4 (&acc)[2][2][4][2], const Unit& u, int wr, int wc, int fr, int fq) const {
        const int row0 = u.pm * BM + wr * 64 + fr, col0 = u.pn * BM + wc * 32 + 4 * fq;
#pragma unroll
        for (int ai = 0; ai < 2; ++ai)
#pragma unroll
            for (int m = 0; m < 4; ++m) {
                const int row = row0 + ai * HALF + m * 16;
                const float* src = (row < M_P ? xp + (size_t)row * DM : xs + (size_t)(row - M_P) * DM) + col0;
                float* dst = X + (size_t)row * DM + col0; bf16_t* dstb = XB + (size_t)row * DM + col0;
                float ss = 0.f;
#pragma unroll
                for (int bj = 0; bj < 2; ++bj)
#pragma unroll
                    for (int n = 0; n < 2; ++n) {
                        const f32x4 o = *(const f32x4*)(src + bj * HALF + n * 16) + acc[ai][bj][m][n];
                        *(f32x4*)(dst + bj * HALF + n * 16) = o;
                        u32x2 w; w.x = pk2(o[0], o[1]); w.y = pk2(o[2], o[3]); *(u32x2*)(dstb + bj * HALF + n * 16) = w;
                        ss += (o[0] * o[0] + o[1] * o[1]) + (o[2] * o[2] + o[3] * o[3]);
                    }
                ss += __shfl_xor(ss, 16); ss += __shfl_xor(ss, 32);
                if (fq == 0) rssp[(size_t)(u.pn * 4 + wc) * MTOT + row] = ss;
                asm volatile("" ::: "memory");
            }
    }
};

struct EpiQ {
    static constexpr bool PERM = true;
    bf16_t* P; const float* rssp; float* rss2;
    __device__ __forceinline__ void operator()(const f32x4 (&acc)[2][2][4][2], const Unit& u, int wr, int wc, int fr, int fq) const {
        const int row0 = u.pm * BM + wr * 64 + fr, col0 = u.pn * BM + wc * 32 + 8 * fq;
#pragma unroll
        for (int ai = 0; ai < 2; ++ai)
#pragma unroll
            for (int m = 0; m < 4; ++m) {
                const int row = row0 + ai * HALF + m * 16;
                float s = 0.f;
#pragma unroll
                for (int j = 0; j < 16; ++j) s += rssp[(size_t)j * MTOT + row];
                if (u.pn == 0 && wc == 0 && fq == 0) rss2[row] = s;
                const float rstd = rsqrtf(s * (1.0f / DM) + EPS);
                bf16_t* rowp = P + (size_t)row * LDP + PC_QP + col0;
#pragma unroll
                for (int bj = 0; bj < 2; ++bj) {
                    const f32x4 v0 = acc[ai][bj][m][0] * rstd, v1 = acc[ai][bj][m][1] * rstd;
                    u32x4 w; w.x = pk2(v0[0], v0[1]); w.y = pk2(v0[2], v0[3]); w.z = pk2(v1[0], v1[1]); w.w = pk2(v1[2], v1[3]);
                    *(u32x4*)(rowp + bj * HALF) = w;
                }
                asm volatile("" ::: "memory");
            }
    }
};
}

__device__ __forceinline__ void mma32(f32x16& acc, ldsp_t A, int lda_b, ldsp_t Bt, int ldb_b, int ksteps, int lane) {
    ldsp_t ap = A + (lane & 31) * lda_b + (lane >> 5) * 16;
    ldsp_t bp = Bt + (lane & 31) * ldb_b + (lane >> 5) * 16;
    for (int ks = 0; ks < ksteps; ++ks) {
        const bf16x8 a = *(const LAS bf16x8*)(ap + ks * 32), b = *(const LAS bf16x8*)(bp + ks * 32);
        acc = __builtin_amdgcn_mfma_f32_32x32x16_bf16(a, b, acc, 0, 0, 0);
    }
}
#define ZERO16 ((f32x16){0.f,0.f,0.f,0.f,0.f,0.f,0.f,0.f,0.f,0.f,0.f,0.f,0.f,0.f,0.f,0.f})

constexpr int R_QS = 0, R_KS = 18432, R_KST = 36864, R_VST = 54272, R_SS = 89088, R_RST = 123904, R_ST = 142336;
constexpr int LD64 = 144, LD128 = 272;
__device__ __forceinline__ void ret_prompt_unit(const Args& a, Frame& F, int l, int b, int h) {
    const int tid = F.tid, lane = F.lane, w = F.wave, hi = lane >> 5, l31 = lane & 31;
    ldsp_t lds = F.lds;
    bf16_t* P = (bf16_t*)(a.ws + WS_P);
    const float lg = logg_of(h), G = __expf(128.0f * lg);
    f32x16 racc = ZERO16;
    const int db = w >> 2, eb = w & 3;
    for (int n = 0; n < 16; ++n) {
        const size_t tok0 = (size_t)b * SEQ + n * CH;
#pragma unroll
        for (int i = 0; i < 2; ++i) { const int p = tid + 512 * i, row = p >> 3, c8 = p & 7;
            const bf16_t* src = P + (tok0 + row) * LDP + h * 64 + c8 * 8;
            const u32x4 qv = *(const u32x4*)(src + PC_Q), kv = *(const u32x4*)(src + PC_K);
            *(LAS u32x4*)(lds + R_QS + row * LD64 + c8 * 16) = qv; *(LAS u32x4*)(lds + R_KS + row * LD64 + c8 * 16) = kv;
            const unsigned kw[4] = {kv.x, kv.y, kv.z, kv.w};
#pragma unroll
            for (int j = 0; j < 4; ++j) { *(LAS bf16_t*)(lds + R_KST + (c8 * 8 + 2 * j) * LD128 + row * 2) = (bf16_t)(kw[j] & 0xffffu); *(LAS bf16_t*)(lds + R_KST + (c8 * 8 + 2 * j + 1) * LD128 + row * 2) = (bf16_t)(kw[j] >> 16); } }
#pragma unroll
        for (int i = 0; i < 4; ++i) { const int p = tid + 512 * i, row = p >> 4, c8 = p & 15;
            const u32x4 vv = *(const u32x4*)(P + (tok0 + row) * LDP + PC_V + h * 128 + c8 * 8);
            const unsigned vw[4] = {vv.x, vv.y, vv.z, vv.w};
#pragma unroll
            for (int j = 0; j < 4; ++j) { *(LAS bf16_t*)(lds + R_VST + (c8 * 8 + 2 * j) * LD128 + row * 2) = (bf16_t)(vw[j] & 0xffffu); *(LAS bf16_t*)(lds + R_VST + (c8 * 8 + 2 * j + 1) * LD128 + row * 2) = (bf16_t)(vw[j] >> 16); } }
#pragma unroll
        for (int g = 0; g < 4; ++g) { u32x2 wv; wv.x = pk2(racc[4 * g], racc[4 * g + 1]); wv.y = pk2(racc[4 * g + 2], racc[4 * g + 3]);
            *(LAS u32x2*)(lds + R_RST + (32 * eb + l31) * LD64 + (32 * db + 8 * g + 4 * hi) * 2) = wv; }
        __syncthreads();
#pragma unroll
        for (int t2 = 0; t2 < 2; ++t2) { const int t = 2 * w + t2, mb = t >> 2, jb = t & 3;
            if (mb <= jb) { f32x16 sacc = ZERO16;
                mma32(sacc, lds + R_KS + mb * 32 * LD64, LD64, lds + R_QS + jb * 32 * LD64, LD64, 4, lane);
                const int j = 32 * jb + l31;
#pragma unroll
                for (int g = 0; g < 4; ++g) { const int m0 = 32 * mb + 8 * g + 4 * hi; float v[4];
#pragma unroll
                    for (int q = 0; q < 4; ++q) v[q] = (j >= m0 + q) ? sacc[4 * g + q] : 0.f;
                    u32x2 wv; wv.x = pk2(v[0], v[1]); wv.y = pk2(v[2], v[3]);
                    *(LAS u32x2*)(lds + R_SS + j * LD128 + m0 * 2) = wv; } } }
        __syncthreads();
        const int jb = w >> 1, eh = w & 1;
        f32x16 oacc[2];
#pragma unroll
        for (int t = 0; t < 2; ++t) { oacc[t] = ZERO16; const int e2 = 2 * eh + t;
            mma32(oacc[t], lds + R_RST + e2 * 32 * LD64, LD64, lds + R_QS + jb * 32 * LD64, LD64, 4, lane);
            mma32(oacc[t], lds + R_VST + e2 * 32 * LD128, LD128, lds + R_SS + jb * 32 * LD128, LD128, 2 * (jb + 1), lane); }
        float s1 = 0.f, s2 = 0.f;
#pragma unroll
        for (int t = 0; t < 2; ++t)
#pragma unroll
            for (int r = 0; r < 16; ++r) { s1 += oacc[t][r]; s2 += oacc[t][r] * oacc[t][r]; }
        s1 += __shfl_xor(s1, 32); s2 += __shfl_xor(s2, 32);
        if (hi == 0) *(LAS f32x2*)(lds + R_ST + (eh * 128 + 32 * jb + l31) * 8) = (f32x2){s1, s2};
        __syncthreads();
        { const int j = 32 * jb + l31;
          const f32x2 sa = *(const LAS f32x2*)(lds + R_ST + j * 8), sb = *(const LAS f32x2*)(lds + R_ST + (128 + j) * 8);
          const float mu = (sa.x + sb.x) * (1.0f / DV), var = (sa.y + sb.y) * (1.0f / DV) - mu * mu, rstd = rsqrtf(fmaxf(var, 0.f) + EPS);
          bf16_t* prow = P + (tok0 + j) * LDP + h * 128;
#pragma unroll
          for (int t = 0; t < 2; ++t)
#pragma unroll
              for (int g = 0; g < 4; ++g) { const int e0 = 32 * (2 * eh + t) + 8 * g + 4 * hi;
                  const u32x2 gv = *(const u32x2*)(prow + PC_GR + e0);
                  const float o0 = (oacc[t][4 * g] - mu) * rstd * bflo(gv.x), o1 = (oacc[t][4 * g + 1] - mu) * rstd * bfhi(gv.x);
                  const float o2 = (oacc[t][4 * g + 2] - mu) * rstd * bflo(gv.y), o3 = (oacc[t][4 * g + 3] - mu) * rstd * bfhi(gv.y);
                  u32x2 wv; wv.x = pk2(o0, o1); wv.y = pk2(o2, o3);
                  *(u32x2*)(prow + PC_ARET + e0) = wv; } }
        mma32(racc, lds + R_KST + db * 32 * LD128, LD128, lds + R_VST + eb * 32 * LD128, LD128, 8, lane);
#pragma unroll
        for (int r = 0; r < 16; ++r) racc[r] *= G;
        __syncthreads();
    }
    float* so = a.out + O_SRP + ((((size_t)l * NBATCH + b) * HR + h) * DK) * DV;
#pragma unroll
    for (int r = 0; r < 16; ++r) { const int d = 32 * db + (r & 3) + 8 * (r >> 2) + 4 * hi; so[(size_t)d * DV + 32 * eb + l31] = racc[r]; }
}

__device__ __forceinline__ void ret_sample_unit(const Args& a, Frame& F, int l, int bs, int h) {
    const int tid = F.tid, lane = F.lane, w = F.wave;
    LAS float* qd = (LAS float*)F.lds; LAS float* ku = qd + 512; LAS float* vv = ku + 512; LAS float* S = vv + 1024; LAS float* crossp = S + 64; LAS float* red = crossp + 4096;
    bf16_t* P = (bf16_t*)(a.ws + WS_P);
    const size_t tok0 = (size_t)M_P + bs * DECT;
    { const int j = tid >> 6, d = tid & 63; const bf16_t* src = P + (tok0 + j) * LDP + h * 64 + d; qd[tid] = bf1(src[PC_Q]); ku[tid] = bf1(src[PC_K]); }
#pragma unroll
    for (int i = 0; i < 2; ++i) { const int idx = tid + 512 * i, m = idx >> 7, e = idx & 127; vv[idx] = bf1(P[(tok0 + m) * LDP + PC_V + h * 128 + e]); }
    __syncthreads();
    const int dg = tid >> 7, e = tid & 127;
    const size_t soff = ((((size_t)l * DECB + bs) * HR + h) * DK) * DV;
    const float* r0 = a.in[2] + soff; float* rn = a.out + O_SRS + soff;
    const float lg = logg_of(h), G8 = __expf(8.0f * lg);
    float cross[8];
#pragma unroll
    for (int j = 0; j < 8; ++j) cross[j] = 0.f;
#pragma unroll 4
    for (int dd = 0; dd < 16; ++dd) { const int d = dg * 16 + dd; const float r = r0[(size_t)d * DV + e]; float kvs = 0.f;
#pragma unroll
        for (int m = 0; m < 8; ++m) kvs += ku[m * 64 + d] * vv[m * 128 + e];
        rn[(size_t)d * DV + e] = G8 * (r + kvs);
#pragma unroll
        for (int j = 0; j < 8; ++j) cross[j] += qd[j * 64 + d] * r; }
#pragma unroll
    for (int j = 0; j < 8; ++j) crossp[(dg * 8 + j) * 128 + e] = cross[j];
    if (tid < 64) { const int j = tid >> 3, m = tid & 7; float s = 0.f;
        if (j >= m) { for (int d = 0; d < 64; ++d) s += qd[j * 64 + d] * ku[m * 64 + d]; }
        S[tid] = s; }
    __syncthreads();
    float o[2];
#pragma unroll
    for (int jj = 0; jj < 2; ++jj) { const int j = dg + 4 * jj; float s = 0.f;
#pragma unroll
        for (int g = 0; g < 4; ++g) s += crossp[(g * 8 + j) * 128 + e];
#pragma unroll
        for (int m = 0; m < 8; ++m) s += S[j * 8 + m] * vv[m * 128 + e];
        o[jj] = s;
        const float t1 = wave_sum(s), t2 = wave_sum(s * s);
        if (lane == 0) { red[(jj * 8 + w) * 2] = t1; red[(jj * 8 + w) * 2 + 1] = t2; } }
    __syncthreads();
#pragma unroll
    for (int jj = 0; jj < 2; ++jj) { const int j = dg + 4 * jj, w0 = 2 * dg;
        const float t1 = red[(jj * 8 + w0) * 2] + red[(jj * 8 + w0 + 1) * 2], t2 = red[(jj * 8 + w0) * 2 + 1] + red[(jj * 8 + w0 + 1) * 2 + 1];
        const float mu = t1 * (1.0f / DV), var = t2 * (1.0f / DV) - mu * mu, rstd = rsqrtf(fmaxf(var, 0.f) + EPS);
        bf16_t* prow = P + (tok0 + j) * LDP + h * 128 + e;
        prow[PC_ARET] = (bf16_t)f2bf((o[jj] - mu) * rstd * bf1(prow[PC_GR])); }
    __syncthreads();
}

constexpr int N_XRL = 0, N_XCF = 33536, N_XCB = 66304, N_WGT = 84736, N_CAR = 103168, N_BUF = 107264;
__device__ __forceinline__ void rnn_unit(const Args& a, Frame& F, int l, bool sample, int bg, int nb) {
    const int tid = F.tid, lane = F.lane, w = F.wave, hi = lane >> 5, l31 = lane & 31;
    ldsp_t lds = F.lds;
    LAS float* xrl = (LAS float*)(lds + N_XRL); LAS float* xcf = (LAS float*)(lds + N_XCF); LAS float* car = (LAS float*)(lds + N_CAR); LAS float* bufl = (LAS float*)(lds + N_BUF);
    LAS float* aa = xrl; LAS float* uu = xcf;
    bf16_t* P = (bf16_t*)(a.ws + WS_P);
    const int ch0 = nb * BS;
    { const bf16_t* wg = (const bf16_t*)(a.ws + WS_WG) + ((size_t)l * NBLK + nb) * 2 * BS * BS;
#pragma unroll
      for (int i = 0; i < 2; ++i) { const int p = tid + 512 * i, row = p >> 3, c8 = p & 7; *(LAS u32x4*)(lds + N_WGT + row * LD64 + c8 * 16) = *(const u32x4*)(wg + row * 64 + c8 * 8); } }
    const int cc = tid & 63;
    const float* cwp = a.in[11] + (size_t)l * 4 * DM + ch0 + cc;
    const float cw0 = cwp[0], cw1 = cwp[DM], cw2 = cwp[2 * DM], cw3 = cwp[3 * DM], cbv = a.in[12][l * DM + ch0 + cc];
    const int rb = w >> 1, cb = w & 1, dcol = 32 * cb + l31;
    const float bav = a.in[14][l * DM + ch0 + dcol], bxv = a.in[16][l * DM + ch0 + dcol];
    const float spl = log1pf(__expf(-a.in[17][l * DM + ch0 + dcol]));
    const int ntiles = sample ? 1 : 16;
    float hcar = 0.f;
    if (sample) {
        for (int i = tid; i < 16 * 3 * 64; i += NTHREADS) { const int s = i / 192, r = (i / 64) % 3, c = i & 63;
            bufl[i] = a.in[4][(((size_t)l * DECB + bg * 16 + s) * 3 + r) * DM + ch0 + c]; }
    }
    for (int n = 0; n < ntiles; ++n) {
        const size_t tok0 = sample ? (size_t)M_P + bg * 128 : (size_t)bg * SEQ + n * 128;
        for (int p = tid; p < 131 * 8; p += NTHREADS) { const int row = p >> 3, c8 = p & 7;
            u32x4 v = (u32x4){0u, 0u, 0u, 0u};
            if (row >= 3 || (!sample && n > 0)) v = *(const u32x4*)(P + (tok0 + row - 3) * LDP + PC_XR + ch0 + c8 * 8);
            LAS float* d = xrl + row * 64 + c8 * 8;
            d[0] = bflo(v.x); d[1] = bfhi(v.x); d[2] = bflo(v.y); d[3] = bfhi(v.y); d[4] = bflo(v.z); d[5] = bfhi(v.z); d[6] = bflo(v.w); d[7] = bfhi(v.w); }
        __syncthreads();
        { const int tg = tid >> 6;
#pragma unroll 4
          for (int i = 0; i < 16; ++i) { const int t = tg * 16 + i; float x0, x1, x2;
              const float x3 = xrl[(t + 3) * 64 + cc];
              if (sample) { const int s = t >> 3, j = t & 7;
                  x0 = j >= 3 ? xrl[t * 64 + cc] : bufl[(s * 3 + j) * 64 + cc];
                  x1 = j >= 2 ? xrl[(t + 1) * 64 + cc] : bufl[(s * 3 + j + 1) * 64 + cc];
                  x2 = j >= 1 ? xrl[(t + 2) * 64 + cc] : bufl[(s * 3 + j + 2) * 64 + cc];
              } else { x0 = xrl[t * 64 + cc]; x1 = xrl[(t + 1) * 64 + cc]; x2 = xrl[(t + 2) * 64 + cc]; }
              const float xc = cbv + cw0 * x0 + cw1 * x1 + cw2 * x2 + cw3 * x3;
              xcf[t * 64 + cc] = xc; *(LAS bf16_t*)(lds + N_XCB + t * LD64 + cc * 2) = (bf16_t)f2bf(xc); } }
        if (sample) { if (tid < 192) { }     }
        if (sample) { for (int i = tid; i < 16 * 3 * 64; i += NTHREADS) { const int s = i / 192, r = (i / 64) % 3, c = i & 63;
                a.out[O_SCS + (((size_t)l * DECB + bg * 16 + s) * 3 + r) * DM + ch0 + c] = xrl[(3 + s * 8 + 5 + r) * 64 + c]; } }
        else if (n == 15) { if (tid < 192) { const int r = tid >> 6, c = tid & 63; a.out[O_SCP + (((size_t)l * NBATCH + bg) * 3 + r) * DM + ch0 + c] = xrl[(3 + 125 + r) * 64 + c]; } }
        __syncthreads();
        { f32x16 ar = ZERO16, ai = ZERO16;
          mma32(ar, lds + N_XCB + rb * 32 * LD64, LD64, lds + N_WGT + (32 * cb) * LD64, LD64, 4, lane);
          mma32(ai, lds + N_XCB + rb * 32 * LD64, LD64, lds + N_WGT + (64 + 32 * cb) * LD64, LD64, 4, lane);
#pragma unroll
          for (int r = 0; r < 16; ++r) { const int t = 32 * rb + (r & 3) + 8 * (r >> 2) + 4 * hi;
              const float rg = sigmoidf_(ar[r] + bav), ig = sigmoidf_(ai[r] + bxv);
              const float la = -8.0f * rg * spl, av = __expf(la), mult = sqrtf(fmaxf(-expm1f(2.0f * la), 0.f));
              const float xc = xcf[t * 64 + dcol];
              aa[t * 64 + dcol] = av; uu[t * 64 + dcol] = mult * ig * xc; } }
        __syncthreads();
        if (!sample) {
            float Ap = 1.f, Hl = 0.f;
#pragma unroll 4
            for (int i = 0; i < 16; ++i) { const int t = 16 * w + i; const float av = aa[t * 64 + cc], uv = uu[t * 64 + cc]; Hl = av * Hl + uv; Ap *= av; }
            car[w * 64 + cc] = Ap; car[512 + w * 64 + cc] = Hl;
            __syncthreads();
            float hin = hcar, hnext = hcar;
#pragma unroll
            for (int w2 = 0; w2 < 8; ++w2) { const float A2 = car[w2 * 64 + cc], H2 = car[512 + w2 * 64 + cc]; hnext = A2 * hnext + H2; if (w2 < w) hin = hnext; }
            float hh = hin;
#pragma unroll 4
            for (int i = 0; i < 16; ++i) { const int t = 16 * w + i; hh = aa[t * 64 + cc] * hh + uu[t * 64 + cc];
                bf16_t* gp = P + (tok0 + t) * LDP + PC_GN + ch0 + cc; *gp = (bf16_t)f2bf(hh * bf1(*gp)); }
            hcar = hnext;
        } else {
#pragma unroll
            for (int s2 = 0; s2 < 2; ++s2) { const int s = 2 * w + s2, bs = bg * 16 + s;
                float hh = a.in[3][((size_t)l * DECB + bs) * DM + ch0 + cc];
#pragma unroll
                for (int j = 0; j < 8; ++j) { const int t = s * 8 + j; hh = aa[t * 64 + cc] * hh + uu[t * 64 + cc];
                    bf16_t* gp = P + (tok0 + t) * LDP + PC_GN + ch0 + cc; *gp = (bf16_t)f2bf(hh * bf1(*gp)); }
                a.out[O_SHS + ((size_t)l * DECB + bs) * DM + ch0 + cc] = hh; }
        }
        __syncthreads();
    }
    if (!sample && w == 0) a.out[O_SHP + ((size_t)l * NBATCH + bg) * DM + ch0 + cc] = hcar;
}

__device__ __forceinline__ unsigned ord_of(float f) { const unsigned u = __builtin_bit_cast(unsigned, f); return u ^ ((u >> 31) ? 0xFFFFFFFFu : 0x80000000u); }
__device__ __forceinline__ float ord_inv(unsigned o) { const unsigned u = (o >> 31) ? (o ^ 0x80000000u) : ~o; return __builtin_bit_cast(float, u); }
__host__ __device__ constexpr bool cand_ok(int a, int b) { return (a + 1) * (b + 1) <= 16; }

__device__ __forceinline__ void route_unit(const Args& a, int l, int tb, int h, int lane) {
    const int hi = lane >> 5, l31 = lane & 31, token = tb * 32 + l31;
    const bf16_t* P = (const bf16_t*)(a.ws + WS_P);
    const bf16_t* qrow = P + (size_t)token * LDP + PC_QP + h * 256 + hi * 8;
    const bf16_t* kbase = (const bf16_t*)(a.ws + WS_KEYS) + ((size_t)(l * PH + h) * 2) * NKEY * HK + (size_t)l31 * HK + hi * 8;
    unsigned L[2][16];
#pragma unroll
    for (int p = 0; p < 2; ++p) {
        f32x16 acc[4];
#pragma unroll
        for (int kb = 0; kb < 4; ++kb) acc[kb] = ZERO16;
#pragma unroll 2
        for (int ks = 0; ks < 8; ++ks) {
            const bf16x8 bq = *(const bf16x8*)(qrow + p * 128 + ks * 16);
#pragma unroll
            for (int kb = 0; kb < 4; ++kb) { const bf16x8 ak = *(const bf16x8*)(kbase + ((size_t)p * NKEY + kb * 32) * HK + ks * 16);
                acc[kb] = __builtin_amdgcn_mfma_f32_32x32x16_bf16(ak, bq, acc[kb], 0, 0, 0); }
        }
        unsigned pk[64];
#pragma unroll
        for (int kb = 0; kb < 4; ++kb)
#pragma unroll
            for (int r = 0; r < 16; ++r) { const int key = 32 * kb + (r & 3) + 8 * (r >> 2) + 4 * hi; pk[kb * 16 + r] = (ord_of(acc[kb][r]) & ~127u) | (unsigned)(127 - key); }
        unsigned prev = 0xFFFFFFFFu;
#pragma unroll
        for (int it = 0; it < 16; ++it) { unsigned m = 0u;
#pragma unroll
            for (int i = 0; i < 64; ++i) { const unsigned t = pk[i] < prev ? pk[i] : 0u; m = m > t ? m : t; }
            const unsigned o = (unsigned)__shfl_xor((int)m, 32); m = m > o ? m : o; L[p][it] = m; prev = m; }
    }
    float sa[16], sb[16];
#pragma unroll
    for (int i = 0; i < 16; ++i) { sa[i] = ord_inv(L[0][i] & ~127u); sb[i] = ord_inv(L[1][i] & ~127u); }
    unsigned ck[50];
    { int n = 0;
#pragma unroll
      for (int x = 0; x < 16; ++x)
#pragma unroll
          for (int y = 0; y < 16; ++y) if (cand_ok(x, y)) { ck[n] = (ord_of(sa[x] + sb[y]) & ~255u) | (unsigned)(255 - (x * 16 + y)); ++n; } }
    unsigned best[16];
    { unsigned prev = 0xFFFFFFFFu;
#pragma unroll
      for (int it = 0; it < 16; ++it) { unsigned m = 0u;
#pragma unroll
          for (int i = 0; i < 50; ++i) { const unsigned t = ck[i] < prev ? ck[i] : 0u; m = m > t ? m : t; }
          best[it] = m; prev = m; } }
    float sc[16], ssum = 0.f; const float mx = ord_inv(best[0] & ~255u);
#pragma unroll
    for (int it = 0; it < 16; ++it) { sc[it] = __expf(ord_inv(best[it] & ~255u) - mx); ssum += sc[it]; }
    const float inv = 1.0f / ssum;
    unsigned* eo = (unsigned*)(a.ws + WS_EIDX) + (size_t)token * 128 + h * 16 + hi * 8;
    float* go = (float*)(a.ws + WS_GATE) + (size_t)token * 128 + h * 16 + hi * 8;
#pragma unroll
    for (int it = 0; it < 8; ++it) {
        unsigned b0 = best[it], b1 = best[it + 8]; float g0 = sc[it], g1 = sc[it + 8];
        asm volatile("" : "+v"(b0), "+v"(b1), "+v"(g0), "+v"(g1));
        const unsigned bsel = hi ? b1 : b0; const float gsel = (hi ? g1 : g0) * inv;
        const unsigned c = 255u - (bsel & 255u), ca = c >> 4, cb = c & 15u;
        unsigned k1 = 0u, k2 = 0u;
#pragma unroll
        for (int i = 0; i < 16; ++i) { k1 = (ca == (unsigned)i) ? (127u - (L[0][i] & 127u)) : k1; k2 = (cb == (unsigned)i) ? (127u - (L[1][i] & 127u)) : k2; }
        eo[it] = k1 * 128u + k2; go[it] = gsel;
    }
}

constexpr int MAXT = 9;
__device__ __forceinline__ void peer_phase(const Args& a, Frame& F, int l, bool lastlayer) {
    const int lane = F.lane, l7 = lane & 7, lg3 = lane >> 3;
    const int gw = F.vcu * NWAVES + F.wave, NGW = F.G * NWAVES;
    const bf16_t* TU = (const bf16_t*)(a.ws + WS_TAB + ((size_t)l * 2) * 32 * MiB);
    const bf16_t* TV = (const bf16_t*)(a.ws + WS_TAB + ((size_t)l * 2 + 1) * 32 * MiB);
    bf16_t* XB = (bf16_t*)(a.ws + WS_XB); float* X = a.out;
    const unsigned* EI = (const unsigned*)(a.ws + WS_EIDX); const float* GT = (const float*)(a.ws + WS_GATE);
    const float* g2 = a.in[6] + (size_t)l * DM;
    unsigned elo[MAXT], ehi[MAXT]; float hacc[MAXT][2], ssq[MAXT];
#pragma unroll
    for (int i = 0; i < MAXT; ++i) { const int t = gw + NGW * i; hacc[i][0] = 0.f; hacc[i][1] = 0.f; ssq[i] = 0.f; elo[i] = 0u; ehi[i] = 0u;
        if (t < MTOT) { elo[i] = EI[(size_t)t * 128 + lane]; ehi[i] = EI[(size_t)t * 128 + 64 + lane]; } }
    for (int s = 0; s < 16; ++s) {
        const f32x4 ga = *(const f32x4*)(g2 + 64 * s + 8 * l7), gb = *(const f32x4*)(g2 + 64 * s + 8 * l7 + 4);
#pragma unroll
        for (int i = 0; i < MAXT; ++i) { const int t = gw + NGW * i;
            if (t < MTOT) {
                const u32x4 xv = *(const u32x4*)(XB + (size_t)t * DM + 64 * s + 8 * l7);
                const float x0 = bflo(xv.x) * ga[0], x1 = bfhi(xv.x) * ga[1], x2 = bflo(xv.y) * ga[2], x3 = bfhi(xv.y) * ga[3];
                const float x4 = bflo(xv.z) * gb[0], x5 = bfhi(xv.z) * gb[1], x6 = bflo(xv.w) * gb[2], x7 = bfhi(xv.w) * gb[3];
                u32x4 rowv[16];
#pragma unroll
                for (int q = 0; q < 16; ++q) { const unsigned idx = (unsigned)__shfl((int)(q < 8 ? elo[i] : ehi[i]), (q & 7) * 8 + lg3);
                    rowv[q] = *(const u32x4*)(TU + ((size_t)s * NEXP + idx) * 64 + 8 * l7); }
                float p[16];
#pragma unroll
                for (int q = 0; q < 16; ++q) { const u32x4 r = rowv[q];
                    p[q] = ((bflo(r.x) * x0 + bfhi(r.x) * x1) + (bflo(r.y) * x2 + bfhi(r.y) * x3)) + ((bflo(r.z) * x4 + bfhi(r.z) * x5) + (bflo(r.w) * x6 + bfhi(r.w) * x7)); }
                float p8[8], p4[4], p2[2];
#pragma unroll
                for (int q = 0; q < 8; ++q) { const float keep = (lane & 4) ? p[q + 8] : p[q], send = (lane & 4) ? p[q] : p[q + 8]; p8[q] = keep + __shfl_xor(send, 4); }
#pragma unroll
                for (int q = 0; q < 4; ++q) { const float keep = (lane & 2) ? p8[q + 4] : p8[q], send = (lane & 2) ? p8[q] : p8[q + 4]; p4[q] = keep + __shfl_xor(send, 2); }
#pragma unroll
                for (int q = 0; q < 2; ++q) { const float keep = (lane & 1) ? p4[q + 2] : p4[q], send = (lane & 1) ? p4[q] : p4[q + 2]; p2[q] = keep + __shfl_xor(send, 1); }
                hacc[i][0] += p2[0]; hacc[i][1] += p2[1];
            } }
    }
#pragma unroll
    for (int i = 0; i < MAXT; ++i) { const int t = gw + NGW * i;
        if (t < MTOT) { const float rstd = rsqrtf(((const float*)(a.ws + WS_RSS2))[t] * (1.0f / DM) + EPS);
#pragma unroll
            for (int j = 0; j < 2; ++j) { const int k = 16 * l7 + 8 * j + lg3; hacc[i][j] = geluf_(hacc[i][j] * rstd) * GT[(size_t)t * 128 + k]; } } }
    for (int s = 0; s < 16; ++s) {
#pragma unroll
        for (int i = 0; i < MAXT; ++i) { const int t = gw + NGW * i;
            if (t < MTOT) {
                u32x4 rowv[16];
#pragma unroll
                for (int q = 0; q < 16; ++q) { const unsigned idx = (unsigned)__shfl((int)(q < 8 ? elo[i] : ehi[i]), (q & 7) * 8 + lg3);
                    rowv[q] = *(const u32x4*)(TV + ((size_t)s * NEXP + idx) * 64 + 8 * l7); }
                float o[8];
#pragma unroll
                for (int j = 0; j < 8; ++j) o[j] = 0.f;
#pragma unroll
                for (int q = 0; q < 16; ++q) { const float hq = __shfl(hacc[i][q & 1], (lane & ~7) | (q >> 1)); const u32x4 r = rowv[q];
                    o[0] += hq * bflo(r.x); o[1] += hq * bfhi(r.x); o[2] += hq * bflo(r.y); o[3] += hq * bfhi(r.y);
                    o[4] += hq * bflo(r.z); o[5] += hq * bfhi(r.z); o[6] += hq * bflo(r.w); o[7] += hq * bfhi(r.w); }
                float o4[4], o2[2];
#pragma unroll
                for (int q = 0; q < 4; ++q) { const float keep = (lane & 32) ? o[q + 4] : o[q], send = (lane & 32) ? o[q] : o[q + 4]; o4[q] = keep + __shfl_xor(send, 32); }
#pragma unroll
                for (int q = 0; q < 2; ++q) { const float keep = (lane & 16) ? o4[q + 2] : o4[q], send = (lane & 16) ? o4[q] : o4[q + 2]; o2[q] = keep + __shfl_xor(send, 16); }
                const float keep = (lane & 8) ? o2[1] : o2[0], send = (lane & 8) ? o2[0] : o2[1];
                const float ov = keep + __shfl_xor(send, 8);
                const int col = 64 * s + 8 * l7 + 4 * ((lane >> 5) & 1) + 2 * ((lane >> 4) & 1) + ((lane >> 3) & 1);
                const float xn = X[(size_t)t * DM + col] + ov;
                X[(size_t)t * DM + col] = xn; XB[(size_t)t * DM + col] = (bf16_t)f2bf(xn); ssq[i] += xn * xn;
            } }
    }
    float* RSS = (float*)(a.ws + WS_RSS);
#pragma unroll
    for (int i = 0; i < MAXT; ++i) { const int t = gw + NGW * i; if (t < MTOT) { ssq[i] = wave_sum(ssq[i]); if (lane == 0) RSS[t] = ssq[i]; } }
    if (lastlayer) {
        __threadfence();
        const float* gf = a.in[7];
#pragma unroll
        for (int i = 0; i < MAXT; ++i) { const int t = gw + NGW * i;
            if (t < MTOT) { const float rstd = rsqrtf(ssq[i] * (1.0f / DM) + EPS); f32x4* xr = (f32x4*)(X + (size_t)t * DM) + lane;
#pragma unroll
                for (int j = 0; j < 4; ++j) { const f32x4 g = *((const f32x4*)gf + lane + 64 * j); f32x4 v = xr[64 * j]; v = v * rstd * g; xr[64 * j] = v; } } }
    }
}

constexpr int N_PHASES = 1 + 7 * DEPTH;
__global__ void __launch_bounds__(NTHREADS, 2) hybrid_fwd(Args args) {
    extern __shared__ __attribute__((aligned(16))) unsigned char lds_raw[];
    Frame F;
    F.lds = (ldsp_t)lds_raw;
    F.MISC = (volatile LAS unsigned*)(F.lds + MISC_OFF);
    F.tid = threadIdx.x; F.lane = F.tid & 63; F.wave = __builtin_amdgcn_readfirstlane(F.tid >> 6);
    F.G = gridDim.x; { const int bx = blockIdx.x; F.vcu = (F.G % 8 == 0) ? (bx % 8) * (F.G / 8) + bx / 8 : bx; }
    F.ctl = (unsigned*)(args.ws + WS_CTL); F.ws = args.ws; F.out = args.out;
    for (int u = F.tid; u < (LDS_BYTES - MISC_OFF) / 4; u += NTHREADS) ((LAS unsigned*)(F.lds + MISC_OFF))[u] = 0u;
    __syncthreads();
    const int lo = args.ph_lo, hi = args.ph_hi;
    XcdBarrier bar; bar.bar = F.ctl + CW_BAR; bar.x = 0; bar.st = nullptr;
    if (hi - lo > 1) bar = xcd_barrier_post(F.ctl + CW_BAR, F.MISC + 8);
#ifndef PH_MASK
#define PH_MASK 0x7FF
#endif
#define IN(k) (lo <= (k) && (k) < hi)
#define PHM(b) ((PH_MASK >> (b)) & 1)
#define LAUNDER() do { asm volatile("" : "+v"(F.tid)); F.lane = F.tid & 63; F.wave = __builtin_amdgcn_readfirstlane(F.tid >> 6); } while (0)
#define SEAM(k) do { if (IN(k) && IN((k) + 1)) xcd_barrier(bar); } while (0)
    unsigned char* ws = args.ws;
    bf16_t* P = (bf16_t*)(ws + WS_P); bf16_t* XB = (bf16_t*)(ws + WS_XB);

    if (PHM(0) && IN(0)) { LAUNDER(); p0_prologue(args, F); } SEAM(0);

    for (int l = 0; l < DEPTH; ++l) {
        const int pb = 1 + 7 * l;
        if (PHM(1) && IN(pb)) { LAUNDER();
            pg8::Gemm g{XB, (const bf16_t*)(ws + WS_WIN) + (size_t)l * NIN * DM, DM, DM, 0, 0};
            pg8::StaticOrder S; S.init(MTOT, NIN, F.G, (int)blockIdx.x, 1);
            pg8::EpiIn E{P, (const float*)(ws + WS_RSS), (const float*)(ws + WS_ROT)};
            pg8::gemm_phase<pg8::EpiIn, pg8::StaticOrder, true>(F.lds, g, S, E, F.tid);
        }
        SEAM(pb);
        if (PHM(2) && IN(pb + 1)) { LAUNDER();
            for (int u = (int)blockIdx.x; u < 192; u += F.G) {
                LAUNDER();
                if (u < 64) { if (PHM(8)) ret_prompt_unit(args, F, l, u >> 3, u & 7); }
                else { if (PHM(9)) rnn_unit(args, F, l, false, (u - 64) >> 4, (u - 64) & 15); }
            }
            unsigned* qh = F.ctl + CW_QUEUE + 64 * l;
            for (;;) {
                __syncthreads();
                if (F.tid == 0) F.MISC[0] = xb_add(qh, 1u);
                __syncthreads();
                const unsigned q = F.MISC[0];
                LAUNDER();
                if (q >= 1024u + 128u) break;
                if (q < 1024u) { if (PHM(10)) ret_sample_unit(args, F, l, (int)(q >> 3), (int)(q & 7)); }
                else { if (PHM(9)) rnn_unit(args, F, l, true, (int)((q - 1024u) >> 4), (int)((q - 1024u) & 15)); }
            }
        }
        SEAM(pb + 1);
        if (PHM(3) && IN(pb + 2)) { LAUNDER();
            pg8::Gemm g{P + PC_ARET, (const bf16_t*)(ws + WS_WMIX + (size_t)l * 6 * MiB), LDP, DM, (size_t)(PC_ARNN - PC_ARET) * 2, (size_t)(2 * MiB)};
            pg8::StaticOrder S; S.init(MTOT, DM, F.G, (int)blockIdx.x, 2);
            pg8::EpiMerge E{P};
            pg8::gemm_phase<pg8::EpiMerge, pg8::StaticOrder, true>(F.lds, g, S, E, F.tid);
        }
        SEAM(pb + 2);
        if (PHM(4) && IN(pb + 3)) { LAUNDER();
            pg8::Gemm g{P + PC_MRG, (const bf16_t*)(ws + WS_WMIX + (size_t)l * 6 * MiB + 4 * MiB), LDP, DM, 0, 0};
            pg8::StaticOrder S; S.init(MTOT, DM, F.G, (int)blockIdx.x, 1);
            pg8::EpiWo E{l == 0 ? args.in[0] : args.out, l == 0 ? args.in[1] : args.out + (size_t)M_P * DM, args.out, XB, (float*)(ws + WS_RSSP)};
            pg8::gemm_phase<pg8::EpiWo, pg8::StaticOrder, true>(F.lds, g, S, E, F.tid);
        }
        SEAM(pb + 3);
        if (PHM(5) && IN(pb + 4)) { LAUNDER();
            pg8::Gemm g{XB, (const bf16_t*)(ws + WS_WQ) + (size_t)l * 2048 * DM, DM, DM, 0, 0};
            pg8::StaticOrder S; S.init(MTOT, 2048, F.G, (int)blockIdx.x, 1);
            pg8::EpiQ E{P, (const float*)(ws + WS_RSSP), (float*)(ws + WS_RSS2)};
            pg8::gemm_phase<pg8::EpiQ, pg8::StaticOrder, true>(F.lds, g, S, E, F.tid);
        }
        SEAM(pb + 4);
        if (PHM(6) && IN(pb + 5)) { LAUNDER();
            const int gw = F.vcu * NWAVES + F.wave, NGW = F.G * NWAVES;
            for (int u = gw; u < (MTOT / 32) * PH; u += NGW) { int ln = F.lane; asm volatile("" : "+v"(ln)); route_unit(args, l, u >> 3, u & 7, ln); }
        }
        SEAM(pb + 5);
        if (PHM(7) && IN(pb + 6)) { LAUNDER(); peer_phase(args, F, l, l == DEPTH - 1); }
        if (l + 1 < DEPTH) SEAM(pb + 6);
    }
#undef IN
#undef SEAM
}

extern "C" void kernel_launch(void* const* d_in, const int* in_sizes, int n_in, void* d_out, int out_size, void* d_ws, size_t ws_size, hipStream_t stream) {
    static int grid = 0;
    if (grid == 0) {
        if (n_in != 24 || out_size != (int)O_END || ws_size < WS_END) { fprintf(stderr, "kernel_launch: unexpected shapes (n_in %d, out %d, ws %zu)\n", n_in, out_size, ws_size); grid = -1; return; }
        int dev = 0, cus = 0, per_cu = 0;
        if (hipGetDevice(&dev) != hipSuccess || hipDeviceGetAttribute(&cus, hipDeviceAttributeMultiprocessorCount, dev) != hipSuccess) { grid = -1; return; }
        if (hipFuncSetAttribute((const void*)hybrid_fwd, hipFuncAttributeMaxDynamicSharedMemorySize, LDS_BYTES) != hipSuccess) { fprintf(stderr, "kernel_launch: hipFuncSetAttribute failed\n"); grid = -1; return; }
        if (hipOccupancyMaxActiveBlocksPerMultiprocessor(&per_cu, (const void*)hybrid_fwd, NTHREADS, LDS_BYTES) != hipSuccess || per_cu < 1) { fprintf(stderr, "kernel_launch: occupancy query reports %d blocks per CU\n", per_cu); (void)hipGetLastError(); grid = -1; return; }
        grid = cus;
        if (grid != 256) fprintf(stderr, "kernel_launch: %d CUs; the PEER phase assumes 256 workgroups\n", grid);
    }
    if (grid < 0) return;
    (void)hipMemsetAsync((char*)d_ws + WS_CTL, 0, CTL_ZERO_BYTES, stream);
    Args a{};
    for (int i = 0; i < 24; ++i) a.in[i] = (const float*)d_in[i];
    a.out = (float*)d_out; a.ws = (unsigned char*)d_ws;
#if MK_N_LAUNCHES == 1
    a.ph_lo = 0; a.ph_hi = N_PHASES;
    void* kargs[] = {&a};
    hipError_t e = hipLaunchCooperativeKernel((const void*)hybrid_fwd, dim3(grid), dim3(NTHREADS), kargs, LDS_BYTES, stream);
    if (e != hipSuccess) fprintf(stderr, "kernel_launch: cooperative launch failed: %s (grid %d)\n", hipGetErrorString(e), grid);
#else
    for (int p = 0; p < N_PHASES; ++p) { a.ph_lo = p; a.ph_hi = p + 1; hipLaunchKernelGGL(hybrid_fwd, dim3(grid), dim3(NTHREADS), LDS_BYTES, stream, a); }
#endif
}
```

```cpp
#include <hip/hip_runtime.h>
#include <cstdio>
#include <cstdint>

#define LAS __attribute__((address_space(3)))
#define GAS __attribute__((address_space(1)))
typedef unsigned short bf16_t;
typedef short bf16x8 __attribute__((ext_vector_type(8)));
typedef float f32x2 __attribute__((ext_vector_type(2)));
typedef float f32x4 __attribute__((ext_vector_type(4)));
typedef float f32x16 __attribute__((ext_vector_type(16)));
typedef unsigned u32x2 __attribute__((ext_vector_type(2)));
typedef unsigned u32x4 __attribute__((ext_vector_type(4)));
typedef LAS unsigned char* ldsp_t;

#ifndef MK_N_LAUNCHES
#define MK_N_LAUNCHES 1
#endif

constexpr int DM = 1024, NIN = 7168, M_P = 16384, M_S = 1024, MTOT = 17408, DEPTH = 2;
constexpr int SEQ = 2048, NBATCH = 8, DECB = 128, DECT = 8, PAST = 16384;
constexpr int HR = 8, DK = 64, DV = 128, CH = 128;
constexpr int NBLK = 16, BS = 64;
constexpr int PH = 8, NKEY = 128, NEXP = 16384, TOPK = 16, HK = 128;
constexpr float EPS = 1e-6f;
constexpr int LDP = 7168;
constexpr int PC_Q = 0, PC_K = 512, PC_V = 1024, PC_GR = 2048, PC_XR = 3072, PC_GN = 4096, PC_GA = 5120, PC_GB = 6144;
constexpr int PC_MRG = 0, PC_ARET = 1024, PC_ARNN = 4096, PC_QP = 2048;

constexpr size_t MiB = 1u << 20;
constexpr size_t WS_CTL = 0, CTL_ZERO_BYTES = 1 * MiB;
constexpr size_t WS_ROT = 1 * MiB;
constexpr size_t WS_RSS = 2 * MiB;
constexpr size_t WS_RSS2 = 2 * MiB + 128 * 1024;
constexpr size_t WS_RSSP = 2 * MiB + 256 * 1024;
constexpr size_t WS_EIDX = 4 * MiB;
constexpr size_t WS_GATE = 13 * MiB;
constexpr size_t WS_KEYS = 22 * MiB;
constexpr size_t WS_WG = 23 * MiB;
constexpr size_t WS_WIN = 24 * MiB;
constexpr size_t WS_WMIX = 52 * MiB;
constexpr size_t WS_WQ = 64 * MiB;
constexpr size_t WS_XB = 72 * MiB;
constexpr size_t WS_P = 106 * MiB;
constexpr size_t WS_TAB = 344 * MiB;
constexpr size_t WS_END = 472 * MiB;
static_assert(WS_P + (size_t)MTOT * LDP * 2 <= WS_TAB, "ws map");

constexpr size_t O_Y = 0, O_SRP = 17825792, O_SHP = 18874368, O_SCP = 18890752, O_SRS = 18939904, O_SHS = 35717120, O_SCS = 35979264, O_END = 36765696;

constexpr int CW_BAR = 4096;
constexpr int CW_QUEUE = 16384;

constexpr int RING_BYTES = 131072;
constexpr int LDS_BYTES = 155648;
constexpr int MISC_OFF = 153600;
constexpr int NWAVES = 8, NTHREADS = 512;

#define LDS_WAIT() asm volatile("s_waitcnt lgkmcnt(0)" ::: "memory")
#define VM_WAIT() asm volatile("s_waitcnt vmcnt(0)" ::: "memory")
#define RLX_AGENT __ATOMIC_RELAXED, __HIP_MEMORY_SCOPE_AGENT

__device__ __forceinline__ unsigned f2bf(float f) { unsigned u = __builtin_bit_cast(unsigned, f); return (u + 0x7fffu + ((u >> 16) & 1u)) >> 16; }
__device__ __forceinline__ unsigned pk2(float lo, float hi) { return f2bf(lo) | (f2bf(hi) << 16); }
__device__ __forceinline__ float bflo(unsigned w) { return __builtin_bit_cast(float, w << 16); }
__device__ __forceinline__ float bfhi(unsigned w) { return __builtin_bit_cast(float, w & 0xffff0000u); }
__device__ __forceinline__ float bf1(bf16_t h) { return __builtin_bit_cast(float, (unsigned)h << 16); }
__device__ __forceinline__ float sigmoidf_(float x) { return __builtin_amdgcn_rcpf(1.0f + __expf(-x)); }
__device__ __forceinline__ float siluf_(float x) { return x * sigmoidf_(x); }
__device__ __forceinline__ float geluf_(float x) { return x * sigmoidf_(1.5957691216057308f * (x + 0.044715f * x * x * x)); }
__device__ __forceinline__ float logg_of(int h) { return log1pf(-exp2f((float)(-5 - h))); }

namespace pg8 {
constexpr int BM = 256, BK = 64, HALF = 128, HTB = HALF * BK * 2, STAGE_BYTES = 8 * HTB, NXCD = 8, WGM = 8;
__host__ __device__ __forceinline__ int lds_byte(int r, int c) { const int st = (r >> 4) * 2 + (c >> 5), rr = r & 15, cc = c & 31, ob = rr * 64 + cc * 2; return st * 1024 + (ob ^ (((ob >> 9) & 1) << 5)); }
__host__ __device__ __forceinline__ void stage_rc(int b, int& R, int& C) { const int st = b / 1024, sb = b % 1024, swz = sb ^ (((sb >> 9) & 1) << 5); R = (st >> 1) * 16 + swz / 64; C = (st & 1) * 32 + (swz % 64) / 2; }
__host__ __device__ __forceinline__ int perm32(int rho) { const int n = rho >> 4, i = rho & 15; return 8 * (i >> 2) + 4 * n + (i & 3); }

struct Unit { int pm, pn, half; };
struct Gemm { const bf16_t* A; const bf16_t* Bt; int lda, K; size_t aoff2, boff2; };

struct StaticOrder {
    int nM, nN, nwg, G, c, pairs;
    __device__ void init(int M, int N, int G_, int c_, int pairs_) { nM = M / BM; nN = N / BM; nwg = nM * nN; G = G_; c = c_; pairs = pairs_; }
    __device__ bool next(int i, Unit& u) const {
        const int it = (pairs == 2) ? (i >> 1) : i;
        const long L = (long)it * G + c; if (L >= nwg) return false;
        int wgid = (int)L; { const int q = nwg / NXCD, r = nwg % NXCD, xcd = wgid % NXCD, off = wgid / NXCD; wgid = (xcd < r ? xcd * (q + 1) : r * (q + 1) + (xcd - r) * q) + off; }
        const int nig = WGM * nN, gid = wgid / nig, fm = gid * WGM, gsz = (nM - fm) < WGM ? (nM - fm) : WGM;
        u.pm = fm + ((wgid % nig) % gsz); u.pn = (wgid % nig) / gsz; u.half = (pairs == 2) ? (i & 1) : 0; return true;
    }
};

template <class Epi, class Sched, bool ALIGN_EPI>
__device__ __forceinline__ void gemm_phase(ldsp_t lds, const Gemm g, const Sched& S, const Epi& E, const int tid) {
    const int wid = __builtin_amdgcn_readfirstlane(tid >> 6), lane = tid & 63, wr = wid >> 2, wc = wid & 3, fr = lane & 15, fq = lane >> 4;
    const int K = g.K, nt = K / BK;
    unsigned voffA[2], voffB[2];
#pragma unroll
    for (int i = 0; i < 2; ++i) { int R, C; stage_rc(tid * 16 + i * 8192, R, C); const int Rb = Epi::PERM ? ((R & ~31) + perm32(R & 31)) : R;
        voffA[i] = (unsigned)(R * g.lda + C) * 2u; voffB[i] = (unsigned)(Rb * K + C) * 2u; }
    const size_t kstep = (size_t)(BK * 2);
    const size_t hstepA = (size_t)HALF * g.lda * 2, hstepB = (size_t)HALF * K * 2;
    const size_t tstepA = 2 * hstepA, tstepB = 2 * hstepB;
    const unsigned ldsw = (unsigned)wid * 1024u;
    const int aoff = lds_byte(wr * 64 + fr, fq * 8), boff = lds_byte(wc * 32 + fr, fq * 8);
#define PG8_SA(b, h) (((b) * 2 + (h)) * HTB)
#define PG8_SB(b, h) ((4 + (b) * 2 + (h)) * HTB)
#define PG8_STAGE(bufoff, gbase, voff) do { _Pragma("unroll") for (int _i = 0; _i < 2; ++_i) \
        __builtin_amdgcn_global_load_lds((const unsigned*)((const char*)(gbase) + (voff)[_i]), (LAS unsigned*)(lds + (bufoff) + ldsw + _i * 8192), 16, 0, 0); } while (0)
#define PG8_LDA(dst, b, h) do { _Pragma("unroll") for (int m = 0; m < 4; ++m) _Pragma("unroll") for (int k = 0; k < 2; ++k) dst[m][k] = *(const LAS bf16x8*)(lds + PG8_SA(b, h) + aoff + m * 2048 + k * 1024); } while (0)
#define PG8_LDB(dst, b, h) do { _Pragma("unroll") for (int n = 0; n < 2; ++n) _Pragma("unroll") for (int k = 0; k < 2; ++k) dst[n][k] = *(const LAS bf16x8*)(lds + PG8_SB(b, h) + boff + n * 2048 + k * 1024); } while (0)
#define PG8_MMA(ai, bj, At, Bt) do { __builtin_amdgcn_s_setprio(1); _Pragma("unroll") for (int m = 0; m < 4; ++m) _Pragma("unroll") for (int n = 0; n < 2; ++n) _Pragma("unroll") for (int k = 0; k < 2; ++k) \
        acc[ai][bj][m][n] = __builtin_amdgcn_mfma_f32_16x16x32_bf16(Bt[n][k], At[m][k], acc[ai][bj][m][n], 0, 0, 0); __builtin_amdgcn_s_setprio(0); } while (0)
#define PG8_WAIT_V(n) asm volatile("s_waitcnt vmcnt(" #n ")" ::: "memory")
#define PG8_WAIT_L(n) asm volatile("s_waitcnt lgkmcnt(" #n ")" ::: "memory")
#define PG8_BAR __builtin_amdgcn_s_barrier()
#define PG8_SCHED __builtin_amdgcn_sched_barrier(0)
    Unit cur, nxt; int ui = 0;
    if (!S.next(0, cur)) return;
    f32x4 acc[2][2][4][2];
#pragma unroll
    for (int a = 0; a < 2; ++a)
#pragma unroll
        for (int b = 0; b < 2; ++b)
#pragma unroll
            for (int m = 0; m < 4; ++m)
#pragma unroll
                for (int n = 0; n < 2; ++n) acc[a][b][m][n] = (f32x4){0.f, 0.f, 0.f, 0.f};
    bf16x8 At[4][2], B0[2][2], B1[2][2];
    const char* cA = (const char*)g.A + (size_t)cur.pm * tstepA + (cur.half ? g.aoff2 : 0); const char* cB = (const char*)g.Bt + (size_t)cur.pn * tstepB + (cur.half ? g.boff2 : 0);
    PG8_STAGE(PG8_SB(0, 0), cB, voffB); PG8_STAGE(PG8_SB(0, 1), cB + hstepB, voffB); PG8_STAGE(PG8_SA(0, 0), cA, voffA); PG8_STAGE(PG8_SA(0, 1), cA + hstepA, voffA);
    if (wr == 1) PG8_BAR;
    PG8_WAIT_V(2); PG8_BAR;
    PG8_STAGE(PG8_SB(1, 0), cB + kstep, voffB); PG8_STAGE(PG8_SA(1, 0), cA + kstep, voffA); PG8_STAGE(PG8_SB(1, 1), cB + hstepB + kstep, voffB);
    PG8_WAIT_V(6); PG8_BAR;
    for (;;) {
        const bool has_next = S.next(ui + 1, nxt);
        const char* nA = has_next ? (const char*)g.A + (size_t)nxt.pm * tstepA + (nxt.half ? g.aoff2 : 0) : cA;
        const char* nB = has_next ? (const char*)g.Bt + (size_t)nxt.pn * tstepB + (nxt.half ? g.boff2 : 0) : cB;
        for (int t = 0; t < nt; t += 2) {
            const bool last = (t == nt - 2);
            const char* a1 = cA + (size_t)(t + 1) * kstep;
            const char* a2 = last ? nA : cA + (size_t)(t + 2) * kstep; const char* b2 = last ? nB : cB + (size_t)(t + 2) * kstep;
            const char* a3 = a2 + kstep; const char* b3 = b2 + kstep;
            PG8_LDB(B0, 0, 0); PG8_LDB(B1, 0, 1); PG8_SCHED; PG8_LDA(At, 0, 0); PG8_STAGE(PG8_SA(1, 1), a1 + hstepA, voffA);
            PG8_WAIT_V(8); PG8_WAIT_L(0); PG8_BAR; PG8_MMA(0, 0, At, B0); PG8_MMA(0, 1, At, B1); PG8_BAR; PG8_SCHED;
            PG8_LDA(At, 0, 1); PG8_STAGE(PG8_SB(0, 0), b2, voffB); PG8_STAGE(PG8_SB(0, 1), b2 + hstepB, voffB); PG8_STAGE(PG8_SA(0, 0), a2, voffA);
            PG8_WAIT_V(8); PG8_WAIT_L(0); PG8_BAR; PG8_MMA(1, 0, At, B0); PG8_MMA(1, 1, At, B1); PG8_BAR; PG8_SCHED;
            PG8_LDB(B0, 1, 0); PG8_LDB(B1, 1, 1); PG8_SCHED; PG8_LDA(At, 1, 0); PG8_STAGE(PG8_SA(0, 1), a2 + hstepA, voffA);
            PG8_WAIT_V(8); PG8_WAIT_L(0); PG8_BAR; PG8_MMA(0, 0, At, B0); PG8_MMA(0, 1, At, B1); PG8_BAR; PG8_SCHED;
            PG8_LDA(At, 1, 1); PG8_STAGE(PG8_SB(1, 0), b3, voffB); PG8_STAGE(PG8_SB(1, 1), b3 + hstepB, voffB); PG8_STAGE(PG8_SA(1, 0), a3, voffA);
            PG8_WAIT_V(8); PG8_WAIT_L(0); PG8_BAR; PG8_MMA(1, 0, At, B0); PG8_MMA(1, 1, At, B1); PG8_BAR; PG8_SCHED;
        }
        if constexpr (ALIGN_EPI) { if (wr == 0) PG8_BAR; }
        E(acc, cur, wr, wc, fr, fq);
        if (!has_next) break;
#pragma unroll
        for (int a = 0; a < 2; ++a)
#pragma unroll
            for (int b = 0; b < 2; ++b)
#pragma unroll
                for (int m = 0; m < 4; ++m)
#pragma unroll
                    for (int n = 0; n < 2; ++n) acc[a][b][m][n] = (f32x4){0.f, 0.f, 0.f, 0.f};
        cur = nxt; cA = nA; cB = nB; ++ui;
        if constexpr (ALIGN_EPI) { if (wr == 1) PG8_BAR; }
    }
    PG8_WAIT_V(0);
    if constexpr (!ALIGN_EPI) { if (wr == 0) PG8_BAR; }
    PG8_BAR;
#undef PG8_SA
#undef PG8_SB
#undef PG8_STAGE
#undef PG8_LDA
#undef PG8_LDB
#undef PG8_MMA
#undef PG8_WAIT_V
#undef PG8_WAIT_L
#undef PG8_BAR
#undef PG8_SCHED
}
}

typedef GAS unsigned gu32;
#define XB_TMO      128
#define XB_XCNT(j)  (256  + 64 * (j))
#define XB_XSUB(j)  (1280 + 64 * (j))
#define XB_XGEN(j)  (2304 + 64 * (j))
#define XB_TOP      3328
#define XB_TOPGEN   3392
#define XCD_BAR_WORDS 3456
#define XB_SPIN_CAP (1u << 18)
__device__ __forceinline__ unsigned xb_ld(unsigned* p)              { return __hip_atomic_load(p, __ATOMIC_RELAXED, __HIP_MEMORY_SCOPE_AGENT); }
__device__ __forceinline__ unsigned xb_add(unsigned* p, unsigned v) { return __hip_atomic_fetch_add(p, v, __ATOMIC_RELAXED, __HIP_MEMORY_SCOPE_AGENT); }
__device__ __forceinline__ unsigned xb_xcc_id() { return (unsigned)__builtin_amdgcn_s_getreg((3 << 11) | 20) & 0xFu; }
#define XB_SPIN(cond, bar) do { unsigned _sp = 0; while (cond) { __builtin_amdgcn_s_sleep(1); \
    if ((++_sp & 255u) == 0u) { if (xb_ld(&(bar)[XB_TMO])) break; if (_sp > XB_SPIN_CAP) { atomicAdd(&(bar)[XB_TMO], 1u); break; } } } } while (0)
struct XcdBarrier { unsigned* bar; unsigned x; volatile LAS unsigned* st; };
__device__ __forceinline__ XcdBarrier xcd_barrier_post(unsigned* bar, volatile LAS unsigned* st) {
    XcdBarrier b; b.bar = bar; b.x = xb_xcc_id(); b.st = st;
    if (threadIdx.x == 0) (void)xb_add(&bar[XB_XCNT(b.x)], 1u);
    return b;
}
__device__ __forceinline__ void xcd_barrier_complete(unsigned* bar, unsigned x, unsigned& nloc, unsigned& nx) {
    const unsigned G = gridDim.x * gridDim.y * gridDim.z;
    unsigned sum, cnt, mine, sp = 0u;
    for (;;) {
        sum = 0u; cnt = 0u; mine = 0u;
#pragma unroll
        for (unsigned j = 0; j < 16; ++j) { const unsigned c = xb_ld(&bar[XB_XCNT(j)]); sum += c; cnt += (c > 0u) ? 1u : 0u; mine = (j == x) ? c : mine; }
        if (sum == G) break;
        __builtin_amdgcn_s_sleep(1);
        if ((++sp & 255u) == 0u) { if (xb_ld(&bar[XB_TMO])) break; if (sp > XB_SPIN_CAP) { atomicAdd(&bar[XB_TMO], 1u); break; } }
    }
    nloc = mine > 0u ? mine : 1u; nx = cnt > 0u ? cnt : 1u;
}
__device__ __forceinline__ void xcd_barrier(const XcdBarrier& b) {
    asm volatile("s_waitcnt vmcnt(0)" ::: "memory");
    __syncthreads();
    if (threadIdx.x == 0) {
        unsigned* bar = b.bar;
        __builtin_amdgcn_s_waitcnt(0);
        unsigned nloc = b.st[0], nx = b.st[1];
        if (nloc == 0u) { xcd_barrier_complete(bar, b.x, nloc, nx); b.st[0] = nloc; b.st[1] = nx; }
        const unsigned old = xb_add(&bar[XB_XSUB(b.x)], 1u);
        const unsigned gen = old / nloc;
        if (old + 1u == (gen + 1u) * nloc) {
            __builtin_amdgcn_fence(__ATOMIC_RELEASE, "agent");
            asm volatile("s_waitcnt vmcnt(0)" ::: "memory");
            const unsigned og = xb_add(&bar[XB_TOP], 1u);
            const unsigned tg = og / nx;
            if (og + 1u == (tg + 1u) * nx) xb_add(&bar[XB_TOPGEN], 1u);
            else XB_SPIN(xb_ld(&bar[XB_TOPGEN]) == tg, bar);
            __builtin_amdgcn_fence(__ATOMIC_ACQUIRE, "agent");
            xb_add(&bar[XB_XGEN(b.x)], 1u);
            asm volatile("s_waitcnt vmcnt(0)" ::: "memory");
        } else {
            XB_SPIN(xb_ld(&bar[XB_XGEN(b.x)]) == gen, bar);
            __builtin_amdgcn_fence(__ATOMIC_ACQUIRE, "agent");
            asm volatile("s_waitcnt vmcnt(0)" ::: "memory");
        }
    }
    __syncthreads();
}

struct Frame {
    ldsp_t lds;
    volatile LAS unsigned* MISC;
    unsigned* ctl;
    int tid, lane, wave, vcu, G;
    const float* const* in;
    unsigned char* ws;
    float* out;
};
struct Args { const float* in[24]; float* out; unsigned char* ws; int ph_lo, ph_hi; };

__device__ __forceinline__ float wave_sum(float v) {
#pragma unroll
    for (int o = 1; o < 64; o <<= 1) v += __shfl_xor(v, o);
    return v;
}

__device__ __forceinline__ void p0_transpose_item(const float* W, int K, int N, bf16_t* WT, int ldk, const float* rowscale, float colscale, bool qkperm, LAS float* scr, int item, int lane) {
    const int nblk = N / 32, kb = item / nblk, nb = item % nblk, k0 = 64 * kb, n0 = 32 * nb;
    int srcn = n0 + (lane & 31);
    if (qkperm) { const int p = srcn & 63; srcn = (srcn & ~63) + ((p & 1) ? 32 + (p >> 1) : (p >> 1)); }
#pragma unroll 8
    for (int i = 0; i < 32; ++i) { const int kk = 2 * i + (lane >> 5); float v = W[(size_t)(k0 + kk) * N + srcn] * colscale; if (rowscale) v *= rowscale[k0 + kk]; scr[kk * 33 + (lane & 31)] = v; }
    LDS_WAIT(); asm volatile("" ::: "memory");
    const int c = lane & 7;
#pragma unroll
    for (int j = 0; j < 4; ++j) { const int n = (lane >> 3) + 8 * j; const LAS float* s = scr + (8 * c) * 33 + n;
        u32x4 o; o.x = pk2(s[0 * 33], s[1 * 33]); o.y = pk2(s[2 * 33], s[3 * 33]); o.z = pk2(s[4 * 33], s[5 * 33]); o.w = pk2(s[6 * 33], s[7 * 33]);
        *(u32x4*)(WT + (size_t)(n0 + n) * ldk + k0 + 8 * c) = o; }
    LDS_WAIT(); asm volatile("" ::: "memory");
}

__device__ __forceinline__ void p0_xrow(const float* xrow, bf16_t* orow, float* rss, int lane) {
    const f32x4* xr = (const f32x4*)xrow + lane;
    f32x4 v[4]; float s = 0.f;
#pragma unroll
    for (int j = 0; j < 4; ++j) { v[j] = xr[64 * j]; s += (v[j].x * v[j].x + v[j].y * v[j].y) + (v[j].z * v[j].z + v[j].w * v[j].w); }
    s = wave_sum(s);
    u32x2* o8 = (u32x2*)orow + lane;
#pragma unroll
    for (int j = 0; j < 4; ++j) { u32x2 w; w.x = pk2(v[j].x, v[j].y); w.y = pk2(v[j].z, v[j].w); o8[64 * j] = w; }
    if (lane == 0) *rss = s;
}

__device__ __forceinline__ void p0_tabrow(const float* row, bf16_t* img, int e, int lane) {
    const f32x4* xr = (const f32x4*)row + lane;
#pragma unroll
    for (int j = 0; j < 4; ++j) { const f32x4 v = xr[64 * j]; const int col = 256 * j + 4 * lane, s = col >> 6, w = col & 63;
        u32x2 o; o.x = pk2(v.x, v.y); o.y = pk2(v.z, v.w);
        *(u32x2*)(img + ((size_t)s * NEXP + e) * 64 + w) = o; }
}

__device__ __forceinline__ void p0_prologue(const Args& a, Frame& F) {
    unsigned char* ws = a.ws;
    LAS float* scr = (LAS float*)(F.lds + F.wave * 16384);
    const int gw = F.vcu * NWAVES + F.wave, NGW = F.G * NWAVES, lane = F.lane;
    constexpr int I_IN = (DM / 64) * (NIN / 32), I_SQ = (DM / 64) * (DM / 32), I_Q = (DM / 64) * (2048 / 32), I_G = 2;
    constexpr int PER_L = I_IN + 3 * I_SQ + I_Q + 32 * I_G;
    for (int it = gw; it < DEPTH * PER_L; it += NGW) {
        const int l = it / PER_L; int r = it % PER_L;
        if (r < I_IN) { const int nb = r % (NIN / 32), n0 = nb * 32; const int seg = n0 >> 9;
            p0_transpose_item(a.in[8] + (size_t)l * DM * NIN, DM, NIN, (bf16_t*)(ws + WS_WIN) + (size_t)l * NIN * DM, DM, a.in[5] + l * DM, seg == 1 ? 0.125f : 1.0f, seg <= 1, scr, r, lane); continue; }
        r -= I_IN;
        if (r < I_SQ) { p0_transpose_item(a.in[10] + (size_t)l * DM * DM, DM, DM, (bf16_t*)(ws + WS_WMIX + (size_t)l * 6 * MiB), DM, a.in[9] + l * DM, 1.0f, false, scr, r, lane); continue; }
        r -= I_SQ;
        if (r < I_SQ) { p0_transpose_item(a.in[18] + (size_t)l * DM * DM, DM, DM, (bf16_t*)(ws + WS_WMIX + (size_t)l * 6 * MiB + 2 * MiB), DM, nullptr, 1.0f, false, scr, r, lane); continue; }
        r -= I_SQ;
        if (r < I_SQ) { p0_transpose_item(a.in[19] + (size_t)l * DM * DM, DM, DM, (bf16_t*)(ws + WS_WMIX + (size_t)l * 6 * MiB + 4 * MiB), DM, nullptr, 1.0f, false, scr, r, lane); continue; }
        r -= I_SQ;
        if (r < I_Q) { p0_transpose_item(a.in[20] + (size_t)l * DM * 2048, DM, 2048, (bf16_t*)(ws + WS_WQ) + (size_t)l * 2048 * DM, DM, a.in[6] + l * DM, 1.0f, false, scr, r, lane); continue; }
        r -= I_Q;
        { const int mat = r >> 1, sub = r & 1, nb = mat >> 1, gsel = mat & 1;
          const float* W = (gsel ? a.in[15] : a.in[13]) + ((size_t)l * NBLK + nb) * BS * BS;
          bf16_t* WT = (bf16_t*)(ws + WS_WG) + (((size_t)l * NBLK + nb) * 2 + gsel) * BS * BS;
          p0_transpose_item(W, BS, BS, WT, BS, nullptr, 1.0f, false, scr, sub, lane); }
    }
    { const float* ksrc = a.in[21]; bf16_t* kdst = (bf16_t*)(ws + WS_KEYS); const int n4 = DEPTH * PH * 2 * NKEY * HK / 4;
      for (int i = gw * 64 + lane; i < n4; i += NGW * 64) { const f32x4 v = ((const f32x4*)ksrc)[i]; u32x2 o; o.x = pk2(v.x, v.y); o.y = pk2(v.z, v.w); ((u32x2*)kdst)[i] = o; } }
    for (int m = gw; m < MTOT; m += NGW) {
        const float* xr = m < M_P ? a.in[0] + (size_t)m * DM : a.in[1] + (size_t)(m - M_P) * DM;
        p0_xrow(xr, (bf16_t*)(ws + WS_XB) + (size_t)m * DM, (float*)(ws + WS_RSS) + m, lane);
    }
    { float* rot = (float*)(ws + WS_ROT);
      for (int i = gw * 64 + lane; i < 2056 * 32; i += NGW * 64) {
          const int pi = i >> 5, fi = i & 31; const double pos = pi < 2048 ? (double)pi : (double)(PAST + pi - 2048);
          const double f8[8] = {1.0, 0.7498942093324559, 0.5623413251903491, 0.4216965034285822, 0.31622776601683794, 0.23713737056616552, 0.1778279410038923, 0.1333521432163324};
          double fr = 1.0; switch (fi >> 3) { case 1: fr = 0.1; break; case 2: fr = 0.01; break; case 3: fr = 0.001; break; default: break; }
          double fsel = f8[0];
#pragma unroll
          for (int q = 1; q < 8; ++q) fsel = ((fi & 7) == q) ? f8[q] : fsel;
          const double ang = pos * (fr * fsel);
          const double n = __builtin_rint(ang * 0.15915494309189535);
          double rr = __builtin_fma(-n, 6.283185307179586, ang); rr = __builtin_fma(-n, 2.4492935982947064e-16, rr);
          const float rf = (float)rr;
          rot[(size_t)pi * 64 + fi] = cosf(rf); rot[(size_t)pi * 64 + 32 + fi] = sinf(rf);
      } }
    for (int r = gw; r < DEPTH * 2 * NEXP; r += NGW) {
        const int l = r / (2 * NEXP), t = (r / NEXP) & 1, e = r % NEXP;
        const float* src = (t ? a.in[23] : a.in[22]) + ((size_t)l * NEXP + e) * DM;
        bf16_t* img = (bf16_t*)(ws + WS_TAB + ((size_t)l * 2 + t) * 32 * MiB);
        p0_tabrow(src, img, e, lane);
    }
}

namespace pg8 {
struct EpiIn {
    static constexpr bool PERM = true;
    bf16_t* P; const float* rss; const float* rot;
    __device__ __forceinline__ void operator()(const f32x4 (&acc)[2][2][4][2], const Unit& u, int wr, int wc, int fr, int fq) const {
        const int seg = u.pn < 4 ? (u.pn >> 1) : (u.pn >> 2) + 1;
        const int row0 = u.pm * BM + wr * 64 + fr;
        if (seg <= 1) {
            float lg[2];
#pragma unroll
            for (int bj = 0; bj < 2; ++bj) { const int hh = 4 * (u.pn & 1) + 2 * bj + (wc >> 1); lg[bj] = logg_of(hh); }
            const int i0 = 16 * (wc & 1) + 4 * fq;
#pragma unroll
            for (int ai = 0; ai < 2; ++ai)
#pragma unroll
                for (int m = 0; m < 4; ++m) {
                    const int row = row0 + ai * HALF + m * 16;
                    const float rstd = rsqrtf(rss[row] * (1.0f / DM) + EPS);
                    const int pi = row < M_P ? (row & (SEQ - 1)) : SEQ + ((row - M_P) & (DECT - 1));
                    const float jj1 = (float)((row < M_P ? (row & (CH - 1)) : ((row - M_P) & (DECT - 1))) + 1);
                    const f32x4 c4 = *(const f32x4*)(rot + (size_t)pi * 64 + i0), s4 = *(const f32x4*)(rot + (size_t)pi * 64 + 32 + i0);
#pragma unroll
                    for (int bj = 0; bj < 2; ++bj) {
                        const int hh = 4 * (u.pn & 1) + 2 * bj + (wc >> 1);
                        const float f = __expf(seg == 0 ? jj1 * lg[bj] : -jj1 * lg[bj]) * rstd;
                        const f32x4 v0 = acc[ai][bj][m][0], v1 = acc[ai][bj][m][1];
                        const f32x4 x1 = (f32x4){v0[0], v0[2], v1[0], v1[2]}, x2 = (f32x4){v0[1], v0[3], v1[1], v1[3]};
                        const f32x4 o1 = (x1 * c4 - x2 * s4) * f, o2 = (x1 * s4 + x2 * c4) * f;
                        bf16_t* dst = P + (size_t)row * LDP + seg * 512 + hh * 64 + i0;
                        u32x2 w1, w2; w1.x = pk2(o1[0], o1[1]); w1.y = pk2(o1[2], o1[3]); w2.x = pk2(o2[0], o2[1]); w2.y = pk2(o2[2], o2[3]);
                        *(u32x2*)dst = w1; *(u32x2*)(dst + 32) = w2;
                    }
                    asm volatile("" ::: "memory");
                }
        } else {
            const int col0 = u.pn * BM + wc * 32 + 8 * fq;
#pragma unroll
            for (int ai = 0; ai < 2; ++ai)
#pragma unroll
                for (int m = 0; m < 4; ++m) {
                    const int row = row0 + ai * HALF + m * 16;
                    const float rstd = rsqrtf(rss[row] * (1.0f / DM) + EPS);
                    bf16_t* rowp = P + (size_t)row * LDP + col0;
#pragma unroll
                    for (int bj = 0; bj < 2; ++bj) {
                        f32x4 v0 = acc[ai][bj][m][0] * rstd, v1 = acc[ai][bj][m][1] * rstd;
                        if (seg == 3) {
#pragma unroll
                            for (int j = 0; j < 4; ++j) { v0[j] = siluf_(v0[j]); v1[j] = siluf_(v1[j]); }
                        } else if (seg == 5) {
#pragma unroll
                            for (int j = 0; j < 4; ++j) { v0[j] = geluf_(v0[j]); v1[j] = geluf_(v1[j]); }
                        } else if (seg >= 6) {
#pragma unroll
                            for (int j = 0; j < 4; ++j) { v0[j] = sigmoidf_(v0[j]); v1[j] = sigmoidf_(v1[j]); }
                        }
                        u32x4 w; w.x = pk2(v0[0], v0[1]); w.y = pk2(v0[2], v0[3]); w.z = pk2(v1[0], v1[1]); w.w = pk2(v1[2], v1[3]);
                        *(u32x4*)(rowp + bj * HALF) = w;
                    }
                    asm volatile("" ::: "memory");
                }
        }
    }
};

struct EpiMerge {
    static constexpr bool PERM = true;
    bf16_t* P;
    __device__ __forceinline__ void operator()(const f32x4 (&acc)[2][2][4][2], const Unit& u, int wr, int wc, int fr, int fq) const {
        const int row0 = u.pm * BM + wr * 64 + fr, col0 = u.pn * BM + wc * 32 + 8 * fq;
        const int gc = u.half ? PC_GB : PC_GA;
#pragma unroll
        for (int ai = 0; ai < 2; ++ai)
#pragma unroll
            for (int m = 0; m < 4; ++m) {
                bf16_t* rowp = P + (size_t)(row0 + ai * HALF + m * 16) * LDP;
#pragma unroll
                for (int bj = 0; bj < 2; ++bj) {
                    const int c = col0 + bj * HALF;
                    const u32x4 g = *(const u32x4*)(rowp + gc + c);
                    f32x4 v0 = acc[ai][bj][m][0], v1 = acc[ai][bj][m][1];
                    v0[0] *= bflo(g.x); v0[1] *= bfhi(g.x); v0[2] *= bflo(g.y); v0[3] *= bfhi(g.y);
                    v1[0] *= bflo(g.z); v1[1] *= bfhi(g.z); v1[2] *= bflo(g.w); v1[3] *= bfhi(g.w);
                    if (u.half) { const u32x4 p = *(const u32x4*)(rowp + PC_MRG + c);
                        v0[0] += bflo(p.x); v0[1] += bfhi(p.x); v0[2] += bflo(p.y); v0[3] += bfhi(p.y);
                        v1[0] += bflo(p.z); v1[1] += bfhi(p.z); v1[2] += bflo(p.w); v1[3] += bfhi(p.w); }
                    u32x4 w; w.x = pk2(v0[0], v0[1]); w.y = pk2(v0[2], v0[3]); w.z = pk2(v1[0], v1[1]); w.w = pk2(v1[2], v1[3]);
                    *(u32x4*)(rowp + PC_MRG + c) = w;
                }
                asm volatile("" ::: "memory");
            }
    }
};

struct EpiWo {
    static constexpr bool PERM = false;
    const float* xp; const float* xs;
    float* X; bf16_t* XB; float* rssp;
    __device__ __forceinline__ void operator()(const f32x4 (&acc)[2][2][4][2], const Unit& u, int wr, int wc, int fr, int fq) const {
        const int row0 = u.pm * BM + wr * 64 + fr, col0 = u.pn * BM + wc * 32 + 4 * fq;
#pragma unroll
        for (int ai = 0; ai < 2; ++ai)
#pragma unroll
            for (int m = 0; m < 4; ++m) {
                const int row = row0 + ai * HALF + m * 16;
                const float* src = (row < M_P ? xp + (size_t)row * DM : xs + (size_t)(row - M_P) * DM) + col0;
                float* dst = X + (size_t)row * DM + col0; bf16_t* dstb = XB + (size_t)row * DM + col0;
                float ss = 0.f;
#pragma unroll
                for (int bj = 0; bj < 2; ++bj)
#pragma unroll
                    for (int n = 0; n < 2; ++n) {
                        const f32x4 o = *(const f32x4*)(src + bj * HALF + n * 16) + acc[ai][bj][m][n];
                        *(f32x4*)(dst + bj * HALF + n * 16) = o;
                        u32x2 w; w.x = pk2(o[0], o[1]); w.y = pk2(o[2], o[3]); *(u32x2*)(dstb + bj * HALF + n * 16) = w;
                        ss += (o[0] * o[0] + o[1] * o[1]) + (o[2] * o[2] + o[3] * o[3]);
                    }
                ss += __shfl_xor(ss, 16); ss += __shfl_xor(ss, 32);
                if (fq == 0) rssp[(size_t)(u.pn * 4 + wc) * MTOT + row] = ss;
                asm volatile("" ::: "memory");
            }
    }
};

struct EpiQ {
    static constexpr bool PERM = true;
    bf16_t* P; const float* rssp; float* rss2;
    __device__ __forceinline__ void operator()(const f32x4 (&acc)[2][2][4][2], const Unit& u, int wr, int wc, int fr, int fq) const {
        const int row0 = u.pm * BM + wr * 64 + fr, col0 = u.pn * BM + wc * 32 + 8 * fq;
#pragma unroll
        for (int ai = 0; ai < 2; ++ai)
#pragma unroll
            for (int m = 0; m < 4; ++m) {
                const int row = row0 + ai * HALF + m * 16;
                float s = 0.f;
#pragma unroll
                for (int j = 0; j < 16; ++j) s += rssp[(size_t)j * MTOT + row];
                if (u.pn == 0 && wc == 0 && fq == 0) rss2[row] = s;
                const float rstd = rsqrtf(s * (1.0f / DM) + EPS);
                bf16_t* rowp = P + (size_t)row * LDP + PC_QP + col0;
#pragma unroll
                for (int bj = 0; bj < 2; ++bj) {
                    const f32x4 v0 = acc[ai][bj][m][0] * rstd, v1 = acc[ai][bj][m][1] * rstd;
                    u32x4 w; w.x = pk2(v0[0], v0[1]); w.y = pk2(v0[2], v0[3]); w.z = pk2(v1[0], v1[1]); w.w = pk2(v1[2], v1[3]);
                    *(u32x4*)(rowp + bj * HALF) = w;
                }
                asm volatile("" ::: "memory");
            }
    }
};
}

__device__ __forceinline__ void mma32(f32x16& acc, ldsp_t A, int lda_b, ldsp_t Bt, int ldb_b, int ksteps, int lane) {
    ldsp_t ap = A + (lane & 31) * lda_b + (lane >> 5) * 16;
    ldsp_t bp = Bt + (lane & 31) * ldb_b + (lane >> 5) * 16;
    for (int ks = 0; ks < ksteps; ++ks) {
        const bf16x8 a = *(const LAS bf16x8*)(ap + ks * 32), b = *(const LAS bf16x8*)(bp + ks * 32);
        acc = __builtin_amdgcn_mfma_f32_32x32x16_bf16(a, b, acc, 0, 0, 0);
    }
}
#define ZERO16 ((f32x16){0.f,0.f,0.f,0.f,0.f,0.f,0.f,0.f,0.f,0.f,0.f,0.f,0.f,0.f,0.f,0.f})

constexpr int R_QS = 0, R_KS = 18432, R_KST = 36864, R_VST = 54272, R_SS = 89088, R_RST = 123904, R_ST = 142336;
constexpr int LD64 = 144, LD128 = 272;
__device__ __forceinline__ void ret_prompt_unit(const Args& a, Frame& F, int l, int b, int h) {
    const int tid = F.tid, lane = F.lane, w = F.wave, hi = lane >> 5, l31 = lane & 31;
    ldsp_t lds = F.lds;
    bf16_t* P = (bf16_t*)(a.ws + WS_P);
    const float lg = logg_of(h), G = __expf(128.0f * lg);
    f32x16 racc = ZERO16;
    const int db = w >> 2, eb = w & 3;
    for (int n = 0; n < 16; ++n) {
        const size_t tok0 = (size_t)b * SEQ + n * CH;
#pragma unroll
        for (int i = 0; i < 2; ++i) { const int p = tid + 512 * i, row = p >> 3, c8 = p & 7;
            const bf16_t* src = P + (tok0 + row) * LDP + h * 64 + c8 * 8;
            const u32x4 qv = *(const u32x4*)(src + PC_Q), kv = *(const u32x4*)(src + PC_K);
            *(LAS u32x4*)(lds + R_QS + row * LD64 + c8 * 16) = qv; *(LAS u32x4*)(lds + R_KS + row * LD64 + c8 * 16) = kv;
            const unsigned kw[4] = {kv.x, kv.y, kv.z, kv.w};
#pragma unroll
            for (int j = 0; j < 4; ++j) { *(LAS bf16_t*)(lds + R_KST + (c8 * 8 + 2 * j) * LD128 + row * 2) = (bf16_t)(kw[j] & 0xffffu); *(LAS bf16_t*)(lds + R_KST + (c8 * 8 + 2 * j + 1) * LD128 + row * 2) = (bf16_t)(kw[j] >> 16); } }
#pragma unroll
        for (int i = 0; i < 4; ++i) { const int p = tid + 512 * i, row = p >> 4, c8 = p & 15;
            const u32x4 vv = *(const u32x4*)(P + (tok0 + row) * LDP + PC_V + h * 128 + c8 * 8);
            const unsigned vw[4] = {vv.x, vv.y, vv.z, vv.w};
#pragma unroll
            for (int j = 0; j < 4; ++j) { *(LAS bf16_t*)(lds + R_VST + (c8 * 8 + 2 * j) * LD128 + row * 2) = (bf16_t)(vw[j] & 0xffffu); *(LAS bf16_t*)(lds + R_VST + (c8 * 8 + 2 * j + 1) * LD128 + row * 2) = (bf16_t)(vw[j] >> 16); } }
#pragma unroll
        for (int g = 0; g < 4; ++g) { u32x2 wv; wv.x = pk2(racc[4 * g], racc[4 * g + 1]); wv.y = pk2(racc[4 * g + 2], racc[4 * g + 3]);
            *(LAS u32x2*)(lds + R_RST + (32 * eb + l31) * LD64 + (32 * db + 8 * g + 4 * hi) * 2) = wv; }
        __syncthreads();
#pragma unroll
        for (int t2 = 0; t2 < 2; ++t2) { const int t = 2 * w + t2, mb = t >> 2, jb = t & 3;
            if (mb <= jb) { f32x16 sacc = ZERO16;
                mma32(sacc, lds + R_KS + mb * 32 * LD64, LD64, lds + R_QS + jb * 32 * LD64, LD64, 4, lane);
                const int j = 32 * jb + l31;
#pragma unroll
                for (int g = 0; g < 4; ++g) { const int m0 = 32 * mb + 8 * g + 4 * hi; float v[4];
#pragma unroll
                    for (int q = 0; q < 4; ++q) v[q] = (j >= m0 + q) ? sacc[4 * g + q] : 0.f;
                    u32x2 wv; wv.x = pk2(v[0], v[1]); wv.y = pk2(v[2], v[3]);
                    *(LAS u32x2*)(lds + R_SS + j * LD128 + m0 * 2) = wv; } } }
        __syncthreads();
        const int jb = w >> 1, eh = w & 1;
        f32x16 oacc[2];
#pragma unroll
        for (int t = 0; t < 2; ++t) { oacc[t] = ZERO16; const int e2 = 2 * eh + t;
            mma32(oacc[t], lds + R_RST + e2 * 32 * LD64, LD64, lds + R_QS + jb * 32 * LD64, LD64, 4, lane);
            mma32(oacc[t], lds + R_VST + e2 * 32 * LD128, LD128, lds + R_SS + jb * 32 * LD128, LD128, 2 * (jb + 1), lane); }
        float s1 = 0.f, s2 = 0.f;
#pragma unroll
        for (int t = 0; t < 2; ++t)
#pragma unroll
            for (int r = 0; r < 16; ++r) { s1 += oacc[t][r]; s2 += oacc[t][r] * oacc[t][r]; }
        s1 += __shfl_xor(s1, 32); s2 += __shfl_xor(s2, 32);
        if (hi == 0) *(LAS f32x2*)(lds + R_ST + (eh * 128 + 32 * jb + l31) * 8) = (f32x2){s1, s2};
        __syncthreads();
        { const int j = 32 * jb + l31;
          const f32x2 sa = *(const LAS f32x2*)(lds + R_ST + j * 8), sb = *(const LAS f32x2*)(lds + R_ST + (128 + j) * 8);
          const float mu = (sa.x + sb.x) * (1.0f / DV), var = (sa.y + sb.y) * (1.0f / DV) - mu * mu, rstd = rsqrtf(fmaxf(var, 0.f) + EPS);
          bf16_t* prow = P + (tok0 + j) * LDP + h * 128;
#pragma unroll
          for (int t = 0; t < 2; ++t)
#pragma unroll
              for (int g = 0; g < 4; ++g) { const int e0 = 32 * (2 * eh + t) + 8 * g + 4 * hi;
                  const u32x2 gv = *(const u32x2*)(prow + PC_GR + e0);
                  const float o0 = (oacc[t][4 * g] - mu) * rstd * bflo(gv.x), o1 = (oacc[t][4 * g + 1] - mu) * rstd * bfhi(gv.x);
                  const float o2 = (oacc[t][4 * g + 2] - mu) * rstd * bflo(gv.y), o3 = (oacc[t][4 * g + 3] - mu) * rstd * bfhi(gv.y);
                  u32x2 wv; wv.x = pk2(o0, o1); wv.y = pk2(o2, o3);
                  *(u32x2*)(prow + PC_ARET + e0) = wv; } }
        mma32(racc, lds + R_KST + db * 32 * LD128, LD128, lds + R_VST + eb * 32 * LD128, LD128, 8, lane);
#pragma unroll
        for (int r = 0; r < 16; ++r) racc[r] *= G;
        __syncthreads();
    }
    float* so = a.out + O_SRP + ((((size_t)l * NBATCH + b) * HR + h) * DK) * DV;
#pragma unroll
    for (int r = 0; r < 16; ++r) { const int d = 32 * db + (r & 3) + 8 * (r >> 2) + 4 * hi; so[(size_t)d * DV + 32 * eb + l31] = racc[r]; }
}

__device__ __forceinline__ void ret_sample_unit(const Args& a, Frame& F, int l, int bs, int h) {
    const int tid = F.tid, lane = F.lane, w = F.wave;
    LAS float* qd = (LAS float*)F.lds; LAS float* ku = qd + 512; LAS float* vv = ku + 512; LAS float* S = vv + 1024; LAS float* crossp = S + 64; LAS float* red = crossp + 4096;
    bf16_t* P = (bf16_t*)(a.ws + WS_P);
    const size_t tok0 = (size_t)M_P + bs * DECT;
    { const int j = tid >> 6, d = tid & 63; const bf16_t* src = P + (tok0 + j) * LDP + h * 64 + d; qd[tid] = bf1(src[PC_Q]); ku[tid] = bf1(src[PC_K]); }
#pragma unroll
    for (int i = 0; i < 2; ++i) { const int idx = tid + 512 * i, m = idx >> 7, e = idx & 127; vv[idx] = bf1(P[(tok0 + m) * LDP + PC_V + h * 128 + e]); }
    __syncthreads();
    const int dg = tid >> 7, e = tid & 127;
    const size_t soff = ((((size_t)l * DECB + bs) * HR + h) * DK) * DV;
    const float* r0 = a.in[2] + soff; float* rn = a.out + O_SRS + soff;
    const float lg = logg_of(h), G8 = __expf(8.0f * lg);
    float cross[8];
#pragma unroll
    for (int j = 0; j < 8; ++j) cross[j] = 0.f;
#pragma unroll 4
    for (int dd = 0; dd < 16; ++dd) { const int d = dg * 16 + dd; const float r = r0[(size_t)d * DV + e]; float kvs = 0.f;
#pragma unroll
        for (int m = 0; m < 8; ++m) kvs += ku[m * 64 + d] * vv[m * 128 + e];
        rn[(size_t)d * DV + e] = G8 * (r + kvs);
#pragma unroll
        for (int j = 0; j < 8; ++j) cross[j] += qd[j * 64 + d] * r; }
#pragma unroll
    for (int j = 0; j < 8; ++j) crossp[(dg * 8 + j) * 128 + e] = cross[j];
    if (tid < 64) { const int j = tid >> 3, m = tid & 7; float s = 0.f;
        if (j >= m) { for (int d = 0; d < 64; ++d) s += qd[j * 64 + d] * ku[m * 64 + d]; }
        S[tid] = s; }
    __syncthreads();
    float o[2];
#pragma unroll
    for (int jj = 0; jj < 2; ++jj) { const int j = dg + 4 * jj; float s = 0.f;
#pragma unroll
        for (int g = 0; g < 4; ++g) s += crossp[(g * 8 + j) * 128 + e];
#pragma unroll
        for (int m = 0; m < 8; ++m) s += S[j * 8 + m] * vv[m * 128 + e];
        o[jj] = s;
        const float t1 = wave_sum(s), t2 = wave_sum(s * s);
        if (lane == 0) { red[(jj * 8 + w) * 2] = t1; red[(jj * 8 + w) * 2 + 1] = t2; } }
    __syncthreads();
#pragma unroll
    for (int jj = 0; jj < 2; ++jj) { const int j = dg + 4 * jj, w0 = 2 * dg;
        const float t1 = red[(jj * 8 + w0) * 2] + red[(jj * 8 + w0 + 1) * 2], t2 = red[(jj * 8 + w0) * 2 + 1] + red[(jj * 8 + w0 + 1) * 2 + 1];
        const float mu = t1 * (1.0f / DV), var = t2 * (1.0f / DV) - mu * mu, rstd = rsqrtf(fmaxf(var, 0.f) + EPS);
        bf16_t* prow = P + (tok0 + j) * LDP + h * 128 + e;
        prow[PC_ARET] = (bf16_t)f2bf((o[jj] - mu) * rstd * bf1(prow[PC_GR])); }
    __syncthreads();
}

constexpr int N_XRL = 0, N_XCF = 33536, N_XCB = 66304, N_WGT = 84736, N_CAR = 103168, N_BUF = 107264;
__device__ __forceinline__ void rnn_unit(const Args& a, Frame& F, int l, bool sample, int bg, int nb) {
    const int tid = F.tid, lane = F.lane, w = F.wave, hi = lane >> 5, l31 = lane & 31;
    ldsp_t lds = F.lds;
    LAS float* xrl = (LAS float*)(lds + N_XRL); LAS float* xcf = (LAS float*)(lds + N_XCF); LAS float* car = (LAS float*)(lds + N_CAR); LAS float* bufl = (LAS float*)(lds + N_BUF);
    LAS float* aa = xrl; LAS float* uu = xcf;
    bf16_t* P = (bf16_t*)(a.ws + WS_P);
    const int ch0 = nb * BS;
    { const bf16_t* wg = (const bf16_t*)(a.ws + WS_WG) + ((size_t)l * NBLK + nb) * 2 * BS * BS;
#pragma unroll
      for (int i = 0; i < 2; ++i) { const int p = tid + 512 * i, row = p >> 3, c8 = p & 7; *(LAS u32x4*)(lds + N_WGT + row * LD64 + c8 * 16) = *(const u32x4*)(wg + row * 64 + c8 * 8); } }
    const int cc = tid & 63;
    const float* cwp = a.in[11] + (size_t)l * 4 * DM + ch0 + cc;
    const float cw0 = cwp[0], cw1 = cwp[DM], cw2 = cwp[2 * DM], cw3 = cwp[3 * DM], cbv = a.in[12][l * DM + ch0 + cc];
    const int rb = w >> 1, cb = w & 1, dcol = 32 * cb + l31;
    const float bav = a.in[14][l * DM + ch0 + dcol], bxv = a.in[16][l * DM + ch0 + dcol];
    const float spl = log1pf(__expf(-a.in[17][l * DM + ch0 + dcol]));
    const int ntiles = sample ? 1 : 16;
    float hcar = 0.f;
    if (sample) {
        for (int i = tid; i < 16 * 3 * 64; i += NTHREADS) { const int s = i / 192, r = (i / 64) % 3, c = i & 63;
            bufl[i] = a.in[4][(((size_t)l * DECB + bg * 16 + s) * 3 + r) * DM + ch0 + c]; }
    }
    for (int n = 0; n < ntiles; ++n) {
        const size_t tok0 = sample ? (size_t)M_P + bg * 128 : (size_t)bg * SEQ + n * 128;
        for (int p = tid; p < 131 * 8; p += NTHREADS) { const int row = p >> 3, c8 = p & 7;
            u32x4 v = (u32x4){0u, 0u, 0u, 0u};
            if (row >= 3 || (!sample && n > 0)) v = *(const u32x4*)(P + (tok0 + row - 3) * LDP + PC_XR + ch0 + c8 * 8);
            LAS float* d = xrl + row * 64 + c8 * 8;
            d[0] = bflo(v.x); d[1] = bfhi(v.x); d[2] = bflo(v.y); d[3] = bfhi(v.y); d[4] = bflo(v.z); d[5] = bfhi(v.z); d[6] = bflo(v.w); d[7] = bfhi(v.w); }
        __syncthreads();
        { const int tg = tid >> 6;
#pragma unroll 4
          for (int i = 0; i < 16; ++i) { const int t = tg * 16 + i; float x0, x1, x2;
              const float x3 = xrl[(t + 3) * 64 + cc];
              if (sample) { const int s = t >> 3, j = t & 7;
                  x0 = j >= 3 ? xrl[t * 64 + cc] : bufl[(s * 3 + j) * 64 + cc];
                  x1 = j >= 2 ? xrl[(t + 1) * 64 + cc] : bufl[(s * 3 + j + 1) * 64 + cc];
                  x2 = j >= 1 ? xrl[(t + 2) * 64 + cc] : bufl[(s * 3 + j + 2) * 64 + cc];
              } else { x0 = xrl[t * 64 + cc]; x1 = xrl[(t + 1) * 64 + cc]; x2 = xrl[(t + 2) * 64 + cc]; }
              const float xc = cbv + cw0 * x0 + cw1 * x1 + cw2 * x2 + cw3 * x3;
              xcf[t * 64 + cc] = xc; *(LAS bf16_t*)(lds + N_XCB + t * LD64 + cc * 2) = (bf16_t)f2bf(xc); } }
        if (sample) { if (tid < 192) { }     }
        if (sample) { for (int i = tid; i < 16 * 3 * 64; i += NTHREADS) { const int s = i / 192, r = (i / 64) % 3, c = i & 63;
                a.out[O_SCS + (((size_t)l * DECB + bg * 16 + s) * 3 + r) * DM + ch0 + c] = xrl[(3 + s * 8 + 5 + r) * 64 + c]; } }
        else if (n == 15) { if (tid < 192) { const int r = tid >> 6, c = tid & 63; a.out[O_SCP + (((size_t)l * NBATCH + bg) * 3 + r) * DM + ch0 + c] = xrl[(3 + 125 + r) * 64 + c]; } }
        __syncthreads();
        { f32x16 ar = ZERO16, ai = ZERO16;
          mma32(ar, lds + N_XCB + rb * 32 * LD64, LD64, lds + N_WGT + (32 * cb) * LD64, LD64, 4, lane);
          mma32(ai, lds + N_XCB + rb * 32 * LD64, LD64, lds + N_WGT + (64 + 32 * cb) * LD64, LD64, 4, lane);
#pragma unroll
          for (int r = 0; r < 16; ++r) { const int t = 32 * rb + (r & 3) + 8 * (r >> 2) + 4 * hi;
              const float rg = sigmoidf_(ar[r] + bav), ig = sigmoidf_(ai[r] + bxv);
              const float la = -8.0f * rg * spl, av = __expf(la), mult = sqrtf(fmaxf(-expm1f(2.0f * la), 0.f));
              const float xc = xcf[t * 64 + dcol];
              aa[t * 64 + dcol] = av; uu[t * 64 + dcol] = mult * ig * xc; } }
        __syncthreads();
        if (!sample) {
            float Ap = 1.f, Hl = 0.f;
#pragma unroll 4
            for (int i = 0; i < 16; ++i) { const int t = 16 * w + i; const float av = aa[t * 64 + cc], uv = uu[t * 64 + cc]; Hl = av * Hl + uv; Ap *= av; }
            car[w * 64 + cc] = Ap; car[512 + w * 64 + cc] = Hl;
            __syncthreads();
            float hin = hcar, hnext = hcar;
#pragma unroll
            for (int w2 = 0; w2 < 8; ++w2) { const float A2 = car[w2 * 64 + cc], H2 = car[512 + w2 * 64 + cc]; hnext = A2 * hnext + H2; if (w2 < w) hin = hnext; }
            float hh = hin;
#pragma unroll 4
            for (int i = 0; i < 16; ++i) { const int t = 16 * w + i; hh = aa[t * 64 + cc] * hh + uu[t * 64 + cc];
                bf16_t* gp = P + (tok0 + t) * LDP + PC_GN + ch0 + cc; *gp = (bf16_t)f2bf(hh * bf1(*gp)); }
            hcar = hnext;
        } else {
#pragma unroll
            for (int s2 = 0; s2 < 2; ++s2) { const int s = 2 * w + s2, bs = bg * 16 + s;
                float hh = a.in[3][((size_t)l * DECB + bs) * DM + ch0 + cc];
#pragma unroll
                for (int j = 0; j < 8; ++j) { const int t = s * 8 + j; hh = aa[t * 64 + cc] * hh + uu[t * 64 + cc];
                    bf16_t* gp = P + (tok0 + t) * LDP + PC_GN + ch0 + cc; *gp = (bf16_t)f2bf(hh * bf1(*gp)); }
                a.out[O_SHS + ((size_t)l * DECB + bs) * DM + ch0 + cc] = hh; }
        }
        __syncthreads();
    }
    if (!sample && w == 0) a.out[O_SHP + ((size_t)l * NBATCH + bg) * DM + ch0 + cc] = hcar;
}

__device__ __forceinline__ unsigned ord_of(float f) { const unsigned u = __builtin_bit_cast(unsigned, f); return u ^ ((u >> 31) ? 0xFFFFFFFFu : 0x80000000u); }
__device__ __forceinline__ float ord_inv(unsigned o) { const unsigned u = (o >> 31) ? (o ^ 0x80000000u) : ~o; return __builtin_bit_cast(float, u); }
__host__ __device__ constexpr bool cand_ok(int a, int b) { return (a + 1) * (b + 1) <= 16; }

__device__ __forceinline__ void route_unit(const Args& a, int l, int tb, int h, int lane) {
    const int hi = lane >> 5, l31 = lane & 31, token = tb * 32 + l31;
    const bf16_t* P = (const bf16_t*)(a.ws + WS_P);
    const bf16_t* qrow = P + (size_t)token * LDP + PC_QP + h * 256 + hi * 8;
    const bf16_t* kbase = (const bf16_t*)(a.ws + WS_KEYS) + ((size_t)(l * PH + h) * 2) * NKEY * HK + (size_t)l31 * HK + hi * 8;
    unsigned L[2][16];
#pragma unroll
    for (int p = 0; p < 2; ++p) {
        f32x16 acc[4];
#pragma unroll
        for (int kb = 0; kb < 4; ++kb) acc[kb] = ZERO16;
#pragma unroll 2
        for (int ks = 0; ks < 8; ++ks) {
            const bf16x8 bq = *(const bf16x8*)(qrow + p * 128 + ks * 16);
#pragma unroll
            for (int kb = 0; kb < 4; ++kb) { const bf16x8 ak = *(const bf16x8*)(kbase + ((size_t)p * NKEY + kb * 32) * HK + ks * 16);
                acc[kb] = __builtin_amdgcn_mfma_f32_32x32x16_bf16(ak, bq, acc[kb], 0, 0, 0); }
        }
        unsigned pk[64];
#pragma unroll
        for (int kb = 0; kb < 4; ++kb)
#pragma unroll
            for (int r = 0; r < 16; ++r) { const int key = 32 * kb + (r & 3) + 8 * (r >> 2) + 4 * hi; pk[kb * 16 + r] = (ord_of(acc[kb][r]) & ~127u) | (unsigned)(127 - key); }
        unsigned prev = 0xFFFFFFFFu;
#pragma unroll
        for (int it = 0; it < 16; ++it) { unsigned m = 0u;
#pragma unroll
            for (int i = 0; i < 64; ++i) { const unsigned t = pk[i] < prev ? pk[i] : 0u; m = m > t ? m : t; }
            const unsigned o = (unsigned)__shfl_xor((int)m, 32); m = m > o ? m : o; L[p][it] = m; prev = m; }
    }
    float sa[16], sb[16];
#pragma unroll
    for (int i = 0; i < 16; ++i) { sa[i] = ord_inv(L[0][i] & ~127u); sb[i] = ord_inv(L[1][i] & ~127u); }
    unsigned ck[50];
    { int n = 0;
#pragma unroll
      for (int x = 0; x < 16; ++x)
#pragma unroll
          for (int y = 0; y < 16; ++y) if (cand_ok(x, y)) { ck[n] = (ord_of(sa[x] + sb[y]) & ~255u) | (unsigned)(255 - (x * 16 + y)); ++n; } }
    unsigned best[16];
    { unsigned prev = 0xFFFFFFFFu;
#pragma unroll
      for (int it = 0; it < 16; ++it) { unsigned m = 0u;
#pragma unroll
          for (int i = 0; i < 50; ++i) { const unsigned t = ck[i] < prev ? ck[i] : 0u; m = m > t ? m : t; }
          best[it] = m; prev = m; } }
    float sc[16], ssum = 0.f; const float mx = ord_inv(best[0] & ~255u);
#pragma unroll
    for (int it = 0; it < 16; ++it) { sc[it] = __expf(ord_inv(best[it] & ~255u) - mx); ssum += sc[it]; }
    const float inv = 1.0f / ssum;
    unsigned* eo = (unsigned*)(a.ws + WS_EIDX) + (size_t)token * 128 + h * 16 + hi * 8;
    float* go = (float*)(a.ws + WS_GATE) + (size_t)token * 128 + h * 16 + hi * 8;
#pragma unroll
    for (int it = 0; it < 8; ++it) {
        unsigned b0 = best[it], b1 = best[it + 8]; float g0 = sc[it], g1 = sc[it + 8];
        asm volatile("" : "+v"(b0), "+v"(b1), "+v"(g0), "+v"(g1));
        const unsigned bsel = hi ? b1 : b0; const float gsel = (hi ? g1 : g0) * inv;
        const unsigned c = 255u - (bsel & 255u), ca = c >> 4, cb = c & 15u;
        unsigned k1 = 0u, k2 = 0u;
#pragma unroll
        for (int i = 0; i < 16; ++i) { k1 = (ca == (unsigned)i) ? (127u - (L[0][i] & 127u)) : k1; k2 = (cb == (unsigned)i) ? (127u - (L[1][i] & 127u)) : k2; }
        eo[it] = k1 * 128u + k2; go[it] = gsel;
    }
}

constexpr int MAXT = 9;
__device__ __forceinline__ void peer_phase(const Args& a, Frame& F, int l, bool lastlayer) {
    const int lane = F.lane, l7 = lane & 7, lg3 = lane >> 3;
    const int gw = F.vcu * NWAVES + F.wave, NGW = F.G * NWAVES;
    const bf16_t* TU = (const bf16_t*)(a.ws + WS_TAB + ((size_t)l * 2) * 32 * MiB);
    const bf16_t* TV = (const bf16_t*)(a.ws + WS_TAB + ((size_t)l * 2 + 1) * 32 * MiB);
    bf16_t* XB = (bf16_t*)(a.ws + WS_XB); float* X = a.out;
    const unsigned* EI = (const unsigned*)(a.ws + WS_EIDX); const float* GT = (const float*)(a.ws + WS_GATE);
    const float* g2 = a.in[6] + (size_t)l * DM;
    unsigned elo[MAXT], ehi[MAXT]; float hacc[MAXT][2], ssq[MAXT];
#pragma unroll
    for (int i = 0; i < MAXT; ++i) { const int t = gw + NGW * i; hacc[i][0] = 0.f; hacc[i][1] = 0.f; ssq[i] = 0.f; elo[i] = 0u; ehi[i] = 0u;
        if (t < MTOT) { elo[i] = EI[(size_t)t * 128 + lane]; ehi[i] = EI[(size_t)t * 128 + 64 + lane]; } }
    for (int s = 0; s < 16; ++s) {
        const f32x4 ga = *(const f32x4*)(g2 + 64 * s + 8 * l7), gb = *(const f32x4*)(g2 + 64 * s + 8 * l7 + 4);
#pragma unroll
        for (int i = 0; i < MAXT; ++i) { const int t = gw + NGW * i;
            if (t < MTOT) {
                const u32x4 xv = *(const u32x4*)(XB + (size_t)t * DM + 64 * s + 8 * l7);
                const float x0 = bflo(xv.x) * ga[0], x1 = bfhi(xv.x) * ga[1], x2 = bflo(xv.y) * ga[2], x3 = bfhi(xv.y) * ga[3];
                const float x4 = bflo(xv.z) * gb[0], x5 = bfhi(xv.z) * gb[1], x6 = bflo(xv.w) * gb[2], x7 = bfhi(xv.w) * gb[3];
                u32x4 rowv[16];
#pragma unroll
                for (int q = 0; q < 16; ++q) { const unsigned idx = (unsigned)__shfl((int)(q < 8 ? elo[i] : ehi[i]), (q & 7) * 8 + lg3);
                    rowv[q] = *(const u32x4*)(TU + ((size_t)s * NEXP + idx) * 64 + 8 * l7); }
                float p[16];
#pragma unroll
                for (int q = 0; q < 16; ++q) { const u32x4 r = rowv[q];
                    p[q] = ((bflo(r.x) * x0 + bfhi(r.x) * x1) + (bflo(r.y) * x2 + bfhi(r.y) * x3)) + ((bflo(r.z) * x4 + bfhi(r.z) * x5) + (bflo(r.w) * x6 + bfhi(r.w) * x7)); }
                float p8[8], p4[4], p2[2];
#pragma unroll
                for (int q = 0; q < 8; ++q) { const float keep = (lane & 4) ? p[q + 8] : p[q], send = (lane & 4) ? p[q] : p[q + 8]; p8[q] = keep + __shfl_xor(send, 4); }
#pragma unroll
                for (int q = 0; q < 4; ++q) { const float keep = (lane & 2) ? p8[q + 4] : p8[q], send = (lane & 2) ? p8[q] : p8[q + 4]; p4[q] = keep + __shfl_xor(send, 2); }
#pragma unroll
                for (int q = 0; q < 2; ++q) { const float keep = (lane & 1) ? p4[q + 2] : p4[q], send = (lane & 1) ? p4[q] : p4[q + 2]; p2[q] = keep + __shfl_xor(send, 1); }
                hacc[i][0] += p2[0]; hacc[i][1] += p2[1];
            } }
    }
#pragma unroll
    for (int i = 0; i < MAXT; ++i) { const int t = gw + NGW * i;
        if (t < MTOT) { const float rstd = rsqrtf(((const float*)(a.ws + WS_RSS2))[t] * (1.0f / DM) + EPS);
#pragma unroll
            for (int j = 0; j < 2; ++j) { const int k = 16 * l7 + 8 * j + lg3; hacc[i][j] = geluf_(hacc[i][j] * rstd) * GT[(size_t)t * 128 + k]; } } }
    for (int s = 0; s < 16; ++s) {
#pragma unroll
        for (int i = 0; i < MAXT; ++i) { const int t = gw + NGW * i;
            if (t < MTOT) {
                u32x4 rowv[16];
#pragma unroll
                for (int q = 0; q < 16; ++q) { const unsigned idx = (unsigned)__shfl((int)(q < 8 ? elo[i] : ehi[i]), (q & 7) * 8 + lg3);
                    rowv[q] = *(const u32x4*)(TV + ((size_t)s * NEXP + idx) * 64 + 8 * l7); }
                float o[8];
#pragma unroll
                for (int j = 0; j < 8; ++j) o[j] = 0.f;
#pragma unroll
                for (int q = 0; q < 16; ++q) { const float hq = __shfl(hacc[i][q & 1], (lane & ~7) | (q >> 1)); const u32x4 r = rowv[q];
                    o[0] += hq * bflo(r.x); o[1] += hq * bfhi(r.x); o[2] += hq * bflo(r.y); o[3] += hq * bfhi(r.y);
                    o[4] += hq * bflo(r.z); o[5] += hq * bfhi(r.z); o[6] += hq * bflo(r.w); o[7] += hq * bfhi(r.w); }
                float o4[4], o2[2];
#pragma unroll
                for (int q = 0; q < 4; ++q) { const float keep = (lane & 32) ? o[q + 4] : o[q], send = (lane & 32) ? o[q] : o[q + 4]; o4[q] = keep + __shfl_xor(send, 32); }
#pragma unroll
                for (int q = 0; q < 2; ++q) { const float keep = (lane & 16) ? o4[q + 2] : o4[q], send = (lane & 16) ? o4[q] : o4[q + 2]; o2[q] = keep + __shfl_xor(send, 16); }
                const float keep = (lane & 8) ? o2[1] : o2[0], send = (lane & 8) ? o2[0] : o2[1];
                const float ov = keep + __shfl_xor(send, 8);
                const int col = 64 * s + 8 * l7 + 4 * ((lane >> 5) & 1) + 2 * ((lane >> 4) & 1) + ((lane >> 3) & 1);
                const float xn = X[(size_t)t * DM + col] + ov;
                X[(size_t)t * DM + col] = xn; XB[(size_t)t * DM + col] = (bf16_t)f2bf(xn); ssq[i] += xn * xn;
            } }
    }
    float* RSS = (float*)(a.ws + WS_RSS);
#pragma unroll
    for (int i = 0; i < MAXT; ++i) { const int t = gw + NGW * i; if (t < MTOT) { ssq[i] = wave_sum(ssq[i]); if (lane == 0) RSS[t] = ssq[i]; } }
    if (lastlayer) {
        __threadfence();
        const float* gf = a.in[7];
#pragma unroll
        for (int i = 0; i < MAXT; ++i) { const int t = gw + NGW * i;
            if (t < MTOT) { const float rstd = rsqrtf(ssq[i] * (1.0f / DM) + EPS); f32x4* xr = (f32x4*)(X + (size_t)t * DM) + lane;
#pragma unroll
                for (int j = 0; j < 4; ++j) { const f32x4 g = *((const f32x4*)gf + lane + 64 * j); f32x4 v = xr[64 * j]; v = v * rstd * g; xr[64 * j] = v; } } }
    }
}

constexpr int N_PHASES = 1 + 7 * DEPTH;
__global__ void __launch_bounds__(NTHREADS, 2) hybrid_fwd(Args args) {
    extern __shared__ __attribute__((aligned(16))) unsigned char lds_raw[];
    Frame F;
    F.lds = (ldsp_t)lds_raw;
    F.MISC = (volatile LAS unsigned*)(F.lds + MISC_OFF);
    F.tid = threadIdx.x; F.lane = F.tid & 63; F.wave = __builtin_amdgcn_readfirstlane(F.tid >> 6);
    F.G = gridDim.x; { const int bx = blockIdx.x; F.vcu = (F.G % 8 == 0) ? (bx % 8) * (F.G / 8) + bx / 8 : bx; }
    F.ctl = (unsigned*)(args.ws + WS_CTL); F.ws = args.ws; F.out = args.out;
    for (int u = F.tid; u < (LDS_BYTES - MISC_OFF) / 4; u += NTHREADS) ((LAS unsigned*)(F.lds + MISC_OFF))[u] = 0u;
    __syncthreads();
    const int lo = args.ph_lo, hi = args.ph_hi;
    XcdBarrier bar; bar.bar = F.ctl + CW_BAR; bar.x = 0; bar.st = nullptr;
    if (hi - lo > 1) bar = xcd_barrier_post(F.ctl + CW_BAR, F.MISC + 8);
#ifndef PH_MASK
#define PH_MASK 0x7FF
#endif
#define IN(k) (lo <= (k) && (k) < hi)
#define PHM(b) ((PH_MASK >> (b)) & 1)
#define LAUNDER() do { asm volatile("" : "+v"(F.tid)); F.lane = F.tid & 63; F.wave = __builtin_amdgcn_readfirstlane(F.tid >> 6); } while (0)
#define SEAM(k) do { if (IN(k) && IN((k) + 1)) xcd_barrier(bar); } while (0)
    unsigned char* ws = args.ws;
    bf16_t* P = (bf16_t*)(ws + WS_P); bf16_t* XB = (bf16_t*)(ws + WS_XB);

    if (PHM(0) && IN(0)) { LAUNDER(); p0_prologue(args, F); } SEAM(0);

    for (int l = 0; l < DEPTH; ++l) {
        const int pb = 1 + 7 * l;
        if (PHM(1) && IN(pb)) { LAUNDER();
            pg8::Gemm g{XB, (const bf16_t*)(ws + WS_WIN) + (size_t)l * NIN * DM, DM, DM, 0, 0};
            pg8::StaticOrder S; S.init(MTOT, NIN, F.G, (int)blockIdx.x, 1);
            pg8::EpiIn E{P, (const float*)(ws + WS_RSS), (const float*)(ws + WS_ROT)};
            pg8::gemm_phase<pg8::EpiIn, pg8::StaticOrder, true>(F.lds, g, S, E, F.tid);
        }
        SEAM(pb);
        if (PHM(2) && IN(pb + 1)) { LAUNDER();
            for (int u = (int)blockIdx.x; u < 192; u += F.G) {
                LAUNDER();
                if (u < 64) { if (PHM(8)) ret_prompt_unit(args, F, l, u >> 3, u & 7); }
                else { if (PHM(9)) rnn_unit(args, F, l, false, (u - 64) >> 4, (u - 64) & 15); }
            }
            unsigned* qh = F.ctl + CW_QUEUE + 64 * l;
            for (;;) {
                __syncthreads();
                if (F.tid == 0) F.MISC[0] = xb_add(qh, 1u);
                __syncthreads();
                const unsigned q = F.MISC[0];
                LAUNDER();
                if (q >= 1024u + 128u) break;
                if (q < 1024u) { if (PHM(10)) ret_sample_unit(args, F, l, (int)(q >> 3), (int)(q & 7)); }
                else { if (PHM(9)) rnn_unit(args, F, l, true, (int)((q - 1024u) >> 4), (int)((q - 1024u) & 15)); }
            }
        }
        SEAM(pb + 1);
        if (PHM(3) && IN(pb + 2)) { LAUNDER();
            pg8::Gemm g{P + PC_ARET, (const bf16_t*)(ws + WS_WMIX + (size_t)l * 6 * MiB), LDP, DM, (size_t)(PC_ARNN - PC_ARET) * 2, (size_t)(2 * MiB)};
            pg8::StaticOrder S; S.init(MTOT, DM, F.G, (int)blockIdx.x, 2);
            pg8::EpiMerge E{P};
            pg8::gemm_phase<pg8::EpiMerge, pg8::StaticOrder, true>(F.lds, g, S, E, F.tid);
        }
        SEAM(pb + 2);
        if (PHM(4) && IN(pb + 3)) { LAUNDER();
            pg8::Gemm g{P + PC_MRG, (const bf16_t*)(ws + WS_WMIX + (size_t)l * 6 * MiB + 4 * MiB), LDP, DM, 0, 0};
            pg8::StaticOrder S; S.init(MTOT, DM, F.G, (int)blockIdx.x, 1);
            pg8::EpiWo E{l == 0 ? args.in[0] : args.out, l == 0 ? args.in[1] : args.out + (size_t)M_P * DM, args.out, XB, (float*)(ws + WS_RSSP)};
            pg8::gemm_phase<pg8::EpiWo, pg8::StaticOrder, true>(F.lds, g, S, E, F.tid);
        }
        SEAM(pb + 3);
        if (PHM(5) && IN(pb + 4)) { LAUNDER();
            pg8::Gemm g{XB, (const bf16_t*)(ws + WS_WQ) + (size_t)l * 2048 * DM, DM, DM, 0, 0};
            pg8::StaticOrder S; S.init(MTOT, 2048, F.G, (int)blockIdx.x, 1);
            pg8::EpiQ E{P, (const float*)(ws + WS_RSSP), (float*)(ws + WS_RSS2)};
            pg8::gemm_phase<pg8::EpiQ, pg8::StaticOrder, true>(F.lds, g, S, E, F.tid);
        }
        SEAM(pb + 4);
        if (PHM(6) && IN(pb + 5)) { LAUNDER();
            const int gw = F.vcu * NWAVES + F.wave, NGW = F.G * NWAVES;
            for (int u = gw; u < (MTOT / 32) * PH; u += NGW) { int ln = F.lane; asm volatile("" : "+v"(ln)); route_unit(args, l, u >> 3, u & 7, ln); }
        }
        SEAM(pb + 5);
        if (PHM(7) && IN(pb + 6)) { LAUNDER(); peer_phase(args, F, l, l == DEPTH - 1); }
        if (l + 1 < DEPTH) SEAM(pb + 6);
    }
#undef IN
#undef SEAM
}

extern "C" void kernel_launch(void* const* d_in, const int* in_sizes, int n_in, void* d_out, int out_size, void* d_ws, size_t ws_size, hipStream_t stream) {
    static int grid = 0;
    if (grid == 0) {
        if (n_in != 24 || out_size != (int)O_END || ws_size < WS_END) { fprintf(stderr, "kernel_launch: unexpected shapes (n_in %d, out %d, ws %zu)\n", n_in, out_size, ws_size); grid = -1; return; }
        int dev = 0, cus = 0, per_cu = 0;
        if (hipGetDevice(&dev) != hipSuccess || hipDeviceGetAttribute(&cus, hipDeviceAttributeMultiprocessorCount, dev) != hipSuccess) { grid = -1; return; }
        if (hipFuncSetAttribute((const void*)hybrid_fwd, hipFuncAttributeMaxDynamicSharedMemorySize, LDS_BYTES) != hipSuccess) { fprintf(stderr, "kernel_launch: hipFuncSetAttribute failed\n"); grid = -1; return; }
        if (hipOccupancyMaxActiveBlocksPerMultiprocessor(&per_cu, (const void*)hybrid_fwd, NTHREADS, LDS_BYTES) != hipSuccess || per_cu < 1) { fprintf(stderr, "kernel_launch: occupancy query reports %d blocks per CU\n", per_cu); (void)hipGetLastError(); grid = -1; return; }
        grid = cus;
        if (grid != 256) fprintf(stderr, "kernel_launch: %d CUs; the PEER phase assumes 256 workgroups\n", grid);
    }
    if (grid < 0) return;
    (void)hipMemsetAsync((char*)d_ws + WS_CTL, 0, CTL_ZERO_BYTES, stream);
    Args a{};
    for (int i = 0; i < 24; ++i) a.in[i] = (const float*)d_in[i];
    a.out = (float*)d_out; a.ws = (unsigned char*)d_ws;
#if MK_N_LAUNCHES == 1
    a.ph_lo = 0; a.ph_hi = N_PHASES;
    void* kargs[] = {&a};
    hipError_t e = hipLaunchCooperativeKernel((const void*)hybrid_fwd, dim3(grid), dim3(NTHREADS), kargs, LDS_BYTES, stream);
    if (e != hipSuccess) fprintf(stderr, "kernel_launch: cooperative launch failed: %s (grid %d)\n", hipGetErrorString(e), grid);
#else
    for (int p = 0; p < N_PHASES; ++p) { a.ph_lo = p; a.ph_hi = p + 1; hipLaunchKernelGGL(hybrid_fwd, dim3(grid), dim3(NTHREADS), LDS_BYTES, stream, a); }
#endif
}
```

```cpp
#include <hip/hip_runtime.h>
#include <cstdio>
#include <cstdint>

#define LAS __attribute__((address_space(3)))
#define GAS __attribute__((address_space(1)))
typedef unsigned short bf16_t;
typedef short bf16x8 __attribute__((ext_vector_type(8)));
typedef float f32x2 __attribute__((ext_vector_type(2)));
typedef float f32x4 __attribute__((ext_vector_type(4)));
typedef float f32x16 __attribute__((ext_vector_type(16)));
typedef unsigned u32x2 __attribute__((ext_vector_type(2)));
typedef unsigned u32x4 __attribute__((ext_vector_type(4)));
typedef LAS unsigned char* ldsp_t;

#ifndef REP_MASK
#define REP_MASK 0
#endif
#define REPS(k) (((REP_MASK >> (k)) & 1) ? 2 : 1)
#ifndef MK_N_LAUNCHES
#define MK_N_LAUNCHES 1
#endif

constexpr int DM = 1024, NIN = 7168, M_P = 16384, M_S = 1024, MTOT = 17408, DEPTH = 2;
constexpr int SEQ = 2048, NBATCH = 8, DECB = 128, DECT = 8, PAST = 16384;
constexpr int HR = 8, DK = 64, DV = 128, CH = 128;
constexpr int NBLK = 16, BS = 64;
constexpr int PH = 8, NKEY = 128, NEXP = 16384, TOPK = 16, HK = 128;
constexpr float EPS = 1e-6f;
constexpr int LDP = 7168;
constexpr int PC_Q = 0, PC_K = 512, PC_V = 1024, PC_GR = 2048, PC_XR = 3072, PC_GN = 4096, PC_GA = 5120, PC_GB = 6144;
constexpr int PC_MRG = 0, PC_ARET = 1024, PC_ARNN = 4096, PC_QP = 2048;

constexpr size_t MiB = 1u << 20;
constexpr size_t WS_CTL = 0, CTL_ZERO_BYTES = 1 * MiB;
constexpr size_t WS_ROT = 1 * MiB;
constexpr size_t WS_RSS = 2 * MiB;
constexpr size_t WS_RSS2 = 2 * MiB + 128 * 1024;
constexpr size_t WS_RSSP = 2 * MiB + 256 * 1024;
constexpr size_t WS_TSC = 3 * MiB + 512 * 1024;
constexpr size_t WS_EIDX = 4 * MiB;
constexpr size_t WS_GATE = 13 * MiB;
constexpr size_t WS_KEYS = 22 * MiB;
constexpr size_t WS_WG = 23 * MiB;
constexpr size_t WS_WIN = 24 * MiB;
constexpr size_t WS_WMIX = 52 * MiB;
constexpr size_t WS_WQ = 64 * MiB;
constexpr size_t WS_XB = 72 * MiB;
constexpr size_t WS_P = 106 * MiB;
constexpr size_t WS_TAB = 344 * MiB;
constexpr size_t WS_END = 472 * MiB;
static_assert(WS_P + (size_t)MTOT * LDP * 2 <= WS_TAB, "ws map");

constexpr size_t O_Y = 0, O_SRP = 17825792, O_SHP = 18874368, O_SCP = 18890752, O_SRS = 18939904, O_SHS = 35717120, O_SCS = 35979264, O_END = 36765696;

constexpr int CW_BAR = 4096;
constexpr int CW_QUEUE = 16384;

constexpr int RING_BYTES = 131072;
constexpr int LDS_BYTES = 155648;
constexpr int MISC_OFF = 153600;
constexpr int NWAVES = 8, NTHREADS = 512;

#define LDS_WAIT() asm volatile("s_waitcnt lgkmcnt(0)" ::: "memory")
#define VM_WAIT() asm volatile("s_waitcnt vmcnt(0)" ::: "memory")
#define RLX_AGENT __ATOMIC_RELAXED, __HIP_MEMORY_SCOPE_AGENT

__device__ __forceinline__ unsigned f2bf(float f) { unsigned u = __builtin_bit_cast(unsigned, f); return (u + 0x7fffu + ((u >> 16) & 1u)) >> 16; }
__device__ __forceinline__ unsigned pk2(float lo, float hi) { return f2bf(lo) | (f2bf(hi) << 16); }
__device__ __forceinline__ float bflo(unsigned w) { return __builtin_bit_cast(float, w << 16); }
__device__ __forceinline__ float bfhi(unsigned w) { return __builtin_bit_cast(float, w & 0xffff0000u); }
__device__ __forceinline__ float bf1(bf16_t h) { return __builtin_bit_cast(float, (unsigned)h << 16); }
__device__ __forceinline__ float sigmoidf_(float x) { return __builtin_amdgcn_rcpf(1.0f + __expf(-x)); }
__device__ __forceinline__ float siluf_(float x) { return x * sigmoidf_(x); }
__device__ __forceinline__ float geluf_(float x) { return x * sigmoidf_(1.5957691216057308f * (x + 0.044715f * x * x * x)); }
__device__ __forceinline__ float logg_of(int h) { return log1pf(-exp2f((float)(-5 - h))); }

namespace pg8 {
constexpr int BM = 256, BK = 64, HALF = 128, HTB = HALF * BK * 2, STAGE_BYTES = 8 * HTB, NXCD = 8, WGM = 8;
__host__ __device__ __forceinline__ int lds_byte(int r, int c) { const int st = (r >> 4) * 2 + (c >> 5), rr = r & 15, cc = c & 31, ob = rr * 64 + cc * 2; return st * 1024 + (ob ^ (((ob >> 9) & 1) << 5)); }
__host__ __device__ __forceinline__ void stage_rc(int b, int& R, int& C) { const int st = b / 1024, sb = b % 1024, swz = sb ^ (((sb >> 9) & 1) << 5); R = (st >> 1) * 16 + swz / 64; C = (st & 1) * 32 + (swz % 64) / 2; }
__host__ __device__ __forceinline__ int perm32(int rho) { const int n = rho >> 4, i = rho & 15; return 8 * (i >> 2) + 4 * n + (i & 3); }

struct Unit { int pm, pn, half; };
struct Gemm { const bf16_t* A; const bf16_t* Bt; int lda, K; size_t aoff2, boff2; };

struct StaticOrder {
    int nM, nN, nwg, G, c, pairs;
    __device__ void init(int M, int N, int G_, int c_, int pairs_) { nM = M / BM; nN = N / BM; nwg = nM * nN; G = G_; c = c_; pairs = pairs_; }
    __device__ bool next(int i, Unit& u) const {
        const int it = (pairs == 2) ? (i >> 1) : i;
        const long L = (long)it * G + c; if (L >= nwg) return false;
        int wgid = (int)L; { const int q = nwg / NXCD, r = nwg % NXCD, xcd = wgid % NXCD, off = wgid / NXCD; wgid = (xcd < r ? xcd * (q + 1) : r * (q + 1) + (xcd - r) * q) + off; }
        const int nig = WGM * nN, gid = wgid / nig, fm = gid * WGM, gsz = (nM - fm) < WGM ? (nM - fm) : WGM;
        u.pm = fm + ((wgid % nig) % gsz); u.pn = (wgid % nig) / gsz; u.half = (pairs == 2) ? (i & 1) : 0; return true;
    }
};

template <class Epi, class Sched, bool ALIGN_EPI>
__device__ __forceinline__ void gemm_phase(ldsp_t lds, const Gemm g, const Sched& S, const Epi& E, const int tid) {
    const int wid = __builtin_amdgcn_readfirstlane(tid >> 6), lane = tid & 63, wr = wid >> 2, wc = wid & 3, fr = lane & 15, fq = lane >> 4;
    const int K = g.K, nt = K / BK;
    unsigned voffA[2], voffB[2];
#pragma unroll
    for (int i = 0; i < 2; ++i) { int R, C; stage_rc(tid * 16 + i * 8192, R, C); const int Rb = Epi::PERM ? ((R & ~31) + perm32(R & 31)) : R;
        voffA[i] = (unsigned)(R * g.lda + C) * 2u; voffB[i] = (unsigned)(Rb * K + C) * 2u; }
    const size_t kstep = (size_t)(BK * 2);
    const size_t hstepA = (size_t)HALF * g.lda * 2, hstepB = (size_t)HALF * K * 2;
    const size_t tstepA = 2 * hstepA, tstepB = 2 * hstepB;
    const unsigned ldsw = (unsigned)wid * 1024u;
    const int aoff = lds_byte(wr * 64 + fr, fq * 8), boff = lds_byte(wc * 32 + fr, fq * 8);
#define PG8_SA(b, h) (((b) * 2 + (h)) * HTB)
#define PG8_SB(b, h) ((4 + (b) * 2 + (h)) * HTB)
#define PG8_STAGE(bufoff, gbase, voff) do { _Pragma("unroll") for (int _i = 0; _i < 2; ++_i) \
        __builtin_amdgcn_global_load_lds((const unsigned*)((const char*)(gbase) + (voff)[_i]), (LAS unsigned*)(lds + (bufoff) + ldsw + _i * 8192), 16, 0, 0); } while (0)
#define PG8_LDA(dst, b, h) do { _Pragma("unroll") for (int m = 0; m < 4; ++m) _Pragma("unroll") for (int k = 0; k < 2; ++k) dst[m][k] = *(const LAS bf16x8*)(lds + PG8_SA(b, h) + aoff + m * 2048 + k * 1024); } while (0)
#define PG8_LDB(dst, b, h) do { _Pragma("unroll") for (int n = 0; n < 2; ++n) _Pragma("unroll") for (int k = 0; k < 2; ++k) dst[n][k] = *(const LAS bf16x8*)(lds + PG8_SB(b, h) + boff + n * 2048 + k * 1024); } while (0)
#define PG8_MMA(ai, bj, At, Bt) do { __builtin_amdgcn_s_setprio(1); _Pragma("unroll") for (int m = 0; m < 4; ++m) _Pragma("unroll") for (int n = 0; n < 2; ++n) _Pragma("unroll") for (int k = 0; k < 2; ++k) \
        acc[ai][bj][m][n] = __builtin_amdgcn_mfma_f32_16x16x32_bf16(Bt[n][k], At[m][k], acc[ai][bj][m][n], 0, 0, 0); __builtin_amdgcn_s_setprio(0); } while (0)
#define PG8_WAIT_V(n) asm volatile("s_waitcnt vmcnt(" #n ")" ::: "memory")
#define PG8_WAIT_L(n) asm volatile("s_waitcnt lgkmcnt(" #n ")" ::: "memory")
#define PG8_BAR __builtin_amdgcn_s_barrier()
#define PG8_SCHED __builtin_amdgcn_sched_barrier(0)
    Unit cur, nxt; int ui = 0;
    if (!S.next(0, cur)) return;
    f32x4 acc[2][2][4][2];
#pragma unroll
    for (int a = 0; a < 2; ++a)
#pragma unroll
        for (int b = 0; b < 2; ++b)
#pragma unroll
            for (int m = 0; m < 4; ++m)
#pragma unroll
                for (int n = 0; n < 2; ++n) acc[a][b][m][n] = (f32x4){0.f, 0.f, 0.f, 0.f};
    bf16x8 At[4][2], B0[2][2], B1[2][2];
    const char* cA = (const char*)g.A + (size_t)cur.pm * tstepA + (cur.half ? g.aoff2 : 0); const char* cB = (const char*)g.Bt + (size_t)cur.pn * tstepB + (cur.half ? g.boff2 : 0);
    PG8_STAGE(PG8_SB(0, 0), cB, voffB); PG8_STAGE(PG8_SB(0, 1), cB + hstepB, voffB); PG8_STAGE(PG8_SA(0, 0), cA, voffA); PG8_STAGE(PG8_SA(0, 1), cA + hstepA, voffA);
    if (wr == 1) PG8_BAR;
    PG8_WAIT_V(2); PG8_BAR;
    PG8_STAGE(PG8_SB(1, 0), cB + kstep, voffB); PG8_STAGE(PG8_SA(1, 0), cA + kstep, voffA); PG8_STAGE(PG8_SB(1, 1), cB + hstepB + kstep, voffB);
    PG8_WAIT_V(6); PG8_BAR;
    for (;;) {
        const bool has_next = S.next(ui + 1, nxt);
        const char* nA = has_next ? (const char*)g.A + (size_t)nxt.pm * tstepA + (nxt.half ? g.aoff2 : 0) : cA;
        const char* nB = has_next ? (const char*)g.Bt + (size_t)nxt.pn * tstepB + (nxt.half ? g.boff2 : 0) : cB;
        for (int t = 0; t < nt; t += 2) {
            const bool last = (t == nt - 2);
            const char* a1 = cA + (size_t)(t + 1) * kstep;
            const char* a2 = last ? nA : cA + (size_t)(t + 2) * kstep; const char* b2 = last ? nB : cB + (size_t)(t + 2) * kstep;
            const char* a3 = a2 + kstep; const char* b3 = b2 + kstep;
            PG8_LDB(B0, 0, 0); PG8_LDB(B1, 0, 1); PG8_SCHED; PG8_LDA(At, 0, 0); PG8_STAGE(PG8_SA(1, 1), a1 + hstepA, voffA);
            PG8_WAIT_V(8); PG8_WAIT_L(0); PG8_BAR; PG8_MMA(0, 0, At, B0); PG8_MMA(0, 1, At, B1); PG8_BAR; PG8_SCHED;
            PG8_LDA(At, 0, 1); PG8_STAGE(PG8_SB(0, 0), b2, voffB); PG8_STAGE(PG8_SB(0, 1), b2 + hstepB, voffB); PG8_STAGE(PG8_SA(0, 0), a2, voffA);
            PG8_WAIT_V(8); PG8_WAIT_L(0); PG8_BAR; PG8_MMA(1, 0, At, B0); PG8_MMA(1, 1, At, B1); PG8_BAR; PG8_SCHED;
            PG8_LDB(B0, 1, 0); PG8_LDB(B1, 1, 1); PG8_SCHED; PG8_LDA(At, 1, 0); PG8_STAGE(PG8_SA(0, 1), a2 + hstepA, voffA);
            PG8_WAIT_V(8); PG8_WAIT_L(0); PG8_BAR; PG8_MMA(0, 0, At, B0); PG8_MMA(0, 1, At, B1); PG8_BAR; PG8_SCHED;
            PG8_LDA(At, 1, 1); PG8_STAGE(PG8_SB(1, 0), b3, voffB); PG8_STAGE(PG8_SB(1, 1), b3 + hstepB, voffB); PG8_STAGE(PG8_SA(1, 0), a3, voffA);
            PG8_WAIT_V(8); PG8_WAIT_L(0); PG8_BAR; PG8_MMA(1, 0, At, B0); PG8_MMA(1, 1, At, B1); PG8_BAR; PG8_SCHED;
        }
        if constexpr (ALIGN_EPI) { if (wr == 0) PG8_BAR; }
        E(acc, cur, wr, wc, fr, fq);
        if (!has_next) break;
#pragma unroll
        for (int a = 0; a < 2; ++a)
#pragma unroll
            for (int b = 0; b < 2; ++b)
#pragma unroll
                for (int m = 0; m < 4; ++m)
#pragma unroll
                    for (int n = 0; n < 2; ++n) acc[a][b][m][n] = (f32x4){0.f, 0.f, 0.f, 0.f};
        cur = nxt; cA = nA; cB = nB; ++ui;
        if constexpr (ALIGN_EPI) { if (wr == 1) PG8_BAR; }
    }
    PG8_WAIT_V(0);
    if constexpr (!ALIGN_EPI) { if (wr == 0) PG8_BAR; }
    PG8_BAR;
#undef PG8_SA
#undef PG8_SB
#undef PG8_STAGE
#undef PG8_LDA
#undef PG8_LDB
#undef PG8_MMA
#undef PG8_WAIT_V
#undef PG8_WAIT_L
#undef PG8_BAR
#undef PG8_SCHED
}
}

typedef GAS unsigned gu32;
#define XB_TMO      128
#define XB_XCNT(j)  (256  + 64 * (j))
#define XB_XSUB(j)  (1280 + 64 * (j))
#define XB_XGEN(j)  (2304 + 64 * (j))
#define XB_TOP      3328
#define XB_TOPGEN   3392
#define XCD_BAR_WORDS 3456
#define XB_SPIN_CAP (1u << 18)
__device__ __forceinline__ unsigned xb_ld(unsigned* p)              { return __hip_atomic_load(p, __ATOMIC_RELAXED, __HIP_MEMORY_SCOPE_AGENT); }
__device__ __forceinline__ unsigned xb_add(unsigned* p, unsigned v) { return __hip_atomic_fetch_add(p, v, __ATOMIC_RELAXED, __HIP_MEMORY_SCOPE_AGENT); }
__device__ __forceinline__ unsigned xb_xcc_id() { return (unsigned)__builtin_amdgcn_s_getreg((3 << 11) | 20) & 0xFu; }
#define XB_SPIN(cond, bar) do { unsigned _sp = 0; while (cond) { __builtin_amdgcn_s_sleep(1); \
    if ((++_sp & 255u) == 0u) { if (xb_ld(&(bar)[XB_TMO])) break; if (_sp > XB_SPIN_CAP) { atomicAdd(&(bar)[XB_TMO], 1u); break; } } } } while (0)
struct XcdBarrier { unsigned* bar; unsigned x; volatile LAS unsigned* st; };
__device__ __forceinline__ XcdBarrier xcd_barrier_post(unsigned* bar, volatile LAS unsigned* st) {
    XcdBarrier b; b.bar = bar; b.x = xb_xcc_id(); b.st = st;
    if (threadIdx.x == 0) (void)xb_add(&bar[XB_XCNT(b.x)], 1u);
    return b;
}
__device__ __forceinline__ void xcd_barrier_complete(unsigned* bar, unsigned x, unsigned& nloc, unsigned& nx) {
    const unsigned G = gridDim.x * gridDim.y * gridDim.z;
    unsigned sum, cnt, mine, sp = 0u;
    for (;;) {
        sum = 0u; cnt = 0u; mine = 0u;
#pragma unroll
        for (unsigned j = 0; j < 16; ++j) { const unsigned c = xb_ld(&bar[XB_XCNT(j)]); sum += c; cnt += (c > 0u) ? 1u : 0u; mine = (j == x) ? c : mine; }
        if (sum == G) break;
        __builtin_amdgcn_s_sleep(1);
        if ((++sp & 255u) == 0u) { if (xb_ld(&bar[XB_TMO])) break; if (sp > XB_SPIN_CAP) { atomicAdd(&bar[XB_TMO], 1u); break; } }
    }
    nloc = mine > 0u ? mine : 1u; nx = cnt > 0u ? cnt : 1u;
}
__device__ __forceinline__ void xcd_barrier(const XcdBarrier& b) {
    asm volatile("s_waitcnt vmcnt(0)" ::: "memory");
    __syncthreads();
    if (threadIdx.x == 0) {
        unsigned* bar = b.bar;
        __builtin_amdgcn_s_waitcnt(0);
        unsigned nloc = b.st[0], nx = b.st[1];
        if (nloc == 0u) { xcd_barrier_complete(bar, b.x, nloc, nx); b.st[0] = nloc; b.st[1] = nx; }
        const unsigned old = xb_add(&bar[XB_XSUB(b.x)], 1u);
        const unsigned gen = old / nloc;
        if (old + 1u == (gen + 1u) * nloc) {
            __builtin_amdgcn_fence(__ATOMIC_RELEASE, "agent");
            asm volatile("s_waitcnt vmcnt(0)" ::: "memory");
            const unsigned og = xb_add(&bar[XB_TOP], 1u);
            const unsigned tg = og / nx;
            if (og + 1u == (tg + 1u) * nx) xb_add(&bar[XB_TOPGEN], 1u);
            else XB_SPIN(xb_ld(&bar[XB_TOPGEN]) == tg, bar);
            __builtin_amdgcn_fence(__ATOMIC_ACQUIRE, "agent");
            xb_add(&bar[XB_XGEN(b.x)], 1u);
            asm volatile("s_waitcnt vmcnt(0)" ::: "memory");
        } else {
            XB_SPIN(xb_ld(&bar[XB_XGEN(b.x)]) == gen, bar);
            __builtin_amdgcn_fence(__ATOMIC_ACQUIRE, "agent");
            asm volatile("s_waitcnt vmcnt(0)" ::: "memory");
        }
    }
    __syncthreads();
}

struct Frame {
    ldsp_t lds;
    volatile LAS unsigned* MISC;
    unsigned* ctl;
    int tid, lane, wave, vcu, G;
    const float* const* in;
    unsigned char* ws;
    float* out;
};
struct Args { const float* in[24]; float* out; unsigned char* ws; int ph_lo, ph_hi; };

__device__ __forceinline__ float wave_sum(float v) {
#pragma unroll
    for (int o = 1; o < 64; o <<= 1) v += __shfl_xor(v, o);
    return v;
}

__device__ __forceinline__ void p0_transpose_item(const float* W, int K, int N, bf16_t* WT, int ldk, const float* rowscale, float colscale, bool qkperm, LAS float* scr, int item, int lane) {
    const int nblk = N / 32, kb = item / nblk, nb = item % nblk, k0 = 64 * kb, n0 = 32 * nb;
    int srcn = n0 + (lane & 31);
    if (qkperm) { const int p = srcn & 63; srcn = (srcn & ~63) + ((p & 1) ? 32 + (p >> 1) : (p >> 1)); }
#pragma unroll 8
    for (int i = 0; i < 32; ++i) { const int kk = 2 * i + (lane >> 5); float v = W[(size_t)(k0 + kk) * N + srcn] * colscale; if (rowscale) v *= rowscale[k0 + kk]; scr[kk * 33 + (lane & 31)] = v; }
    LDS_WAIT(); asm volatile("" ::: "memory");
    const int c = lane & 7;
#pragma unroll
    for (int j = 0; j < 4; ++j) { const int n = (lane >> 3) + 8 * j; const LAS float* s = scr + (8 * c) * 33 + n;
        u32x4 o; o.x = pk2(s[0 * 33], s[1 * 33]); o.y = pk2(s[2 * 33], s[3 * 33]); o.z = pk2(s[4 * 33], s[5 * 33]); o.w = pk2(s[6 * 33], s[7 * 33]);
        *(u32x4*)(WT + (size_t)(n0 + n) * ldk + k0 + 8 * c) = o; }
    LDS_WAIT(); asm volatile("" ::: "memory");
}

__device__ __forceinline__ void p0_xrow(const float* xrow, bf16_t* orow, float* rss, int lane) {
    const f32x4* xr = (const f32x4*)xrow + lane;
    f32x4 v[4]; float s = 0.f;
#pragma unroll
    for (int j = 0; j < 4; ++j) { v[j] = xr[64 * j]; s += (v[j].x * v[j].x + v[j].y * v[j].y) + (v[j].z * v[j].z + v[j].w * v[j].w); }
    s = wave_sum(s);
    u32x2* o8 = (u32x2*)orow + lane;
#pragma unroll
    for (int j = 0; j < 4; ++j) { u32x2 w; w.x = pk2(v[j].x, v[j].y); w.y = pk2(v[j].z, v[j].w); o8[64 * j] = w; }
    if (lane == 0) *rss = s;
}

__device__ __forceinline__ void p0_tabrow(const float* row, unsigned char* img, float* isc, int e, int lane) {
    const f32x4* xr = (const f32x4*)row + lane;
    f32x4 v[4]; float am = 0.f;
#pragma unroll
    for (int j = 0; j < 4; ++j) { v[j] = xr[64 * j]; am = fmaxf(am, fmaxf(fmaxf(fabsf(v[j].x), fabsf(v[j].y)), fmaxf(fabsf(v[j].z), fabsf(v[j].w)))); }
#pragma unroll
    for (int o = 1; o < 64; o <<= 1) am = fmaxf(am, __shfl_xor(am, o));
    const float sc = am > 0.f ? exp2f(floorf(log2f(224.0f / am))) : 1.0f;
#pragma unroll
    for (int j = 0; j < 4; ++j) { const int col = 256 * j + 4 * lane, sl = col >> 7, w = col & 127;
        int pk = __builtin_amdgcn_cvt_pk_fp8_f32(v[j].x * sc, v[j].y * sc, 0, false);
        pk = __builtin_amdgcn_cvt_pk_fp8_f32(v[j].z * sc, v[j].w * sc, pk, true);
        *(int*)(img + ((size_t)sl * NEXP + e) * 128 + w) = pk; }
    if (lane == 0) isc[e] = 1.0f / sc;
}

__device__ __forceinline__ void p0_prologue(const Args& a, Frame& F) {
    unsigned char* ws = a.ws;
    LAS float* scr = (LAS float*)(F.lds + F.wave * 16384);
    const int gw = F.vcu * NWAVES + F.wave, NGW = F.G * NWAVES, lane = F.lane;
    constexpr int I_IN = (DM / 64) * (NIN / 32), I_SQ = (DM / 64) * (DM / 32), I_Q = (DM / 64) * (2048 / 32), I_G = 2;
    constexpr int PER_L = I_IN + 3 * I_SQ + I_Q + 32 * I_G;
    for (int it = gw; it < DEPTH * PER_L; it += NGW) {
        const int l = it / PER_L; int r = it % PER_L;
        if (r < I_IN) { const int nb = r % (NIN / 32), n0 = nb * 32; const int seg = n0 >> 9;
            p0_transpose_item(a.in[8] + (size_t)l * DM * NIN, DM, NIN, (bf16_t*)(ws + WS_WIN) + (size_t)l * NIN * DM, DM, a.in[5] + l * DM, seg == 1 ? 0.125f : 1.0f, seg <= 1, scr, r, lane); continue; }
        r -= I_IN;
        if (r < I_SQ) { p0_transpose_item(a.in[10] + (size_t)l * DM * DM, DM, DM, (bf16_t*)(ws + WS_WMIX + (size_t)l * 6 * MiB), DM, a.in[9] + l * DM, 1.0f, false, scr, r, lane); continue; }
        r -= I_SQ;
        if (r < I_SQ) { p0_transpose_item(a.in[18] + (size_t)l * DM * DM, DM, DM, (bf16_t*)(ws + WS_WMIX + (size_t)l * 6 * MiB + 2 * MiB), DM, nullptr, 1.0f, false, scr, r, lane); continue; }
        r -= I_SQ;
        if (r < I_SQ) { p0_transpose_item(a.in[19] + (size_t)l * DM * DM, DM, DM, (bf16_t*)(ws + WS_WMIX + (size_t)l * 6 * MiB + 4 * MiB), DM, nullptr, 1.0f, false, scr, r, lane); continue; }
        r -= I_SQ;
        if (r < I_Q) { p0_transpose_item(a.in[20] + (size_t)l * DM * 2048, DM, 2048, (bf16_t*)(ws + WS_WQ) + (size_t)l * 2048 * DM, DM, a.in[6] + l * DM, 1.0f, false, scr, r, lane); continue; }
        r -= I_Q;
        { const int mat = r >> 1, sub = r & 1, nb = mat >> 1, gsel = mat & 1;
          const float* W = (gsel ? a.in[15] : a.in[13]) + ((size_t)l * NBLK + nb) * BS * BS;
          bf16_t* WT = (bf16_t*)(ws + WS_WG) + (((size_t)l * NBLK + nb) * 2 + gsel) * BS * BS;
          p0_transpose_item(W, BS, BS, WT, BS, nullptr, 1.0f, false, scr, sub, lane); }
    }
    { const float* ksrc = a.in[21]; bf16_t* kdst = (bf16_t*)(ws + WS_KEYS); const int n4 = DEPTH * PH * 2 * NKEY * HK / 4;
      for (int i = gw * 64 + lane; i < n4; i += NGW * 64) { const f32x4 v = ((const f32x4*)ksrc)[i]; u32x2 o; o.x = pk2(v.x, v.y); o.y = pk2(v.z, v.w); ((u32x2*)kdst)[i] = o; } }
    for (int m = gw; m < MTOT; m += NGW) {
        const float* xr = m < M_P ? a.in[0] + (size_t)m * DM : a.in[1] + (size_t)(m - M_P) * DM;
        p0_xrow(xr, (bf16_t*)(ws + WS_XB) + (size_t)m * DM, (float*)(ws + WS_RSS) + m, lane);
    }
    { float* rot = (float*)(ws + WS_ROT);
      for (int i = gw * 64 + lane; i < 2056 * 32; i += NGW * 64) {
          const int pi = i >> 5, fi = i & 31; const double pos = pi < 2048 ? (double)pi : (double)(PAST + pi - 2048);
          const double f8[8] = {1.0, 0.7498942093324559, 0.5623413251903491, 0.4216965034285822, 0.31622776601683794, 0.23713737056616552, 0.1778279410038923, 0.1333521432163324};
          double fr = 1.0; switch (fi >> 3) { case 1: fr = 0.1; break; case 2: fr = 0.01; break; case 3: fr = 0.001; break; default: break; }
          double fsel = f8[0];
#pragma unroll
          for (int q = 1; q < 8; ++q) fsel = ((fi & 7) == q) ? f8[q] : fsel;
          const double ang = pos * (fr * fsel);
          const double n = __builtin_rint(ang * 0.15915494309189535);
          double rr = __builtin_fma(-n, 6.283185307179586, ang); rr = __builtin_fma(-n, 2.4492935982947064e-16, rr);
          const float rf = (float)rr;
          rot[(size_t)pi * 64 + fi] = cosf(rf); rot[(size_t)pi * 64 + 32 + fi] = sinf(rf);
      } }
    for (int r = gw; r < DEPTH * 2 * NEXP; r += NGW) {
        const int l = r / (2 * NEXP), t = (r / NEXP) & 1, e = r % NEXP;
        const float* src = (t ? a.in[23] : a.in[22]) + ((size_t)l * NEXP + e) * DM;
        unsigned char* img = ws + WS_TAB + ((size_t)l * 2 + t) * 16 * MiB;
        p0_tabrow(src, img, (float*)(ws + WS_TSC) + ((size_t)l * 2 + t) * NEXP, e, lane);
    }
}

namespace pg8 {
struct EpiIn {
    static constexpr bool PERM = true;
    bf16_t* P; const float* rss; const float* rot;
    __device__ __forceinline__ void operator()(const f32x4 (&acc)[2][2][4][2], const Unit& u, int wr, int wc, int fr, int fq) const {
        const int seg = u.pn < 4 ? (u.pn >> 1) : (u.pn >> 2) + 1;
        const int row0 = u.pm * BM + wr * 64 + fr;
        if (seg <= 1) {
            float lg[2];
#pragma unroll
            for (int bj = 0; bj < 2; ++bj) { const int hh = 4 * (u.pn & 1) + 2 * bj + (wc >> 1); lg[bj] = logg_of(hh); }
            const int i0 = 16 * (wc & 1) + 4 * fq;
#pragma unroll
            for (int ai = 0; ai < 2; ++ai)
#pragma unroll
                for (int m = 0; m < 4; ++m) {
                    const int row = row0 + ai * HALF + m * 16;
                    const float rstd = rsqrtf(rss[row] * (1.0f / DM) + EPS);
                    const int pi = row < M_P ? (row & (SEQ - 1)) : SEQ + ((row - M_P) & (DECT - 1));
                    const float jj1 = (float)((row < M_P ? (row & (CH - 1)) : ((row - M_P) & (DECT - 1))) + 1);
                    const f32x4 c4 = *(const f32x4*)(rot + (size_t)pi * 64 + i0), s4 = *(const f32x4*)(rot + (size_t)pi * 64 + 32 + i0);
#pragma unroll
                    for (int bj = 0; bj < 2; ++bj) {
                        const int hh = 4 * (u.pn & 1) + 2 * bj + (wc >> 1);
                        const float f = __expf(seg == 0 ? jj1 * lg[bj] : -jj1 * lg[bj]) * rstd;
                        const f32x4 v0 = acc[ai][bj][m][0], v1 = acc[ai][bj][m][1];
                        const f32x4 x1 = (f32x4){v0[0], v0[2], v1[0], v1[2]}, x2 = (f32x4){v0[1], v0[3], v1[1], v1[3]};
                        const f32x4 o1 = (x1 * c4 - x2 * s4) * f, o2 = (x1 * s4 + x2 * c4) * f;
                        bf16_t* dst = P + (size_t)row * LDP + seg * 512 + hh * 64 + i0;
                        u32x2 w1, w2; w1.x = pk2(o1[0], o1[1]); w1.y = pk2(o1[2], o1[3]); w2.x = pk2(o2[0], o2[1]); w2.y = pk2(o2[2], o2[3]);
                        *(u32x2*)dst = w1; *(u32x2*)(dst + 32) = w2;
                    }
                    asm volatile("" ::: "memory");
                }
        } else {
            const int col0 = u.pn * BM + wc * 32 + 8 * fq;
#pragma unroll
            for (int ai = 0; ai < 2; ++ai)
#pragma unroll
                for (int m = 0; m < 4; ++m) {
                    const int row = row0 + ai * HALF + m * 16;
                    const float rstd = rsqrtf(rss[row] * (1.0f / DM) + EPS);
                    bf16_t* rowp = P + (size_t)row * LDP + col0;
#pragma unroll
                    for (int bj = 0; bj < 2; ++bj) {
                        f32x4 v0 = acc[ai][bj][m][0] * rstd, v1 = acc[ai][bj][m][1] * rstd;
                        if (seg == 3) {
#pragma unroll
                            for (int j = 0; j < 4; ++j) { v0[j] = siluf_(v0[j]); v1[j] = siluf_(v1[j]); }
                        } else if (seg == 5) {
#pragma unroll
                            for (int j = 0; j < 4; ++j) { v0[j] = geluf_(v0[j]); v1[j] = geluf_(v1[j]); }
                        } else if (seg >= 6) {
#pragma unroll
                            for (int j = 0; j < 4; ++j) { v0[j] = sigmoidf_(v0[j]); v1[j] = sigmoidf_(v1[j]); }
                        }
                        u32x4 w; w.x = pk2(v0[0], v0[1]); w.y = pk2(v0[2], v0[3]); w.z = pk2(v1[0], v1[1]); w.w = pk2(v1[2], v1[3]);
                        *(u32x4*)(rowp + bj * HALF) = w;
                    }
                    asm volatile("" ::: "memory");
                }
        }
    }
};

struct EpiMerge {
    static constexpr bool PERM = true;
    bf16_t* P;
    __device__ __forceinline__ void operator()(const f32x4 (&acc)[2][2][4][2], const Unit& u, int wr, int wc, int fr, int fq) const {
        const int row0 = u.pm * BM + wr * 64 + fr, col0 = u.pn * BM + wc * 32 + 8 * fq;
        const int gc = u.half ? PC_GB : PC_GA;
#pragma unroll
        for (int ai = 0; ai < 2; ++ai)
#pragma unroll
            for (int m = 0; m < 4; ++m) {
                bf16_t* rowp = P + (size_t)(row0 + ai * HALF + m * 16) * LDP;
#pragma unroll
                for (int bj = 0; bj < 2; ++bj) {
                    const int c = col0 + bj * HALF;
                    const u32x4 g = *(const u32x4*)(rowp + gc + c);
                    f32x4 v0 = acc[ai][bj][m][0], v1 = acc[ai][bj][m][1];
                    v0[0] *= bflo(g.x); v0[1] *= bfhi(g.x); v0[2] *= bflo(g.y); v0[3] *= bfhi(g.y);
                    v1[0] *= bflo(g.z); v1[1] *= bfhi(g.z); v1[2] *= bflo(g.w); v1[3] *= bfhi(g.w);
                    if (u.half) { const u32x4 p = *(const u32x4*)(rowp + PC_MRG + c);
                        v0[0] += bflo(p.x); v0[1] += bfhi(p.x); v0[2] += bflo(p.y); v0[3] += bfhi(p.y);
                        v1[0] += bflo(p.z); v1[1] += bfhi(p.z); v1[2] += bflo(p.w); v1[3] += bfhi(p.w); }
                    u32x4 w; w.x = pk2(v0[0], v0[1]); w.y = pk2(v0[2], v0[3]); w.z = pk2(v1[0], v1[1]); w.w = pk2(v1[2], v1[3]);
                    *(u32x4*)(rowp + PC_MRG + c) = w;
                }
                asm volatile("" ::: "memory");
            }
    }
};

struct EpiWo {
    static constexpr bool PERM = false;
    const float* xp; const float* xs;
    float* X; bf16_t* XB; float* rssp;
    __device__ __forceinline__ void operator()(const f32x4 (&acc)[2][2][4][2], const Unit& u, int wr, int wc, int fr, int fq) const {
        const int row0 = u.pm * BM + wr * 64 + fr, col0 = u.pn * BM + wc * 32 + 4 * fq;
#pragma unroll
        for (int ai = 0; ai < 2; ++ai)
#pragma unroll
            for (int m = 0; m < 4; ++m) {
                const int row = row0 + ai * HALF + m * 16;
                const float* src = (row < M_P ? xp + (size_t)row * DM : xs + (size_t)(row - M_P) * DM) + col0;
                float* dst = X + (size_t)row * DM + col0; bf16_t* dstb = XB + (size_t)row * DM + col0;
                float ss = 0.f;
#pragma unroll
                for (int bj = 0; bj < 2; ++bj)
#pragma unroll
                    for (int n = 0; n < 2; ++n) {
                        const f32x4 o = *(const f32x4*)(src + bj * HALF + n * 16) + acc[ai][bj][m][n];
                        *(f32x4*)(dst + bj * HALF + n * 16) = o;
                        u32x2 w; w.x = pk2(o[0], o[1]); w.y = pk2(o[2], o[3]); *(u32x2*)(dstb + bj * HALF + n * 16) = w;
                        ss += (o[0] * o[0] + o[1] * o[1]) + (o[2] * o[2] + o[3] * o[3]);
                    }
                ss += __shfl_xor(ss, 16); ss += __shfl_xor(ss, 32);
                if (fq == 0) rssp[(size_t)(u.pn * 4 + wc) * MTOT + row] = ss;
                asm volatile("" ::: "memory");
            }
    }
};

struct EpiQ {
    static constexpr bool PERM = true;
    bf16_t* P; const float* rssp; float* rss2;
    __device__ __forceinline__ void operator()(const f32x4 (&acc)[2][2][4][2], const Unit& u, int wr, int wc, int fr, int fq) const {
        const int row0 = u.pm * BM + wr * 64 + fr, col0 = u.pn * BM + wc * 32 + 8 * fq;
#pragma unroll
        for (int ai = 0; ai < 2; ++ai)
#pragma unroll
            for (int m = 0; m < 4; ++m) {
                const int row = row0 + ai * HALF + m * 16;
                float s = 0.f;
#pragma unroll
                for (int j = 0; j < 16; ++j) s += rssp[(size_t)j * MTOT + row];
                if (u.pn == 0 && wc == 0 && fq == 0) rss2[row] = s;
                const float rstd = rsqrtf(s * (1.0f / DM) + EPS);
                bf16_t* rowp = P + (size_t)row * LDP + PC_QP + col0;
#pragma unroll
                for (int bj = 0; bj < 2; ++bj) {
                    const f32x4 v0 = acc[ai][bj][m][0] * rstd, v1 = acc[ai][bj][m][1] * rstd;
                    u32x4 w; w.x = pk2(v0[0], v0[1]); w.y = pk2(v0[2], v0[3]); w.z = pk2(v1[0], v1[1]); w.w = pk2(v1[2], v1[3]);
                    *(u32x4*)(rowp + bj * HALF) = w;
                }
                asm volatile("" ::: "memory");
            }
    }
};
}

__device__ __forceinline__ void mma32(f32x16& acc, ldsp_t A, int lda_b, ldsp_t Bt, int ldb_b, int ksteps, int lane) {
    ldsp_t ap = A + (lane & 31) * lda_b + (lane >> 5) * 16;
    ldsp_t bp = Bt + (lane & 31) * ldb_b + (lane >> 5) * 16;
    for (int ks = 0; ks < ksteps; ++ks) {
        const bf16x8 a = *(const LAS bf16x8*)(ap + ks * 32), b = *(const LAS bf16x8*)(bp + ks * 32);
        acc = __builtin_amdgcn_mfma_f32_32x32x16_bf16(a, b, acc, 0, 0, 0);
    }
}
#define ZERO16 ((f32x16){0.f,0.f,0.f,0.f,0.f,0.f,0.f,0.f,0.f,0.f,0.f,0.f,0.f,0.f,0.f,0.f})

constexpr int R_QS = 0, R_KS = 18432, R_KST = 36864, R_VST = 54272, R_SS = 89088, R_RST = 123904, R_ST = 142336;
constexpr int LD64 = 144, LD128 = 272;
__device__ __forceinline__ void ret_prompt_unit(const Args& a, Frame& F, int l, int b, int h) {
    const int tid = F.tid, lane = F.lane, w = F.wave, hi = lane >> 5, l31 = lane & 31;
    ldsp_t lds = F.lds;
    bf16_t* P = (bf16_t*)(a.ws + WS_P);
    const float lg = logg_of(h), G = __expf(128.0f * lg);
    f32x16 racc = ZERO16;
    const int db = w >> 2, eb = w & 3;
    for (int n = 0; n < 16; ++n) {
        const size_t tok0 = (size_t)b * SEQ + n * CH;
#pragma unroll
        for (int i = 0; i < 2; ++i) { const int p = tid + 512 * i, row = p >> 3, c8 = p & 7;
            const bf16_t* src = P + (tok0 + row) * LDP + h * 64 + c8 * 8;
            const u32x4 qv = *(const u32x4*)(src + PC_Q), kv = *(const u32x4*)(src + PC_K);
            *(LAS u32x4*)(lds + R_QS + row * LD64 + c8 * 16) = qv; *(LAS u32x4*)(lds + R_KS + row * LD64 + c8 * 16) = kv;
            const unsigned kw[4] = {kv.x, kv.y, kv.z, kv.w};
#pragma unroll
            for (int j = 0; j < 4; ++j) { *(LAS bf16_t*)(lds + R_KST + (c8 * 8 + 2 * j) * LD128 + row * 2) = (bf16_t)(kw[j] & 0xffffu); *(LAS bf16_t*)(lds + R_KST + (c8 * 8 + 2 * j + 1) * LD128 + row * 2) = (bf16_t)(kw[j] >> 16); } }
#pragma unroll
        for (int i = 0; i < 4; ++i) { const int p = tid + 512 * i, row = p >> 4, c8 = p & 15;
            const u32x4 vv = *(const u32x4*)(P + (tok0 + row) * LDP + PC_V + h * 128 + c8 * 8);
            const unsigned vw[4] = {vv.x, vv.y, vv.z, vv.w};
#pragma unroll
            for (int j = 0; j < 4; ++j) { *(LAS bf16_t*)(lds + R_VST + (c8 * 8 + 2 * j) * LD128 + row * 2) = (bf16_t)(vw[j] & 0xffffu); *(LAS bf16_t*)(lds + R_VST + (c8 * 8 + 2 * j + 1) * LD128 + row * 2) = (bf16_t)(vw[j] >> 16); } }
#pragma unroll
        for (int g = 0; g < 4; ++g) { u32x2 wv; wv.x = pk2(racc[4 * g], racc[4 * g + 1]); wv.y = pk2(racc[4 * g + 2], racc[4 * g + 3]);
            *(LAS u32x2*)(lds + R_RST + (32 * eb + l31) * LD64 + (32 * db + 8 * g + 4 * hi) * 2) = wv; }
        __syncthreads();
#pragma unroll
        for (int t2 = 0; t2 < 2; ++t2) { const int t = 2 * w + t2, mb = t >> 2, jb = t & 3;
            if (mb <= jb) { f32x16 sacc = ZERO16;
                mma32(sacc, lds + R_KS + mb * 32 * LD64, LD64, lds + R_QS + jb * 32 * LD64, LD64, 4, lane);
                const int j = 32 * jb + l31;
#pragma unroll
                for (int g = 0; g < 4; ++g) { const int m0 = 32 * mb + 8 * g + 4 * hi; float v[4];
#pragma unroll
                    for (int q = 0; q < 4; ++q) v[q] = (j >= m0 + q) ? sacc[4 * g + q] : 0.f;
                    u32x2 wv; wv.x = pk2(v[0], v[1]); wv.y = pk2(v[2], v[3]);
                    *(LAS u32x2*)(lds + R_SS + j * LD128 + m0 * 2) = wv; } } }
        __syncthreads();
        const int jb = w >> 1, eh = w & 1;
        f32x16 oacc[2];
#pragma unroll
        for (int t = 0; t < 2; ++t) { oacc[t] = ZERO16; const int e2 = 2 * eh + t;
            mma32(oacc[t], lds + R_RST + e2 * 32 * LD64, LD64, lds + R_QS + jb * 32 * LD64, LD64, 4, lane);
            mma32(oacc[t], lds + R_VST + e2 * 32 * LD128, LD128, lds + R_SS + jb * 32 * LD128, LD128, 2 * (jb + 1), lane); }
        float s1 = 0.f, s2 = 0.f;
#pragma unroll
        for (int t = 0; t < 2; ++t)
#pragma unroll
            for (int r = 0; r < 16; ++r) { s1 += oacc[t][r]; s2 += oacc[t][r] * oacc[t][r]; }
        s1 += __shfl_xor(s1, 32); s2 += __shfl_xor(s2, 32);
        if (hi == 0) *(LAS f32x2*)(lds + R_ST + (eh * 128 + 32 * jb + l31) * 8) = (f32x2){s1, s2};
        __syncthreads();
        { const int j = 32 * jb + l31;
          const f32x2 sa = *(const LAS f32x2*)(lds + R_ST + j * 8), sb = *(const LAS f32x2*)(lds + R_ST + (128 + j) * 8);
          const float mu = (sa.x + sb.x) * (1.0f / DV), var = (sa.y + sb.y) * (1.0f / DV) - mu * mu, rstd = rsqrtf(fmaxf(var, 0.f) + EPS);
          bf16_t* prow = P + (tok0 + j) * LDP + h * 128;
#pragma unroll
          for (int t = 0; t < 2; ++t)
#pragma unroll
              for (int g = 0; g < 4; ++g) { const int e0 = 32 * (2 * eh + t) + 8 * g + 4 * hi;
                  const u32x2 gv = *(const u32x2*)(prow + PC_GR + e0);
                  const float o0 = (oacc[t][4 * g] - mu) * rstd * bflo(gv.x), o1 = (oacc[t][4 * g + 1] - mu) * rstd * bfhi(gv.x);
                  const float o2 = (oacc[t][4 * g + 2] - mu) * rstd * bflo(gv.y), o3 = (oacc[t][4 * g + 3] - mu) * rstd * bfhi(gv.y);
                  u32x2 wv; wv.x = pk2(o0, o1); wv.y = pk2(o2, o3);
                  *(u32x2*)(prow + PC_ARET + e0) = wv; } }
        mma32(racc, lds + R_KST + db * 32 * LD128, LD128, lds + R_VST + eb * 32 * LD128, LD128, 8, lane);
#pragma unroll
        for (int r = 0; r < 16; ++r) racc[r] *= G;
        __syncthreads();
    }
    float* so = a.out + O_SRP + ((((size_t)l * NBATCH + b) * HR + h) * DK) * DV;
#pragma unroll
    for (int r = 0; r < 16; ++r) { const int d = 32 * db + (r & 3) + 8 * (r >> 2) + 4 * hi; so[(size_t)d * DV + 32 * eb + l31] = racc[r]; }
}

__device__ __forceinline__ void ret_sample_unit(const Args& a, Frame& F, int l, int bs, int h) {
    const int tid = F.tid, lane = F.lane, w = F.wave;
    LAS float* qd = (LAS float*)F.lds; LAS float* ku = qd + 512; LAS float* vv = ku + 512; LAS float* S = vv + 1024; LAS float* crossp = S + 64; LAS float* red = crossp + 4096;
    bf16_t* P = (bf16_t*)(a.ws + WS_P);
    const size_t tok0 = (size_t)M_P + bs * DECT;
    { const int j = tid >> 6, d = tid & 63; const bf16_t* src = P + (tok0 + j) * LDP + h * 64 + d; qd[tid] = bf1(src[PC_Q]); ku[tid] = bf1(src[PC_K]); }
#pragma unroll
    for (int i = 0; i < 2; ++i) { const int idx = tid + 512 * i, m = idx >> 7, e = idx & 127; vv[idx] = bf1(P[(tok0 + m) * LDP + PC_V + h * 128 + e]); }
    __syncthreads();
    const int dg = tid >> 7, e = tid & 127;
    const size_t soff = ((((size_t)l * DECB + bs) * HR + h) * DK) * DV;
    const float* r0 = a.in[2] + soff; float* rn = a.out + O_SRS + soff;
    const float lg = logg_of(h), G8 = __expf(8.0f * lg);
    float cross[8];
#pragma unroll
    for (int j = 0; j < 8; ++j) cross[j] = 0.f;
#pragma unroll 4
    for (int dd = 0; dd < 16; ++dd) { const int d = dg * 16 + dd; const float r = r0[(size_t)d * DV + e]; float kvs = 0.f;
#pragma unroll
        for (int m = 0; m < 8; ++m) kvs += ku[m * 64 + d] * vv[m * 128 + e];
        rn[(size_t)d * DV + e] = G8 * (r + kvs);
#pragma unroll
        for (int j = 0; j < 8; ++j) cross[j] += qd[j * 64 + d] * r; }
#pragma unroll
    for (int j = 0; j < 8; ++j) crossp[(dg * 8 + j) * 128 + e] = cross[j];
    if (tid < 64) { const int j = tid >> 3, m = tid & 7; float s = 0.f;
        if (j >= m) { for (int d = 0; d < 64; ++d) s += qd[j * 64 + d] * ku[m * 64 + d]; }
        S[tid] = s; }
    __syncthreads();
    float o[2];
#pragma unroll
    for (int jj = 0; jj < 2; ++jj) { const int j = dg + 4 * jj; float s = 0.f;
#pragma unroll
        for (int g = 0; g < 4; ++g) s += crossp[(g * 8 + j) * 128 + e];
#pragma unroll
        for (int m = 0; m < 8; ++m) s += S[j * 8 + m] * vv[m * 128 + e];
        o[jj] = s;
        const float t1 = wave_sum(s), t2 = wave_sum(s * s);
        if (lane == 0) { red[(jj * 8 + w) * 2] = t1; red[(jj * 8 + w) * 2 + 1] = t2; } }
    __syncthreads();
#pragma unroll
    for (int jj = 0; jj < 2; ++jj) { const int j = dg + 4 * jj, w0 = 2 * dg;
        const float t1 = red[(jj * 8 + w0) * 2] + red[(jj * 8 + w0 + 1) * 2], t2 = red[(jj * 8 + w0) * 2 + 1] + red[(jj * 8 + w0 + 1) * 2 + 1];
        const float mu = t1 * (1.0f / DV), var = t2 * (1.0f / DV) - mu * mu, rstd = rsqrtf(fmaxf(var, 0.f) + EPS);
        bf16_t* prow = P + (tok0 + j) * LDP + h * 128 + e;
        prow[PC_ARET] = (bf16_t)f2bf((o[jj] - mu) * rstd * bf1(prow[PC_GR])); }
    __syncthreads();
}

constexpr int N_XRL = 0, N_XCF = 33536, N_XCB = 66304, N_WGT = 84736, N_CAR = 103168, N_BUF = 107264;
__device__ __forceinline__ void rnn_unit(const Args& a, Frame& F, int l, bool sample, int bg, int nb) {
    const int tid = F.tid, lane = F.lane, w = F.wave, hi = lane >> 5, l31 = lane & 31;
    ldsp_t lds = F.lds;
    LAS float* xrl = (LAS float*)(lds + N_XRL); LAS float* xcf = (LAS float*)(lds + N_XCF); LAS float* car = (LAS float*)(lds + N_CAR); LAS float* bufl = (LAS float*)(lds + N_BUF);
    LAS float* aa = xrl; LAS float* uu = xcf;
    bf16_t* P = (bf16_t*)(a.ws + WS_P);
    const int ch0 = nb * BS;
    { const bf16_t* wg = (const bf16_t*)(a.ws + WS_WG) + ((size_t)l * NBLK + nb) * 2 * BS * BS;
#pragma unroll
      for (int i = 0; i < 2; ++i) { const int p = tid + 512 * i, row = p >> 3, c8 = p & 7; *(LAS u32x4*)(lds + N_WGT + row * LD64 + c8 * 16) = *(const u32x4*)(wg + row * 64 + c8 * 8); } }
    const int cc = tid & 63;
    const float* cwp = a.in[11] + (size_t)l * 4 * DM + ch0 + cc;
    const float cw0 = cwp[0], cw1 = cwp[DM], cw2 = cwp[2 * DM], cw3 = cwp[3 * DM], cbv = a.in[12][l * DM + ch0 + cc];
    const int rb = w >> 1, cb = w & 1, dcol = 32 * cb + l31;
    const float bav = a.in[14][l * DM + ch0 + dcol], bxv = a.in[16][l * DM + ch0 + dcol];
    const float spl = log1pf(__expf(-a.in[17][l * DM + ch0 + dcol]));
    const int ntiles = sample ? 1 : 16;
    float hcar = 0.f;
    if (sample) {
        for (int i = tid; i < 16 * 3 * 64; i += NTHREADS) { const int s = i / 192, r = (i / 64) % 3, c = i & 63;
            bufl[i] = a.in[4][(((size_t)l * DECB + bg * 16 + s) * 3 + r) * DM + ch0 + c]; }
    }
    for (int n = 0; n < ntiles; ++n) {
        const size_t tok0 = sample ? (size_t)M_P + bg * 128 : (size_t)bg * SEQ + n * 128;
        for (int p = tid; p < 131 * 8; p += NTHREADS) { const int row = p >> 3, c8 = p & 7;
            u32x4 v = (u32x4){0u, 0u, 0u, 0u};
            if (row >= 3 || (!sample && n > 0)) v = *(const u32x4*)(P + (tok0 + row - 3) * LDP + PC_XR + ch0 + c8 * 8);
            LAS float* d = xrl + row * 64 + c8 * 8;
            d[0] = bflo(v.x); d[1] = bfhi(v.x); d[2] = bflo(v.y); d[3] = bfhi(v.y); d[4] = bflo(v.z); d[5] = bfhi(v.z); d[6] = bflo(v.w); d[7] = bfhi(v.w); }
        __syncthreads();
        { const int tg = tid >> 6;
#pragma unroll 4
          for (int i = 0; i < 16; ++i) { const int t = tg * 16 + i; float x0, x1, x2;
              const float x3 = xrl[(t + 3) * 64 + cc];
              if (sample) { const int s = t >> 3, j = t & 7;
                  x0 = j >= 3 ? xrl[t * 64 + cc] : bufl[(s * 3 + j) * 64 + cc];
                  x1 = j >= 2 ? xrl[(t + 1) * 64 + cc] : bufl[(s * 3 + j + 1) * 64 + cc];
                  x2 = j >= 1 ? xrl[(t + 2) * 64 + cc] : bufl[(s * 3 + j + 2) * 64 + cc];
              } else { x0 = xrl[t * 64 + cc]; x1 = xrl[(t + 1) * 64 + cc]; x2 = xrl[(t + 2) * 64 + cc]; }
              const float xc = cbv + cw0 * x0 + cw1 * x1 + cw2 * x2 + cw3 * x3;
              xcf[t * 64 + cc] = xc; *(LAS bf16_t*)(lds + N_XCB + t * LD64 + cc * 2) = (bf16_t)f2bf(xc); } }
        if (sample) { if (tid < 192) { }     }
        if (sample) { for (int i = tid; i < 16 * 3 * 64; i += NTHREADS) { const int s = i / 192, r = (i / 64) % 3, c = i & 63;
                a.out[O_SCS + (((size_t)l * DECB + bg * 16 + s) * 3 + r) * DM + ch0 + c] = xrl[(3 + s * 8 + 5 + r) * 64 + c]; } }
        else if (n == 15) { if (tid < 192) { const int r = tid >> 6, c = tid & 63; a.out[O_SCP + (((size_t)l * NBATCH + bg) * 3 + r) * DM + ch0 + c] = xrl[(3 + 125 + r) * 64 + c]; } }
        __syncthreads();
        { f32x16 ar = ZERO16, ai = ZERO16;
          mma32(ar, lds + N_XCB + rb * 32 * LD64, LD64, lds + N_WGT + (32 * cb) * LD64, LD64, 4, lane);
          mma32(ai, lds + N_XCB + rb * 32 * LD64, LD64, lds + N_WGT + (64 + 32 * cb) * LD64, LD64, 4, lane);
#pragma unroll
          for (int r = 0; r < 16; ++r) { const int t = 32 * rb + (r & 3) + 8 * (r >> 2) + 4 * hi;
              const float rg = sigmoidf_(ar[r] + bav), ig = sigmoidf_(ai[r] + bxv);
              const float la = -8.0f * rg * spl, av = __expf(la), mult = sqrtf(fmaxf(-expm1f(2.0f * la), 0.f));
              const float xc = xcf[t * 64 + dcol];
              aa[t * 64 + dcol] = av; uu[t * 64 + dcol] = mult * ig * xc; } }
        __syncthreads();
        if (!sample) {
            float Ap = 1.f, Hl = 0.f;
#pragma unroll 4
            for (int i = 0; i < 16; ++i) { const int t = 16 * w + i; const float av = aa[t * 64 + cc], uv = uu[t * 64 + cc]; Hl = av * Hl + uv; Ap *= av; }
            car[w * 64 + cc] = Ap; car[512 + w * 64 + cc] = Hl;
            __syncthreads();
            float hin = hcar, hnext = hcar;
#pragma unroll
            for (int w2 = 0; w2 < 8; ++w2) { const float A2 = car[w2 * 64 + cc], H2 = car[512 + w2 * 64 + cc]; hnext = A2 * hnext + H2; if (w2 < w) hin = hnext; }
            float hh = hin;
#pragma unroll 4
            for (int i = 0; i < 16; ++i) { const int t = 16 * w + i; hh = aa[t * 64 + cc] * hh + uu[t * 64 + cc];
                bf16_t* gp = P + (tok0 + t) * LDP + PC_GN + ch0 + cc; *gp = (bf16_t)f2bf(hh * bf1(*gp)); }
            hcar = hnext;
        } else {
#pragma unroll
            for (int s2 = 0; s2 < 2; ++s2) { const int s = 2 * w + s2, bs = bg * 16 + s;
                float hh = a.in[3][((size_t)l * DECB + bs) * DM + ch0 + cc];
#pragma unroll
                for (int j = 0; j < 8; ++j) { const int t = s * 8 + j; hh = aa[t * 64 + cc] * hh + uu[t * 64 + cc];
                    bf16_t* gp = P + (tok0 + t) * LDP + PC_GN + ch0 + cc; *gp = (bf16_t)f2bf(hh * bf1(*gp)); }
                a.out[O_SHS + ((size_t)l * DECB + bs) * DM + ch0 + cc] = hh; }
        }
        __syncthreads();
    }
    if (!sample && w == 0) a.out[O_SHP + ((size_t)l * NBATCH + bg) * DM + ch0 + cc] = hcar;
}

__device__ __forceinline__ unsigned ord_of(float f) { const unsigned u = __builtin_bit_cast(unsigned, f); return u ^ ((u >> 31) ? 0xFFFFFFFFu : 0x80000000u); }
__device__ __forceinline__ float ord_inv(unsigned o) { const unsigned u = (o >> 31) ? (o ^ 0x80000000u) : ~o; return __builtin_bit_cast(float, u); }
__host__ __device__ constexpr bool cand_ok(int a, int b) { return (a + 1) * (b + 1) <= 16; }

__device__ __forceinline__ void route_unit(const Args& a, int l, int tb, int h, int lane) {
    const int hi = lane >> 5, l31 = lane & 31, token = tb * 32 + l31;
    const bf16_t* P = (const bf16_t*)(a.ws + WS_P);
    const bf16_t* qrow = P + (size_t)token * LDP + PC_QP + h * 256 + hi * 8;
    const bf16_t* kbase = (const bf16_t*)(a.ws + WS_KEYS) + ((size_t)(l * PH + h) * 2) * NKEY * HK + (size_t)l31 * HK + hi * 8;
    unsigned L[2][16];
#pragma unroll
    for (int p = 0; p < 2; ++p) {
        f32x16 acc[4];
#pragma unroll
        for (int kb = 0; kb < 4; ++kb) acc[kb] = ZERO16;
#pragma unroll 2
        for (int ks = 0; ks < 8; ++ks) {
            const bf16x8 bq = *(const bf16x8*)(qrow + p * 128 + ks * 16);
#pragma unroll
            for (int kb = 0; kb < 4; ++kb) { const bf16x8 ak = *(const bf16x8*)(kbase + ((size_t)p * NKEY + kb * 32) * HK + ks * 16);
                acc[kb] = __builtin_amdgcn_mfma_f32_32x32x16_bf16(ak, bq, acc[kb], 0, 0, 0); }
        }
        unsigned pk[64];
#pragma unroll
        for (int kb = 0; kb < 4; ++kb)
#pragma unroll
            for (int r = 0; r < 16; ++r) { const int key = 32 * kb + (r & 3) + 8 * (r >> 2) + 4 * hi; pk[kb * 16 + r] = (ord_of(acc[kb][r]) & ~127u) | (unsigned)(127 - key); }
        unsigned prev = 0xFFFFFFFFu;
#pragma unroll
        for (int it = 0; it < 16; ++it) { unsigned m = 0u;
#pragma unroll
            for (int i = 0; i < 64; ++i) { const unsigned t = pk[i] < prev ? pk[i] : 0u; m = m > t ? m : t; }
            const unsigned o = (unsigned)__shfl_xor((int)m, 32); m = m > o ? m : o; L[p][it] = m; prev = m; }
    }
    float sa[16], sb[16];
#pragma unroll
    for (int i = 0; i < 16; ++i) { sa[i] = ord_inv(L[0][i] & ~127u); sb[i] = ord_inv(L[1][i] & ~127u); }
    unsigned ck[50];
    { int n = 0;
#pragma unroll
      for (int x = 0; x < 16; ++x)
#pragma unroll
          for (int y = 0; y < 16; ++y) if (cand_ok(x, y)) { ck[n] = (ord_of(sa[x] + sb[y]) & ~255u) | (unsigned)(255 - (x * 16 + y)); ++n; } }
    unsigned best[16];
    { unsigned prev = 0xFFFFFFFFu;
#pragma unroll
      for (int it = 0; it < 16; ++it) { unsigned m = 0u;
#pragma unroll
          for (int i = 0; i < 50; ++i) { const unsigned t = ck[i] < prev ? ck[i] : 0u; m = m > t ? m : t; }
          best[it] = m; prev = m; } }
    float sc[16], ssum = 0.f; const float mx = ord_inv(best[0] & ~255u);
#pragma unroll
    for (int it = 0; it < 16; ++it) { sc[it] = __expf(ord_inv(best[it] & ~255u) - mx); ssum += sc[it]; }
    const float inv = 1.0f / ssum;
    unsigned* eo = (unsigned*)(a.ws + WS_EIDX) + (size_t)token * 128 + h * 16 + hi * 8;
    float* go = (float*)(a.ws + WS_GATE) + (size_t)token * 128 + h * 16 + hi * 8;
#pragma unroll
    for (int it = 0; it < 8; ++it) {
        unsigned b0 = best[it], b1 = best[it + 8]; float g0 = sc[it], g1 = sc[it + 8];
        asm volatile("" : "+v"(b0), "+v"(b1), "+v"(g0), "+v"(g1));
        const unsigned bsel = hi ? b1 : b0; const float gsel = (hi ? g1 : g0) * inv;
        const unsigned c = 255u - (bsel & 255u), ca = c >> 4, cb = c & 15u;
        unsigned k1 = 0u, k2 = 0u;
#pragma unroll
        for (int i = 0; i < 16; ++i) { k1 = (ca == (unsigned)i) ? (127u - (L[0][i] & 127u)) : k1; k2 = (cb == (unsigned)i) ? (127u - (L[1][i] & 127u)) : k2; }
        eo[it] = k1 * 128u + k2; go[it] = gsel;
    }
}

constexpr int MAXT = 9;
__device__ __forceinline__ void dec16(const u32x4 r, float (&f)[16]) {
    const unsigned w[4] = {r.x, r.y, r.z, r.w};
#pragma unroll
    for (int j = 0; j < 4; ++j) { const f32x2 a = __builtin_amdgcn_cvt_pk_f32_fp8((int)w[j], false), b = __builtin_amdgcn_cvt_pk_f32_fp8((int)w[j], true);
        f[4 * j] = a.x; f[4 * j + 1] = a.y; f[4 * j + 2] = b.x; f[4 * j + 3] = b.y; }
}
__device__ __forceinline__ void peer_phase(const Args& a, Frame& F, int l, bool lastlayer) {
    const int lane = F.lane, l7 = lane & 7, lg3 = lane >> 3;
    const int gw = F.vcu * NWAVES + F.wave, NGW = F.G * NWAVES;
    const unsigned char* TU = a.ws + WS_TAB + ((size_t)l * 2) * 16 * MiB;
    const unsigned char* TV = a.ws + WS_TAB + ((size_t)l * 2 + 1) * 16 * MiB;
    const float* SCU = (const float*)(a.ws + WS_TSC) + ((size_t)l * 2) * NEXP; const float* SCV = SCU + NEXP;
    bf16_t* XB = (bf16_t*)(a.ws + WS_XB); float* X = a.out;
    const unsigned* EI = (const unsigned*)(a.ws + WS_EIDX); const float* GT = (const float*)(a.ws + WS_GATE);
    const float* g2 = a.in[6] + (size_t)l * DM;
    LAS unsigned* st = (LAS unsigned*)(F.lds + F.wave * 16384) + lane;
#define ST_ELO(i) st[(0 * MAXT + (i)) * 64]
#define ST_EHI(i) st[(1 * MAXT + (i)) * 64]
#define ST_H0(i)  ((LAS float*)st)[(2 * MAXT + (i)) * 64]
#define ST_H1(i)  ((LAS float*)st)[(3 * MAXT + (i)) * 64]
#define ST_SSQ(i) ((LAS float*)st)[(4 * MAXT + (i)) * 64]
    const int ntok = (MTOT - gw + NGW - 1) / NGW;
    for (int i = 0; i < ntok; ++i) { const int t = gw + NGW * i; ST_ELO(i) = EI[(size_t)t * 128 + lane]; ST_EHI(i) = EI[(size_t)t * 128 + 64 + lane]; ST_H0(i) = 0.f; ST_H1(i) = 0.f; ST_SSQ(i) = 0.f; }
    for (int urep = 0; urep < REPS(7); ++urep) {
    if (urep) { for (int i = 0; i < ntok; ++i) { ST_H0(i) = 0.f; ST_H1(i) = 0.f; } }
#pragma unroll 1
    for (int s = 0; s < 8; ++s) {
        float gv[16];
#pragma unroll
        for (int j = 0; j < 4; ++j) { const f32x4 g = *(const f32x4*)(g2 + 128 * s + 16 * l7 + 4 * j); gv[4 * j] = g[0]; gv[4 * j + 1] = g[1]; gv[4 * j + 2] = g[2]; gv[4 * j + 3] = g[3]; }
#pragma unroll 1
        for (int i = 0; i < ntok; ++i) { const int t = gw + NGW * i;
            const unsigned elo = ST_ELO(i), ehi = ST_EHI(i);
            const u32x4 xa = *(const u32x4*)(XB + (size_t)t * DM + 128 * s + 16 * l7), xb = *(const u32x4*)(XB + (size_t)t * DM + 128 * s + 16 * l7 + 8);
            float p[16];
#pragma unroll
            for (int qh = 0; qh < 2; ++qh) {
                u32x4 rowv[8];
#pragma unroll
                for (int q = 0; q < 8; ++q) { const unsigned idx = (unsigned)__shfl((int)(qh ? ehi : elo), q * 8 + lg3);
                    rowv[q] = *(const u32x4*)(TU + ((size_t)s * NEXP + idx) * 128 + 16 * l7); }
                float xg[16];
                { const unsigned xw[8] = {xa.x, xa.y, xa.z, xa.w, xb.x, xb.y, xb.z, xb.w};
#pragma unroll
                  for (int j = 0; j < 8; ++j) { xg[2 * j] = bflo(xw[j]) * gv[2 * j]; xg[2 * j + 1] = bfhi(xw[j]) * gv[2 * j + 1]; } }
#pragma unroll
                for (int q = 0; q < 8; ++q) { float f[16]; dec16(rowv[q], f); float s0 = 0.f, s1 = 0.f;
#pragma unroll
                    for (int j = 0; j < 8; ++j) { s0 += f[2 * j] * xg[2 * j]; s1 += f[2 * j + 1] * xg[2 * j + 1]; }
                    p[8 * qh + q] = s0 + s1;
                    if (q < 7) asm volatile("" : "+v"(rowv[q + 1].x), "+v"(rowv[q + 1].y), "+v"(rowv[q + 1].z), "+v"(rowv[q + 1].w) : "v"(p[8 * qh + q])); }
            }
            float p8[8], p4[4], p2[2];
#pragma unroll
            for (int q = 0; q < 8; ++q) { const float keep = (lane & 4) ? p[q + 8] : p[q], send = (lane & 4) ? p[q] : p[q + 8]; p8[q] = keep + __shfl_xor(send, 4); }
#pragma unroll
            for (int q = 0; q < 4; ++q) { const float keep = (lane & 2) ? p8[q + 4] : p8[q], send = (lane & 2) ? p8[q] : p8[q + 4]; p4[q] = keep + __shfl_xor(send, 2); }
#pragma unroll
            for (int q = 0; q < 2; ++q) { const float keep = (lane & 1) ? p4[q + 2] : p4[q], send = (lane & 1) ? p4[q] : p4[q + 2]; p2[q] = keep + __shfl_xor(send, 1); }
            ST_H0(i) += p2[0]; ST_H1(i) += p2[1];
        }
    } }
    for (int i = 0; i < ntok; ++i) { const int t = gw + NGW * i;
        const float rstd = rsqrtf(((const float*)(a.ws + WS_RSS2))[t] * (1.0f / DM) + EPS);
        const int k0 = 16 * l7 + lg3, k1 = k0 + 8; const unsigned e0 = EI[(size_t)t * 128 + k0], e1 = EI[(size_t)t * 128 + k1];
        ST_H0(i) = geluf_(ST_H0(i) * rstd * SCU[e0]) * GT[(size_t)t * 128 + k0] * SCV[e0];
        ST_H1(i) = geluf_(ST_H1(i) * rstd * SCU[e1]) * GT[(size_t)t * 128 + k1] * SCV[e1]; }
#pragma unroll 1
    for (int s = 0; s < 8; ++s) {
#pragma unroll 1
        for (int i = 0; i < ntok; ++i) { const int t = gw + NGW * i;
            const unsigned elo = ST_ELO(i), ehi = ST_EHI(i); const float h0 = ST_H0(i), h1 = ST_H1(i);
            float o[16];
#pragma unroll
            for (int j = 0; j < 16; ++j) o[j] = 0.f;
#pragma unroll
            for (int qh = 0; qh < 2; ++qh) {
                u32x4 rowv[8];
#pragma unroll
                for (int q = 0; q < 8; ++q) { const unsigned idx = (unsigned)__shfl((int)(qh ? ehi : elo), q * 8 + lg3);
                    rowv[q] = *(const u32x4*)(TV + ((size_t)s * NEXP + idx) * 128 + 16 * l7); }
#pragma unroll
                for (int q = 0; q < 8; ++q) { const float hq = __shfl((q & 1) ? h1 : h0, (lane & ~7) | (4 * qh + (q >> 1))); float f[16]; dec16(rowv[q], f);
#pragma unroll
                    for (int j = 0; j < 16; ++j) o[j] += hq * f[j];
                    if (q < 7) asm volatile("" : "+v"(rowv[q + 1].x), "+v"(rowv[q + 1].y), "+v"(rowv[q + 1].z), "+v"(rowv[q + 1].w) : "v"(o[15])); }
            }
            float o8[8], o4[4], o2[2];
#pragma unroll
            for (int q = 0; q < 8; ++q) { const float keep = (lane & 32) ? o[q + 8] : o[q], send = (lane & 32) ? o[q] : o[q + 8]; o8[q] = keep + __shfl_xor(send, 32); }
#pragma unroll
            for (int q = 0; q < 4; ++q) { const float keep = (lane & 16) ? o8[q + 4] : o8[q], send = (lane & 16) ? o8[q] : o8[q + 4]; o4[q] = keep + __shfl_xor(send, 16); }
#pragma unroll
            for (int q = 0; q < 2; ++q) { const float keep = (lane & 8) ? o4[q + 2] : o4[q], send = (lane & 8) ? o4[q] : o4[q + 2]; o2[q] = keep + __shfl_xor(send, 8); }
            const int col = 128 * s + 16 * l7 + 8 * ((lane >> 5) & 1) + 4 * ((lane >> 4) & 1) + 2 * ((lane >> 3) & 1);
            f32x2 xv = *(const f32x2*)(X + (size_t)t * DM + col);
            xv.x += o2[0]; xv.y += o2[1];
            *(f32x2*)(X + (size_t)t * DM + col) = xv; *(unsigned*)(XB + (size_t)t * DM + col) = pk2(xv.x, xv.y); ST_SSQ(i) += xv.x * xv.x + xv.y * xv.y;
        }
    }
    float* RSS = (float*)(a.ws + WS_RSS);
    if (lastlayer) __threadfence();
    for (int i = 0; i < ntok; ++i) { const int t = gw + NGW * i; const float ss = wave_sum(ST_SSQ(i)); if (lane == 0) RSS[t] = ss;
        if (lastlayer) { const float* gf = a.in[7]; const float rstd = rsqrtf(ss * (1.0f / DM) + EPS); f32x4* xr = (f32x4*)(X + (size_t)t * DM) + lane;
#pragma unroll
            for (int j = 0; j < 4; ++j) { const f32x4 g = *((const f32x4*)gf + lane + 64 * j); f32x4 v = xr[64 * j]; v = v * rstd * g; xr[64 * j] = v; } } }
#undef ST_ELO
#undef ST_EHI
#undef ST_H0
#undef ST_H1
#undef ST_SSQ
}

constexpr int N_PHASES = 1 + 7 * DEPTH;
__global__ void __launch_bounds__(NTHREADS, 2) hybrid_fwd(Args args) {
    extern __shared__ __attribute__((aligned(16))) unsigned char lds_raw[];
    Frame F;
    F.lds = (ldsp_t)lds_raw;
    F.MISC = (volatile LAS unsigned*)(F.lds + MISC_OFF);
    F.tid = threadIdx.x; F.lane = F.tid & 63; F.wave = __builtin_amdgcn_readfirstlane(F.tid >> 6);
    F.G = gridDim.x; { const int bx = blockIdx.x; F.vcu = (F.G % 8 == 0) ? (bx % 8) * (F.G / 8) + bx / 8 : bx; }
    F.ctl = (unsigned*)(args.ws + WS_CTL); F.ws = args.ws; F.out = args.out;
    for (int u = F.tid; u < (LDS_BYTES - MISC_OFF) / 4; u += NTHREADS) ((LAS unsigned*)(F.lds + MISC_OFF))[u] = 0u;
    __syncthreads();
    const int lo = args.ph_lo, hi = args.ph_hi;
    XcdBarrier bar; bar.bar = F.ctl + CW_BAR; bar.x = 0; bar.st = nullptr;
    if (hi - lo > 1) bar = xcd_barrier_post(F.ctl + CW_BAR, F.MISC + 8);
#ifndef PH_MASK
#define PH_MASK 0x7FF
#endif
#define IN(k) (lo <= (k) && (k) < hi)
#define PHM(b) ((PH_MASK >> (b)) & 1)
#define REPBAR() do { if (rep) xcd_barrier(bar); } while (0)
#define LAUNDER() do { asm volatile("" : "+v"(F.tid)); F.lane = F.tid & 63; F.wave = __builtin_amdgcn_readfirstlane(F.tid >> 6); } while (0)
#define SEAM(k) do { if (IN(k) && IN((k) + 1)) xcd_barrier(bar); } while (0)
    unsigned char* ws = args.ws;
    bf16_t* P = (bf16_t*)(ws + WS_P); bf16_t* XB = (bf16_t*)(ws + WS_XB);

    for (int rep = 0; rep < REPS(0); ++rep) { REPBAR(); if (PHM(0) && IN(0)) { LAUNDER(); p0_prologue(args, F); } } SEAM(0);

    for (int l = 0; l < DEPTH; ++l) {
        const int pb = 1 + 7 * l;
        for (int rep = 0; rep < REPS(1); ++rep) { REPBAR();
        if (PHM(1) && IN(pb)) { LAUNDER();
            pg8::Gemm g{XB, (const bf16_t*)(ws + WS_WIN) + (size_t)l * NIN * DM, DM, DM, 0, 0};
            pg8::StaticOrder S; S.init(MTOT, NIN, F.G, (int)blockIdx.x, 1);
            pg8::EpiIn E{P, (const float*)(ws + WS_RSS), (const float*)(ws + WS_ROT)};
            pg8::gemm_phase<pg8::EpiIn, pg8::StaticOrder, true>(F.lds, g, S, E, F.tid);
        } }
        SEAM(pb);
        if (PHM(2) && IN(pb + 1)) { LAUNDER();
            for (int u = (int)blockIdx.x; u < 192; u += F.G) {
                LAUNDER();
                if (u < 64) { if (PHM(8)) ret_prompt_unit(args, F, l, u >> 3, u & 7); }
                else { if (PHM(9)) rnn_unit(args, F, l, false, (u - 64) >> 4, (u - 64) & 15); }
            }
            unsigned* qh = F.ctl + CW_QUEUE + 64 * l;
            for (;;) {
                __syncthreads();
                if (F.tid == 0) F.MISC[0] = xb_add(qh, 1u);
                __syncthreads();
                const unsigned q = F.MISC[0];
                LAUNDER();
                if (q >= 1024u + 128u) break;
                if (q < 1024u) { if (PHM(10)) ret_sample_unit(args, F, l, (int)(q >> 3), (int)(q & 7)); }
                else { if (PHM(9)) rnn_unit(args, F, l, true, (int)((q - 1024u) >> 4), (int)((q - 1024u) & 15)); }
            }
        }
        SEAM(pb + 1);
        for (int rep = 0; rep < REPS(3); ++rep) { REPBAR();
        if (PHM(3) && IN(pb + 2)) { LAUNDER();
            pg8::Gemm g{P + PC_ARET, (const bf16_t*)(ws + WS_WMIX + (size_t)l * 6 * MiB), LDP, DM, (size_t)(PC_ARNN - PC_ARET) * 2, (size_t)(2 * MiB)};
            pg8::StaticOrder S; S.init(MTOT, DM, F.G, (int)blockIdx.x, 2);
            pg8::EpiMerge E{P};
            pg8::gemm_phase<pg8::EpiMerge, pg8::StaticOrder, true>(F.lds, g, S, E, F.tid);
        } }
        SEAM(pb + 2);
        if (PHM(4) && IN(pb + 3)) { LAUNDER();
            pg8::Gemm g{P + PC_MRG, (const bf16_t*)(ws + WS_WMIX + (size_t)l * 6 * MiB + 4 * MiB), LDP, DM, 0, 0};
            pg8::StaticOrder S; S.init(MTOT, DM, F.G, (int)blockIdx.x, 1);
            pg8::EpiWo E{l == 0 ? args.in[0] : args.out, l == 0 ? args.in[1] : args.out + (size_t)M_P * DM, args.out, XB, (float*)(ws + WS_RSSP)};
            pg8::gemm_phase<pg8::EpiWo, pg8::StaticOrder, true>(F.lds, g, S, E, F.tid);
        }
        SEAM(pb + 3);
        for (int rep = 0; rep < REPS(5); ++rep) { REPBAR();
        if (PHM(5) && IN(pb + 4)) { LAUNDER();
            pg8::Gemm g{XB, (const bf16_t*)(ws + WS_WQ) + (size_t)l * 2048 * DM, DM, DM, 0, 0};
            pg8::StaticOrder S; S.init(MTOT, 2048, F.G, (int)blockIdx.x, 1);
            pg8::EpiQ E{P, (const float*)(ws + WS_RSSP), (float*)(ws + WS_RSS2)};
            pg8::gemm_phase<pg8::EpiQ, pg8::StaticOrder, true>(F.lds, g, S, E, F.tid);
        } }
        SEAM(pb + 4);
        for (int rep = 0; rep < REPS(6); ++rep) { REPBAR();
        if (PHM(6) && IN(pb + 5)) { LAUNDER();
            const int gw = F.vcu * NWAVES + F.wave, NGW = F.G * NWAVES;
            for (int u = gw; u < (MTOT / 32) * PH; u += NGW) { int ln = F.lane; asm volatile("" : "+v"(ln)); route_unit(args, l, u >> 3, u & 7, ln); }
        } }
        SEAM(pb + 5);
        if (PHM(7) && IN(pb + 6)) { LAUNDER(); peer_phase(args, F, l, l == DEPTH - 1); }
        if (l + 1 < DEPTH) SEAM(pb + 6);
    }
#undef IN
#undef SEAM
}

extern "C" void kernel_launch(void* const* d_in, const int* in_sizes, int n_in, void* d_out, int out_size, void* d_ws, size_t ws_size, hipStream_t stream) {
    static int grid = 0;
    if (grid == 0) {
        if (n_in != 24 || out_size != (int)O_END || ws_size < WS_END) { fprintf(stderr, "kernel_launch: unexpected shapes (n_in %d, out %d, ws %zu)\n", n_in, out_size, ws_size); grid = -1; return; }
        int dev = 0, cus = 0, per_cu = 0;
        if (hipGetDevice(&dev) != hipSuccess || hipDeviceGetAttribute(&cus, hipDeviceAttributeMultiprocessorCount, dev) != hipSuccess) { grid = -1; return; }
        if (hipFuncSetAttribute((const void*)hybrid_fwd, hipFuncAttributeMaxDynamicSharedMemorySize, LDS_BYTES) != hipSuccess) { fprintf(stderr, "kernel_launch: hipFuncSetAttribute failed\n"); grid = -1; return; }
        if (hipOccupancyMaxActiveBlocksPerMultiprocessor(&per_cu, (const void*)hybrid_fwd, NTHREADS, LDS_BYTES) != hipSuccess || per_cu < 1) { fprintf(stderr, "kernel_launch: occupancy query reports %d blocks per CU\n", per_cu); (void)hipGetLastError(); grid = -1; return; }
        grid = cus;
        if (grid != 256) fprintf(stderr, "kernel_launch: %d CUs; the PEER phase assumes 256 workgroups\n", grid);
    }
    if (grid < 0) return;
    (void)hipMemsetAsync((char*)d_ws + WS_CTL, 0, CTL_ZERO_BYTES, stream);
    Args a{};
    for (int i = 0; i < 24; ++i) a.in[i] = (const float*)d_in[i];
    a.out = (float*)d_out; a.ws = (unsigned char*)d_ws;
#if MK_N_LAUNCHES == 1
    a.ph_lo = 0; a.ph_hi = N_PHASES;
    void* kargs[] = {&a};
    hipError_t e = hipLaunchCooperativeKernel((const void*)hybrid_fwd, dim3(grid), dim3(NTHREADS), kargs, LDS_BYTES, stream);
    if (e != hipSuccess) fprintf(stderr, "kernel_launch: cooperative launch failed: %s (grid %d)\n", hipGetErrorString(e), grid);
#else
    for (int p = 0; p < N_PHASES; ++p) { a.ph_lo = p; a.ph_hi = p + 1; hipLaunchKernelGGL(hybrid_fwd, dim3(grid), dim3(NTHREADS), LDS_BYTES, stream, a); }
#endif
}
```

```cpp
#include <hip/hip_runtime.h>
#include <cstdio>
#include <cstdint>

#define LAS __attribute__((address_space(3)))
#define GAS __attribute__((address_space(1)))
typedef unsigned short bf16_t;
typedef short bf16x8 __attribute__((ext_vector_type(8)));
typedef float f32x2 __attribute__((ext_vector_type(2)));
typedef float f32x4 __attribute__((ext_vector_type(4)));
typedef float f32x16 __attribute__((ext_vector_type(16)));
typedef unsigned u32x2 __attribute__((ext_vector_type(2)));
typedef unsigned u32x4 __attribute__((ext_vector_type(4)));
typedef LAS unsigned char* ldsp_t;

#ifndef REP_MASK
#define REP_MASK 0
#endif
#define REPS(k) (((REP_MASK >> (k)) & 1) ? 2 : 1)
#ifndef MK_N_LAUNCHES
#define MK_N_LAUNCHES 1
#endif

constexpr int DM = 1024, NIN = 7168, M_P = 16384, M_S = 1024, MTOT = 17408, DEPTH = 2;
constexpr int SEQ = 2048, NBATCH = 8, DECB = 128, DECT = 8, PAST = 16384;
constexpr int HR = 8, DK = 64, DV = 128, CH = 128;
constexpr int NBLK = 16, BS = 64;
constexpr int PH = 8, NKEY = 128, NEXP = 16384, TOPK = 16, HK = 128;
constexpr float EPS = 1e-6f;
constexpr int LDP = 7168;
constexpr int PC_Q = 0, PC_K = 512, PC_V = 1024, PC_GR = 2048, PC_XR = 3072, PC_GN = 4096, PC_GA = 5120, PC_GB = 6144;
constexpr int PC_MRG = 0, PC_ARET = 1024, PC_ARNN = 4096, PC_QP = 2048;

constexpr size_t MiB = 1u << 20;
constexpr size_t WS_CTL = 0, CTL_ZERO_BYTES = 1 * MiB;
constexpr size_t WS_ROT = 1 * MiB;
constexpr size_t WS_RSS = 2 * MiB;
constexpr size_t WS_RSS2 = 2 * MiB + 128 * 1024;
constexpr size_t WS_RSSP = 2 * MiB + 256 * 1024;
constexpr size_t WS_TSC = 3 * MiB + 512 * 1024;
constexpr size_t WS_EIDX = 4 * MiB;
constexpr size_t WS_GATE = 13 * MiB;
constexpr size_t WS_KEYS = 22 * MiB;
constexpr size_t WS_WG = 23 * MiB;
constexpr size_t WS_WIN = 24 * MiB;
constexpr size_t WS_WMIX = 52 * MiB;
constexpr size_t WS_WQ = 64 * MiB;
constexpr size_t WS_XB = 72 * MiB;
constexpr size_t WS_P = 106 * MiB;
constexpr size_t WS_TAB = 344 * MiB;
constexpr size_t WS_END = 472 * MiB;
static_assert(WS_P + (size_t)MTOT * LDP * 2 <= WS_TAB, "ws map");

constexpr size_t O_Y = 0, O_SRP = 17825792, O_SHP = 18874368, O_SCP = 18890752, O_SRS = 18939904, O_SHS = 35717120, O_SCS = 35979264, O_END = 36765696;

constexpr int CW_BAR = 4096;
constexpr int CW_QUEUE = 16384;

constexpr int RING_BYTES = 131072;
constexpr int LDS_BYTES = 155648;
constexpr int MISC_OFF = 153600;
constexpr int NWAVES = 8, NTHREADS = 512;

#define LDS_WAIT() asm volatile("s_waitcnt lgkmcnt(0)" ::: "memory")
#define VM_WAIT() asm volatile("s_waitcnt vmcnt(0)" ::: "memory")
#define RLX_AGENT __ATOMIC_RELAXED, __HIP_MEMORY_SCOPE_AGENT

__device__ __forceinline__ unsigned f2bf(float f) { unsigned u = __builtin_bit_cast(unsigned, f); return (u + 0x7fffu + ((u >> 16) & 1u)) >> 16; }
__device__ __forceinline__ unsigned pk2(float lo, float hi) { return f2bf(lo) | (f2bf(hi) << 16); }
__device__ __forceinline__ float bflo(unsigned w) { return __builtin_bit_cast(float, w << 16); }
__device__ __forceinline__ float bfhi(unsigned w) { return __builtin_bit_cast(float, w & 0xffff0000u); }
__device__ __forceinline__ float bf1(bf16_t h) { return __builtin_bit_cast(float, (unsigned)h << 16); }
__device__ __forceinline__ float sigmoidf_(float x) { return __builtin_amdgcn_rcpf(1.0f + __expf(-x)); }
__device__ __forceinline__ float siluf_(float x) { return x * sigmoidf_(x); }
__device__ __forceinline__ float geluf_(float x) { return x * sigmoidf_(1.5957691216057308f * (x + 0.044715f * x * x * x)); }
__device__ __forceinline__ float logg_of(int h) { return log1pf(-exp2f((float)(-5 - h))); }

namespace pg8 {
constexpr int BM = 256, BK = 64, HALF = 128, HTB = HALF * BK * 2, STAGE_BYTES = 8 * HTB, NXCD = 8, WGM = 8;
__host__ __device__ __forceinline__ int lds_byte(int r, int c) { const int st = (r >> 4) * 2 + (c >> 5), rr = r & 15, cc = c & 31, ob = rr * 64 + cc * 2; return st * 1024 + (ob ^ (((ob >> 9) & 1) << 5)); }
__host__ __device__ __forceinline__ void stage_rc(int b, int& R, int& C) { const int st = b / 1024, sb = b % 1024, swz = sb ^ (((sb >> 9) & 1) << 5); R = (st >> 1) * 16 + swz / 64; C = (st & 1) * 32 + (swz % 64) / 2; }
__host__ __device__ __forceinline__ int perm32(int rho) { const int n = rho >> 4, i = rho & 15; return 8 * (i >> 2) + 4 * n + (i & 3); }

struct Unit { int pm, pn, half; };
struct Gemm { const bf16_t* A; const bf16_t* Bt; int lda, K; size_t aoff2, boff2; };

struct StaticOrder {
    int nM, nN, nwg, G, c, pairs;
    __device__ void init(int M, int N, int G_, int c_, int pairs_) { nM = M / BM; nN = N / BM; nwg = nM * nN; G = G_; c = c_; pairs = pairs_; }
    __device__ bool next(int i, Unit& u) const {
        const int it = (pairs == 2) ? (i >> 1) : i;
        const long L = (long)it * G + c; if (L >= nwg) return false;
        int wgid = (int)L; { const int q = nwg / NXCD, r = nwg % NXCD, xcd = wgid % NXCD, off = wgid / NXCD; wgid = (xcd < r ? xcd * (q + 1) : r * (q + 1) + (xcd - r) * q) + off; }
        const int nig = WGM * nN, gid = wgid / nig, fm = gid * WGM, gsz = (nM - fm) < WGM ? (nM - fm) : WGM;
        u.pm = fm + ((wgid % nig) % gsz); u.pn = (wgid % nig) / gsz; u.half = (pairs == 2) ? (i & 1) : 0; return true;
    }
};

template <class Epi, class Sched, bool ALIGN_EPI>
__device__ __forceinline__ void gemm_phase(ldsp_t lds, const Gemm g, const Sched& S, const Epi& E, const int tid) {
    const int wid = __builtin_amdgcn_readfirstlane(tid >> 6), lane = tid & 63, wr = wid >> 2, wc = wid & 3, fr = lane & 15, fq = lane >> 4;
    const int K = g.K, nt = K / BK;
    unsigned voffA[2], voffB[2];
#pragma unroll
    for (int i = 0; i < 2; ++i) { int R, C; stage_rc(tid * 16 + i * 8192, R, C); const int Rb = Epi::PERM ? ((R & ~31) + perm32(R & 31)) : R;
        voffA[i] = (unsigned)(R * g.lda + C) * 2u; voffB[i] = (unsigned)(Rb * K + C) * 2u; }
    const size_t kstep = (size_t)(BK * 2);
    const size_t hstepA = (size_t)HALF * g.lda * 2, hstepB = (size_t)HALF * K * 2;
    const size_t tstepA = 2 * hstepA, tstepB = 2 * hstepB;
    const unsigned ldsw = (unsigned)wid * 1024u;
    const int aoff = lds_byte(wr * 64 + fr, fq * 8), boff = lds_byte(wc * 32 + fr, fq * 8);
#define PG8_SA(b, h) (((b) * 2 + (h)) * HTB)
#define PG8_SB(b, h) ((4 + (b) * 2 + (h)) * HTB)
#define PG8_STAGE(bufoff, gbase, voff) do { _Pragma("unroll") for (int _i = 0; _i < 2; ++_i) \
        __builtin_amdgcn_global_load_lds((const unsigned*)((const char*)(gbase) + (voff)[_i]), (LAS unsigned*)(lds + (bufoff) + ldsw + _i * 8192), 16, 0, 0); } while (0)
#define PG8_LDA(dst, b, h) do { _Pragma("unroll") for (int m = 0; m < 4; ++m) _Pragma("unroll") for (int k = 0; k < 2; ++k) dst[m][k] = *(const LAS bf16x8*)(lds + PG8_SA(b, h) + aoff + m * 2048 + k * 1024); } while (0)
#define PG8_LDB(dst, b, h) do { _Pragma("unroll") for (int n = 0; n < 2; ++n) _Pragma("unroll") for (int k = 0; k < 2; ++k) dst[n][k] = *(const LAS bf16x8*)(lds + PG8_SB(b, h) + boff + n * 2048 + k * 1024); } while (0)
#define PG8_MMA(ai, bj, At, Bt) do { __builtin_amdgcn_s_setprio(1); _Pragma("unroll") for (int m = 0; m < 4; ++m) _Pragma("unroll") for (int n = 0; n < 2; ++n) _Pragma("unroll") for (int k = 0; k < 2; ++k) \
        acc[ai][bj][m][n] = __builtin_amdgcn_mfma_f32_16x16x32_bf16(Bt[n][k], At[m][k], acc[ai][bj][m][n], 0, 0, 0); __builtin_amdgcn_s_setprio(0); } while (0)
#define PG8_WAIT_V(n) asm volatile("s_waitcnt vmcnt(" #n ")" ::: "memory")
#define PG8_WAIT_L(n) asm volatile("s_waitcnt lgkmcnt(" #n ")" ::: "memory")
#define PG8_BAR __builtin_amdgcn_s_barrier()
#define PG8_SCHED __builtin_amdgcn_sched_barrier(0)
    Unit cur, nxt; int ui = 0;
    if (!S.next(0, cur)) return;
    f32x4 acc[2][2][4][2];
#pragma unroll
    for (int a = 0; a < 2; ++a)
#pragma unroll
        for (int b = 0; b < 2; ++b)
#pragma unroll
            for (int m = 0; m < 4; ++m)
#pragma unroll
                for (int n = 0; n < 2; ++n) acc[a][b][m][n] = (f32x4){0.f, 0.f, 0.f, 0.f};
    bf16x8 At[4][2], B0[2][2], B1[2][2];
    const char* cA = (const char*)g.A + (size_t)cur.pm * tstepA + (cur.half ? g.aoff2 : 0); const char* cB = (const char*)g.Bt + (size_t)cur.pn * tstepB + (cur.half ? g.boff2 : 0);
    PG8_STAGE(PG8_SB(0, 0), cB, voffB); PG8_STAGE(PG8_SB(0, 1), cB + hstepB, voffB); PG8_STAGE(PG8_SA(0, 0), cA, voffA); PG8_STAGE(PG8_SA(0, 1), cA + hstepA, voffA);
    if (wr == 1) PG8_BAR;
    PG8_WAIT_V(2); PG8_BAR;
    PG8_STAGE(PG8_SB(1, 0), cB + kstep, voffB); PG8_STAGE(PG8_SA(1, 0), cA + kstep, voffA); PG8_STAGE(PG8_SB(1, 1), cB + hstepB + kstep, voffB);
    PG8_WAIT_V(6); PG8_BAR;
    for (;;) {
        const bool has_next = S.next(ui + 1, nxt);
        const char* nA = has_next ? (const char*)g.A + (size_t)nxt.pm * tstepA + (nxt.half ? g.aoff2 : 0) : cA;
        const char* nB = has_next ? (const char*)g.Bt + (size_t)nxt.pn * tstepB + (nxt.half ? g.boff2 : 0) : cB;
        for (int t = 0; t < nt; t += 2) {
            const bool last = (t == nt - 2);
            const char* a1 = cA + (size_t)(t + 1) * kstep;
            const char* a2 = last ? nA : cA + (size_t)(t + 2) * kstep; const char* b2 = last ? nB : cB + (size_t)(t + 2) * kstep;
            const char* a3 = a2 + kstep; const char* b3 = b2 + kstep;
            PG8_LDB(B0, 0, 0); PG8_LDB(B1, 0, 1); PG8_SCHED; PG8_LDA(At, 0, 0); PG8_STAGE(PG8_SA(1, 1), a1 + hstepA, voffA);
            PG8_WAIT_V(8); PG8_WAIT_L(0); PG8_BAR; PG8_MMA(0, 0, At, B0); PG8_MMA(0, 1, At, B1); PG8_BAR; PG8_SCHED;
            PG8_LDA(At, 0, 1); PG8_STAGE(PG8_SB(0, 0), b2, voffB); PG8_STAGE(PG8_SB(0, 1), b2 + hstepB, voffB); PG8_STAGE(PG8_SA(0, 0), a2, voffA);
            PG8_WAIT_V(8); PG8_WAIT_L(0); PG8_BAR; PG8_MMA(1, 0, At, B0); PG8_MMA(1, 1, At, B1); PG8_BAR; PG8_SCHED;
            PG8_LDB(B0, 1, 0); PG8_LDB(B1, 1, 1); PG8_SCHED; PG8_LDA(At, 1, 0); PG8_STAGE(PG8_SA(0, 1), a2 + hstepA, voffA);
            PG8_WAIT_V(8); PG8_WAIT_L(0); PG8_BAR; PG8_MMA(0, 0, At, B0); PG8_MMA(0, 1, At, B1); PG8_BAR; PG8_SCHED;
            PG8_LDA(At, 1, 1); PG8_STAGE(PG8_SB(1, 0), b3, voffB); PG8_STAGE(PG8_SB(1, 1), b3 + hstepB, voffB); PG8_STAGE(PG8_SA(1, 0), a3, voffA);
            PG8_WAIT_V(8); PG8_WAIT_L(0); PG8_BAR; PG8_MMA(1, 0, At, B0); PG8_MMA(1, 1, At, B1); PG8_BAR; PG8_SCHED;
        }
        if constexpr (ALIGN_EPI) { if (wr == 0) PG8_BAR; }
        E(acc, cur, wr, wc, fr, fq);
        if (!has_next) break;
#pragma unroll
        for (int a = 0; a < 2; ++a)
#pragma unroll
            for (int b = 0; b < 2; ++b)
#pragma unroll
                for (int m = 0; m < 4; ++m)
#pragma unroll
                    for (int n = 0; n < 2; ++n) acc[a][b][m][n] = (f32x4){0.f, 0.f, 0.f, 0.f};
        cur = nxt; cA = nA; cB = nB; ++ui;
        if constexpr (ALIGN_EPI) { if (wr == 1) PG8_BAR; }
    }
    PG8_WAIT_V(0);
    if constexpr (!ALIGN_EPI) { if (wr == 0) PG8_BAR; }
    PG8_BAR;
#undef PG8_SA
#undef PG8_SB
#undef PG8_STAGE
#undef PG8_LDA
#undef PG8_LDB
#undef PG8_MMA
#undef PG8_WAIT_V
#undef PG8_WAIT_L
#undef PG8_BAR
#undef PG8_SCHED
}
}

typedef GAS unsigned gu32;
#define XB_TMO      128
#define XB_XCNT(j)  (256  + 64 * (j))
#define XB_XSUB(j)  (1280 + 64 * (j))
#define XB_XGEN(j)  (2304 + 64 * (j))
#define XB_TOP      3328
#define XB_TOPGEN   3392
#define XCD_BAR_WORDS 3456
#define XB_SPIN_CAP (1u << 18)
__device__ __forceinline__ unsigned xb_ld(unsigned* p)              { return __hip_atomic_load(p, __ATOMIC_RELAXED, __HIP_MEMORY_SCOPE_AGENT); }
__device__ __forceinline__ unsigned xb_add(unsigned* p, unsigned v) { return __hip_atomic_fetch_add(p, v, __ATOMIC_RELAXED, __HIP_MEMORY_SCOPE_AGENT); }
__device__ __forceinline__ unsigned xb_xcc_id() { return (unsigned)__builtin_amdgcn_s_getreg((3 << 11) | 20) & 0xFu; }
#define XB_SPIN(cond, bar) do { unsigned _sp = 0; while (cond) { __builtin_amdgcn_s_sleep(1); \
    if ((++_sp & 255u) == 0u) { if (xb_ld(&(bar)[XB_TMO])) break; if (_sp > XB_SPIN_CAP) { atomicAdd(&(bar)[XB_TMO], 1u); break; } } } } while (0)
struct XcdBarrier { unsigned* bar; unsigned x; volatile LAS unsigned* st; };
__device__ __forceinline__ XcdBarrier xcd_barrier_post(unsigned* bar, volatile LAS unsigned* st) {
    XcdBarrier b; b.bar = bar; b.x = xb_xcc_id(); b.st = st;
    if (threadIdx.x == 0) (void)xb_add(&bar[XB_XCNT(b.x)], 1u);
    return b;
}
__device__ __forceinline__ void xcd_barrier_complete(unsigned* bar, unsigned x, unsigned& nloc, unsigned& nx) {
    const unsigned G = gridDim.x * gridDim.y * gridDim.z;
    unsigned sum, cnt, mine, sp = 0u;
    for (;;) {
        sum = 0u; cnt = 0u; mine = 0u;
#pragma unroll
        for (unsigned j = 0; j < 16; ++j) { const unsigned c = xb_ld(&bar[XB_XCNT(j)]); sum += c; cnt += (c > 0u) ? 1u : 0u; mine = (j == x) ? c : mine; }
        if (sum == G) break;
        __builtin_amdgcn_s_sleep(1);
        if ((++sp & 255u) == 0u) { if (xb_ld(&bar[XB_TMO])) break; if (sp > XB_SPIN_CAP) { atomicAdd(&bar[XB_TMO], 1u); break; } }
    }
    nloc = mine > 0u ? mine : 1u; nx = cnt > 0u ? cnt : 1u;
}
__device__ __forceinline__ void xcd_barrier(const XcdBarrier& b) {
    asm volatile("s_waitcnt vmcnt(0)" ::: "memory");
    __syncthreads();
    if (threadIdx.x == 0) {
        unsigned* bar = b.bar;
        __builtin_amdgcn_s_waitcnt(0);
        unsigned nloc = b.st[0], nx = b.st[1];
        if (nloc == 0u) { xcd_barrier_complete(bar, b.x, nloc, nx); b.st[0] = nloc; b.st[1] = nx; }
        const unsigned old = xb_add(&bar[XB_XSUB(b.x)], 1u);
        const unsigned gen = old / nloc;
        if (old + 1u == (gen + 1u) * nloc) {
            __builtin_amdgcn_fence(__ATOMIC_RELEASE, "agent");
            asm volatile("s_waitcnt vmcnt(0)" ::: "memory");
            const unsigned og = xb_add(&bar[XB_TOP], 1u);
            const unsigned tg = og / nx;
            if (og + 1u == (tg + 1u) * nx) xb_add(&bar[XB_TOPGEN], 1u);
            else XB_SPIN(xb_ld(&bar[XB_TOPGEN]) == tg, bar);
            __builtin_amdgcn_fence(__ATOMIC_ACQUIRE, "agent");
            xb_add(&bar[XB_XGEN(b.x)], 1u);
            asm volatile("s_waitcnt vmcnt(0)" ::: "memory");
        } else {
            XB_SPIN(xb_ld(&bar[XB_XGEN(b.x)]) == gen, bar);
            __builtin_amdgcn_fence(__ATOMIC_ACQUIRE, "agent");
            asm volatile("s_waitcnt vmcnt(0)" ::: "memory");
        }
    }
    __syncthreads();
}

struct Frame {
    ldsp_t lds;
    volatile LAS unsigned* MISC;
    unsigned* ctl;
    int tid, lane, wave, vcu, G;
    const float* const* in;
    unsigned char* ws;
    float* out;
};
struct Args { const float* in[24]; float* out; unsigned char* ws; int ph_lo, ph_hi; };

__device__ __forceinline__ float wave_sum(float v) {
#pragma unroll
    for (int o = 1; o < 64; o <<= 1) v += __shfl_xor(v, o);
    return v;
}

__device__ __forceinline__ void p0_transpose_item(const float* W, int K, int N, bf16_t* WT, int ldk, const float* rowscale, float colscale, bool qkperm, LAS float* scr, int item, int lane) {
    const int nblk = N / 32, kb = item / nblk, nb = item % nblk, k0 = 64 * kb, n0 = 32 * nb;
    int srcn = n0 + (lane & 31);
    if (qkperm) { const int p = srcn & 63; srcn = (srcn & ~63) + ((p & 1) ? 32 + (p >> 1) : (p >> 1)); }
#pragma unroll 16
    for (int i = 0; i < 32; ++i) { const int kk = 2 * i + (lane >> 5); float v = W[(size_t)(k0 + kk) * N + srcn] * colscale; if (rowscale) v *= rowscale[k0 + kk]; scr[kk * 33 + (lane & 31)] = v; }
    LDS_WAIT(); asm volatile("" ::: "memory");
    const int c = lane & 7;
#pragma unroll
    for (int j = 0; j < 4; ++j) { const int n = (lane >> 3) + 8 * j; const LAS float* s = scr + (8 * c) * 33 + n;
        u32x4 o; o.x = pk2(s[0 * 33], s[1 * 33]); o.y = pk2(s[2 * 33], s[3 * 33]); o.z = pk2(s[4 * 33], s[5 * 33]); o.w = pk2(s[6 * 33], s[7 * 33]);
        *(u32x4*)(WT + (size_t)(n0 + n) * ldk + k0 + 8 * c) = o; }
    LDS_WAIT(); asm volatile("" ::: "memory");
}

__device__ __forceinline__ void p0_xrow(const float* xrow, bf16_t* orow, float* rss, int lane) {
    const f32x4* xr = (const f32x4*)xrow + lane;
    f32x4 v[4]; float s = 0.f;
#pragma unroll
    for (int j = 0; j < 4; ++j) { v[j] = xr[64 * j]; s += (v[j].x * v[j].x + v[j].y * v[j].y) + (v[j].z * v[j].z + v[j].w * v[j].w); }
    s = wave_sum(s);
    u32x2* o8 = (u32x2*)orow + lane;
#pragma unroll
    for (int j = 0; j < 4; ++j) { u32x2 w; w.x = pk2(v[j].x, v[j].y); w.y = pk2(v[j].z, v[j].w); o8[64 * j] = w; }
    if (lane == 0) *rss = s;
}

__device__ __forceinline__ void p0_tabrow(const float* row, unsigned char* img, float* isc, int e, int lane) {
    const f32x4* xr = (const f32x4*)row + lane;
    f32x4 v[4]; float am = 0.f;
#pragma unroll
    for (int j = 0; j < 4; ++j) { v[j] = xr[64 * j]; am = fmaxf(am, fmaxf(fmaxf(fabsf(v[j].x), fabsf(v[j].y)), fmaxf(fabsf(v[j].z), fabsf(v[j].w)))); }
#pragma unroll
    for (int o = 1; o < 64; o <<= 1) am = fmaxf(am, __shfl_xor(am, o));
    const float sc = am > 0.f ? exp2f(floorf(log2f(224.0f / am))) : 1.0f;
#pragma unroll
    for (int j = 0; j < 4; ++j) { const int col = 256 * j + 4 * lane, sl = col >> 7, w = col & 127;
        int pk = __builtin_amdgcn_cvt_pk_fp8_f32(v[j].x * sc, v[j].y * sc, 0, false);
        pk = __builtin_amdgcn_cvt_pk_fp8_f32(v[j].z * sc, v[j].w * sc, pk, true);
        *(int*)(img + ((size_t)sl * NEXP + e) * 128 + w) = pk; }
    if (lane == 0) isc[e] = 1.0f / sc;
}

__device__ __forceinline__ void p0_prologue(const Args& a, Frame& F) {
    unsigned char* ws = a.ws;
    LAS float* scr = (LAS float*)(F.lds + F.wave * 16384);
    const int gw = F.vcu * NWAVES + F.wave, NGW = F.G * NWAVES, lane = F.lane;
    constexpr int I_IN = (DM / 64) * (NIN / 32), I_SQ = (DM / 64) * (DM / 32), I_Q = (DM / 64) * (2048 / 32), I_G = 2;
    constexpr int PER_L = I_IN + 3 * I_SQ + I_Q + 32 * I_G;
    for (int it = gw; it < DEPTH * PER_L; it += NGW) {
        const int l = it / PER_L; int r = it % PER_L;
        if (r < I_IN) { const int nb = r % (NIN / 32), n0 = nb * 32; const int seg = n0 >> 9;
            p0_transpose_item(a.in[8] + (size_t)l * DM * NIN, DM, NIN, (bf16_t*)(ws + WS_WIN) + (size_t)l * NIN * DM, DM, a.in[5] + l * DM, seg == 1 ? 0.125f : 1.0f, seg <= 1, scr, r, lane); continue; }
        r -= I_IN;
        if (r < I_SQ) { p0_transpose_item(a.in[10] + (size_t)l * DM * DM, DM, DM, (bf16_t*)(ws + WS_WMIX + (size_t)l * 6 * MiB), DM, a.in[9] + l * DM, 1.0f, false, scr, r, lane); continue; }
        r -= I_SQ;
        if (r < I_SQ) { p0_transpose_item(a.in[18] + (size_t)l * DM * DM, DM, DM, (bf16_t*)(ws + WS_WMIX + (size_t)l * 6 * MiB + 2 * MiB), DM, nullptr, 1.0f, false, scr, r, lane); continue; }
        r -= I_SQ;
        if (r < I_SQ) { p0_transpose_item(a.in[19] + (size_t)l * DM * DM, DM, DM, (bf16_t*)(ws + WS_WMIX + (size_t)l * 6 * MiB + 4 * MiB), DM, nullptr, 1.0f, false, scr, r, lane); continue; }
        r -= I_SQ;
        if (r < I_Q) { p0_transpose_item(a.in[20] + (size_t)l * DM * 2048, DM, 2048, (bf16_t*)(ws + WS_WQ) + (size_t)l * 2048 * DM, DM, a.in[6] + l * DM, 1.0f, false, scr, r, lane); continue; }
        r -= I_Q;
        { const int mat = r >> 1, sub = r & 1, nb = mat >> 1, gsel = mat & 1;
          const float* W = (gsel ? a.in[15] : a.in[13]) + ((size_t)l * NBLK + nb) * BS * BS;
          bf16_t* WT = (bf16_t*)(ws + WS_WG) + (((size_t)l * NBLK + nb) * 2 + gsel) * BS * BS;
          p0_transpose_item(W, BS, BS, WT, BS, nullptr, 1.0f, false, scr, sub, lane); }
    }
    { const float* ksrc = a.in[21]; bf16_t* kdst = (bf16_t*)(ws + WS_KEYS); const int n4 = DEPTH * PH * 2 * NKEY * HK / 4;
      for (int i = gw * 64 + lane; i < n4; i += NGW * 64) { const f32x4 v = ((const f32x4*)ksrc)[i]; u32x2 o; o.x = pk2(v.x, v.y); o.y = pk2(v.z, v.w); ((u32x2*)kdst)[i] = o; } }
    for (int m = gw; m < MTOT; m += 2 * NGW) {
        const int m2 = m + NGW; const bool v2 = m2 < MTOT; const int mm2 = v2 ? m2 : m;
        const f32x4* x1 = (const f32x4*)(m < M_P ? a.in[0] + (size_t)m * DM : a.in[1] + (size_t)(m - M_P) * DM) + lane;
        const f32x4* x2 = (const f32x4*)(mm2 < M_P ? a.in[0] + (size_t)mm2 * DM : a.in[1] + (size_t)(mm2 - M_P) * DM) + lane;
        f32x4 v[8]; float s1 = 0.f, s2 = 0.f;
#pragma unroll
        for (int j = 0; j < 4; ++j) { v[j] = x1[64 * j]; v[4 + j] = x2[64 * j]; }
#pragma unroll
        for (int j = 0; j < 4; ++j) { s1 += (v[j].x * v[j].x + v[j].y * v[j].y) + (v[j].z * v[j].z + v[j].w * v[j].w); s2 += (v[4 + j].x * v[4 + j].x + v[4 + j].y * v[4 + j].y) + (v[4 + j].z * v[4 + j].z + v[4 + j].w * v[4 + j].w); }
        s1 = wave_sum(s1); s2 = wave_sum(s2);
        u32x2* o1 = (u32x2*)((bf16_t*)(ws + WS_XB) + (size_t)m * DM) + lane; u32x2* o2 = (u32x2*)((bf16_t*)(ws + WS_XB) + (size_t)mm2 * DM) + lane;
#pragma unroll
        for (int j = 0; j < 4; ++j) { u32x2 w; w.x = pk2(v[j].x, v[j].y); w.y = pk2(v[j].z, v[j].w); o1[64 * j] = w; }
        if (v2) {
#pragma unroll
            for (int j = 0; j < 4; ++j) { u32x2 w; w.x = pk2(v[4 + j].x, v[4 + j].y); w.y = pk2(v[4 + j].z, v[4 + j].w); o2[64 * j] = w; } }
        if (lane == 0) { ((float*)(ws + WS_RSS))[m] = s1; if (v2) ((float*)(ws + WS_RSS))[m2] = s2; }
    }
    { float* rot = (float*)(ws + WS_ROT);
      for (int i = gw * 64 + lane; i < 2056 * 32; i += NGW * 64) {
          const int pi = i >> 5, fi = i & 31; const double pos = pi < 2048 ? (double)pi : (double)(PAST + pi - 2048);
          const double f8[8] = {1.0, 0.7498942093324559, 0.5623413251903491, 0.4216965034285822, 0.31622776601683794, 0.23713737056616552, 0.1778279410038923, 0.1333521432163324};
          double fr = 1.0; switch (fi >> 3) { case 1: fr = 0.1; break; case 2: fr = 0.01; break; case 3: fr = 0.001; break; default: break; }
          double fsel = f8[0];
#pragma unroll
          for (int q = 1; q < 8; ++q) fsel = ((fi & 7) == q) ? f8[q] : fsel;
          const double ang = pos * (fr * fsel);
          const double n = __builtin_rint(ang * 0.15915494309189535);
          double rr = __builtin_fma(-n, 6.283185307179586, ang); rr = __builtin_fma(-n, 2.4492935982947064e-16, rr);
          const float rf = (float)rr;
          rot[(size_t)pi * 64 + fi] = cosf(rf); rot[(size_t)pi * 64 + 32 + fi] = sinf(rf);
      } }
}

__device__ __forceinline__ void tab_unit(const Args& a, Frame& F, int l, int cu) {
    unsigned char* ws = a.ws;
#pragma unroll 2
    for (int j = 0; j < 16; ++j) { const int r = cu * 128 + F.wave * 16 + j, t = r >> 14, e = r & (NEXP - 1);
        const float* src = (t ? a.in[23] : a.in[22]) + ((size_t)l * NEXP + e) * DM;
        p0_tabrow(src, ws + WS_TAB + ((size_t)l * 2 + t) * 16 * MiB, (float*)(ws + WS_TSC) + ((size_t)l * 2 + t) * NEXP, e, F.lane); }
}

namespace pg8 {
struct EpiIn {
    static constexpr bool PERM = true;
    bf16_t* P; const float* rss; const float* rot;
    __device__ __forceinline__ void operator()(const f32x4 (&acc)[2][2][4][2], const Unit& u, int wr, int wc, int fr, int fq) const {
        const int seg = u.pn < 4 ? (u.pn >> 1) : (u.pn >> 2) + 1;
        const int row0 = u.pm * BM + wr * 64 + fr;
        float rstdv[8];
#pragma unroll
        for (int i = 0; i < 8; ++i) rstdv[i] = rss[row0 + (i >> 2) * HALF + (i & 3) * 16];
#pragma unroll
        for (int i = 0; i < 8; ++i) rstdv[i] = rsqrtf(rstdv[i] * (1.0f / DM) + EPS);
        if (seg <= 1) {
            float lg[2];
#pragma unroll
            for (int bj = 0; bj < 2; ++bj) { const int hh = 4 * (u.pn & 1) + 2 * bj + (wc >> 1); lg[bj] = logg_of(hh); }
            const int i0 = 16 * (wc & 1) + 4 * fq;
#pragma unroll
            for (int ai = 0; ai < 2; ++ai)
#pragma unroll
                for (int m = 0; m < 4; ++m) {
                    const int row = row0 + ai * HALF + m * 16;
                    const float rstd = rstdv[ai * 4 + m];
                    const int pi = row < M_P ? (row & (SEQ - 1)) : SEQ + ((row - M_P) & (DECT - 1));
                    const float jj1 = (float)((row < M_P ? (row & (CH - 1)) : ((row - M_P) & (DECT - 1))) + 1);
                    const f32x4 c4 = *(const f32x4*)(rot + (size_t)pi * 64 + i0), s4 = *(const f32x4*)(rot + (size_t)pi * 64 + 32 + i0);
#pragma unroll
                    for (int bj = 0; bj < 2; ++bj) {
                        const int hh = 4 * (u.pn & 1) + 2 * bj + (wc >> 1);
                        const float f = __expf(seg == 0 ? jj1 * lg[bj] : -jj1 * lg[bj]) * rstd;
                        const f32x4 v0 = acc[ai][bj][m][0], v1 = acc[ai][bj][m][1];
                        const f32x4 x1 = (f32x4){v0[0], v0[2], v1[0], v1[2]}, x2 = (f32x4){v0[1], v0[3], v1[1], v1[3]};
                        const f32x4 o1 = (x1 * c4 - x2 * s4) * f, o2 = (x1 * s4 + x2 * c4) * f;
                        bf16_t* dst = P + (size_t)row * LDP + seg * 512 + hh * 64 + i0;
                        u32x2 w1, w2; w1.x = pk2(o1[0], o1[1]); w1.y = pk2(o1[2], o1[3]); w2.x = pk2(o2[0], o2[1]); w2.y = pk2(o2[2], o2[3]);
                        *(u32x2*)dst = w1; *(u32x2*)(dst + 32) = w2;
                    }
                    if (m & 1) asm volatile("" ::: "memory");
                }
        } else {
            const int col0 = u.pn * BM + wc * 32 + 8 * fq;
#pragma unroll
            for (int ai = 0; ai < 2; ++ai)
#pragma unroll
                for (int m = 0; m < 4; ++m) {
                    const int row = row0 + ai * HALF + m * 16;
                    const float rstd = rstdv[ai * 4 + m];
                    bf16_t* rowp = P + (size_t)row * LDP + col0;
#pragma unroll
                    for (int bj = 0; bj < 2; ++bj) {
                        f32x4 v0 = acc[ai][bj][m][0] * rstd, v1 = acc[ai][bj][m][1] * rstd;
                        if (seg == 3) {
#pragma unroll
                            for (int j = 0; j < 4; ++j) { v0[j] = siluf_(v0[j]); v1[j] = siluf_(v1[j]); }
                        } else if (seg == 5) {
#pragma unroll
                            for (int j = 0; j < 4; ++j) { v0[j] = geluf_(v0[j]); v1[j] = geluf_(v1[j]); }
                        } else if (seg >= 6) {
#pragma unroll
                            for (int j = 0; j < 4; ++j) { v0[j] = sigmoidf_(v0[j]); v1[j] = sigmoidf_(v1[j]); }
                        }
                        u32x4 w; w.x = pk2(v0[0], v0[1]); w.y = pk2(v0[2], v0[3]); w.z = pk2(v1[0], v1[1]); w.w = pk2(v1[2], v1[3]);
                        *(u32x4*)(rowp + bj * HALF) = w;
                    }
                }
        }
    }
};

struct EpiMerge {
    static constexpr bool PERM = true;
    bf16_t* P;
    __device__ __forceinline__ void operator()(const f32x4 (&acc)[2][2][4][2], const Unit& u, int wr, int wc, int fr, int fq) const {
        const int row0 = u.pm * BM + wr * 64 + fr, col0 = u.pn * BM + wc * 32 + 8 * fq;
        const int gc = u.half ? PC_GB : PC_GA;
#pragma unroll
        for (int ai = 0; ai < 2; ++ai)
#pragma unroll
            for (int m = 0; m < 4; ++m) {
                bf16_t* rowp = P + (size_t)(row0 + ai * HALF + m * 16) * LDP;
#pragma unroll
                for (int bj = 0; bj < 2; ++bj) {
                    const int c = col0 + bj * HALF;
                    const u32x4 g = *(const u32x4*)(rowp + gc + c);
                    f32x4 v0 = acc[ai][bj][m][0], v1 = acc[ai][bj][m][1];
                    v0[0] *= bflo(g.x); v0[1] *= bfhi(g.x); v0[2] *= bflo(g.y); v0[3] *= bfhi(g.y);
                    v1[0] *= bflo(g.z); v1[1] *= bfhi(g.z); v1[2] *= bflo(g.w); v1[3] *= bfhi(g.w);
                    if (u.half) { const u32x4 p = *(const u32x4*)(rowp + PC_MRG + c);
                        v0[0] += bflo(p.x); v0[1] += bfhi(p.x); v0[2] += bflo(p.y); v0[3] += bfhi(p.y);
                        v1[0] += bflo(p.z); v1[1] += bfhi(p.z); v1[2] += bflo(p.w); v1[3] += bfhi(p.w); }
                    u32x4 w; w.x = pk2(v0[0], v0[1]); w.y = pk2(v0[2], v0[3]); w.z = pk2(v1[0], v1[1]); w.w = pk2(v1[2], v1[3]);
                    *(u32x4*)(rowp + PC_MRG + c) = w;
                }
                if (m & 1) asm volatile("" ::: "memory");
            }
    }
};

struct EpiWo {
    static constexpr bool PERM = false;
    const float* xp; const float* xs;
    float* X; bf16_t* XB; float* rssp;
    __device__ __forceinline__ void operator()(const f32x4 (&acc)[2][2][4][2], const Unit& u, int wr, int wc, int fr, int fq) const {
        const int row0 = u.pm * BM + wr * 64 + fr, col0 = u.pn * BM + wc * 32 + 4 * fq;
#pragma unroll
        for (int ai = 0; ai < 2; ++ai)
#pragma unroll
            for (int m = 0; m < 4; ++m) {
                const int row = row0 + ai * HALF + m * 16;
                const float* src = (row < M_P ? xp + (size_t)row * DM : xs + (size_t)(row - M_P) * DM) + col0;
                float* dst = X + (size_t)row * DM + col0; bf16_t* dstb = XB + (size_t)row * DM + col0;
                float ss = 0.f;
#pragma unroll
                for (int bj = 0; bj < 2; ++bj)
#pragma unroll
                    for (int n = 0; n < 2; ++n) {
                        const f32x4 o = *(const f32x4*)(src + bj * HALF + n * 16) + acc[ai][bj][m][n];
                        *(f32x4*)(dst + bj * HALF + n * 16) = o;
                        u32x2 w; w.x = pk2(o[0], o[1]); w.y = pk2(o[2], o[3]); *(u32x2*)(dstb + bj * HALF + n * 16) = w;
                        ss += (o[0] * o[0] + o[1] * o[1]) + (o[2] * o[2] + o[3] * o[3]);
                    }
                ss += __shfl_xor(ss, 16); ss += __shfl_xor(ss, 32);
                if (fq == 0) rssp[(size_t)(u.pn * 4 + wc) * MTOT + row] = ss;
                if (m & 1) asm volatile("" ::: "memory");
            }
    }
};

struct EpiQ {
    static constexpr bool PERM = true;
    bf16_t* P; const float* rssp; float* rss2;
    __device__ __forceinline__ void operator()(const f32x4 (&acc)[2][2][4][2], const Unit& u, int wr, int wc, int fr, int fq) const {
        const int row0 = u.pm * BM + wr * 64 + fr, col0 = u.pn * BM + wc * 32 + 8 * fq;
        float rstdv[8];
#pragma unroll
        for (int i = 0; i < 8; ++i) { const int row = row0 + (i >> 2) * HALF + (i & 3) * 16; float s = 0.f;
#pragma unroll
            for (int j = 0; j < 16; ++j) s += rssp[(size_t)j * MTOT + row];
            if (u.pn == 0 && wc == 0 && fq == 0) rss2[row] = s;
            rstdv[i] = rsqrtf(s * (1.0f / DM) + EPS);
            if ((i & 1)) asm volatile("" ::: "memory"); }
#pragma unroll
        for (int ai = 0; ai < 2; ++ai)
#pragma unroll
            for (int m = 0; m < 4; ++m) {
                const int row = row0 + ai * HALF + m * 16;
                const float rstd = rstdv[ai * 4 + m];
                bf16_t* rowp = P + (size_t)row * LDP + PC_QP + col0;
#pragma unroll
                for (int bj = 0; bj < 2; ++bj) {
                    const f32x4 v0 = acc[ai][bj][m][0] * rstd, v1 = acc[ai][bj][m][1] * rstd;
                    u32x4 w; w.x = pk2(v0[0], v0[1]); w.y = pk2(v0[2], v0[3]); w.z = pk2(v1[0], v1[1]); w.w = pk2(v1[2], v1[3]);
                    *(u32x4*)(rowp + bj * HALF) = w;
                }
            }
    }
};
}

__device__ __forceinline__ void mma32(f32x16& acc, ldsp_t A, int lda_b, ldsp_t Bt, int ldb_b, int ksteps, int lane) {
    ldsp_t ap = A + (lane & 31) * lda_b + (lane >> 5) * 16;
    ldsp_t bp = Bt + (lane & 31) * ldb_b + (lane >> 5) * 16;
    for (int ks = 0; ks < ksteps; ++ks) {
        const bf16x8 a = *(const LAS bf16x8*)(ap + ks * 32), b = *(const LAS bf16x8*)(bp + ks * 32);
        acc = __builtin_amdgcn_mfma_f32_32x32x16_bf16(a, b, acc, 0, 0, 0);
    }
}
#define ZERO16 ((f32x16){0.f,0.f,0.f,0.f,0.f,0.f,0.f,0.f,0.f,0.f,0.f,0.f,0.f,0.f,0.f,0.f})

constexpr int R_QS = 0, R_KS = 18432, R_KST = 36864, R_VST = 54272, R_SS = 89088, R_RST = 123904, R_ST = 142336;
constexpr int LD64 = 144, LD128 = 272;
__device__ __forceinline__ void ret_prompt_unit(const Args& a, Frame& F, int l, int b, int h) {
    const int tid = F.tid, lane = F.lane, w = F.wave, hi = lane >> 5, l31 = lane & 31;
    ldsp_t lds = F.lds;
    bf16_t* P = (bf16_t*)(a.ws + WS_P);
    const float lg = logg_of(h), G = __expf(128.0f * lg);
    f32x16 racc = ZERO16;
    const int db = w >> 2, eb = w & 3;
    u32x4 pq[2], pk[2], pv[4];
#define RET_FETCH(nn) do { const bf16_t* _r0 = P + ((size_t)b * SEQ + (nn) * CH + 2 * lane) * LDP; \
        pq[0] = *(const u32x4*)(_r0 + PC_Q + h * 64 + w * 8); pq[1] = *(const u32x4*)(_r0 + LDP + PC_Q + h * 64 + w * 8); \
        pk[0] = *(const u32x4*)(_r0 + PC_K + h * 64 + w * 8); pk[1] = *(const u32x4*)(_r0 + LDP + PC_K + h * 64 + w * 8); \
        pv[0] = *(const u32x4*)(_r0 + PC_V + h * 128 + w * 16); pv[1] = *(const u32x4*)(_r0 + LDP + PC_V + h * 128 + w * 16); \
        pv[2] = *(const u32x4*)(_r0 + PC_V + h * 128 + w * 16 + 8); pv[3] = *(const u32x4*)(_r0 + LDP + PC_V + h * 128 + w * 16 + 8); } while (0)
    RET_FETCH(0);
    for (int n = 0; n < 16; ++n) {
        const size_t tok0 = (size_t)b * SEQ + n * CH;
        *(LAS u32x4*)(lds + R_QS + (2 * lane) * LD64 + w * 16) = pq[0]; *(LAS u32x4*)(lds + R_QS + (2 * lane + 1) * LD64 + w * 16) = pq[1];
        *(LAS u32x4*)(lds + R_KS + (2 * lane) * LD64 + w * 16) = pk[0]; *(LAS u32x4*)(lds + R_KS + (2 * lane + 1) * LD64 + w * 16) = pk[1];
        { const unsigned a0[4] = {pk[0].x, pk[0].y, pk[0].z, pk[0].w}, a1[4] = {pk[1].x, pk[1].y, pk[1].z, pk[1].w};
#pragma unroll
          for (int j = 0; j < 4; ++j) { *(LAS unsigned*)(lds + R_KST + (w * 8 + 2 * j) * LD128 + lane * 4) = (a0[j] & 0xffffu) | (a1[j] << 16);
                                        *(LAS unsigned*)(lds + R_KST + (w * 8 + 2 * j + 1) * LD128 + lane * 4) = (a0[j] >> 16) | (a1[j] & 0xffff0000u); } }
#pragma unroll
        for (int c = 0; c < 2; ++c) { const unsigned a0[4] = {pv[2 * c].x, pv[2 * c].y, pv[2 * c].z, pv[2 * c].w}, a1[4] = {pv[2 * c + 1].x, pv[2 * c + 1].y, pv[2 * c + 1].z, pv[2 * c + 1].w};
#pragma unroll
            for (int j = 0; j < 4; ++j) { *(LAS unsigned*)(lds + R_VST + ((2 * w + c) * 8 + 2 * j) * LD128 + lane * 4) = (a0[j] & 0xffffu) | (a1[j] << 16);
                                          *(LAS unsigned*)(lds + R_VST + ((2 * w + c) * 8 + 2 * j + 1) * LD128 + lane * 4) = (a0[j] >> 16) | (a1[j] & 0xffff0000u); } }
        if (n + 1 < 16) RET_FETCH(n + 1);
#pragma unroll
        for (int g = 0; g < 4; ++g) { u32x2 wv; wv.x = pk2(racc[4 * g], racc[4 * g + 1]); wv.y = pk2(racc[4 * g + 2], racc[4 * g + 3]);
            *(LAS u32x2*)(lds + R_RST + (32 * eb + l31) * LD64 + (32 * db + 8 * g + 4 * hi) * 2) = wv; }
        __syncthreads();
#pragma unroll
        for (int t2 = 0; t2 < 2; ++t2) { const int t = 2 * w + t2, mb = t >> 2, jb = t & 3;
            if (mb <= jb) { f32x16 sacc = ZERO16;
                mma32(sacc, lds + R_KS + mb * 32 * LD64, LD64, lds + R_QS + jb * 32 * LD64, LD64, 4, lane);
                const int j = 32 * jb + l31;
#pragma unroll
                for (int g = 0; g < 4; ++g) { const int m0 = 32 * mb + 8 * g + 4 * hi; float v[4];
#pragma unroll
                    for (int q = 0; q < 4; ++q) v[q] = (j >= m0 + q) ? sacc[4 * g + q] : 0.f;
                    u32x2 wv; wv.x = pk2(v[0], v[1]); wv.y = pk2(v[2], v[3]);
                    *(LAS u32x2*)(lds + R_SS + j * LD128 + m0 * 2) = wv; } } }
        __syncthreads();
        const int jb = w >> 1, eh = w & 1;
        f32x16 oacc[2];
#pragma unroll
        for (int t = 0; t < 2; ++t) { oacc[t] = ZERO16; const int e2 = 2 * eh + t;
            mma32(oacc[t], lds + R_RST + e2 * 32 * LD64, LD64, lds + R_QS + jb * 32 * LD64, LD64, 4, lane);
            mma32(oacc[t], lds + R_VST + e2 * 32 * LD128, LD128, lds + R_SS + jb * 32 * LD128, LD128, 2 * (jb + 1), lane); }
        float s1 = 0.f, s2 = 0.f;
#pragma unroll
        for (int t = 0; t < 2; ++t)
#pragma unroll
            for (int r = 0; r < 16; ++r) { s1 += oacc[t][r]; s2 += oacc[t][r] * oacc[t][r]; }
        s1 += __shfl_xor(s1, 32); s2 += __shfl_xor(s2, 32);
        if (hi == 0) *(LAS f32x2*)(lds + R_ST + (eh * 128 + 32 * jb + l31) * 8) = (f32x2){s1, s2};
        __syncthreads();
        { const int j = 32 * jb + l31;
          const f32x2 sa = *(const LAS f32x2*)(lds + R_ST + j * 8), sb = *(const LAS f32x2*)(lds + R_ST + (128 + j) * 8);
          const float mu = (sa.x + sb.x) * (1.0f / DV), var = (sa.y + sb.y) * (1.0f / DV) - mu * mu, rstd = rsqrtf(fmaxf(var, 0.f) + EPS);
          bf16_t* prow = P + (tok0 + j) * LDP + h * 128;
#pragma unroll
          for (int t = 0; t < 2; ++t)
#pragma unroll
              for (int g = 0; g < 4; ++g) { const int e0 = 32 * (2 * eh + t) + 8 * g + 4 * hi;
                  const u32x2 gv = *(const u32x2*)(prow + PC_GR + e0);
                  const float o0 = (oacc[t][4 * g] - mu) * rstd * bflo(gv.x), o1 = (oacc[t][4 * g + 1] - mu) * rstd * bfhi(gv.x);
                  const float o2 = (oacc[t][4 * g + 2] - mu) * rstd * bflo(gv.y), o3 = (oacc[t][4 * g + 3] - mu) * rstd * bfhi(gv.y);
                  u32x2 wv; wv.x = pk2(o0, o1); wv.y = pk2(o2, o3);
                  *(u32x2*)(prow + PC_ARET + e0) = wv; } }
        mma32(racc, lds + R_KST + db * 32 * LD128, LD128, lds + R_VST + eb * 32 * LD128, LD128, 8, lane);
#pragma unroll
        for (int r = 0; r < 16; ++r) racc[r] *= G;
        __syncthreads();
    }
    float* so = a.out + O_SRP + ((((size_t)l * NBATCH + b) * HR + h) * DK) * DV;
#pragma unroll
    for (int r = 0; r < 16; ++r) { const int d = 32 * db + (r & 3) + 8 * (r >> 2) + 4 * hi; so[(size_t)d * DV + 32 * eb + l31] = racc[r]; }
#undef RET_FETCH
}

__device__ __forceinline__ void ret_sample_unit(const Args& a, Frame& F, int l, int bs, int h) {
    const int tid = F.tid, lane = F.lane, w = F.wave;
    LAS float* qd = (LAS float*)F.lds; LAS float* ku = qd + 512; LAS float* vv = ku + 512; LAS float* S = vv + 1024; LAS float* crossp = S + 64; LAS float* red = crossp + 4096;
    bf16_t* P = (bf16_t*)(a.ws + WS_P);
    const size_t tok0 = (size_t)M_P + bs * DECT;
    { const int j = tid >> 6, d = tid & 63; const bf16_t* src = P + (tok0 + j) * LDP + h * 64 + d; qd[tid] = bf1(src[PC_Q]); ku[tid] = bf1(src[PC_K]); }
#pragma unroll
    for (int i = 0; i < 2; ++i) { const int idx = tid + 512 * i, m = idx >> 7, e = idx & 127; vv[idx] = bf1(P[(tok0 + m) * LDP + PC_V + h * 128 + e]); }
    __syncthreads();
    const int dg = tid >> 7, e = tid & 127;
    const size_t soff = ((((size_t)l * DECB + bs) * HR + h) * DK) * DV;
    const float* r0 = a.in[2] + soff; float* rn = a.out + O_SRS + soff;
    const float lg = logg_of(h), G8 = __expf(8.0f * lg);
    float cross[8];
#pragma unroll
    for (int j = 0; j < 8; ++j) cross[j] = 0.f;
    float rv[16];
#pragma unroll
    for (int dd = 0; dd < 16; ++dd) rv[dd] = r0[(size_t)(dg * 16 + dd) * DV + e];
#pragma unroll
    for (int dd = 0; dd < 16; ++dd) { const int d = dg * 16 + dd; const float r = rv[dd]; float kvs = 0.f;
#pragma unroll
        for (int m = 0; m < 8; ++m) kvs += ku[m * 64 + d] * vv[m * 128 + e];
        rn[(size_t)d * DV + e] = G8 * (r + kvs);
#pragma unroll
        for (int j = 0; j < 8; ++j) cross[j] += qd[j * 64 + d] * r; }
#pragma unroll
    for (int j = 0; j < 8; ++j) crossp[(dg * 8 + j) * 128 + e] = cross[j];
    { const int pr = tid >> 3, part = tid & 7, j = pr >> 3, m = pr & 7; float sp = 0.f;
#pragma unroll
      for (int d = 0; d < 8; ++d) sp += qd[j * 64 + part * 8 + d] * ku[m * 64 + part * 8 + d];
      sp += __shfl_xor(sp, 1); sp += __shfl_xor(sp, 2); sp += __shfl_xor(sp, 4);
      if (part == 0) S[pr] = (j >= m) ? sp : 0.f; }
    __syncthreads();
    float o[2];
#pragma unroll
    for (int jj = 0; jj < 2; ++jj) { const int j = dg + 4 * jj; float s = 0.f;
#pragma unroll
        for (int g = 0; g < 4; ++g) s += crossp[(g * 8 + j) * 128 + e];
#pragma unroll
        for (int m = 0; m < 8; ++m) s += S[j * 8 + m] * vv[m * 128 + e];
        o[jj] = s;
        const float t1 = wave_sum(s), t2 = wave_sum(s * s);
        if (lane == 0) { red[(jj * 8 + w) * 2] = t1; red[(jj * 8 + w) * 2 + 1] = t2; } }
    __syncthreads();
#pragma unroll
    for (int jj = 0; jj < 2; ++jj) { const int j = dg + 4 * jj, w0 = 2 * dg;
        const float t1 = red[(jj * 8 + w0) * 2] + red[(jj * 8 + w0 + 1) * 2], t2 = red[(jj * 8 + w0) * 2 + 1] + red[(jj * 8 + w0 + 1) * 2 + 1];
        const float mu = t1 * (1.0f / DV), var = t2 * (1.0f / DV) - mu * mu, rstd = rsqrtf(fmaxf(var, 0.f) + EPS);
        bf16_t* prow = P + (tok0 + j) * LDP + h * 128 + e;
        prow[PC_ARET] = (bf16_t)f2bf((o[jj] - mu) * rstd * bf1(prow[PC_GR])); }
    __syncthreads();
}

constexpr int N_XRL = 0, N_XCF = 33536, N_XCB = 66304, N_WGT = 84736, N_CAR = 103168, N_BUF = 107264;
__device__ __forceinline__ void rnn_unit(const Args& a, Frame& F, int l, bool sample, int bg, int nb) {
    const int tid = F.tid, lane = F.lane, w = F.wave, hi = lane >> 5, l31 = lane & 31;
    ldsp_t lds = F.lds;
    LAS float* xrl = (LAS float*)(lds + N_XRL); LAS float* xcf = (LAS float*)(lds + N_XCF); LAS float* car = (LAS float*)(lds + N_CAR); LAS float* bufl = (LAS float*)(lds + N_BUF);
    LAS float* aa = xrl; LAS float* uu = xcf;
    bf16_t* P = (bf16_t*)(a.ws + WS_P);
    const int ch0 = nb * BS;
    { const bf16_t* wg = (const bf16_t*)(a.ws + WS_WG) + ((size_t)l * NBLK + nb) * 2 * BS * BS;
#pragma unroll
      for (int i = 0; i < 2; ++i) { const int p = tid + 512 * i, row = p >> 3, c8 = p & 7; *(LAS u32x4*)(lds + N_WGT + row * LD64 + c8 * 16) = *(const u32x4*)(wg + row * 64 + c8 * 8); } }
    const int cc = tid & 63;
    const float* cwp = a.in[11] + (size_t)l * 4 * DM + ch0 + cc;
    const float cw0 = cwp[0], cw1 = cwp[DM], cw2 = cwp[2 * DM], cw3 = cwp[3 * DM], cbv = a.in[12][l * DM + ch0 + cc];
    const int rb = w >> 1, cb = w & 1, dcol = 32 * cb + l31;
    const float bav = a.in[14][l * DM + ch0 + dcol], bxv = a.in[16][l * DM + ch0 + dcol];
    const float spl = log1pf(__expf(-a.in[17][l * DM + ch0 + dcol]));
    const int ntiles = sample ? 1 : 16;
    float hcar = 0.f;
    if (sample) {
        for (int i = tid; i < 16 * 3 * 64; i += NTHREADS) { const int s = i / 192, r = (i / 64) % 3, c = i & 63;
            bufl[i] = a.in[4][(((size_t)l * DECB + bg * 16 + s) * 3 + r) * DM + ch0 + c]; }
    }
    u32x4 pre[3];
#define RNN_FETCH(nn) do { const size_t _t0 = sample ? (size_t)M_P + bg * 128 : (size_t)bg * SEQ + (nn) * 128; _Pragma("unroll") for (int k = 0; k < 3; ++k) { \
        const int p = tid + 512 * k, row = p >> 3, c8 = p & 7; pre[k] = (u32x4){0u, 0u, 0u, 0u}; \
        if (p < 131 * 8 && (row >= 3 || (!sample && (nn) > 0))) pre[k] = *(const u32x4*)(P + (_t0 + row - 3) * LDP + PC_XR + ch0 + c8 * 8); } } while (0)
    RNN_FETCH(0);
    for (int n = 0; n < ntiles; ++n) {
        const size_t tok0 = sample ? (size_t)M_P + bg * 128 : (size_t)bg * SEQ + n * 128;
        unsigned short gl[16];
#pragma unroll
        for (int i = 0; i < 16; ++i) gl[i] = P[(tok0 + 16 * w + i) * LDP + PC_GN + ch0 + cc];
#pragma unroll
        for (int k = 0; k < 3; ++k) { const int p = tid + 512 * k, row = p >> 3, c8 = p & 7;
            if (p < 131 * 8) { const u32x4 v = pre[k]; LAS float* d = xrl + row * 64 + c8 * 8;
                *(LAS f32x4*)d = (f32x4){bflo(v.x), bfhi(v.x), bflo(v.y), bfhi(v.y)}; *(LAS f32x4*)(d + 4) = (f32x4){bflo(v.z), bfhi(v.z), bflo(v.w), bfhi(v.w)}; } }
        __syncthreads();
        if (n + 1 < ntiles) RNN_FETCH(n + 1);
        { const int tg = tid >> 6;
#pragma unroll 4
          for (int i = 0; i < 16; ++i) { const int t = tg * 16 + i; float x0, x1, x2;
              const float x3 = xrl[(t + 3) * 64 + cc];
              if (sample) { const int s = t >> 3, j = t & 7;
                  x0 = j >= 3 ? xrl[t * 64 + cc] : bufl[(s * 3 + j) * 64 + cc];
                  x1 = j >= 2 ? xrl[(t + 1) * 64 + cc] : bufl[(s * 3 + j + 1) * 64 + cc];
                  x2 = j >= 1 ? xrl[(t + 2) * 64 + cc] : bufl[(s * 3 + j + 2) * 64 + cc];
              } else { x0 = xrl[t * 64 + cc]; x1 = xrl[(t + 1) * 64 + cc]; x2 = xrl[(t + 2) * 64 + cc]; }
              const float xc = cbv + cw0 * x0 + cw1 * x1 + cw2 * x2 + cw3 * x3;
              xcf[t * 64 + cc] = xc; *(LAS bf16_t*)(lds + N_XCB + t * LD64 + cc * 2) = (bf16_t)f2bf(xc); } }
        if (sample) { if (tid < 192) { }     }
        if (sample) { for (int i = tid; i < 16 * 3 * 64; i += NTHREADS) { const int s = i / 192, r = (i / 64) % 3, c = i & 63;
                a.out[O_SCS + (((size_t)l * DECB + bg * 16 + s) * 3 + r) * DM + ch0 + c] = xrl[(3 + s * 8 + 5 + r) * 64 + c]; } }
        else if (n == 15) { if (tid < 192) { const int r = tid >> 6, c = tid & 63; a.out[O_SCP + (((size_t)l * NBATCH + bg) * 3 + r) * DM + ch0 + c] = xrl[(3 + 125 + r) * 64 + c]; } }
        __syncthreads();
        { f32x16 ar = ZERO16, ai = ZERO16;
          mma32(ar, lds + N_XCB + rb * 32 * LD64, LD64, lds + N_WGT + (32 * cb) * LD64, LD64, 4, lane);
          mma32(ai, lds + N_XCB + rb * 32 * LD64, LD64, lds + N_WGT + (64 + 32 * cb) * LD64, LD64, 4, lane);
#pragma unroll
          for (int r = 0; r < 16; ++r) { const int t = 32 * rb + (r & 3) + 8 * (r >> 2) + 4 * hi;
              const float rg = sigmoidf_(ar[r] + bav), ig = sigmoidf_(ai[r] + bxv);
              const float la = -8.0f * rg * spl, av = __expf(la), mult = sqrtf(fmaxf(-expm1f(2.0f * la), 0.f));
              const float xc = xcf[t * 64 + dcol];
              aa[t * 64 + dcol] = av; uu[t * 64 + dcol] = mult * ig * xc; } }
        __syncthreads();
        if (!sample) {
            float Ap = 1.f, Hl = 0.f;
#pragma unroll 4
            for (int i = 0; i < 16; ++i) { const int t = 16 * w + i; const float av = aa[t * 64 + cc], uv = uu[t * 64 + cc]; Hl = av * Hl + uv; Ap *= av; }
            car[w * 64 + cc] = Ap; car[512 + w * 64 + cc] = Hl;
            __syncthreads();
            float hin = hcar, hnext = hcar;
#pragma unroll
            for (int w2 = 0; w2 < 8; ++w2) { const float A2 = car[w2 * 64 + cc], H2 = car[512 + w2 * 64 + cc]; hnext = A2 * hnext + H2; if (w2 < w) hin = hnext; }
            float hh = hin;
#pragma unroll
            for (int i = 0; i < 16; ++i) { const int t = 16 * w + i; hh = aa[t * 64 + cc] * hh + uu[t * 64 + cc];
                P[(tok0 + t) * LDP + PC_GN + ch0 + cc] = (bf16_t)f2bf(hh * bf1(gl[i])); }
            hcar = hnext;
        } else {
#pragma unroll
            for (int s2 = 0; s2 < 2; ++s2) { const int s = 2 * w + s2, bs = bg * 16 + s;
                float hh = a.in[3][((size_t)l * DECB + bs) * DM + ch0 + cc];
#pragma unroll
                for (int j = 0; j < 8; ++j) { const int t = s * 8 + j; hh = aa[t * 64 + cc] * hh + uu[t * 64 + cc];
                    P[(tok0 + t) * LDP + PC_GN + ch0 + cc] = (bf16_t)f2bf(hh * bf1(gl[s2 * 8 + j])); }
                a.out[O_SHS + ((size_t)l * DECB + bs) * DM + ch0 + cc] = hh; }
        }
        __syncthreads();
    }
    if (!sample && w == 0) a.out[O_SHP + ((size_t)l * NBATCH + bg) * DM + ch0 + cc] = hcar;
#undef RNN_FETCH
}

__device__ __forceinline__ unsigned ord_of(float f) { const unsigned u = __builtin_bit_cast(unsigned, f); return u ^ ((u >> 31) ? 0xFFFFFFFFu : 0x80000000u); }
__device__ __forceinline__ float ord_inv(unsigned o) { const unsigned u = (o >> 31) ? (o ^ 0x80000000u) : ~o; return __builtin_bit_cast(float, u); }
__host__ __device__ constexpr bool cand_ok(int a, int b) { return (a + 1) * (b + 1) <= 16; }

__device__ __forceinline__ void route_unit(const Args& a, int l, int tb, int h, int lane) {
    const int hi = lane >> 5, l31 = lane & 31, token = tb * 32 + l31;
    const bf16_t* P = (const bf16_t*)(a.ws + WS_P);
    const bf16_t* qrow = P + (size_t)token * LDP + PC_QP + h * 256 + hi * 8;
    const bf16_t* kbase = (const bf16_t*)(a.ws + WS_KEYS) + ((size_t)(l * PH + h) * 2) * NKEY * HK + (size_t)l31 * HK + hi * 8;
    unsigned L[2][16];
#pragma unroll
    for (int p = 0; p < 2; ++p) {
        f32x16 acc[4];
#pragma unroll
        for (int kb = 0; kb < 4; ++kb) acc[kb] = ZERO16;
#pragma unroll 2
        for (int ks = 0; ks < 8; ++ks) {
            const bf16x8 bq = *(const bf16x8*)(qrow + p * 128 + ks * 16);
#pragma unroll
            for (int kb = 0; kb < 4; ++kb) { const bf16x8 ak = *(const bf16x8*)(kbase + ((size_t)p * NKEY + kb * 32) * HK + ks * 16);
                acc[kb] = __builtin_amdgcn_mfma_f32_32x32x16_bf16(ak, bq, acc[kb], 0, 0, 0); }
        }
        unsigned pk[64];
#pragma unroll
        for (int kb = 0; kb < 4; ++kb)
#pragma unroll
            for (int r = 0; r < 16; ++r) { const int key = 32 * kb + (r & 3) + 8 * (r >> 2) + 4 * hi; pk[kb * 16 + r] = (ord_of(acc[kb][r]) & ~127u) | (unsigned)(127 - key); }
        unsigned prev = 0xFFFFFFFFu;
#pragma unroll
        for (int it = 0; it < 16; ++it) { unsigned m = 0u;
#pragma unroll
            for (int i = 0; i < 64; ++i) { const unsigned t = pk[i] < prev ? pk[i] : 0u; m = m > t ? m : t; }
            const unsigned o = (unsigned)__shfl_xor((int)m, 32); m = m > o ? m : o; L[p][it] = m; prev = m; }
    }
    float sa[16], sb[16];
#pragma unroll
    for (int i = 0; i < 16; ++i) { sa[i] = ord_inv(L[0][i] & ~127u); sb[i] = ord_inv(L[1][i] & ~127u); }
    unsigned ck[50];
    { int n = 0;
#pragma unroll
      for (int x = 0; x < 16; ++x)
#pragma unroll
          for (int y = 0; y < 16; ++y) if (cand_ok(x, y)) { ck[n] = (ord_of(sa[x] + sb[y]) & ~255u) | (unsigned)(255 - (x * 16 + y)); ++n; } }
    unsigned best[16];
    { unsigned prev = 0xFFFFFFFFu;
#pragma unroll
      for (int it = 0; it < 16; ++it) { unsigned m = 0u;
#pragma unroll
          for (int i = 0; i < 50; ++i) { const unsigned t = ck[i] < prev ? ck[i] : 0u; m = m > t ? m : t; }
          best[it] = m; prev = m; } }
    float sc[16], ssum = 0.f; const float mx = ord_inv(best[0] & ~255u);
#pragma unroll
    for (int it = 0; it < 16; ++it) { sc[it] = __expf(ord_inv(best[it] & ~255u) - mx); ssum += sc[it]; }
    const float inv = 1.0f / ssum;
    unsigned* eo = (unsigned*)(a.ws + WS_EIDX) + (size_t)token * 128 + h * 16 + hi * 8;
    float* go = (float*)(a.ws + WS_GATE) + (size_t)token * 128 + h * 16 + hi * 8;
#pragma unroll
    for (int it = 0; it < 8; ++it) {
        unsigned b0 = best[it], b1 = best[it + 8]; float g0 = sc[it], g1 = sc[it + 8];
        asm volatile("" : "+v"(b0), "+v"(b1), "+v"(g0), "+v"(g1));
        const unsigned bsel = hi ? b1 : b0; const float gsel = (hi ? g1 : g0) * inv;
        const unsigned c = 255u - (bsel & 255u), ca = c >> 4, cb = c & 15u;
        unsigned k1 = 0u, k2 = 0u;
#pragma unroll
        for (int i = 0; i < 16; ++i) { k1 = (ca == (unsigned)i) ? (127u - (L[0][i] & 127u)) : k1; k2 = (cb == (unsigned)i) ? (127u - (L[1][i] & 127u)) : k2; }
        eo[it] = k1 * 128u + k2; go[it] = gsel;
    }
}

constexpr int MAXT = 9;
__device__ __forceinline__ void dec16(const u32x4 r, float (&f)[16]) {
    const unsigned w[4] = {r.x, r.y, r.z, r.w};
#pragma unroll
    for (int j = 0; j < 4; ++j) { const f32x2 a = __builtin_amdgcn_cvt_pk_f32_fp8((int)w[j], false), b = __builtin_amdgcn_cvt_pk_f32_fp8((int)w[j], true);
        f[4 * j] = a.x; f[4 * j + 1] = a.y; f[4 * j + 2] = b.x; f[4 * j + 3] = b.y; }
}
__device__ __forceinline__ void peer_phase(const Args& a, Frame& F, int l, bool lastlayer) {
    const int lane = F.lane, l7 = lane & 7, lg3 = lane >> 3;
    const int gw = F.vcu * NWAVES + F.wave, NGW = F.G * NWAVES;
    const unsigned char* TU = a.ws + WS_TAB + ((size_t)l * 2) * 16 * MiB;
    const unsigned char* TV = a.ws + WS_TAB + ((size_t)l * 2 + 1) * 16 * MiB;
    const float* SCU = (const float*)(a.ws + WS_TSC) + ((size_t)l * 2) * NEXP; const float* SCV = SCU + NEXP;
    bf16_t* XB = (bf16_t*)(a.ws + WS_XB); float* X = a.out;
    const unsigned* EI = (const unsigned*)(a.ws + WS_EIDX); const float* GT = (const float*)(a.ws + WS_GATE);
    const float* g2 = a.in[6] + (size_t)l * DM;
    LAS unsigned* st = (LAS unsigned*)(F.lds + F.wave * 16384) + lane;
#define ST_ELO(i) st[(0 * MAXT + (i)) * 64]
#define ST_EHI(i) st[(1 * MAXT + (i)) * 64]
#define ST_H0(i)  ((LAS float*)st)[(2 * MAXT + (i)) * 64]
#define ST_H1(i)  ((LAS float*)st)[(3 * MAXT + (i)) * 64]
#define ST_SSQ(i) ((LAS float*)st)[(4 * MAXT + (i)) * 64]
    const int ntok = (MTOT - gw + NGW - 1) / NGW;
    for (int i = 0; i < ntok; ++i) { const int t = gw + NGW * i; ST_ELO(i) = EI[(size_t)t * 128 + lane]; ST_EHI(i) = EI[(size_t)t * 128 + 64 + lane]; ST_H0(i) = 0.f; ST_H1(i) = 0.f; ST_SSQ(i) = 0.f; }
#define PEER_ISSUE(R, TAB, ss, ii, eword) do { const unsigned _e = (eword); _Pragma("unroll") for (int q = 0; q < 8; ++q) { \
        const unsigned idx = (unsigned)__shfl((int)_e, q * 8 + lg3); R[q] = *(const u32x4*)((TAB) + ((size_t)(ss) * NEXP + idx) * 128 + 16 * l7); } } while (0)
    for (int urep = 0; urep < REPS(7); ++urep) {
    if (urep) { for (int i = 0; i < ntok; ++i) { ST_H0(i) = 0.f; ST_H1(i) = 0.f; } }
    {
        u32x4 RA[8], RB[8];
        PEER_ISSUE(RA, TU, 0, 0, ST_ELO(0));
        u32x4 xa = *(const u32x4*)(XB + (size_t)gw * DM + 16 * l7), xb = *(const u32x4*)(XB + (size_t)gw * DM + 16 * l7 + 8);
#pragma unroll 1
        for (int s = 0; s < 8; ++s) {
            float gv[16];
#pragma unroll
            for (int j = 0; j < 4; ++j) { const f32x4 g = *(const f32x4*)(g2 + 128 * s + 16 * l7 + 4 * j); gv[4 * j] = g[0]; gv[4 * j + 1] = g[1]; gv[4 * j + 2] = g[2]; gv[4 * j + 3] = g[3]; }
#pragma unroll 1
            for (int i = 0; i < ntok; ++i) {
                PEER_ISSUE(RB, TU, s, i, ST_EHI(i));
                int sn = s, in = i + 1; if (in == ntok) { in = 0; sn = s + 1; } if (sn == 8) { sn = 7; in = ntok - 1; }
                const int tn = gw + NGW * in;
                const u32x4 xan = *(const u32x4*)(XB + (size_t)tn * DM + 128 * sn + 16 * l7), xbn = *(const u32x4*)(XB + (size_t)tn * DM + 128 * sn + 16 * l7 + 8);
                float xg[16];
                { const unsigned xw[8] = {xa.x, xa.y, xa.z, xa.w, xb.x, xb.y, xb.z, xb.w};
#pragma unroll
                  for (int j = 0; j < 8; ++j) { xg[2 * j] = bflo(xw[j]) * gv[2 * j]; xg[2 * j + 1] = bfhi(xw[j]) * gv[2 * j + 1]; } }
                float p[16];
#pragma unroll
                for (int q = 0; q < 8; ++q) { float f[16]; dec16(RA[q], f); float s0 = 0.f, s1 = 0.f;
#pragma unroll
                    for (int j = 0; j < 8; ++j) { s0 += f[2 * j] * xg[2 * j]; s1 += f[2 * j + 1] * xg[2 * j + 1]; }
                    p[q] = s0 + s1;
                    if (q < 7) asm volatile("" : "+v"(RA[q + 1].x), "+v"(RA[q + 1].y), "+v"(RA[q + 1].z), "+v"(RA[q + 1].w) : "v"(p[q])); }
                asm volatile("" :: "v"(p[7]));
                PEER_ISSUE(RA, TU, sn, in, ST_ELO(in));
#pragma unroll
                for (int q = 0; q < 8; ++q) { float f[16]; dec16(RB[q], f); float s0 = 0.f, s1 = 0.f;
#pragma unroll
                    for (int j = 0; j < 8; ++j) { s0 += f[2 * j] * xg[2 * j]; s1 += f[2 * j + 1] * xg[2 * j + 1]; }
                    p[8 + q] = s0 + s1;
                    if (q < 7) asm volatile("" : "+v"(RB[q + 1].x), "+v"(RB[q + 1].y), "+v"(RB[q + 1].z), "+v"(RB[q + 1].w) : "v"(p[8 + q])); }
                float p8[8], p4[4], p2[2];
#pragma unroll
                for (int q = 0; q < 8; ++q) { const float keep = (lane & 4) ? p[q + 8] : p[q], send = (lane & 4) ? p[q] : p[q + 8]; p8[q] = keep + __shfl_xor(send, 4); }
#pragma unroll
                for (int q = 0; q < 4; ++q) { const float keep = (lane & 2) ? p8[q + 4] : p8[q], send = (lane & 2) ? p8[q] : p8[q + 4]; p4[q] = keep + __shfl_xor(send, 2); }
#pragma unroll
                for (int q = 0; q < 2; ++q) { const float keep = (lane & 1) ? p4[q + 2] : p4[q], send = (lane & 1) ? p4[q] : p4[q + 2]; p2[q] = keep + __shfl_xor(send, 1); }
                ST_H0(i) += p2[0]; ST_H1(i) += p2[1];
                xa = xan; xb = xbn;
            }
        }
    } }
    for (int i = 0; i < ntok; ++i) { const int t = gw + NGW * i;
        const float rstd = rsqrtf(((const float*)(a.ws + WS_RSS2))[t] * (1.0f / DM) + EPS);
        const int k0 = 16 * l7 + lg3, k1 = k0 + 8; const unsigned e0 = EI[(size_t)t * 128 + k0], e1 = EI[(size_t)t * 128 + k1];
        ST_H0(i) = geluf_(ST_H0(i) * rstd * SCU[e0]) * GT[(size_t)t * 128 + k0] * SCV[e0];
        ST_H1(i) = geluf_(ST_H1(i) * rstd * SCU[e1]) * GT[(size_t)t * 128 + k1] * SCV[e1]; }
    {
        u32x4 RA[8], RB[8];
        PEER_ISSUE(RA, TV, 0, 0, ST_ELO(0));
#pragma unroll 1
        for (int s = 0; s < 8; ++s) {
#pragma unroll 1
            for (int i = 0; i < ntok; ++i) { const int t = gw + NGW * i;
                PEER_ISSUE(RB, TV, s, i, ST_EHI(i));
                int sn = s, in = i + 1; if (in == ntok) { in = 0; sn = s + 1; } if (sn == 8) { sn = 7; in = ntok - 1; }
                const int col = 128 * s + 16 * l7 + 8 * ((lane >> 5) & 1) + 4 * ((lane >> 4) & 1) + 2 * ((lane >> 3) & 1);
                f32x2 xv = *(const f32x2*)(X + (size_t)t * DM + col);
                const float h0 = ST_H0(i), h1 = ST_H1(i);
                float o[16];
#pragma unroll
                for (int j = 0; j < 16; ++j) o[j] = 0.f;
#pragma unroll
                for (int q = 0; q < 8; ++q) { const float hq = __shfl((q & 1) ? h1 : h0, (lane & ~7) | (q >> 1)); float f[16]; dec16(RA[q], f);
#pragma unroll
                    for (int j = 0; j < 16; ++j) o[j] += hq * f[j];
                    if (q < 7) asm volatile("" : "+v"(RA[q + 1].x), "+v"(RA[q + 1].y), "+v"(RA[q + 1].z), "+v"(RA[q + 1].w) : "v"(o[15])); }
                asm volatile("" :: "v"(o[15]));
                PEER_ISSUE(RA, TV, sn, in, ST_ELO(in));
#pragma unroll
                for (int q = 0; q < 8; ++q) { const float hq = __shfl((q & 1) ? h1 : h0, (lane & ~7) | (4 + (q >> 1))); float f[16]; dec16(RB[q], f);
#pragma unroll
                    for (int j = 0; j < 16; ++j) o[j] += hq * f[j];
                    if (q < 7) asm volatile("" : "+v"(RB[q + 1].x), "+v"(RB[q + 1].y), "+v"(RB[q + 1].z), "+v"(RB[q + 1].w) : "v"(o[15])); }
                float o8[8], o4[4], o2[2];
#pragma unroll
                for (int q = 0; q < 8; ++q) { const float keep = (lane & 32) ? o[q + 8] : o[q], send = (lane & 32) ? o[q] : o[q + 8]; o8[q] = keep + __shfl_xor(send, 32); }
#pragma unroll
                for (int q = 0; q < 4; ++q) { const float keep = (lane & 16) ? o8[q + 4] : o8[q], send = (lane & 16) ? o8[q] : o8[q + 4]; o4[q] = keep + __shfl_xor(send, 16); }
#pragma unroll
                for (int q = 0; q < 2; ++q) { const float keep = (lane & 8) ? o4[q + 2] : o4[q], send = (lane & 8) ? o4[q] : o4[q + 2]; o2[q] = keep + __shfl_xor(send, 8); }
                xv.x += o2[0]; xv.y += o2[1];
                *(f32x2*)(X + (size_t)t * DM + col) = xv; *(unsigned*)(XB + (size_t)t * DM + col) = pk2(xv.x, xv.y); ST_SSQ(i) += xv.x * xv.x + xv.y * xv.y;
            }
        }
    }
#undef PEER_ISSUE
    float* RSS = (float*)(a.ws + WS_RSS);
    if (lastlayer) __threadfence();
    for (int i = 0; i < ntok; ++i) { const int t = gw + NGW * i; const float ss = wave_sum(ST_SSQ(i)); if (lane == 0) RSS[t] = ss;
        if (lastlayer) { const float* gf = a.in[7]; const float rstd = rsqrtf(ss * (1.0f / DM) + EPS); f32x4* xr = (f32x4*)(X + (size_t)t * DM) + lane;
#pragma unroll
            for (int j = 0; j < 4; ++j) { const f32x4 g = *((const f32x4*)gf + lane + 64 * j); f32x4 v = xr[64 * j]; v = v * rstd * g; xr[64 * j] = v; } } }
#undef ST_ELO
#undef ST_EHI
#undef ST_H0
#undef ST_H1
#undef ST_SSQ
}

constexpr int N_PHASES = 1 + 7 * DEPTH;
__global__ void __launch_bounds__(NTHREADS, 2) hybrid_fwd(Args args) {
    extern __shared__ __attribute__((aligned(16))) unsigned char lds_raw[];
    Frame F;
    F.lds = (ldsp_t)lds_raw;
    F.MISC = (volatile LAS unsigned*)(F.lds + MISC_OFF);
    F.tid = threadIdx.x; F.lane = F.tid & 63; F.wave = __builtin_amdgcn_readfirstlane(F.tid >> 6);
    F.G = gridDim.x; { const int bx = blockIdx.x; F.vcu = (F.G % 8 == 0) ? (bx % 8) * (F.G / 8) + bx / 8 : bx; }
    F.ctl = (unsigned*)(args.ws + WS_CTL); F.ws = args.ws; F.out = args.out;
    for (int u = F.tid; u < (LDS_BYTES - MISC_OFF) / 4; u += NTHREADS) ((LAS unsigned*)(F.lds + MISC_OFF))[u] = 0u;
    __syncthreads();
    const int lo = args.ph_lo, hi = args.ph_hi;
    XcdBarrier bar; bar.bar = F.ctl + CW_BAR; bar.x = 0; bar.st = nullptr;
    if (hi - lo > 1) bar = xcd_barrier_post(F.ctl + CW_BAR, F.MISC + 8);
#ifndef PH_MASK
#define PH_MASK 0x7FF
#endif
#define IN(k) (lo <= (k) && (k) < hi)
#define PHM(b) ((PH_MASK >> (b)) & 1)
#define REPBAR() do { if (rep) xcd_barrier(bar); } while (0)
#define LAUNDER() do { asm volatile("" : "+v"(F.tid)); F.lane = F.tid & 63; F.wave = __builtin_amdgcn_readfirstlane(F.tid >> 6); } while (0)
#define SEAM(k) do { if (IN(k) && IN((k) + 1)) xcd_barrier(bar); } while (0)
    unsigned char* ws = args.ws;
    bf16_t* P = (bf16_t*)(ws + WS_P); bf16_t* XB = (bf16_t*)(ws + WS_XB);

    for (int rep = 0; rep < REPS(0); ++rep) { REPBAR(); if (PHM(0) && IN(0)) { LAUNDER(); p0_prologue(args, F); } } SEAM(0);

    for (int l = 0; l < DEPTH; ++l) {
        const int pb = 1 + 7 * l;
        for (int rep = 0; rep < REPS(1); ++rep) { REPBAR();
        if (PHM(1) && IN(pb)) { LAUNDER();
            pg8::Gemm g{XB, (const bf16_t*)(ws + WS_WIN) + (size_t)l * NIN * DM, DM, DM, 0, 0};
            pg8::StaticOrder S; S.init(MTOT, NIN, F.G, (int)blockIdx.x, 1);
            pg8::EpiIn E{P, (const float*)(ws + WS_RSS), (const float*)(ws + WS_ROT)};
            pg8::gemm_phase<pg8::EpiIn, pg8::StaticOrder, true>(F.lds, g, S, E, F.tid);
        } }
        SEAM(pb);
        if (PHM(2) && IN(pb + 1)) { LAUNDER();
            for (int u = (int)blockIdx.x; u < 192; u += F.G) {
                LAUNDER();
                if (u < 64) { if (PHM(8)) ret_prompt_unit(args, F, l, u >> 3, u & 7); }
                else { if (PHM(9)) rnn_unit(args, F, l, false, (u - 64) >> 4, (u - 64) & 15); }
            }
            unsigned* qh = F.ctl + CW_QUEUE + 64 * l;
            for (;;) {
                __syncthreads();
                if (F.tid == 0) F.MISC[0] = xb_add(qh, 1u);
                __syncthreads();
                const unsigned q = F.MISC[0];
                LAUNDER();
                if (q >= 1024u + 128u + 256u) break;
                if (q < 1024u) { if (PHM(10)) ret_sample_unit(args, F, l, (int)(q >> 3), (int)(q & 7)); }
                else if (q < 1152u) { if (PHM(9)) rnn_unit(args, F, l, true, (int)((q - 1024u) >> 4), (int)((q - 1024u) & 15)); }
                else tab_unit(args, F, l, (int)(q - 1152u));
            }
        }
        SEAM(pb + 1);
        for (int rep = 0; rep < REPS(3); ++rep) { REPBAR();
        if (PHM(3) && IN(pb + 2)) { LAUNDER();
            pg8::Gemm g{P + PC_ARET, (const bf16_t*)(ws + WS_WMIX + (size_t)l * 6 * MiB), LDP, DM, (size_t)(PC_ARNN - PC_ARET) * 2, (size_t)(2 * MiB)};
            pg8::StaticOrder S; S.init(MTOT, DM, F.G, (int)blockIdx.x, 2);
            pg8::EpiMerge E{P};
            pg8::gemm_phase<pg8::EpiMerge, pg8::StaticOrder, true>(F.lds, g, S, E, F.tid);
        } }
        SEAM(pb + 2);
        if (PHM(4) && IN(pb + 3)) { LAUNDER();
            pg8::Gemm g{P + PC_MRG, (const bf16_t*)(ws + WS_WMIX + (size_t)l * 6 * MiB + 4 * MiB), LDP, DM, 0, 0};
            pg8::StaticOrder S; S.init(MTOT, DM, F.G, (int)blockIdx.x, 1);
            pg8::EpiWo E{l == 0 ? args.in[0] : args.out, l == 0 ? args.in[1] : args.out + (size_t)M_P * DM, args.out, XB, (float*)(ws + WS_RSSP)};
            pg8::gemm_phase<pg8::EpiWo, pg8::StaticOrder, true>(F.lds, g, S, E, F.tid);
        }
        SEAM(pb + 3);
        for (int rep = 0; rep < REPS(5); ++rep) { REPBAR();
        if (PHM(5) && IN(pb + 4)) { LAUNDER();
            pg8::Gemm g{XB, (const bf16_t*)(ws + WS_WQ) + (size_t)l * 2048 * DM, DM, DM, 0, 0};
            pg8::StaticOrder S; S.init(MTOT, 2048, F.G, (int)blockIdx.x, 1);
            pg8::EpiQ E{P, (const float*)(ws + WS_RSSP), (float*)(ws + WS_RSS2)};
            pg8::gemm_phase<pg8::EpiQ, pg8::StaticOrder, true>(F.lds, g, S, E, F.tid);
        } }
        SEAM(pb + 4);
        for (int rep = 0; rep < REPS(6); ++rep) { REPBAR();
        if (PHM(6) && IN(pb + 5)) { LAUNDER();
            const int gw = F.vcu * NWAVES + F.wave, NGW = F.G * NWAVES;
            for (int u = gw; u < (MTOT / 32) * PH; u += NGW) { int ln = F.lane; asm volatile("" : "+v"(ln)); route_unit(args, l, u >> 3, u & 7, ln); }
        } }
        SEAM(pb + 5);
        if (PHM(7) && IN(pb + 6)) { LAUNDER(); peer_phase(args, F, l, l == DEPTH - 1); }
        if (l + 1 < DEPTH) SEAM(pb + 6);
    }
#undef IN
#undef SEAM
}

extern "C" void kernel_launch(void* const* d_in, const int* in_sizes, int n_in, void* d_out, int out_size, void* d_ws, size_t ws_size, hipStream_t stream) {
    static int grid = 0;
    if (grid == 0) {
        if (n_in != 24 || out_size != (int)O_END || ws_size < WS_END) { fprintf(stderr, "kernel_launch: unexpected shapes (n_in %d, out %d, ws %zu)\n", n_in, out_size, ws_size); grid = -1; return; }
        int dev = 0, cus = 0, per_cu = 0;
        if (hipGetDevice(&dev) != hipSuccess || hipDeviceGetAttribute(&cus, hipDeviceAttributeMultiprocessorCount, dev) != hipSuccess) { grid = -1; return; }
        if (hipFuncSetAttribute((const void*)hybrid_fwd, hipFuncAttributeMaxDynamicSharedMemorySize, LDS_BYTES) != hipSuccess) { fprintf(stderr, "kernel_launch: hipFuncSetAttribute failed\n"); grid = -1; return; }
        if (hipOccupancyMaxActiveBlocksPerMultiprocessor(&per_cu, (const void*)hybrid_fwd, NTHREADS, LDS_BYTES) != hipSuccess || per_cu < 1) { fprintf(stderr, "kernel_launch: occupancy query reports %d blocks per CU\n", per_cu); (void)hipGetLastError(); grid = -1; return; }
        grid = cus;
        if (grid != 256) fprintf(stderr, "kernel_launch: %d CUs; the PEER phase assumes 256 workgroups\n", grid);
    }
    if (grid < 0) return;
    (void)hipMemsetAsync((char*)d_ws + WS_CTL, 0, CTL_ZERO_BYTES, stream);
    Args a{};
    for (int i = 0; i < 24; ++i) a.in[i] = (const float*)d_in[i];
    a.out = (float*)d_out; a.ws = (unsigned char*)d_ws;
#if MK_N_LAUNCHES == 1
    a.ph_lo = 0; a.ph_hi = N_PHASES;
    void* kargs[] = {&a};
    hipError_t e = hipLaunchCooperativeKernel((const void*)hybrid_fwd, dim3(grid), dim3(NTHREADS), kargs, LDS_BYTES, stream);
    if (e != hipSuccess) fprintf(stderr, "kernel_launch: cooperative launch failed: %s (grid %d)\n", hipGetErrorString(e), grid);
#else
    for (int p = 0; p < N_PHASES; ++p) { a.ph_lo = p; a.ph_hi = p + 1; hipLaunchKernelGGL(hybrid_fwd, dim3(grid), dim3(NTHREADS), LDS_BYTES, stream, a); }
#endif
}
```

```cpp
#include <hip/hip_runtime.h>
#include <cstdio>
#include <cstdint>

#define LAS __attribute__((address_space(3)))
#define GAS __attribute__((address_space(1)))
typedef unsigned short bf16_t;
typedef short bf16x8 __attribute__((ext_vector_type(8)));
typedef float f32x2 __attribute__((ext_vector_type(2)));
typedef float f32x4 __attribute__((ext_vector_type(4)));
typedef float f32x16 __attribute__((ext_vector_type(16)));
typedef unsigned u32x2 __attribute__((ext_vector_type(2)));
typedef unsigned u32x4 __attribute__((ext_vector_type(4)));
typedef LAS unsigned char* ldsp_t;

#ifndef REP_MASK
#define REP_MASK 0
#endif
#define REPS(k) (((REP_MASK >> (k)) & 1) ? 2 : 1)
#ifndef MK_N_LAUNCHES
#define MK_N_LAUNCHES 1
#endif

constexpr int DM = 1024, NIN = 7168, M_P = 16384, M_S = 1024, MTOT = 17408, DEPTH = 2;
constexpr int SEQ = 2048, NBATCH = 8, DECB = 128, DECT = 8, PAST = 16384;
constexpr int HR = 8, DK = 64, DV = 128, CH = 128;
constexpr int NBLK = 16, BS = 64;
constexpr int PH = 8, NKEY = 128, NEXP = 16384, TOPK = 16, HK = 128;
constexpr float EPS = 1e-6f;
constexpr int LDP = 7168;
constexpr int PC_Q = 0, PC_K = 512, PC_V = 1024, PC_GR = 2048, PC_XR = 3072, PC_GN = 4096, PC_GA = 5120, PC_GB = 6144;
constexpr int PC_MRG = 0, PC_ARET = 1024, PC_ARNN = 4096, PC_QP = 2048;

constexpr size_t MiB = 1u << 20;
constexpr size_t WS_CTL = 0, CTL_ZERO_BYTES = 1 * MiB;
constexpr size_t WS_ROT = 1 * MiB;
constexpr size_t WS_RSS = 2 * MiB;
constexpr size_t WS_RSS2 = 2 * MiB + 128 * 1024;
constexpr size_t WS_RSSP = 2 * MiB + 256 * 1024;
constexpr size_t WS_TSC = 3 * MiB + 512 * 1024;
constexpr size_t WS_EIDX = 4 * MiB;
constexpr size_t WS_GATE = 13 * MiB;
constexpr size_t WS_KEYS = 22 * MiB;
constexpr size_t WS_WG = 23 * MiB;
constexpr size_t WS_WIN = 24 * MiB;
constexpr size_t WS_WMIX = 52 * MiB;
constexpr size_t WS_WQ = 64 * MiB;
constexpr size_t WS_XB = 72 * MiB;
constexpr size_t WS_P = 106 * MiB;
constexpr size_t WS_TAB = 344 * MiB;
constexpr size_t WS_END = 472 * MiB;
static_assert(WS_P + (size_t)MTOT * LDP * 2 <= WS_TAB, "ws map");

constexpr size_t O_Y = 0, O_SRP = 17825792, O_SHP = 18874368, O_SCP = 18890752, O_SRS = 18939904, O_SHS = 35717120, O_SCS = 35979264, O_END = 36765696;

constexpr int CW_BAR = 4096;
constexpr int CW_QUEUE = 16384;

constexpr int RING_BYTES = 131072;
constexpr int LDS_BYTES = 155648;
constexpr int MISC_OFF = 153600;
constexpr int NWAVES = 8, NTHREADS = 512;

#define LDS_WAIT() asm volatile("s_waitcnt lgkmcnt(0)" ::: "memory")
#define VM_WAIT() asm volatile("s_waitcnt vmcnt(0)" ::: "memory")
#define RLX_AGENT __ATOMIC_RELAXED, __HIP_MEMORY_SCOPE_AGENT

__device__ __forceinline__ unsigned f2bf(float f) { unsigned u = __builtin_bit_cast(unsigned, f); return (u + 0x7fffu + ((u >> 16) & 1u)) >> 16; }
typedef __bf16 bf16x2_t __attribute__((ext_vector_type(2)));
__device__ __forceinline__ unsigned pk2(float lo, float hi) { const f32x2 v = {lo, hi}; const bf16x2_t b = __builtin_convertvector(v, bf16x2_t); return __builtin_bit_cast(unsigned, b); }
__device__ __forceinline__ float bflo(unsigned w) { return __builtin_bit_cast(float, w << 16); }
__device__ __forceinline__ float bfhi(unsigned w) { return __builtin_bit_cast(float, w & 0xffff0000u); }
__device__ __forceinline__ float bf1(bf16_t h) { return __builtin_bit_cast(float, (unsigned)h << 16); }
__device__ __forceinline__ float sigmoidf_(float x) { return __builtin_amdgcn_rcpf(1.0f + __expf(-x)); }
__device__ __forceinline__ float siluf_(float x) { return x * sigmoidf_(x); }
__device__ __forceinline__ float geluf_(float x) { return x * sigmoidf_(1.5957691216057308f * (x + 0.044715f * x * x * x)); }
__device__ __forceinline__ float logg_of(int h) { return log1pf(-exp2f((float)(-5 - h))); }

namespace pg8 {
constexpr int BM = 256, BK = 64, HALF = 128, HTB = HALF * BK * 2, STAGE_BYTES = 8 * HTB, NXCD = 8, WGM = 8;
__host__ __device__ __forceinline__ int lds_byte(int r, int c) { const int st = (r >> 4) * 2 + (c >> 5), rr = r & 15, cc = c & 31, ob = rr * 64 + cc * 2; return st * 1024 + (ob ^ (((ob >> 9) & 1) << 5)); }
__host__ __device__ __forceinline__ void stage_rc(int b, int& R, int& C) { const int st = b / 1024, sb = b % 1024, swz = sb ^ (((sb >> 9) & 1) << 5); R = (st >> 1) * 16 + swz / 64; C = (st & 1) * 32 + (swz % 64) / 2; }
__host__ __device__ __forceinline__ int perm32(int rho) { const int n = rho >> 4, i = rho & 15; return 8 * (i >> 2) + 4 * n + (i & 3); }

struct Unit { int pm, pn, half; };
struct Gemm { const bf16_t* A; const bf16_t* Bt; int lda, K; size_t aoff2, boff2; };

struct StaticOrder {
    int nM, nN, nwg, G, c, pairs;
    __device__ void init(int M, int N, int G_, int c_, int pairs_) { nM = M / BM; nN = N / BM; nwg = nM * nN; G = G_; c = c_; pairs = pairs_; }
    __device__ bool next(int i, Unit& u) const {
        const int it = (pairs == 2) ? (i >> 1) : i;
        const long L = (long)it * G + c; if (L >= nwg) return false;
        int wgid = (int)L; { const int q = nwg / NXCD, r = nwg % NXCD, xcd = wgid % NXCD, off = wgid / NXCD; wgid = (xcd < r ? xcd * (q + 1) : r * (q + 1) + (xcd - r) * q) + off; }
        const int nig = WGM * nN, gid = wgid / nig, fm = gid * WGM, gsz = (nM - fm) < WGM ? (nM - fm) : WGM;
        u.pm = fm + ((wgid % nig) % gsz); u.pn = (wgid % nig) / gsz; u.half = (pairs == 2) ? (i & 1) : 0; return true;
    }
};

template <class Epi, class Sched, bool ALIGN_EPI>
__device__ __forceinline__ void gemm_phase(ldsp_t lds, const Gemm g, const Sched& S, const Epi& E, const int tid) {
    const int wid = __builtin_amdgcn_readfirstlane(tid >> 6), lane = tid & 63, wr = wid >> 2, wc = wid & 3, fr = lane & 15, fq = lane >> 4;
    const int K = g.K, nt = K / BK;
    unsigned voffA[2], voffB[2];
#pragma unroll
    for (int i = 0; i < 2; ++i) { int R, C; stage_rc(tid * 16 + i * 8192, R, C); const int Rb = Epi::PERM ? ((R & ~31) + perm32(R & 31)) : R;
        voffA[i] = (unsigned)(R * g.lda + C) * 2u; voffB[i] = (unsigned)(Rb * K + C) * 2u; }
    const size_t kstep = (size_t)(BK * 2);
    const size_t hstepA = (size_t)HALF * g.lda * 2, hstepB = (size_t)HALF * K * 2;
    const size_t tstepA = 2 * hstepA, tstepB = 2 * hstepB;
    const unsigned ldsw = (unsigned)wid * 1024u;
    const int aoff = lds_byte(wr * 64 + fr, fq * 8), boff = lds_byte(wc * 32 + fr, fq * 8);
#define PG8_SA(b, h) (((b) * 2 + (h)) * HTB)
#define PG8_SB(b, h) ((4 + (b) * 2 + (h)) * HTB)
#define PG8_STAGE(bufoff, gbase, voff) do { _Pragma("unroll") for (int _i = 0; _i < 2; ++_i) \
        __builtin_amdgcn_global_load_lds((const unsigned*)((const char*)(gbase) + (voff)[_i]), (LAS unsigned*)(lds + (bufoff) + ldsw + _i * 8192), 16, 0, 0); } while (0)
#define PG8_LDA(dst, b, h) do { _Pragma("unroll") for (int m = 0; m < 4; ++m) _Pragma("unroll") for (int k = 0; k < 2; ++k) dst[m][k] = *(const LAS bf16x8*)(lds + PG8_SA(b, h) + aoff + m * 2048 + k * 1024); } while (0)
#define PG8_LDB(dst, b, h) do { _Pragma("unroll") for (int n = 0; n < 2; ++n) _Pragma("unroll") for (int k = 0; k < 2; ++k) dst[n][k] = *(const LAS bf16x8*)(lds + PG8_SB(b, h) + boff + n * 2048 + k * 1024); } while (0)
#define PG8_MMA(ai, bj, At, Bt) do { __builtin_amdgcn_s_setprio(1); _Pragma("unroll") for (int m = 0; m < 4; ++m) _Pragma("unroll") for (int n = 0; n < 2; ++n) _Pragma("unroll") for (int k = 0; k < 2; ++k) \
        acc[ai][bj][m][n] = __builtin_amdgcn_mfma_f32_16x16x32_bf16(Bt[n][k], At[m][k], acc[ai][bj][m][n], 0, 0, 0); __builtin_amdgcn_s_setprio(0); } while (0)
#define PG8_WAIT_V(n) asm volatile("s_waitcnt vmcnt(" #n ")" ::: "memory")
#define PG8_WAIT_L(n) asm volatile("s_waitcnt lgkmcnt(" #n ")" ::: "memory")
#define PG8_BAR __builtin_amdgcn_s_barrier()
#define PG8_SCHED __builtin_amdgcn_sched_barrier(0)
    Unit cur, nxt; int ui = 0;
    if (!S.next(0, cur)) return;
    f32x4 acc[2][2][4][2];
#pragma unroll
    for (int a = 0; a < 2; ++a)
#pragma unroll
        for (int b = 0; b < 2; ++b)
#pragma unroll
            for (int m = 0; m < 4; ++m)
#pragma unroll
                for (int n = 0; n < 2; ++n) acc[a][b][m][n] = (f32x4){0.f, 0.f, 0.f, 0.f};
    bf16x8 At[4][2], B0[2][2], B1[2][2];
    const char* cA = (const char*)g.A + (size_t)cur.pm * tstepA + (cur.half ? g.aoff2 : 0); const char* cB = (const char*)g.Bt + (size_t)cur.pn * tstepB + (cur.half ? g.boff2 : 0);
    PG8_STAGE(PG8_SB(0, 0), cB, voffB); PG8_STAGE(PG8_SB(0, 1), cB + hstepB, voffB); PG8_STAGE(PG8_SA(0, 0), cA, voffA); PG8_STAGE(PG8_SA(0, 1), cA + hstepA, voffA);
    if (wr == 1) PG8_BAR;
    PG8_WAIT_V(2); PG8_BAR;
    PG8_STAGE(PG8_SB(1, 0), cB + kstep, voffB); PG8_STAGE(PG8_SA(1, 0), cA + kstep, voffA); PG8_STAGE(PG8_SB(1, 1), cB + hstepB + kstep, voffB);
    PG8_WAIT_V(6); PG8_BAR;
    for (;;) {
        const bool has_next = S.next(ui + 1, nxt);
        const char* nA = has_next ? (const char*)g.A + (size_t)nxt.pm * tstepA + (nxt.half ? g.aoff2 : 0) : cA;
        const char* nB = has_next ? (const char*)g.Bt + (size_t)nxt.pn * tstepB + (nxt.half ? g.boff2 : 0) : cB;
        for (int t = 0; t < nt; t += 2) {
            const bool last = (t == nt - 2);
            const char* a1 = cA + (size_t)(t + 1) * kstep;
            const char* a2 = last ? nA : cA + (size_t)(t + 2) * kstep; const char* b2 = last ? nB : cB + (size_t)(t + 2) * kstep;
            const char* a3 = a2 + kstep; const char* b3 = b2 + kstep;
            PG8_LDB(B0, 0, 0); PG8_LDB(B1, 0, 1); PG8_SCHED; PG8_LDA(At, 0, 0); PG8_STAGE(PG8_SA(1, 1), a1 + hstepA, voffA);
            PG8_WAIT_V(8); PG8_WAIT_L(0); PG8_BAR; PG8_MMA(0, 0, At, B0); PG8_MMA(0, 1, At, B1); PG8_BAR; PG8_SCHED;
            PG8_LDA(At, 0, 1); PG8_STAGE(PG8_SB(0, 0), b2, voffB); PG8_STAGE(PG8_SB(0, 1), b2 + hstepB, voffB); PG8_STAGE(PG8_SA(0, 0), a2, voffA);
            PG8_WAIT_V(8); PG8_WAIT_L(0); PG8_BAR; PG8_MMA(1, 0, At, B0); PG8_MMA(1, 1, At, B1); PG8_BAR; PG8_SCHED;
            PG8_LDB(B0, 1, 0); PG8_LDB(B1, 1, 1); PG8_SCHED; PG8_LDA(At, 1, 0); PG8_STAGE(PG8_SA(0, 1), a2 + hstepA, voffA);
            PG8_WAIT_V(8); PG8_WAIT_L(0); PG8_BAR; PG8_MMA(0, 0, At, B0); PG8_MMA(0, 1, At, B1); PG8_BAR; PG8_SCHED;
            PG8_LDA(At, 1, 1); PG8_STAGE(PG8_SB(1, 0), b3, voffB); PG8_STAGE(PG8_SB(1, 1), b3 + hstepB, voffB); PG8_STAGE(PG8_SA(1, 0), a3, voffA);
            PG8_WAIT_V(8); PG8_WAIT_L(0); PG8_BAR; PG8_MMA(1, 0, At, B0); PG8_MMA(1, 1, At, B1); PG8_BAR; PG8_SCHED;
        }
        if constexpr (ALIGN_EPI) { if (wr == 0) PG8_BAR; }
        E(acc, cur, wr, wc, fr, fq);
        if (!has_next) break;
#pragma unroll
        for (int a = 0; a < 2; ++a)
#pragma unroll
            for (int b = 0; b < 2; ++b)
#pragma unroll
                for (int m = 0; m < 4; ++m)
#pragma unroll
                    for (int n = 0; n < 2; ++n) acc[a][b][m][n] = (f32x4){0.f, 0.f, 0.f, 0.f};
        cur = nxt; cA = nA; cB = nB; ++ui;
        if constexpr (ALIGN_EPI) { if (wr == 1) PG8_BAR; }
    }
    PG8_WAIT_V(0);
    if constexpr (!ALIGN_EPI) { if (wr == 0) PG8_BAR; }
    PG8_BAR;
#undef PG8_SA
#undef PG8_SB
#undef PG8_STAGE
#undef PG8_LDA
#undef PG8_LDB
#undef PG8_MMA
#undef PG8_WAIT_V
#undef PG8_WAIT_L
#undef PG8_BAR
#undef PG8_SCHED
}
}

typedef GAS unsigned gu32;
#define XB_TMO      128
#define XB_XCNT(j)  (256  + 64 * (j))
#define XB_XSUB(j)  (1280 + 64 * (j))
#define XB_XGEN(j)  (2304 + 64 * (j))
#define XB_TOP      3328
#define XB_TOPGEN   3392
#define XCD_BAR_WORDS 3456
#define XB_SPIN_CAP (1u << 18)
__device__ __forceinline__ unsigned xb_ld(unsigned* p)              { return __hip_atomic_load(p, __ATOMIC_RELAXED, __HIP_MEMORY_SCOPE_AGENT); }
__device__ __forceinline__ unsigned xb_add(unsigned* p, unsigned v) { return __hip_atomic_fetch_add(p, v, __ATOMIC_RELAXED, __HIP_MEMORY_SCOPE_AGENT); }
__device__ __forceinline__ unsigned xb_xcc_id() { return (unsigned)__builtin_amdgcn_s_getreg((3 << 11) | 20) & 0xFu; }
#define XB_SPIN(cond, bar) do { unsigned _sp = 0; while (cond) { __builtin_amdgcn_s_sleep(1); \
    if ((++_sp & 255u) == 0u) { if (xb_ld(&(bar)[XB_TMO])) break; if (_sp > XB_SPIN_CAP) { atomicAdd(&(bar)[XB_TMO], 1u); break; } } } } while (0)
struct XcdBarrier { unsigned* bar; unsigned x; volatile LAS unsigned* st; };
__device__ __forceinline__ XcdBarrier xcd_barrier_post(unsigned* bar, volatile LAS unsigned* st) {
    XcdBarrier b; b.bar = bar; b.x = xb_xcc_id(); b.st = st;
    if (threadIdx.x == 0) (void)xb_add(&bar[XB_XCNT(b.x)], 1u);
    return b;
}
__device__ __forceinline__ void xcd_barrier_complete(unsigned* bar, unsigned x, unsigned& nloc, unsigned& nx) {
    const unsigned G = gridDim.x * gridDim.y * gridDim.z;
    unsigned sum, cnt, mine, sp = 0u;
    for (;;) {
        sum = 0u; cnt = 0u; mine = 0u;
#pragma unroll
        for (unsigned j = 0; j < 16; ++j) { const unsigned c = xb_ld(&bar[XB_XCNT(j)]); sum += c; cnt += (c > 0u) ? 1u : 0u; mine = (j == x) ? c : mine; }
        if (sum == G) break;
        __builtin_amdgcn_s_sleep(1);
        if ((++sp & 255u) == 0u) { if (xb_ld(&bar[XB_TMO])) break; if (sp > XB_SPIN_CAP) { atomicAdd(&bar[XB_TMO], 1u); break; } }
    }
    nloc = mine > 0u ? mine : 1u; nx = cnt > 0u ? cnt : 1u;
}
__device__ __forceinline__ void xcd_barrier(const XcdBarrier& b) {
    asm volatile("s_waitcnt vmcnt(0)" ::: "memory");
    __syncthreads();
    if (threadIdx.x == 0) {
        unsigned* bar = b.bar;
        __builtin_amdgcn_s_waitcnt(0);
        unsigned nloc = b.st[0], nx = b.st[1];
        if (nloc == 0u) { xcd_barrier_complete(bar, b.x, nloc, nx); b.st[0] = nloc; b.st[1] = nx; }
        const unsigned old = xb_add(&bar[XB_XSUB(b.x)], 1u);
        const unsigned gen = old / nloc;
        if (old + 1u == (gen + 1u) * nloc) {
            __builtin_amdgcn_fence(__ATOMIC_RELEASE, "agent");
            asm volatile("s_waitcnt vmcnt(0)" ::: "memory");
            const unsigned og = xb_add(&bar[XB_TOP], 1u);
            const unsigned tg = og / nx;
            if (og + 1u == (tg + 1u) * nx) xb_add(&bar[XB_TOPGEN], 1u);
            else XB_SPIN(xb_ld(&bar[XB_TOPGEN]) == tg, bar);
            __builtin_amdgcn_fence(__ATOMIC_ACQUIRE, "agent");
            xb_add(&bar[XB_XGEN(b.x)], 1u);
            asm volatile("s_waitcnt vmcnt(0)" ::: "memory");
        } else {
            XB_SPIN(xb_ld(&bar[XB_XGEN(b.x)]) == gen, bar);
            __builtin_amdgcn_fence(__ATOMIC_ACQUIRE, "agent");
            asm volatile("s_waitcnt vmcnt(0)" ::: "memory");
        }
    }
    __syncthreads();
}

struct Frame {
    ldsp_t lds;
    volatile LAS unsigned* MISC;
    unsigned* ctl;
    int tid, lane, wave, vcu, G;
    const float* const* in;
    unsigned char* ws;
    float* out;
};
struct Args { const float* in[24]; float* out; unsigned char* ws; int ph_lo, ph_hi; };

__device__ __forceinline__ float wave_sum(float v) {
#pragma unroll
    for (int o = 1; o < 64; o <<= 1) v += __shfl_xor(v, o);
    return v;
}

__device__ __forceinline__ void p0_transpose_item(const float* W, int K, int N, bf16_t* WT, int ldk, const float* rowscale, float colscale, bool qkperm, LAS float* scr, int item, int lane) {
    const int nblk = N / 32, kb = item / nblk, nb = item % nblk, k0 = 64 * kb, n0 = 32 * nb;
    int srcn = n0 + (lane & 31);
    if (qkperm) { const int p = srcn & 63; srcn = (srcn & ~63) + ((p & 1) ? 32 + (p >> 1) : (p >> 1)); }
#pragma unroll 16
    for (int i = 0; i < 32; ++i) { const int kk = 2 * i + (lane >> 5); float v = W[(size_t)(k0 + kk) * N + srcn] * colscale; if (rowscale) v *= rowscale[k0 + kk]; scr[kk * 33 + (lane & 31)] = v; }
    LDS_WAIT(); asm volatile("" ::: "memory");
    const int c = lane & 7;
#pragma unroll
    for (int j = 0; j < 4; ++j) { const int n = (lane >> 3) + 8 * j; const LAS float* s = scr + (8 * c) * 33 + n;
        u32x4 o; o.x = pk2(s[0 * 33], s[1 * 33]); o.y = pk2(s[2 * 33], s[3 * 33]); o.z = pk2(s[4 * 33], s[5 * 33]); o.w = pk2(s[6 * 33], s[7 * 33]);
        *(u32x4*)(WT + (size_t)(n0 + n) * ldk + k0 + 8 * c) = o; }
    LDS_WAIT(); asm volatile("" ::: "memory");
}

__device__ __forceinline__ void p0_xrow(const float* xrow, bf16_t* orow, float* rss, int lane) {
    const f32x4* xr = (const f32x4*)xrow + lane;
    f32x4 v[4]; float s = 0.f;
#pragma unroll
    for (int j = 0; j < 4; ++j) { v[j] = xr[64 * j]; s += (v[j].x * v[j].x + v[j].y * v[j].y) + (v[j].z * v[j].z + v[j].w * v[j].w); }
    s = wave_sum(s);
    u32x2* o8 = (u32x2*)orow + lane;
#pragma unroll
    for (int j = 0; j < 4; ++j) { u32x2 w; w.x = pk2(v[j].x, v[j].y); w.y = pk2(v[j].z, v[j].w); o8[64 * j] = w; }
    if (lane == 0) *rss = s;
}

__device__ __forceinline__ void p0_tabrow(const float* row, unsigned char* img, float* isc, int e, int lane) {
    const f32x4* xr = (const f32x4*)row + lane;
    f32x4 v[4]; float am = 0.f;
#pragma unroll
    for (int j = 0; j < 4; ++j) { v[j] = xr[64 * j]; am = fmaxf(am, fmaxf(fmaxf(fabsf(v[j].x), fabsf(v[j].y)), fmaxf(fabsf(v[j].z), fabsf(v[j].w)))); }
#pragma unroll
    for (int o = 1; o < 64; o <<= 1) am = fmaxf(am, __shfl_xor(am, o));
    const float sc = am > 0.f ? exp2f(floorf(log2f(224.0f / am))) : 1.0f;
#pragma unroll
    for (int j = 0; j < 4; ++j) { const int col = 256 * j + 4 * lane, sl = col >> 7, w = col & 127;
        int pk = __builtin_amdgcn_cvt_pk_fp8_f32(v[j].x * sc, v[j].y * sc, 0, false);
        pk = __builtin_amdgcn_cvt_pk_fp8_f32(v[j].z * sc, v[j].w * sc, pk, true);
        *(int*)(img + ((size_t)sl * NEXP + e) * 128 + w) = pk; }
    if (lane == 0) isc[e] = 1.0f / sc;
}

__device__ __forceinline__ void p0_prologue(const Args& a, Frame& F) {
    unsigned char* ws = a.ws;
    LAS float* scr = (LAS float*)(F.lds + F.wave * 16384);
    const int gw = F.vcu * NWAVES + F.wave, NGW = F.G * NWAVES, lane = F.lane;
    constexpr int I_IN = (DM / 64) * (NIN / 32), I_SQ = (DM / 64) * (DM / 32), I_Q = (DM / 64) * (2048 / 32), I_G = 2;
    constexpr int PER_L = I_IN + 3 * I_SQ + I_Q + 32 * I_G;
    for (int it = gw; it < DEPTH * PER_L; it += NGW) {
        const int l = it / PER_L; int r = it % PER_L;
        if (r < I_IN) { const int nb = r % (NIN / 32), n0 = nb * 32; const int seg = n0 >> 9;
            p0_transpose_item(a.in[8] + (size_t)l * DM * NIN, DM, NIN, (bf16_t*)(ws + WS_WIN) + (size_t)l * NIN * DM, DM, a.in[5] + l * DM, seg == 1 ? 0.125f : 1.0f, seg <= 1, scr, r, lane); continue; }
        r -= I_IN;
        if (r < I_SQ) { p0_transpose_item(a.in[10] + (size_t)l * DM * DM, DM, DM, (bf16_t*)(ws + WS_WMIX + (size_t)l * 6 * MiB), DM, a.in[9] + l * DM, 1.0f, false, scr, r, lane); continue; }
        r -= I_SQ;
        if (r < I_SQ) { p0_transpose_item(a.in[18] + (size_t)l * DM * DM, DM, DM, (bf16_t*)(ws + WS_WMIX + (size_t)l * 6 * MiB + 2 * MiB), DM, nullptr, 1.0f, false, scr, r, lane); continue; }
        r -= I_SQ;
        if (r < I_SQ) { p0_transpose_item(a.in[19] + (size_t)l * DM * DM, DM, DM, (bf16_t*)(ws + WS_WMIX + (size_t)l * 6 * MiB + 4 * MiB), DM, nullptr, 1.0f, false, scr, r, lane); continue; }
        r -= I_SQ;
        if (r < I_Q) { p0_transpose_item(a.in[20] + (size_t)l * DM * 2048, DM, 2048, (bf16_t*)(ws + WS_WQ) + (size_t)l * 2048 * DM, DM, a.in[6] + l * DM, 1.0f, false, scr, r, lane); continue; }
        r -= I_Q;
        { const int mat = r >> 1, sub = r & 1, nb = mat >> 1, gsel = mat & 1;
          const float* W = (gsel ? a.in[15] : a.in[13]) + ((size_t)l * NBLK + nb) * BS * BS;
          bf16_t* WT = (bf16_t*)(ws + WS_WG) + (((size_t)l * NBLK + nb) * 2 + gsel) * BS * BS;
          p0_transpose_item(W, BS, BS, WT, BS, nullptr, 1.0f, false, scr, sub, lane); }
    }
    { const float* ksrc = a.in[21]; bf16_t* kdst = (bf16_t*)(ws + WS_KEYS); const int n4 = DEPTH * PH * 2 * NKEY * HK / 4;
      for (int i = gw * 64 + lane; i < n4; i += NGW * 64) { const f32x4 v = ((const f32x4*)ksrc)[i]; u32x2 o; o.x = pk2(v.x, v.y); o.y = pk2(v.z, v.w); ((u32x2*)kdst)[i] = o; } }
    for (int m = gw; m < MTOT; m += 2 * NGW) {
        const int m2 = m + NGW; const bool v2 = m2 < MTOT; const int mm2 = v2 ? m2 : m;
        const f32x4* x1 = (const f32x4*)(m < M_P ? a.in[0] + (size_t)m * DM : a.in[1] + (size_t)(m - M_P) * DM) + lane;
        const f32x4* x2 = (const f32x4*)(mm2 < M_P ? a.in[0] + (size_t)mm2 * DM : a.in[1] + (size_t)(mm2 - M_P) * DM) + lane;
        f32x4 v[8]; float s1 = 0.f, s2 = 0.f;
#pragma unroll
        for (int j = 0; j < 4; ++j) { v[j] = x1[64 * j]; v[4 + j] = x2[64 * j]; }
#pragma unroll
        for (int j = 0; j < 4; ++j) { s1 += (v[j].x * v[j].x + v[j].y * v[j].y) + (v[j].z * v[j].z + v[j].w * v[j].w); s2 += (v[4 + j].x * v[4 + j].x + v[4 + j].y * v[4 + j].y) + (v[4 + j].z * v[4 + j].z + v[4 + j].w * v[4 + j].w); }
        s1 = wave_sum(s1); s2 = wave_sum(s2);
        u32x2* o1 = (u32x2*)((bf16_t*)(ws + WS_XB) + (size_t)m * DM) + lane; u32x2* o2 = (u32x2*)((bf16_t*)(ws + WS_XB) + (size_t)mm2 * DM) + lane;
#pragma unroll
        for (int j = 0; j < 4; ++j) { u32x2 w; w.x = pk2(v[j].x, v[j].y); w.y = pk2(v[j].z, v[j].w); o1[64 * j] = w; }
        if (v2) {
#pragma unroll
            for (int j = 0; j < 4; ++j) { u32x2 w; w.x = pk2(v[4 + j].x, v[4 + j].y); w.y = pk2(v[4 + j].z, v[4 + j].w); o2[64 * j] = w; } }
        if (lane == 0) { ((float*)(ws + WS_RSS))[m] = s1; if (v2) ((float*)(ws + WS_RSS))[m2] = s2; }
    }
    { float* rot = (float*)(ws + WS_ROT);
      for (int i = gw * 64 + lane; i < 2056 * 32; i += NGW * 64) {
          const int pi = i >> 5, fi = i & 31; const double pos = pi < 2048 ? (double)pi : (double)(PAST + pi - 2048);
          const double f8[8] = {1.0, 0.7498942093324559, 0.5623413251903491, 0.4216965034285822, 0.31622776601683794, 0.23713737056616552, 0.1778279410038923, 0.1333521432163324};
          double fr = 1.0; switch (fi >> 3) { case 1: fr = 0.1; break; case 2: fr = 0.01; break; case 3: fr = 0.001; break; default: break; }
          double fsel = f8[0];
#pragma unroll
          for (int q = 1; q < 8; ++q) fsel = ((fi & 7) == q) ? f8[q] : fsel;
          const double ang = pos * (fr * fsel);
          const double n = __builtin_rint(ang * 0.15915494309189535);
          double rr = __builtin_fma(-n, 6.283185307179586, ang); rr = __builtin_fma(-n, 2.4492935982947064e-16, rr);
          const float rf = (float)rr;
          rot[(size_t)pi * 64 + fi] = cosf(rf); rot[(size_t)pi * 64 + 32 + fi] = sinf(rf);
      } }
}

__device__ __forceinline__ void tab_unit(const Args& a, Frame& F, int l, int cu) {
    unsigned char* ws = a.ws;
#pragma unroll 2
    for (int j = 0; j < 16; ++j) { const int r = cu * 128 + F.wave * 16 + j, t = r >> 14, e = r & (NEXP - 1);
        const float* src = (t ? a.in[23] : a.in[22]) + ((size_t)l * NEXP + e) * DM;
        p0_tabrow(src, ws + WS_TAB + ((size_t)l * 2 + t) * 16 * MiB, (float*)(ws + WS_TSC) + ((size_t)l * 2 + t) * NEXP, e, F.lane); }
}

namespace pg8 {
struct EpiIn {
    static constexpr bool PERM = true;
    bf16_t* P; const float* rss; const float* rot;
    __device__ __forceinline__ void operator()(const f32x4 (&acc)[2][2][4][2], const Unit& u, int wr, int wc, int fr, int fq) const {
        const int seg = u.pn < 4 ? (u.pn >> 1) : (u.pn >> 2) + 1;
        const int row0 = u.pm * BM + wr * 64 + fr;
        float rstdv[8];
#pragma unroll
        for (int i = 0; i < 8; ++i) rstdv[i] = rss[row0 + (i >> 2) * HALF + (i & 3) * 16];
#pragma unroll
        for (int i = 0; i < 8; ++i) rstdv[i] = rsqrtf(rstdv[i] * (1.0f / DM) + EPS);
        if (seg <= 1) {
            float lg[2];
#pragma unroll
            for (int bj = 0; bj < 2; ++bj) { const int hh = 4 * (u.pn & 1) + 2 * bj + (wc >> 1); lg[bj] = logg_of(hh); }
            const int i0 = 16 * (wc & 1) + 4 * fq;
#pragma unroll
            for (int ai = 0; ai < 2; ++ai)
#pragma unroll
                for (int m = 0; m < 4; ++m) {
                    const int row = row0 + ai * HALF + m * 16;
                    const float rstd = rstdv[ai * 4 + m];
                    const int pi = row < M_P ? (row & (SEQ - 1)) : SEQ + ((row - M_P) & (DECT - 1));
                    const float jj1 = (float)((row < M_P ? (row & (CH - 1)) : ((row - M_P) & (DECT - 1))) + 1);
                    const f32x4 c4 = *(const f32x4*)(rot + (size_t)pi * 64 + i0), s4 = *(const f32x4*)(rot + (size_t)pi * 64 + 32 + i0);
#pragma unroll
                    for (int bj = 0; bj < 2; ++bj) {
                        const int hh = 4 * (u.pn & 1) + 2 * bj + (wc >> 1);
                        const float f = __expf(seg == 0 ? jj1 * lg[bj] : -jj1 * lg[bj]) * rstd;
                        const f32x4 v0 = acc[ai][bj][m][0], v1 = acc[ai][bj][m][1];
                        const f32x4 x1 = (f32x4){v0[0], v0[2], v1[0], v1[2]}, x2 = (f32x4){v0[1], v0[3], v1[1], v1[3]};
                        const f32x4 o1 = (x1 * c4 - x2 * s4) * f, o2 = (x1 * s4 + x2 * c4) * f;
                        bf16_t* dst = P + (size_t)row * LDP + seg * 512 + hh * 64 + i0;
                        u32x2 w1, w2; w1.x = pk2(o1[0], o1[1]); w1.y = pk2(o1[2], o1[3]); w2.x = pk2(o2[0], o2[1]); w2.y = pk2(o2[2], o2[3]);
                        *(u32x2*)dst = w1; *(u32x2*)(dst + 32) = w2;
                    }
                    if (m & 1) asm volatile("" ::: "memory");
                }
        } else {
            const int col0 = u.pn * BM + wc * 32 + 8 * fq;
#pragma unroll
            for (int ai = 0; ai < 2; ++ai)
#pragma unroll
                for (int m = 0; m < 4; ++m) {
                    const int row = row0 + ai * HALF + m * 16;
                    const float rstd = rstdv[ai * 4 + m];
                    bf16_t* rowp = P + (size_t)row * LDP + col0;
#pragma unroll
                    for (int bj = 0; bj < 2; ++bj) {
                        f32x4 v0 = acc[ai][bj][m][0] * rstd, v1 = acc[ai][bj][m][1] * rstd;
                        if (seg == 3) {
#pragma unroll
                            for (int j = 0; j < 4; ++j) { v0[j] = siluf_(v0[j]); v1[j] = siluf_(v1[j]); }
                        } else if (seg == 5) {
#pragma unroll
                            for (int j = 0; j < 4; ++j) { v0[j] = geluf_(v0[j]); v1[j] = geluf_(v1[j]); }
                        } else if (seg >= 6) {
#pragma unroll
                            for (int j = 0; j < 4; ++j) { v0[j] = sigmoidf_(v0[j]); v1[j] = sigmoidf_(v1[j]); }
                        }
                        u32x4 w; w.x = pk2(v0[0], v0[1]); w.y = pk2(v0[2], v0[3]); w.z = pk2(v1[0], v1[1]); w.w = pk2(v1[2], v1[3]);
                        *(u32x4*)(rowp + bj * HALF) = w;
                    }
                }
        }
    }
};

struct EpiMerge {
    static constexpr bool PERM = true;
    bf16_t* P;
    __device__ __forceinline__ void operator()(const f32x4 (&acc)[2][2][4][2], const Unit& u, int wr, int wc, int fr, int fq) const {
        const int row0 = u.pm * BM + wr * 64 + fr, col0 = u.pn * BM + wc * 32 + 8 * fq;
        const int gc = u.half ? PC_GB : PC_GA;
#pragma unroll
        for (int ai = 0; ai < 2; ++ai)
#pragma unroll
            for (int m = 0; m < 4; ++m) {
                bf16_t* rowp = P + (size_t)(row0 + ai * HALF + m * 16) * LDP;
#pragma unroll
                for (int bj = 0; bj < 2; ++bj) {
                    const int c = col0 + bj * HALF;
                    const u32x4 g = *(const u32x4*)(rowp + gc + c);
                    f32x4 v0 = acc[ai][bj][m][0], v1 = acc[ai][bj][m][1];
                    v0[0] *= bflo(g.x); v0[1] *= bfhi(g.x); v0[2] *= bflo(g.y); v0[3] *= bfhi(g.y);
                    v1[0] *= bflo(g.z); v1[1] *= bfhi(g.z); v1[2] *= bflo(g.w); v1[3] *= bfhi(g.w);
                    if (u.half) { const u32x4 p = *(const u32x4*)(rowp + PC_MRG + c);
                        v0[0] += bflo(p.x); v0[1] += bfhi(p.x); v0[2] += bflo(p.y); v0[3] += bfhi(p.y);
                        v1[0] += bflo(p.z); v1[1] += bfhi(p.z); v1[2] += bflo(p.w); v1[3] += bfhi(p.w); }
                    u32x4 w; w.x = pk2(v0[0], v0[1]); w.y = pk2(v0[2], v0[3]); w.z = pk2(v1[0], v1[1]); w.w = pk2(v1[2], v1[3]);
                    *(u32x4*)(rowp + PC_MRG + c) = w;
                }
                if (m & 1) asm volatile("" ::: "memory");
            }
    }
};

struct EpiWo {
    static constexpr bool PERM = false;
    const float* xp; const float* xs;
    float* X; bf16_t* XB; float* rssp;
    __device__ __forceinline__ void operator()(const f32x4 (&acc)[2][2][4][2], const Unit& u, int wr, int wc, int fr, int fq) const {
        const int row0 = u.pm * BM + wr * 64 + fr, col0 = u.pn * BM + wc * 32 + 4 * fq;
#pragma unroll
        for (int ai = 0; ai < 2; ++ai)
#pragma unroll
            for (int m = 0; m < 4; ++m) {
                const int row = row0 + ai * HALF + m * 16;
                const float* src = (row < M_P ? xp + (size_t)row * DM : xs + (size_t)(row - M_P) * DM) + col0;
                float* dst = X + (size_t)row * DM + col0; bf16_t* dstb = XB + (size_t)row * DM + col0;
                float ss = 0.f;
#pragma unroll
                for (int bj = 0; bj < 2; ++bj)
#pragma unroll
                    for (int n = 0; n < 2; ++n) {
                        const f32x4 o = *(const f32x4*)(src + bj * HALF + n * 16) + acc[ai][bj][m][n];
                        *(f32x4*)(dst + bj * HALF + n * 16) = o;
                        u32x2 w; w.x = pk2(o[0], o[1]); w.y = pk2(o[2], o[3]); *(u32x2*)(dstb + bj * HALF + n * 16) = w;
                        ss += (o[0] * o[0] + o[1] * o[1]) + (o[2] * o[2] + o[3] * o[3]);
                    }
                ss += __shfl_xor(ss, 16); ss += __shfl_xor(ss, 32);
                if (fq == 0) rssp[(size_t)(u.pn * 4 + wc) * MTOT + row] = ss;
                if (m & 1) asm volatile("" ::: "memory");
            }
    }
};

struct EpiQ {
    static constexpr bool PERM = true;
    bf16_t* P; const float* rssp; float* rss2;
    __device__ __forceinline__ void operator()(const f32x4 (&acc)[2][2][4][2], const Unit& u, int wr, int wc, int fr, int fq) const {
        const int row0 = u.pm * BM + wr * 64 + fr, col0 = u.pn * BM + wc * 32 + 8 * fq;
        float rstdv[8];
#pragma unroll
        for (int i = 0; i < 8; ++i) { const int row = row0 + (i >> 2) * HALF + (i & 3) * 16; float s = 0.f;
#pragma unroll
            for (int j = 0; j < 16; ++j) s += rssp[(size_t)j * MTOT + row];
            if (u.pn == 0 && wc == 0 && fq == 0) rss2[row] = s;
            rstdv[i] = rsqrtf(s * (1.0f / DM) + EPS);
            if ((i & 1)) asm volatile("" ::: "memory"); }
#pragma unroll
        for (int ai = 0; ai < 2; ++ai)
#pragma unroll
            for (int m = 0; m < 4; ++m) {
                const int row = row0 + ai * HALF + m * 16;
                const float rstd = rstdv[ai * 4 + m];
                bf16_t* rowp = P + (size_t)row * LDP + PC_QP + col0;
#pragma unroll
                for (int bj = 0; bj < 2; ++bj) {
                    const f32x4 v0 = acc[ai][bj][m][0] * rstd, v1 = acc[ai][bj][m][1] * rstd;
                    u32x4 w; w.x = pk2(v0[0], v0[1]); w.y = pk2(v0[2], v0[3]); w.z = pk2(v1[0], v1[1]); w.w = pk2(v1[2], v1[3]);
                    *(u32x4*)(rowp + bj * HALF) = w;
                }
            }
    }
};
}

__device__ __forceinline__ void mma32(f32x16& acc, ldsp_t A, int lda_b, ldsp_t Bt, int ldb_b, int ksteps, int lane) {
    ldsp_t ap = A + (lane & 31) * lda_b + (lane >> 5) * 16;
    ldsp_t bp = Bt + (lane & 31) * ldb_b + (lane >> 5) * 16;
    for (int ks = 0; ks < ksteps; ++ks) {
        const bf16x8 a = *(const LAS bf16x8*)(ap + ks * 32), b = *(const LAS bf16x8*)(bp + ks * 32);
        acc = __builtin_amdgcn_mfma_f32_32x32x16_bf16(a, b, acc, 0, 0, 0);
    }
}
#define ZERO16 ((f32x16){0.f,0.f,0.f,0.f,0.f,0.f,0.f,0.f,0.f,0.f,0.f,0.f,0.f,0.f,0.f,0.f})

constexpr int R_QS = 0, R_KS = 18432, R_KST = 36864, R_VST = 54272, R_SS = 89088, R_RST = 123904, R_ST = 142336;
constexpr int LD64 = 144, LD128 = 272;
__device__ __forceinline__ void ret_prompt_unit(const Args& a, Frame& F, int l, int b, int h) {
    const int tid = F.tid, lane = F.lane, w = F.wave, hi = lane >> 5, l31 = lane & 31;
    ldsp_t lds = F.lds;
    bf16_t* P = (bf16_t*)(a.ws + WS_P);
    const float lg = logg_of(h), G = __expf(128.0f * lg);
    f32x16 racc = ZERO16;
    const int db = w >> 2, eb = w & 3;
    u32x4 pq[2], pk[2], pv[4];
#define RET_FETCH(nn) do { const bf16_t* _r0 = P + ((size_t)b * SEQ + (nn) * CH + 2 * lane) * LDP; \
        pq[0] = *(const u32x4*)(_r0 + PC_Q + h * 64 + w * 8); pq[1] = *(const u32x4*)(_r0 + LDP + PC_Q + h * 64 + w * 8); \
        pk[0] = *(const u32x4*)(_r0 + PC_K + h * 64 + w * 8); pk[1] = *(const u32x4*)(_r0 + LDP + PC_K + h * 64 + w * 8); \
        pv[0] = *(const u32x4*)(_r0 + PC_V + h * 128 + w * 16); pv[1] = *(const u32x4*)(_r0 + LDP + PC_V + h * 128 + w * 16); \
        pv[2] = *(const u32x4*)(_r0 + PC_V + h * 128 + w * 16 + 8); pv[3] = *(const u32x4*)(_r0 + LDP + PC_V + h * 128 + w * 16 + 8); } while (0)
    RET_FETCH(0);
    for (int n = 0; n < 16; ++n) {
        const size_t tok0 = (size_t)b * SEQ + n * CH;
        *(LAS u32x4*)(lds + R_QS + (2 * lane) * LD64 + w * 16) = pq[0]; *(LAS u32x4*)(lds + R_QS + (2 * lane + 1) * LD64 + w * 16) = pq[1];
        *(LAS u32x4*)(lds + R_KS + (2 * lane) * LD64 + w * 16) = pk[0]; *(LAS u32x4*)(lds + R_KS + (2 * lane + 1) * LD64 + w * 16) = pk[1];
        { const unsigned a0[4] = {pk[0].x, pk[0].y, pk[0].z, pk[0].w}, a1[4] = {pk[1].x, pk[1].y, pk[1].z, pk[1].w};
#pragma unroll
          for (int j = 0; j < 4; ++j) { *(LAS unsigned*)(lds + R_KST + (w * 8 + 2 * j) * LD128 + lane * 4) = (a0[j] & 0xffffu) | (a1[j] << 16);
                                        *(LAS unsigned*)(lds + R_KST + (w * 8 + 2 * j + 1) * LD128 + lane * 4) = (a0[j] >> 16) | (a1[j] & 0xffff0000u); } }
#pragma unroll
        for (int c = 0; c < 2; ++c) { const unsigned a0[4] = {pv[2 * c].x, pv[2 * c].y, pv[2 * c].z, pv[2 * c].w}, a1[4] = {pv[2 * c + 1].x, pv[2 * c + 1].y, pv[2 * c + 1].z, pv[2 * c + 1].w};
#pragma unroll
            for (int j = 0; j < 4; ++j) { *(LAS unsigned*)(lds + R_VST + ((2 * w + c) * 8 + 2 * j) * LD128 + lane * 4) = (a0[j] & 0xffffu) | (a1[j] << 16);
                                          *(LAS unsigned*)(lds + R_VST + ((2 * w + c) * 8 + 2 * j + 1) * LD128 + lane * 4) = (a0[j] >> 16) | (a1[j] & 0xffff0000u); } }
        if (n + 1 < 16) RET_FETCH(n + 1);
#pragma unroll
        for (int g = 0; g < 4; ++g) { u32x2 wv; wv.x = pk2(racc[4 * g], racc[4 * g + 1]); wv.y = pk2(racc[4 * g + 2], racc[4 * g + 3]);
            *(LAS u32x2*)(lds + R_RST + (32 * eb + l31) * LD64 + (32 * db + 8 * g + 4 * hi) * 2) = wv; }
        __syncthreads();
#pragma unroll
        for (int t2 = 0; t2 < 2; ++t2) { const int t = 2 * w + t2, mb = t >> 2, jb = t & 3;
            if (mb <= jb) { f32x16 sacc = ZERO16;
                mma32(sacc, lds + R_KS + mb * 32 * LD64, LD64, lds + R_QS + jb * 32 * LD64, LD64, 4, lane);
                const int j = 32 * jb + l31;
#pragma unroll
                for (int g = 0; g < 4; ++g) { const int m0 = 32 * mb + 8 * g + 4 * hi; float v[4];
#pragma unroll
                    for (int q = 0; q < 4; ++q) v[q] = (j >= m0 + q) ? sacc[4 * g + q] : 0.f;
                    u32x2 wv; wv.x = pk2(v[0], v[1]); wv.y = pk2(v[2], v[3]);
                    *(LAS u32x2*)(lds + R_SS + j * LD128 + m0 * 2) = wv; } } }
        __syncthreads();
        const int jb = w >> 1, eh = w & 1;
        f32x16 oacc[2];
#pragma unroll
        for (int t = 0; t < 2; ++t) { oacc[t] = ZERO16; const int e2 = 2 * eh + t;
            mma32(oacc[t], lds + R_RST + e2 * 32 * LD64, LD64, lds + R_QS + jb * 32 * LD64, LD64, 4, lane);
            mma32(oacc[t], lds + R_VST + e2 * 32 * LD128, LD128, lds + R_SS + jb * 32 * LD128, LD128, 2 * (jb + 1), lane); }
        float s1 = 0.f, s2 = 0.f;
#pragma unroll
        for (int t = 0; t < 2; ++t)
#pragma unroll
            for (int r = 0; r < 16; ++r) { s1 += oacc[t][r]; s2 += oacc[t][r] * oacc[t][r]; }
        s1 += __shfl_xor(s1, 32); s2 += __shfl_xor(s2, 32);
        if (hi == 0) *(LAS f32x2*)(lds + R_ST + (eh * 128 + 32 * jb + l31) * 8) = (f32x2){s1, s2};
        __syncthreads();
        { const int j = 32 * jb + l31;
          const f32x2 sa = *(const LAS f32x2*)(lds + R_ST + j * 8), sb = *(const LAS f32x2*)(lds + R_ST + (128 + j) * 8);
          const float mu = (sa.x + sb.x) * (1.0f / DV), var = (sa.y + sb.y) * (1.0f / DV) - mu * mu, rstd = rsqrtf(fmaxf(var, 0.f) + EPS);
          bf16_t* prow = P + (tok0 + j) * LDP + h * 128;
#pragma unroll
          for (int t = 0; t < 2; ++t)
#pragma unroll
              for (int g = 0; g < 4; ++g) { const int e0 = 32 * (2 * eh + t) + 8 * g + 4 * hi;
                  const u32x2 gv = *(const u32x2*)(prow + PC_GR + e0);
                  const float o0 = (oacc[t][4 * g] - mu) * rstd * bflo(gv.x), o1 = (oacc[t][4 * g + 1] - mu) * rstd * bfhi(gv.x);
                  const float o2 = (oacc[t][4 * g + 2] - mu) * rstd * bflo(gv.y), o3 = (oacc[t][4 * g + 3] - mu) * rstd * bfhi(gv.y);
                  u32x2 wv; wv.x = pk2(o0, o1); wv.y = pk2(o2, o3);
                  *(u32x2*)(prow + PC_ARET + e0) = wv; } }
        mma32(racc, lds + R_KST + db * 32 * LD128, LD128, lds + R_VST + eb * 32 * LD128, LD128, 8, lane);
#pragma unroll
        for (int r = 0; r < 16; ++r) racc[r] *= G;
        __syncthreads();
    }
    float* so = a.out + O_SRP + ((((size_t)l * NBATCH + b) * HR + h) * DK) * DV;
#pragma unroll
    for (int r = 0; r < 16; ++r) { const int d = 32 * db + (r & 3) + 8 * (r >> 2) + 4 * hi; so[(size_t)d * DV + 32 * eb + l31] = racc[r]; }
#undef RET_FETCH
}

__device__ __forceinline__ void ret_sample_unit(const Args& a, Frame& F, int l, int bs, int h) {
    const int tid = F.tid, lane = F.lane, w = F.wave;
    LAS float* qd = (LAS float*)F.lds; LAS float* ku = qd + 512; LAS float* vv = ku + 512; LAS float* S = vv + 1024; LAS float* crossp = S + 64; LAS float* red = crossp + 4096;
    bf16_t* P = (bf16_t*)(a.ws + WS_P);
    const size_t tok0 = (size_t)M_P + bs * DECT;
    { const int j = tid >> 6, d = tid & 63; const bf16_t* src = P + (tok0 + j) * LDP + h * 64 + d; qd[tid] = bf1(src[PC_Q]); ku[tid] = bf1(src[PC_K]); }
#pragma unroll
    for (int i = 0; i < 2; ++i) { const int idx = tid + 512 * i, m = idx >> 7, e = idx & 127; vv[idx] = bf1(P[(tok0 + m) * LDP + PC_V + h * 128 + e]); }
    __syncthreads();
    const int dg = tid >> 7, e = tid & 127;
    const size_t soff = ((((size_t)l * DECB + bs) * HR + h) * DK) * DV;
    const float* r0 = a.in[2] + soff; float* rn = a.out + O_SRS + soff;
    const float lg = logg_of(h), G8 = __expf(8.0f * lg);
    float cross[8];
#pragma unroll
    for (int j = 0; j < 8; ++j) cross[j] = 0.f;
    float rv[16];
#pragma unroll
    for (int dd = 0; dd < 16; ++dd) rv[dd] = r0[(size_t)(dg * 16 + dd) * DV + e];
#pragma unroll
    for (int dd = 0; dd < 16; ++dd) { const int d = dg * 16 + dd; const float r = rv[dd]; float kvs = 0.f;
#pragma unroll
        for (int m = 0; m < 8; ++m) kvs += ku[m * 64 + d] * vv[m * 128 + e];
        rn[(size_t)d * DV + e] = G8 * (r + kvs);
#pragma unroll
        for (int j = 0; j < 8; ++j) cross[j] += qd[j * 64 + d] * r; }
#pragma unroll
    for (int j = 0; j < 8; ++j) crossp[(dg * 8 + j) * 128 + e] = cross[j];
    { const int pr = tid >> 3, part = tid & 7, j = pr >> 3, m = pr & 7; float sp = 0.f;
#pragma unroll
      for (int d = 0; d < 8; ++d) sp += qd[j * 64 + part * 8 + d] * ku[m * 64 + part * 8 + d];
      sp += __shfl_xor(sp, 1); sp += __shfl_xor(sp, 2); sp += __shfl_xor(sp, 4);
      if (part == 0) S[pr] = (j >= m) ? sp : 0.f; }
    __syncthreads();
    float o[2];
#pragma unroll
    for (int jj = 0; jj < 2; ++jj) { const int j = dg + 4 * jj; float s = 0.f;
#pragma unroll
        for (int g = 0; g < 4; ++g) s += crossp[(g * 8 + j) * 128 + e];
#pragma unroll
        for (int m = 0; m < 8; ++m) s += S[j * 8 + m] * vv[m * 128 + e];
        o[jj] = s;
        const float t1 = wave_sum(s), t2 = wave_sum(s * s);
        if (lane == 0) { red[(jj * 8 + w) * 2] = t1; red[(jj * 8 + w) * 2 + 1] = t2; } }
    __syncthreads();
#pragma unroll
    for (int jj = 0; jj < 2; ++jj) { const int j = dg + 4 * jj, w0 = 2 * dg;
        const float t1 = red[(jj * 8 + w0) * 2] + red[(jj * 8 + w0 + 1) * 2], t2 = red[(jj * 8 + w0) * 2 + 1] + red[(jj * 8 + w0 + 1) * 2 + 1];
        const float mu = t1 * (1.0f / DV), var = t2 * (1.0f / DV) - mu * mu, rstd = rsqrtf(fmaxf(var, 0.f) + EPS);
        bf16_t* prow = P + (tok0 + j) * LDP + h * 128 + e;
        prow[PC_ARET] = (bf16_t)f2bf((o[jj] - mu) * rstd * bf1(prow[PC_GR])); }
    __syncthreads();
}

constexpr int N_XRL = 0, N_XCF = 33536, N_XCB = 66304, N_WGT = 84736, N_CAR = 103168, N_BUF = 107264;
__device__ __forceinline__ void rnn_unit(const Args& a, Frame& F, int l, bool sample, int bg, int nb) {
    const int tid = F.tid, lane = F.lane, w = F.wave, hi = lane >> 5, l31 = lane & 31;
    ldsp_t lds = F.lds;
    LAS float* xrl = (LAS float*)(lds + N_XRL); LAS float* xcf = (LAS float*)(lds + N_XCF); LAS float* car = (LAS float*)(lds + N_CAR); LAS float* bufl = (LAS float*)(lds + N_BUF);
    LAS float* aa = xrl; LAS float* uu = xcf;
    bf16_t* P = (bf16_t*)(a.ws + WS_P);
    const int ch0 = nb * BS;
    { const bf16_t* wg = (const bf16_t*)(a.ws + WS_WG) + ((size_t)l * NBLK + nb) * 2 * BS * BS;
#pragma unroll
      for (int i = 0; i < 2; ++i) { const int p = tid + 512 * i, row = p >> 3, c8 = p & 7; *(LAS u32x4*)(lds + N_WGT + row * LD64 + c8 * 16) = *(const u32x4*)(wg + row * 64 + c8 * 8); } }
    const int cc = tid & 63;
    const float* cwp = a.in[11] + (size_t)l * 4 * DM + ch0 + cc;
    const float cw0 = cwp[0], cw1 = cwp[DM], cw2 = cwp[2 * DM], cw3 = cwp[3 * DM], cbv = a.in[12][l * DM + ch0 + cc];
    const int rb = w >> 1, cb = w & 1, dcol = 32 * cb + l31;
    const float bav = a.in[14][l * DM + ch0 + dcol], bxv = a.in[16][l * DM + ch0 + dcol];
    const float spl = log1pf(__expf(-a.in[17][l * DM + ch0 + dcol]));
    const int ntiles = sample ? 1 : 16;
    float hcar = 0.f;
    if (sample) {
        for (int i = tid; i < 16 * 3 * 64; i += NTHREADS) { const int s = i / 192, r = (i / 64) % 3, c = i & 63;
            bufl[i] = a.in[4][(((size_t)l * DECB + bg * 16 + s) * 3 + r) * DM + ch0 + c]; }
    }
    u32x4 pre[3];
#define RNN_FETCH(nn) do { const size_t _t0 = sample ? (size_t)M_P + bg * 128 : (size_t)bg * SEQ + (nn) * 128; _Pragma("unroll") for (int k = 0; k < 3; ++k) { \
        const int p = tid + 512 * k, row = p >> 3, c8 = p & 7; pre[k] = (u32x4){0u, 0u, 0u, 0u}; \
        if (p < 131 * 8 && (row >= 3 || (!sample && (nn) > 0))) pre[k] = *(const u32x4*)(P + (_t0 + row - 3) * LDP + PC_XR + ch0 + c8 * 8); } } while (0)
    RNN_FETCH(0);
    for (int n = 0; n < ntiles; ++n) {
        const size_t tok0 = sample ? (size_t)M_P + bg * 128 : (size_t)bg * SEQ + n * 128;
        unsigned short gl[16];
#pragma unroll
        for (int i = 0; i < 16; ++i) gl[i] = P[(tok0 + 16 * w + i) * LDP + PC_GN + ch0 + cc];
#pragma unroll
        for (int k = 0; k < 3; ++k) { const int p = tid + 512 * k, row = p >> 3, c8 = p & 7;
            if (p < 131 * 8) { const u32x4 v = pre[k]; LAS float* d = xrl + row * 64 + c8 * 8;
                *(LAS f32x4*)d = (f32x4){bflo(v.x), bfhi(v.x), bflo(v.y), bfhi(v.y)}; *(LAS f32x4*)(d + 4) = (f32x4){bflo(v.z), bfhi(v.z), bflo(v.w), bfhi(v.w)}; } }
        __syncthreads();
        if (n + 1 < ntiles) RNN_FETCH(n + 1);
        { const int tg = tid >> 6;
#pragma unroll 4
          for (int i = 0; i < 16; ++i) { const int t = tg * 16 + i; float x0, x1, x2;
              const float x3 = xrl[(t + 3) * 64 + cc];
              if (sample) { const int s = t >> 3, j = t & 7;
                  x0 = j >= 3 ? xrl[t * 64 + cc] : bufl[(s * 3 + j) * 64 + cc];
                  x1 = j >= 2 ? xrl[(t + 1) * 64 + cc] : bufl[(s * 3 + j + 1) * 64 + cc];
                  x2 = j >= 1 ? xrl[(t + 2) * 64 + cc] : bufl[(s * 3 + j + 2) * 64 + cc];
              } else { x0 = xrl[t * 64 + cc]; x1 = xrl[(t + 1) * 64 + cc]; x2 = xrl[(t + 2) * 64 + cc]; }
              const float xc = cbv + cw0 * x0 + cw1 * x1 + cw2 * x2 + cw3 * x3;
              xcf[t * 64 + cc] = xc; *(LAS bf16_t*)(lds + N_XCB + t * LD64 + cc * 2) = (bf16_t)f2bf(xc); } }
        if (sample) { if (tid < 192) { }     }
        if (sample) { for (int i = tid; i < 16 * 3 * 64; i += NTHREADS) { const int s = i / 192, r = (i / 64) % 3, c = i & 63;
                a.out[O_SCS + (((size_t)l * DECB + bg * 16 + s) * 3 + r) * DM + ch0 + c] = xrl[(3 + s * 8 + 5 + r) * 64 + c]; } }
        else if (n == 15) { if (tid < 192) { const int r = tid >> 6, c = tid & 63; a.out[O_SCP + (((size_t)l * NBATCH + bg) * 3 + r) * DM + ch0 + c] = xrl[(3 + 125 + r) * 64 + c]; } }
        __syncthreads();
        { f32x16 ar = ZERO16, ai = ZERO16;
          mma32(ar, lds + N_XCB + rb * 32 * LD64, LD64, lds + N_WGT + (32 * cb) * LD64, LD64, 4, lane);
          mma32(ai, lds + N_XCB + rb * 32 * LD64, LD64, lds + N_WGT + (64 + 32 * cb) * LD64, LD64, 4, lane);
#pragma unroll
          for (int r = 0; r < 16; ++r) { const int t = 32 * rb + (r & 3) + 8 * (r >> 2) + 4 * hi;
              const float rg = sigmoidf_(ar[r] + bav), ig = sigmoidf_(ai[r] + bxv);
              const float la = -8.0f * rg * spl, av = __expf(la), mult = sqrtf(fmaxf(-expm1f(2.0f * la), 0.f));
              const float xc = xcf[t * 64 + dcol];
              aa[t * 64 + dcol] = av; uu[t * 64 + dcol] = mult * ig * xc; } }
        __syncthreads();
        if (!sample) {
            float Ap = 1.f, Hl = 0.f;
#pragma unroll 4
            for (int i = 0; i < 16; ++i) { const int t = 16 * w + i; const float av = aa[t * 64 + cc], uv = uu[t * 64 + cc]; Hl = av * Hl + uv; Ap *= av; }
            car[w * 64 + cc] = Ap; car[512 + w * 64 + cc] = Hl;
            __syncthreads();
            float hin = hcar, hnext = hcar;
#pragma unroll
            for (int w2 = 0; w2 < 8; ++w2) { const float A2 = car[w2 * 64 + cc], H2 = car[512 + w2 * 64 + cc]; hnext = A2 * hnext + H2; if (w2 < w) hin = hnext; }
            float hh = hin;
#pragma unroll
            for (int i = 0; i < 16; ++i) { const int t = 16 * w + i; hh = aa[t * 64 + cc] * hh + uu[t * 64 + cc];
                P[(tok0 + t) * LDP + PC_GN + ch0 + cc] = (bf16_t)f2bf(hh * bf1(gl[i])); }
            hcar = hnext;
        } else {
#pragma unroll
            for (int s2 = 0; s2 < 2; ++s2) { const int s = 2 * w + s2, bs = bg * 16 + s;
                float hh = a.in[3][((size_t)l * DECB + bs) * DM + ch0 + cc];
#pragma unroll
                for (int j = 0; j < 8; ++j) { const int t = s * 8 + j; hh = aa[t * 64 + cc] * hh + uu[t * 64 + cc];
                    P[(tok0 + t) * LDP + PC_GN + ch0 + cc] = (bf16_t)f2bf(hh * bf1(gl[s2 * 8 + j])); }
                a.out[O_SHS + ((size_t)l * DECB + bs) * DM + ch0 + cc] = hh; }
        }
        __syncthreads();
    }
    if (!sample && w == 0) a.out[O_SHP + ((size_t)l * NBATCH + bg) * DM + ch0 + cc] = hcar;
#undef RNN_FETCH
}

__device__ __forceinline__ unsigned ord_of(float f) { const unsigned u = __builtin_bit_cast(unsigned, f); return u ^ ((u >> 31) ? 0xFFFFFFFFu : 0x80000000u); }
__device__ __forceinline__ float ord_inv(unsigned o) { const unsigned u = (o >> 31) ? (o ^ 0x80000000u) : ~o; return __builtin_bit_cast(float, u); }
__host__ __device__ constexpr bool cand_ok(int a, int b) { return (a + 1) * (b + 1) <= 16; }

#define CEX(a, b) do { const unsigned _x = (a), _y = (b); (a) = _x > _y ? _x : _y; (b) = _x > _y ? _y : _x; } while (0)
__device__ __forceinline__ void sort16_desc(unsigned (&v)[16]) {
#pragma unroll
    for (int k = 2; k <= 16; k <<= 1)
#pragma unroll
        for (int j = k >> 1; j > 0; j >>= 1)
#pragma unroll
            for (int i = 0; i < 16; ++i) { const int p = i ^ j; if (p > i) { if ((i & k) == 0) CEX(v[i], v[p]); else CEX(v[p], v[i]); } }
}
__device__ __forceinline__ void bitonic_merge16_desc(unsigned (&v)[16]) {
#pragma unroll
    for (int j = 8; j > 0; j >>= 1)
#pragma unroll
        for (int i = 0; i < 16; ++i) { const int p = i ^ j; if (p > i) CEX(v[i], v[p]); }
}
__device__ __forceinline__ void merge_top16(unsigned (&a)[16], const unsigned (&b)[16]) {
#pragma unroll
    for (int i = 0; i < 16; ++i) a[i] = a[i] > b[15 - i] ? a[i] : b[15 - i];
    bitonic_merge16_desc(a);
}

__device__ __forceinline__ void route_unit(const Args& a, int l, int tb, int h, int lane) {
    const int hi = lane >> 5, l31 = lane & 31, token = tb * 32 + l31;
    const bf16_t* P = (const bf16_t*)(a.ws + WS_P);
    const bf16_t* qrow = P + (size_t)token * LDP + PC_QP + h * 256 + hi * 8;
    const bf16_t* kbase = (const bf16_t*)(a.ws + WS_KEYS) + ((size_t)(l * PH + h) * 2) * NKEY * HK + (size_t)l31 * HK + hi * 8;
    unsigned L[2][16];
#pragma unroll
    for (int p = 0; p < 2; ++p) {
        f32x16 acc[4];
#pragma unroll
        for (int kb = 0; kb < 4; ++kb) acc[kb] = ZERO16;
#pragma unroll 2
        for (int ks = 0; ks < 8; ++ks) {
            const bf16x8 bq = *(const bf16x8*)(qrow + p * 128 + ks * 16);
#pragma unroll
            for (int kb = 0; kb < 4; ++kb) { const bf16x8 ak = *(const bf16x8*)(kbase + ((size_t)p * NKEY + kb * 32) * HK + ks * 16);
                acc[kb] = __builtin_amdgcn_mfma_f32_32x32x16_bf16(ak, bq, acc[kb], 0, 0, 0); }
        }
        unsigned g0[16], g1[16];
#pragma unroll
        for (int r = 0; r < 16; ++r) { const int key = (r & 3) + 8 * (r >> 2) + 4 * hi; g0[r] = (ord_of(acc[0][r]) & ~127u) | (unsigned)(127 - key); g1[r] = (ord_of(acc[1][r]) & ~127u) | (unsigned)(127 - (32 + key)); }
        sort16_desc(g0); sort16_desc(g1); merge_top16(g0, g1);
        unsigned g2[16];
#pragma unroll
        for (int r = 0; r < 16; ++r) { const int key = (r & 3) + 8 * (r >> 2) + 4 * hi; g1[r] = (ord_of(acc[2][r]) & ~127u) | (unsigned)(127 - (64 + key)); g2[r] = (ord_of(acc[3][r]) & ~127u) | (unsigned)(127 - (96 + key)); }
        sort16_desc(g1); sort16_desc(g2); merge_top16(g1, g2); merge_top16(g0, g1);
#pragma unroll
        for (int i = 0; i < 16; ++i) g1[i] = (unsigned)__shfl_xor((int)g0[i], 32);
        merge_top16(g0, g1);
#pragma unroll
        for (int i = 0; i < 16; ++i) L[p][i] = g0[i];
    }
    float sa[16], sb[16];
#pragma unroll
    for (int i = 0; i < 16; ++i) { sa[i] = ord_inv(L[0][i] & ~127u); sb[i] = ord_inv(L[1][i] & ~127u); }
#define CKEY(x, y) ((ord_of(sa[x] + sb[y]) & ~255u) | (unsigned)(255 - ((x) * 16 + (y))))
    unsigned best[16], t1[16];
#pragma unroll
    for (int y = 0; y < 16; ++y) { best[y] = CKEY(0, y); t1[y] = y < 8 ? CKEY(1, y) : 0u; }
    merge_top16(best, t1);
    { int n = 0;
#pragma unroll
      for (int x = 2; x < 7; ++x)
#pragma unroll
          for (int y = 0; y < 16; ++y) if (cand_ok(x, y)) { t1[n] = CKEY(x, y); ++n; }
    }
    sort16_desc(t1); merge_top16(best, t1);
    { int n = 0;
#pragma unroll
      for (int x = 7; x < 16; ++x)
#pragma unroll
          for (int y = 0; y < 16; ++y) if (cand_ok(x, y)) { t1[n] = CKEY(x, y); ++n; }
#pragma unroll
      for (int i = 10; i < 16; ++i) t1[i] = 0u;
    }
    sort16_desc(t1); merge_top16(best, t1);
#undef CKEY
    float sc[16], ssum = 0.f; const float mx = ord_inv(best[0] & ~255u);
#pragma unroll
    for (int it = 0; it < 16; ++it) { sc[it] = __expf(ord_inv(best[it] & ~255u) - mx); ssum += sc[it]; }
    const float inv = 1.0f / ssum;
    unsigned* eo = (unsigned*)(a.ws + WS_EIDX) + (size_t)token * 128 + h * 16 + hi * 8;
    float* go = (float*)(a.ws + WS_GATE) + (size_t)token * 128 + h * 16 + hi * 8;
#pragma unroll
    for (int it = 0; it < 8; ++it) {
        unsigned b0 = best[it], b1 = best[it + 8]; float g0 = sc[it], g1 = sc[it + 8];
        asm volatile("" : "+v"(b0), "+v"(b1), "+v"(g0), "+v"(g1));
        const unsigned bsel = hi ? b1 : b0; const float gsel = (hi ? g1 : g0) * inv;
        const unsigned c = 255u - (bsel & 255u), ca = c >> 4, cb = c & 15u;
        unsigned k1 = 0u, k2 = 0u;
#pragma unroll
        for (int i = 0; i < 16; ++i) { k1 = (ca == (unsigned)i) ? (127u - (L[0][i] & 127u)) : k1; k2 = (cb == (unsigned)i) ? (127u - (L[1][i] & 127u)) : k2; }
        eo[it] = k1 * 128u + k2; go[it] = gsel;
    }
}
#undef CEX

constexpr int MAXT = 9;
__device__ __forceinline__ void dec16(const u32x4 r, float (&f)[16]) {
    const unsigned w[4] = {r.x, r.y, r.z, r.w};
#pragma unroll
    for (int j = 0; j < 4; ++j) { const f32x2 a = __builtin_amdgcn_cvt_pk_f32_fp8((int)w[j], false), b = __builtin_amdgcn_cvt_pk_f32_fp8((int)w[j], true);
        f[4 * j] = a.x; f[4 * j + 1] = a.y; f[4 * j + 2] = b.x; f[4 * j + 3] = b.y; }
}
__device__ __forceinline__ void peer_phase(const Args& a, Frame& F, int l, bool lastlayer) {
    const int lane = F.lane, l7 = lane & 7, lg3 = lane >> 3;
    const int gw = F.vcu * NWAVES + F.wave, NGW = F.G * NWAVES;
    const unsigned char* TU = a.ws + WS_TAB + ((size_t)l * 2) * 16 * MiB;
    const unsigned char* TV = a.ws + WS_TAB + ((size_t)l * 2 + 1) * 16 * MiB;
    const float* SCU = (const float*)(a.ws + WS_TSC) + ((size_t)l * 2) * NEXP; const float* SCV = SCU + NEXP;
    bf16_t* XB = (bf16_t*)(a.ws + WS_XB); float* X = a.out;
    const unsigned* EI = (const unsigned*)(a.ws + WS_EIDX); const float* GT = (const float*)(a.ws + WS_GATE);
    const float* g2 = a.in[6] + (size_t)l * DM;
    LAS unsigned* st = (LAS unsigned*)(F.lds + F.wave * 16384) + lane;
#define ST_ELO(i) st[(0 * MAXT + (i)) * 64]
#define ST_EHI(i) st[(1 * MAXT + (i)) * 64]
#define ST_H0(i)  ((LAS float*)st)[(2 * MAXT + (i)) * 64]
#define ST_H1(i)  ((LAS float*)st)[(3 * MAXT + (i)) * 64]
#define ST_SSQ(i) ((LAS float*)st)[(4 * MAXT + (i)) * 64]
    const int ntok = (MTOT - gw + NGW - 1) / NGW;
    for (int i = 0; i < ntok; ++i) { const int t = gw + NGW * i; ST_ELO(i) = EI[(size_t)t * 128 + lane]; ST_EHI(i) = EI[(size_t)t * 128 + 64 + lane]; ST_H0(i) = 0.f; ST_H1(i) = 0.f; ST_SSQ(i) = 0.f; }
#define PEER_ISSUE(R, TAB, ss, ii, eword) do { const unsigned _e = (eword); _Pragma("unroll") for (int q = 0; q < 8; ++q) { \
        const unsigned idx = (unsigned)__shfl((int)_e, q * 8 + lg3); R[q] = *(const u32x4*)((TAB) + ((size_t)(ss) * NEXP + idx) * 128 + 16 * l7); } } while (0)
    for (int urep = 0; urep < REPS(7); ++urep) {
    if (urep) { for (int i = 0; i < ntok; ++i) { ST_H0(i) = 0.f; ST_H1(i) = 0.f; } }
    {
        u32x4 RA[8], RB[8];
        PEER_ISSUE(RA, TU, 0, 0, ST_ELO(0));
        u32x4 xa = *(const u32x4*)(XB + (size_t)gw * DM + 16 * l7), xb = *(const u32x4*)(XB + (size_t)gw * DM + 16 * l7 + 8);
#pragma unroll 1
        for (int s = 0; s < 8; ++s) {
            float gv[16];
#pragma unroll
            for (int j = 0; j < 4; ++j) { const f32x4 g = *(const f32x4*)(g2 + 128 * s + 16 * l7 + 4 * j); gv[4 * j] = g[0]; gv[4 * j + 1] = g[1]; gv[4 * j + 2] = g[2]; gv[4 * j + 3] = g[3]; }
#pragma unroll 1
            for (int i = 0; i < ntok; ++i) {
                PEER_ISSUE(RB, TU, s, i, ST_EHI(i));
                int sn = s, in = i + 1; if (in == ntok) { in = 0; sn = s + 1; } if (sn == 8) { sn = 7; in = ntok - 1; }
                const int tn = gw + NGW * in;
                const u32x4 xan = *(const u32x4*)(XB + (size_t)tn * DM + 128 * sn + 16 * l7), xbn = *(const u32x4*)(XB + (size_t)tn * DM + 128 * sn + 16 * l7 + 8);
                float xg[16];
                { const unsigned xw[8] = {xa.x, xa.y, xa.z, xa.w, xb.x, xb.y, xb.z, xb.w};
#pragma unroll
                  for (int j = 0; j < 8; ++j) { xg[2 * j] = bflo(xw[j]) * gv[2 * j]; xg[2 * j + 1] = bfhi(xw[j]) * gv[2 * j + 1]; } }
                float p[16];
#pragma unroll
                for (int q = 0; q < 8; ++q) { float f[16]; dec16(RA[q], f); float s0 = 0.f, s1 = 0.f;
#pragma unroll
                    for (int j = 0; j < 8; ++j) { s0 += f[2 * j] * xg[2 * j]; s1 += f[2 * j + 1] * xg[2 * j + 1]; }
                    p[q] = s0 + s1;
                    if (q < 7) asm volatile("" : "+v"(RA[q + 1].x), "+v"(RA[q + 1].y), "+v"(RA[q + 1].z), "+v"(RA[q + 1].w) : "v"(p[q])); }
                asm volatile("" :: "v"(p[7]));
                PEER_ISSUE(RA, TU, sn, in, ST_ELO(in));
#pragma unroll
                for (int q = 0; q < 8; ++q) { float f[16]; dec16(RB[q], f); float s0 = 0.f, s1 = 0.f;
#pragma unroll
                    for (int j = 0; j < 8; ++j) { s0 += f[2 * j] * xg[2 * j]; s1 += f[2 * j + 1] * xg[2 * j + 1]; }
                    p[8 + q] = s0 + s1;
                    if (q < 7) asm volatile("" : "+v"(RB[q + 1].x), "+v"(RB[q + 1].y), "+v"(RB[q + 1].z), "+v"(RB[q + 1].w) : "v"(p[8 + q])); }
                float p8[8], p4[4], p2[2];
#pragma unroll
                for (int q = 0; q < 8; ++q) { const float keep = (lane & 4) ? p[q + 8] : p[q], send = (lane & 4) ? p[q] : p[q + 8]; p8[q] = keep + __shfl_xor(send, 4); }
#pragma unroll
                for (int q = 0; q < 4; ++q) { const float keep = (lane & 2) ? p8[q + 4] : p8[q], send = (lane & 2) ? p8[q] : p8[q + 4]; p4[q] = keep + __shfl_xor(send, 2); }
#pragma unroll
                for (int q = 0; q < 2; ++q) { const float keep = (lane & 1) ? p4[q + 2] : p4[q], send = (lane & 1) ? p4[q] : p4[q + 2]; p2[q] = keep + __shfl_xor(send, 1); }
                ST_H0(i) += p2[0]; ST_H1(i) += p2[1];
                xa = xan; xb = xbn;
            }
        }
    } }
    for (int i = 0; i < ntok; ++i) { const int t = gw + NGW * i;
        const float rstd = rsqrtf(((const float*)(a.ws + WS_RSS2))[t] * (1.0f / DM) + EPS);
        const int k0 = 16 * l7 + lg3, k1 = k0 + 8; const unsigned e0 = EI[(size_t)t * 128 + k0], e1 = EI[(size_t)t * 128 + k1];
        ST_H0(i) = geluf_(ST_H0(i) * rstd * SCU[e0]) * GT[(size_t)t * 128 + k0] * SCV[e0];
        ST_H1(i) = geluf_(ST_H1(i) * rstd * SCU[e1]) * GT[(size_t)t * 128 + k1] * SCV[e1]; }
    {
        u32x4 RA[8], RB[8];
        PEER_ISSUE(RA, TV, 0, 0, ST_ELO(0));
#pragma unroll 1
        for (int s = 0; s < 8; ++s) {
#pragma unroll 1
            for (int i = 0; i < ntok; ++i) { const int t = gw + NGW * i;
                PEER_ISSUE(RB, TV, s, i, ST_EHI(i));
                int sn = s, in = i + 1; if (in == ntok) { in = 0; sn = s + 1; } if (sn == 8) { sn = 7; in = ntok - 1; }
                const int col = 128 * s + 16 * l7 + 8 * ((lane >> 5) & 1) + 4 * ((lane >> 4) & 1) + 2 * ((lane >> 3) & 1);
                f32x2 xv = *(const f32x2*)(X + (size_t)t * DM + col);
                const float h0 = ST_H0(i), h1 = ST_H1(i);
                float o[16];
#pragma unroll
                for (int j = 0; j < 16; ++j) o[j] = 0.f;
#pragma unroll
                for (int q = 0; q < 8; ++q) { const float hq = __shfl((q & 1) ? h1 : h0, (lane & ~7) | (q >> 1)); float f[16]; dec16(RA[q], f);
#pragma unroll
                    for (int j = 0; j < 16; ++j) o[j] += hq * f[j];
                    if (q < 7) asm volatile("" : "+v"(RA[q + 1].x), "+v"(RA[q + 1].y), "+v"(RA[q + 1].z), "+v"(RA[q + 1].w) : "v"(o[15])); }
                asm volatile("" :: "v"(o[15]));
                PEER_ISSUE(RA, TV, sn, in, ST_ELO(in));
#pragma unroll
                for (int q = 0; q < 8; ++q) { const float hq = __shfl((q & 1) ? h1 : h0, (lane & ~7) | (4 + (q >> 1))); float f[16]; dec16(RB[q], f);
#pragma unroll
                    for (int j = 0; j < 16; ++j) o[j] += hq * f[j];
                    if (q < 7) asm volatile("" : "+v"(RB[q + 1].x), "+v"(RB[q + 1].y), "+v"(RB[q + 1].z), "+v"(RB[q + 1].w) : "v"(o[15])); }
                float o8[8], o4[4], o2[2];
#pragma unroll
                for (int q = 0; q < 8; ++q) { const float keep = (lane & 32) ? o[q + 8] : o[q], send = (lane & 32) ? o[q] : o[q + 8]; o8[q] = keep + __shfl_xor(send, 32); }
#pragma unroll
                for (int q = 0; q < 4; ++q) { const float keep = (lane & 16) ? o8[q + 4] : o8[q], send = (lane & 16) ? o8[q] : o8[q + 4]; o4[q] = keep + __shfl_xor(send, 16); }
#pragma unroll
                for (int q = 0; q < 2; ++q) { const float keep = (lane & 8) ? o4[q + 2] : o4[q], send = (lane & 8) ? o4[q] : o4[q + 2]; o2[q] = keep + __shfl_xor(send, 8); }
                xv.x += o2[0]; xv.y += o2[1];
                *(f32x2*)(X + (size_t)t * DM + col) = xv; *(unsigned*)(XB + (size_t)t * DM + col) = pk2(xv.x, xv.y); ST_SSQ(i) += xv.x * xv.x + xv.y * xv.y;
            }
        }
    }
#undef PEER_ISSUE
    float* RSS = (float*)(a.ws + WS_RSS);
    if (lastlayer) __threadfence();
    for (int i = 0; i < ntok; ++i) { const int t = gw + NGW * i; const float ss = wave_sum(ST_SSQ(i)); if (lane == 0) RSS[t] = ss;
        if (lastlayer) { const float* gf = a.in[7]; const float rstd = rsqrtf(ss * (1.0f / DM) + EPS); f32x4* xr = (f32x4*)(X + (size_t)t * DM) + lane;
#pragma unroll
            for (int j = 0; j < 4; ++j) { const f32x4 g = *((const f32x4*)gf + lane + 64 * j); f32x4 v = xr[64 * j]; v = v * rstd * g; xr[64 * j] = v; } } }
#undef ST_ELO
#undef ST_EHI
#undef ST_H0
#undef ST_H1
#undef ST_SSQ
}

constexpr int N_PHASES = 1 + 7 * DEPTH;
__global__ void __launch_bounds__(NTHREADS, 2) hybrid_fwd(Args args) {
    extern __shared__ __attribute__((aligned(16))) unsigned char lds_raw[];
    Frame F;
    F.lds = (ldsp_t)lds_raw;
    F.MISC = (volatile LAS unsigned*)(F.lds + MISC_OFF);
    F.tid = threadIdx.x; F.lane = F.tid & 63; F.wave = __builtin_amdgcn_readfirstlane(F.tid >> 6);
    F.G = gridDim.x; { const int bx = blockIdx.x; F.vcu = (F.G % 8 == 0) ? (bx % 8) * (F.G / 8) + bx / 8 : bx; }
    F.ctl = (unsigned*)(args.ws + WS_CTL); F.ws = args.ws; F.out = args.out;
    for (int u = F.tid; u < (LDS_BYTES - MISC_OFF) / 4; u += NTHREADS) ((LAS unsigned*)(F.lds + MISC_OFF))[u] = 0u;
    __syncthreads();
    const int lo = args.ph_lo, hi = args.ph_hi;
    XcdBarrier bar; bar.bar = F.ctl + CW_BAR; bar.x = 0; bar.st = nullptr;
    if (hi - lo > 1) bar = xcd_barrier_post(F.ctl + CW_BAR, F.MISC + 8);
#ifndef PH_MASK
#define PH_MASK 0x7FF
#endif
#define IN(k) (lo <= (k) && (k) < hi)
#define PHM(b) ((PH_MASK >> (b)) & 1)
#define REPBAR() do { if (rep) xcd_barrier(bar); } while (0)
#define LAUNDER() do { asm volatile("" : "+v"(F.tid)); F.lane = F.tid & 63; F.wave = __builtin_amdgcn_readfirstlane(F.tid >> 6); } while (0)
#define SEAM(k) do { if (IN(k) && IN((k) + 1)) xcd_barrier(bar); } while (0)
    unsigned char* ws = args.ws;
    bf16_t* P = (bf16_t*)(ws + WS_P); bf16_t* XB = (bf16_t*)(ws + WS_XB);

    for (int rep = 0; rep < REPS(0); ++rep) { REPBAR(); if (PHM(0) && IN(0)) { LAUNDER(); p0_prologue(args, F); } } SEAM(0);

    for (int l = 0; l < DEPTH; ++l) {
        const int pb = 1 + 7 * l;
        for (int rep = 0; rep < REPS(1); ++rep) { REPBAR();
        if (PHM(1) && IN(pb)) { LAUNDER();
            pg8::Gemm g{XB, (const bf16_t*)(ws + WS_WIN) + (size_t)l * NIN * DM, DM, DM, 0, 0};
            pg8::StaticOrder S; S.init(MTOT, NIN, F.G, (int)blockIdx.x, 1);
            pg8::EpiIn E{P, (const float*)(ws + WS_RSS), (const float*)(ws + WS_ROT)};
            pg8::gemm_phase<pg8::EpiIn, pg8::StaticOrder, true>(F.lds, g, S, E, F.tid);
        } }
        SEAM(pb);
        if (PHM(2) && IN(pb + 1)) { LAUNDER();
            for (int u = (int)blockIdx.x; u < 192; u += F.G) {
                LAUNDER();
                if (u < 64) { if (PHM(8)) ret_prompt_unit(args, F, l, u >> 3, u & 7); }
                else { if (PHM(9)) rnn_unit(args, F, l, false, (u - 64) >> 4, (u - 64) & 15); }
            }
            unsigned* qh = F.ctl + CW_QUEUE + 64 * l;
            for (;;) {
                __syncthreads();
                if (F.tid == 0) F.MISC[0] = xb_add(qh, 1u);
                __syncthreads();
                const unsigned q = F.MISC[0];
                LAUNDER();
                if (q >= 1024u + 128u + 256u) break;
                if (q < 1024u) { if (PHM(10)) ret_sample_unit(args, F, l, (int)(q >> 3), (int)(q & 7)); }
                else if (q < 1152u) { if (PHM(9)) rnn_unit(args, F, l, true, (int)((q - 1024u) >> 4), (int)((q - 1024u) & 15)); }
                else tab_unit(args, F, l, (int)(q - 1152u));
            }
        }
        SEAM(pb + 1);
        for (int rep = 0; rep < REPS(3); ++rep) { REPBAR();
        if (PHM(3) && IN(pb + 2)) { LAUNDER();
            pg8::Gemm g{P + PC_ARET, (const bf16_t*)(ws + WS_WMIX + (size_t)l * 6 * MiB), LDP, DM, (size_t)(PC_ARNN - PC_ARET) * 2, (size_t)(2 * MiB)};
            pg8::StaticOrder S; S.init(MTOT, DM, F.G, (int)blockIdx.x, 2);
            pg8::EpiMerge E{P};
            pg8::gemm_phase<pg8::EpiMerge, pg8::StaticOrder, true>(F.lds, g, S, E, F.tid);
        } }
        SEAM(pb + 2);
        if (PHM(4) && IN(pb + 3)) { LAUNDER();
            pg8::Gemm g{P + PC_MRG, (const bf16_t*)(ws + WS_WMIX + (size_t)l * 6 * MiB + 4 * MiB), LDP, DM, 0, 0};
            pg8::StaticOrder S; S.init(MTOT, DM, F.G, (int)blockIdx.x, 1);
            pg8::EpiWo E{l == 0 ? args.in[0] : args.out, l == 0 ? args.in[1] : args.out + (size_t)M_P * DM, args.out, XB, (float*)(ws + WS_RSSP)};
            pg8::gemm_phase<pg8::EpiWo, pg8::StaticOrder, true>(F.lds, g, S, E, F.tid);
        }
        SEAM(pb + 3);
        for (int rep = 0; rep < REPS(5); ++rep) { REPBAR();
        if (PHM(5) && IN(pb + 4)) { LAUNDER();
            pg8::Gemm g{XB, (const bf16_t*)(ws + WS_WQ) + (size_t)l * 2048 * DM, DM, DM, 0, 0};
            pg8::StaticOrder S; S.init(MTOT, 2048, F.G, (int)blockIdx.x, 1);
            pg8::EpiQ E{P, (const float*)(ws + WS_RSSP), (float*)(ws + WS_RSS2)};
            pg8::gemm_phase<pg8::EpiQ, pg8::StaticOrder, true>(F.lds, g, S, E, F.tid);
        } }
        SEAM(pb + 4);
        for (int rep = 0; rep < 1; ++rep) {
        if (PHM(6) && IN(pb + 5)) { LAUNDER();
            const int gw = F.vcu * NWAVES + F.wave, NGW = F.G * NWAVES;
            for (int u = gw; u < (MTOT / 32) * PH; u += NGW) { for (int rr = 0; rr < REPS(6); ++rr) { int ln = F.lane; asm volatile("" : "+v"(ln)); route_unit(args, l, u >> 3, u & 7, ln); } }
        } }
        SEAM(pb + 5);
        if (PHM(7) && IN(pb + 6)) { LAUNDER(); peer_phase(args, F, l, l == DEPTH - 1); }
        if (l + 1 < DEPTH) SEAM(pb + 6);
    }
#undef IN
#undef SEAM
}

extern "C" void kernel_launch(void* const* d_in, const int* in_sizes, int n_in, void* d_out, int out_size, void* d_ws, size_t ws_size, hipStream_t stream) {
    static int grid = 0;
    if (grid == 0) {
        if (n_in != 24 || out_size != (int)O_END || ws_size < WS_END) { fprintf(stderr, "kernel_launch: unexpected shapes (n_in %d, out %d, ws %zu)\n", n_in, out_size, ws_size); grid = -1; return; }
        int dev = 0, cus = 0, per_cu = 0;
        if (hipGetDevice(&dev) != hipSuccess || hipDeviceGetAttribute(&cus, hipDeviceAttributeMultiprocessorCount, dev) != hipSuccess) { grid = -1; return; }
        if (hipFuncSetAttribute((const void*)hybrid_fwd, hipFuncAttributeMaxDynamicSharedMemorySize, LDS_BYTES) != hipSuccess) { fprintf(stderr, "kernel_launch: hipFuncSetAttribute failed\n"); grid = -1; return; }
        if (hipOccupancyMaxActiveBlocksPerMultiprocessor(&per_cu, (const void*)hybrid_fwd, NTHREADS, LDS_BYTES) != hipSuccess || per_cu < 1) { fprintf(stderr, "kernel_launch: occupancy query reports %d blocks per CU\n", per_cu); (void)hipGetLastError(); grid = -1; return; }
        grid = cus;
        if (grid != 256) fprintf(stderr, "kernel_launch: %d CUs; the PEER phase assumes 256 workgroups\n", grid);
    }
    if (grid < 0) return;
    (void)hipMemsetAsync((char*)d_ws + WS_CTL, 0, CTL_ZERO_BYTES, stream);
    Args a{};
    for (int i = 0; i < 24; ++i) a.in[i] = (const float*)d_in[i];
    a.out = (float*)d_out; a.ws = (unsigned char*)d_ws;
#if MK_N_LAUNCHES == 1
    a.ph_lo = 0; a.ph_hi = N_PHASES;
    void* kargs[] = {&a};
    hipError_t e = hipLaunchCooperativeKernel((const void*)hybrid_fwd, dim3(grid), dim3(NTHREADS), kargs, LDS_BYTES, stream);
    if (e != hipSuccess) fprintf(stderr, "kernel_launch: cooperative launch failed: %s (grid %d)\n", hipGetErrorString(e), grid);
#else
    for (int p = 0; p < N_PHASES; ++p) { a.ph_lo = p; a.ph_hi = p + 1; hipLaunchKernelGGL(hybrid_fwd, dim3(grid), dim3(NTHREADS), LDS_BYTES, stream, a); }
#endif
}
```

```cpp
#include <hip/hip_runtime.h>
#include <cstdio>
#include <cstdint>

#define LAS __attribute__((address_space(3)))
#define GAS __attribute__((address_space(1)))
typedef unsigned short bf16_t;
typedef short bf16x8 __attribute__((ext_vector_type(8)));
typedef float f32x2 __attribute__((ext_vector_type(2)));
typedef float f32x4 __attribute__((ext_vector_type(4)));
typedef float f32x16 __attribute__((ext_vector_type(16)));
typedef unsigned u32x2 __attribute__((ext_vector_type(2)));
typedef unsigned u32x4 __attribute__((ext_vector_type(4)));
typedef LAS unsigned char* ldsp_t;

#ifndef REP_MASK
#define REP_MASK 0
#endif
#define REPS(k) (((REP_MASK >> (k)) & 1) ? 2 : 1)
#ifndef PROBE_SEL
#define PROBE_SEL 0
#endif
#ifndef MK_N_LAUNCHES
#define MK_N_LAUNCHES 1
#endif

constexpr int DM = 1024, NIN = 7168, M_P = 16384, M_S = 1024, MTOT = 17408, DEPTH = 2;
constexpr int SEQ = 2048, NBATCH = 8, DECB = 128, DECT = 8, PAST = 16384;
constexpr int HR = 8, DK = 64, DV = 128, CH = 128;
constexpr int NBLK = 16, BS = 64;
constexpr int PH = 8, NKEY = 128, NEXP = 16384, TOPK = 16, HK = 128;
constexpr float EPS = 1e-6f;
constexpr int LDP = 7168;
constexpr int PC_Q = 0, PC_K = 512, PC_V = 1024, PC_GR = 2048, PC_XR = 3072, PC_GN = 4096, PC_GA = 5120, PC_GB = 6144;
constexpr int PC_MRG = 0, PC_ARET = 1024, PC_ARNN = 4096, PC_QP = 2048;

constexpr size_t MiB = 1u << 20;
constexpr size_t WS_CTL = 0, CTL_ZERO_BYTES = 1 * MiB;
constexpr size_t WS_ROT = 1 * MiB;
constexpr size_t WS_RSS = 2 * MiB;
constexpr size_t WS_RSS2 = 2 * MiB + 128 * 1024;
constexpr size_t WS_RSSP = 2 * MiB + 256 * 1024;
constexpr size_t WS_TSC = 3 * MiB + 512 * 1024;
constexpr size_t WS_EIDX = 4 * MiB;
constexpr size_t WS_GATE = 13 * MiB;
constexpr size_t WS_KEYS = 22 * MiB;
constexpr size_t WS_WG = 23 * MiB;
constexpr size_t WS_WIN = 24 * MiB;
constexpr size_t WS_WMIX = 52 * MiB;
constexpr size_t WS_WQ = 64 * MiB;
constexpr size_t WS_XB = 72 * MiB;
constexpr size_t WS_P = 106 * MiB;
constexpr size_t WS_TAB = 344 * MiB;
constexpr size_t WS_ARET = 408 * MiB, WS_ARNN = 442 * MiB, WS_MRG = 476 * MiB;
constexpr size_t WS_END = 510 * MiB;
static_assert(WS_P + (size_t)MTOT * LDP * 2 <= WS_TAB, "ws map");

constexpr size_t O_Y = 0, O_SRP = 17825792, O_SHP = 18874368, O_SCP = 18890752, O_SRS = 18939904, O_SHS = 35717120, O_SCS = 35979264, O_END = 36765696;

constexpr int CW_BAR = 4096;
constexpr int CW_QUEUE = 16384;
constexpr int CW_TS = 20480;

constexpr int RING_BYTES = 131072;
constexpr int LDS_BYTES = 155648;
constexpr int MISC_OFF = 153600;
constexpr int NWAVES = 8, NTHREADS = 512;

#define LDS_WAIT() asm volatile("s_waitcnt lgkmcnt(0)" ::: "memory")
#define VM_WAIT() asm volatile("s_waitcnt vmcnt(0)" ::: "memory")
#define LBAR() do { asm volatile("s_waitcnt lgkmcnt(0)" ::: "memory"); __builtin_amdgcn_s_barrier(); asm volatile("" ::: "memory"); } while (0)
#define RLX_AGENT __ATOMIC_RELAXED, __HIP_MEMORY_SCOPE_AGENT

__device__ __forceinline__ unsigned f2bf(float f) { unsigned u = __builtin_bit_cast(unsigned, f); return (u + 0x7fffu + ((u >> 16) & 1u)) >> 16; }
typedef __bf16 bf16x2_t __attribute__((ext_vector_type(2)));
__device__ __forceinline__ unsigned pk2(float lo, float hi) { const f32x2 v = {lo, hi}; const bf16x2_t b = __builtin_convertvector(v, bf16x2_t); return __builtin_bit_cast(unsigned, b); }
__device__ __forceinline__ float bflo(unsigned w) { return __builtin_bit_cast(float, w << 16); }
__device__ __forceinline__ float bfhi(unsigned w) { return __builtin_bit_cast(float, w & 0xffff0000u); }
__device__ __forceinline__ float bf1(bf16_t h) { return __builtin_bit_cast(float, (unsigned)h << 16); }
__device__ __forceinline__ float sigmoidf_(float x) { return __builtin_amdgcn_rcpf(1.0f + __expf(-x)); }
__device__ __forceinline__ float siluf_(float x) { return x * sigmoidf_(x); }
__device__ __forceinline__ float geluf_(float x) { return x * sigmoidf_(1.5957691216057308f * (x + 0.044715f * x * x * x)); }
__device__ __forceinline__ float logg_of(int h) { return log1pf(-exp2f((float)(-5 - h))); }

namespace pg8 {
constexpr int BM = 256, BK = 64, HALF = 128, HTB = HALF * BK * 2, STAGE_BYTES = 8 * HTB, NXCD = 8, WGM = 8;
__host__ __device__ __forceinline__ int lds_byte(int r, int c) { const int st = (r >> 4) * 2 + (c >> 5), rr = r & 15, cc = c & 31, ob = rr * 64 + cc * 2; return st * 1024 + (ob ^ (((ob >> 9) & 1) << 5)); }
__host__ __device__ __forceinline__ void stage_rc(int b, int& R, int& C) { const int st = b / 1024, sb = b % 1024, swz = sb ^ (((sb >> 9) & 1) << 5); R = (st >> 1) * 16 + swz / 64; C = (st & 1) * 32 + (swz % 64) / 2; }
__host__ __device__ __forceinline__ int perm32(int rho) { const int n = rho >> 4, i = rho & 15; return 8 * (i >> 2) + 4 * n + (i & 3); }

struct Unit { int pm, pn, half; };
struct Gemm { const bf16_t* A; const bf16_t* Bt; int lda, K; size_t aoff2, boff2; };

struct StaticOrder {
    int nM, nN, nwg, G, c, pairs;
    __device__ void init(int M, int N, int G_, int c_, int pairs_) { nM = M / BM; nN = N / BM; nwg = nM * nN; G = G_; c = c_; pairs = pairs_; }
    __device__ bool next(int i, Unit& u) const {
        const int it = (pairs == 2) ? (i >> 1) : i;
        const long L = (long)it * G + c; if (L >= nwg) return false;
        int wgid = (int)L; { const int q = nwg / NXCD, r = nwg % NXCD, xcd = wgid % NXCD, off = wgid / NXCD; wgid = (xcd < r ? xcd * (q + 1) : r * (q + 1) + (xcd - r) * q) + off; }
        const int nig = WGM * nN, gid = wgid / nig, fm = gid * WGM, gsz = (nM - fm) < WGM ? (nM - fm) : WGM;
        u.pm = fm + ((wgid % nig) % gsz); u.pn = (wgid % nig) / gsz; u.half = (pairs == 2) ? (i & 1) : 0; return true;
    }
};

template <class Epi, class Sched, bool ALIGN_EPI>
__device__ __forceinline__ void gemm_phase(ldsp_t lds, const Gemm g, const Sched& S, const Epi& E, const int tid) {
    const int wid = __builtin_amdgcn_readfirstlane(tid >> 6), lane = tid & 63, wr = wid >> 2, wc = wid & 3, fr = lane & 15, fq = lane >> 4;
    const int K = g.K, nt = K / BK;
    unsigned voffA[2], voffB[2];
#pragma unroll
    for (int i = 0; i < 2; ++i) { int R, C; stage_rc(tid * 16 + i * 8192, R, C); const int Rb = Epi::PERM ? ((R & ~31) + perm32(R & 31)) : R;
        voffA[i] = (unsigned)(R * g.lda + C) * 2u; voffB[i] = (unsigned)(Rb * K + C) * 2u; }
    const size_t kstep = (size_t)(BK * 2);
    const size_t hstepA = (size_t)HALF * g.lda * 2, hstepB = (size_t)HALF * K * 2;
    const size_t tstepA = 2 * hstepA, tstepB = 2 * hstepB;
    const unsigned ldsw = (unsigned)wid * 1024u;
    const int aoff = lds_byte(wr * 64 + fr, fq * 8), boff = lds_byte(wc * 32 + fr, fq * 8);
#define PG8_SA(b, h) (((b) * 2 + (h)) * HTB)
#define PG8_SB(b, h) ((4 + (b) * 2 + (h)) * HTB)
#define PG8_STAGE(bufoff, gbase, voff) do { _Pragma("unroll") for (int _i = 0; _i < 2; ++_i) \
        __builtin_amdgcn_global_load_lds((const unsigned*)((const char*)(gbase) + (voff)[_i]), (LAS unsigned*)(lds + (bufoff) + ldsw + _i * 8192), 16, 0, 0); } while (0)
#define PG8_LDA(dst, b, h) do { _Pragma("unroll") for (int m = 0; m < 4; ++m) _Pragma("unroll") for (int k = 0; k < 2; ++k) dst[m][k] = *(const LAS bf16x8*)(lds + PG8_SA(b, h) + aoff + m * 2048 + k * 1024); } while (0)
#define PG8_LDB(dst, b, h) do { _Pragma("unroll") for (int n = 0; n < 2; ++n) _Pragma("unroll") for (int k = 0; k < 2; ++k) dst[n][k] = *(const LAS bf16x8*)(lds + PG8_SB(b, h) + boff + n * 2048 + k * 1024); } while (0)
#define PG8_MMA(ai, bj, At, Bt) do { __builtin_amdgcn_s_setprio(1); _Pragma("unroll") for (int m = 0; m < 4; ++m) _Pragma("unroll") for (int n = 0; n < 2; ++n) _Pragma("unroll") for (int k = 0; k < 2; ++k) \
        acc[ai][bj][m][n] = __builtin_amdgcn_mfma_f32_16x16x32_bf16(Bt[n][k], At[m][k], acc[ai][bj][m][n], 0, 0, 0); __builtin_amdgcn_s_setprio(0); } while (0)
#define PG8_WAIT_V(n) asm volatile("s_waitcnt vmcnt(" #n ")" ::: "memory")
#define PG8_WAIT_L(n) asm volatile("s_waitcnt lgkmcnt(" #n ")" ::: "memory")
#define PG8_BAR __builtin_amdgcn_s_barrier()
#define PG8_SCHED __builtin_amdgcn_sched_barrier(0)
    Unit cur, nxt; int ui = 0;
    if (!S.next(0, cur)) return;
    f32x4 acc[2][2][4][2];
#pragma unroll
    for (int a = 0; a < 2; ++a)
#pragma unroll
        for (int b = 0; b < 2; ++b)
#pragma unroll
            for (int m = 0; m < 4; ++m)
#pragma unroll
                for (int n = 0; n < 2; ++n) acc[a][b][m][n] = (f32x4){0.f, 0.f, 0.f, 0.f};
    bf16x8 At[4][2], B0[2][2], B1[2][2];
    const char* cA = (const char*)g.A + (size_t)cur.pm * tstepA + (cur.half ? g.aoff2 : 0); const char* cB = (const char*)g.Bt + (size_t)cur.pn * tstepB + (cur.half ? g.boff2 : 0);
    PG8_STAGE(PG8_SB(0, 0), cB, voffB); PG8_STAGE(PG8_SB(0, 1), cB + hstepB, voffB); PG8_STAGE(PG8_SA(0, 0), cA, voffA); PG8_STAGE(PG8_SA(0, 1), cA + hstepA, voffA);
    if (wr == 1) PG8_BAR;
    PG8_WAIT_V(2); PG8_BAR;
    PG8_STAGE(PG8_SB(1, 0), cB + kstep, voffB); PG8_STAGE(PG8_SA(1, 0), cA + kstep, voffA); PG8_STAGE(PG8_SB(1, 1), cB + hstepB + kstep, voffB);
    PG8_WAIT_V(6); PG8_BAR;
    for (;;) {
        const bool has_next = S.next(ui + 1, nxt);
        const char* nA = has_next ? (const char*)g.A + (size_t)nxt.pm * tstepA + (nxt.half ? g.aoff2 : 0) : cA;
        const char* nB = has_next ? (const char*)g.Bt + (size_t)nxt.pn * tstepB + (nxt.half ? g.boff2 : 0) : cB;
        for (int t = 0; t < nt; t += 2) {
            const bool last = (t == nt - 2);
            const char* a1 = cA + (size_t)(t + 1) * kstep;
            const char* a2 = last ? nA : cA + (size_t)(t + 2) * kstep; const char* b2 = last ? nB : cB + (size_t)(t + 2) * kstep;
            const char* a3 = a2 + kstep; const char* b3 = b2 + kstep;
            PG8_LDB(B0, 0, 0); PG8_LDB(B1, 0, 1); PG8_SCHED; PG8_LDA(At, 0, 0); PG8_STAGE(PG8_SA(1, 1), a1 + hstepA, voffA);
            PG8_WAIT_V(8); PG8_WAIT_L(0); PG8_BAR; PG8_MMA(0, 0, At, B0); PG8_MMA(0, 1, At, B1); PG8_BAR; PG8_SCHED;
            PG8_LDA(At, 0, 1); PG8_STAGE(PG8_SB(0, 0), b2, voffB); PG8_STAGE(PG8_SB(0, 1), b2 + hstepB, voffB); PG8_STAGE(PG8_SA(0, 0), a2, voffA);
            PG8_WAIT_V(8); PG8_WAIT_L(0); PG8_BAR; PG8_MMA(1, 0, At, B0); PG8_MMA(1, 1, At, B1); PG8_BAR; PG8_SCHED;
            PG8_LDB(B0, 1, 0); PG8_LDB(B1, 1, 1); PG8_SCHED; PG8_LDA(At, 1, 0); PG8_STAGE(PG8_SA(0, 1), a2 + hstepA, voffA);
            PG8_WAIT_V(8); PG8_WAIT_L(0); PG8_BAR; PG8_MMA(0, 0, At, B0); PG8_MMA(0, 1, At, B1); PG8_BAR; PG8_SCHED;
            PG8_LDA(At, 1, 1); PG8_STAGE(PG8_SB(1, 0), b3, voffB); PG8_STAGE(PG8_SB(1, 1), b3 + hstepB, voffB); PG8_STAGE(PG8_SA(1, 0), a3, voffA);
            PG8_WAIT_V(8); PG8_WAIT_L(0); PG8_BAR; PG8_MMA(1, 0, At, B0); PG8_MMA(1, 1, At, B1); PG8_BAR; PG8_SCHED;
        }
        if constexpr (ALIGN_EPI) { if (wr == 0) PG8_BAR; }
        E(acc, cur, wr, wc, fr, fq);
        if (!has_next) break;
#pragma unroll
        for (int a = 0; a < 2; ++a)
#pragma unroll
            for (int b = 0; b < 2; ++b)
#pragma unroll
                for (int m = 0; m < 4; ++m)
#pragma unroll
                    for (int n = 0; n < 2; ++n) acc[a][b][m][n] = (f32x4){0.f, 0.f, 0.f, 0.f};
        cur = nxt; cA = nA; cB = nB; ++ui;
        if constexpr (ALIGN_EPI) { if (wr == 1) PG8_BAR; }
    }
    PG8_WAIT_V(0);
    if constexpr (!ALIGN_EPI) { if (wr == 0) PG8_BAR; }
    PG8_BAR;
#undef PG8_SA
#undef PG8_SB
#undef PG8_STAGE
#undef PG8_LDA
#undef PG8_LDB
#undef PG8_MMA
#undef PG8_WAIT_V
#undef PG8_WAIT_L
#undef PG8_BAR
#undef PG8_SCHED
}
}

typedef GAS unsigned gu32;
#define XB_TMO      128
#define XB_XCNT(j)  (256  + 64 * (j))
#define XB_XSUB(j)  (1280 + 64 * (j))
#define XB_XGEN(j)  (2304 + 64 * (j))
#define XB_TOP      3328
#define XB_TOPGEN   3392
#define XCD_BAR_WORDS 3456
#define XB_SPIN_CAP (1u << 18)
__device__ __forceinline__ unsigned xb_ld(unsigned* p)              { return __hip_atomic_load(p, __ATOMIC_RELAXED, __HIP_MEMORY_SCOPE_AGENT); }
__device__ __forceinline__ unsigned xb_add(unsigned* p, unsigned v) { return __hip_atomic_fetch_add(p, v, __ATOMIC_RELAXED, __HIP_MEMORY_SCOPE_AGENT); }
__device__ __forceinline__ unsigned xb_xcc_id() { return (unsigned)__builtin_amdgcn_s_getreg((3 << 11) | 20) & 0xFu; }
#define XB_SPIN(cond, bar) do { unsigned _sp = 0; while (cond) { __builtin_amdgcn_s_sleep(1); \
    if ((++_sp & 255u) == 0u) { if (xb_ld(&(bar)[XB_TMO])) break; if (_sp > XB_SPIN_CAP) { atomicAdd(&(bar)[XB_TMO], 1u); break; } } } } while (0)
struct XcdBarrier { unsigned* bar; unsigned x; volatile LAS unsigned* st; };
__device__ __forceinline__ XcdBarrier xcd_barrier_post(unsigned* bar, volatile LAS unsigned* st) {
    XcdBarrier b; b.bar = bar; b.x = (unsigned)__builtin_amdgcn_readfirstlane((int)xb_xcc_id()); b.st = st;
    if (threadIdx.x == 0) (void)xb_add(&bar[XB_XCNT(b.x)], 1u);
    return b;
}
__device__ __forceinline__ void xcd_barrier_complete(unsigned* bar, unsigned x, unsigned& nloc, unsigned& nx) {
    const unsigned G = gridDim.x * gridDim.y * gridDim.z;
    unsigned sum, cnt, mine, sp = 0u;
    for (;;) {
        sum = 0u; cnt = 0u; mine = 0u;
#pragma unroll
        for (unsigned j = 0; j < 16; ++j) { const unsigned c = xb_ld(&bar[XB_XCNT(j)]); sum += c; cnt += (c > 0u) ? 1u : 0u; mine = (j == x) ? c : mine; }
        if (sum == G) break;
        __builtin_amdgcn_s_sleep(1);
        if ((++sp & 255u) == 0u) { if (xb_ld(&bar[XB_TMO])) break; if (sp > XB_SPIN_CAP) { atomicAdd(&bar[XB_TMO], 1u); break; } }
    }
    nloc = mine > 0u ? mine : 1u; nx = cnt > 0u ? cnt : 1u;
}
__device__ __forceinline__ void xcd_barrier(const XcdBarrier& b) {
    asm volatile("s_waitcnt vmcnt(0)" ::: "memory");
    __syncthreads();
    if (threadIdx.x == 0) {
        unsigned* bar = b.bar; const unsigned bx = (unsigned)__builtin_amdgcn_readfirstlane((int)b.x);
        __builtin_amdgcn_s_waitcnt(0);
        unsigned nloc = b.st[0], nx = b.st[1];
        if (nloc == 0u) { xcd_barrier_complete(bar, bx, nloc, nx); b.st[0] = nloc; b.st[1] = nx; }
        const unsigned old = xb_add(&bar[XB_XSUB(bx)], 1u);
        const unsigned gen = old / nloc;
        if (old + 1u == (gen + 1u) * nloc) {
            __builtin_amdgcn_fence(__ATOMIC_RELEASE, "agent");
            asm volatile("s_waitcnt vmcnt(0)" ::: "memory");
            const unsigned og = xb_add(&bar[XB_TOP], 1u);
            const unsigned tg = og / nx;
            if (og + 1u == (tg + 1u) * nx) xb_add(&bar[XB_TOPGEN], 1u);
            else XB_SPIN(xb_ld(&bar[XB_TOPGEN]) == tg, bar);
            __builtin_amdgcn_fence(__ATOMIC_ACQUIRE, "agent");
            xb_add(&bar[XB_XGEN(bx)], 1u);
            asm volatile("s_waitcnt vmcnt(0)" ::: "memory");
        } else {
            XB_SPIN(xb_ld(&bar[XB_XGEN(bx)]) == gen, bar);
            __builtin_amdgcn_fence(__ATOMIC_ACQUIRE, "agent");
            asm volatile("s_waitcnt vmcnt(0)" ::: "memory");
        }
    }
    __syncthreads();
}

struct Frame {
    ldsp_t lds;
    volatile LAS unsigned* MISC;
    unsigned* ctl;
    int tid, lane, wave, vcu, G;
    const float* const* in;
    unsigned char* ws;
    float* out;
};
struct Args { const float* in[24]; float* out; unsigned char* ws; int ph_lo, ph_hi; };

__device__ __forceinline__ float wave_sum(float v) {
#pragma unroll
    for (int o = 1; o < 64; o <<= 1) v += __shfl_xor(v, o);
    return v;
}

__device__ __forceinline__ void p0_transpose_item(const float* W, int K, int N, bf16_t* WT, int ldk, const float* rowscale, float colscale, bool qkperm, LAS float* scr, int item, int lane) {
    const int nblk = N / 32, kb = item / nblk, nb = item % nblk, k0 = 64 * kb, n0 = 32 * nb;
    int srcn = n0 + (lane & 31);
    if (qkperm) { const int p = srcn & 63; srcn = (srcn & ~63) + ((p & 1) ? 32 + (p >> 1) : (p >> 1)); }
#pragma unroll 16
    for (int i = 0; i < 32; ++i) { const int kk = 2 * i + (lane >> 5); float v = W[(size_t)(k0 + kk) * N + srcn] * colscale; if (rowscale) v *= rowscale[k0 + kk]; scr[kk * 33 + (lane & 31)] = v; }
    LDS_WAIT(); asm volatile("" ::: "memory");
    const int c = lane & 7;
#pragma unroll
    for (int j = 0; j < 4; ++j) { const int n = (lane >> 3) + 8 * j; const LAS float* s = scr + (8 * c) * 33 + n;
        u32x4 o; o.x = pk2(s[0 * 33], s[1 * 33]); o.y = pk2(s[2 * 33], s[3 * 33]); o.z = pk2(s[4 * 33], s[5 * 33]); o.w = pk2(s[6 * 33], s[7 * 33]);
        *(u32x4*)(WT + (size_t)(n0 + n) * ldk + k0 + 8 * c) = o; }
    LDS_WAIT(); asm volatile("" ::: "memory");
}

__device__ __forceinline__ void p0_xrow(const float* xrow, bf16_t* orow, float* rss, int lane) {
    const f32x4* xr = (const f32x4*)xrow + lane;
    f32x4 v[4]; float s = 0.f;
#pragma unroll
    for (int j = 0; j < 4; ++j) { v[j] = xr[64 * j]; s += (v[j].x * v[j].x + v[j].y * v[j].y) + (v[j].z * v[j].z + v[j].w * v[j].w); }
    s = wave_sum(s);
    u32x2* o8 = (u32x2*)orow + lane;
#pragma unroll
    for (int j = 0; j < 4; ++j) { u32x2 w; w.x = pk2(v[j].x, v[j].y); w.y = pk2(v[j].z, v[j].w); o8[64 * j] = w; }
    if (lane == 0) *rss = s;
}

__device__ __forceinline__ void p0_tabrow(const float* row, unsigned char* img, float* isc, int e, int lane) {
    const f32x4* xr = (const f32x4*)row + lane;
    f32x4 v[4]; float am = 0.f;
#pragma unroll
    for (int j = 0; j < 4; ++j) { v[j] = xr[64 * j]; am = fmaxf(am, fmaxf(fmaxf(fabsf(v[j].x), fabsf(v[j].y)), fmaxf(fabsf(v[j].z), fabsf(v[j].w)))); }
#pragma unroll
    for (int o = 1; o < 64; o <<= 1) am = fmaxf(am, __shfl_xor(am, o));
    const float sc = am > 0.f ? exp2f(floorf(log2f(224.0f / am))) : 1.0f;
#pragma unroll
    for (int j = 0; j < 4; ++j) { const int col = 256 * j + 4 * lane, sl = col >> 7, w = col & 127;
        int pk = __builtin_amdgcn_cvt_pk_fp8_f32(v[j].x * sc, v[j].y * sc, 0, false);
        pk = __builtin_amdgcn_cvt_pk_fp8_f32(v[j].z * sc, v[j].w * sc, pk, true);
        *(int*)(img + ((size_t)sl * NEXP + e) * 128 + w) = pk; }
    if (lane == 0) isc[e] = 1.0f / sc;
}

__device__ __forceinline__ void p0_prologue(const Args& a, Frame& F) {
    unsigned char* ws = a.ws;
    LAS float* scr = (LAS float*)(F.lds + F.wave * 16384);
    const int gw = F.vcu * NWAVES + F.wave, NGW = F.G * NWAVES, lane = F.lane;
    constexpr int I_IN = (DM / 64) * (NIN / 32), I_SQ = (DM / 64) * (DM / 32), I_Q = (DM / 64) * (2048 / 32), I_G = 2;
    constexpr int PER_L = I_IN + 3 * I_SQ + I_Q + 32 * I_G;
    for (int it = gw; it < DEPTH * PER_L; it += NGW) {
        const int l = it / PER_L; int r = it % PER_L;
        if (r < I_IN) { const int nb = r % (NIN / 32), n0 = nb * 32; const int seg = n0 >> 9;
            p0_transpose_item(a.in[8] + (size_t)l * DM * NIN, DM, NIN, (bf16_t*)(ws + WS_WIN) + (size_t)l * NIN * DM, DM, a.in[5] + l * DM, seg == 1 ? 0.125f : 1.0f, seg <= 1, scr, r, lane); continue; }
        r -= I_IN;
        if (r < I_SQ) { p0_transpose_item(a.in[10] + (size_t)l * DM * DM, DM, DM, (bf16_t*)(ws + WS_WMIX + (size_t)l * 6 * MiB), DM, a.in[9] + l * DM, 1.0f, false, scr, r, lane); continue; }
        r -= I_SQ;
        if (r < I_SQ) { p0_transpose_item(a.in[18] + (size_t)l * DM * DM, DM, DM, (bf16_t*)(ws + WS_WMIX + (size_t)l * 6 * MiB + 2 * MiB), DM, nullptr, 1.0f, false, scr, r, lane); continue; }
        r -= I_SQ;
        if (r < I_SQ) { p0_transpose_item(a.in[19] + (size_t)l * DM * DM, DM, DM, (bf16_t*)(ws + WS_WMIX + (size_t)l * 6 * MiB + 4 * MiB), DM, nullptr, 1.0f, false, scr, r, lane); continue; }
        r -= I_SQ;
        if (r < I_Q) { p0_transpose_item(a.in[20] + (size_t)l * DM * 2048, DM, 2048, (bf16_t*)(ws + WS_WQ) + (size_t)l * 2048 * DM, DM, a.in[6] + l * DM, 1.0f, false, scr, r, lane); continue; }
        r -= I_Q;
        { const int mat = r >> 1, sub = r & 1, nb = mat >> 1, gsel = mat & 1;
          const float* W = (gsel ? a.in[15] : a.in[13]) + ((size_t)l * NBLK + nb) * BS * BS;
          bf16_t* WT = (bf16_t*)(ws + WS_WG) + (((size_t)l * NBLK + nb) * 2 + gsel) * BS * BS;
          p0_transpose_item(W, BS, BS, WT, BS, nullptr, 1.0f, false, scr, sub, lane); }
    }
    { const float* ksrc = a.in[21]; bf16_t* kdst = (bf16_t*)(ws + WS_KEYS); const int n4 = DEPTH * PH * 2 * NKEY * HK / 4;
      for (int i = gw * 64 + lane; i < n4; i += NGW * 64) { const f32x4 v = ((const f32x4*)ksrc)[i]; u32x2 o; o.x = pk2(v.x, v.y); o.y = pk2(v.z, v.w); ((u32x2*)kdst)[i] = o; } }
    for (int m = gw; m < MTOT; m += 2 * NGW) {
        const int m2 = m + NGW; const bool v2 = m2 < MTOT; const int mm2 = v2 ? m2 : m;
        const f32x4* x1 = (const f32x4*)(m < M_P ? a.in[0] + (size_t)m * DM : a.in[1] + (size_t)(m - M_P) * DM) + lane;
        const f32x4* x2 = (const f32x4*)(mm2 < M_P ? a.in[0] + (size_t)mm2 * DM : a.in[1] + (size_t)(mm2 - M_P) * DM) + lane;
        f32x4 v[8]; float s1 = 0.f, s2 = 0.f;
#pragma unroll
        for (int j = 0; j < 4; ++j) { v[j] = x1[64 * j]; v[4 + j] = x2[64 * j]; }
#pragma unroll
        for (int j = 0; j < 4; ++j) { s1 += (v[j].x * v[j].x + v[j].y * v[j].y) + (v[j].z * v[j].z + v[j].w * v[j].w); s2 += (v[4 + j].x * v[4 + j].x + v[4 + j].y * v[4 + j].y) + (v[4 + j].z * v[4 + j].z + v[4 + j].w * v[4 + j].w); }
        s1 = wave_sum(s1); s2 = wave_sum(s2);
        u32x2* o1 = (u32x2*)((bf16_t*)(ws + WS_XB) + (size_t)m * DM) + lane; u32x2* o2 = (u32x2*)((bf16_t*)(ws + WS_XB) + (size_t)mm2 * DM) + lane;
#pragma unroll
        for (int j = 0; j < 4; ++j) { u32x2 w; w.x = pk2(v[j].x, v[j].y); w.y = pk2(v[j].z, v[j].w); o1[64 * j] = w; }
        if (v2) {
#pragma unroll
            for (int j = 0; j < 4; ++j) { u32x2 w; w.x = pk2(v[4 + j].x, v[4 + j].y); w.y = pk2(v[4 + j].z, v[4 + j].w); o2[64 * j] = w; } }
        if (lane == 0) { ((float*)(ws + WS_RSS))[m] = s1; if (v2) ((float*)(ws + WS_RSS))[m2] = s2; }
    }
    { float* rot = (float*)(ws + WS_ROT);
      for (int i = gw * 64 + lane; i < 2056 * 32; i += NGW * 64) {
          const int pi = i >> 5, fi = i & 31; const double pos = pi < 2048 ? (double)pi : (double)(PAST + pi - 2048);
          const double f8[8] = {1.0, 0.7498942093324559, 0.5623413251903491, 0.4216965034285822, 0.31622776601683794, 0.23713737056616552, 0.1778279410038923, 0.1333521432163324};
          double fr = 1.0; switch (fi >> 3) { case 1: fr = 0.1; break; case 2: fr = 0.01; break; case 3: fr = 0.001; break; default: break; }
          double fsel = f8[0];
#pragma unroll
          for (int q = 1; q < 8; ++q) fsel = ((fi & 7) == q) ? f8[q] : fsel;
          const double ang = pos * (fr * fsel);
          const double n = __builtin_rint(ang * 0.15915494309189535);
          double rr = __builtin_fma(-n, 6.283185307179586, ang); rr = __builtin_fma(-n, 2.4492935982947064e-16, rr);
          const float rf = (float)rr;
          rot[(size_t)pi * 64 + fi] = cosf(rf); rot[(size_t)pi * 64 + 32 + fi] = sinf(rf);
      } }
}

__device__ __forceinline__ void tab_unit(const Args& a, Frame& F, int l, int cu) {
    unsigned char* ws = a.ws;
#pragma unroll 2
    for (int j = 0; j < 16; ++j) { const int r = cu * 128 + F.wave * 16 + j, t = r >> 14, e = r & (NEXP - 1);
        const float* src = (t ? a.in[23] : a.in[22]) + ((size_t)l * NEXP + e) * DM;
        p0_tabrow(src, ws + WS_TAB + ((size_t)l * 2 + t) * 16 * MiB, (float*)(ws + WS_TSC) + ((size_t)l * 2 + t) * NEXP, e, F.lane); }
}

namespace pg8 {
struct EpiIn {
    static constexpr bool PERM = true;
    bf16_t* P; const float* rss; const float* rot;
    __device__ __forceinline__ void operator()(const f32x4 (&acc)[2][2][4][2], const Unit& u, int wr, int wc, int fr, int fq) const {
        const int seg = u.pn < 4 ? (u.pn >> 1) : (u.pn >> 2) + 1;
        const int row0 = u.pm * BM + wr * 64 + fr;
#if PROBE_SEL
        const float* rstdv = rss + row0;
#define RSTD_AT(ai, m) rstdv[(ai) * HALF + (m) * 16]
#else
        float rstdv[8];
#pragma unroll
        for (int i = 0; i < 8; ++i) rstdv[i] = rss[row0 + (i >> 2) * HALF + (i & 3) * 16];
#define RSTD_AT(ai, m) rstdv[(ai) * 4 + (m)]
#endif
        if (seg <= 1) {
            float lg[2];
#pragma unroll
            for (int bj = 0; bj < 2; ++bj) { const int hh = 4 * (u.pn & 1) + 2 * bj + (wc >> 1); lg[bj] = logg_of(hh); }
            const int i0 = 16 * (wc & 1) + 4 * fq;
#pragma unroll
            for (int ai = 0; ai < 2; ++ai)
#pragma unroll
                for (int m = 0; m < 4; ++m) {
                    const int row = row0 + ai * HALF + m * 16;
                    const float rstd = rsqrtf(RSTD_AT(ai, m) * (1.0f / DM) + EPS);
                    asm volatile("" ::: "memory");
                    const int pi = row < M_P ? (row & (SEQ - 1)) : SEQ + ((row - M_P) & (DECT - 1));
                    const float jj1 = (float)((row < M_P ? (row & (CH - 1)) : ((row - M_P) & (DECT - 1))) + 1);
                    const float* rp = rot + (size_t)pi * 64 + i0;
#pragma unroll
                    for (int bj = 0; bj < 2; ++bj) {
                        const int hh = 4 * (u.pn & 1) + 2 * bj + (wc >> 1);
                        const float f = __expf(seg == 0 ? jj1 * lg[bj] : -jj1 * lg[bj]) * rstd;
                        bf16_t* dst = P + (size_t)row * LDP + seg * 512 + hh * 64 + i0;
#pragma unroll
                        for (int n = 0; n < 2; ++n) {
                            const f32x2 c2 = *(const f32x2*)(rp + 2 * n), s2 = *(const f32x2*)(rp + 32 + 2 * n);
                            const f32x4 v = acc[ai][bj][m][n];
                            const float a0 = (v[0] * c2.x - v[1] * s2.x) * f, a1 = (v[2] * c2.y - v[3] * s2.y) * f;
                            const float b0 = (v[0] * s2.x + v[1] * c2.x) * f, b1 = (v[2] * s2.y + v[3] * c2.y) * f;
                            *(unsigned*)(dst + 2 * n) = pk2(a0, a1); *(unsigned*)(dst + 32 + 2 * n) = pk2(b0, b1);
                        }
                    }
                    if (m & 1) asm volatile("" ::: "memory");
                }
        } else {
            const int col0 = u.pn * BM + wc * 32 + 8 * fq;
#pragma unroll
            for (int ai = 0; ai < 2; ++ai)
#pragma unroll
                for (int m = 0; m < 4; ++m) {
                    const int row = row0 + ai * HALF + m * 16;
                    const float rstd = rsqrtf(RSTD_AT(ai, m) * (1.0f / DM) + EPS);
                    bf16_t* rowp = P + (size_t)row * LDP + col0;
#pragma unroll
                    for (int bj = 0; bj < 2; ++bj) {
                        f32x4 v0 = acc[ai][bj][m][0] * rstd, v1 = acc[ai][bj][m][1] * rstd;
                        if (seg == 3) {
#pragma unroll
                            for (int j = 0; j < 4; ++j) { v0[j] = siluf_(v0[j]); v1[j] = siluf_(v1[j]); }
                        } else if (seg == 5) {
#pragma unroll
                            for (int j = 0; j < 4; ++j) { v0[j] = geluf_(v0[j]); v1[j] = geluf_(v1[j]); }
                        } else if (seg >= 6) {
#pragma unroll
                            for (int j = 0; j < 4; ++j) { v0[j] = sigmoidf_(v0[j]); v1[j] = sigmoidf_(v1[j]); }
                        }
                        u32x4 w; w.x = pk2(v0[0], v0[1]); w.y = pk2(v0[2], v0[3]); w.z = pk2(v1[0], v1[1]); w.w = pk2(v1[2], v1[3]);
                        *(u32x4*)(rowp + bj * HALF) = w;
                    }
                }
        }
    }
};

struct EpiMerge {
    static constexpr bool PERM = true;
    bf16_t* P; bf16_t* MRG;
    __device__ __forceinline__ void operator()(const f32x4 (&acc)[2][2][4][2], const Unit& u, int wr, int wc, int fr, int fq) const {
        const int row0 = u.pm * BM + wr * 64 + fr, col0 = u.pn * BM + wc * 32 + 8 * fq;
        const int gc = u.half ? PC_GB : PC_GA;
#pragma unroll
        for (int ai = 0; ai < 2; ++ai)
#pragma unroll
            for (int m = 0; m < 4; ++m) {
                bf16_t* rowp = P + (size_t)(row0 + ai * HALF + m * 16) * LDP; bf16_t* mrow = MRG + (size_t)(row0 + ai * HALF + m * 16) * DM;
#pragma unroll
                for (int bj = 0; bj < 2; ++bj) {
                    const int c = col0 + bj * HALF;
                    const u32x4 g = *(const u32x4*)(rowp + gc + c);
                    f32x4 v0 = acc[ai][bj][m][0], v1 = acc[ai][bj][m][1];
                    v0[0] *= bflo(g.x); v0[1] *= bfhi(g.x); v0[2] *= bflo(g.y); v0[3] *= bfhi(g.y);
                    v1[0] *= bflo(g.z); v1[1] *= bfhi(g.z); v1[2] *= bflo(g.w); v1[3] *= bfhi(g.w);
                    if (u.half) { const u32x4 p = *(const u32x4*)(mrow + c);
                        v0[0] += bflo(p.x); v0[1] += bfhi(p.x); v0[2] += bflo(p.y); v0[3] += bfhi(p.y);
                        v1[0] += bflo(p.z); v1[1] += bfhi(p.z); v1[2] += bflo(p.w); v1[3] += bfhi(p.w); }
                    u32x4 w; w.x = pk2(v0[0], v0[1]); w.y = pk2(v0[2], v0[3]); w.z = pk2(v1[0], v1[1]); w.w = pk2(v1[2], v1[3]);
                    *(u32x4*)(mrow + c) = w;
                }
                if (m & 1) asm volatile("" ::: "memory");
            }
    }
};

struct EpiWo {
    static constexpr bool PERM = false;
    const float* xp; const float* xs;
    float* X; bf16_t* XB; float* rssp;
    __device__ __forceinline__ void operator()(const f32x4 (&acc)[2][2][4][2], const Unit& u, int wr, int wc, int fr, int fq) const {
        const int row0 = u.pm * BM + wr * 64 + fr, col0 = u.pn * BM + wc * 32 + 4 * fq;
#pragma unroll
        for (int ai = 0; ai < 2; ++ai)
#pragma unroll
            for (int m = 0; m < 4; ++m) {
                const int row = row0 + ai * HALF + m * 16;
                const float* src = (row < M_P ? xp + (size_t)row * DM : xs + (size_t)(row - M_P) * DM) + col0;
                float* dst = X + (size_t)row * DM + col0; bf16_t* dstb = XB + (size_t)row * DM + col0;
                float ss = 0.f;
#pragma unroll
                for (int bj = 0; bj < 2; ++bj)
#pragma unroll
                    for (int n = 0; n < 2; ++n) {
                        const f32x4 o = *(const f32x4*)(src + bj * HALF + n * 16) + acc[ai][bj][m][n];
                        *(f32x4*)(dst + bj * HALF + n * 16) = o;
                        u32x2 w; w.x = pk2(o[0], o[1]); w.y = pk2(o[2], o[3]); *(u32x2*)(dstb + bj * HALF + n * 16) = w;
                        ss += (o[0] * o[0] + o[1] * o[1]) + (o[2] * o[2] + o[3] * o[3]);
                    }
                ss += __shfl_xor(ss, 16); ss += __shfl_xor(ss, 32);
                if (fq == 0) rssp[(size_t)(u.pn * 4 + wc) * MTOT + row] = ss;
                if (m & 1) asm volatile("" ::: "memory");
            }
    }
};

struct EpiQ {
    static constexpr bool PERM = true;
    bf16_t* P; const float* rssp; float* rss2;
    __device__ __forceinline__ void operator()(const f32x4 (&acc)[2][2][4][2], const Unit& u, int wr, int wc, int fr, int fq) const {
        const int row0 = u.pm * BM + wr * 64 + fr, col0 = u.pn * BM + wc * 32 + 8 * fq;
        float rstdv[8];
#pragma unroll
        for (int i = 0; i < 8; ++i) { const int row = row0 + (i >> 2) * HALF + (i & 3) * 16; float s = 0.f;
#pragma unroll
            for (int j = 0; j < 16; ++j) s += rssp[(size_t)j * MTOT + row];
            if (u.pn == 0 && wc == 0 && fq == 0) rss2[row] = s;
            rstdv[i] = rsqrtf(s * (1.0f / DM) + EPS);
            if ((i & 1)) asm volatile("" ::: "memory"); }
#pragma unroll
        for (int ai = 0; ai < 2; ++ai)
#pragma unroll
            for (int m = 0; m < 4; ++m) {
                const int row = row0 + ai * HALF + m * 16;
                const float rstd = rstdv[ai * 4 + m];
                bf16_t* rowp = P + (size_t)row * LDP + PC_QP + col0;
#pragma unroll
                for (int bj = 0; bj < 2; ++bj) {
                    const f32x4 v0 = acc[ai][bj][m][0] * rstd, v1 = acc[ai][bj][m][1] * rstd;
                    u32x4 w; w.x = pk2(v0[0], v0[1]); w.y = pk2(v0[2], v0[3]); w.z = pk2(v1[0], v1[1]); w.w = pk2(v1[2], v1[3]);
                    *(u32x4*)(rowp + bj * HALF) = w;
                }
            }
    }
};
}

__device__ __forceinline__ void mma32(f32x16& acc, ldsp_t A, int lda_b, ldsp_t Bt, int ldb_b, int ksteps, int lane) {
    ldsp_t ap = A + (lane & 31) * lda_b + (lane >> 5) * 16;
    ldsp_t bp = Bt + (lane & 31) * ldb_b + (lane >> 5) * 16;
    for (int ks = 0; ks < ksteps; ++ks) {
        const bf16x8 a = *(const LAS bf16x8*)(ap + ks * 32), b = *(const LAS bf16x8*)(bp + ks * 32);
        acc = __builtin_amdgcn_mfma_f32_32x32x16_bf16(a, b, acc, 0, 0, 0);
    }
}
template <int KS>
__device__ __forceinline__ void mma32t(f32x16& acc, ldsp_t A, int lda_b, ldsp_t Bt, int ldb_b, int lane) {
    ldsp_t ap = A + (lane & 31) * lda_b + (lane >> 5) * 16;
    ldsp_t bp = Bt + (lane & 31) * ldb_b + (lane >> 5) * 16;
    bf16x8 av[KS], bv[KS];
#pragma unroll
    for (int ks = 0; ks < KS; ++ks) { av[ks] = *(const LAS bf16x8*)(ap + ks * 32); bv[ks] = *(const LAS bf16x8*)(bp + ks * 32); }
#pragma unroll
    for (int ks = 0; ks < KS; ++ks) acc = __builtin_amdgcn_mfma_f32_32x32x16_bf16(av[ks], bv[ks], acc, 0, 0, 0);
}
#define ZERO16 ((f32x16){0.f,0.f,0.f,0.f,0.f,0.f,0.f,0.f,0.f,0.f,0.f,0.f,0.f,0.f,0.f,0.f})

constexpr int R_QS = 0, R_KS = 18432, R_KST = 36864, R_VST = 54272, R_SS = 89088, R_RST = 123904, R_ST = 142336;
constexpr int LD64 = 144, LD128 = 272;
__device__ __forceinline__ void ret_prompt_unit(const Args& a, Frame& F, int l, int b, int h) {
    const int tid = F.tid, lane = F.lane, w = F.wave, hi = lane >> 5, l31 = lane & 31;
    ldsp_t lds = F.lds;
    bf16_t* P = (bf16_t*)(a.ws + WS_P);
    const float lg = logg_of(h), G = __expf(128.0f * lg);
    f32x16 racc = ZERO16;
    const int db = w >> 2, eb = w & 3;
    u32x4 pq[2], pk[2], pv[4];
#define RET_FETCH(nn) do { const bf16_t* _r0 = P + ((size_t)b * SEQ + (nn) * CH + 2 * lane) * LDP; \
        pq[0] = *(const u32x4*)(_r0 + PC_Q + h * 64 + w * 8); pq[1] = *(const u32x4*)(_r0 + LDP + PC_Q + h * 64 + w * 8); \
        pk[0] = *(const u32x4*)(_r0 + PC_K + h * 64 + w * 8); pk[1] = *(const u32x4*)(_r0 + LDP + PC_K + h * 64 + w * 8); \
        pv[0] = *(const u32x4*)(_r0 + PC_V + h * 128 + w * 16); pv[1] = *(const u32x4*)(_r0 + LDP + PC_V + h * 128 + w * 16); \
        pv[2] = *(const u32x4*)(_r0 + PC_V + h * 128 + w * 16 + 8); pv[3] = *(const u32x4*)(_r0 + LDP + PC_V + h * 128 + w * 16 + 8); } while (0)
    RET_FETCH(0);
    for (int i = tid; i < 128 * LD128 / 16; i += NTHREADS) *(LAS u32x4*)(lds + R_SS + i * 16) = (u32x4){0u, 0u, 0u, 0u};
    for (int n = 0; n < 16; ++n) {
        const size_t tok0 = (size_t)b * SEQ + n * CH;
        *(LAS u32x4*)(lds + R_QS + (2 * lane) * LD64 + w * 16) = pq[0]; *(LAS u32x4*)(lds + R_QS + (2 * lane + 1) * LD64 + w * 16) = pq[1];
        *(LAS u32x4*)(lds + R_KS + (2 * lane) * LD64 + w * 16) = pk[0]; *(LAS u32x4*)(lds + R_KS + (2 * lane + 1) * LD64 + w * 16) = pk[1];
        { const unsigned a0[4] = {pk[0].x, pk[0].y, pk[0].z, pk[0].w}, a1[4] = {pk[1].x, pk[1].y, pk[1].z, pk[1].w};
#pragma unroll
          for (int j = 0; j < 4; ++j) { *(LAS unsigned*)(lds + R_KST + (w * 8 + 2 * j) * LD128 + lane * 4) = (a0[j] & 0xffffu) | (a1[j] << 16);
                                        *(LAS unsigned*)(lds + R_KST + (w * 8 + 2 * j + 1) * LD128 + lane * 4) = (a0[j] >> 16) | (a1[j] & 0xffff0000u); } }
#pragma unroll
        for (int c = 0; c < 2; ++c) { const unsigned a0[4] = {pv[2 * c].x, pv[2 * c].y, pv[2 * c].z, pv[2 * c].w}, a1[4] = {pv[2 * c + 1].x, pv[2 * c + 1].y, pv[2 * c + 1].z, pv[2 * c + 1].w};
#pragma unroll
            for (int j = 0; j < 4; ++j) { *(LAS unsigned*)(lds + R_VST + ((2 * w + c) * 8 + 2 * j) * LD128 + lane * 4) = (a0[j] & 0xffffu) | (a1[j] << 16);
                                          *(LAS unsigned*)(lds + R_VST + ((2 * w + c) * 8 + 2 * j + 1) * LD128 + lane * 4) = (a0[j] >> 16) | (a1[j] & 0xffff0000u); } }
        if (n + 1 < 16) RET_FETCH(n + 1);
#pragma unroll
        for (int g = 0; g < 4; ++g) { u32x2 wv; wv.x = pk2(racc[4 * g], racc[4 * g + 1]); wv.y = pk2(racc[4 * g + 2], racc[4 * g + 3]);
            *(LAS u32x2*)(lds + R_RST + (32 * eb + l31) * LD64 + (32 * db + 8 * g + 4 * hi) * 2) = wv; }
        LBAR();
#pragma unroll
        for (int t2 = 0; t2 < 2; ++t2) { const int t = 2 * w + t2, mb = t >> 2, jb = t & 3;
            if (mb <= jb) { f32x16 sacc = ZERO16;
                mma32t<4>(sacc, lds + R_KS + mb * 32 * LD64, LD64, lds + R_QS + jb * 32 * LD64, LD64, lane);
                const int j = 32 * jb + l31;
#pragma unroll
                for (int g = 0; g < 4; ++g) { const int m0 = 32 * mb + 8 * g + 4 * hi; float v[4];
#pragma unroll
                    for (int q = 0; q < 4; ++q) v[q] = (j >= m0 + q) ? sacc[4 * g + q] : 0.f;
                    u32x2 wv; wv.x = pk2(v[0], v[1]); wv.y = pk2(v[2], v[3]);
                    *(LAS u32x2*)(lds + R_SS + j * LD128 + m0 * 2) = wv; } } }
        LBAR();
        const int jb = w >> 1, eh = w & 1;
        f32x16 oacc[2];
        u32x2 gpre[2][4];
        { const bf16_t* prow = P + (tok0 + 32 * jb + l31) * LDP + h * 128 + PC_GR;
#pragma unroll
          for (int t = 0; t < 2; ++t)
#pragma unroll
              for (int g = 0; g < 4; ++g) gpre[t][g] = *(const u32x2*)(prow + 32 * (2 * eh + t) + 8 * g + 4 * hi); }
#pragma unroll
        for (int t = 0; t < 2; ++t) { oacc[t] = ZERO16; const int e2 = 2 * eh + t;
            mma32t<4>(oacc[t], lds + R_RST + e2 * 32 * LD64, LD64, lds + R_QS + jb * 32 * LD64, LD64, lane);
            mma32t<8>(oacc[t], lds + R_VST + e2 * 32 * LD128, LD128, lds + R_SS + jb * 32 * LD128, LD128, lane); }
        float s1 = 0.f, s2 = 0.f;
#pragma unroll
        for (int t = 0; t < 2; ++t)
#pragma unroll
            for (int r = 0; r < 16; ++r) { s1 += oacc[t][r]; s2 += oacc[t][r] * oacc[t][r]; }
        s1 += __shfl_xor(s1, 32); s2 += __shfl_xor(s2, 32);
        if (hi == 0) *(LAS f32x2*)(lds + R_ST + (eh * 128 + 32 * jb + l31) * 8) = (f32x2){s1, s2};
        LBAR();
        { const int j = 32 * jb + l31;
          const f32x2 sa = *(const LAS f32x2*)(lds + R_ST + j * 8), sb = *(const LAS f32x2*)(lds + R_ST + (128 + j) * 8);
          const float mu = (sa.x + sb.x) * (1.0f / DV), var = (sa.y + sb.y) * (1.0f / DV) - mu * mu, rstd = rsqrtf(fmaxf(var, 0.f) + EPS);
          bf16_t* prow = P + (tok0 + j) * LDP + h * 128; bf16_t* arow = (bf16_t*)(a.ws + WS_ARET) + (tok0 + j) * DM + h * 128;
#pragma unroll
          for (int t = 0; t < 2; ++t)
#pragma unroll
              for (int g = 0; g < 4; ++g) { const int e0 = 32 * (2 * eh + t) + 8 * g + 4 * hi;
                  const u32x2 gv = gpre[t][g];
                  const float o0 = (oacc[t][4 * g] - mu) * rstd * bflo(gv.x), o1 = (oacc[t][4 * g + 1] - mu) * rstd * bfhi(gv.x);
                  const float o2 = (oacc[t][4 * g + 2] - mu) * rstd * bflo(gv.y), o3 = (oacc[t][4 * g + 3] - mu) * rstd * bfhi(gv.y);
                  u32x2 wv; wv.x = pk2(o0, o1); wv.y = pk2(o2, o3);
                  *(u32x2*)(arow + e0) = wv; } }
        mma32t<8>(racc, lds + R_KST + db * 32 * LD128, LD128, lds + R_VST + eb * 32 * LD128, LD128, lane);
#pragma unroll
        for (int r = 0; r < 16; ++r) racc[r] *= G;
        LBAR();
    }
    float* so = a.out + O_SRP + ((((size_t)l * NBATCH + b) * HR + h) * DK) * DV;
#pragma unroll
    for (int r = 0; r < 16; ++r) { const int d = 32 * db + (r & 3) + 8 * (r >> 2) + 4 * hi; so[(size_t)d * DV + 32 * eb + l31] = racc[r]; }
#undef RET_FETCH
}

__device__ __forceinline__ void ret_sample_unit(const Args& a, Frame& F, int l, int bs, int h) {
    const int tid = F.tid, lane = F.lane, w = F.wave;
    LAS float* qd = (LAS float*)F.lds; LAS float* ku = qd + 512; LAS float* vv = ku + 512; LAS float* S = vv + 1024; LAS float* crossp = S + 64; LAS float* red = crossp + 4096;
    bf16_t* P = (bf16_t*)(a.ws + WS_P);
    const size_t tok0 = (size_t)M_P + bs * DECT;
    { const int j = tid >> 6, d = tid & 63; const bf16_t* src = P + (tok0 + j) * LDP + h * 64 + d; qd[tid] = bf1(src[PC_Q]); ku[tid] = bf1(src[PC_K]); }
#pragma unroll
    for (int i = 0; i < 2; ++i) { const int idx = tid + 512 * i, m = idx >> 7, e = idx & 127; vv[idx] = bf1(P[(tok0 + m) * LDP + PC_V + h * 128 + e]); }
    LBAR();
    const int dg = tid >> 7, e = tid & 127;
    const size_t soff = ((((size_t)l * DECB + bs) * HR + h) * DK) * DV;
    const float* r0 = a.in[2] + soff; float* rn = a.out + O_SRS + soff;
    const float lg = logg_of(h), G8 = __expf(8.0f * lg);
    float cross[8];
#pragma unroll
    for (int j = 0; j < 8; ++j) cross[j] = 0.f;
    float rv[16];
#pragma unroll
    for (int dd = 0; dd < 16; ++dd) rv[dd] = r0[(size_t)(dg * 16 + dd) * DV + e];
#pragma unroll
    for (int dd = 0; dd < 16; ++dd) { const int d = dg * 16 + dd; const float r = rv[dd]; float kvs = 0.f;
#pragma unroll
        for (int m = 0; m < 8; ++m) kvs += ku[m * 64 + d] * vv[m * 128 + e];
        rn[(size_t)d * DV + e] = G8 * (r + kvs);
#pragma unroll
        for (int j = 0; j < 8; ++j) cross[j] += qd[j * 64 + d] * r; }
#pragma unroll
    for (int j = 0; j < 8; ++j) crossp[(dg * 8 + j) * 128 + e] = cross[j];
    { const int pr = tid >> 3, part = tid & 7, j = pr >> 3, m = pr & 7; float sp = 0.f;
#pragma unroll
      for (int d = 0; d < 8; ++d) sp += qd[j * 64 + part * 8 + d] * ku[m * 64 + part * 8 + d];
      sp += __shfl_xor(sp, 1); sp += __shfl_xor(sp, 2); sp += __shfl_xor(sp, 4);
      if (part == 0) S[pr] = (j >= m) ? sp : 0.f; }
    LBAR();
    float o[2];
#pragma unroll
    for (int jj = 0; jj < 2; ++jj) { const int j = dg + 4 * jj; float s = 0.f;
#pragma unroll
        for (int g = 0; g < 4; ++g) s += crossp[(g * 8 + j) * 128 + e];
#pragma unroll
        for (int m = 0; m < 8; ++m) s += S[j * 8 + m] * vv[m * 128 + e];
        o[jj] = s;
        const float t1 = wave_sum(s), t2 = wave_sum(s * s);
        if (lane == 0) { red[(jj * 8 + w) * 2] = t1; red[(jj * 8 + w) * 2 + 1] = t2; } }
    LBAR();
#pragma unroll
    for (int jj = 0; jj < 2; ++jj) { const int j = dg + 4 * jj, w0 = 2 * dg;
        const float t1 = red[(jj * 8 + w0) * 2] + red[(jj * 8 + w0 + 1) * 2], t2 = red[(jj * 8 + w0) * 2 + 1] + red[(jj * 8 + w0 + 1) * 2 + 1];
        const float mu = t1 * (1.0f / DV), var = t2 * (1.0f / DV) - mu * mu, rstd = rsqrtf(fmaxf(var, 0.f) + EPS);
        const bf16_t* prow = P + (tok0 + j) * LDP + h * 128 + e;
        ((bf16_t*)(a.ws + WS_ARET))[(tok0 + j) * DM + h * 128 + e] = (bf16_t)f2bf((o[jj] - mu) * rstd * bf1(prow[PC_GR])); }
    LBAR();
}

constexpr int N_XRL = 0, N_XCF = 33536, N_XCB = 66304, N_WGT = 84736, N_CAR = 103168, N_BUF = 107264;
__device__ __forceinline__ void rnn_unit(const Args& a, Frame& F, int l, bool sample, int bg, int nb) {
    const int tid = F.tid, lane = F.lane, w = F.wave, hi = lane >> 5, l31 = lane & 31;
    ldsp_t lds = F.lds;
    LAS float* xrl = (LAS float*)(lds + N_XRL); LAS float* xcf = (LAS float*)(lds + N_XCF); LAS float* car = (LAS float*)(lds + N_CAR); LAS float* bufl = (LAS float*)(lds + N_BUF);
    LAS float* aa = xrl; LAS float* uu = xcf;
    bf16_t* P = (bf16_t*)(a.ws + WS_P);
    const int ch0 = nb * BS;
    { const bf16_t* wg = (const bf16_t*)(a.ws + WS_WG) + ((size_t)l * NBLK + nb) * 2 * BS * BS;
#pragma unroll
      for (int i = 0; i < 2; ++i) { const int p = tid + 512 * i, row = p >> 3, c8 = p & 7; *(LAS u32x4*)(lds + N_WGT + row * LD64 + c8 * 16) = *(const u32x4*)(wg + row * 64 + c8 * 8); } }
    const int cc = tid & 63;
    const float* cwp = a.in[11] + (size_t)l * 4 * DM + ch0 + cc;
    const float cw0 = cwp[0], cw1 = cwp[DM], cw2 = cwp[2 * DM], cw3 = cwp[3 * DM], cbv = a.in[12][l * DM + ch0 + cc];
    const int rb = w >> 1, cb = w & 1, dcol = 32 * cb + l31;
    const float bav = a.in[14][l * DM + ch0 + dcol], bxv = a.in[16][l * DM + ch0 + dcol];
    const float spl = log1pf(__expf(-a.in[17][l * DM + ch0 + dcol]));
    const int ntiles = sample ? 1 : 16;
    float hcar = 0.f;
    if (sample) {
        for (int i = tid; i < 16 * 3 * 64; i += NTHREADS) { const int s = i / 192, r = (i / 64) % 3, c = i & 63;
            bufl[i] = a.in[4][(((size_t)l * DECB + bg * 16 + s) * 3 + r) * DM + ch0 + c]; }
    }
    u32x4 pre[3];
#define RNN_FETCH(nn) do { const size_t _t0 = sample ? (size_t)M_P + bg * 128 : (size_t)bg * SEQ + (nn) * 128; _Pragma("unroll") for (int k = 0; k < 3; ++k) { \
        const int p = tid + 512 * k, row = p >> 3, c8 = p & 7; pre[k] = (u32x4){0u, 0u, 0u, 0u}; \
        if (p < 131 * 8 && (row >= 3 || (!sample && (nn) > 0))) pre[k] = *(const u32x4*)(P + (_t0 + row - 3) * LDP + PC_XR + ch0 + c8 * 8); } } while (0)
    RNN_FETCH(0);
    for (int n = 0; n < ntiles; ++n) {
        const size_t tok0 = sample ? (size_t)M_P + bg * 128 : (size_t)bg * SEQ + n * 128;
        unsigned short gl[16];
#pragma unroll
        for (int i = 0; i < 16; ++i) gl[i] = P[(tok0 + 16 * w + i) * LDP + PC_GN + ch0 + cc];
#pragma unroll
        for (int k = 0; k < 3; ++k) { const int p = tid + 512 * k, row = p >> 3, c8 = p & 7;
            if (p < 131 * 8) { const u32x4 v = pre[k]; LAS float* d = xrl + row * 64 + c8 * 8;
                *(LAS f32x4*)d = (f32x4){bflo(v.x), bfhi(v.x), bflo(v.y), bfhi(v.y)}; *(LAS f32x4*)(d + 4) = (f32x4){bflo(v.z), bfhi(v.z), bflo(v.w), bfhi(v.w)}; } }
        LBAR();
        if (n + 1 < ntiles) RNN_FETCH(n + 1);
        { const int tg = tid >> 6;
#pragma unroll 4
          for (int i = 0; i < 16; ++i) { const int t = tg * 16 + i; float x0, x1, x2;
              const float x3 = xrl[(t + 3) * 64 + cc];
              if (sample) { const int s = t >> 3, j = t & 7;
                  x0 = j >= 3 ? xrl[t * 64 + cc] : bufl[(s * 3 + j) * 64 + cc];
                  x1 = j >= 2 ? xrl[(t + 1) * 64 + cc] : bufl[(s * 3 + j + 1) * 64 + cc];
                  x2 = j >= 1 ? xrl[(t + 2) * 64 + cc] : bufl[(s * 3 + j + 2) * 64 + cc];
              } else { x0 = xrl[t * 64 + cc]; x1 = xrl[(t + 1) * 64 + cc]; x2 = xrl[(t + 2) * 64 + cc]; }
              const float xc = cbv + cw0 * x0 + cw1 * x1 + cw2 * x2 + cw3 * x3;
              xcf[t * 64 + cc] = xc; *(LAS bf16_t*)(lds + N_XCB + t * LD64 + cc * 2) = (bf16_t)f2bf(xc); } }
        if (sample) { if (tid < 192) { }     }
        if (sample) { for (int i = tid; i < 16 * 3 * 64; i += NTHREADS) { const int s = i / 192, r = (i / 64) % 3, c = i & 63;
                a.out[O_SCS + (((size_t)l * DECB + bg * 16 + s) * 3 + r) * DM + ch0 + c] = xrl[(3 + s * 8 + 5 + r) * 64 + c]; } }
        else if (n == 15) { if (tid < 192) { const int r = tid >> 6, c = tid & 63; a.out[O_SCP + (((size_t)l * NBATCH + bg) * 3 + r) * DM + ch0 + c] = xrl[(3 + 125 + r) * 64 + c]; } }
        LBAR();
        { f32x16 ar = ZERO16, ai = ZERO16;
          mma32t<4>(ar, lds + N_XCB + rb * 32 * LD64, LD64, lds + N_WGT + (32 * cb) * LD64, LD64, lane);
          mma32t<4>(ai, lds + N_XCB + rb * 32 * LD64, LD64, lds + N_WGT + (64 + 32 * cb) * LD64, LD64, lane);
#pragma unroll
          for (int r = 0; r < 16; ++r) { const int t = 32 * rb + (r & 3) + 8 * (r >> 2) + 4 * hi;
              const float rg = sigmoidf_(ar[r] + bav), ig = sigmoidf_(ai[r] + bxv);
              const float la = -8.0f * rg * spl, av = __expf(la), mult = sqrtf(fmaxf(-expm1f(2.0f * la), 0.f));
              const float xc = xcf[t * 64 + dcol];
              aa[t * 64 + dcol] = av; uu[t * 64 + dcol] = mult * ig * xc; } }
        LBAR();
        if (!sample) {
            float Ap = 1.f, Hl = 0.f;
#pragma unroll 4
            for (int i = 0; i < 16; ++i) { const int t = 16 * w + i; const float av = aa[t * 64 + cc], uv = uu[t * 64 + cc]; Hl = av * Hl + uv; Ap *= av; }
            car[w * 64 + cc] = Ap; car[512 + w * 64 + cc] = Hl;
            LBAR();
            float hin = hcar, hnext = hcar;
#pragma unroll
            for (int w2 = 0; w2 < 8; ++w2) { const float A2 = car[w2 * 64 + cc], H2 = car[512 + w2 * 64 + cc]; hnext = A2 * hnext + H2; if (w2 < w) hin = hnext; }
            float hh = hin;
#pragma unroll
            for (int i = 0; i < 16; ++i) { const int t = 16 * w + i; hh = aa[t * 64 + cc] * hh + uu[t * 64 + cc];
                ((bf16_t*)(a.ws + WS_ARNN))[(tok0 + t) * DM + ch0 + cc] = (bf16_t)f2bf(hh * bf1(gl[i])); }
            hcar = hnext;
        } else {
#pragma unroll
            for (int s2 = 0; s2 < 2; ++s2) { const int s = 2 * w + s2, bs = bg * 16 + s;
                float hh = a.in[3][((size_t)l * DECB + bs) * DM + ch0 + cc];
#pragma unroll
                for (int j = 0; j < 8; ++j) { const int t = s * 8 + j; hh = aa[t * 64 + cc] * hh + uu[t * 64 + cc];
                    ((bf16_t*)(a.ws + WS_ARNN))[(tok0 + t) * DM + ch0 + cc] = (bf16_t)f2bf(hh * bf1(gl[s2 * 8 + j])); }
                a.out[O_SHS + ((size_t)l * DECB + bs) * DM + ch0 + cc] = hh; }
        }
        LBAR();
    }
    if (!sample && w == 0) a.out[O_SHP + ((size_t)l * NBATCH + bg) * DM + ch0 + cc] = hcar;
#undef RNN_FETCH
}

__device__ __forceinline__ unsigned ord_of(float f) { const unsigned u = __builtin_bit_cast(unsigned, f); return u ^ ((u >> 31) ? 0xFFFFFFFFu : 0x80000000u); }
__device__ __forceinline__ float ord_inv(unsigned o) { const unsigned u = (o >> 31) ? (o ^ 0x80000000u) : ~o; return __builtin_bit_cast(float, u); }
__host__ __device__ constexpr bool cand_ok(int a, int b) { return (a + 1) * (b + 1) <= 16; }

#define CEX(a, b) do { const unsigned _x = (a), _y = (b); (a) = _x > _y ? _x : _y; (b) = _x > _y ? _y : _x; } while (0)
__device__ __forceinline__ void sort16_desc(unsigned (&v)[16]) {
#pragma unroll
    for (int k = 2; k <= 16; k <<= 1)
#pragma unroll
        for (int j = k >> 1; j > 0; j >>= 1)
#pragma unroll
            for (int i = 0; i < 16; ++i) { const int p = i ^ j; if (p > i) { if ((i & k) == 0) CEX(v[i], v[p]); else CEX(v[p], v[i]); } }
}
__device__ __forceinline__ void bitonic_merge16_desc(unsigned (&v)[16]) {
#pragma unroll
    for (int j = 8; j > 0; j >>= 1)
#pragma unroll
        for (int i = 0; i < 16; ++i) { const int p = i ^ j; if (p > i) CEX(v[i], v[p]); }
}
__device__ __forceinline__ void merge_top16(unsigned (&a)[16], const unsigned (&b)[16]) {
#pragma unroll
    for (int i = 0; i < 16; ++i) a[i] = a[i] > b[15 - i] ? a[i] : b[15 - i];
    bitonic_merge16_desc(a);
}

__device__ __forceinline__ void route_unit(const Args& a, int l, int tb, int h, int lane) {
    const int hi = lane >> 5, l31 = lane & 31, token = tb * 32 + l31;
    const bf16_t* P = (const bf16_t*)(a.ws + WS_P);
    const bf16_t* qrow = P + (size_t)token * LDP + PC_QP + h * 256 + hi * 8;
    const bf16_t* kbase = (const bf16_t*)(a.ws + WS_KEYS) + ((size_t)(l * PH + h) * 2) * NKEY * HK + (size_t)l31 * HK + hi * 8;
    unsigned L[2][16];
#pragma unroll
    for (int p = 0; p < 2; ++p) {
        f32x16 acc[4];
#pragma unroll
        for (int kb = 0; kb < 4; ++kb) acc[kb] = ZERO16;
#pragma unroll 2
        for (int ks = 0; ks < 8; ++ks) {
            const bf16x8 bq = *(const bf16x8*)(qrow + p * 128 + ks * 16);
#pragma unroll
            for (int kb = 0; kb < 4; ++kb) { const bf16x8 ak = *(const bf16x8*)(kbase + ((size_t)p * NKEY + kb * 32) * HK + ks * 16);
                acc[kb] = __builtin_amdgcn_mfma_f32_32x32x16_bf16(ak, bq, acc[kb], 0, 0, 0); }
        }
        unsigned g0[16], g1[16];
#pragma unroll
        for (int r = 0; r < 16; ++r) { const int key = (r & 3) + 8 * (r >> 2) + 4 * hi; g0[r] = (ord_of(acc[0][r]) & ~127u) | (unsigned)(127 - key); g1[r] = (ord_of(acc[1][r]) & ~127u) | (unsigned)(127 - (32 + key)); }
        sort16_desc(g0); sort16_desc(g1); merge_top16(g0, g1);
        unsigned g2[16];
#pragma unroll
        for (int r = 0; r < 16; ++r) { const int key = (r & 3) + 8 * (r >> 2) + 4 * hi; g1[r] = (ord_of(acc[2][r]) & ~127u) | (unsigned)(127 - (64 + key)); g2[r] = (ord_of(acc[3][r]) & ~127u) | (unsigned)(127 - (96 + key)); }
        sort16_desc(g1); sort16_desc(g2); merge_top16(g1, g2); merge_top16(g0, g1);
#pragma unroll
        for (int i = 0; i < 16; ++i) g1[i] = (unsigned)__shfl_xor((int)g0[i], 32);
        merge_top16(g0, g1);
#pragma unroll
        for (int i = 0; i < 16; ++i) L[p][i] = g0[i];
    }
    float sa[16], sb[16];
#pragma unroll
    for (int i = 0; i < 16; ++i) { sa[i] = ord_inv(L[0][i] & ~127u); sb[i] = ord_inv(L[1][i] & ~127u); }
#define CKEY(x, y) ((ord_of(sa[x] + sb[y]) & ~255u) | (unsigned)(255 - ((x) * 16 + (y))))
    unsigned best[16], t1[16];
#pragma unroll
    for (int y = 0; y < 16; ++y) { best[y] = CKEY(0, y); t1[y] = y < 8 ? CKEY(1, y) : 0u; }
    merge_top16(best, t1);
    { int n = 0;
#pragma unroll
      for (int x = 2; x < 7; ++x)
#pragma unroll
          for (int y = 0; y < 16; ++y) if (cand_ok(x, y)) { t1[n] = CKEY(x, y); ++n; }
    }
    sort16_desc(t1); merge_top16(best, t1);
    { int n = 0;
#pragma unroll
      for (int x = 7; x < 16; ++x)
#pragma unroll
          for (int y = 0; y < 16; ++y) if (cand_ok(x, y)) { t1[n] = CKEY(x, y); ++n; }
#pragma unroll
      for (int i = 10; i < 16; ++i) t1[i] = 0u;
    }
    sort16_desc(t1); merge_top16(best, t1);
#undef CKEY
    float sc[16], ssum = 0.f; const float mx = ord_inv(best[0] & ~255u);
#pragma unroll
    for (int it = 0; it < 16; ++it) { sc[it] = __expf(ord_inv(best[it] & ~255u) - mx); ssum += sc[it]; }
    const float inv = 1.0f / ssum;
    unsigned* eo = (unsigned*)(a.ws + WS_EIDX) + (size_t)token * 128 + h * 16 + hi * 8;
    float* go = (float*)(a.ws + WS_GATE) + (size_t)token * 128 + h * 16 + hi * 8;
#pragma unroll
    for (int it = 0; it < 8; ++it) {
        unsigned b0 = best[it], b1 = best[it + 8]; float g0 = sc[it], g1 = sc[it + 8];
        asm volatile("" : "+v"(b0), "+v"(b1), "+v"(g0), "+v"(g1));
        const unsigned bsel = hi ? b1 : b0; const float gsel = (hi ? g1 : g0) * inv;
        const unsigned c = 255u - (bsel & 255u), ca = c >> 4, cb = c & 15u;
        unsigned k1 = 0u, k2 = 0u;
#pragma unroll
        for (int i = 0; i < 16; ++i) { k1 = (ca == (unsigned)i) ? (127u - (L[0][i] & 127u)) : k1; k2 = (cb == (unsigned)i) ? (127u - (L[1][i] & 127u)) : k2; }
        eo[it] = k1 * 128u + k2; go[it] = gsel;
    }
}
#undef CEX

constexpr int MAXT = 9;
__device__ __forceinline__ void dec16(const u32x4 r, float (&f)[16]) {
    const unsigned w[4] = {r.x, r.y, r.z, r.w};
#pragma unroll
    for (int j = 0; j < 4; ++j) { const f32x2 a = __builtin_amdgcn_cvt_pk_f32_fp8((int)w[j], false), b = __builtin_amdgcn_cvt_pk_f32_fp8((int)w[j], true);
        f[4 * j] = a.x; f[4 * j + 1] = a.y; f[4 * j + 2] = b.x; f[4 * j + 3] = b.y; }
}
__device__ __forceinline__ void peer_phase(const Args& a, Frame& F, int l, bool lastlayer) {
    const int lane = F.lane, l7 = lane & 7, lg3 = lane >> 3;
    const int gw = F.vcu * NWAVES + F.wave, NGW = F.G * NWAVES;
    const unsigned char* TU = a.ws + WS_TAB + ((size_t)l * 2) * 16 * MiB;
    const unsigned char* TV = a.ws + WS_TAB + ((size_t)l * 2 + 1) * 16 * MiB;
    const float* SCU = (const float*)(a.ws + WS_TSC) + ((size_t)l * 2) * NEXP; const float* SCV = SCU + NEXP;
    bf16_t* XB = (bf16_t*)(a.ws + WS_XB); float* X = a.out;
    const unsigned* EI = (const unsigned*)(a.ws + WS_EIDX); const float* GT = (const float*)(a.ws + WS_GATE);
    const float* g2 = a.in[6] + (size_t)l * DM;
    LAS unsigned* st = (LAS unsigned*)(F.lds + F.wave * 16384) + lane;
#define ST_ELO(i) st[(0 * MAXT + (i)) * 64]
#define ST_EHI(i) st[(1 * MAXT + (i)) * 64]
#define ST_H0(i)  ((LAS float*)st)[(2 * MAXT + (i)) * 64]
#define ST_H1(i)  ((LAS float*)st)[(3 * MAXT + (i)) * 64]
#define ST_SSQ(i) ((LAS float*)st)[(4 * MAXT + (i)) * 64]
    const int ntok = (MTOT - gw + NGW - 1) / NGW;
    for (int i = 0; i < ntok; ++i) { const int t = gw + NGW * i; ST_ELO(i) = EI[(size_t)t * 128 + lane]; ST_EHI(i) = EI[(size_t)t * 128 + 64 + lane]; ST_H0(i) = 0.f; ST_H1(i) = 0.f; ST_SSQ(i) = 0.f; }
#define PEER_ISSUE(R, TAB, ss, ii, eword) do { const unsigned _e = (eword); _Pragma("unroll") for (int q = 0; q < 8; ++q) { \
        const unsigned idx = (unsigned)__shfl((int)_e, q * 8 + lg3); R[q] = *(const u32x4*)((TAB) + ((size_t)(ss) * NEXP + idx) * 128 + 16 * l7); } } while (0)
    for (int urep = 0; urep < REPS(7); ++urep) {
    if (urep) { for (int i = 0; i < ntok; ++i) { ST_H0(i) = 0.f; ST_H1(i) = 0.f; } }
    {
        u32x4 RA[8], RB[8];
        PEER_ISSUE(RA, TU, 0, 0, ST_ELO(0));
        u32x4 xa = *(const u32x4*)(XB + (size_t)gw * DM + 16 * l7), xb = *(const u32x4*)(XB + (size_t)gw * DM + 16 * l7 + 8);
#pragma unroll 1
        for (int s = 0; s < 8; ++s) {
            float gv[16];
#pragma unroll
            for (int j = 0; j < 4; ++j) { const f32x4 g = *(const f32x4*)(g2 + 128 * s + 16 * l7 + 4 * j); gv[4 * j] = g[0]; gv[4 * j + 1] = g[1]; gv[4 * j + 2] = g[2]; gv[4 * j + 3] = g[3]; }
#pragma unroll 1
            for (int i = 0; i < ntok; ++i) {
                PEER_ISSUE(RB, TU, s, i, ST_EHI(i));
                int sn = s, in = i + 1; if (in == ntok) { in = 0; sn = s + 1; } if (sn == 8) { sn = 7; in = ntok - 1; }
                const int tn = gw + NGW * in;
                const u32x4 xan = *(const u32x4*)(XB + (size_t)tn * DM + 128 * sn + 16 * l7), xbn = *(const u32x4*)(XB + (size_t)tn * DM + 128 * sn + 16 * l7 + 8);
                float xg[16];
                { const unsigned xw[8] = {xa.x, xa.y, xa.z, xa.w, xb.x, xb.y, xb.z, xb.w};
#pragma unroll
                  for (int j = 0; j < 8; ++j) { xg[2 * j] = bflo(xw[j]) * gv[2 * j]; xg[2 * j + 1] = bfhi(xw[j]) * gv[2 * j + 1]; } }
                float p[16];
#pragma unroll
                for (int q = 0; q < 8; ++q) { float f[16]; dec16(RA[q], f); float s0 = 0.f, s1 = 0.f;
#pragma unroll
                    for (int j = 0; j < 8; ++j) { s0 += f[2 * j] * xg[2 * j]; s1 += f[2 * j + 1] * xg[2 * j + 1]; }
                    p[q] = s0 + s1;
                    if (q < 7) asm volatile("" : "+v"(RA[q + 1].x), "+v"(RA[q + 1].y), "+v"(RA[q + 1].z), "+v"(RA[q + 1].w) : "v"(p[q])); }
                asm volatile("" :: "v"(p[7]));
                PEER_ISSUE(RA, TU, sn, in, ST_ELO(in));
#pragma unroll
                for (int q = 0; q < 8; ++q) { float f[16]; dec16(RB[q], f); float s0 = 0.f, s1 = 0.f;
#pragma unroll
                    for (int j = 0; j < 8; ++j) { s0 += f[2 * j] * xg[2 * j]; s1 += f[2 * j + 1] * xg[2 * j + 1]; }
                    p[8 + q] = s0 + s1;
                    if (q < 7) asm volatile("" : "+v"(RB[q + 1].x), "+v"(RB[q + 1].y), "+v"(RB[q + 1].z), "+v"(RB[q + 1].w) : "v"(p[8 + q])); }
                float p8[8], p4[4], p2[2];
#pragma unroll
                for (int q = 0; q < 8; ++q) { const float keep = (lane & 4) ? p[q + 8] : p[q], send = (lane & 4) ? p[q] : p[q + 8]; p8[q] = keep + __shfl_xor(send, 4); }
#pragma unroll
                for (int q = 0; q < 4; ++q) { const float keep = (lane & 2) ? p8[q + 4] : p8[q], send = (lane & 2) ? p8[q] : p8[q + 4]; p4[q] = keep + __shfl_xor(send, 2); }
#pragma unroll
                for (int q = 0; q < 2; ++q) { const float keep = (lane & 1) ? p4[q + 2] : p4[q], send = (lane & 1) ? p4[q] : p4[q + 2]; p2[q] = keep + __shfl_xor(send, 1); }
                ST_H0(i) += p2[0]; ST_H1(i) += p2[1];
                xa = xan; xb = xbn;
            }
        }
    } }
    for (int i = 0; i < ntok; ++i) { const int t = gw + NGW * i;
        const float rstd = rsqrtf(((const float*)(a.ws + WS_RSS2))[t] * (1.0f / DM) + EPS);
        const int k0 = 16 * l7 + lg3, k1 = k0 + 8; const unsigned e0 = EI[(size_t)t * 128 + k0], e1 = EI[(size_t)t * 128 + k1];
        ST_H0(i) = geluf_(ST_H0(i) * rstd * SCU[e0]) * GT[(size_t)t * 128 + k0] * SCV[e0];
        ST_H1(i) = geluf_(ST_H1(i) * rstd * SCU[e1]) * GT[(size_t)t * 128 + k1] * SCV[e1]; }
    {
        u32x4 RA[8], RB[8];
        PEER_ISSUE(RA, TV, 0, 0, ST_ELO(0));
#pragma unroll 1
        for (int s = 0; s < 8; ++s) {
#pragma unroll 1
            for (int i = 0; i < ntok; ++i) { const int t = gw + NGW * i;
                PEER_ISSUE(RB, TV, s, i, ST_EHI(i));
                int sn = s, in = i + 1; if (in == ntok) { in = 0; sn = s + 1; } if (sn == 8) { sn = 7; in = ntok - 1; }
                const int col = 128 * s + 16 * l7 + 8 * ((lane >> 5) & 1) + 4 * ((lane >> 4) & 1) + 2 * ((lane >> 3) & 1);
                f32x2 xv = *(const f32x2*)(X + (size_t)t * DM + col);
                const float h0 = ST_H0(i), h1 = ST_H1(i);
                float o[16];
#pragma unroll
                for (int j = 0; j < 16; ++j) o[j] = 0.f;
#pragma unroll
                for (int q = 0; q < 8; ++q) { const float hq = __shfl((q & 1) ? h1 : h0, (lane & ~7) | (q >> 1)); float f[16]; dec16(RA[q], f);
#pragma unroll
                    for (int j = 0; j < 16; ++j) o[j] += hq * f[j];
                    if (q < 7) asm volatile("" : "+v"(RA[q + 1].x), "+v"(RA[q + 1].y), "+v"(RA[q + 1].z), "+v"(RA[q + 1].w) : "v"(o[15])); }
                asm volatile("" :: "v"(o[15]));
                PEER_ISSUE(RA, TV, sn, in, ST_ELO(in));
#pragma unroll
                for (int q = 0; q < 8; ++q) { const float hq = __shfl((q & 1) ? h1 : h0, (lane & ~7) | (4 + (q >> 1))); float f[16]; dec16(RB[q], f);
#pragma unroll
                    for (int j = 0; j < 16; ++j) o[j] += hq * f[j];
                    if (q < 7) asm volatile("" : "+v"(RB[q + 1].x), "+v"(RB[q + 1].y), "+v"(RB[q + 1].z), "+v"(RB[q + 1].w) : "v"(o[15])); }
                float o8[8], o4[4], o2[2];
#pragma unroll
                for (int q = 0; q < 8; ++q) { const float keep = (lane & 32) ? o[q + 8] : o[q], send = (lane & 32) ? o[q] : o[q + 8]; o8[q] = keep + __shfl_xor(send, 32); }
#pragma unroll
                for (int q = 0; q < 4; ++q) { const float keep = (lane & 16) ? o8[q + 4] : o8[q], send = (lane & 16) ? o8[q] : o8[q + 4]; o4[q] = keep + __shfl_xor(send, 16); }
#pragma unroll
                for (int q = 0; q < 2; ++q) { const float keep = (lane & 8) ? o4[q + 2] : o4[q], send = (lane & 8) ? o4[q] : o4[q + 2]; o2[q] = keep + __shfl_xor(send, 8); }
                xv.x += o2[0]; xv.y += o2[1];
                *(f32x2*)(X + (size_t)t * DM + col) = xv; *(unsigned*)(XB + (size_t)t * DM + col) = pk2(xv.x, xv.y); ST_SSQ(i) += xv.x * xv.x + xv.y * xv.y;
            }
        }
    }
#undef PEER_ISSUE
    float* RSS = (float*)(a.ws + WS_RSS);
    if (lastlayer) __threadfence();
    for (int i = 0; i < ntok; ++i) { const int t = gw + NGW * i; const float ss = wave_sum(ST_SSQ(i)); if (lane == 0) RSS[t] = ss;
        if (lastlayer) { const float* gf = a.in[7]; const float rstd = rsqrtf(ss * (1.0f / DM) + EPS); f32x4* xr = (f32x4*)(X + (size_t)t * DM) + lane;
#pragma unroll
            for (int j = 0; j < 4; ++j) { const f32x4 g = *((const f32x4*)gf + lane + 64 * j); f32x4 v = xr[64 * j]; v = v * rstd * g; xr[64 * j] = v; } } }
#undef ST_ELO
#undef ST_EHI
#undef ST_H0
#undef ST_H1
#undef ST_SSQ
}

constexpr int N_PHASES = 1 + 7 * DEPTH;
__global__ void __launch_bounds__(NTHREADS, 2) hybrid_fwd(Args args) {
    extern __shared__ __attribute__((aligned(16))) unsigned char lds_raw[];
    Frame F;
    F.lds = (ldsp_t)lds_raw;
    F.MISC = (volatile LAS unsigned*)(F.lds + MISC_OFF);
    F.tid = threadIdx.x; F.lane = F.tid & 63; F.wave = __builtin_amdgcn_readfirstlane(F.tid >> 6);
    F.G = gridDim.x; { const int bx = blockIdx.x; F.vcu = (F.G % 8 == 0) ? (bx % 8) * (F.G / 8) + bx / 8 : bx; }
    F.ctl = (unsigned*)(args.ws + WS_CTL); F.ws = args.ws; F.out = args.out;
    for (int u = F.tid; u < (LDS_BYTES - MISC_OFF) / 4; u += NTHREADS) ((LAS unsigned*)(F.lds + MISC_OFF))[u] = 0u;
    __syncthreads();
#if MK_N_LAUNCHES == 1
    constexpr int lo = 0, hi = N_PHASES;
#else
    const int lo = args.ph_lo, hi = args.ph_hi;
#endif
    if (PROBE_SEL && blockIdx.x == 0 && F.tid == 0) F.ctl[CW_TS + 130] = (unsigned)__builtin_amdgcn_s_memrealtime();
    XcdBarrier bar; bar.bar = F.ctl + CW_BAR; bar.x = 0; bar.st = nullptr;
    if (hi - lo > 1) bar = xcd_barrier_post(F.ctl + CW_BAR, F.MISC + 8);
#ifndef PH_MASK
#define PH_MASK (PROBE_SEL ? ((PROBE_SEL >= 32 && PROBE_SEL < 40) ? 0x717 : 0x73F) : 0x7FF)
#endif
#define IN(k) (lo <= (k) && (k) < hi)
#define PHM(b) ((PH_MASK >> (b)) & 1)
#define REPBAR() do { if (rep) xcd_barrier(bar); } while (0)
#define LAUNDER() do { asm volatile("" : "+v"(F.tid)); F.lane = F.tid & 63; F.wave = __builtin_amdgcn_readfirstlane(F.tid >> 6); } while (0)
constexpr int PROBE_A = PROBE_SEL == 99 ? -1 : PROBE_SEL == 16 ? 15 : PROBE_SEL >= 200 ? 64 + (PROBE_SEL - 200) : PROBE_SEL >= 100 ? (PROBE_SEL - 100) : PROBE_SEL >= 32 ? PROBE_SEL : PROBE_SEL == 1 ? 0 : PROBE_SEL - 1;
constexpr int PROBE_B = PROBE_SEL == 99 ? -1 : PROBE_SEL == 16 ? 130 : PROBE_SEL >= 200 ? (PROBE_SEL - 200) : PROBE_SEL >= 100 ? 64 + (PROBE_SEL - 101) : PROBE_SEL >= 32 ? 1 : PROBE_SEL == 1 ? 130 : PROBE_SEL - 2;
#define STAMP(k) do { if (PROBE_SEL && ((k) == PROBE_A || (k) == PROBE_B) && F.tid == 0) atomicMax(F.ctl + CW_TS + (k), (unsigned)__builtin_amdgcn_s_memrealtime()); } while (0)
#define SEAM(k) do { STAMP(k); if (IN(k) && IN((k) + 1)) xcd_barrier(bar); STAMP(64 + (k)); } while (0)
    unsigned char* ws = args.ws;
    bf16_t* P = (bf16_t*)(ws + WS_P); bf16_t* XB = (bf16_t*)(ws + WS_XB);

    for (int rep = 0; rep < REPS(0); ++rep) { REPBAR(); if (PHM(0) && IN(0)) { LAUNDER(); p0_prologue(args, F); } } SEAM(0);

    for (int l = 0; l < DEPTH; ++l) {
        const int pb = 1 + 7 * l;
        for (int rep = 0; rep < REPS(1); ++rep) { REPBAR();
        if (PHM(1) && IN(pb)) { LAUNDER();
            pg8::Gemm g{XB, (const bf16_t*)(ws + WS_WIN) + (size_t)l * NIN * DM, DM, DM, 0, 0};
            pg8::StaticOrder S; S.init(MTOT, NIN, F.G, (int)blockIdx.x, 1);
            pg8::EpiIn E{P, (const float*)(ws + WS_RSS), (const float*)(ws + WS_ROT)};
            pg8::gemm_phase<pg8::EpiIn, pg8::StaticOrder, true>(F.lds, g, S, E, F.tid);
        } }
        SEAM(pb);
        if (PHM(2) && IN(pb + 1)) { LAUNDER();
            for (int u = (int)blockIdx.x; u < 192; u += F.G) {
                LAUNDER();
                if (u < 64) { if (PHM(8)) ret_prompt_unit(args, F, l, u >> 3, u & 7); if (l == 0) STAMP(32); }
                else { if (PHM(9)) rnn_unit(args, F, l, false, (u - 64) >> 4, (u - 64) & 15); if (l == 0) STAMP(33); }
            }
            unsigned* qh = F.ctl + CW_QUEUE + 64 * l;
            for (;;) {
                __syncthreads();
                if (F.tid == 0) F.MISC[0] = xb_add(qh, 1u);
                __syncthreads();
                const unsigned q = F.MISC[0];
                LAUNDER();
                if (PROBE_SEL && l == 0 && q >= 1152u && q < 1152u + 256u) STAMP(34);
                if (q >= 1024u + 128u + 256u) break;
                if (q < 1024u) { if (PHM(10)) ret_sample_unit(args, F, l, (int)(q >> 3), (int)(q & 7)); }
                else if (q < 1152u) { if (PHM(9)) rnn_unit(args, F, l, true, (int)((q - 1024u) >> 4), (int)((q - 1024u) & 15)); }
                else tab_unit(args, F, l, (int)(q - 1152u));
            }
        }
        SEAM(pb + 1);
        for (int rep = 0; rep < REPS(3); ++rep) { REPBAR();
        if (PHM(3) && IN(pb + 2)) { LAUNDER();
            pg8::Gemm g{(const bf16_t*)(ws + WS_ARET), (const bf16_t*)(ws + WS_WMIX + (size_t)l * 6 * MiB), DM, DM, (size_t)(WS_ARNN - WS_ARET), (size_t)(2 * MiB)};
            pg8::StaticOrder S; S.init(MTOT, DM, F.G, (int)blockIdx.x, 2);
            pg8::EpiMerge E{P, (bf16_t*)(ws + WS_MRG)};
            pg8::gemm_phase<pg8::EpiMerge, pg8::StaticOrder, true>(F.lds, g, S, E, F.tid);
        } }
        SEAM(pb + 2);
        if (PHM(4) && IN(pb + 3)) { LAUNDER();
            pg8::Gemm g{(const bf16_t*)(ws + WS_MRG), (const bf16_t*)(ws + WS_WMIX + (size_t)l * 6 * MiB + 4 * MiB), DM, DM, 0, 0};
            pg8::StaticOrder S; S.init(MTOT, DM, F.G, (int)blockIdx.x, 1);
            pg8::EpiWo E{l == 0 ? args.in[0] : args.out, l == 0 ? args.in[1] : args.out + (size_t)M_P * DM, args.out, XB, (float*)(ws + WS_RSSP)};
            pg8::gemm_phase<pg8::EpiWo, pg8::StaticOrder, true>(F.lds, g, S, E, F.tid);
        }
        SEAM(pb + 3);
        for (int rep = 0; rep < REPS(5); ++rep) { REPBAR();
        if (PHM(5) && IN(pb + 4)) { LAUNDER();
            pg8::Gemm g{XB, (const bf16_t*)(ws + WS_WQ) + (size_t)l * 2048 * DM, DM, DM, 0, 0};
            pg8::StaticOrder S; S.init(MTOT, 2048, F.G, (int)blockIdx.x, 1);
            pg8::EpiQ E{P, (const float*)(ws + WS_RSSP), (float*)(ws + WS_RSS2)};
            pg8::gemm_phase<pg8::EpiQ, pg8::StaticOrder, true>(F.lds, g, S, E, F.tid);
        } }
        SEAM(pb + 4);
        for (int rep = 0; rep < 1; ++rep) {
        if (PHM(6) && IN(pb + 5)) { LAUNDER();
            const int gw = F.vcu * NWAVES + F.wave, NGW = F.G * NWAVES;
            for (int u = gw; u < (MTOT / 32) * PH; u += NGW) { for (int rr = 0; rr < REPS(6); ++rr) { int ln = F.lane; asm volatile("" : "+v"(ln)); route_unit(args, l, u >> 3, u & 7, ln); } }
        } }
        SEAM(pb + 5);
        if (PHM(7) && IN(pb + 6)) { LAUNDER(); peer_phase(args, F, l, l == DEPTH - 1); }
        if (l + 1 < DEPTH) SEAM(pb + 6); else STAMP(pb + 6);
    }
    if (PROBE_SEL) {
        STAMP(15);
        if (PROBE_A == 15 || PROBE_A == 14 || PROBE_A == 78) xcd_barrier(bar);
        if (blockIdx.x == 0) {
            const unsigned* ts = F.ctl + CW_TS;
            unsigned ta, tb;
            if (PROBE_SEL == 99) { ta = 10000u; tb = 0u; }
            else { ta = __hip_atomic_load(ts + (PROBE_A < 0 ? 0 : PROBE_A), RLX_AGENT); tb = __hip_atomic_load(ts + (PROBE_B < 0 ? 0 : PROBE_B), RLX_AGENT); if (PROBE_SEL == 16) ta = tb + (ta - tb) / 16u; }
            const float dl = sqrtf((float)(ta - tb)) * 1e-2f;
            for (int i = F.tid; i < DEPTH * NBATCH * DM; i += NTHREADS) args.out[O_SHP + i] += dl;
        }
    }
#undef IN
#undef SEAM
}

extern "C" void kernel_launch(void* const* d_in, const int* in_sizes, int n_in, void* d_out, int out_size, void* d_ws, size_t ws_size, hipStream_t stream) {
    static int grid = 0;
    if (grid == 0) {
        if (n_in != 24 || out_size != (int)O_END || ws_size < WS_END) { fprintf(stderr, "kernel_launch: unexpected shapes (n_in %d, out %d, ws %zu)\n", n_in, out_size, ws_size); grid = -1; return; }
        int dev = 0, cus = 0, per_cu = 0;
        if (hipGetDevice(&dev) != hipSuccess || hipDeviceGetAttribute(&cus, hipDeviceAttributeMultiprocessorCount, dev) != hipSuccess) { grid = -1; return; }
        if (hipFuncSetAttribute((const void*)hybrid_fwd, hipFuncAttributeMaxDynamicSharedMemorySize, LDS_BYTES) != hipSuccess) { fprintf(stderr, "kernel_launch: hipFuncSetAttribute failed\n"); grid = -1; return; }
        if (hipOccupancyMaxActiveBlocksPerMultiprocessor(&per_cu, (const void*)hybrid_fwd, NTHREADS, LDS_BYTES) != hipSuccess || per_cu < 1) { fprintf(stderr, "kernel_launch: occupancy query reports %d blocks per CU\n", per_cu); (void)hipGetLastError(); grid = -1; return; }
        grid = cus;
        if (grid != 256) fprintf(stderr, "kernel_launch: %d CUs; the PEER phase assumes 256 workgroups\n", grid);
    }
    if (grid < 0) return;
    (void)hipMemsetAsync((char*)d_ws + WS_CTL, 0, CTL_ZERO_BYTES, stream);
    Args a{};
    for (int i = 0; i < 24; ++i) a.in[i] = (const float*)d_in[i];
    a.out = (float*)d_out; a.ws = (unsigned char*)d_ws;
#if MK_N_LAUNCHES == 1
    a.ph_lo = 0; a.ph_hi = N_PHASES;
    void* kargs[] = {&a};
    hipError_t e = hipLaunchCooperativeKernel((const void*)hybrid_fwd, dim3(grid), dim3(NTHREADS), kargs, LDS_BYTES, stream);
    if (e != hipSuccess) fprintf(stderr, "kernel_launch: cooperative launch failed: %s (grid %d)\n", hipGetErrorString(e), grid);
#else
    for (int p = 0; p < N_PHASES; ++p) { a.ph_lo = p; a.ph_hi = p + 1; hipLaunchKernelGGL(hybrid_fwd, dim3(grid), dim3(NTHREADS), LDS_BYTES, stream, a); }
#endif
}
```

```cpp
#include <hip/hip_runtime.h>
#include <cstdio>
#include <cstdint>

#define LAS __attribute__((address_space(3)))
#define GAS __attribute__((address_space(1)))
typedef unsigned short bf16_t;
typedef short bf16x8 __attribute__((ext_vector_type(8)));
typedef float f32x2 __attribute__((ext_vector_type(2)));
typedef float f32x4 __attribute__((ext_vector_type(4)));
typedef float f32x16 __attribute__((ext_vector_type(16)));
typedef unsigned u32x2 __attribute__((ext_vector_type(2)));
typedef unsigned u32x4 __attribute__((ext_vector_type(4)));
typedef LAS unsigned char* ldsp_t;

#ifndef REP_MASK
#define REP_MASK 0
#endif
#define REPS(k) (((REP_MASK >> (k)) & 1) ? 2 : 1)
#ifndef PROBE_SEL
#define PROBE_SEL 0
#endif
#ifndef MK_N_LAUNCHES
#define MK_N_LAUNCHES 1
#endif

constexpr int DM = 1024, NIN = 7168, M_P = 16384, M_S = 1024, MTOT = 17408, DEPTH = 2;
constexpr int SEQ = 2048, NBATCH = 8, DECB = 128, DECT = 8, PAST = 16384;
constexpr int HR = 8, DK = 64, DV = 128, CH = 128;
constexpr int NBLK = 16, BS = 64;
constexpr int PH = 8, NKEY = 128, NEXP = 16384, TOPK = 16, HK = 128;
constexpr float EPS = 1e-6f;
constexpr int LDP = 7168;
constexpr int PC_Q = 0, PC_K = 512, PC_V = 1024, PC_GR = 2048, PC_XR = 3072, PC_GN = 4096, PC_GA = 5120, PC_GB = 6144;
constexpr int PC_MRG = 0, PC_ARET = 1024, PC_ARNN = 4096, PC_QP = 2048;

constexpr size_t MiB = 1u << 20;
constexpr size_t WS_CTL = 0, CTL_ZERO_BYTES = 1 * MiB;
constexpr size_t WS_ROT = 1 * MiB;
constexpr size_t WS_RSS = 2 * MiB;
constexpr size_t WS_RSS2 = 2 * MiB + 128 * 1024;
constexpr size_t WS_RSSP = 2 * MiB + 256 * 1024;
constexpr size_t WS_TSC = 3 * MiB + 512 * 1024;
constexpr size_t WS_EIDX = 4 * MiB;
constexpr size_t WS_GATE = 13 * MiB;
constexpr size_t WS_KEYS = 22 * MiB;
constexpr size_t WS_WG = 23 * MiB;
constexpr size_t WS_WIN = 24 * MiB;
constexpr size_t WS_WMIX = 52 * MiB;
constexpr size_t WS_WQ = 64 * MiB;
constexpr size_t WS_XB = 72 * MiB;
constexpr size_t WS_P = 106 * MiB;
constexpr size_t WS_TAB = 344 * MiB;
constexpr size_t WS_ARET = 408 * MiB, WS_ARNN = 442 * MiB, WS_MRG = 476 * MiB;
constexpr size_t WS_END = 510 * MiB;
static_assert(WS_P + (size_t)MTOT * LDP * 2 <= WS_TAB, "ws map");

constexpr size_t O_Y = 0, O_SRP = 17825792, O_SHP = 18874368, O_SCP = 18890752, O_SRS = 18939904, O_SHS = 35717120, O_SCS = 35979264, O_END = 36765696;

constexpr int CW_BAR = 4096;
constexpr int CW_QUEUE = 16384;
constexpr int CW_TS = 20480;

constexpr int RING_BYTES = 131072;
constexpr int LDS_BYTES = 155648;
constexpr int MISC_OFF = 153600;
constexpr int NWAVES = 8, NTHREADS = 512;

#define LDS_WAIT() asm volatile("s_waitcnt lgkmcnt(0)" ::: "memory")
#define VM_WAIT() asm volatile("s_waitcnt vmcnt(0)" ::: "memory")
#define LBAR() do { asm volatile("s_waitcnt lgkmcnt(0)" ::: "memory"); __builtin_amdgcn_s_barrier(); asm volatile("" ::: "memory"); } while (0)
#define RLX_AGENT __ATOMIC_RELAXED, __HIP_MEMORY_SCOPE_AGENT

__device__ __forceinline__ unsigned f2bf(float f) { unsigned u = __builtin_bit_cast(unsigned, f); return (u + 0x7fffu + ((u >> 16) & 1u)) >> 16; }
typedef __bf16 bf16x2_t __attribute__((ext_vector_type(2)));
__device__ __forceinline__ unsigned pk2(float lo, float hi) { const f32x2 v = {lo, hi}; const bf16x2_t b = __builtin_convertvector(v, bf16x2_t); return __builtin_bit_cast(unsigned, b); }
__device__ __forceinline__ float bflo(unsigned w) { return __builtin_bit_cast(float, w << 16); }
__device__ __forceinline__ float bfhi(unsigned w) { return __builtin_bit_cast(float, w & 0xffff0000u); }
__device__ __forceinline__ float bf1(bf16_t h) { return __builtin_bit_cast(float, (unsigned)h << 16); }
__device__ __forceinline__ float sigmoidf_(float x) { return __builtin_amdgcn_rcpf(1.0f + __expf(-x)); }
__device__ __forceinline__ float siluf_(float x) { return x * sigmoidf_(x); }
__device__ __forceinline__ float geluf_(float x) { return x * sigmoidf_(1.5957691216057308f * (x + 0.044715f * x * x * x)); }
__device__ __forceinline__ float logg_of(int h) { return log1pf(-exp2f((float)(-5 - h))); }

namespace pg8 {
constexpr int BM = 256, BK = 64, HALF = 128, HTB = HALF * BK * 2, STAGE_BYTES = 8 * HTB, NXCD = 8, WGM = 8;
__host__ __device__ __forceinline__ int lds_byte(int r, int c) { const int st = (r >> 4) * 2 + (c >> 5), rr = r & 15, cc = c & 31, ob = rr * 64 + cc * 2; return st * 1024 + (ob ^ (((ob >> 9) & 1) << 5)); }
__host__ __device__ __forceinline__ void stage_rc(int b, int& R, int& C) { const int st = b / 1024, sb = b % 1024, swz = sb ^ (((sb >> 9) & 1) << 5); R = (st >> 1) * 16 + swz / 64; C = (st & 1) * 32 + (swz % 64) / 2; }
__host__ __device__ __forceinline__ int perm32(int rho) { const int n = rho >> 4, i = rho & 15; return 8 * (i >> 2) + 4 * n + (i & 3); }

struct Unit { int pm, pn, half; };
struct Gemm { const bf16_t* A; const bf16_t* Bt; int lda, K; size_t aoff2, boff2; };

struct StaticOrder {
    int nM, nN, nwg, G, c, pairs;
    __device__ void init(int M, int N, int G_, int c_, int pairs_) { nM = M / BM; nN = N / BM; nwg = nM * nN; G = G_; c = c_; pairs = pairs_; }
    __device__ bool next(int i, Unit& u) const {
        const int it = (pairs == 2) ? (i >> 1) : i;
        const long L = (long)it * G + c; if (L >= nwg) return false;
        int wgid = (int)L; { const int q = nwg / NXCD, r = nwg % NXCD, xcd = wgid % NXCD, off = wgid / NXCD; wgid = (xcd < r ? xcd * (q + 1) : r * (q + 1) + (xcd - r) * q) + off; }
        const int nig = WGM * nN, gid = wgid / nig, fm = gid * WGM, gsz = (nM - fm) < WGM ? (nM - fm) : WGM;
        u.pm = fm + ((wgid % nig) % gsz); u.pn = (wgid % nig) / gsz; u.half = (pairs == 2) ? (i & 1) : 0; return true;
    }
};

template <class Epi, class Sched, bool ALIGN_EPI>
__device__ __forceinline__ void gemm_phase(ldsp_t lds, const Gemm g, const Sched& S, const Epi& E, const int tid) {
    const int wid = __builtin_amdgcn_readfirstlane(tid >> 6), lane = tid & 63, wr = wid >> 2, wc = wid & 3, fr = lane & 15, fq = lane >> 4;
    const int K = g.K, nt = K / BK;
    unsigned voffA[2], voffB[2];
#pragma unroll
    for (int i = 0; i < 2; ++i) { int R, C; stage_rc(tid * 16 + i * 8192, R, C); const int Rb = Epi::PERM ? ((R & ~31) + perm32(R & 31)) : R;
        voffA[i] = (unsigned)(R * g.lda + C) * 2u; voffB[i] = (unsigned)(Rb * K + C) * 2u; }
    const size_t kstep = (size_t)(BK * 2);
    const size_t hstepA = (size_t)HALF * g.lda * 2, hstepB = (size_t)HALF * K * 2;
    const size_t tstepA = 2 * hstepA, tstepB = 2 * hstepB;
    const unsigned ldsw = (unsigned)wid * 1024u;
    const int aoff = lds_byte(wr * 64 + fr, fq * 8), boff = lds_byte(wc * 32 + fr, fq * 8);
#define PG8_SA(b, h) (((b) * 2 + (h)) * HTB)
#define PG8_SB(b, h) ((4 + (b) * 2 + (h)) * HTB)
#define PG8_STAGE(bufoff, gbase, voff) do { _Pragma("unroll") for (int _i = 0; _i < 2; ++_i) \
        __builtin_amdgcn_global_load_lds((const unsigned*)((const char*)(gbase) + (voff)[_i]), (LAS unsigned*)(lds + (bufoff) + ldsw + _i * 8192), 16, 0, 0); } while (0)
#define PG8_LDA(dst, b, h) do { _Pragma("unroll") for (int m = 0; m < 4; ++m) _Pragma("unroll") for (int k = 0; k < 2; ++k) dst[m][k] = *(const LAS bf16x8*)(lds + PG8_SA(b, h) + aoff + m * 2048 + k * 1024); } while (0)
#define PG8_LDB(dst, b, h) do { _Pragma("unroll") for (int n = 0; n < 2; ++n) _Pragma("unroll") for (int k = 0; k < 2; ++k) dst[n][k] = *(const LAS bf16x8*)(lds + PG8_SB(b, h) + boff + n * 2048 + k * 1024); } while (0)
#define PG8_MMA(ai, bj, At, Bt) do { __builtin_amdgcn_s_setprio(1); _Pragma("unroll") for (int m = 0; m < 4; ++m) _Pragma("unroll") for (int n = 0; n < 2; ++n) _Pragma("unroll") for (int k = 0; k < 2; ++k) \
        acc[ai][bj][m][n] = __builtin_amdgcn_mfma_f32_16x16x32_bf16(Bt[n][k], At[m][k], acc[ai][bj][m][n], 0, 0, 0); __builtin_amdgcn_s_setprio(0); } while (0)
#define PG8_WAIT_V(n) asm volatile("s_waitcnt vmcnt(" #n ")" ::: "memory")
#define PG8_WAIT_L(n) asm volatile("s_waitcnt lgkmcnt(" #n ")" ::: "memory")
#define PG8_BAR __builtin_amdgcn_s_barrier()
#define PG8_SCHED __builtin_amdgcn_sched_barrier(0)
    Unit cur, nxt; int ui = 0;
    if (!S.next(0, cur)) return;
    f32x4 acc[2][2][4][2];
#pragma unroll
    for (int a = 0; a < 2; ++a)
#pragma unroll
        for (int b = 0; b < 2; ++b)
#pragma unroll
            for (int m = 0; m < 4; ++m)
#pragma unroll
                for (int n = 0; n < 2; ++n) acc[a][b][m][n] = (f32x4){0.f, 0.f, 0.f, 0.f};
    bf16x8 At[4][2], B0[2][2], B1[2][2];
    const char* cA = (const char*)g.A + (size_t)cur.pm * tstepA + (cur.half ? g.aoff2 : 0); const char* cB = (const char*)g.Bt + (size_t)cur.pn * tstepB + (cur.half ? g.boff2 : 0);
    PG8_STAGE(PG8_SB(0, 0), cB, voffB); PG8_STAGE(PG8_SB(0, 1), cB + hstepB, voffB); PG8_STAGE(PG8_SA(0, 0), cA, voffA); PG8_STAGE(PG8_SA(0, 1), cA + hstepA, voffA);
    if (wr == 1) PG8_BAR;
    PG8_WAIT_V(2); PG8_BAR;
    PG8_STAGE(PG8_SB(1, 0), cB + kstep, voffB); PG8_STAGE(PG8_SA(1, 0), cA + kstep, voffA); PG8_STAGE(PG8_SB(1, 1), cB + hstepB + kstep, voffB);
    PG8_WAIT_V(6); PG8_BAR;
    for (;;) {
        const bool has_next = S.next(ui + 1, nxt);
        const char* nA = has_next ? (const char*)g.A + (size_t)nxt.pm * tstepA + (nxt.half ? g.aoff2 : 0) : cA;
        const char* nB = has_next ? (const char*)g.Bt + (size_t)nxt.pn * tstepB + (nxt.half ? g.boff2 : 0) : cB;
        for (int t = 0; t < nt; t += 2) {
            const bool last = (t == nt - 2);
            const char* a1 = cA + (size_t)(t + 1) * kstep;
            const char* a2 = last ? nA : cA + (size_t)(t + 2) * kstep; const char* b2 = last ? nB : cB + (size_t)(t + 2) * kstep;
            const char* a3 = a2 + kstep; const char* b3 = b2 + kstep;
            PG8_LDB(B0, 0, 0); PG8_LDB(B1, 0, 1); PG8_SCHED; PG8_LDA(At, 0, 0); PG8_STAGE(PG8_SA(1, 1), a1 + hstepA, voffA);
            PG8_WAIT_V(8); PG8_WAIT_L(0); PG8_BAR; PG8_MMA(0, 0, At, B0); PG8_MMA(0, 1, At, B1); PG8_BAR; PG8_SCHED;
            PG8_LDA(At, 0, 1); PG8_STAGE(PG8_SB(0, 0), b2, voffB); PG8_STAGE(PG8_SB(0, 1), b2 + hstepB, voffB); PG8_STAGE(PG8_SA(0, 0), a2, voffA);
            PG8_WAIT_V(8); PG8_WAIT_L(0); PG8_BAR; PG8_MMA(1, 0, At, B0); PG8_MMA(1, 1, At, B1); PG8_BAR; PG8_SCHED;
            PG8_LDB(B0, 1, 0); PG8_LDB(B1, 1, 1); PG8_SCHED; PG8_LDA(At, 1, 0); PG8_STAGE(PG8_SA(0, 1), a2 + hstepA, voffA);
            PG8_WAIT_V(8); PG8_WAIT_L(0); PG8_BAR; PG8_MMA(0, 0, At, B0); PG8_MMA(0, 1, At, B1); PG8_BAR; PG8_SCHED;
            PG8_LDA(At, 1, 1); PG8_STAGE(PG8_SB(1, 0), b3, voffB); PG8_STAGE(PG8_SB(1, 1), b3 + hstepB, voffB); PG8_STAGE(PG8_SA(1, 0), a3, voffA);
            PG8_WAIT_V(8); PG8_WAIT_L(0); PG8_BAR; PG8_MMA(1, 0, At, B0); PG8_MMA(1, 1, At, B1); PG8_BAR; PG8_SCHED;
        }
        if constexpr (ALIGN_EPI) { if (wr == 0) PG8_BAR; }
        E(acc, cur, wr, wc, fr, fq);
        if (!has_next) break;
#pragma unroll
        for (int a = 0; a < 2; ++a)
#pragma unroll
            for (int b = 0; b < 2; ++b)
#pragma unroll
                for (int m = 0; m < 4; ++m)
#pragma unroll
                    for (int n = 0; n < 2; ++n) acc[a][b][m][n] = (f32x4){0.f, 0.f, 0.f, 0.f};
        cur = nxt; cA = nA; cB = nB; ++ui;
        if constexpr (ALIGN_EPI) { if (wr == 1) PG8_BAR; }
    }
    PG8_WAIT_V(0);
    if constexpr (!ALIGN_EPI) { if (wr == 0) PG8_BAR; }
    PG8_BAR;
#undef PG8_SA
#undef PG8_SB
#undef PG8_STAGE
#undef PG8_LDA
#undef PG8_LDB
#undef PG8_MMA
#undef PG8_WAIT_V
#undef PG8_WAIT_L
#undef PG8_BAR
#undef PG8_SCHED
}
}

typedef GAS unsigned gu32;
#define XB_TMO      128
#define XB_XCNT(j)  (256  + 64 * (j))
#define XB_XSUB(j)  (1280 + 64 * (j))
#define XB_XGEN(j)  (2304 + 64 * (j))
#define XB_TOP      3328
#define XB_TOPGEN   3392
#define XCD_BAR_WORDS 3456
#define XB_SPIN_CAP (1u << 18)
__device__ __forceinline__ unsigned xb_ld(unsigned* p)              { return __hip_atomic_load(p, __ATOMIC_RELAXED, __HIP_MEMORY_SCOPE_AGENT); }
__device__ __forceinline__ unsigned xb_add(unsigned* p, unsigned v) { return __hip_atomic_fetch_add(p, v, __ATOMIC_RELAXED, __HIP_MEMORY_SCOPE_AGENT); }
__device__ __forceinline__ unsigned xb_xcc_id() { return (unsigned)__builtin_amdgcn_s_getreg((3 << 11) | 20) & 0xFu; }
#define XB_SPIN(cond, bar) do { unsigned _sp = 0; while (cond) { __builtin_amdgcn_s_sleep(1); \
    if ((++_sp & 255u) == 0u) { if (xb_ld(&(bar)[XB_TMO])) break; if (_sp > XB_SPIN_CAP) { atomicAdd(&(bar)[XB_TMO], 1u); break; } } } } while (0)
struct XcdBarrier { unsigned* bar; unsigned x; volatile LAS unsigned* st; };
__device__ __forceinline__ XcdBarrier xcd_barrier_post(unsigned* bar, volatile LAS unsigned* st) {
    XcdBarrier b; b.bar = bar; b.x = (unsigned)__builtin_amdgcn_readfirstlane((int)xb_xcc_id()); b.st = st;
    if (threadIdx.x == 0) (void)xb_add(&bar[XB_XCNT(b.x)], 1u);
    return b;
}
__device__ __forceinline__ void xcd_barrier_complete(unsigned* bar, unsigned x, unsigned& nloc, unsigned& nx) {
    const unsigned G = gridDim.x * gridDim.y * gridDim.z;
    unsigned sum, cnt, mine, sp = 0u;
    for (;;) {
        sum = 0u; cnt = 0u; mine = 0u;
#pragma unroll
        for (unsigned j = 0; j < 16; ++j) { const unsigned c = xb_ld(&bar[XB_XCNT(j)]); sum += c; cnt += (c > 0u) ? 1u : 0u; mine = (j == x) ? c : mine; }
        if (sum == G) break;
        __builtin_amdgcn_s_sleep(1);
        if ((++sp & 255u) == 0u) { if (xb_ld(&bar[XB_TMO])) break; if (sp > XB_SPIN_CAP) { atomicAdd(&bar[XB_TMO], 1u); break; } }
    }
    nloc = mine > 0u ? mine : 1u; nx = cnt > 0u ? cnt : 1u;
}
__device__ __forceinline__ void xcd_barrier(const XcdBarrier& b) {
    asm volatile("s_waitcnt vmcnt(0)" ::: "memory");
    __syncthreads();
    if (threadIdx.x == 0) {
        unsigned* bar = b.bar; const unsigned bx = (unsigned)__builtin_amdgcn_readfirstlane((int)b.x);
        __builtin_amdgcn_s_waitcnt(0);
        unsigned nloc = b.st[0], nx = b.st[1];
        if (nloc == 0u) { xcd_barrier_complete(bar, bx, nloc, nx); b.st[0] = nloc; b.st[1] = nx; }
        const unsigned old = xb_add(&bar[XB_XSUB(bx)], 1u);
        const unsigned gen = old / nloc;
        if (old + 1u == (gen + 1u) * nloc) {
            __builtin_amdgcn_fence(__ATOMIC_RELEASE, "agent");
            asm volatile("s_waitcnt vmcnt(0)" ::: "memory");
            const unsigned og = xb_add(&bar[XB_TOP], 1u);
            const unsigned tg = og / nx;
            if (og + 1u == (tg + 1u) * nx) xb_add(&bar[XB_TOPGEN], 1u);
            else XB_SPIN(xb_ld(&bar[XB_TOPGEN]) == tg, bar);
            __builtin_amdgcn_fence(__ATOMIC_ACQUIRE, "agent");
            xb_add(&bar[XB_XGEN(bx)], 1u);
            asm volatile("s_waitcnt vmcnt(0)" ::: "memory");
        } else {
            XB_SPIN(xb_ld(&bar[XB_XGEN(bx)]) == gen, bar);
            __builtin_amdgcn_fence(__ATOMIC_ACQUIRE, "agent");
            asm volatile("s_waitcnt vmcnt(0)" ::: "memory");
        }
    }
    __syncthreads();
}

struct Frame {
    ldsp_t lds;
    volatile LAS unsigned* MISC;
    unsigned* ctl;
    int tid, lane, wave, vcu, G;
    const float* const* in;
    unsigned char* ws;
    float* out;
};
struct Args { const float* in[24]; float* out; unsigned char* ws; int ph_lo, ph_hi; };

__device__ __forceinline__ float wave_sum(float v) {
#pragma unroll
    for (int o = 1; o < 64; o <<= 1) v += __shfl_xor(v, o);
    return v;
}

__device__ __forceinline__ void p0_transpose_item(const float* W, int K, int N, bf16_t* WT, int ldk, const float* rowscale, float colscale, bool qkperm, LAS float* scr, int item, int lane) {
    const int nblk = N / 32, kb = item / nblk, nb = item % nblk, k0 = 64 * kb, n0 = 32 * nb;
    int srcn = n0 + (lane & 31);
    if (qkperm) { const int p = srcn & 63; srcn = (srcn & ~63) + ((p & 1) ? 32 + (p >> 1) : (p >> 1)); }
#pragma unroll 16
    for (int i = 0; i < 32; ++i) { const int kk = 2 * i + (lane >> 5); float v = W[(size_t)(k0 + kk) * N + srcn] * colscale; if (rowscale) v *= rowscale[k0 + kk]; scr[kk * 33 + (lane & 31)] = v; }
    LDS_WAIT(); asm volatile("" ::: "memory");
    const int c = lane & 7;
#pragma unroll
    for (int j = 0; j < 4; ++j) { const int n = (lane >> 3) + 8 * j; const LAS float* s = scr + (8 * c) * 33 + n;
        u32x4 o; o.x = pk2(s[0 * 33], s[1 * 33]); o.y = pk2(s[2 * 33], s[3 * 33]); o.z = pk2(s[4 * 33], s[5 * 33]); o.w = pk2(s[6 * 33], s[7 * 33]);
        *(u32x4*)(WT + (size_t)(n0 + n) * ldk + k0 + 8 * c) = o; }
    LDS_WAIT(); asm volatile("" ::: "memory");
}

__device__ __forceinline__ void p0_xrow(const float* xrow, bf16_t* orow, float* rss, int lane) {
    const f32x4* xr = (const f32x4*)xrow + lane;
    f32x4 v[4]; float s = 0.f;
#pragma unroll
    for (int j = 0; j < 4; ++j) { v[j] = xr[64 * j]; s += (v[j].x * v[j].x + v[j].y * v[j].y) + (v[j].z * v[j].z + v[j].w * v[j].w); }
    s = wave_sum(s);
    u32x2* o8 = (u32x2*)orow + lane;
#pragma unroll
    for (int j = 0; j < 4; ++j) { u32x2 w; w.x = pk2(v[j].x, v[j].y); w.y = pk2(v[j].z, v[j].w); o8[64 * j] = w; }
    if (lane == 0) *rss = s;
}

__device__ __forceinline__ void p0_tabrow(const float* row, unsigned char* img, float* isc, int e, int lane) {
    const f32x4* xr = (const f32x4*)row + lane;
    f32x4 v[4]; float am = 0.f;
#pragma unroll
    for (int j = 0; j < 4; ++j) { v[j] = xr[64 * j]; am = fmaxf(am, fmaxf(fmaxf(fabsf(v[j].x), fabsf(v[j].y)), fmaxf(fabsf(v[j].z), fabsf(v[j].w)))); }
#pragma unroll
    for (int o = 1; o < 64; o <<= 1) am = fmaxf(am, __shfl_xor(am, o));
    const float sc = am > 0.f ? exp2f(floorf(log2f(224.0f / am))) : 1.0f;
#pragma unroll
    for (int j = 0; j < 4; ++j) { const int col = 256 * j + 4 * lane, sl = col >> 7, w = col & 127;
        int pk = __builtin_amdgcn_cvt_pk_fp8_f32(v[j].x * sc, v[j].y * sc, 0, false);
        pk = __builtin_amdgcn_cvt_pk_fp8_f32(v[j].z * sc, v[j].w * sc, pk, true);
        *(int*)(img + ((size_t)sl * NEXP + e) * 128 + w) = pk; }
    if (lane == 0) isc[e] = 1.0f / sc;
}

__device__ __forceinline__ void p0_prologue(const Args& a, Frame& F) {
    unsigned char* ws = a.ws;
    LAS float* scr = (LAS float*)(F.lds + F.wave * 16384);
    const int gw = F.vcu * NWAVES + F.wave, NGW = F.G * NWAVES, lane = F.lane;
    constexpr int I_IN = (DM / 64) * (NIN / 32), I_SQ = (DM / 64) * (DM / 32), I_Q = (DM / 64) * (2048 / 32), I_G = 2;
    constexpr int PER_L = I_IN + 3 * I_SQ + I_Q + 32 * I_G;
    for (int it = gw; it < DEPTH * PER_L; it += NGW) {
        const int l = it / PER_L; int r = it % PER_L;
        if (r < I_IN) { const int nb = r % (NIN / 32), n0 = nb * 32; const int seg = n0 >> 9;
            p0_transpose_item(a.in[8] + (size_t)l * DM * NIN, DM, NIN, (bf16_t*)(ws + WS_WIN) + (size_t)l * NIN * DM, DM, a.in[5] + l * DM, seg == 1 ? 0.125f : 1.0f, seg <= 1, scr, r, lane); continue; }
        r -= I_IN;
        if (r < I_SQ) { p0_transpose_item(a.in[10] + (size_t)l * DM * DM, DM, DM, (bf16_t*)(ws + WS_WMIX + (size_t)l * 6 * MiB), DM, a.in[9] + l * DM, 1.0f, false, scr, r, lane); continue; }
        r -= I_SQ;
        if (r < I_SQ) { p0_transpose_item(a.in[18] + (size_t)l * DM * DM, DM, DM, (bf16_t*)(ws + WS_WMIX + (size_t)l * 6 * MiB + 2 * MiB), DM, nullptr, 1.0f, false, scr, r, lane); continue; }
        r -= I_SQ;
        if (r < I_SQ) { p0_transpose_item(a.in[19] + (size_t)l * DM * DM, DM, DM, (bf16_t*)(ws + WS_WMIX + (size_t)l * 6 * MiB + 4 * MiB), DM, nullptr, 1.0f, false, scr, r, lane); continue; }
        r -= I_SQ;
        if (r < I_Q) { p0_transpose_item(a.in[20] + (size_t)l * DM * 2048, DM, 2048, (bf16_t*)(ws + WS_WQ) + (size_t)l * 2048 * DM, DM, a.in[6] + l * DM, 1.0f, false, scr, r, lane); continue; }
        r -= I_Q;
        { const int mat = r >> 1, sub = r & 1, nb = mat >> 1, gsel = mat & 1;
          const float* W = (gsel ? a.in[15] : a.in[13]) + ((size_t)l * NBLK + nb) * BS * BS;
          bf16_t* WT = (bf16_t*)(ws + WS_WG) + (((size_t)l * NBLK + nb) * 2 + gsel) * BS * BS;
          p0_transpose_item(W, BS, BS, WT, BS, nullptr, 1.0f, false, scr, sub, lane); }
    }
    { const float* ksrc = a.in[21]; bf16_t* kdst = (bf16_t*)(ws + WS_KEYS); const int n4 = DEPTH * PH * 2 * NKEY * HK / 4;
      for (int i = gw * 64 + lane; i < n4; i += NGW * 64) { const f32x4 v = ((const f32x4*)ksrc)[i]; u32x2 o; o.x = pk2(v.x, v.y); o.y = pk2(v.z, v.w); ((u32x2*)kdst)[i] = o; } }
    for (int m = gw; m < MTOT; m += 2 * NGW) {
        const int m2 = m + NGW; const bool v2 = m2 < MTOT; const int mm2 = v2 ? m2 : m;
        const f32x4* x1 = (const f32x4*)(m < M_P ? a.in[0] + (size_t)m * DM : a.in[1] + (size_t)(m - M_P) * DM) + lane;
        const f32x4* x2 = (const f32x4*)(mm2 < M_P ? a.in[0] + (size_t)mm2 * DM : a.in[1] + (size_t)(mm2 - M_P) * DM) + lane;
        f32x4 v[8]; float s1 = 0.f, s2 = 0.f;
#pragma unroll
        for (int j = 0; j < 4; ++j) { v[j] = x1[64 * j]; v[4 + j] = x2[64 * j]; }
#pragma unroll
        for (int j = 0; j < 4; ++j) { s1 += (v[j].x * v[j].x + v[j].y * v[j].y) + (v[j].z * v[j].z + v[j].w * v[j].w); s2 += (v[4 + j].x * v[4 + j].x + v[4 + j].y * v[4 + j].y) + (v[4 + j].z * v[4 + j].z + v[4 + j].w * v[4 + j].w); }
        s1 = wave_sum(s1); s2 = wave_sum(s2);
        u32x2* o1 = (u32x2*)((bf16_t*)(ws + WS_XB) + (size_t)m * DM) + lane; u32x2* o2 = (u32x2*)((bf16_t*)(ws + WS_XB) + (size_t)mm2 * DM) + lane;
#pragma unroll
        for (int j = 0; j < 4; ++j) { u32x2 w; w.x = pk2(v[j].x, v[j].y); w.y = pk2(v[j].z, v[j].w); o1[64 * j] = w; }
        if (v2) {
#pragma unroll
            for (int j = 0; j < 4; ++j) { u32x2 w; w.x = pk2(v[4 + j].x, v[4 + j].y); w.y = pk2(v[4 + j].z, v[4 + j].w); o2[64 * j] = w; } }
        if (lane == 0) { ((float*)(ws + WS_RSS))[m] = s1; if (v2) ((float*)(ws + WS_RSS))[m2] = s2; }
    }
    { float* rot = (float*)(ws + WS_ROT);
      for (int i = gw * 64 + lane; i < 2056 * 32; i += NGW * 64) {
          const int pi = i >> 5, fi = i & 31; const double pos = pi < 2048 ? (double)pi : (double)(PAST + pi - 2048);
          const double f8[8] = {1.0, 0.7498942093324559, 0.5623413251903491, 0.4216965034285822, 0.31622776601683794, 0.23713737056616552, 0.1778279410038923, 0.1333521432163324};
          double fr = 1.0; switch (fi >> 3) { case 1: fr = 0.1; break; case 2: fr = 0.01; break; case 3: fr = 0.001; break; default: break; }
          double fsel = f8[0];
#pragma unroll
          for (int q = 1; q < 8; ++q) fsel = ((fi & 7) == q) ? f8[q] : fsel;
          const double ang = pos * (fr * fsel);
          const double n = __builtin_rint(ang * 0.15915494309189535);
          double rr = __builtin_fma(-n, 6.283185307179586, ang); rr = __builtin_fma(-n, 2.4492935982947064e-16, rr);
          const float rf = (float)rr;
          rot[(size_t)pi * 64 + fi] = cosf(rf); rot[(size_t)pi * 64 + 32 + fi] = sinf(rf);
      } }
}

__device__ __forceinline__ void tab_unit(const Args& a, Frame& F, int l, int cu) {
    unsigned char* ws = a.ws;
#pragma unroll 2
    for (int j = 0; j < 16; ++j) { const int r = cu * 128 + F.wave * 16 + j, t = r >> 14, e = r & (NEXP - 1);
        const float* src = (t ? a.in[23] : a.in[22]) + ((size_t)l * NEXP + e) * DM;
        p0_tabrow(src, ws + WS_TAB + ((size_t)l * 2 + t) * 16 * MiB, (float*)(ws + WS_TSC) + ((size_t)l * 2 + t) * NEXP, e, F.lane); }
}

namespace pg8 {
struct EpiIn {
    static constexpr bool PERM = true;
    bf16_t* P; const float* rss; const float* rot;
    __device__ __forceinline__ void operator()(const f32x4 (&acc)[2][2][4][2], const Unit& u, int wr, int wc, int fr, int fq) const {
        const int seg = u.pn < 4 ? (u.pn >> 1) : (u.pn >> 2) + 1;
        const int row0 = u.pm * BM + wr * 64 + fr;
#if PROBE_SEL
        const float* rstdv = rss + row0;
#define RSTD_AT(ai, m) rstdv[(ai) * HALF + (m) * 16]
#else
        float rstdv[8];
#pragma unroll
        for (int i = 0; i < 8; ++i) rstdv[i] = rss[row0 + (i >> 2) * HALF + (i & 3) * 16];
#define RSTD_AT(ai, m) rstdv[(ai) * 4 + (m)]
#endif
        if (seg <= 1) {
            float lg[2];
#pragma unroll
            for (int bj = 0; bj < 2; ++bj) { const int hh = 4 * (u.pn & 1) + 2 * bj + (wc >> 1); lg[bj] = logg_of(hh); }
            const int i0 = 16 * (wc & 1) + 4 * fq;
#pragma unroll
            for (int ai = 0; ai < 2; ++ai)
#pragma unroll
                for (int m = 0; m < 4; ++m) {
                    const int row = row0 + ai * HALF + m * 16;
                    const float rstd = rsqrtf(RSTD_AT(ai, m) * (1.0f / DM) + EPS);
                    asm volatile("" ::: "memory");
                    const int pi = row < M_P ? (row & (SEQ - 1)) : SEQ + ((row - M_P) & (DECT - 1));
                    const float jj1 = (float)((row < M_P ? (row & (CH - 1)) : ((row - M_P) & (DECT - 1))) + 1);
                    const float* rp = rot + (size_t)pi * 64 + i0;
#pragma unroll
                    for (int bj = 0; bj < 2; ++bj) {
                        const int hh = 4 * (u.pn & 1) + 2 * bj + (wc >> 1);
                        const float f = __expf(seg == 0 ? jj1 * lg[bj] : -jj1 * lg[bj]) * rstd;
                        bf16_t* dst = P + (size_t)row * LDP + seg * 512 + hh * 64 + i0;
#pragma unroll
                        for (int n = 0; n < 2; ++n) {
                            const f32x2 c2 = *(const f32x2*)(rp + 2 * n), s2 = *(const f32x2*)(rp + 32 + 2 * n);
                            const f32x4 v = acc[ai][bj][m][n];
                            const float a0 = (v[0] * c2.x - v[1] * s2.x) * f, a1 = (v[2] * c2.y - v[3] * s2.y) * f;
                            const float b0 = (v[0] * s2.x + v[1] * c2.x) * f, b1 = (v[2] * s2.y + v[3] * c2.y) * f;
                            *(unsigned*)(dst + 2 * n) = pk2(a0, a1); *(unsigned*)(dst + 32 + 2 * n) = pk2(b0, b1);
                        }
                    }
                    if (m & 1) asm volatile("" ::: "memory");
                }
        } else {
            const int col0 = u.pn * BM + wc * 32 + 8 * fq;
#pragma unroll
            for (int ai = 0; ai < 2; ++ai)
#pragma unroll
                for (int m = 0; m < 4; ++m) {
                    const int row = row0 + ai * HALF + m * 16;
                    const float rstd = rsqrtf(RSTD_AT(ai, m) * (1.0f / DM) + EPS);
                    bf16_t* rowp = P + (size_t)row * LDP + col0;
#pragma unroll
                    for (int bj = 0; bj < 2; ++bj) {
                        f32x4 v0 = acc[ai][bj][m][0] * rstd, v1 = acc[ai][bj][m][1] * rstd;
                        if (seg == 3) {
#pragma unroll
                            for (int j = 0; j < 4; ++j) { v0[j] = siluf_(v0[j]); v1[j] = siluf_(v1[j]); }
                        } else if (seg == 5) {
#pragma unroll
                            for (int j = 0; j < 4; ++j) { v0[j] = geluf_(v0[j]); v1[j] = geluf_(v1[j]); }
                        } else if (seg >= 6) {
#pragma unroll
                            for (int j = 0; j < 4; ++j) { v0[j] = sigmoidf_(v0[j]); v1[j] = sigmoidf_(v1[j]); }
                        }
                        u32x4 w; w.x = pk2(v0[0], v0[1]); w.y = pk2(v0[2], v0[3]); w.z = pk2(v1[0], v1[1]); w.w = pk2(v1[2], v1[3]);
                        *(u32x4*)(rowp + bj * HALF) = w;
                    }
                }
        }
    }
};

struct EpiMerge {
    static constexpr bool PERM = true;
    bf16_t* P; bf16_t* MRG;
    __device__ __forceinline__ void operator()(const f32x4 (&acc)[2][2][4][2], const Unit& u, int wr, int wc, int fr, int fq) const {
        const int row0 = u.pm * BM + wr * 64 + fr, col0 = u.pn * BM + wc * 32 + 8 * fq;
        const int gc = u.half ? PC_GB : PC_GA;
#pragma unroll
        for (int ai = 0; ai < 2; ++ai)
#pragma unroll
            for (int m = 0; m < 4; ++m) {
                bf16_t* rowp = P + (size_t)(row0 + ai * HALF + m * 16) * LDP; bf16_t* mrow = MRG + (size_t)(row0 + ai * HALF + m * 16) * DM;
#pragma unroll
                for (int bj = 0; bj < 2; ++bj) {
                    const int c = col0 + bj * HALF;
                    const u32x4 g = *(const u32x4*)(rowp + gc + c);
                    f32x4 v0 = acc[ai][bj][m][0], v1 = acc[ai][bj][m][1];
                    v0[0] *= bflo(g.x); v0[1] *= bfhi(g.x); v0[2] *= bflo(g.y); v0[3] *= bfhi(g.y);
                    v1[0] *= bflo(g.z); v1[1] *= bfhi(g.z); v1[2] *= bflo(g.w); v1[3] *= bfhi(g.w);
                    if (u.half) { const u32x4 p = *(const u32x4*)(mrow + c);
                        v0[0] += bflo(p.x); v0[1] += bfhi(p.x); v0[2] += bflo(p.y); v0[3] += bfhi(p.y);
                        v1[0] += bflo(p.z); v1[1] += bfhi(p.z); v1[2] += bflo(p.w); v1[3] += bfhi(p.w); }
                    u32x4 w; w.x = pk2(v0[0], v0[1]); w.y = pk2(v0[2], v0[3]); w.z = pk2(v1[0], v1[1]); w.w = pk2(v1[2], v1[3]);
                    *(u32x4*)(mrow + c) = w;
                }
                if (m & 1) asm volatile("" ::: "memory");
            }
    }
};

struct EpiWo {
    static constexpr bool PERM = false;
    const float* xp; const float* xs;
    float* X; bf16_t* XB; float* rssp;
    __device__ __forceinline__ void operator()(const f32x4 (&acc)[2][2][4][2], const Unit& u, int wr, int wc, int fr, int fq) const {
        const int row0 = u.pm * BM + wr * 64 + fr, col0 = u.pn * BM + wc * 32 + 4 * fq;
#pragma unroll
        for (int ai = 0; ai < 2; ++ai)
#pragma unroll
            for (int m = 0; m < 4; ++m) {
                const int row = row0 + ai * HALF + m * 16;
                const float* src = (row < M_P ? xp + (size_t)row * DM : xs + (size_t)(row - M_P) * DM) + col0;
                float* dst = X + (size_t)row * DM + col0; bf16_t* dstb = XB + (size_t)row * DM + col0;
                float ss = 0.f;
#pragma unroll
                for (int bj = 0; bj < 2; ++bj)
#pragma unroll
                    for (int n = 0; n < 2; ++n) {
                        const f32x4 o = *(const f32x4*)(src + bj * HALF + n * 16) + acc[ai][bj][m][n];
                        *(f32x4*)(dst + bj * HALF + n * 16) = o;
                        u32x2 w; w.x = pk2(o[0], o[1]); w.y = pk2(o[2], o[3]); *(u32x2*)(dstb + bj * HALF + n * 16) = w;
                        ss += (o[0] * o[0] + o[1] * o[1]) + (o[2] * o[2] + o[3] * o[3]);
                    }
                ss += __shfl_xor(ss, 16); ss += __shfl_xor(ss, 32);
                if (fq == 0) rssp[(size_t)(u.pn * 4 + wc) * MTOT + row] = ss;
                if (m & 1) asm volatile("" ::: "memory");
            }
    }
};

struct EpiQ {
    static constexpr bool PERM = true;
    bf16_t* P; const float* rssp; float* rss2;
    __device__ __forceinline__ void operator()(const f32x4 (&acc)[2][2][4][2], const Unit& u, int wr, int wc, int fr, int fq) const {
        const int row0 = u.pm * BM + wr * 64 + fr, col0 = u.pn * BM + wc * 32 + 8 * fq;
        float rstdv[8];
#pragma unroll
        for (int i = 0; i < 8; ++i) { const int row = row0 + (i >> 2) * HALF + (i & 3) * 16; float s = 0.f;
#pragma unroll
            for (int j = 0; j < 16; ++j) s += rssp[(size_t)j * MTOT + row];
            if (u.pn == 0 && wc == 0 && fq == 0) rss2[row] = s;
            rstdv[i] = rsqrtf(s * (1.0f / DM) + EPS);
            if ((i & 1)) asm volatile("" ::: "memory"); }
#pragma unroll
        for (int ai = 0; ai < 2; ++ai)
#pragma unroll
            for (int m = 0; m < 4; ++m) {
                const int row = row0 + ai * HALF + m * 16;
                const float rstd = rstdv[ai * 4 + m];
                bf16_t* rowp = P + (size_t)row * LDP + PC_QP + col0;
#pragma unroll
                for (int bj = 0; bj < 2; ++bj) {
                    const f32x4 v0 = acc[ai][bj][m][0] * rstd, v1 = acc[ai][bj][m][1] * rstd;
                    u32x4 w; w.x = pk2(v0[0], v0[1]); w.y = pk2(v0[2], v0[3]); w.z = pk2(v1[0], v1[1]); w.w = pk2(v1[2], v1[3]);
                    *(u32x4*)(rowp + bj * HALF) = w;
                }
            }
    }
};
}

__device__ __forceinline__ void mma32(f32x16& acc, ldsp_t A, int lda_b, ldsp_t Bt, int ldb_b, int ksteps, int lane) {
    ldsp_t ap = A + (lane & 31) * lda_b + (lane >> 5) * 16;
    ldsp_t bp = Bt + (lane & 31) * ldb_b + (lane >> 5) * 16;
    for (int ks = 0; ks < ksteps; ++ks) {
        const bf16x8 a = *(const LAS bf16x8*)(ap + ks * 32), b = *(const LAS bf16x8*)(bp + ks * 32);
        acc = __builtin_amdgcn_mfma_f32_32x32x16_bf16(a, b, acc, 0, 0, 0);
    }
}
template <int KS>
__device__ __forceinline__ void mma32t(f32x16& acc, ldsp_t A, int lda_b, ldsp_t Bt, int ldb_b, int lane) {
    ldsp_t ap = A + (lane & 31) * lda_b + (lane >> 5) * 16;
    ldsp_t bp = Bt + (lane & 31) * ldb_b + (lane >> 5) * 16;
    bf16x8 av[KS], bv[KS];
#pragma unroll
    for (int ks = 0; ks < KS; ++ks) { av[ks] = *(const LAS bf16x8*)(ap + ks * 32); bv[ks] = *(const LAS bf16x8*)(bp + ks * 32); }
#pragma unroll
    for (int ks = 0; ks < KS; ++ks) acc = __builtin_amdgcn_mfma_f32_32x32x16_bf16(av[ks], bv[ks], acc, 0, 0, 0);
}
#define ZERO16 ((f32x16){0.f,0.f,0.f,0.f,0.f,0.f,0.f,0.f,0.f,0.f,0.f,0.f,0.f,0.f,0.f,0.f})

constexpr int R_QS = 0, R_KS = 18432, R_VS = 43008, R_SS = 83968, R_RST = 118784, R_ST = 137216;
constexpr int LD64 = 144, LDK = 192, LDV = 320, LD128 = 272;
typedef short v4i16_t __attribute__((ext_vector_type(4)));
__device__ __forceinline__ bf16x8 frag_tr(ldsp_t X, int stride_b, int c0, int k0, int lane) {
    const int h = lane >> 5, blk = (lane >> 4) & 1, q = (lane & 15) >> 2, p = lane & 3;
    ldsp_t a = X + (k0 + 8 * h + q) * stride_b + (c0 + 16 * blk + 4 * p) * 2;
    const v4i16_t lo = __builtin_amdgcn_ds_read_tr16_b64_v4i16((LAS v4i16_t*)a), hi = __builtin_amdgcn_ds_read_tr16_b64_v4i16((LAS v4i16_t*)(a + 4 * stride_b));
    return (bf16x8){lo[0], lo[1], lo[2], lo[3], hi[0], hi[1], hi[2], hi[3]};
}
__device__ __forceinline__ bf16x8 frag_row(ldsp_t X, int stride_b, int r0, int k0, int lane) { return *(const LAS bf16x8*)(X + (r0 + (lane & 31)) * stride_b + (k0 + 8 * (lane >> 5)) * 2); }

__device__ __forceinline__ void ret_prompt_unit(const Args& a, Frame& F, int l, int b, int h) {
    const int tid = F.tid, lane = F.lane, w = F.wave, hi = lane >> 5, l31 = lane & 31;
    ldsp_t lds = F.lds;
    const bf16_t* P = (const bf16_t*)(a.ws + WS_P);
    bf16_t* ARET = (bf16_t*)(a.ws + WS_ARET);
    const float lg = logg_of(h), G = __expf(128.0f * lg);
    f32x16 racc = ZERO16;
    const int db = w >> 2, eb = w & 3;
    u32x4 pq[2], pk[2], pv[4], pg[4];
#define RET_FETCH(nn) do { const bf16_t* _b = P + ((size_t)b * SEQ + (nn) * CH) * LDP + h * 64; \
        _Pragma("unroll") for (int i = 0; i < 2; ++i) { const int p = tid + 512 * i; const bf16_t* _r = _b + (size_t)(p >> 3) * LDP + (p & 7) * 8; pq[i] = *(const u32x4*)(_r + PC_Q); pk[i] = *(const u32x4*)(_r + PC_K); } \
        _Pragma("unroll") for (int i = 0; i < 4; ++i) { const int p = tid + 512 * i; const bf16_t* _r = _b + h * 64 + (size_t)(p >> 4) * LDP + (p & 15) * 8; pv[i] = *(const u32x4*)(_r + PC_V); } } while (0)
#define RET_FETCH_G(nn) do { const bf16_t* _b = P + ((size_t)b * SEQ + (nn) * CH) * LDP + h * 128 + PC_GR; \
        _Pragma("unroll") for (int i = 0; i < 4; ++i) { const int p = tid + 512 * i; pg[i] = *(const u32x4*)(_b + (size_t)(p >> 4) * LDP + (p & 15) * 8); } } while (0)
    RET_FETCH(0);
    for (int n = 0; n < 16; ++n) {
        const size_t tok0 = (size_t)b * SEQ + n * CH;
#pragma unroll
        for (int i = 0; i < 2; ++i) { const int p = tid + 512 * i; *(LAS u32x4*)(lds + R_QS + (p >> 3) * LD64 + (p & 7) * 16) = pq[i]; *(LAS u32x4*)(lds + R_KS + (p >> 3) * LDK + (p & 7) * 16) = pk[i]; }
#pragma unroll
        for (int i = 0; i < 4; ++i) { const int p = tid + 512 * i; *(LAS u32x4*)(lds + R_VS + (p >> 4) * LDV + (p & 15) * 16) = pv[i]; }
#pragma unroll
        for (int g = 0; g < 4; ++g) { u32x2 wv; wv.x = pk2(racc[4 * g], racc[4 * g + 1]); wv.y = pk2(racc[4 * g + 2], racc[4 * g + 3]);
            *(LAS u32x2*)(lds + R_RST + (32 * eb + l31) * LD64 + (32 * db + 8 * g + 4 * hi) * 2) = wv; }
        if (n + 1 < 16) RET_FETCH(n + 1);
        RET_FETCH_G(n);
        LBAR();
#pragma unroll
        for (int t2 = 0; t2 < 2; ++t2) { const int t = 2 * w + t2, mb = t >> 2, jb = t & 3;
            if (mb <= jb) { f32x16 sacc = ZERO16;
                bf16x8 af[4], bf[4];
#pragma unroll
                for (int ks = 0; ks < 4; ++ks) { af[ks] = frag_row(lds + R_KS, LDK, 32 * mb, 16 * ks, lane); bf[ks] = frag_row(lds + R_QS, LD64, 32 * jb, 16 * ks, lane); }
#pragma unroll
                for (int ks = 0; ks < 4; ++ks) sacc = __builtin_amdgcn_mfma_f32_32x32x16_bf16(af[ks], bf[ks], sacc, 0, 0, 0);
                const int j = 32 * jb + l31;
#pragma unroll
                for (int g = 0; g < 4; ++g) { const int m0 = 32 * mb + 8 * g + 4 * hi; float v[4];
#pragma unroll
                    for (int q = 0; q < 4; ++q) v[q] = (j >= m0 + q) ? sacc[4 * g + q] : 0.f;
                    u32x2 wv; wv.x = pk2(v[0], v[1]); wv.y = pk2(v[2], v[3]);
                    *(LAS u32x2*)(lds + R_SS + j * LD128 + m0 * 2) = wv; } } }
        LBAR();
        const int jb = w >> 1, eh = w & 1;
        f32x16 oacc[2];
        oacc[0] = ZERO16; oacc[1] = ZERO16;
        { bf16x8 a0[4], a1[4], bf[4];
#pragma unroll
          for (int ks = 0; ks < 4; ++ks) { a0[ks] = frag_row(lds + R_RST, LD64, 32 * (2 * eh), 16 * ks, lane); a1[ks] = frag_row(lds + R_RST, LD64, 32 * (2 * eh + 1), 16 * ks, lane); bf[ks] = frag_row(lds + R_QS, LD64, 32 * jb, 16 * ks, lane); }
#pragma unroll
          for (int ks = 0; ks < 4; ++ks) { oacc[0] = __builtin_amdgcn_mfma_f32_32x32x16_bf16(a0[ks], bf[ks], oacc[0], 0, 0, 0); oacc[1] = __builtin_amdgcn_mfma_f32_32x32x16_bf16(a1[ks], bf[ks], oacc[1], 0, 0, 0); } }
        for (int mbk = 0; mbk <= jb; ++mbk) {
            bf16x8 a0[2], a1[2], bf[2];
#pragma unroll
            for (int ks = 0; ks < 2; ++ks) { const int k0 = 32 * mbk + 16 * ks; a0[ks] = frag_tr(lds + R_VS, LDV, 32 * (2 * eh), k0, lane); a1[ks] = frag_tr(lds + R_VS, LDV, 32 * (2 * eh + 1), k0, lane); bf[ks] = frag_row(lds + R_SS, LD128, 32 * jb, k0, lane); }
#pragma unroll
            for (int ks = 0; ks < 2; ++ks) { oacc[0] = __builtin_amdgcn_mfma_f32_32x32x16_bf16(a0[ks], bf[ks], oacc[0], 0, 0, 0); oacc[1] = __builtin_amdgcn_mfma_f32_32x32x16_bf16(a1[ks], bf[ks], oacc[1], 0, 0, 0); }
        }
        float s1 = 0.f, s2 = 0.f;
#pragma unroll
        for (int t = 0; t < 2; ++t)
#pragma unroll
            for (int r = 0; r < 16; ++r) { s1 += oacc[t][r]; s2 += oacc[t][r] * oacc[t][r]; }
        s1 += __shfl_xor(s1, 32); s2 += __shfl_xor(s2, 32);
        if (hi == 0) *(LAS f32x2*)(lds + R_ST + (eh * 128 + 32 * jb + l31) * 8) = (f32x2){s1, s2};
        LBAR();
        { const int j = 32 * jb + l31;
          const f32x2 sa = *(const LAS f32x2*)(lds + R_ST + j * 8), sb = *(const LAS f32x2*)(lds + R_ST + (128 + j) * 8);
          const float mu = (sa.x + sb.x) * (1.0f / DV), var = (sa.y + sb.y) * (1.0f / DV) - mu * mu, rstd = rsqrtf(fmaxf(var, 0.f) + EPS);
#pragma unroll
          for (int t = 0; t < 2; ++t)
#pragma unroll
              for (int g = 0; g < 4; ++g) { const int e0 = 32 * (2 * eh + t) + 8 * g + 4 * hi;
                  u32x2 wv; wv.x = pk2((oacc[t][4 * g] - mu) * rstd, (oacc[t][4 * g + 1] - mu) * rstd); wv.y = pk2((oacc[t][4 * g + 2] - mu) * rstd, (oacc[t][4 * g + 3] - mu) * rstd);
                  *(LAS u32x2*)(lds + R_SS + j * LD128 + e0 * 2) = wv; } }
#pragma unroll
        for (int kh = 0; kh < 2; ++kh) { bf16x8 af[4], bf[4];
#pragma unroll
          for (int ks = 0; ks < 4; ++ks) { af[ks] = frag_tr(lds + R_KS, LDK, 32 * db, 64 * kh + 16 * ks, lane); bf[ks] = frag_tr(lds + R_VS, LDV, 32 * eb, 64 * kh + 16 * ks, lane); }
#pragma unroll
          for (int ks = 0; ks < 4; ++ks) racc = __builtin_amdgcn_mfma_f32_32x32x16_bf16(af[ks], bf[ks], racc, 0, 0, 0); }
#pragma unroll
        for (int r = 0; r < 16; ++r) racc[r] *= G;
        LBAR();
#pragma unroll
        for (int i = 0; i < 4; ++i) { const int p = tid + 512 * i, row = p >> 4, c = p & 15;
            const u32x4 ov = *(const LAS u32x4*)(lds + R_SS + row * LD128 + c * 16), gv = pg[i];
            u32x4 wv; wv.x = pk2(bflo(ov.x) * bflo(gv.x), bfhi(ov.x) * bfhi(gv.x)); wv.y = pk2(bflo(ov.y) * bflo(gv.y), bfhi(ov.y) * bfhi(gv.y));
            wv.z = pk2(bflo(ov.z) * bflo(gv.z), bfhi(ov.z) * bfhi(gv.z)); wv.w = pk2(bflo(ov.w) * bflo(gv.w), bfhi(ov.w) * bfhi(gv.w));
            *(u32x4*)(ARET + (tok0 + row) * DM + h * 128 + c * 8) = wv; }
    }
    float* so = a.out + O_SRP + ((((size_t)l * NBATCH + b) * HR + h) * DK) * DV;
#pragma unroll
    for (int r = 0; r < 16; ++r) { const int d = 32 * db + (r & 3) + 8 * (r >> 2) + 4 * hi; so[(size_t)d * DV + 32 * eb + l31] = racc[r]; }
#undef RET_FETCH
#undef RET_FETCH_G
}

__device__ __forceinline__ void ret_sample_unit(const Args& a, Frame& F, int l, int bs, int h) {
    const int tid = F.tid, lane = F.lane, w = F.wave;
    LAS float* qd = (LAS float*)F.lds; LAS float* ku = qd + 512; LAS float* vv = ku + 512; LAS float* S = vv + 1024; LAS float* crossp = S + 64; LAS float* red = crossp + 4096;
    bf16_t* P = (bf16_t*)(a.ws + WS_P);
    const size_t tok0 = (size_t)M_P + bs * DECT;
    { const int j = tid >> 6, d = tid & 63; const bf16_t* src = P + (tok0 + j) * LDP + h * 64 + d; qd[tid] = bf1(src[PC_Q]); ku[tid] = bf1(src[PC_K]); }
#pragma unroll
    for (int i = 0; i < 2; ++i) { const int idx = tid + 512 * i, m = idx >> 7, e = idx & 127; vv[idx] = bf1(P[(tok0 + m) * LDP + PC_V + h * 128 + e]); }
    LBAR();
    const int dg = tid >> 7, e = tid & 127;
    const size_t soff = ((((size_t)l * DECB + bs) * HR + h) * DK) * DV;
    const float* r0 = a.in[2] + soff; float* rn = a.out + O_SRS + soff;
    const float lg = logg_of(h), G8 = __expf(8.0f * lg);
    float cross[8];
#pragma unroll
    for (int j = 0; j < 8; ++j) cross[j] = 0.f;
    float rv[16];
#pragma unroll
    for (int dd = 0; dd < 16; ++dd) rv[dd] = r0[(size_t)(dg * 16 + dd) * DV + e];
#pragma unroll
    for (int dd = 0; dd < 16; ++dd) { const int d = dg * 16 + dd; const float r = rv[dd]; float kvs = 0.f;
#pragma unroll
        for (int m = 0; m < 8; ++m) kvs += ku[m * 64 + d] * vv[m * 128 + e];
        rn[(size_t)d * DV + e] = G8 * (r + kvs);
#pragma unroll
        for (int j = 0; j < 8; ++j) cross[j] += qd[j * 64 + d] * r; }
#pragma unroll
    for (int j = 0; j < 8; ++j) crossp[(dg * 8 + j) * 128 + e] = cross[j];
    { const int pr = tid >> 3, part = tid & 7, j = pr >> 3, m = pr & 7; float sp = 0.f;
#pragma unroll
      for (int d = 0; d < 8; ++d) sp += qd[j * 64 + part * 8 + d] * ku[m * 64 + part * 8 + d];
      sp += __shfl_xor(sp, 1); sp += __shfl_xor(sp, 2); sp += __shfl_xor(sp, 4);
      if (part == 0) S[pr] = (j >= m) ? sp : 0.f; }
    LBAR();
    float o[2];
#pragma unroll
    for (int jj = 0; jj < 2; ++jj) { const int j = dg + 4 * jj; float s = 0.f;
#pragma unroll
        for (int g = 0; g < 4; ++g) s += crossp[(g * 8 + j) * 128 + e];
#pragma unroll
        for (int m = 0; m < 8; ++m) s += S[j * 8 + m] * vv[m * 128 + e];
        o[jj] = s;
        const float t1 = wave_sum(s), t2 = wave_sum(s * s);
        if (lane == 0) { red[(jj * 8 + w) * 2] = t1; red[(jj * 8 + w) * 2 + 1] = t2; } }
    LBAR();
#pragma unroll
    for (int jj = 0; jj < 2; ++jj) { const int j = dg + 4 * jj, w0 = 2 * dg;
        const float t1 = red[(jj * 8 + w0) * 2] + red[(jj * 8 + w0 + 1) * 2], t2 = red[(jj * 8 + w0) * 2 + 1] + red[(jj * 8 + w0 + 1) * 2 + 1];
        const float mu = t1 * (1.0f / DV), var = t2 * (1.0f / DV) - mu * mu, rstd = rsqrtf(fmaxf(var, 0.f) + EPS);
        const bf16_t* prow = P + (tok0 + j) * LDP + h * 128 + e;
        ((bf16_t*)(a.ws + WS_ARET))[(tok0 + j) * DM + h * 128 + e] = (bf16_t)f2bf((o[jj] - mu) * rstd * bf1(prow[PC_GR])); }
    LBAR();
}

constexpr int N_XRL = 0, N_XCF = 33536, N_XCB = 66304, N_WGT = 84736, N_CAR = 103168, N_BUF = 107264;
__device__ __forceinline__ void rnn_unit(const Args& a, Frame& F, int l, bool sample, int bg, int nb) {
    const int tid = F.tid, lane = F.lane, w = F.wave, hi = lane >> 5, l31 = lane & 31;
    ldsp_t lds = F.lds;
    LAS float* xrl = (LAS float*)(lds + N_XRL); LAS float* xcf = (LAS float*)(lds + N_XCF); LAS float* car = (LAS float*)(lds + N_CAR); LAS float* bufl = (LAS float*)(lds + N_BUF);
    LAS float* aa = xrl; LAS float* uu = xcf;
    bf16_t* P = (bf16_t*)(a.ws + WS_P);
    const int ch0 = nb * BS;
    { const bf16_t* wg = (const bf16_t*)(a.ws + WS_WG) + ((size_t)l * NBLK + nb) * 2 * BS * BS;
#pragma unroll
      for (int i = 0; i < 2; ++i) { const int p = tid + 512 * i, row = p >> 3, c8 = p & 7; *(LAS u32x4*)(lds + N_WGT + row * LD64 + c8 * 16) = *(const u32x4*)(wg + row * 64 + c8 * 8); } }
    const int cc = tid & 63;
    const float* cwp = a.in[11] + (size_t)l * 4 * DM + ch0 + cc;
    const float cw0 = cwp[0], cw1 = cwp[DM], cw2 = cwp[2 * DM], cw3 = cwp[3 * DM], cbv = a.in[12][l * DM + ch0 + cc];
    const int rb = w >> 1, cb = w & 1, dcol = 32 * cb + l31;
    const float bav = a.in[14][l * DM + ch0 + dcol], bxv = a.in[16][l * DM + ch0 + dcol];
    const float spl = log1pf(__expf(-a.in[17][l * DM + ch0 + dcol]));
    const int ntiles = sample ? 1 : 16;
    float hcar = 0.f;
    if (sample) {
        for (int i = tid; i < 16 * 3 * 64; i += NTHREADS) { const int s = i / 192, r = (i / 64) % 3, c = i & 63;
            bufl[i] = a.in[4][(((size_t)l * DECB + bg * 16 + s) * 3 + r) * DM + ch0 + c]; }
    }
    u32x4 pre[3];
#define RNN_FETCH(nn) do { const size_t _t0 = sample ? (size_t)M_P + bg * 128 : (size_t)bg * SEQ + (nn) * 128; _Pragma("unroll") for (int k = 0; k < 3; ++k) { \
        const int p = tid + 512 * k, row = p >> 3, c8 = p & 7; pre[k] = (u32x4){0u, 0u, 0u, 0u}; \
        if (p < 131 * 8 && (row >= 3 || (!sample && (nn) > 0))) pre[k] = *(const u32x4*)(P + (_t0 + row - 3) * LDP + PC_XR + ch0 + c8 * 8); } } while (0)
    RNN_FETCH(0);
    for (int n = 0; n < ntiles; ++n) {
        const size_t tok0 = sample ? (size_t)M_P + bg * 128 : (size_t)bg * SEQ + n * 128;
        unsigned short gl[16];
#pragma unroll
        for (int i = 0; i < 16; ++i) gl[i] = P[(tok0 + 16 * w + i) * LDP + PC_GN + ch0 + cc];
#pragma unroll
        for (int k = 0; k < 3; ++k) { const int p = tid + 512 * k, row = p >> 3, c8 = p & 7;
            if (p < 131 * 8) { const u32x4 v = pre[k]; LAS float* d = xrl + row * 64 + c8 * 8;
                *(LAS f32x4*)d = (f32x4){bflo(v.x), bfhi(v.x), bflo(v.y), bfhi(v.y)}; *(LAS f32x4*)(d + 4) = (f32x4){bflo(v.z), bfhi(v.z), bflo(v.w), bfhi(v.w)}; } }
        LBAR();
        if (n + 1 < ntiles) RNN_FETCH(n + 1);
        { const int tg = tid >> 6;
#pragma unroll 4
          for (int i = 0; i < 16; ++i) { const int t = tg * 16 + i; float x0, x1, x2;
              const float x3 = xrl[(t + 3) * 64 + cc];
              if (sample) { const int s = t >> 3, j = t & 7;
                  x0 = j >= 3 ? xrl[t * 64 + cc] : bufl[(s * 3 + j) * 64 + cc];
                  x1 = j >= 2 ? xrl[(t + 1) * 64 + cc] : bufl[(s * 3 + j + 1) * 64 + cc];
                  x2 = j >= 1 ? xrl[(t + 2) * 64 + cc] : bufl[(s * 3 + j + 2) * 64 + cc];
              } else { x0 = xrl[t * 64 + cc]; x1 = xrl[(t + 1) * 64 + cc]; x2 = xrl[(t + 2) * 64 + cc]; }
              const float xc = cbv + cw0 * x0 + cw1 * x1 + cw2 * x2 + cw3 * x3;
              xcf[t * 64 + cc] = xc; *(LAS bf16_t*)(lds + N_XCB + t * LD64 + cc * 2) = (bf16_t)f2bf(xc); } }
        if (sample) { if (tid < 192) { }     }
        if (sample) { for (int i = tid; i < 16 * 3 * 64; i += NTHREADS) { const int s = i / 192, r = (i / 64) % 3, c = i & 63;
                a.out[O_SCS + (((size_t)l * DECB + bg * 16 + s) * 3 + r) * DM + ch0 + c] = xrl[(3 + s * 8 + 5 + r) * 64 + c]; } }
        else if (n == 15) { if (tid < 192) { const int r = tid >> 6, c = tid & 63; a.out[O_SCP + (((size_t)l * NBATCH + bg) * 3 + r) * DM + ch0 + c] = xrl[(3 + 125 + r) * 64 + c]; } }
        LBAR();
        { f32x16 ar = ZERO16, ai = ZERO16;
          mma32t<4>(ar, lds + N_XCB + rb * 32 * LD64, LD64, lds + N_WGT + (32 * cb) * LD64, LD64, lane);
          mma32t<4>(ai, lds + N_XCB + rb * 32 * LD64, LD64, lds + N_WGT + (64 + 32 * cb) * LD64, LD64, lane);
#pragma unroll
          for (int r = 0; r < 16; ++r) { const int t = 32 * rb + (r & 3) + 8 * (r >> 2) + 4 * hi;
              const float rg = sigmoidf_(ar[r] + bav), ig = sigmoidf_(ai[r] + bxv);
              const float la = -8.0f * rg * spl, av = __expf(la), mult = sqrtf(fmaxf(-expm1f(2.0f * la), 0.f));
              const float xc = xcf[t * 64 + dcol];
              aa[t * 64 + dcol] = av; uu[t * 64 + dcol] = mult * ig * xc; } }
        LBAR();
        if (!sample) {
            float Ap = 1.f, Hl = 0.f;
#pragma unroll 4
            for (int i = 0; i < 16; ++i) { const int t = 16 * w + i; const float av = aa[t * 64 + cc], uv = uu[t * 64 + cc]; Hl = av * Hl + uv; Ap *= av; }
            car[w * 64 + cc] = Ap; car[512 + w * 64 + cc] = Hl;
            LBAR();
            float hin = hcar, hnext = hcar;
#pragma unroll
            for (int w2 = 0; w2 < 8; ++w2) { const float A2 = car[w2 * 64 + cc], H2 = car[512 + w2 * 64 + cc]; hnext = A2 * hnext + H2; if (w2 < w) hin = hnext; }
            float hh = hin;
#pragma unroll
            for (int i = 0; i < 16; ++i) { const int t = 16 * w + i; hh = aa[t * 64 + cc] * hh + uu[t * 64 + cc];
                ((bf16_t*)(a.ws + WS_ARNN))[(tok0 + t) * DM + ch0 + cc] = (bf16_t)f2bf(hh * bf1(gl[i])); }
            hcar = hnext;
        } else {
#pragma unroll
            for (int s2 = 0; s2 < 2; ++s2) { const int s = 2 * w + s2, bs = bg * 16 + s;
                float hh = a.in[3][((size_t)l * DECB + bs) * DM + ch0 + cc];
#pragma unroll
                for (int j = 0; j < 8; ++j) { const int t = s * 8 + j; hh = aa[t * 64 + cc] * hh + uu[t * 64 + cc];
                    ((bf16_t*)(a.ws + WS_ARNN))[(tok0 + t) * DM + ch0 + cc] = (bf16_t)f2bf(hh * bf1(gl[s2 * 8 + j])); }
                a.out[O_SHS + ((size_t)l * DECB + bs) * DM + ch0 + cc] = hh; }
        }
        LBAR();
    }
    if (!sample && w == 0) a.out[O_SHP + ((size_t)l * NBATCH + bg) * DM + ch0 + cc] = hcar;
#undef RNN_FETCH
}

__device__ __forceinline__ unsigned ord_of(float f) { const unsigned u = __builtin_bit_cast(unsigned, f); return u ^ ((u >> 31) ? 0xFFFFFFFFu : 0x80000000u); }
__device__ __forceinline__ float ord_inv(unsigned o) { const unsigned u = (o >> 31) ? (o ^ 0x80000000u) : ~o; return __builtin_bit_cast(float, u); }
__host__ __device__ constexpr bool cand_ok(int a, int b) { return (a + 1) * (b + 1) <= 16; }

#define CEX(a, b) do { const unsigned _x = (a), _y = (b); (a) = _x > _y ? _x : _y; (b) = _x > _y ? _y : _x; } while (0)
__device__ __forceinline__ void sort16_desc(unsigned (&v)[16]) {
#pragma unroll
    for (int k = 2; k <= 16; k <<= 1)
#pragma unroll
        for (int j = k >> 1; j > 0; j >>= 1)
#pragma unroll
            for (int i = 0; i < 16; ++i) { const int p = i ^ j; if (p > i) { if ((i & k) == 0) CEX(v[i], v[p]); else CEX(v[p], v[i]); } }
}
__device__ __forceinline__ void bitonic_merge16_desc(unsigned (&v)[16]) {
#pragma unroll
    for (int j = 8; j > 0; j >>= 1)
#pragma unroll
        for (int i = 0; i < 16; ++i) { const int p = i ^ j; if (p > i) CEX(v[i], v[p]); }
}
__device__ __forceinline__ void merge_top16(unsigned (&a)[16], const unsigned (&b)[16]) {
#pragma unroll
    for (int i = 0; i < 16; ++i) a[i] = a[i] > b[15 - i] ? a[i] : b[15 - i];
    bitonic_merge16_desc(a);
}

__device__ __forceinline__ void route_unit(const Args& a, int l, int tb, int h, int lane) {
    const int hi = lane >> 5, l31 = lane & 31, token = tb * 32 + l31;
    const bf16_t* P = (const bf16_t*)(a.ws + WS_P);
    const bf16_t* qrow = P + (size_t)token * LDP + PC_QP + h * 256 + hi * 8;
    const bf16_t* kbase = (const bf16_t*)(a.ws + WS_KEYS) + ((size_t)(l * PH + h) * 2) * NKEY * HK + (size_t)l31 * HK + hi * 8;
    unsigned L[2][16];
#pragma unroll
    for (int p = 0; p < 2; ++p) {
        f32x16 acc[4];
#pragma unroll
        for (int kb = 0; kb < 4; ++kb) acc[kb] = ZERO16;
#pragma unroll 2
        for (int ks = 0; ks < 8; ++ks) {
            const bf16x8 bq = *(const bf16x8*)(qrow + p * 128 + ks * 16);
#pragma unroll
            for (int kb = 0; kb < 4; ++kb) { const bf16x8 ak = *(const bf16x8*)(kbase + ((size_t)p * NKEY + kb * 32) * HK + ks * 16);
                acc[kb] = __builtin_amdgcn_mfma_f32_32x32x16_bf16(ak, bq, acc[kb], 0, 0, 0); }
        }
        unsigned g0[16], g1[16];
#pragma unroll
        for (int r = 0; r < 16; ++r) { const int key = (r & 3) + 8 * (r >> 2) + 4 * hi; g0[r] = (ord_of(acc[0][r]) & ~127u) | (unsigned)(127 - key); g1[r] = (ord_of(acc[1][r]) & ~127u) | (unsigned)(127 - (32 + key)); }
        sort16_desc(g0); sort16_desc(g1); merge_top16(g0, g1);
        unsigned g2[16];
#pragma unroll
        for (int r = 0; r < 16; ++r) { const int key = (r & 3) + 8 * (r >> 2) + 4 * hi; g1[r] = (ord_of(acc[2][r]) & ~127u) | (unsigned)(127 - (64 + key)); g2[r] = (ord_of(acc[3][r]) & ~127u) | (unsigned)(127 - (96 + key)); }
        sort16_desc(g1); sort16_desc(g2); merge_top16(g1, g2); merge_top16(g0, g1);
#pragma unroll
        for (int i = 0; i < 16; ++i) g1[i] = (unsigned)__shfl_xor((int)g0[i], 32);
        merge_top16(g0, g1);
#pragma unroll
        for (int i = 0; i < 16; ++i) L[p][i] = g0[i];
    }
    float sa[16], sb[16];
#pragma unroll
    for (int i = 0; i < 16; ++i) { sa[i] = ord_inv(L[0][i] & ~127u); sb[i] = ord_inv(L[1][i] & ~127u); }
#define CKEY(x, y) ((ord_of(sa[x] + sb[y]) & ~255u) | (unsigned)(255 - ((x) * 16 + (y))))
    unsigned best[16], t1[16];
#pragma unroll
    for (int y = 0; y < 16; ++y) { best[y] = CKEY(0, y); t1[y] = y < 8 ? CKEY(1, y) : 0u; }
    merge_top16(best, t1);
    { int n = 0;
#pragma unroll
      for (int x = 2; x < 7; ++x)
#pragma unroll
          for (int y = 0; y < 16; ++y) if (cand_ok(x, y)) { t1[n] = CKEY(x, y); ++n; }
    }
    sort16_desc(t1); merge_top16(best, t1);
    { int n = 0;
#pragma unroll
      for (int x = 7; x < 16; ++x)
#pragma unroll
          for (int y = 0; y < 16; ++y) if (cand_ok(x, y)) { t1[n] = CKEY(x, y); ++n; }
#pragma unroll
      for (int i = 10; i < 16; ++i) t1[i] = 0u;
    }
    sort16_desc(t1); merge_top16(best, t1);
#undef CKEY
    float sc[16], ssum = 0.f; const float mx = ord_inv(best[0] & ~255u);
#pragma unroll
    for (int it = 0; it < 16; ++it) { sc[it] = __expf(ord_inv(best[it] & ~255u) - mx); ssum += sc[it]; }
    const float inv = 1.0f / ssum;
    unsigned* eo = (unsigned*)(a.ws + WS_EIDX) + (size_t)token * 128 + h * 16 + hi * 8;
    float* go = (float*)(a.ws + WS_GATE) + (size_t)token * 128 + h * 16 + hi * 8;
#pragma unroll
    for (int it = 0; it < 8; ++it) {
        unsigned b0 = best[it], b1 = best[it + 8]; float g0 = sc[it], g1 = sc[it + 8];
        asm volatile("" : "+v"(b0), "+v"(b1), "+v"(g0), "+v"(g1));
        const unsigned bsel = hi ? b1 : b0; const float gsel = (hi ? g1 : g0) * inv;
        const unsigned c = 255u - (bsel & 255u), ca = c >> 4, cb = c & 15u;
        unsigned k1 = 0u, k2 = 0u;
#pragma unroll
        for (int i = 0; i < 16; ++i) { k1 = (ca == (unsigned)i) ? (127u - (L[0][i] & 127u)) : k1; k2 = (cb == (unsigned)i) ? (127u - (L[1][i] & 127u)) : k2; }
        eo[it] = k1 * 128u + k2; go[it] = gsel;
    }
}
#undef CEX

constexpr int MAXT = 9;
__device__ __forceinline__ void dec16(const u32x4 r, float (&f)[16]) {
    const unsigned w[4] = {r.x, r.y, r.z, r.w};
#pragma unroll
    for (int j = 0; j < 4; ++j) { const f32x2 a = __builtin_amdgcn_cvt_pk_f32_fp8((int)w[j], false), b = __builtin_amdgcn_cvt_pk_f32_fp8((int)w[j], true);
        f[4 * j] = a.x; f[4 * j + 1] = a.y; f[4 * j + 2] = b.x; f[4 * j + 3] = b.y; }
}
__device__ __forceinline__ void peer_phase(const Args& a, Frame& F, int l, bool lastlayer) {
    const int lane = F.lane, l7 = lane & 7, lg3 = lane >> 3;
    const int gw = F.vcu * NWAVES + F.wave, NGW = F.G * NWAVES;
    const unsigned char* TU = a.ws + WS_TAB + ((size_t)l * 2) * 16 * MiB;
    const unsigned char* TV = a.ws + WS_TAB + ((size_t)l * 2 + 1) * 16 * MiB;
    const float* SCU = (const float*)(a.ws + WS_TSC) + ((size_t)l * 2) * NEXP; const float* SCV = SCU + NEXP;
    bf16_t* XB = (bf16_t*)(a.ws + WS_XB); float* X = a.out;
    const unsigned* EI = (const unsigned*)(a.ws + WS_EIDX); const float* GT = (const float*)(a.ws + WS_GATE);
    const float* g2 = a.in[6] + (size_t)l * DM;
    LAS unsigned* st = (LAS unsigned*)(F.lds + F.wave * 16384) + lane;
#define ST_ELO(i) st[(0 * MAXT + (i)) * 64]
#define ST_EHI(i) st[(1 * MAXT + (i)) * 64]
#define ST_H0(i)  ((LAS float*)st)[(2 * MAXT + (i)) * 64]
#define ST_H1(i)  ((LAS float*)st)[(3 * MAXT + (i)) * 64]
#define ST_SSQ(i) ((LAS float*)st)[(4 * MAXT + (i)) * 64]
    const int ntok = (MTOT - gw + NGW - 1) / NGW;
    for (int i = 0; i < ntok; ++i) { const int t = gw + NGW * i; ST_ELO(i) = EI[(size_t)t * 128 + lane]; ST_EHI(i) = EI[(size_t)t * 128 + 64 + lane]; ST_H0(i) = 0.f; ST_H1(i) = 0.f; ST_SSQ(i) = 0.f; }
#define PEER_ISSUE(R, TAB, ss, ii, eword) do { const unsigned _e = (eword); _Pragma("unroll") for (int q = 0; q < 8; ++q) { \
        const unsigned idx = (unsigned)__shfl((int)_e, q * 8 + lg3); R[q] = *(const u32x4*)((TAB) + ((size_t)(ss) * NEXP + idx) * 128 + 16 * l7); } } while (0)
    for (int urep = 0; urep < REPS(7); ++urep) {
    if (urep) { for (int i = 0; i < ntok; ++i) { ST_H0(i) = 0.f; ST_H1(i) = 0.f; } }
    {
        u32x4 RA[8], RB[8];
        PEER_ISSUE(RA, TU, 0, 0, ST_ELO(0));
        u32x4 xa = *(const u32x4*)(XB + (size_t)gw * DM + 16 * l7), xb = *(const u32x4*)(XB + (size_t)gw * DM + 16 * l7 + 8);
#pragma unroll 1
        for (int s = 0; s < 8; ++s) {
            float gv[16];
#pragma unroll
            for (int j = 0; j < 4; ++j) { const f32x4 g = *(const f32x4*)(g2 + 128 * s + 16 * l7 + 4 * j); gv[4 * j] = g[0]; gv[4 * j + 1] = g[1]; gv[4 * j + 2] = g[2]; gv[4 * j + 3] = g[3]; }
#pragma unroll 1
            for (int i = 0; i < ntok; ++i) {
                PEER_ISSUE(RB, TU, s, i, ST_EHI(i));
                int sn = s, in = i + 1; if (in == ntok) { in = 0; sn = s + 1; } if (sn == 8) { sn = 7; in = ntok - 1; }
                const int tn = gw + NGW * in;
                const u32x4 xan = *(const u32x4*)(XB + (size_t)tn * DM + 128 * sn + 16 * l7), xbn = *(const u32x4*)(XB + (size_t)tn * DM + 128 * sn + 16 * l7 + 8);
                float xg[16];
                { const unsigned xw[8] = {xa.x, xa.y, xa.z, xa.w, xb.x, xb.y, xb.z, xb.w};
#pragma unroll
                  for (int j = 0; j < 8; ++j) { xg[2 * j] = bflo(xw[j]) * gv[2 * j]; xg[2 * j + 1] = bfhi(xw[j]) * gv[2 * j + 1]; } }
                float p[16];
#pragma unroll
                for (int q = 0; q < 8; ++q) { float f[16]; dec16(RA[q], f); float s0 = 0.f, s1 = 0.f;
#pragma unroll
                    for (int j = 0; j < 8; ++j) { s0 += f[2 * j] * xg[2 * j]; s1 += f[2 * j + 1] * xg[2 * j + 1]; }
                    p[q] = s0 + s1;
                    if (q < 7) asm volatile("" : "+v"(RA[q + 1].x), "+v"(RA[q + 1].y), "+v"(RA[q + 1].z), "+v"(RA[q + 1].w) : "v"(p[q])); }
                asm volatile("" :: "v"(p[7]));
                PEER_ISSUE(RA, TU, sn, in, ST_ELO(in));
#pragma unroll
                for (int q = 0; q < 8; ++q) { float f[16]; dec16(RB[q], f); float s0 = 0.f, s1 = 0.f;
#pragma unroll
                    for (int j = 0; j < 8; ++j) { s0 += f[2 * j] * xg[2 * j]; s1 += f[2 * j + 1] * xg[2 * j + 1]; }
                    p[8 + q] = s0 + s1;
                    if (q < 7) asm volatile("" : "+v"(RB[q + 1].x), "+v"(RB[q + 1].y), "+v"(RB[q + 1].z), "+v"(RB[q + 1].w) : "v"(p[8 + q])); }
                float p8[8], p4[4], p2[2];
#pragma unroll
                for (int q = 0; q < 8; ++q) { const float keep = (lane & 4) ? p[q + 8] : p[q], send = (lane & 4) ? p[q] : p[q + 8]; p8[q] = keep + __shfl_xor(send, 4); }
#pragma unroll
                for (int q = 0; q < 4; ++q) { const float keep = (lane & 2) ? p8[q + 4] : p8[q], send = (lane & 2) ? p8[q] : p8[q + 4]; p4[q] = keep + __shfl_xor(send, 2); }
#pragma unroll
                for (int q = 0; q < 2; ++q) { const float keep = (lane & 1) ? p4[q + 2] : p4[q], send = (lane & 1) ? p4[q] : p4[q + 2]; p2[q] = keep + __shfl_xor(send, 1); }
                ST_H0(i) += p2[0]; ST_H1(i) += p2[1];
                xa = xan; xb = xbn;
            }
        }
    } }
    for (int i = 0; i < ntok; ++i) { const int t = gw + NGW * i;
        const float rstd = rsqrtf(((const float*)(a.ws + WS_RSS2))[t] * (1.0f / DM) + EPS);
        const int k0 = 16 * l7 + lg3, k1 = k0 + 8; const unsigned e0 = EI[(size_t)t * 128 + k0], e1 = EI[(size_t)t * 128 + k1];
        ST_H0(i) = geluf_(ST_H0(i) * rstd * SCU[e0]) * GT[(size_t)t * 128 + k0] * SCV[e0];
        ST_H1(i) = geluf_(ST_H1(i) * rstd * SCU[e1]) * GT[(size_t)t * 128 + k1] * SCV[e1]; }
    {
        u32x4 RA[8], RB[8];
        PEER_ISSUE(RA, TV, 0, 0, ST_ELO(0));
#pragma unroll 1
        for (int s = 0; s < 8; ++s) {
#pragma unroll 1
            for (int i = 0; i < ntok; ++i) { const int t = gw + NGW * i;
                PEER_ISSUE(RB, TV, s, i, ST_EHI(i));
                int sn = s, in = i + 1; if (in == ntok) { in = 0; sn = s + 1; } if (sn == 8) { sn = 7; in = ntok - 1; }
                const int col = 128 * s + 16 * l7 + 8 * ((lane >> 5) & 1) + 4 * ((lane >> 4) & 1) + 2 * ((lane >> 3) & 1);
                f32x2 xv = *(const f32x2*)(X + (size_t)t * DM + col);
                const float h0 = ST_H0(i), h1 = ST_H1(i);
                float o[16];
#pragma unroll
                for (int j = 0; j < 16; ++j) o[j] = 0.f;
#pragma unroll
                for (int q = 0; q < 8; ++q) { const float hq = __shfl((q & 1) ? h1 : h0, (lane & ~7) | (q >> 1)); float f[16]; dec16(RA[q], f);
#pragma unroll
                    for (int j = 0; j < 16; ++j) o[j] += hq * f[j];
                    if (q < 7) asm volatile("" : "+v"(RA[q + 1].x), "+v"(RA[q + 1].y), "+v"(RA[q + 1].z), "+v"(RA[q + 1].w) : "v"(o[15])); }
                asm volatile("" :: "v"(o[15]));
                PEER_ISSUE(RA, TV, sn, in, ST_ELO(in));
#pragma unroll
                for (int q = 0; q < 8; ++q) { const float hq = __shfl((q & 1) ? h1 : h0, (lane & ~7) | (4 + (q >> 1))); float f[16]; dec16(RB[q], f);
#pragma unroll
                    for (int j = 0; j < 16; ++j) o[j] += hq * f[j];
                    if (q < 7) asm volatile("" : "+v"(RB[q + 1].x), "+v"(RB[q + 1].y), "+v"(RB[q + 1].z), "+v"(RB[q + 1].w) : "v"(o[15])); }
                float o8[8], o4[4], o2[2];
#pragma unroll
                for (int q = 0; q < 8; ++q) { const float keep = (lane & 32) ? o[q + 8] : o[q], send = (lane & 32) ? o[q] : o[q + 8]; o8[q] = keep + __shfl_xor(send, 32); }
#pragma unroll
                for (int q = 0; q < 4; ++q) { const float keep = (lane & 16) ? o8[q + 4] : o8[q], send = (lane & 16) ? o8[q] : o8[q + 4]; o4[q] = keep + __shfl_xor(send, 16); }
#pragma unroll
                for (int q = 0; q < 2; ++q) { const float keep = (lane & 8) ? o4[q + 2] : o4[q], send = (lane & 8) ? o4[q] : o4[q + 2]; o2[q] = keep + __shfl_xor(send, 8); }
                xv.x += o2[0]; xv.y += o2[1];
                *(f32x2*)(X + (size_t)t * DM + col) = xv; *(unsigned*)(XB + (size_t)t * DM + col) = pk2(xv.x, xv.y); ST_SSQ(i) += xv.x * xv.x + xv.y * xv.y;
            }
        }
    }
#undef PEER_ISSUE
    float* RSS = (float*)(a.ws + WS_RSS);
    if (lastlayer) __threadfence();
    for (int i = 0; i < ntok; ++i) { const int t = gw + NGW * i; const float ss = wave_sum(ST_SSQ(i)); if (lane == 0) RSS[t] = ss;
        if (lastlayer) { const float* gf = a.in[7]; const float rstd = rsqrtf(ss * (1.0f / DM) + EPS); f32x4* xr = (f32x4*)(X + (size_t)t * DM) + lane;
#pragma unroll
            for (int j = 0; j < 4; ++j) { const f32x4 g = *((const f32x4*)gf + lane + 64 * j); f32x4 v = xr[64 * j]; v = v * rstd * g; xr[64 * j] = v; } } }
#undef ST_ELO
#undef ST_EHI
#undef ST_H0
#undef ST_H1
#undef ST_SSQ
}

constexpr int N_PHASES = 1 + 7 * DEPTH;
__global__ void __launch_bounds__(NTHREADS, 2) hybrid_fwd(Args args) {
    extern __shared__ __attribute__((aligned(16))) unsigned char lds_raw[];
    Frame F;
    F.lds = (ldsp_t)lds_raw;
    F.MISC = (volatile LAS unsigned*)(F.lds + MISC_OFF);
    F.tid = threadIdx.x; F.lane = F.tid & 63; F.wave = __builtin_amdgcn_readfirstlane(F.tid >> 6);
    F.G = gridDim.x; { const int bx = blockIdx.x; F.vcu = (F.G % 8 == 0) ? (bx % 8) * (F.G / 8) + bx / 8 : bx; }
    F.ctl = (unsigned*)(args.ws + WS_CTL); F.ws = args.ws; F.out = args.out;
    for (int u = F.tid; u < (LDS_BYTES - MISC_OFF) / 4; u += NTHREADS) ((LAS unsigned*)(F.lds + MISC_OFF))[u] = 0u;
    __syncthreads();
#if MK_N_LAUNCHES == 1
    constexpr int lo = 0, hi = N_PHASES;
#else
    const int lo = args.ph_lo, hi = args.ph_hi;
#endif
    if (PROBE_SEL && blockIdx.x == 0 && F.tid == 0) F.ctl[CW_TS + 130] = (unsigned)__builtin_amdgcn_s_memrealtime();
    XcdBarrier bar; bar.bar = F.ctl + CW_BAR; bar.x = 0; bar.st = nullptr;
    if (hi - lo > 1) bar = xcd_barrier_post(F.ctl + CW_BAR, F.MISC + 8);
#ifndef PH_MASK
#define PH_MASK (PROBE_SEL ? ((PROBE_SEL >= 32 && PROBE_SEL < 40) ? 0x717 : 0x73F) : 0x7FF)
#endif
#define IN(k) (lo <= (k) && (k) < hi)
#define PHM(b) ((PH_MASK >> (b)) & 1)
#define REPBAR() do { if (rep) xcd_barrier(bar); } while (0)
#define LAUNDER() do { asm volatile("" : "+v"(F.tid)); F.lane = F.tid & 63; F.wave = __builtin_amdgcn_readfirstlane(F.tid >> 6); } while (0)
constexpr int PROBE_A = PROBE_SEL == 99 ? -1 : PROBE_SEL == 16 ? 15 : PROBE_SEL >= 200 ? 64 + (PROBE_SEL - 200) : PROBE_SEL >= 100 ? (PROBE_SEL - 100) : PROBE_SEL >= 32 ? PROBE_SEL : PROBE_SEL == 1 ? 0 : PROBE_SEL - 1;
constexpr int PROBE_B = PROBE_SEL == 99 ? -1 : PROBE_SEL == 16 ? 130 : PROBE_SEL >= 200 ? (PROBE_SEL - 200) : PROBE_SEL >= 100 ? 64 + (PROBE_SEL - 101) : PROBE_SEL >= 32 ? 1 : PROBE_SEL == 1 ? 130 : PROBE_SEL - 2;
#define STAMP(k) do { if (PROBE_SEL && ((k) == PROBE_A || (k) == PROBE_B) && F.tid == 0) atomicMax(F.ctl + CW_TS + (k), (unsigned)__builtin_amdgcn_s_memrealtime()); } while (0)
#define SEAM(k) do { STAMP(k); if (IN(k) && IN((k) + 1)) xcd_barrier(bar); STAMP(64 + (k)); } while (0)
    unsigned char* ws = args.ws;
    bf16_t* P = (bf16_t*)(ws + WS_P); bf16_t* XB = (bf16_t*)(ws + WS_XB);

    for (int rep = 0; rep < REPS(0); ++rep) { REPBAR(); if (PHM(0) && IN(0)) { LAUNDER(); p0_prologue(args, F); } } SEAM(0);

    for (int l = 0; l < DEPTH; ++l) {
        const int pb = 1 + 7 * l;
        for (int rep = 0; rep < REPS(1); ++rep) { REPBAR();
        if (PHM(1) && IN(pb)) { LAUNDER();
            pg8::Gemm g{XB, (const bf16_t*)(ws + WS_WIN) + (size_t)l * NIN * DM, DM, DM, 0, 0};
            pg8::StaticOrder S; S.init(MTOT, NIN, F.G, (int)blockIdx.x, 1);
            pg8::EpiIn E{P, (const float*)(ws + WS_RSS), (const float*)(ws + WS_ROT)};
            pg8::gemm_phase<pg8::EpiIn, pg8::StaticOrder, true>(F.lds, g, S, E, F.tid);
        } }
        SEAM(pb);
        if (PHM(2) && IN(pb + 1)) { LAUNDER();
            for (int u = (int)blockIdx.x; u < 192; u += F.G) {
                LAUNDER();
                if (u < 64) { if (PHM(8)) ret_prompt_unit(args, F, l, u >> 3, u & 7); if (l == 0) STAMP(32); }
                else { if (PHM(9)) rnn_unit(args, F, l, false, (u - 64) >> 4, (u - 64) & 15); if (l == 0) STAMP(33); }
            }
            unsigned* qh = F.ctl + CW_QUEUE + 64 * l;
            for (;;) {
                __syncthreads();
                if (F.tid == 0) F.MISC[0] = xb_add(qh, 1u);
                __syncthreads();
                const unsigned q = F.MISC[0];
                LAUNDER();
                if (PROBE_SEL && l == 0 && q >= 1152u && q < 1152u + 256u) STAMP(34);
                if (q >= 1024u + 128u + 256u) break;
                if (q < 1024u) { if (PHM(10)) ret_sample_unit(args, F, l, (int)(q >> 3), (int)(q & 7)); }
                else if (q < 1152u) { if (PHM(9)) rnn_unit(args, F, l, true, (int)((q - 1024u) >> 4), (int)((q - 1024u) & 15)); }
                else tab_unit(args, F, l, (int)(q - 1152u));
            }
        }
        SEAM(pb + 1);
        for (int rep = 0; rep < REPS(3); ++rep) { REPBAR();
        if (PHM(3) && IN(pb + 2)) { LAUNDER();
            pg8::Gemm g{(const bf16_t*)(ws + WS_ARET), (const bf16_t*)(ws + WS_WMIX + (size_t)l * 6 * MiB), DM, DM, (size_t)(WS_ARNN - WS_ARET), (size_t)(2 * MiB)};
            pg8::StaticOrder S; S.init(MTOT, DM, F.G, (int)blockIdx.x, 2);
            pg8::EpiMerge E{P, (bf16_t*)(ws + WS_MRG)};
            pg8::gemm_phase<pg8::EpiMerge, pg8::StaticOrder, true>(F.lds, g, S, E, F.tid);
        } }
        SEAM(pb + 2);
        if (PHM(4) && IN(pb + 3)) { LAUNDER();
            pg8::Gemm g{(const bf16_t*)(ws + WS_MRG), (const bf16_t*)(ws + WS_WMIX + (size_t)l * 6 * MiB + 4 * MiB), DM, DM, 0, 0};
            pg8::StaticOrder S; S.init(MTOT, DM, F.G, (int)blockIdx.x, 1);
            pg8::EpiWo E{l == 0 ? args.in[0] : args.out, l == 0 ? args.in[1] : args.out + (size_t)M_P * DM, args.out, XB, (float*)(ws + WS_RSSP)};
            pg8::gemm_phase<pg8::EpiWo, pg8::StaticOrder, true>(F.lds, g, S, E, F.tid);
        }
        SEAM(pb + 3);
        for (int rep = 0; rep < REPS(5); ++rep) { REPBAR();
        if (PHM(5) && IN(pb + 4)) { LAUNDER();
            pg8::Gemm g{XB, (const bf16_t*)(ws + WS_WQ) + (size_t)l * 2048 * DM, DM, DM, 0, 0};
            pg8::StaticOrder S; S.init(MTOT, 2048, F.G, (int)blockIdx.x, 1);
            pg8::EpiQ E{P, (const float*)(ws + WS_RSSP), (float*)(ws + WS_RSS2)};
            pg8::gemm_phase<pg8::EpiQ, pg8::StaticOrder, true>(F.lds, g, S, E, F.tid);
        } }
        SEAM(pb + 4);
        for (int rep = 0; rep < 1; ++rep) {
        if (PHM(6) && IN(pb + 5)) { LAUNDER();
            const int gw = F.vcu * NWAVES + F.wave, NGW = F.G * NWAVES;
            for (int u = gw; u < (MTOT / 32) * PH; u += NGW) { for (int rr = 0; rr < REPS(6); ++rr) { int ln = F.lane; asm volatile("" : "+v"(ln)); route_unit(args, l, u >> 3, u & 7, ln); } }
        } }
        SEAM(pb + 5);
        if (PHM(7) && IN(pb + 6)) { LAUNDER(); peer_phase(args, F, l, l == DEPTH - 1); }
        if (l + 1 < DEPTH) SEAM(pb + 6); else STAMP(pb + 6);
    }
    if (PROBE_SEL) {
        STAMP(15);
        if (PROBE_A == 15 || PROBE_A == 14 || PROBE_A == 78) xcd_barrier(bar);
        if (blockIdx.x == 0) {
            const unsigned* ts = F.ctl + CW_TS;
            unsigned ta, tb;
            if (PROBE_SEL == 99) { ta = 10000u; tb = 0u; }
            else { ta = __hip_atomic_load(ts + (PROBE_A < 0 ? 0 : PROBE_A), RLX_AGENT); tb = __hip_atomic_load(ts + (PROBE_B < 0 ? 0 : PROBE_B), RLX_AGENT); if (PROBE_SEL == 16) ta = tb + (ta - tb) / 16u; }
            const float dl = sqrtf((float)(ta - tb)) * 1e-2f;
            for (int i = F.tid; i < DEPTH * NBATCH * DM; i += NTHREADS) args.out[O_SHP + i] += dl;
        }
    }
#undef IN
#undef SEAM
}

extern "C" void kernel_launch(void* const* d_in, const int* in_sizes, int n_in, void* d_out, int out_size, void* d_ws, size_t ws_size, hipStream_t stream) {
    static int grid = 0;
    if (grid == 0) {
        if (n_in != 24 || out_size != (int)O_END || ws_size < WS_END) { fprintf(stderr, "kernel_launch: unexpected shapes (n_in %d, out %d, ws %zu)\n", n_in, out_size, ws_size); grid = -1; return; }
        int dev = 0, cus = 0, per_cu = 0;
        if (hipGetDevice(&dev) != hipSuccess || hipDeviceGetAttribute(&cus, hipDeviceAttributeMultiprocessorCount, dev) != hipSuccess) { grid = -1; return; }
        if (hipFuncSetAttribute((const void*)hybrid_fwd, hipFuncAttributeMaxDynamicSharedMemorySize, LDS_BYTES) != hipSuccess) { fprintf(stderr, "kernel_launch: hipFuncSetAttribute failed\n"); grid = -1; return; }
        if (hipOccupancyMaxActiveBlocksPerMultiprocessor(&per_cu, (const void*)hybrid_fwd, NTHREADS, LDS_BYTES) != hipSuccess || per_cu < 1) { fprintf(stderr, "kernel_launch: occupancy query reports %d blocks per CU\n", per_cu); (void)hipGetLastError(); grid = -1; return; }
        grid = cus;
        if (grid != 256) fprintf(stderr, "kernel_launch: %d CUs; the PEER phase assumes 256 workgroups\n", grid);
    }
    if (grid < 0) return;
    (void)hipMemsetAsync((char*)d_ws + WS_CTL, 0, CTL_ZERO_BYTES, stream);
    Args a{};
    for (int i = 0; i < 24; ++i) a.in[i] = (const float*)d_in[i];
    a.out = (float*)d_out; a.ws = (unsigned char*)d_ws;
#if MK_N_LAUNCHES == 1
    a.ph_lo = 0; a.ph_hi = N_PHASES;
    void* kargs[] = {&a};
    hipError_t e = hipLaunchCooperativeKernel((const void*)hybrid_fwd, dim3(grid), dim3(NTHREADS), kargs, LDS_BYTES, stream);
    if (e != hipSuccess) fprintf(stderr, "kernel_launch: cooperative launch failed: %s (grid %d)\n", hipGetErrorString(e), grid);
#else
    for (int p = 0; p < N_PHASES; ++p) { a.ph_lo = p; a.ph_hi = p + 1; hipLaunchKernelGGL(hybrid_fwd, dim3(grid), dim3(NTHREADS), LDS_BYTES, stream, a); }
#endif
}
```

```cpp
#include <hip/hip_runtime.h>
#include <cstdio>
#include <cstdint>

#define LAS __attribute__((address_space(3)))
#define GAS __attribute__((address_space(1)))
typedef unsigned short bf16_t;
typedef short bf16x8 __attribute__((ext_vector_type(8)));
typedef float f32x2 __attribute__((ext_vector_type(2)));
typedef float f32x4 __attribute__((ext_vector_type(4)));
typedef float f32x16 __attribute__((ext_vector_type(16)));
typedef unsigned u32x2 __attribute__((ext_vector_type(2)));
typedef unsigned u32x4 __attribute__((ext_vector_type(4)));
typedef LAS unsigned char* ldsp_t;

#ifndef REP_MASK
#define REP_MASK 0
#endif
#define REPS(k) (((REP_MASK >> (k)) & 1) ? 2 : 1)
#ifndef PROBE_SEL
#define PROBE_SEL 0
#endif
#ifndef MK_N_LAUNCHES
#define MK_N_LAUNCHES 1
#endif

constexpr int DM = 1024, NIN = 7168, M_P = 16384, M_S = 1024, MTOT = 17408, DEPTH = 2;
constexpr int SEQ = 2048, NBATCH = 8, DECB = 128, DECT = 8, PAST = 16384;
constexpr int HR = 8, DK = 64, DV = 128, CH = 128;
constexpr int NBLK = 16, BS = 64;
constexpr int PH = 8, NKEY = 128, NEXP = 16384, TOPK = 16, HK = 128;
constexpr float EPS = 1e-6f;
constexpr int LDP = 7168;
constexpr int PC_Q = 0, PC_K = 512, PC_V = 1024, PC_GR = 2048, PC_XR = 3072, PC_GN = 4096, PC_GA = 5120, PC_GB = 6144;
constexpr int PC_MRG = 0, PC_ARET = 1024, PC_ARNN = 4096, PC_QP = 2048;

constexpr size_t MiB = 1u << 20;
constexpr size_t WS_CTL = 0, CTL_ZERO_BYTES = 1 * MiB;
constexpr size_t WS_ROT = 1 * MiB;
constexpr size_t WS_RSS = 2 * MiB;
constexpr size_t WS_RSS2 = 2 * MiB + 128 * 1024;
constexpr size_t WS_RSSP = 2 * MiB + 256 * 1024;
constexpr size_t WS_TSC = 3 * MiB + 512 * 1024;
constexpr size_t WS_EIDX = 4 * MiB;
constexpr size_t WS_GATE = 13 * MiB;
constexpr size_t WS_KEYS = 22 * MiB;
constexpr size_t WS_WG = 23 * MiB;
constexpr size_t WS_WIN = 24 * MiB;
constexpr size_t WS_WMIX = 52 * MiB;
constexpr size_t WS_WQ = 64 * MiB;
constexpr size_t WS_XB = 72 * MiB;
constexpr size_t WS_P = 106 * MiB;
constexpr size_t WS_TAB = 344 * MiB;
constexpr size_t WS_ARET = 408 * MiB, WS_ARNN = 442 * MiB, WS_MRG = 476 * MiB;
constexpr size_t WS_END = 510 * MiB;
static_assert(WS_P + (size_t)MTOT * LDP * 2 <= WS_TAB, "ws map");

constexpr size_t O_Y = 0, O_SRP = 17825792, O_SHP = 18874368, O_SCP = 18890752, O_SRS = 18939904, O_SHS = 35717120, O_SCS = 35979264, O_END = 36765696;

constexpr int CW_BAR = 4096;
constexpr int CW_QUEUE = 16384;
constexpr int CW_TS = 20480;

constexpr int RING_BYTES = 131072;
constexpr int LDS_BYTES = 155648;
constexpr int MISC_OFF = 153600;
constexpr int NWAVES = 8, NTHREADS = 512;

#define LDS_WAIT() asm volatile("s_waitcnt lgkmcnt(0)" ::: "memory")
#define VM_WAIT() asm volatile("s_waitcnt vmcnt(0)" ::: "memory")
#define LBAR() do { asm volatile("s_waitcnt lgkmcnt(0)" ::: "memory"); __builtin_amdgcn_s_barrier(); asm volatile("" ::: "memory"); } while (0)
#define RLX_AGENT __ATOMIC_RELAXED, __HIP_MEMORY_SCOPE_AGENT

__device__ __forceinline__ unsigned f2bf(float f) { unsigned u = __builtin_bit_cast(unsigned, f); return (u + 0x7fffu + ((u >> 16) & 1u)) >> 16; }
typedef __bf16 bf16x2_t __attribute__((ext_vector_type(2)));
__device__ __forceinline__ unsigned pk2(float lo, float hi) { const f32x2 v = {lo, hi}; const bf16x2_t b = __builtin_convertvector(v, bf16x2_t); return __builtin_bit_cast(unsigned, b); }
__device__ __forceinline__ float bflo(unsigned w) { return __builtin_bit_cast(float, w << 16); }
__device__ __forceinline__ float bfhi(unsigned w) { return __builtin_bit_cast(float, w & 0xffff0000u); }
__device__ __forceinline__ float bf1(bf16_t h) { return __builtin_bit_cast(float, (unsigned)h << 16); }
__device__ __forceinline__ float sigmoidf_(float x) { return __builtin_amdgcn_rcpf(1.0f + __expf(-x)); }
__device__ __forceinline__ float siluf_(float x) { return x * sigmoidf_(x); }
__device__ __forceinline__ float geluf_(float x) { return x * sigmoidf_(1.5957691216057308f * (x + 0.044715f * x * x * x)); }
__device__ __forceinline__ float logg_of(int h) { return log1pf(-exp2f((float)(-5 - h))); }

namespace pg8 {
constexpr int BM = 256, BK = 64, HALF = 128, HTB = HALF * BK * 2, STAGE_BYTES = 8 * HTB, NXCD = 8, WGM = 8;
__host__ __device__ __forceinline__ int lds_byte(int r, int c) { const int st = (r >> 4) * 2 + (c >> 5), rr = r & 15, cc = c & 31, ob = rr * 64 + cc * 2; return st * 1024 + (ob ^ (((ob >> 9) & 1) << 5)); }
__host__ __device__ __forceinline__ void stage_rc(int b, int& R, int& C) { const int st = b / 1024, sb = b % 1024, swz = sb ^ (((sb >> 9) & 1) << 5); R = (st >> 1) * 16 + swz / 64; C = (st & 1) * 32 + (swz % 64) / 2; }
__host__ __device__ __forceinline__ int perm32(int rho) { const int n = rho >> 4, i = rho & 15; return 8 * (i >> 2) + 4 * n + (i & 3); }

struct Unit { int pm, pn, half; };
struct Gemm { const bf16_t* A; const bf16_t* Bt; int lda, K; size_t aoff2, boff2; };

struct StaticOrder {
    int nM, nN, nwg, G, c, pairs;
    __device__ void init(int M, int N, int G_, int c_, int pairs_) { nM = M / BM; nN = N / BM; nwg = nM * nN; G = G_; c = c_; pairs = pairs_; }
    __device__ bool next(int i, Unit& u) const {
        const int it = (pairs == 2) ? (i >> 1) : i;
        const long L = (long)it * G + c; if (L >= nwg) return false;
        int wgid = (int)L; { const int q = nwg / NXCD, r = nwg % NXCD, xcd = wgid % NXCD, off = wgid / NXCD; wgid = (xcd < r ? xcd * (q + 1) : r * (q + 1) + (xcd - r) * q) + off; }
        const int nig = WGM * nN, gid = wgid / nig, fm = gid * WGM, gsz = (nM - fm) < WGM ? (nM - fm) : WGM;
        u.pm = fm + ((wgid % nig) % gsz); u.pn = (wgid % nig) / gsz; u.half = (pairs == 2) ? (i & 1) : 0; return true;
    }
};

template <class Epi, class Sched, bool ALIGN_EPI>
__device__ __forceinline__ void gemm_phase(ldsp_t lds, const Gemm g, const Sched& S, const Epi& E, const int tid) {
    const int wid = __builtin_amdgcn_readfirstlane(tid >> 6), lane = tid & 63, wr = wid >> 2, wc = wid & 3, fr = lane & 15, fq = lane >> 4;
    const int K = g.K, nt = K / BK;
    unsigned voffA[2], voffB[2];
#pragma unroll
    for (int i = 0; i < 2; ++i) { int R, C; stage_rc(tid * 16 + i * 8192, R, C); const int Rb = Epi::PERM ? ((R & ~31) + perm32(R & 31)) : R;
        voffA[i] = (unsigned)(R * g.lda + C) * 2u; voffB[i] = (unsigned)(Rb * K + C) * 2u; }
    const size_t kstep = (size_t)(BK * 2);
    const size_t hstepA = (size_t)HALF * g.lda * 2, hstepB = (size_t)HALF * K * 2;
    const size_t tstepA = 2 * hstepA, tstepB = 2 * hstepB;
    const unsigned ldsw = (unsigned)wid * 1024u;
    const int aoff = lds_byte(wr * 64 + fr, fq * 8), boff = lds_byte(wc * 32 + fr, fq * 8);
#define PG8_SA(b, h) (((b) * 2 + (h)) * HTB)
#define PG8_SB(b, h) ((4 + (b) * 2 + (h)) * HTB)
#define PG8_STAGE(bufoff, gbase, voff) do { _Pragma("unroll") for (int _i = 0; _i < 2; ++_i) \
        __builtin_amdgcn_global_load_lds((const unsigned*)((const char*)(gbase) + (voff)[_i]), (LAS unsigned*)(lds + (bufoff) + ldsw + _i * 8192), 16, 0, 0); } while (0)
#define PG8_LDA(dst, b, h) do { _Pragma("unroll") for (int m = 0; m < 4; ++m) _Pragma("unroll") for (int k = 0; k < 2; ++k) dst[m][k] = *(const LAS bf16x8*)(lds + PG8_SA(b, h) + aoff + m * 2048 + k * 1024); } while (0)
#define PG8_LDB(dst, b, h) do { _Pragma("unroll") for (int n = 0; n < 2; ++n) _Pragma("unroll") for (int k = 0; k < 2; ++k) dst[n][k] = *(const LAS bf16x8*)(lds + PG8_SB(b, h) + boff + n * 2048 + k * 1024); } while (0)
#define PG8_MMA(ai, bj, At, Bt) do { __builtin_amdgcn_s_setprio(1); _Pragma("unroll") for (int m = 0; m < 4; ++m) _Pragma("unroll") for (int n = 0; n < 2; ++n) _Pragma("unroll") for (int k = 0; k < 2; ++k) \
        acc[ai][bj][m][n] = __builtin_amdgcn_mfma_f32_16x16x32_bf16(Bt[n][k], At[m][k], acc[ai][bj][m][n], 0, 0, 0); __builtin_amdgcn_s_setprio(0); } while (0)
#define PG8_WAIT_V(n) asm volatile("s_waitcnt vmcnt(" #n ")" ::: "memory")
#define PG8_WAIT_L(n) asm volatile("s_waitcnt lgkmcnt(" #n ")" ::: "memory")
#define PG8_BAR __builtin_amdgcn_s_barrier()
#define PG8_SCHED __builtin_amdgcn_sched_barrier(0)
    Unit cur, nxt; int ui = 0;
    if (!S.next(0, cur)) return;
    f32x4 acc[2][2][4][2];
#pragma unroll
    for (int a = 0; a < 2; ++a)
#pragma unroll
        for (int b = 0; b < 2; ++b)
#pragma unroll
            for (int m = 0; m < 4; ++m)
#pragma unroll
                for (int n = 0; n < 2; ++n) acc[a][b][m][n] = (f32x4){0.f, 0.f, 0.f, 0.f};
    bf16x8 At[4][2], B0[2][2], B1[2][2];
    const char* cA = (const char*)g.A + (size_t)cur.pm * tstepA + (cur.half ? g.aoff2 : 0); const char* cB = (const char*)g.Bt + (size_t)cur.pn * tstepB + (cur.half ? g.boff2 : 0);
    PG8_STAGE(PG8_SB(0, 0), cB, voffB); PG8_STAGE(PG8_SB(0, 1), cB + hstepB, voffB); PG8_STAGE(PG8_SA(0, 0), cA, voffA); PG8_STAGE(PG8_SA(0, 1), cA + hstepA, voffA);
    if (wr == 1) PG8_BAR;
    PG8_WAIT_V(2); PG8_BAR;
    PG8_STAGE(PG8_SB(1, 0), cB + kstep, voffB); PG8_STAGE(PG8_SA(1, 0), cA + kstep, voffA); PG8_STAGE(PG8_SB(1, 1), cB + hstepB + kstep, voffB);
    PG8_WAIT_V(6); PG8_BAR;
    for (;;) {
        const bool has_next = S.next(ui + 1, nxt);
        const char* nA = has_next ? (const char*)g.A + (size_t)nxt.pm * tstepA + (nxt.half ? g.aoff2 : 0) : cA;
        const char* nB = has_next ? (const char*)g.Bt + (size_t)nxt.pn * tstepB + (nxt.half ? g.boff2 : 0) : cB;
        for (int t = 0; t < nt; t += 2) {
            const bool last = (t == nt - 2);
            const char* a1 = cA + (size_t)(t + 1) * kstep;
            const char* a2 = last ? nA : cA + (size_t)(t + 2) * kstep; const char* b2 = last ? nB : cB + (size_t)(t + 2) * kstep;
            const char* a3 = a2 + kstep; const char* b3 = b2 + kstep;
            PG8_LDB(B0, 0, 0); PG8_LDB(B1, 0, 1); PG8_SCHED; PG8_LDA(At, 0, 0); PG8_STAGE(PG8_SA(1, 1), a1 + hstepA, voffA);
            PG8_WAIT_V(8); PG8_WAIT_L(0); PG8_BAR; PG8_MMA(0, 0, At, B0); PG8_MMA(0, 1, At, B1); PG8_BAR; PG8_SCHED;
            PG8_LDA(At, 0, 1); PG8_STAGE(PG8_SB(0, 0), b2, voffB); PG8_STAGE(PG8_SB(0, 1), b2 + hstepB, voffB); PG8_STAGE(PG8_SA(0, 0), a2, voffA);
            PG8_WAIT_V(8); PG8_WAIT_L(0); PG8_BAR; PG8_MMA(1, 0, At, B0); PG8_MMA(1, 1, At, B1); PG8_BAR; PG8_SCHED;
            PG8_LDB(B0, 1, 0); PG8_LDB(B1, 1, 1); PG8_SCHED; PG8_LDA(At, 1, 0); PG8_STAGE(PG8_SA(0, 1), a2 + hstepA, voffA);
            PG8_WAIT_V(8); PG8_WAIT_L(0); PG8_BAR; PG8_MMA(0, 0, At, B0); PG8_MMA(0, 1, At, B1); PG8_BAR; PG8_SCHED;
            PG8_LDA(At, 1, 1); PG8_STAGE(PG8_SB(1, 0), b3, voffB); PG8_STAGE(PG8_SB(1, 1), b3 + hstepB, voffB); PG8_STAGE(PG8_SA(1, 0), a3, voffA);
            PG8_WAIT_V(8); PG8_WAIT_L(0); PG8_BAR; PG8_MMA(1, 0, At, B0); PG8_MMA(1, 1, At, B1); PG8_BAR; PG8_SCHED;
        }
        if constexpr (ALIGN_EPI) { if (wr == 0) PG8_BAR; }
        E(acc, cur, wr, wc, fr, fq);
        if (!has_next) break;
#pragma unroll
        for (int a = 0; a < 2; ++a)
#pragma unroll
            for (int b = 0; b < 2; ++b)
#pragma unroll
                for (int m = 0; m < 4; ++m)
#pragma unroll
                    for (int n = 0; n < 2; ++n) acc[a][b][m][n] = (f32x4){0.f, 0.f, 0.f, 0.f};
        cur = nxt; cA = nA; cB = nB; ++ui;
        if constexpr (ALIGN_EPI) { if (wr == 1) PG8_BAR; }
    }
    PG8_WAIT_V(0);
    if constexpr (!ALIGN_EPI) { if (wr == 0) PG8_BAR; }
    PG8_BAR;
#undef PG8_SA
#undef PG8_SB
#undef PG8_STAGE
#undef PG8_LDA
#undef PG8_LDB
#undef PG8_MMA
#undef PG8_WAIT_V
#undef PG8_WAIT_L
#undef PG8_BAR
#undef PG8_SCHED
}
}

typedef GAS unsigned gu32;
#define XB_TMO      128
#define XB_XCNT(j)  (256  + 64 * (j))
#define XB_XSUB(j)  (1280 + 64 * (j))
#define XB_XGEN(j)  (2304 + 64 * (j))
#define XB_TOP      3328
#define XB_TOPGEN   3392
#define XCD_BAR_WORDS 3456
#define XB_SPIN_CAP (1u << 18)
__device__ __forceinline__ unsigned xb_ld(unsigned* p)              { return __hip_atomic_load(p, __ATOMIC_RELAXED, __HIP_MEMORY_SCOPE_AGENT); }
__device__ __forceinline__ unsigned xb_add(unsigned* p, unsigned v) { return __hip_atomic_fetch_add(p, v, __ATOMIC_RELAXED, __HIP_MEMORY_SCOPE_AGENT); }
__device__ __forceinline__ unsigned xb_xcc_id() { return (unsigned)__builtin_amdgcn_s_getreg((3 << 11) | 20) & 0xFu; }
#define XB_SPIN(cond, bar) do { unsigned _sp = 0; while (cond) { __builtin_amdgcn_s_sleep(1); \
    if ((++_sp & 255u) == 0u) { if (xb_ld(&(bar)[XB_TMO])) break; if (_sp > XB_SPIN_CAP) { atomicAdd(&(bar)[XB_TMO], 1u); break; } } } } while (0)
struct XcdBarrier { unsigned* bar; unsigned x; volatile LAS unsigned* st; };
__device__ __forceinline__ XcdBarrier xcd_barrier_post(unsigned* bar, volatile LAS unsigned* st) {
    XcdBarrier b; b.bar = bar; b.x = (unsigned)__builtin_amdgcn_readfirstlane((int)xb_xcc_id()); b.st = st;
    if (threadIdx.x == 0) (void)xb_add(&bar[XB_XCNT(b.x)], 1u);
    return b;
}
__device__ __forceinline__ void xcd_barrier_complete(unsigned* bar, unsigned x, unsigned& nloc, unsigned& nx) {
    const unsigned G = gridDim.x * gridDim.y * gridDim.z;
    unsigned sum, cnt, mine, sp = 0u;
    for (;;) {
        sum = 0u; cnt = 0u; mine = 0u;
#pragma unroll
        for (unsigned j = 0; j < 16; ++j) { const unsigned c = xb_ld(&bar[XB_XCNT(j)]); sum += c; cnt += (c > 0u) ? 1u : 0u; mine = (j == x) ? c : mine; }
        if (sum == G) break;
        __builtin_amdgcn_s_sleep(1);
        if ((++sp & 255u) == 0u) { if (xb_ld(&bar[XB_TMO])) break; if (sp > XB_SPIN_CAP) { atomicAdd(&bar[XB_TMO], 1u); break; } }
    }
    nloc = mine > 0u ? mine : 1u; nx = cnt > 0u ? cnt : 1u;
}
__device__ __forceinline__ void xcd_barrier(const XcdBarrier& b) {
    asm volatile("s_waitcnt vmcnt(0)" ::: "memory");
    __syncthreads();
    if (threadIdx.x == 0) {
        unsigned* bar = b.bar; const unsigned bx = (unsigned)__builtin_amdgcn_readfirstlane((int)b.x);
        __builtin_amdgcn_s_waitcnt(0);
        unsigned nloc = b.st[0], nx = b.st[1];
        if (nloc == 0u) { xcd_barrier_complete(bar, bx, nloc, nx); b.st[0] = nloc; b.st[1] = nx; }
        const unsigned old = xb_add(&bar[XB_XSUB(bx)], 1u);
        const unsigned gen = old / nloc;
        if (old + 1u == (gen + 1u) * nloc) {
            __builtin_amdgcn_fence(__ATOMIC_RELEASE, "agent");
            asm volatile("s_waitcnt vmcnt(0)" ::: "memory");
            const unsigned og = xb_add(&bar[XB_TOP], 1u);
            const unsigned tg = og / nx;
            if (og + 1u == (tg + 1u) * nx) xb_add(&bar[XB_TOPGEN], 1u);
            else XB_SPIN(xb_ld(&bar[XB_TOPGEN]) == tg, bar);
            __builtin_amdgcn_fence(__ATOMIC_ACQUIRE, "agent");
            xb_add(&bar[XB_XGEN(bx)], 1u);
            asm volatile("s_waitcnt vmcnt(0)" ::: "memory");
        } else {
            XB_SPIN(xb_ld(&bar[XB_XGEN(bx)]) == gen, bar);
            __builtin_amdgcn_fence(__ATOMIC_ACQUIRE, "agent");
            asm volatile("s_waitcnt vmcnt(0)" ::: "memory");
        }
    }
    __syncthreads();
}

struct Frame {
    ldsp_t lds;
    volatile LAS unsigned* MISC;
    unsigned* ctl;
    int tid, lane, wave, vcu, G;
    const float* const* in;
    unsigned char* ws;
    float* out;
};
struct Args { const float* in[24]; float* out; unsigned char* ws; int ph_lo, ph_hi; };

__device__ __forceinline__ float wave_sum(float v) {
#pragma unroll
    for (int o = 1; o < 64; o <<= 1) v += __shfl_xor(v, o);
    return v;
}

__device__ __forceinline__ void p0_transpose_item(const float* W, int K, int N, bf16_t* WT, int ldk, const float* rowscale, float colscale, bool qkperm, LAS float* scr, int item, int lane) {
    const int nblk = N / 32, kb = item / nblk, nb = item % nblk, k0 = 64 * kb, n0 = 32 * nb;
    int srcn = n0 + (lane & 31);
    if (qkperm) { const int p = srcn & 63; srcn = (srcn & ~63) + ((p & 1) ? 32 + (p >> 1) : (p >> 1)); }
#pragma unroll 16
    for (int i = 0; i < 32; ++i) { const int kk = 2 * i + (lane >> 5); float v = W[(size_t)(k0 + kk) * N + srcn] * colscale; if (rowscale) v *= rowscale[k0 + kk]; scr[kk * 33 + (lane & 31)] = v; }
    LDS_WAIT(); asm volatile("" ::: "memory");
    const int c = lane & 7;
#pragma unroll
    for (int j = 0; j < 4; ++j) { const int n = (lane >> 3) + 8 * j; const LAS float* s = scr + (8 * c) * 33 + n;
        u32x4 o; o.x = pk2(s[0 * 33], s[1 * 33]); o.y = pk2(s[2 * 33], s[3 * 33]); o.z = pk2(s[4 * 33], s[5 * 33]); o.w = pk2(s[6 * 33], s[7 * 33]);
        *(u32x4*)(WT + (size_t)(n0 + n) * ldk + k0 + 8 * c) = o; }
    LDS_WAIT(); asm volatile("" ::: "memory");
}

__device__ __forceinline__ void p0_xrow(const float* xrow, bf16_t* orow, float* rss, int lane) {
    const f32x4* xr = (const f32x4*)xrow + lane;
    f32x4 v[4]; float s = 0.f;
#pragma unroll
    for (int j = 0; j < 4; ++j) { v[j] = xr[64 * j]; s += (v[j].x * v[j].x + v[j].y * v[j].y) + (v[j].z * v[j].z + v[j].w * v[j].w); }
    s = wave_sum(s);
    u32x2* o8 = (u32x2*)orow + lane;
#pragma unroll
    for (int j = 0; j < 4; ++j) { u32x2 w; w.x = pk2(v[j].x, v[j].y); w.y = pk2(v[j].z, v[j].w); o8[64 * j] = w; }
    if (lane == 0) *rss = s;
}

__device__ __forceinline__ void p0_tabrow(const float* row, unsigned char* img, float* isc, int e, int lane) {
    const f32x4* xr = (const f32x4*)row + lane;
    f32x4 v[4]; float am = 0.f;
#pragma unroll
    for (int j = 0; j < 4; ++j) { v[j] = xr[64 * j]; am = fmaxf(am, fmaxf(fmaxf(fabsf(v[j].x), fabsf(v[j].y)), fmaxf(fabsf(v[j].z), fabsf(v[j].w)))); }
#pragma unroll
    for (int o = 1; o < 64; o <<= 1) am = fmaxf(am, __shfl_xor(am, o));
    const float sc = am > 0.f ? exp2f(floorf(log2f(224.0f / am))) : 1.0f;
#pragma unroll
    for (int j = 0; j < 4; ++j) { const int col = 256 * j + 4 * lane, sl = col >> 7, w = col & 127;
        int pk = __builtin_amdgcn_cvt_pk_fp8_f32(v[j].x * sc, v[j].y * sc, 0, false);
        pk = __builtin_amdgcn_cvt_pk_fp8_f32(v[j].z * sc, v[j].w * sc, pk, true);
        *(int*)(img + ((size_t)sl * NEXP + e) * 128 + w) = pk; }
    if (lane == 0) isc[e] = 1.0f / sc;
}

__device__ __forceinline__ void p0_prologue(const Args& a, Frame& F) {
    unsigned char* ws = a.ws;
    LAS float* scr = (LAS float*)(F.lds + F.wave * 16384);
    const int gw = F.vcu * NWAVES + F.wave, NGW = F.G * NWAVES, lane = F.lane;
    constexpr int I_IN = (DM / 64) * (NIN / 32), I_SQ = (DM / 64) * (DM / 32), I_Q = (DM / 64) * (2048 / 32), I_G = 2;
    constexpr int PER_L = I_IN + 3 * I_SQ + I_Q + 32 * I_G;
    for (int it = gw; it < DEPTH * PER_L; it += NGW) {
        const int l = it / PER_L; int r = it % PER_L;
        if (r < I_IN) { const int nb = r % (NIN / 32), n0 = nb * 32; const int seg = n0 >> 9;
            p0_transpose_item(a.in[8] + (size_t)l * DM * NIN, DM, NIN, (bf16_t*)(ws + WS_WIN) + (size_t)l * NIN * DM, DM, a.in[5] + l * DM, seg == 1 ? 0.125f : 1.0f, seg <= 1, scr, r, lane); continue; }
        r -= I_IN;
        if (r < I_SQ) { p0_transpose_item(a.in[10] + (size_t)l * DM * DM, DM, DM, (bf16_t*)(ws + WS_WMIX + (size_t)l * 6 * MiB), DM, a.in[9] + l * DM, 1.0f, false, scr, r, lane); continue; }
        r -= I_SQ;
        if (r < I_SQ) { p0_transpose_item(a.in[18] + (size_t)l * DM * DM, DM, DM, (bf16_t*)(ws + WS_WMIX + (size_t)l * 6 * MiB + 2 * MiB), DM, nullptr, 1.0f, false, scr, r, lane); continue; }
        r -= I_SQ;
        if (r < I_SQ) { p0_transpose_item(a.in[19] + (size_t)l * DM * DM, DM, DM, (bf16_t*)(ws + WS_WMIX + (size_t)l * 6 * MiB + 4 * MiB), DM, nullptr, 1.0f, false, scr, r, lane); continue; }
        r -= I_SQ;
        if (r < I_Q) { p0_transpose_item(a.in[20] + (size_t)l * DM * 2048, DM, 2048, (bf16_t*)(ws + WS_WQ) + (size_t)l * 2048 * DM, DM, a.in[6] + l * DM, 1.0f, false, scr, r, lane); continue; }
        r -= I_Q;
        { const int mat = r >> 1, sub = r & 1, nb = mat >> 1, gsel = mat & 1;
          const float* W = (gsel ? a.in[15] : a.in[13]) + ((size_t)l * NBLK + nb) * BS * BS;
          bf16_t* WT = (bf16_t*)(ws + WS_WG) + (((size_t)l * NBLK + nb) * 2 + gsel) * BS * BS;
          p0_transpose_item(W, BS, BS, WT, BS, nullptr, 1.0f, false, scr, sub, lane); }
    }
    { const float* ksrc = a.in[21]; bf16_t* kdst = (bf16_t*)(ws + WS_KEYS); const int n4 = DEPTH * PH * 2 * NKEY * HK / 4;
      for (int i = gw * 64 + lane; i < n4; i += NGW * 64) { const f32x4 v = ((const f32x4*)ksrc)[i]; u32x2 o; o.x = pk2(v.x, v.y); o.y = pk2(v.z, v.w); ((u32x2*)kdst)[i] = o; } }
    for (int m = gw; m < MTOT; m += 2 * NGW) {
        const int m2 = m + NGW; const bool v2 = m2 < MTOT; const int mm2 = v2 ? m2 : m;
        const f32x4* x1 = (const f32x4*)(m < M_P ? a.in[0] + (size_t)m * DM : a.in[1] + (size_t)(m - M_P) * DM) + lane;
        const f32x4* x2 = (const f32x4*)(mm2 < M_P ? a.in[0] + (size_t)mm2 * DM : a.in[1] + (size_t)(mm2 - M_P) * DM) + lane;
        f32x4 v[8]; float s1 = 0.f, s2 = 0.f;
#pragma unroll
        for (int j = 0; j < 4; ++j) { v[j] = x1[64 * j]; v[4 + j] = x2[64 * j]; }
#pragma unroll
        for (int j = 0; j < 4; ++j) { s1 += (v[j].x * v[j].x + v[j].y * v[j].y) + (v[j].z * v[j].z + v[j].w * v[j].w); s2 += (v[4 + j].x * v[4 + j].x + v[4 + j].y * v[4 + j].y) + (v[4 + j].z * v[4 + j].z + v[4 + j].w * v[4 + j].w); }
        s1 = wave_sum(s1); s2 = wave_sum(s2);
        u32x2* o1 = (u32x2*)((bf16_t*)(ws + WS_XB) + (size_t)m * DM) + lane; u32x2* o2 = (u32x2*)((bf16_t*)(ws + WS_XB) + (size_t)mm2 * DM) + lane;
#pragma unroll
        for (int j = 0; j < 4; ++j) { u32x2 w; w.x = pk2(v[j].x, v[j].y); w.y = pk2(v[j].z, v[j].w); o1[64 * j] = w; }
        if (v2) {
#pragma unroll
            for (int j = 0; j < 4; ++j) { u32x2 w; w.x = pk2(v[4 + j].x, v[4 + j].y); w.y = pk2(v[4 + j].z, v[4 + j].w); o2[64 * j] = w; } }
        if (lane == 0) { ((float*)(ws + WS_RSS))[m] = s1; if (v2) ((float*)(ws + WS_RSS))[m2] = s2; }
    }
    { float* rot = (float*)(ws + WS_ROT);
      for (int i = gw * 64 + lane; i < 2056 * 32; i += NGW * 64) {
          const int pi = i >> 5, fi = i & 31; const double pos = pi < 2048 ? (double)pi : (double)(PAST + pi - 2048);
          const double f8[8] = {1.0, 0.7498942093324559, 0.5623413251903491, 0.4216965034285822, 0.31622776601683794, 0.23713737056616552, 0.1778279410038923, 0.1333521432163324};
          double fr = 1.0; switch (fi >> 3) { case 1: fr = 0.1; break; case 2: fr = 0.01; break; case 3: fr = 0.001; break; default: break; }
          double fsel = f8[0];
#pragma unroll
          for (int q = 1; q < 8; ++q) fsel = ((fi & 7) == q) ? f8[q] : fsel;
          const double ang = pos * (fr * fsel);
          const double n = __builtin_rint(ang * 0.15915494309189535);
          double rr = __builtin_fma(-n, 6.283185307179586, ang); rr = __builtin_fma(-n, 2.4492935982947064e-16, rr);
          const float rf = (float)rr;
          rot[(size_t)pi * 64 + fi] = cosf(rf); rot[(size_t)pi * 64 + 32 + fi] = sinf(rf);
      } }
}

__device__ __forceinline__ void tab_unit(const Args& a, Frame& F, int l, int cu) {
    unsigned char* ws = a.ws;
#pragma unroll 2
    for (int j = 0; j < 16; ++j) { const int r = cu * 128 + F.wave * 16 + j, t = r >> 14, e = r & (NEXP - 1);
        const float* src = (t ? a.in[23] : a.in[22]) + ((size_t)l * NEXP + e) * DM;
        p0_tabrow(src, ws + WS_TAB + ((size_t)l * 2 + t) * 16 * MiB, (float*)(ws + WS_TSC) + ((size_t)l * 2 + t) * NEXP, e, F.lane); }
}

namespace pg8 {
struct EpiIn {
    static constexpr bool PERM = true;
    bf16_t* P; const float* rss; const float* rot;
    __device__ __forceinline__ void operator()(const f32x4 (&acc)[2][2][4][2], const Unit& u, int wr, int wc, int fr, int fq) const {
        const int seg = u.pn < 4 ? (u.pn >> 1) : (u.pn >> 2) + 1;
        const int row0 = u.pm * BM + wr * 64 + fr;
#if 0
        const float* rstdv = rss + row0;
#define RSTD_AT(ai, m) rstdv[(ai) * HALF + (m) * 16]
#else
        float rstdv[8];
#pragma unroll
        for (int i = 0; i < 8; ++i) rstdv[i] = rss[row0 + (i >> 2) * HALF + (i & 3) * 16];
#define RSTD_AT(ai, m) rstdv[(ai) * 4 + (m)]
#endif
        if (seg <= 1) {
            float lg[2];
#pragma unroll
            for (int bj = 0; bj < 2; ++bj) { const int hh = 4 * (u.pn & 1) + 2 * bj + (wc >> 1); lg[bj] = logg_of(hh); }
            const int i0 = 16 * (wc & 1) + 4 * fq;
#pragma unroll
            for (int ai = 0; ai < 2; ++ai)
#pragma unroll
                for (int m = 0; m < 4; ++m) {
                    const int row = row0 + ai * HALF + m * 16;
                    const float rstd = rsqrtf(RSTD_AT(ai, m) * (1.0f / DM) + EPS);
                    asm volatile("" ::: "memory");
                    const int pi = row < M_P ? (row & (SEQ - 1)) : SEQ + ((row - M_P) & (DECT - 1));
                    const float jj1 = (float)((row < M_P ? (row & (CH - 1)) : ((row - M_P) & (DECT - 1))) + 1);
                    const float* rp = rot + (size_t)pi * 64 + i0;
#pragma unroll
                    for (int bj = 0; bj < 2; ++bj) {
                        const int hh = 4 * (u.pn & 1) + 2 * bj + (wc >> 1);
                        const float f = __expf(seg == 0 ? jj1 * lg[bj] : -jj1 * lg[bj]) * rstd;
                        bf16_t* dst = P + (size_t)row * LDP + seg * 512 + hh * 64 + i0;
#pragma unroll
                        for (int n = 0; n < 2; ++n) {
                            const f32x2 c2 = *(const f32x2*)(rp + 2 * n), s2 = *(const f32x2*)(rp + 32 + 2 * n);
                            const f32x4 v = acc[ai][bj][m][n];
                            const float a0 = (v[0] * c2.x - v[1] * s2.x) * f, a1 = (v[2] * c2.y - v[3] * s2.y) * f;
                            const float b0 = (v[0] * s2.x + v[1] * c2.x) * f, b1 = (v[2] * s2.y + v[3] * c2.y) * f;
                            *(unsigned*)(dst + 2 * n) = pk2(a0, a1); *(unsigned*)(dst + 32 + 2 * n) = pk2(b0, b1);
                        }
                    }
                    if (m & 1) asm volatile("" ::: "memory");
                }
        } else {
            const int col0 = u.pn * BM + wc * 32 + 8 * fq;
#pragma unroll
            for (int ai = 0; ai < 2; ++ai)
#pragma unroll
                for (int m = 0; m < 4; ++m) {
                    const int row = row0 + ai * HALF + m * 16;
                    const float rstd = rsqrtf(RSTD_AT(ai, m) * (1.0f / DM) + EPS);
                    bf16_t* rowp = P + (size_t)row * LDP + col0;
#pragma unroll
                    for (int bj = 0; bj < 2; ++bj) {
                        f32x4 v0 = acc[ai][bj][m][0] * rstd, v1 = acc[ai][bj][m][1] * rstd;
                        if (seg == 3) {
#pragma unroll
                            for (int j = 0; j < 4; ++j) { v0[j] = siluf_(v0[j]); v1[j] = siluf_(v1[j]); }
                        } else if (seg == 5) {
#pragma unroll
                            for (int j = 0; j < 4; ++j) { v0[j] = geluf_(v0[j]); v1[j] = geluf_(v1[j]); }
                        } else if (seg >= 6) {
#pragma unroll
                            for (int j = 0; j < 4; ++j) { v0[j] = sigmoidf_(v0[j]); v1[j] = sigmoidf_(v1[j]); }
                        }
                        u32x4 w; w.x = pk2(v0[0], v0[1]); w.y = pk2(v0[2], v0[3]); w.z = pk2(v1[0], v1[1]); w.w = pk2(v1[2], v1[3]);
                        *(u32x4*)(rowp + bj * HALF) = w;
                    }
                }
        }
    }
};

struct EpiMerge {
    static constexpr bool PERM = true;
    bf16_t* P; bf16_t* MRG;
    __device__ __forceinline__ void operator()(const f32x4 (&acc)[2][2][4][2], const Unit& u, int wr, int wc, int fr, int fq) const {
        const int row0 = u.pm * BM + wr * 64 + fr, col0 = u.pn * BM + wc * 32 + 8 * fq;
        const int gc = u.half ? PC_GB : PC_GA;
#pragma unroll
        for (int ai = 0; ai < 2; ++ai)
#pragma unroll
            for (int m = 0; m < 4; ++m) {
                bf16_t* rowp = P + (size_t)(row0 + ai * HALF + m * 16) * LDP; bf16_t* mrow = MRG + (size_t)(row0 + ai * HALF + m * 16) * DM;
#pragma unroll
                for (int bj = 0; bj < 2; ++bj) {
                    const int c = col0 + bj * HALF;
                    const u32x4 g = *(const u32x4*)(rowp + gc + c);
                    f32x4 v0 = acc[ai][bj][m][0], v1 = acc[ai][bj][m][1];
                    v0[0] *= bflo(g.x); v0[1] *= bfhi(g.x); v0[2] *= bflo(g.y); v0[3] *= bfhi(g.y);
                    v1[0] *= bflo(g.z); v1[1] *= bfhi(g.z); v1[2] *= bflo(g.w); v1[3] *= bfhi(g.w);
                    if (u.half) { const u32x4 p = *(const u32x4*)(mrow + c);
                        v0[0] += bflo(p.x); v0[1] += bfhi(p.x); v0[2] += bflo(p.y); v0[3] += bfhi(p.y);
                        v1[0] += bflo(p.z); v1[1] += bfhi(p.z); v1[2] += bflo(p.w); v1[3] += bfhi(p.w); }
                    u32x4 w; w.x = pk2(v0[0], v0[1]); w.y = pk2(v0[2], v0[3]); w.z = pk2(v1[0], v1[1]); w.w = pk2(v1[2], v1[3]);
                    *(u32x4*)(mrow + c) = w;
                }
                if (m & 1) asm volatile("" ::: "memory");
            }
    }
};

struct EpiWo {
    static constexpr bool PERM = false;
    const float* xp; const float* xs;
    float* X; bf16_t* XB; float* rssp;
    __device__ __forceinline__ void operator()(const f32x4 (&acc)[2][2][4][2], const Unit& u, int wr, int wc, int fr, int fq) const {
        const int row0 = u.pm * BM + wr * 64 + fr, col0 = u.pn * BM + wc * 32 + 4 * fq;
#pragma unroll
        for (int ai = 0; ai < 2; ++ai)
#pragma unroll
            for (int m = 0; m < 4; ++m) {
                const int row = row0 + ai * HALF + m * 16;
                const float* src = (row < M_P ? xp + (size_t)row * DM : xs + (size_t)(row - M_P) * DM) + col0;
                float* dst = X + (size_t)row * DM + col0; bf16_t* dstb = XB + (size_t)row * DM + col0;
                float ss = 0.f;
#pragma unroll
                for (int bj = 0; bj < 2; ++bj)
#pragma unroll
                    for (int n = 0; n < 2; ++n) {
                        const f32x4 o = *(const f32x4*)(src + bj * HALF + n * 16) + acc[ai][bj][m][n];
                        *(f32x4*)(dst + bj * HALF + n * 16) = o;
                        u32x2 w; w.x = pk2(o[0], o[1]); w.y = pk2(o[2], o[3]); *(u32x2*)(dstb + bj * HALF + n * 16) = w;
                        ss += (o[0] * o[0] + o[1] * o[1]) + (o[2] * o[2] + o[3] * o[3]);
                    }
                ss += __shfl_xor(ss, 16); ss += __shfl_xor(ss, 32);
                if (fq == 0) rssp[(size_t)(u.pn * 4 + wc) * MTOT + row] = ss;
                if (m & 1) asm volatile("" ::: "memory");
            }
    }
};

struct EpiQ {
    static constexpr bool PERM = true;
    bf16_t* P; const float* rssp; float* rss2;
    __device__ __forceinline__ void operator()(const f32x4 (&acc)[2][2][4][2], const Unit& u, int wr, int wc, int fr, int fq) const {
        const int row0 = u.pm * BM + wr * 64 + fr, col0 = u.pn * BM + wc * 32 + 8 * fq;
        float rstdv[8];
#pragma unroll
        for (int i = 0; i < 8; ++i) { const int row = row0 + (i >> 2) * HALF + (i & 3) * 16; float s = 0.f;
#pragma unroll
            for (int j = 0; j < 16; ++j) s += rssp[(size_t)j * MTOT + row];
            if (u.pn == 0 && wc == 0 && fq == 0) rss2[row] = s;
            rstdv[i] = rsqrtf(s * (1.0f / DM) + EPS);
            if ((i & 1)) asm volatile("" ::: "memory"); }
#pragma unroll
        for (int ai = 0; ai < 2; ++ai)
#pragma unroll
            for (int m = 0; m < 4; ++m) {
                const int row = row0 + ai * HALF + m * 16;
                const float rstd = rstdv[ai * 4 + m];
                bf16_t* rowp = P + (size_t)row * LDP + PC_QP + col0;
#pragma unroll
                for (int bj = 0; bj < 2; ++bj) {
                    const f32x4 v0 = acc[ai][bj][m][0] * rstd, v1 = acc[ai][bj][m][1] * rstd;
                    u32x4 w; w.x = pk2(v0[0], v0[1]); w.y = pk2(v0[2], v0[3]); w.z = pk2(v1[0], v1[1]); w.w = pk2(v1[2], v1[3]);
                    *(u32x4*)(rowp + bj * HALF) = w;
                }
            }
    }
};
}

__device__ __forceinline__ void mma32(f32x16& acc, ldsp_t A, int lda_b, ldsp_t Bt, int ldb_b, int ksteps, int lane) {
    ldsp_t ap = A + (lane & 31) * lda_b + (lane >> 5) * 16;
    ldsp_t bp = Bt + (lane & 31) * ldb_b + (lane >> 5) * 16;
    for (int ks = 0; ks < ksteps; ++ks) {
        const bf16x8 a = *(const LAS bf16x8*)(ap + ks * 32), b = *(const LAS bf16x8*)(bp + ks * 32);
        acc = __builtin_amdgcn_mfma_f32_32x32x16_bf16(a, b, acc, 0, 0, 0);
    }
}
template <int KS>
__device__ __forceinline__ void mma32t(f32x16& acc, ldsp_t A, int lda_b, ldsp_t Bt, int ldb_b, int lane) {
    ldsp_t ap = A + (lane & 31) * lda_b + (lane >> 5) * 16;
    ldsp_t bp = Bt + (lane & 31) * ldb_b + (lane >> 5) * 16;
    bf16x8 av[KS], bv[KS];
#pragma unroll
    for (int ks = 0; ks < KS; ++ks) { av[ks] = *(const LAS bf16x8*)(ap + ks * 32); bv[ks] = *(const LAS bf16x8*)(bp + ks * 32); }
#pragma unroll
    for (int ks = 0; ks < KS; ++ks) acc = __builtin_amdgcn_mfma_f32_32x32x16_bf16(av[ks], bv[ks], acc, 0, 0, 0);
}
#define ZERO16 ((f32x16){0.f,0.f,0.f,0.f,0.f,0.f,0.f,0.f,0.f,0.f,0.f,0.f,0.f,0.f,0.f,0.f})

constexpr int R_QS = 0, R_KS = 18432, R_VS = 43008, R_SS = 83968, R_RST = 118784, R_ST = 137216;
constexpr int LD64 = 144, LDK = 192, LDV = 320, LD128 = 272;
typedef short v4i16_t __attribute__((ext_vector_type(4)));
__device__ __forceinline__ bf16x8 frag_tr(ldsp_t X, int stride_b, int c0, int k0, int lane) {
    const int h = lane >> 5, blk = (lane >> 4) & 1, q = (lane & 15) >> 2, p = lane & 3;
    ldsp_t a = X + (k0 + 8 * h + q) * stride_b + (c0 + 16 * blk + 4 * p) * 2;
    const v4i16_t lo = __builtin_amdgcn_ds_read_tr16_b64_v4i16((LAS v4i16_t*)a), hi = __builtin_amdgcn_ds_read_tr16_b64_v4i16((LAS v4i16_t*)(a + 4 * stride_b));
    return (bf16x8){lo[0], lo[1], lo[2], lo[3], hi[0], hi[1], hi[2], hi[3]};
}
__device__ __forceinline__ bf16x8 frag_row(ldsp_t X, int stride_b, int r0, int k0, int lane) { return *(const LAS bf16x8*)(X + (r0 + (lane & 31)) * stride_b + (k0 + 8 * (lane >> 5)) * 2); }

__device__ __forceinline__ void ret_prompt_unit(const Args& a, Frame& F, int l, int b, int h) {
    const int tid = F.tid, lane = F.lane, w = F.wave, hi = lane >> 5, l31 = lane & 31;
    ldsp_t lds = F.lds;
    const bf16_t* P = (const bf16_t*)(a.ws + WS_P);
    bf16_t* ARET = (bf16_t*)(a.ws + WS_ARET);
    const float lg = logg_of(h), G = __expf(128.0f * lg);
    f32x16 racc = ZERO16;
    const int db = w >> 2, eb = w & 3;
    u32x4 pq[2], pk[2], pv[4], pg[4];
#define RET_FETCH(nn) do { const bf16_t* _b = P + ((size_t)b * SEQ + (nn) * CH) * LDP + h * 64; \
        _Pragma("unroll") for (int i = 0; i < 2; ++i) { const int p = tid + 512 * i; const bf16_t* _r = _b + (size_t)(p >> 3) * LDP + (p & 7) * 8; pq[i] = *(const u32x4*)(_r + PC_Q); pk[i] = *(const u32x4*)(_r + PC_K); } \
        _Pragma("unroll") for (int i = 0; i < 4; ++i) { const int p = tid + 512 * i; const bf16_t* _r = _b + h * 64 + (size_t)(p >> 4) * LDP + (p & 15) * 8; pv[i] = *(const u32x4*)(_r + PC_V); } } while (0)
#define RET_FETCH_G(nn) do { const bf16_t* _b = P + ((size_t)b * SEQ + (nn) * CH) * LDP + h * 128 + PC_GR; \
        _Pragma("unroll") for (int i = 0; i < 4; ++i) { const int p = tid + 512 * i; pg[i] = *(const u32x4*)(_b + (size_t)(p >> 4) * LDP + (p & 15) * 8); } } while (0)
    RET_FETCH(0);
    for (int n = 0; n < 16; ++n) {
        const size_t tok0 = (size_t)b * SEQ + n * CH;
#pragma unroll
        for (int i = 0; i < 2; ++i) { const int p = tid + 512 * i; *(LAS u32x4*)(lds + R_QS + (p >> 3) * LD64 + (p & 7) * 16) = pq[i]; *(LAS u32x4*)(lds + R_KS + (p >> 3) * LDK + (p & 7) * 16) = pk[i]; }
#pragma unroll
        for (int i = 0; i < 4; ++i) { const int p = tid + 512 * i; *(LAS u32x4*)(lds + R_VS + (p >> 4) * LDV + (p & 15) * 16) = pv[i]; }
#pragma unroll
        for (int g = 0; g < 4; ++g) { u32x2 wv; wv.x = pk2(racc[4 * g], racc[4 * g + 1]); wv.y = pk2(racc[4 * g + 2], racc[4 * g + 3]);
            *(LAS u32x2*)(lds + R_RST + (32 * eb + l31) * LD64 + (32 * db + 8 * g + 4 * hi) * 2) = wv; }
        if (n + 1 < 16) RET_FETCH(n + 1);
        RET_FETCH_G(n);
        LBAR();
#pragma unroll
        for (int t2 = 0; t2 < 2; ++t2) { const int t = 2 * w + t2, mb = t >> 2, jb = t & 3;
            if (mb <= jb) { f32x16 sacc = ZERO16;
                bf16x8 af[4], bf[4];
#pragma unroll
                for (int ks = 0; ks < 4; ++ks) { af[ks] = frag_row(lds + R_KS, LDK, 32 * mb, 16 * ks, lane); bf[ks] = frag_row(lds + R_QS, LD64, 32 * jb, 16 * ks, lane); }
#pragma unroll
                for (int ks = 0; ks < 4; ++ks) sacc = __builtin_amdgcn_mfma_f32_32x32x16_bf16(af[ks], bf[ks], sacc, 0, 0, 0);
                const int j = 32 * jb + l31;
#pragma unroll
                for (int g = 0; g < 4; ++g) { const int m0 = 32 * mb + 8 * g + 4 * hi; float v[4];
#pragma unroll
                    for (int q = 0; q < 4; ++q) v[q] = (j >= m0 + q) ? sacc[4 * g + q] : 0.f;
                    u32x2 wv; wv.x = pk2(v[0], v[1]); wv.y = pk2(v[2], v[3]);
                    *(LAS u32x2*)(lds + R_SS + j * LD128 + m0 * 2) = wv; } } }
        LBAR();
        const int jb = w >> 1, eh = w & 1;
        f32x16 oacc[2];
        oacc[0] = ZERO16; oacc[1] = ZERO16;
        { bf16x8 a0[4], a1[4], bf[4];
#pragma unroll
          for (int ks = 0; ks < 4; ++ks) { a0[ks] = frag_row(lds + R_RST, LD64, 32 * (2 * eh), 16 * ks, lane); a1[ks] = frag_row(lds + R_RST, LD64, 32 * (2 * eh + 1), 16 * ks, lane); bf[ks] = frag_row(lds + R_QS, LD64, 32 * jb, 16 * ks, lane); }
#pragma unroll
          for (int ks = 0; ks < 4; ++ks) { oacc[0] = __builtin_amdgcn_mfma_f32_32x32x16_bf16(a0[ks], bf[ks], oacc[0], 0, 0, 0); oacc[1] = __builtin_amdgcn_mfma_f32_32x32x16_bf16(a1[ks], bf[ks], oacc[1], 0, 0, 0); } }
        for (int mbk = 0; mbk <= jb; ++mbk) {
            bf16x8 a0[2], a1[2], bf[2];
#pragma unroll
            for (int ks = 0; ks < 2; ++ks) { const int k0 = 32 * mbk + 16 * ks; a0[ks] = frag_tr(lds + R_VS, LDV, 32 * (2 * eh), k0, lane); a1[ks] = frag_tr(lds + R_VS, LDV, 32 * (2 * eh + 1), k0, lane); bf[ks] = frag_row(lds + R_SS, LD128, 32 * jb, k0, lane); }
#pragma unroll
            for (int ks = 0; ks < 2; ++ks) { oacc[0] = __builtin_amdgcn_mfma_f32_32x32x16_bf16(a0[ks], bf[ks], oacc[0], 0, 0, 0); oacc[1] = __builtin_amdgcn_mfma_f32_32x32x16_bf16(a1[ks], bf[ks], oacc[1], 0, 0, 0); }
        }
        float s1 = 0.f, s2 = 0.f;
#pragma unroll
        for (int t = 0; t < 2; ++t)
#pragma unroll
            for (int r = 0; r < 16; ++r) { s1 += oacc[t][r]; s2 += oacc[t][r] * oacc[t][r]; }
        s1 += __shfl_xor(s1, 32); s2 += __shfl_xor(s2, 32);
        if (hi == 0) *(LAS f32x2*)(lds + R_ST + (eh * 128 + 32 * jb + l31) * 8) = (f32x2){s1, s2};
        LBAR();
        { const int j = 32 * jb + l31;
          const f32x2 sa = *(const LAS f32x2*)(lds + R_ST + j * 8), sb = *(const LAS f32x2*)(lds + R_ST + (128 + j) * 8);
          const float mu = (sa.x + sb.x) * (1.0f / DV), var = (sa.y + sb.y) * (1.0f / DV) - mu * mu, rstd = rsqrtf(fmaxf(var, 0.f) + EPS);
#pragma unroll
          for (int t = 0; t < 2; ++t)
#pragma unroll
              for (int g = 0; g < 4; ++g) { const int e0 = 32 * (2 * eh + t) + 8 * g + 4 * hi;
                  u32x2 wv; wv.x = pk2((oacc[t][4 * g] - mu) * rstd, (oacc[t][4 * g + 1] - mu) * rstd); wv.y = pk2((oacc[t][4 * g + 2] - mu) * rstd, (oacc[t][4 * g + 3] - mu) * rstd);
                  *(LAS u32x2*)(lds + R_SS + j * LD128 + e0 * 2) = wv; } }
#pragma unroll
        for (int kh = 0; kh < 2; ++kh) { bf16x8 af[4], bf[4];
#pragma unroll
          for (int ks = 0; ks < 4; ++ks) { af[ks] = frag_tr(lds + R_KS, LDK, 32 * db, 64 * kh + 16 * ks, lane); bf[ks] = frag_tr(lds + R_VS, LDV, 32 * eb, 64 * kh + 16 * ks, lane); }
#pragma unroll
          for (int ks = 0; ks < 4; ++ks) racc = __builtin_amdgcn_mfma_f32_32x32x16_bf16(af[ks], bf[ks], racc, 0, 0, 0); }
#pragma unroll
        for (int r = 0; r < 16; ++r) racc[r] *= G;
        LBAR();
#pragma unroll
        for (int i = 0; i < 4; ++i) { const int p = tid + 512 * i, row = p >> 4, c = p & 15;
            const u32x4 ov = *(const LAS u32x4*)(lds + R_SS + row * LD128 + c * 16), gv = pg[i];
            u32x4 wv; wv.x = pk2(bflo(ov.x) * bflo(gv.x), bfhi(ov.x) * bfhi(gv.x)); wv.y = pk2(bflo(ov.y) * bflo(gv.y), bfhi(ov.y) * bfhi(gv.y));
            wv.z = pk2(bflo(ov.z) * bflo(gv.z), bfhi(ov.z) * bfhi(gv.z)); wv.w = pk2(bflo(ov.w) * bflo(gv.w), bfhi(ov.w) * bfhi(gv.w));
            *(u32x4*)(ARET + (tok0 + row) * DM + h * 128 + c * 8) = wv; }
    }
    float* so = a.out + O_SRP + ((((size_t)l * NBATCH + b) * HR + h) * DK) * DV;
#pragma unroll
    for (int r = 0; r < 16; ++r) { const int d = 32 * db + (r & 3) + 8 * (r >> 2) + 4 * hi; so[(size_t)d * DV + 32 * eb + l31] = racc[r]; }
#undef RET_FETCH
#undef RET_FETCH_G
}

__device__ __forceinline__ void ret_sample_unit(const Args& a, Frame& F, int l, int bs, int h) {
    const int tid = F.tid, lane = F.lane, w = F.wave;
    LAS float* qd = (LAS float*)F.lds; LAS float* ku = qd + 512; LAS float* vv = ku + 512; LAS float* S = vv + 1024; LAS float* crossp = S + 64; LAS float* red = crossp + 4096;
    bf16_t* P = (bf16_t*)(a.ws + WS_P);
    const size_t tok0 = (size_t)M_P + bs * DECT;
    { const int j = tid >> 6, d = tid & 63; const bf16_t* src = P + (tok0 + j) * LDP + h * 64 + d; qd[tid] = bf1(src[PC_Q]); ku[tid] = bf1(src[PC_K]); }
#pragma unroll
    for (int i = 0; i < 2; ++i) { const int idx = tid + 512 * i, m = idx >> 7, e = idx & 127; vv[idx] = bf1(P[(tok0 + m) * LDP + PC_V + h * 128 + e]); }
    LBAR();
    const int dg = tid >> 7, e = tid & 127;
    const size_t soff = ((((size_t)l * DECB + bs) * HR + h) * DK) * DV;
    const float* r0 = a.in[2] + soff; float* rn = a.out + O_SRS + soff;
    const float lg = logg_of(h), G8 = __expf(8.0f * lg);
    float cross[8];
#pragma unroll
    for (int j = 0; j < 8; ++j) cross[j] = 0.f;
    float rv[16];
#pragma unroll
    for (int dd = 0; dd < 16; ++dd) rv[dd] = r0[(size_t)(dg * 16 + dd) * DV + e];
#pragma unroll
    for (int dd = 0; dd < 16; ++dd) { const int d = dg * 16 + dd; const float r = rv[dd]; float kvs = 0.f;
#pragma unroll
        for (int m = 0; m < 8; ++m) kvs += ku[m * 64 + d] * vv[m * 128 + e];
        rn[(size_t)d * DV + e] = G8 * (r + kvs);
#pragma unroll
        for (int j = 0; j < 8; ++j) cross[j] += qd[j * 64 + d] * r; }
#pragma unroll
    for (int j = 0; j < 8; ++j) crossp[(dg * 8 + j) * 128 + e] = cross[j];
    { const int pr = tid >> 3, part = tid & 7, j = pr >> 3, m = pr & 7; float sp = 0.f;
#pragma unroll
      for (int d = 0; d < 8; ++d) sp += qd[j * 64 + part * 8 + d] * ku[m * 64 + part * 8 + d];
      sp += __shfl_xor(sp, 1); sp += __shfl_xor(sp, 2); sp += __shfl_xor(sp, 4);
      if (part == 0) S[pr] = (j >= m) ? sp : 0.f; }
    LBAR();
    float o[2];
#pragma unroll
    for (int jj = 0; jj < 2; ++jj) { const int j = dg + 4 * jj; float s = 0.f;
#pragma unroll
        for (int g = 0; g < 4; ++g) s += crossp[(g * 8 + j) * 128 + e];
#pragma unroll
        for (int m = 0; m < 8; ++m) s += S[j * 8 + m] * vv[m * 128 + e];
        o[jj] = s;
        const float t1 = wave_sum(s), t2 = wave_sum(s * s);
        if (lane == 0) { red[(jj * 8 + w) * 2] = t1; red[(jj * 8 + w) * 2 + 1] = t2; } }
    LBAR();
#pragma unroll
    for (int jj = 0; jj < 2; ++jj) { const int j = dg + 4 * jj, w0 = 2 * dg;
        const float t1 = red[(jj * 8 + w0) * 2] + red[(jj * 8 + w0 + 1) * 2], t2 = red[(jj * 8 + w0) * 2 + 1] + red[(jj * 8 + w0 + 1) * 2 + 1];
        const float mu = t1 * (1.0f / DV), var = t2 * (1.0f / DV) - mu * mu, rstd = rsqrtf(fmaxf(var, 0.f) + EPS);
        const bf16_t* prow = P + (tok0 + j) * LDP + h * 128 + e;
        ((bf16_t*)(a.ws + WS_ARET))[(tok0 + j) * DM + h * 128 + e] = (bf16_t)f2bf((o[jj] - mu) * rstd * bf1(prow[PC_GR])); }
    LBAR();
}

constexpr int N_XRL = 0, N_XCF = 33536, N_XCB = 66304, N_WGT = 84736, N_CAR = 103168, N_BUF = 107264;
__device__ __forceinline__ void rnn_unit(const Args& a, Frame& F, int l, bool sample, int bg, int nb) {
    const int tid = F.tid, lane = F.lane, w = F.wave, hi = lane >> 5, l31 = lane & 31;
    ldsp_t lds = F.lds;
    LAS float* xrl = (LAS float*)(lds + N_XRL); LAS float* xcf = (LAS float*)(lds + N_XCF); LAS float* car = (LAS float*)(lds + N_CAR); LAS float* bufl = (LAS float*)(lds + N_BUF);
    LAS float* aa = xrl; LAS float* uu = xcf;
    bf16_t* P = (bf16_t*)(a.ws + WS_P);
    const int ch0 = nb * BS;
    { const bf16_t* wg = (const bf16_t*)(a.ws + WS_WG) + ((size_t)l * NBLK + nb) * 2 * BS * BS;
#pragma unroll
      for (int i = 0; i < 2; ++i) { const int p = tid + 512 * i, row = p >> 3, c8 = p & 7; *(LAS u32x4*)(lds + N_WGT + row * LD64 + c8 * 16) = *(const u32x4*)(wg + row * 64 + c8 * 8); } }
    const int cc = tid & 63;
    const float* cwp = a.in[11] + (size_t)l * 4 * DM + ch0 + cc;
    const float cw0 = cwp[0], cw1 = cwp[DM], cw2 = cwp[2 * DM], cw3 = cwp[3 * DM], cbv = a.in[12][l * DM + ch0 + cc];
    const int rb = w >> 1, cb = w & 1, dcol = 32 * cb + l31;
    const float bav = a.in[14][l * DM + ch0 + dcol], bxv = a.in[16][l * DM + ch0 + dcol];
    const float spl = log1pf(__expf(-a.in[17][l * DM + ch0 + dcol]));
    const int ntiles = sample ? 1 : 16;
    float hcar = 0.f;
    if (sample) {
        for (int i = tid; i < 16 * 3 * 64; i += NTHREADS) { const int s = i / 192, r = (i / 64) % 3, c = i & 63;
            bufl[i] = a.in[4][(((size_t)l * DECB + bg * 16 + s) * 3 + r) * DM + ch0 + c]; }
    }
    u32x4 pre[3];
#define RNN_FETCH(nn) do { const size_t _t0 = sample ? (size_t)M_P + bg * 128 : (size_t)bg * SEQ + (nn) * 128; _Pragma("unroll") for (int k = 0; k < 3; ++k) { \
        const int p = tid + 512 * k, row = p >> 3, c8 = p & 7; pre[k] = (u32x4){0u, 0u, 0u, 0u}; \
        if (p < 131 * 8 && (row >= 3 || (!sample && (nn) > 0))) pre[k] = *(const u32x4*)(P + (_t0 + row - 3) * LDP + PC_XR + ch0 + c8 * 8); } } while (0)
    RNN_FETCH(0);
    for (int n = 0; n < ntiles; ++n) {
        const size_t tok0 = sample ? (size_t)M_P + bg * 128 : (size_t)bg * SEQ + n * 128;
        unsigned short gl[16];
#pragma unroll
        for (int i = 0; i < 16; ++i) gl[i] = P[(tok0 + 16 * w + i) * LDP + PC_GN + ch0 + cc];
#pragma unroll
        for (int k = 0; k < 3; ++k) { const int p = tid + 512 * k, row = p >> 3, c8 = p & 7;
            if (p < 131 * 8) { const u32x4 v = pre[k]; LAS float* d = xrl + row * 64 + c8 * 8;
                *(LAS f32x4*)d = (f32x4){bflo(v.x), bfhi(v.x), bflo(v.y), bfhi(v.y)}; *(LAS f32x4*)(d + 4) = (f32x4){bflo(v.z), bfhi(v.z), bflo(v.w), bfhi(v.w)}; } }
        LBAR();
        if (n + 1 < ntiles) RNN_FETCH(n + 1);
        { const int tg = tid >> 6;
#pragma unroll 4
          for (int i = 0; i < 16; ++i) { const int t = tg * 16 + i; float x0, x1, x2;
              const float x3 = xrl[(t + 3) * 64 + cc];
              if (sample) { const int s = t >> 3, j = t & 7;
                  x0 = j >= 3 ? xrl[t * 64 + cc] : bufl[(s * 3 + j) * 64 + cc];
                  x1 = j >= 2 ? xrl[(t + 1) * 64 + cc] : bufl[(s * 3 + j + 1) * 64 + cc];
                  x2 = j >= 1 ? xrl[(t + 2) * 64 + cc] : bufl[(s * 3 + j + 2) * 64 + cc];
              } else { x0 = xrl[t * 64 + cc]; x1 = xrl[(t + 1) * 64 + cc]; x2 = xrl[(t + 2) * 64 + cc]; }
              const float xc = cbv + cw0 * x0 + cw1 * x1 + cw2 * x2 + cw3 * x3;
              xcf[t * 64 + cc] = xc; *(LAS bf16_t*)(lds + N_XCB + t * LD64 + cc * 2) = (bf16_t)f2bf(xc); } }
        if (sample) { if (tid < 192) { }     }
        if (sample) { for (int i = tid; i < 16 * 3 * 64; i += NTHREADS) { const int s = i / 192, r = (i / 64) % 3, c = i & 63;
                a.out[O_SCS + (((size_t)l * DECB + bg * 16 + s) * 3 + r) * DM + ch0 + c] = xrl[(3 + s * 8 + 5 + r) * 64 + c]; } }
        else if (n == 15) { if (tid < 192) { const int r = tid >> 6, c = tid & 63; a.out[O_SCP + (((size_t)l * NBATCH + bg) * 3 + r) * DM + ch0 + c] = xrl[(3 + 125 + r) * 64 + c]; } }
        LBAR();
        { f32x16 ar = ZERO16, ai = ZERO16;
          mma32t<4>(ar, lds + N_XCB + rb * 32 * LD64, LD64, lds + N_WGT + (32 * cb) * LD64, LD64, lane);
          mma32t<4>(ai, lds + N_XCB + rb * 32 * LD64, LD64, lds + N_WGT + (64 + 32 * cb) * LD64, LD64, lane);
#pragma unroll
          for (int r = 0; r < 16; ++r) { const int t = 32 * rb + (r & 3) + 8 * (r >> 2) + 4 * hi;
              const float rg = sigmoidf_(ar[r] + bav), ig = sigmoidf_(ai[r] + bxv);
              const float la = -8.0f * rg * spl, av = __expf(la), mult = sqrtf(fmaxf(-expm1f(2.0f * la), 0.f));
              const float xc = xcf[t * 64 + dcol];
              aa[t * 64 + dcol] = av; uu[t * 64 + dcol] = mult * ig * xc; } }
        LBAR();
        if (!sample) {
            float Ap = 1.f, Hl = 0.f;
#pragma unroll 4
            for (int i = 0; i < 16; ++i) { const int t = 16 * w + i; const float av = aa[t * 64 + cc], uv = uu[t * 64 + cc]; Hl = av * Hl + uv; Ap *= av; }
            car[w * 64 + cc] = Ap; car[512 + w * 64 + cc] = Hl;
            LBAR();
            float hin = hcar, hnext = hcar;
#pragma unroll
            for (int w2 = 0; w2 < 8; ++w2) { const float A2 = car[w2 * 64 + cc], H2 = car[512 + w2 * 64 + cc]; hnext = A2 * hnext + H2; if (w2 < w) hin = hnext; }
            float hh = hin;
#pragma unroll
            for (int i = 0; i < 16; ++i) { const int t = 16 * w + i; hh = aa[t * 64 + cc] * hh + uu[t * 64 + cc];
                ((bf16_t*)(a.ws + WS_ARNN))[(tok0 + t) * DM + ch0 + cc] = (bf16_t)f2bf(hh * bf1(gl[i])); }
            hcar = hnext;
        } else {
#pragma unroll
            for (int s2 = 0; s2 < 2; ++s2) { const int s = 2 * w + s2, bs = bg * 16 + s;
                float hh = a.in[3][((size_t)l * DECB + bs) * DM + ch0 + cc];
#pragma unroll
                for (int j = 0; j < 8; ++j) { const int t = s * 8 + j; hh = aa[t * 64 + cc] * hh + uu[t * 64 + cc];
                    ((bf16_t*)(a.ws + WS_ARNN))[(tok0 + t) * DM + ch0 + cc] = (bf16_t)f2bf(hh * bf1(gl[s2 * 8 + j])); }
                a.out[O_SHS + ((size_t)l * DECB + bs) * DM + ch0 + cc] = hh; }
        }
        LBAR();
    }
    if (!sample && w == 0) a.out[O_SHP + ((size_t)l * NBATCH + bg) * DM + ch0 + cc] = hcar;
#undef RNN_FETCH
}

__device__ __forceinline__ unsigned ord_of(float f) { const unsigned u = __builtin_bit_cast(unsigned, f); return u ^ ((u >> 31) ? 0xFFFFFFFFu : 0x80000000u); }
__device__ __forceinline__ float ord_inv(unsigned o) { const unsigned u = (o >> 31) ? (o ^ 0x80000000u) : ~o; return __builtin_bit_cast(float, u); }
__host__ __device__ constexpr bool cand_ok(int a, int b) { return (a + 1) * (b + 1) <= 16; }

#define CEX(a, b) do { const unsigned _x = (a), _y = (b); (a) = _x > _y ? _x : _y; (b) = _x > _y ? _y : _x; } while (0)
__device__ __forceinline__ void sort16_desc(unsigned (&v)[16]) {
#pragma unroll
    for (int k = 2; k <= 16; k <<= 1)
#pragma unroll
        for (int j = k >> 1; j > 0; j >>= 1)
#pragma unroll
            for (int i = 0; i < 16; ++i) { const int p = i ^ j; if (p > i) { if ((i & k) == 0) CEX(v[i], v[p]); else CEX(v[p], v[i]); } }
}
__device__ __forceinline__ void bitonic_merge16_desc(unsigned (&v)[16]) {
#pragma unroll
    for (int j = 8; j > 0; j >>= 1)
#pragma unroll
        for (int i = 0; i < 16; ++i) { const int p = i ^ j; if (p > i) CEX(v[i], v[p]); }
}
__device__ __forceinline__ void merge_top16(unsigned (&a)[16], const unsigned (&b)[16]) {
#pragma unroll
    for (int i = 0; i < 16; ++i) a[i] = a[i] > b[15 - i] ? a[i] : b[15 - i];
    bitonic_merge16_desc(a);
}

__device__ __forceinline__ void route_unit(const Args& a, int l, int tb, int h, int lane) {
    const int hi = lane >> 5, l31 = lane & 31, token = tb * 32 + l31;
    const bf16_t* P = (const bf16_t*)(a.ws + WS_P);
    const bf16_t* qrow = P + (size_t)token * LDP + PC_QP + h * 256 + hi * 8;
    const bf16_t* kbase = (const bf16_t*)(a.ws + WS_KEYS) + ((size_t)(l * PH + h) * 2) * NKEY * HK + (size_t)l31 * HK + hi * 8;
    unsigned L[2][16];
#pragma unroll
    for (int p = 0; p < 2; ++p) {
        f32x16 acc[4];
#pragma unroll
        for (int kb = 0; kb < 4; ++kb) acc[kb] = ZERO16;
#pragma unroll 2
        for (int ks = 0; ks < 8; ++ks) {
            const bf16x8 bq = *(const bf16x8*)(qrow + p * 128 + ks * 16);
#pragma unroll
            for (int kb = 0; kb < 4; ++kb) { const bf16x8 ak = *(const bf16x8*)(kbase + ((size_t)p * NKEY + kb * 32) * HK + ks * 16);
                acc[kb] = __builtin_amdgcn_mfma_f32_32x32x16_bf16(ak, bq, acc[kb], 0, 0, 0); }
        }
        unsigned g0[16], g1[16];
#pragma unroll
        for (int r = 0; r < 16; ++r) { const int key = (r & 3) + 8 * (r >> 2) + 4 * hi; g0[r] = (ord_of(acc[0][r]) & ~127u) | (unsigned)(127 - key); g1[r] = (ord_of(acc[1][r]) & ~127u) | (unsigned)(127 - (32 + key)); }
        sort16_desc(g0); sort16_desc(g1); merge_top16(g0, g1);
        unsigned g2[16];
#pragma unroll
        for (int r = 0; r < 16; ++r) { const int key = (r & 3) + 8 * (r >> 2) + 4 * hi; g1[r] = (ord_of(acc[2][r]) & ~127u) | (unsigned)(127 - (64 + key)); g2[r] = (ord_of(acc[3][r]) & ~127u) | (unsigned)(127 - (96 + key)); }
        sort16_desc(g1); sort16_desc(g2); merge_top16(g1, g2); merge_top16(g0, g1);
#pragma unroll
        for (int i = 0; i < 16; ++i) g1[i] = (unsigned)__shfl_xor((int)g0[i], 32);
        merge_top16(g0, g1);
#pragma unroll
        for (int i = 0; i < 16; ++i) L[p][i] = g0[i];
    }
    float sa[16], sb[16];
#pragma unroll
    for (int i = 0; i < 16; ++i) { sa[i] = ord_inv(L[0][i] & ~127u); sb[i] = ord_inv(L[1][i] & ~127u); }
#define CKEY(x, y) ((ord_of(sa[x] + sb[y]) & ~255u) | (unsigned)(255 - ((x) * 16 + (y))))
    unsigned best[16], t1[16];
#pragma unroll
    for (int y = 0; y < 16; ++y) { best[y] = CKEY(0, y); t1[y] = y < 8 ? CKEY(1, y) : 0u; }
    merge_top16(best, t1);
    { int n = 0;
#pragma unroll
      for (int x = 2; x < 7; ++x)
#pragma unroll
          for (int y = 0; y < 16; ++y) if (cand_ok(x, y)) { t1[n] = CKEY(x, y); ++n; }
    }
    sort16_desc(t1); merge_top16(best, t1);
    { int n = 0;
#pragma unroll
      for (int x = 7; x < 16; ++x)
#pragma unroll
          for (int y = 0; y < 16; ++y) if (cand_ok(x, y)) { t1[n] = CKEY(x, y); ++n; }
#pragma unroll
      for (int i = 10; i < 16; ++i) t1[i] = 0u;
    }
    sort16_desc(t1); merge_top16(best, t1);
#undef CKEY
    float sc[16], ssum = 0.f; const float mx = ord_inv(best[0] & ~255u);
#pragma unroll
    for (int it = 0; it < 16; ++it) { sc[it] = __expf(ord_inv(best[it] & ~255u) - mx); ssum += sc[it]; }
    const float inv = 1.0f / ssum;
    unsigned* eo = (unsigned*)(a.ws + WS_EIDX) + (size_t)token * 128 + h * 16 + hi * 8;
    float* go = (float*)(a.ws + WS_GATE) + (size_t)token * 128 + h * 16 + hi * 8;
#pragma unroll
    for (int it = 0; it < 8; ++it) {
        unsigned b0 = best[it], b1 = best[it + 8]; float g0 = sc[it], g1 = sc[it + 8];
        asm volatile("" : "+v"(b0), "+v"(b1), "+v"(g0), "+v"(g1));
        const unsigned bsel = hi ? b1 : b0; const float gsel = (hi ? g1 : g0) * inv;
        const unsigned c = 255u - (bsel & 255u), ca = c >> 4, cb = c & 15u;
        unsigned k1 = 0u, k2 = 0u;
#pragma unroll
        for (int i = 0; i < 16; ++i) { k1 = (ca == (unsigned)i) ? (127u - (L[0][i] & 127u)) : k1; k2 = (cb == (unsigned)i) ? (127u - (L[1][i] & 127u)) : k2; }
        eo[it] = k1 * 128u + k2; go[it] = gsel;
    }
}
#undef CEX

constexpr int MAXT = 9;
__device__ __forceinline__ void dec16(const u32x4 r, float (&f)[16]) {
    const unsigned w[4] = {r.x, r.y, r.z, r.w};
#pragma unroll
    for (int j = 0; j < 4; ++j) { const f32x2 a = __builtin_amdgcn_cvt_pk_f32_fp8((int)w[j], false), b = __builtin_amdgcn_cvt_pk_f32_fp8((int)w[j], true);
        f[4 * j] = a.x; f[4 * j + 1] = a.y; f[4 * j + 2] = b.x; f[4 * j + 3] = b.y; }
}
__device__ __forceinline__ void peer_phase(const Args& a, Frame& F, int l, bool lastlayer) {
    const int lane = F.lane, l7 = lane & 7, lg3 = lane >> 3;
    const int gw = F.vcu * NWAVES + F.wave, NGW = F.G * NWAVES;
    const unsigned char* TU = a.ws + WS_TAB + ((size_t)l * 2) * 16 * MiB;
    const unsigned char* TV = a.ws + WS_TAB + ((size_t)l * 2 + 1) * 16 * MiB;
    const float* SCU = (const float*)(a.ws + WS_TSC) + ((size_t)l * 2) * NEXP; const float* SCV = SCU + NEXP;
    bf16_t* XB = (bf16_t*)(a.ws + WS_XB); float* X = a.out;
    const unsigned* EI = (const unsigned*)(a.ws + WS_EIDX); const float* GT = (const float*)(a.ws + WS_GATE);
    const float* g2 = a.in[6] + (size_t)l * DM;
    LAS unsigned* st = (LAS unsigned*)(F.lds + F.wave * 16384) + lane;
#define ST_ELO(i) st[(0 * MAXT + (i)) * 64]
#define ST_EHI(i) st[(1 * MAXT + (i)) * 64]
#define ST_H0(i)  ((LAS float*)st)[(2 * MAXT + (i)) * 64]
#define ST_H1(i)  ((LAS float*)st)[(3 * MAXT + (i)) * 64]
#define ST_SSQ(i) ((LAS float*)st)[(4 * MAXT + (i)) * 64]
    const int ntok = (MTOT - gw + NGW - 1) / NGW;
    for (int i = 0; i < ntok; ++i) { const int t = gw + NGW * i; ST_ELO(i) = EI[(size_t)t * 128 + lane]; ST_EHI(i) = EI[(size_t)t * 128 + 64 + lane]; ST_H0(i) = 0.f; ST_H1(i) = 0.f; ST_SSQ(i) = 0.f; }
#define PEER_ISSUE(R, TAB, ss, ii, eword) do { const unsigned _e = (eword); _Pragma("unroll") for (int q = 0; q < 8; ++q) { \
        const unsigned idx = (unsigned)__shfl((int)_e, q * 8 + lg3); R[q] = *(const u32x4*)((TAB) + ((size_t)(ss) * NEXP + idx) * 128 + 16 * l7); } } while (0)
    for (int urep = 0; urep < REPS(7); ++urep) {
    if (urep) { for (int i = 0; i < ntok; ++i) { ST_H0(i) = 0.f; ST_H1(i) = 0.f; } }
    {
        u32x4 RA[8], RB[8];
        PEER_ISSUE(RA, TU, 0, 0, ST_ELO(0));
        u32x4 xa = *(const u32x4*)(XB + (size_t)gw * DM + 16 * l7), xb = *(const u32x4*)(XB + (size_t)gw * DM + 16 * l7 + 8);
#pragma unroll 1
        for (int s = 0; s < 8; ++s) {
            float gv[16];
#pragma unroll
            for (int j = 0; j < 4; ++j) { const f32x4 g = *(const f32x4*)(g2 + 128 * s + 16 * l7 + 4 * j); gv[4 * j] = g[0]; gv[4 * j + 1] = g[1]; gv[4 * j + 2] = g[2]; gv[4 * j + 3] = g[3]; }
#pragma unroll 1
            for (int i = 0; i < ntok; ++i) {
                PEER_ISSUE(RB, TU, s, i, ST_EHI(i));
                int sn = s, in = i + 1; if (in == ntok) { in = 0; sn = s + 1; } if (sn == 8) { sn = 7; in = ntok - 1; }
                const int tn = gw + NGW * in;
                const u32x4 xan = *(const u32x4*)(XB + (size_t)tn * DM + 128 * sn + 16 * l7), xbn = *(const u32x4*)(XB + (size_t)tn * DM + 128 * sn + 16 * l7 + 8);
                float xg[16];
                { const unsigned xw[8] = {xa.x, xa.y, xa.z, xa.w, xb.x, xb.y, xb.z, xb.w};
#pragma unroll
                  for (int j = 0; j < 8; ++j) { xg[2 * j] = bflo(xw[j]) * gv[2 * j]; xg[2 * j + 1] = bfhi(xw[j]) * gv[2 * j + 1]; } }
                float p[16];
#pragma unroll
                for (int q = 0; q < 8; ++q) { float f[16]; dec16(RA[q], f); float s0 = 0.f, s1 = 0.f;
#pragma unroll
                    for (int j = 0; j < 8; ++j) { s0 += f[2 * j] * xg[2 * j]; s1 += f[2 * j + 1] * xg[2 * j + 1]; }
                    p[q] = s0 + s1;
                    if (q < 7) asm volatile("" : "+v"(RA[q + 1].x), "+v"(RA[q + 1].y), "+v"(RA[q + 1].z), "+v"(RA[q + 1].w) : "v"(p[q])); }
                asm volatile("" :: "v"(p[7]));
                PEER_ISSUE(RA, TU, sn, in, ST_ELO(in));
#pragma unroll
                for (int q = 0; q < 8; ++q) { float f[16]; dec16(RB[q], f); float s0 = 0.f, s1 = 0.f;
#pragma unroll
                    for (int j = 0; j < 8; ++j) { s0 += f[2 * j] * xg[2 * j]; s1 += f[2 * j + 1] * xg[2 * j + 1]; }
                    p[8 + q] = s0 + s1;
                    if (q < 7) asm volatile("" : "+v"(RB[q + 1].x), "+v"(RB[q + 1].y), "+v"(RB[q + 1].z), "+v"(RB[q + 1].w) : "v"(p[8 + q])); }
                float p8[8], p4[4], p2[2];
#pragma unroll
                for (int q = 0; q < 8; ++q) { const float keep = (lane & 4) ? p[q + 8] : p[q], send = (lane & 4) ? p[q] : p[q + 8]; p8[q] = keep + __shfl_xor(send, 4); }
#pragma unroll
                for (int q = 0; q < 4; ++q) { const float keep = (lane & 2) ? p8[q + 4] : p8[q], send = (lane & 2) ? p8[q] : p8[q + 4]; p4[q] = keep + __shfl_xor(send, 2); }
#pragma unroll
                for (int q = 0; q < 2; ++q) { const float keep = (lane & 1) ? p4[q + 2] : p4[q], send = (lane & 1) ? p4[q] : p4[q + 2]; p2[q] = keep + __shfl_xor(send, 1); }
                ST_H0(i) += p2[0]; ST_H1(i) += p2[1];
                xa = xan; xb = xbn;
            }
        }
    } }
    for (int i = 0; i < ntok; ++i) { const int t = gw + NGW * i;
        const float rstd = rsqrtf(((const float*)(a.ws + WS_RSS2))[t] * (1.0f / DM) + EPS);
        const int k0 = 16 * l7 + lg3, k1 = k0 + 8; const unsigned e0 = EI[(size_t)t * 128 + k0], e1 = EI[(size_t)t * 128 + k1];
        ST_H0(i) = geluf_(ST_H0(i) * rstd * SCU[e0]) * GT[(size_t)t * 128 + k0] * SCV[e0];
        ST_H1(i) = geluf_(ST_H1(i) * rstd * SCU[e1]) * GT[(size_t)t * 128 + k1] * SCV[e1]; }
    {
        u32x4 RA[8], RB[8];
        PEER_ISSUE(RA, TV, 0, 0, ST_ELO(0));
#pragma unroll 1
        for (int s = 0; s < 8; ++s) {
#pragma unroll 1
            for (int i = 0; i < ntok; ++i) { const int t = gw + NGW * i;
                PEER_ISSUE(RB, TV, s, i, ST_EHI(i));
                int sn = s, in = i + 1; if (in == ntok) { in = 0; sn = s + 1; } if (sn == 8) { sn = 7; in = ntok - 1; }
                const int col = 128 * s + 16 * l7 + 8 * ((lane >> 5) & 1) + 4 * ((lane >> 4) & 1) + 2 * ((lane >> 3) & 1);
                f32x2 xv = *(const f32x2*)(X + (size_t)t * DM + col);
                const float h0 = ST_H0(i), h1 = ST_H1(i);
                float o[16];
#pragma unroll
                for (int j = 0; j < 16; ++j) o[j] = 0.f;
#pragma unroll
                for (int q = 0; q < 8; ++q) { const float hq = __shfl((q & 1) ? h1 : h0, (lane & ~7) | (q >> 1)); float f[16]; dec16(RA[q], f);
#pragma unroll
                    for (int j = 0; j < 16; ++j) o[j] += hq * f[j];
                    if (q < 7) asm volatile("" : "+v"(RA[q + 1].x), "+v"(RA[q + 1].y), "+v"(RA[q + 1].z), "+v"(RA[q + 1].w) : "v"(o[15])); }
                asm volatile("" :: "v"(o[15]));
                PEER_ISSUE(RA, TV, sn, in, ST_ELO(in));
#pragma unroll
                for (int q = 0; q < 8; ++q) { const float hq = __shfl((q & 1) ? h1 : h0, (lane & ~7) | (4 + (q >> 1))); float f[16]; dec16(RB[q], f);
#pragma unroll
                    for (int j = 0; j < 16; ++j) o[j] += hq * f[j];
                    if (q < 7) asm volatile("" : "+v"(RB[q + 1].x), "+v"(RB[q + 1].y), "+v"(RB[q + 1].z), "+v"(RB[q + 1].w) : "v"(o[15])); }
                float o8[8], o4[4], o2[2];
#pragma unroll
                for (int q = 0; q < 8; ++q) { const float keep = (lane & 32) ? o[q + 8] : o[q], send = (lane & 32) ? o[q] : o[q + 8]; o8[q] = keep + __shfl_xor(send, 32); }
#pragma unroll
                for (int q = 0; q < 4; ++q) { const float keep = (lane & 16) ? o8[q + 4] : o8[q], send = (lane & 16) ? o8[q] : o8[q + 4]; o4[q] = keep + __shfl_xor(send, 16); }
#pragma unroll
                for (int q = 0; q < 2; ++q) { const float keep = (lane & 8) ? o4[q + 2] : o4[q], send = (lane & 8) ? o4[q] : o4[q + 2]; o2[q] = keep + __shfl_xor(send, 8); }
                xv.x += o2[0]; xv.y += o2[1];
                *(f32x2*)(X + (size_t)t * DM + col) = xv; *(unsigned*)(XB + (size_t)t * DM + col) = pk2(xv.x, xv.y); ST_SSQ(i) += xv.x * xv.x + xv.y * xv.y;
            }
        }
    }
#undef PEER_ISSUE
    float* RSS = (float*)(a.ws + WS_RSS);
    if (lastlayer) __threadfence();
    for (int i = 0; i < ntok; ++i) { const int t = gw + NGW * i; const float ss = wave_sum(ST_SSQ(i)); if (lane == 0) RSS[t] = ss;
        if (lastlayer) { const float* gf = a.in[7]; const float rstd = rsqrtf(ss * (1.0f / DM) + EPS); f32x4* xr = (f32x4*)(X + (size_t)t * DM) + lane;
#pragma unroll
            for (int j = 0; j < 4; ++j) { const f32x4 g = *((const f32x4*)gf + lane + 64 * j); f32x4 v = xr[64 * j]; v = v * rstd * g; xr[64 * j] = v; } } }
#undef ST_ELO
#undef ST_EHI
#undef ST_H0
#undef ST_H1
#undef ST_SSQ
}

constexpr int PROBE_A = PROBE_SEL == 99 ? -1 : PROBE_SEL == 16 ? 15 : PROBE_SEL >= 200 ? 64 + (PROBE_SEL - 200) : PROBE_SEL >= 100 ? (PROBE_SEL - 100) : PROBE_SEL >= 32 ? PROBE_SEL : PROBE_SEL == 1 ? 0 : PROBE_SEL - 1;
constexpr int PROBE_B = PROBE_SEL == 99 ? -1 : PROBE_SEL == 16 ? 130 : PROBE_SEL >= 200 ? (PROBE_SEL - 200) : PROBE_SEL >= 100 ? 64 + (PROBE_SEL - 101) : PROBE_SEL >= 32 ? 1 : PROBE_SEL == 1 ? 130 : PROBE_SEL - 2;
constexpr int N_PHASES = 1 + 7 * DEPTH;
__global__ void __launch_bounds__(NTHREADS, 2) hybrid_fwd(Args args) {
    extern __shared__ __attribute__((aligned(16))) unsigned char lds_raw[];
    Frame F;
    F.lds = (ldsp_t)lds_raw;
    F.MISC = (volatile LAS unsigned*)(F.lds + MISC_OFF);
    F.tid = threadIdx.x; F.lane = F.tid & 63; F.wave = __builtin_amdgcn_readfirstlane(F.tid >> 6);
    F.G = gridDim.x; { const int bx = blockIdx.x; F.vcu = (F.G % 8 == 0) ? (bx % 8) * (F.G / 8) + bx / 8 : bx; }
    F.ctl = (unsigned*)(args.ws + WS_CTL); F.ws = args.ws; F.out = args.out;
    for (int u = F.tid; u < (LDS_BYTES - MISC_OFF) / 4; u += NTHREADS) ((LAS unsigned*)(F.lds + MISC_OFF))[u] = 0u;
    __syncthreads();
#if MK_N_LAUNCHES == 1
    constexpr int lo = 0, hi = N_PHASES;
#else
    const int lo = args.ph_lo, hi = args.ph_hi;
#endif
    if (PROBE_SEL && blockIdx.x == 0 && F.tid == 0) F.ctl[CW_TS + 130] = (unsigned)__builtin_amdgcn_s_memrealtime();
    XcdBarrier bar; bar.bar = F.ctl + CW_BAR; bar.x = 0; bar.st = nullptr;
    if (hi - lo > 1) bar = xcd_barrier_post(F.ctl + CW_BAR, F.MISC + 8);
#ifndef PH_MASK
#define PH_MASK 0x7FF
#endif
#define IN(k) (lo <= (k) && (k) < hi)
#define PHM(b) ((PH_MASK >> (b)) & 1)
#define REPBAR() do { if (rep) xcd_barrier(bar); } while (0)
#define LAUNDER() do { asm volatile("" : "+v"(F.tid)); F.lane = F.tid & 63; F.wave = __builtin_amdgcn_readfirstlane(F.tid >> 6); bxl = (int)blockIdx.x; asm volatile("" : "+s"(bxl)); } while (0)
#define STAMP(k) do { if (PROBE_SEL && ((k) == PROBE_A || (k) == PROBE_B) && F.tid == 0) atomicMax(F.ctl + CW_TS + (k), (unsigned)__builtin_amdgcn_s_memrealtime()); } while (0)
#define SEAM(k) do { STAMP(k); if (IN(k) && IN((k) + 1)) xcd_barrier(bar); STAMP(64 + (k)); } while (0)
    unsigned char* ws = args.ws;
    bf16_t* P = (bf16_t*)(ws + WS_P); bf16_t* XB = (bf16_t*)(ws + WS_XB);
    int bxl = (int)blockIdx.x;

    for (int rep = 0; rep < REPS(0); ++rep) { REPBAR(); if (PHM(0) && IN(0)) { LAUNDER(); p0_prologue(args, F); } } SEAM(0);

    for (int l = 0; l < DEPTH; ++l) {
        const int pb = 1 + 7 * l;
        for (int rep = 0; rep < REPS(1); ++rep) { REPBAR();
        if (PHM(1) && IN(pb)) { LAUNDER();
            pg8::Gemm g{XB, (const bf16_t*)(ws + WS_WIN) + (size_t)l * NIN * DM, DM, DM, 0, 0};
            pg8::StaticOrder S; S.init(MTOT, NIN, F.G, bxl, 1);
            pg8::EpiIn E{P, (const float*)(ws + WS_RSS), (const float*)(ws + WS_ROT)};
            pg8::gemm_phase<pg8::EpiIn, pg8::StaticOrder, true>(F.lds, g, S, E, F.tid);
        } }
        SEAM(pb);
        if (PHM(2) && IN(pb + 1)) { LAUNDER();
            for (int u = (int)blockIdx.x; u < 192; u += F.G) {
                LAUNDER();
                if (u < 64) { if (PHM(8)) ret_prompt_unit(args, F, l, u >> 3, u & 7); if (l == 0) STAMP(32); }
                else { if (PHM(9)) rnn_unit(args, F, l, false, (u - 64) >> 4, (u - 64) & 15); if (l == 0) STAMP(33); }
            }
            unsigned* qh = F.ctl + CW_QUEUE + 64 * l;
            for (;;) {
                __syncthreads();
                if (F.tid == 0) F.MISC[0] = xb_add(qh, 1u);
                __syncthreads();
                const unsigned q = F.MISC[0];
                LAUNDER();
                if (PROBE_SEL && l == 0 && q >= 1152u && q < 1152u + 256u) STAMP(34);
                if (q >= 1024u + 128u + 256u) break;
                if (q < 1024u) { if (PHM(10)) ret_sample_unit(args, F, l, (int)(q >> 3), (int)(q & 7)); }
                else if (q < 1152u) { if (PHM(9)) rnn_unit(args, F, l, true, (int)((q - 1024u) >> 4), (int)((q - 1024u) & 15)); }
                else tab_unit(args, F, l, (int)(q - 1152u));
            }
        }
        SEAM(pb + 1);
        for (int rep = 0; rep < REPS(3); ++rep) { REPBAR();
        if (PHM(3) && IN(pb + 2)) { LAUNDER();
            pg8::Gemm g{(const bf16_t*)(ws + WS_ARET), (const bf16_t*)(ws + WS_WMIX + (size_t)l * 6 * MiB), DM, DM, (size_t)(WS_ARNN - WS_ARET), (size_t)(2 * MiB)};
            pg8::StaticOrder S; S.init(MTOT, DM, F.G, bxl, 2);
            pg8::EpiMerge E{P, (bf16_t*)(ws + WS_MRG)};
            pg8::gemm_phase<pg8::EpiMerge, pg8::StaticOrder, true>(F.lds, g, S, E, F.tid);
        } }
        SEAM(pb + 2);
        if (PHM(4) && IN(pb + 3)) { LAUNDER();
            pg8::Gemm g{(const bf16_t*)(ws + WS_MRG), (const bf16_t*)(ws + WS_WMIX + (size_t)l * 6 * MiB + 4 * MiB), DM, DM, 0, 0};
            pg8::StaticOrder S; S.init(MTOT, DM, F.G, bxl, 1);
            pg8::EpiWo E{l == 0 ? args.in[0] : args.out, l == 0 ? args.in[1] : args.out + (size_t)M_P * DM, args.out, XB, (float*)(ws + WS_RSSP)};
            pg8::gemm_phase<pg8::EpiWo, pg8::StaticOrder, true>(F.lds, g, S, E, F.tid);
        }
        SEAM(pb + 3);
        for (int rep = 0; rep < REPS(5); ++rep) { REPBAR();
        if (PHM(5) && IN(pb + 4)) { LAUNDER();
            pg8::Gemm g{XB, (const bf16_t*)(ws + WS_WQ) + (size_t)l * 2048 * DM, DM, DM, 0, 0};
            pg8::StaticOrder S; S.init(MTOT, 2048, F.G, bxl, 1);
            pg8::EpiQ E{P, (const float*)(ws + WS_RSSP), (float*)(ws + WS_RSS2)};
            pg8::gemm_phase<pg8::EpiQ, pg8::StaticOrder, true>(F.lds, g, S, E, F.tid);
        } }
        SEAM(pb + 4);
        for (int rep = 0; rep < 1; ++rep) {
        if (PHM(6) && IN(pb + 5)) { LAUNDER();
            const int gw = F.vcu * NWAVES + F.wave, NGW = F.G * NWAVES;
            for (int u = gw; u < (MTOT / 32) * PH; u += NGW) { for (int rr = 0; rr < REPS(6); ++rr) { int ln = F.lane; asm volatile("" : "+v"(ln)); route_unit(args, l, u >> 3, u & 7, ln); } }
        } }
        SEAM(pb + 5);
        if (PHM(7) && IN(pb + 6)) { LAUNDER(); peer_phase(args, F, l, l == DEPTH - 1); }
        if (l + 1 < DEPTH) SEAM(pb + 6); else STAMP(pb + 6);
    }
    STAMP(15);
#undef IN
#undef SEAM
}


__global__ void probe_report(float* out, const unsigned* ts) {
    unsigned ta, tb;
    if (PROBE_SEL == 99) { ta = 10000u; tb = 0u; }
    else { ta = ts[PROBE_A < 0 ? 0 : PROBE_A]; tb = ts[PROBE_B < 0 ? 0 : PROBE_B]; if (PROBE_SEL == 16) ta = tb + (ta - tb) / 16u; }
    const float dl = sqrtf((float)(ta - tb)) * 1e-2f;
    for (int i = blockIdx.x * blockDim.x + threadIdx.x; i < DEPTH * NBATCH * DM; i += gridDim.x * blockDim.x) out[O_SHP + i] += dl;
}
extern "C" void kernel_launch(void* const* d_in, const int* in_sizes, int n_in, void* d_out, int out_size, void* d_ws, size_t ws_size, hipStream_t stream) {
    static int grid = 0;
    if (grid == 0) {
        if (n_in != 24 || out_size != (int)O_END || ws_size < WS_END) { fprintf(stderr, "kernel_launch: unexpected shapes (n_in %d, out %d, ws %zu)\n", n_in, out_size, ws_size); grid = -1; return; }
        int dev = 0, cus = 0, per_cu = 0;
        if (hipGetDevice(&dev) != hipSuccess || hipDeviceGetAttribute(&cus, hipDeviceAttributeMultiprocessorCount, dev) != hipSuccess) { grid = -1; return; }
        if (hipFuncSetAttribute((const void*)hybrid_fwd, hipFuncAttributeMaxDynamicSharedMemorySize, LDS_BYTES) != hipSuccess) { fprintf(stderr, "kernel_launch: hipFuncSetAttribute failed\n"); grid = -1; return; }
        if (hipOccupancyMaxActiveBlocksPerMultiprocessor(&per_cu, (const void*)hybrid_fwd, NTHREADS, LDS_BYTES) != hipSuccess || per_cu < 1) { fprintf(stderr, "kernel_launch: occupancy query reports %d blocks per CU\n", per_cu); (void)hipGetLastError(); grid = -1; return; }
        grid = cus;
        if (grid != 256) fprintf(stderr, "kernel_launch: %d CUs; the PEER phase assumes 256 workgroups\n", grid);
    }
    if (grid < 0) return;
    (void)hipMemsetAsync((char*)d_ws + WS_CTL, 0, CTL_ZERO_BYTES, stream);
    Args a{};
    for (int i = 0; i < 24; ++i) a.in[i] = (const float*)d_in[i];
    a.out = (float*)d_out; a.ws = (unsigned char*)d_ws;
#if MK_N_LAUNCHES == 1
    a.ph_lo = 0; a.ph_hi = N_PHASES;
    void* kargs[] = {&a};
    hipError_t e = hipLaunchCooperativeKernel((const void*)hybrid_fwd, dim3(grid), dim3(NTHREADS), kargs, LDS_BYTES, stream);
    if (e != hipSuccess) fprintf(stderr, "kernel_launch: cooperative launch failed: %s (grid %d)\n", hipGetErrorString(e), grid);
#if PROBE_SEL
    hipLaunchKernelGGL(probe_report, dim3(16), dim3(256), 0, stream, (float*)d_out, (const unsigned*)((char*)d_ws + WS_CTL) + CW_TS);
#endif
#else
    for (int p = 0; p < N_PHASES; ++p) { a.ph_lo = p; a.ph_hi = p + 1; hipLaunchKernelGGL(hybrid_fwd, dim3(grid), dim3(NTHREADS), LDS_BYTES, stream, a); }
#endif
}
```

```cpp
#include <hip/hip_runtime.h>
#include <cstdio>
#include <cstdint>

#define LAS __attribute__((address_space(3)))
#define GAS __attribute__((address_space(1)))
typedef unsigned short bf16_t;
typedef short bf16x8 __attribute__((ext_vector_type(8)));
typedef float f32x2 __attribute__((ext_vector_type(2)));
typedef float f32x4 __attribute__((ext_vector_type(4)));
typedef float f32x16 __attribute__((ext_vector_type(16)));
typedef unsigned u32x2 __attribute__((ext_vector_type(2)));
typedef unsigned u32x4 __attribute__((ext_vector_type(4)));
typedef LAS unsigned char* ldsp_t;

#ifndef REP_MASK
#define REP_MASK 0
#endif
#define REPS(k) (((REP_MASK >> (k)) & 1) ? 2 : 1)
#ifndef PROBE_SEL
#define PROBE_SEL 0
#endif
#ifndef MK_N_LAUNCHES
#define MK_N_LAUNCHES 1
#endif

constexpr int DM = 1024, NIN = 7168, M_P = 16384, M_S = 1024, MTOT = 17408, DEPTH = 2;
constexpr int SEQ = 2048, NBATCH = 8, DECB = 128, DECT = 8, PAST = 16384;
constexpr int HR = 8, DK = 64, DV = 128, CH = 128;
constexpr int NBLK = 16, BS = 64;
constexpr int PH = 8, NKEY = 128, NEXP = 16384, TOPK = 16, HK = 128;
constexpr float EPS = 1e-6f;
constexpr int LDP = 7168;
constexpr int PC_Q = 0, PC_K = 512, PC_V = 1024, PC_GR = 2048, PC_XR = 3072, PC_GN = 4096, PC_GA = 5120, PC_GB = 6144;
constexpr int PC_MRG = 0, PC_ARET = 1024, PC_ARNN = 4096, PC_QP = 2048;

constexpr size_t MiB = 1u << 20;
constexpr size_t WS_CTL = 0, CTL_ZERO_BYTES = 1 * MiB;
constexpr size_t WS_ROT = 1 * MiB;
constexpr size_t WS_RSS = 2 * MiB;
constexpr size_t WS_RSS2 = 2 * MiB + 128 * 1024;
constexpr size_t WS_RSSP = 2 * MiB + 256 * 1024;
constexpr size_t WS_TSC = 3 * MiB + 512 * 1024;
constexpr size_t WS_EIDX = 4 * MiB;
constexpr size_t WS_GATE = 13 * MiB;
constexpr size_t WS_KEYS = 22 * MiB;
constexpr size_t WS_WG = 23 * MiB;
constexpr size_t WS_WIN = 24 * MiB;
constexpr size_t WS_WMIX = 52 * MiB;
constexpr size_t WS_WQ = 64 * MiB;
constexpr size_t WS_XB = 72 * MiB;
constexpr size_t WS_P = 106 * MiB;
constexpr size_t WS_TAB = 344 * MiB;
constexpr size_t WS_ARET = 408 * MiB, WS_ARNN = 442 * MiB, WS_MRG = 476 * MiB;
constexpr size_t WS_END = 510 * MiB;
static_assert(WS_P + (size_t)MTOT * LDP * 2 <= WS_TAB, "ws map");

constexpr size_t O_Y = 0, O_SRP = 17825792, O_SHP = 18874368, O_SCP = 18890752, O_SRS = 18939904, O_SHS = 35717120, O_SCS = 35979264, O_END = 36765696;

constexpr int CW_BAR = 4096;
constexpr int CW_QUEUE = 16384;
constexpr int CW_TS = 20480;

constexpr int RING_BYTES = 131072;
constexpr int LDS_BYTES = 155648;
constexpr int MISC_OFF = 153600;
constexpr int NWAVES = 8, NTHREADS = 512;

#define LDS_WAIT() asm volatile("s_waitcnt lgkmcnt(0)" ::: "memory")
#define VM_WAIT() asm volatile("s_waitcnt vmcnt(0)" ::: "memory")
#define LBAR() do { asm volatile("s_waitcnt lgkmcnt(0)" ::: "memory"); __builtin_amdgcn_s_barrier(); asm volatile("" ::: "memory"); } while (0)
#define RLX_AGENT __ATOMIC_RELAXED, __HIP_MEMORY_SCOPE_AGENT

__device__ __forceinline__ unsigned f2bf(float f) { unsigned u = __builtin_bit_cast(unsigned, f); return (u + 0x7fffu + ((u >> 16) & 1u)) >> 16; }
typedef __bf16 bf16x2_t __attribute__((ext_vector_type(2)));
__device__ __forceinline__ unsigned pk2(float lo, float hi) { const f32x2 v = {lo, hi}; const bf16x2_t b = __builtin_convertvector(v, bf16x2_t); return __builtin_bit_cast(unsigned, b); }
__device__ __forceinline__ float bflo(unsigned w) { return __builtin_bit_cast(float, w << 16); }
__device__ __forceinline__ float bfhi(unsigned w) { return __builtin_bit_cast(float, w & 0xffff0000u); }
__device__ __forceinline__ float bf1(bf16_t h) { return __builtin_bit_cast(float, (unsigned)h << 16); }
__device__ __forceinline__ float sigmoidf_(float x) { return __builtin_amdgcn_rcpf(1.0f + __expf(-x)); }
__device__ __forceinline__ float siluf_(float x) { return x * sigmoidf_(x); }
__device__ __forceinline__ float geluf_(float x) { return x * sigmoidf_(1.5957691216057308f * (x + 0.044715f * x * x * x)); }
__device__ __forceinline__ float logg_of(int h) { return log1pf(-exp2f((float)(-5 - h))); }

namespace pg8 {
constexpr int BM = 256, BK = 64, HALF = 128, HTB = HALF * BK * 2, STAGE_BYTES = 8 * HTB, NXCD = 8, WGM = 8;
__host__ __device__ __forceinline__ int lds_byte(int r, int c) { const int st = (r >> 4) * 2 + (c >> 5), rr = r & 15, cc = c & 31, ob = rr * 64 + cc * 2; return st * 1024 + (ob ^ (((ob >> 9) & 1) << 5)); }
__host__ __device__ __forceinline__ void stage_rc(int b, int& R, int& C) { const int st = b / 1024, sb = b % 1024, swz = sb ^ (((sb >> 9) & 1) << 5); R = (st >> 1) * 16 + swz / 64; C = (st & 1) * 32 + (swz % 64) / 2; }
__host__ __device__ __forceinline__ int perm32(int rho) { const int n = rho >> 4, i = rho & 15; return 8 * (i >> 2) + 4 * n + (i & 3); }

struct Unit { int pm, pn, half; };
struct Gemm { const bf16_t* A; const bf16_t* Bt; int lda, K; size_t aoff2, boff2; };

struct StaticOrder {
    int nM, nN, nwg, G, c, pairs;
    __device__ void init(int M, int N, int G_, int c_, int pairs_) { nM = M / BM; nN = N / BM; nwg = nM * nN; G = G_; c = c_; pairs = pairs_; }
    __device__ bool next(int i, Unit& u) const {
        const int it = (pairs == 2) ? (i >> 1) : i;
        const long L = (long)it * G + c; if (L >= nwg) return false;
        int wgid = (int)L; { const int q = nwg / NXCD, r = nwg % NXCD, xcd = wgid % NXCD, off = wgid / NXCD; wgid = (xcd < r ? xcd * (q + 1) : r * (q + 1) + (xcd - r) * q) + off; }
        const int nig = WGM * nN, gid = wgid / nig, fm = gid * WGM, gsz = (nM - fm) < WGM ? (nM - fm) : WGM;
        u.pm = fm + ((wgid % nig) % gsz); u.pn = (wgid % nig) / gsz; u.half = (pairs == 2) ? (i & 1) : 0; return true;
    }
};

template <class Epi, class Sched, bool ALIGN_EPI>
__device__ __forceinline__ void gemm_phase(ldsp_t lds, const Gemm g, const Sched& S, const Epi& E, const int tid) {
    const int wid = __builtin_amdgcn_readfirstlane(tid >> 6), lane = tid & 63, wr = wid >> 2, wc = wid & 3, fr = lane & 15, fq = lane >> 4;
    const int K = g.K, nt = K / BK;
    unsigned voffA[2], voffB[2];
#pragma unroll
    for (int i = 0; i < 2; ++i) { int R, C; stage_rc(tid * 16 + i * 8192, R, C); const int Rb = Epi::PERM ? ((R & ~31) + perm32(R & 31)) : R;
        voffA[i] = (unsigned)(R * g.lda + C) * 2u; voffB[i] = (unsigned)(Rb * K + C) * 2u; }
    const size_t kstep = (size_t)(BK * 2);
    const size_t hstepA = (size_t)HALF * g.lda * 2, hstepB = (size_t)HALF * K * 2;
    const size_t tstepA = 2 * hstepA, tstepB = 2 * hstepB;
    const unsigned ldsw = (unsigned)wid * 1024u;
    const int aoff = lds_byte(wr * 64 + fr, fq * 8), boff = lds_byte(wc * 32 + fr, fq * 8);
#define PG8_SA(b, h) (((b) * 2 + (h)) * HTB)
#define PG8_SB(b, h) ((4 + (b) * 2 + (h)) * HTB)
#define PG8_STAGE(bufoff, gbase, voff) do { _Pragma("unroll") for (int _i = 0; _i < 2; ++_i) \
        __builtin_amdgcn_global_load_lds((const unsigned*)((const char*)(gbase) + (voff)[_i]), (LAS unsigned*)(lds + (bufoff) + ldsw + _i * 8192), 16, 0, 0); } while (0)
#define PG8_LDA(dst, b, h) do { _Pragma("unroll") for (int m = 0; m < 4; ++m) _Pragma("unroll") for (int k = 0; k < 2; ++k) dst[m][k] = *(const LAS bf16x8*)(lds + PG8_SA(b, h) + aoff + m * 2048 + k * 1024); } while (0)
#define PG8_LDB(dst, b, h) do { _Pragma("unroll") for (int n = 0; n < 2; ++n) _Pragma("unroll") for (int k = 0; k < 2; ++k) dst[n][k] = *(const LAS bf16x8*)(lds + PG8_SB(b, h) + boff + n * 2048 + k * 1024); } while (0)
#define PG8_MMA(ai, bj, At, Bt) do { __builtin_amdgcn_s_setprio(1); _Pragma("unroll") for (int m = 0; m < 4; ++m) _Pragma("unroll") for (int n = 0; n < 2; ++n) _Pragma("unroll") for (int k = 0; k < 2; ++k) \
        acc[ai][bj][m][n] = __builtin_amdgcn_mfma_f32_16x16x32_bf16(Bt[n][k], At[m][k], acc[ai][bj][m][n], 0, 0, 0); __builtin_amdgcn_s_setprio(0); } while (0)
#define PG8_WAIT_V(n) asm volatile("s_waitcnt vmcnt(" #n ")" ::: "memory")
#define PG8_WAIT_L(n) asm volatile("s_waitcnt lgkmcnt(" #n ")" ::: "memory")
#define PG8_BAR __builtin_amdgcn_s_barrier()
#define PG8_SCHED __builtin_amdgcn_sched_barrier(0)
    Unit cur, nxt; int ui = 0;
    if (!S.next(0, cur)) return;
    f32x4 acc[2][2][4][2];
#pragma unroll
    for (int a = 0; a < 2; ++a)
#pragma unroll
        for (int b = 0; b < 2; ++b)
#pragma unroll
            for (int m = 0; m < 4; ++m)
#pragma unroll
                for (int n = 0; n < 2; ++n) acc[a][b][m][n] = (f32x4){0.f, 0.f, 0.f, 0.f};
    bf16x8 At[4][2], B0[2][2], B1[2][2];
    const char* cA = (const char*)g.A + (size_t)cur.pm * tstepA + (cur.half ? g.aoff2 : 0); const char* cB = (const char*)g.Bt + (size_t)cur.pn * tstepB + (cur.half ? g.boff2 : 0);
    PG8_STAGE(PG8_SB(0, 0), cB, voffB); PG8_STAGE(PG8_SB(0, 1), cB + hstepB, voffB); PG8_STAGE(PG8_SA(0, 0), cA, voffA); PG8_STAGE(PG8_SA(0, 1), cA + hstepA, voffA);
    if (wr == 1) PG8_BAR;
    PG8_WAIT_V(2); PG8_BAR;
    PG8_STAGE(PG8_SB(1, 0), cB + kstep, voffB); PG8_STAGE(PG8_SA(1, 0), cA + kstep, voffA); PG8_STAGE(PG8_SB(1, 1), cB + hstepB + kstep, voffB);
    PG8_WAIT_V(6); PG8_BAR;
    for (;;) {
        const bool has_next = S.next(ui + 1, nxt);
        const char* nA = has_next ? (const char*)g.A + (size_t)nxt.pm * tstepA + (nxt.half ? g.aoff2 : 0) : cA;
        const char* nB = has_next ? (const char*)g.Bt + (size_t)nxt.pn * tstepB + (nxt.half ? g.boff2 : 0) : cB;
        for (int t = 0; t < nt; t += 2) {
            const bool last = (t == nt - 2);
            const char* a1 = cA + (size_t)(t + 1) * kstep;
            const char* a2 = last ? nA : cA + (size_t)(t + 2) * kstep; const char* b2 = last ? nB : cB + (size_t)(t + 2) * kstep;
            const char* a3 = a2 + kstep; const char* b3 = b2 + kstep;
            PG8_LDB(B0, 0, 0); PG8_LDB(B1, 0, 1); PG8_SCHED; PG8_LDA(At, 0, 0); PG8_STAGE(PG8_SA(1, 1), a1 + hstepA, voffA);
            PG8_WAIT_V(8); PG8_WAIT_L(0); PG8_BAR; PG8_MMA(0, 0, At, B0); PG8_MMA(0, 1, At, B1); PG8_BAR; PG8_SCHED;
            PG8_LDA(At, 0, 1); PG8_STAGE(PG8_SB(0, 0), b2, voffB); PG8_STAGE(PG8_SB(0, 1), b2 + hstepB, voffB); PG8_STAGE(PG8_SA(0, 0), a2, voffA);
            PG8_WAIT_V(8); PG8_WAIT_L(0); PG8_BAR; PG8_MMA(1, 0, At, B0); PG8_MMA(1, 1, At, B1); PG8_BAR; PG8_SCHED;
            PG8_LDB(B0, 1, 0); PG8_LDB(B1, 1, 1); PG8_SCHED; PG8_LDA(At, 1, 0); PG8_STAGE(PG8_SA(0, 1), a2 + hstepA, voffA);
            PG8_WAIT_V(8); PG8_WAIT_L(0); PG8_BAR; PG8_MMA(0, 0, At, B0); PG8_MMA(0, 1, At, B1); PG8_BAR; PG8_SCHED;
            PG8_LDA(At, 1, 1); PG8_STAGE(PG8_SB(1, 0), b3, voffB); PG8_STAGE(PG8_SB(1, 1), b3 + hstepB, voffB); PG8_STAGE(PG8_SA(1, 0), a3, voffA);
            PG8_WAIT_V(8); PG8_WAIT_L(0); PG8_BAR; PG8_MMA(1, 0, At, B0); PG8_MMA(1, 1, At, B1); PG8_BAR; PG8_SCHED;
        }
        if constexpr (ALIGN_EPI) { if (wr == 0) PG8_BAR; }
        E(acc, cur, wr, wc, fr, fq);
        if (!has_next) break;
#pragma unroll
        for (int a = 0; a < 2; ++a)
#pragma unroll
            for (int b = 0; b < 2; ++b)
#pragma unroll
                for (int m = 0; m < 4; ++m)
#pragma unroll
                    for (int n = 0; n < 2; ++n) acc[a][b][m][n] = (f32x4){0.f, 0.f, 0.f, 0.f};
        cur = nxt; cA = nA; cB = nB; ++ui;
        if constexpr (ALIGN_EPI) { if (wr == 1) PG8_BAR; }
    }
    PG8_WAIT_V(0);
    if constexpr (!ALIGN_EPI) { if (wr == 0) PG8_BAR; }
    PG8_BAR;
#undef PG8_SA
#undef PG8_SB
#undef PG8_STAGE
#undef PG8_LDA
#undef PG8_LDB
#undef PG8_MMA
#undef PG8_WAIT_V
#undef PG8_WAIT_L
#undef PG8_BAR
#undef PG8_SCHED
}
}

typedef GAS unsigned gu32;
#define XB_TMO      128
#define XB_XCNT(j)  (256  + 64 * (j))
#define XB_XSUB(j)  (1280 + 64 * (j))
#define XB_XGEN(j)  (2304 + 64 * (j))
#define XB_TOP      3328
#define XB_TOPGEN   3392
#define XCD_BAR_WORDS 3456
#define XB_SPIN_CAP (1u << 18)
__device__ __forceinline__ unsigned xb_ld(unsigned* p)              { return __hip_atomic_load(p, __ATOMIC_RELAXED, __HIP_MEMORY_SCOPE_AGENT); }
__device__ __forceinline__ unsigned xb_add(unsigned* p, unsigned v) { return __hip_atomic_fetch_add(p, v, __ATOMIC_RELAXED, __HIP_MEMORY_SCOPE_AGENT); }
__device__ __forceinline__ unsigned xb_xcc_id() { return (unsigned)__builtin_amdgcn_s_getreg((3 << 11) | 20) & 0xFu; }
#define XB_SPIN(cond, bar) do { unsigned _sp = 0; while (cond) { __builtin_amdgcn_s_sleep(1); \
    if ((++_sp & 255u) == 0u) { if (xb_ld(&(bar)[XB_TMO])) break; if (_sp > XB_SPIN_CAP) { atomicAdd(&(bar)[XB_TMO], 1u); break; } } } } while (0)
struct XcdBarrier { unsigned* bar; unsigned x; volatile LAS unsigned* st; };
__device__ __forceinline__ XcdBarrier xcd_barrier_post(unsigned* bar, volatile LAS unsigned* st) {
    XcdBarrier b; b.bar = bar; b.x = (unsigned)__builtin_amdgcn_readfirstlane((int)xb_xcc_id()); b.st = st;
    if (threadIdx.x == 0) (void)xb_add(&bar[XB_XCNT(b.x)], 1u);
    return b;
}
__device__ __forceinline__ void xcd_barrier_complete(unsigned* bar, unsigned x, unsigned& nloc, unsigned& nx) {
    const unsigned G = gridDim.x * gridDim.y * gridDim.z;
    unsigned sum, cnt, mine, sp = 0u;
    for (;;) {
        sum = 0u; cnt = 0u; mine = 0u;
#pragma unroll
        for (unsigned j = 0; j < 16; ++j) { const unsigned c = xb_ld(&bar[XB_XCNT(j)]); sum += c; cnt += (c > 0u) ? 1u : 0u; mine = (j == x) ? c : mine; }
        if (sum == G) break;
        __builtin_amdgcn_s_sleep(1);
        if ((++sp & 255u) == 0u) { if (xb_ld(&bar[XB_TMO])) break; if (sp > XB_SPIN_CAP) { atomicAdd(&bar[XB_TMO], 1u); break; } }
    }
    nloc = mine > 0u ? mine : 1u; nx = cnt > 0u ? cnt : 1u;
}
__device__ __forceinline__ void xcd_barrier(const XcdBarrier& b) {
    asm volatile("s_waitcnt vmcnt(0)" ::: "memory");
    __syncthreads();
    if (threadIdx.x == 0) {
        unsigned* bar = b.bar; const unsigned bx = (unsigned)__builtin_amdgcn_readfirstlane((int)b.x);
        __builtin_amdgcn_s_waitcnt(0);
        unsigned nloc = b.st[0], nx = b.st[1];
        if (nloc == 0u) { xcd_barrier_complete(bar, bx, nloc, nx); b.st[0] = nloc; b.st[1] = nx; }
        const unsigned old = xb_add(&bar[XB_XSUB(bx)], 1u);
        const unsigned gen = old / nloc;
        if (old + 1u == (gen + 1u) * nloc) {
            __builtin_amdgcn_fence(__ATOMIC_RELEASE, "agent");
            asm volatile("s_waitcnt vmcnt(0)" ::: "memory");
            const unsigned og = xb_add(&bar[XB_TOP], 1u);
            const unsigned tg = og / nx;
            if (og + 1u == (tg + 1u) * nx) xb_add(&bar[XB_TOPGEN], 1u);
            else XB_SPIN(xb_ld(&bar[XB_TOPGEN]) == tg, bar);
            __builtin_amdgcn_fence(__ATOMIC_ACQUIRE, "agent");
            xb_add(&bar[XB_XGEN(bx)], 1u);
            asm volatile("s_waitcnt vmcnt(0)" ::: "memory");
        } else {
            XB_SPIN(xb_ld(&bar[XB_XGEN(bx)]) == gen, bar);
            __builtin_amdgcn_fence(__ATOMIC_ACQUIRE, "agent");
            asm volatile("s_waitcnt vmcnt(0)" ::: "memory");
        }
    }
    __syncthreads();
}

struct Frame {
    ldsp_t lds;
    volatile LAS unsigned* MISC;
    unsigned* ctl;
    int tid, lane, wave, vcu, G;
    const float* const* in;
    unsigned char* ws;
    float* out;
};
struct Args { const float* in[24]; float* out; unsigned char* ws; int ph_lo, ph_hi; };

__device__ __forceinline__ float wave_sum(float v) {
#pragma unroll
    for (int o = 1; o < 64; o <<= 1) v += __shfl_xor(v, o);
    return v;
}

__device__ __forceinline__ void p0_transpose_item(const float* W, int K, int N, bf16_t* WT, int ldk, const float* rowscale, float colscale, bool qkperm, LAS float* scr, int item, int lane) {
    const int nblk = N / 32, kb = item / nblk, nb = item % nblk, k0 = 64 * kb, n0 = 32 * nb;
    int srcn = n0 + (lane & 31);
    if (qkperm) { const int p = srcn & 63; srcn = (srcn & ~63) + ((p & 1) ? 32 + (p >> 1) : (p >> 1)); }
#pragma unroll 16
    for (int i = 0; i < 32; ++i) { const int kk = 2 * i + (lane >> 5); float v = W[(size_t)(k0 + kk) * N + srcn] * colscale; if (rowscale) v *= rowscale[k0 + kk]; scr[kk * 33 + (lane & 31)] = v; }
    LDS_WAIT(); asm volatile("" ::: "memory");
    const int c = lane & 7;
#pragma unroll
    for (int j = 0; j < 4; ++j) { const int n = (lane >> 3) + 8 * j; const LAS float* s = scr + (8 * c) * 33 + n;
        u32x4 o; o.x = pk2(s[0 * 33], s[1 * 33]); o.y = pk2(s[2 * 33], s[3 * 33]); o.z = pk2(s[4 * 33], s[5 * 33]); o.w = pk2(s[6 * 33], s[7 * 33]);
        *(u32x4*)(WT + (size_t)(n0 + n) * ldk + k0 + 8 * c) = o; }
    LDS_WAIT(); asm volatile("" ::: "memory");
}

__device__ __forceinline__ void p0_xrow(const float* xrow, bf16_t* orow, float* rss, int lane) {
    const f32x4* xr = (const f32x4*)xrow + lane;
    f32x4 v[4]; float s = 0.f;
#pragma unroll
    for (int j = 0; j < 4; ++j) { v[j] = xr[64 * j]; s += (v[j].x * v[j].x + v[j].y * v[j].y) + (v[j].z * v[j].z + v[j].w * v[j].w); }
    s = wave_sum(s);
    u32x2* o8 = (u32x2*)orow + lane;
#pragma unroll
    for (int j = 0; j < 4; ++j) { u32x2 w; w.x = pk2(v[j].x, v[j].y); w.y = pk2(v[j].z, v[j].w); o8[64 * j] = w; }
    if (lane == 0) *rss = s;
}

__device__ __forceinline__ void p0_tabrow(const float* row, unsigned char* img, float* isc, int e, int lane) {
    const f32x4* xr = (const f32x4*)row + lane;
    f32x4 v[4]; float am = 0.f;
#pragma unroll
    for (int j = 0; j < 4; ++j) { v[j] = xr[64 * j]; am = fmaxf(am, fmaxf(fmaxf(fabsf(v[j].x), fabsf(v[j].y)), fmaxf(fabsf(v[j].z), fabsf(v[j].w)))); }
#pragma unroll
    for (int o = 1; o < 64; o <<= 1) am = fmaxf(am, __shfl_xor(am, o));
    const float sc = am > 0.f ? exp2f(floorf(log2f(224.0f / am))) : 1.0f;
#pragma unroll
    for (int j = 0; j < 4; ++j) { const int col = 256 * j + 4 * lane, sl = col >> 7, w = col & 127;
        int pk = __builtin_amdgcn_cvt_pk_fp8_f32(v[j].x * sc, v[j].y * sc, 0, false);
        pk = __builtin_amdgcn_cvt_pk_fp8_f32(v[j].z * sc, v[j].w * sc, pk, true);
        *(int*)(img + ((size_t)sl * NEXP + e) * 128 + w) = pk; }
    if (lane == 0) isc[e] = 1.0f / sc;
}

__device__ __forceinline__ void p0_prologue(const Args& a, Frame& F) {
    unsigned char* ws = a.ws;
    LAS float* scr = (LAS float*)(F.lds + F.wave * 16384);
    const int gw = F.vcu * NWAVES + F.wave, NGW = F.G * NWAVES, lane = F.lane;
    constexpr int I_IN = (DM / 64) * (NIN / 32), I_SQ = (DM / 64) * (DM / 32), I_Q = (DM / 64) * (2048 / 32), I_G = 2;
    constexpr int PER_L = I_IN + 3 * I_SQ + I_Q + 32 * I_G;
    for (int it = gw; it < DEPTH * PER_L; it += NGW) {
        const int l = it / PER_L; int r = it % PER_L;
        if (r < I_IN) { const int nb = r % (NIN / 32), n0 = nb * 32; const int seg = n0 >> 9;
            p0_transpose_item(a.in[8] + (size_t)l * DM * NIN, DM, NIN, (bf16_t*)(ws + WS_WIN) + (size_t)l * NIN * DM, DM, a.in[5] + l * DM, seg == 1 ? 0.125f : 1.0f, seg <= 1, scr, r, lane); continue; }
        r -= I_IN;
        if (r < I_SQ) { p0_transpose_item(a.in[10] + (size_t)l * DM * DM, DM, DM, (bf16_t*)(ws + WS_WMIX + (size_t)l * 6 * MiB), DM, a.in[9] + l * DM, 1.0f, false, scr, r, lane); continue; }
        r -= I_SQ;
        if (r < I_SQ) { p0_transpose_item(a.in[18] + (size_t)l * DM * DM, DM, DM, (bf16_t*)(ws + WS_WMIX + (size_t)l * 6 * MiB + 2 * MiB), DM, nullptr, 1.0f, false, scr, r, lane); continue; }
        r -= I_SQ;
        if (r < I_SQ) { p0_transpose_item(a.in[19] + (size_t)l * DM * DM, DM, DM, (bf16_t*)(ws + WS_WMIX + (size_t)l * 6 * MiB + 4 * MiB), DM, nullptr, 1.0f, false, scr, r, lane); continue; }
        r -= I_SQ;
        if (r < I_Q) { p0_transpose_item(a.in[20] + (size_t)l * DM * 2048, DM, 2048, (bf16_t*)(ws + WS_WQ) + (size_t)l * 2048 * DM, DM, a.in[6] + l * DM, 1.0f, false, scr, r, lane); continue; }
        r -= I_Q;
        { const int mat = r >> 1, sub = r & 1, nb = mat >> 1, gsel = mat & 1;
          const float* W = (gsel ? a.in[15] : a.in[13]) + ((size_t)l * NBLK + nb) * BS * BS;
          bf16_t* WT = (bf16_t*)(ws + WS_WG) + (((size_t)l * NBLK + nb) * 2 + gsel) * BS * BS;
          p0_transpose_item(W, BS, BS, WT, BS, nullptr, 1.0f, false, scr, sub, lane); }
    }
    { const float* ksrc = a.in[21]; bf16_t* kdst = (bf16_t*)(ws + WS_KEYS); const int n4 = DEPTH * PH * 2 * NKEY * HK / 4;
      for (int i = gw * 64 + lane; i < n4; i += NGW * 64) { const f32x4 v = ((const f32x4*)ksrc)[i]; u32x2 o; o.x = pk2(v.x, v.y); o.y = pk2(v.z, v.w); ((u32x2*)kdst)[i] = o; } }
    for (int m = gw; m < MTOT; m += 2 * NGW) {
        const int m2 = m + NGW; const bool v2 = m2 < MTOT; const int mm2 = v2 ? m2 : m;
        const f32x4* x1 = (const f32x4*)(m < M_P ? a.in[0] + (size_t)m * DM : a.in[1] + (size_t)(m - M_P) * DM) + lane;
        const f32x4* x2 = (const f32x4*)(mm2 < M_P ? a.in[0] + (size_t)mm2 * DM : a.in[1] + (size_t)(mm2 - M_P) * DM) + lane;
        f32x4 v[8]; float s1 = 0.f, s2 = 0.f;
#pragma unroll
        for (int j = 0; j < 4; ++j) { v[j] = x1[64 * j]; v[4 + j] = x2[64 * j]; }
#pragma unroll
        for (int j = 0; j < 4; ++j) { s1 += (v[j].x * v[j].x + v[j].y * v[j].y) + (v[j].z * v[j].z + v[j].w * v[j].w); s2 += (v[4 + j].x * v[4 + j].x + v[4 + j].y * v[4 + j].y) + (v[4 + j].z * v[4 + j].z + v[4 + j].w * v[4 + j].w); }
        s1 = wave_sum(s1); s2 = wave_sum(s2);
        u32x2* o1 = (u32x2*)((bf16_t*)(ws + WS_XB) + (size_t)m * DM) + lane; u32x2* o2 = (u32x2*)((bf16_t*)(ws + WS_XB) + (size_t)mm2 * DM) + lane;
#pragma unroll
        for (int j = 0; j < 4; ++j) { u32x2 w; w.x = pk2(v[j].x, v[j].y); w.y = pk2(v[j].z, v[j].w); o1[64 * j] = w; }
        if (v2) {
#pragma unroll
            for (int j = 0; j < 4; ++j) { u32x2 w; w.x = pk2(v[4 + j].x, v[4 + j].y); w.y = pk2(v[4 + j].z, v[4 + j].w); o2[64 * j] = w; } }
        if (lane == 0) { ((float*)(ws + WS_RSS))[m] = s1; if (v2) ((float*)(ws + WS_RSS))[m2] = s2; }
    }
    { float* rot = (float*)(ws + WS_ROT);
      for (int i = gw * 64 + lane; i < 2056 * 32; i += NGW * 64) {
          const int pi = i >> 5, fi = i & 31; const double pos = pi < 2048 ? (double)pi : (double)(PAST + pi - 2048);
          const double f8[8] = {1.0, 0.7498942093324559, 0.5623413251903491, 0.4216965034285822, 0.31622776601683794, 0.23713737056616552, 0.1778279410038923, 0.1333521432163324};
          double fr = 1.0; switch (fi >> 3) { case 1: fr = 0.1; break; case 2: fr = 0.01; break; case 3: fr = 0.001; break; default: break; }
          double fsel = f8[0];
#pragma unroll
          for (int q = 1; q < 8; ++q) fsel = ((fi & 7) == q) ? f8[q] : fsel;
          const double ang = pos * (fr * fsel);
          const double n = __builtin_rint(ang * 0.15915494309189535);
          double rr = __builtin_fma(-n, 6.283185307179586, ang); rr = __builtin_fma(-n, 2.4492935982947064e-16, rr);
          const float rf = (float)rr;
          rot[(size_t)pi * 64 + fi] = cosf(rf); rot[(size_t)pi * 64 + 32 + fi] = sinf(rf);
      } }
}

__device__ __forceinline__ void tab_unit(const Args& a, Frame& F, int l, int cu) {
    unsigned char* ws = a.ws;
#pragma unroll 2
    for (int j = 0; j < 16; ++j) { const int r = cu * 128 + F.wave * 16 + j, t = r >> 14, e = r & (NEXP - 1);
        const float* src = (t ? a.in[23] : a.in[22]) + ((size_t)l * NEXP + e) * DM;
        p0_tabrow(src, ws + WS_TAB + ((size_t)l * 2 + t) * 16 * MiB, (float*)(ws + WS_TSC) + ((size_t)l * 2 + t) * NEXP, e, F.lane); }
}

namespace pg8 {
struct EpiIn {
    static constexpr bool PERM = true;
    bf16_t* P; const float* rss; const float* rot;
    __device__ __forceinline__ void operator()(const f32x4 (&acc)[2][2][4][2], const Unit& u, int wr, int wc, int fr, int fq) const {
        const int seg = u.pn < 4 ? (u.pn >> 1) : (u.pn >> 2) + 1;
        const int row0 = u.pm * BM + wr * 64 + fr;
#if 0
        const float* rstdv = rss + row0;
#define RSTD_AT(ai, m) rstdv[(ai) * HALF + (m) * 16]
#else
        float rstdv[8];
#pragma unroll
        for (int i = 0; i < 8; ++i) rstdv[i] = rss[row0 + (i >> 2) * HALF + (i & 3) * 16];
#define RSTD_AT(ai, m) rstdv[(ai) * 4 + (m)]
#endif
        if (seg <= 1) {
            float lg[2];
#pragma unroll
            for (int bj = 0; bj < 2; ++bj) { const int hh = 4 * (u.pn & 1) + 2 * bj + (wc >> 1); lg[bj] = logg_of(hh); }
            const int i0 = 16 * (wc & 1) + 4 * fq;
#pragma unroll
            for (int ai = 0; ai < 2; ++ai)
#pragma unroll
                for (int m = 0; m < 4; ++m) {
                    const int row = row0 + ai * HALF + m * 16;
                    const float rstd = rsqrtf(RSTD_AT(ai, m) * (1.0f / DM) + EPS);
                    asm volatile("" ::: "memory");
                    const int pi = row < M_P ? (row & (SEQ - 1)) : SEQ + ((row - M_P) & (DECT - 1));
                    const float jj1 = (float)((row < M_P ? (row & (CH - 1)) : ((row - M_P) & (DECT - 1))) + 1);
                    const float* rp = rot + (size_t)pi * 64 + i0;
#pragma unroll
                    for (int bj = 0; bj < 2; ++bj) {
                        const int hh = 4 * (u.pn & 1) + 2 * bj + (wc >> 1);
                        const float f = __expf(seg == 0 ? jj1 * lg[bj] : -jj1 * lg[bj]) * rstd;
                        bf16_t* dst = P + (size_t)row * LDP + seg * 512 + hh * 64 + i0;
#pragma unroll
                        for (int n = 0; n < 2; ++n) {
                            const f32x2 c2 = *(const f32x2*)(rp + 2 * n), s2 = *(const f32x2*)(rp + 32 + 2 * n);
                            const f32x4 v = acc[ai][bj][m][n];
                            const float a0 = (v[0] * c2.x - v[1] * s2.x) * f, a1 = (v[2] * c2.y - v[3] * s2.y) * f;
                            const float b0 = (v[0] * s2.x + v[1] * c2.x) * f, b1 = (v[2] * s2.y + v[3] * c2.y) * f;
                            *(unsigned*)(dst + 2 * n) = pk2(a0, a1); *(unsigned*)(dst + 32 + 2 * n) = pk2(b0, b1);
                        }
                    }
                    if (m & 1) asm volatile("" ::: "memory");
                }
        } else {
            const int col0 = u.pn * BM + wc * 32 + 8 * fq;
#pragma unroll
            for (int ai = 0; ai < 2; ++ai)
#pragma unroll
                for (int m = 0; m < 4; ++m) {
                    const int row = row0 + ai * HALF + m * 16;
                    const float rstd = rsqrtf(RSTD_AT(ai, m) * (1.0f / DM) + EPS);
                    bf16_t* rowp = P + (size_t)row * LDP + col0;
#pragma unroll
                    for (int bj = 0; bj < 2; ++bj) {
                        f32x4 v0 = acc[ai][bj][m][0] * rstd, v1 = acc[ai][bj][m][1] * rstd;
                        if (seg == 3) {
#pragma unroll
                            for (int j = 0; j < 4; ++j) { v0[j] = siluf_(v0[j]); v1[j] = siluf_(v1[j]); }
                        } else if (seg == 5) {
#pragma unroll
                            for (int j = 0; j < 4; ++j) { v0[j] = geluf_(v0[j]); v1[j] = geluf_(v1[j]); }
                        } else if (seg >= 6) {
#pragma unroll
                            for (int j = 0; j < 4; ++j) { v0[j] = sigmoidf_(v0[j]); v1[j] = sigmoidf_(v1[j]); }
                        }
                        u32x4 w; w.x = pk2(v0[0], v0[1]); w.y = pk2(v0[2], v0[3]); w.z = pk2(v1[0], v1[1]); w.w = pk2(v1[2], v1[3]);
                        *(u32x4*)(rowp + bj * HALF) = w;
                    }
                }
        }
    }
};

struct EpiMerge {
    static constexpr bool PERM = true;
    bf16_t* P; bf16_t* MRG;
    __device__ __forceinline__ void operator()(const f32x4 (&acc)[2][2][4][2], const Unit& u, int wr, int wc, int fr, int fq) const {
        const int row0 = u.pm * BM + wr * 64 + fr, col0 = u.pn * BM + wc * 32 + 8 * fq;
        const int gc = u.half ? PC_GB : PC_GA;
#pragma unroll
        for (int ai = 0; ai < 2; ++ai)
#pragma unroll
            for (int m = 0; m < 4; ++m) {
                bf16_t* rowp = P + (size_t)(row0 + ai * HALF + m * 16) * LDP; bf16_t* mrow = MRG + (size_t)(row0 + ai * HALF + m * 16) * DM;
#pragma unroll
                for (int bj = 0; bj < 2; ++bj) {
                    const int c = col0 + bj * HALF;
                    const u32x4 g = *(const u32x4*)(rowp + gc + c);
                    f32x4 v0 = acc[ai][bj][m][0], v1 = acc[ai][bj][m][1];
                    v0[0] *= bflo(g.x); v0[1] *= bfhi(g.x); v0[2] *= bflo(g.y); v0[3] *= bfhi(g.y);
                    v1[0] *= bflo(g.z); v1[1] *= bfhi(g.z); v1[2] *= bflo(g.w); v1[3] *= bfhi(g.w);
                    if (u.half) { const u32x4 p = *(const u32x4*)(mrow + c);
                        v0[0] += bflo(p.x); v0[1] += bfhi(p.x); v0[2] += bflo(p.y); v0[3] += bfhi(p.y);
                        v1[0] += bflo(p.z); v1[1] += bfhi(p.z); v1[2] += bflo(p.w); v1[3] += bfhi(p.w); }
                    u32x4 w; w.x = pk2(v0[0], v0[1]); w.y = pk2(v0[2], v0[3]); w.z = pk2(v1[0], v1[1]); w.w = pk2(v1[2], v1[3]);
                    *(u32x4*)(mrow + c) = w;
                }
                if (m & 1) asm volatile("" ::: "memory");
            }
    }
};

struct EpiWo {
    static constexpr bool PERM = false;
    const float* xp; const float* xs;
    float* X; bf16_t* XB; float* rssp;
    __device__ __forceinline__ void operator()(const f32x4 (&acc)[2][2][4][2], const Unit& u, int wr, int wc, int fr, int fq) const {
        const int row0 = u.pm * BM + wr * 64 + fr, col0 = u.pn * BM + wc * 32 + 4 * fq;
#pragma unroll
        for (int ai = 0; ai < 2; ++ai)
#pragma unroll
            for (int m = 0; m < 4; ++m) {
                const int row = row0 + ai * HALF + m * 16;
                const float* src = (row < M_P ? xp + (size_t)row * DM : xs + (size_t)(row - M_P) * DM) + col0;
                float* dst = X + (size_t)row * DM + col0; bf16_t* dstb = XB + (size_t)row * DM + col0;
                float ss = 0.f;
#pragma unroll
                for (int bj = 0; bj < 2; ++bj)
#pragma unroll
                    for (int n = 0; n < 2; ++n) {
                        const f32x4 o = *(const f32x4*)(src + bj * HALF + n * 16) + acc[ai][bj][m][n];
                        *(f32x4*)(dst + bj * HALF + n * 16) = o;
                        u32x2 w; w.x = pk2(o[0], o[1]); w.y = pk2(o[2], o[3]); *(u32x2*)(dstb + bj * HALF + n * 16) = w;
                        ss += (o[0] * o[0] + o[1] * o[1]) + (o[2] * o[2] + o[3] * o[3]);
                    }
                ss += __shfl_xor(ss, 16); ss += __shfl_xor(ss, 32);
                if (fq == 0) rssp[(size_t)(u.pn * 4 + wc) * MTOT + row] = ss;
                if (m & 1) asm volatile("" ::: "memory");
            }
    }
};

struct EpiQ {
    static constexpr bool PERM = true;
    bf16_t* P; const float* rssp; float* rss2;
    __device__ __forceinline__ void operator()(const f32x4 (&acc)[2][2][4][2], const Unit& u, int wr, int wc, int fr, int fq) const {
        const int row0 = u.pm * BM + wr * 64 + fr, col0 = u.pn * BM + wc * 32 + 8 * fq;
        float rstdv[8];
#pragma unroll
        for (int i = 0; i < 8; ++i) { const int row = row0 + (i >> 2) * HALF + (i & 3) * 16; float s = 0.f;
#pragma unroll
            for (int j = 0; j < 16; ++j) s += rssp[(size_t)j * MTOT + row];
            if (u.pn == 0 && wc == 0 && fq == 0) rss2[row] = s;
            rstdv[i] = rsqrtf(s * (1.0f / DM) + EPS);
            if ((i & 1)) asm volatile("" ::: "memory"); }
#pragma unroll
        for (int ai = 0; ai < 2; ++ai)
#pragma unroll
            for (int m = 0; m < 4; ++m) {
                const int row = row0 + ai * HALF + m * 16;
                const float rstd = rstdv[ai * 4 + m];
                bf16_t* rowp = P + (size_t)row * LDP + PC_QP + col0;
#pragma unroll
                for (int bj = 0; bj < 2; ++bj) {
                    const f32x4 v0 = acc[ai][bj][m][0] * rstd, v1 = acc[ai][bj][m][1] * rstd;
                    u32x4 w; w.x = pk2(v0[0], v0[1]); w.y = pk2(v0[2], v0[3]); w.z = pk2(v1[0], v1[1]); w.w = pk2(v1[2], v1[3]);
                    *(u32x4*)(rowp + bj * HALF) = w;
                }
            }
    }
};
}

__device__ __forceinline__ void mma32(f32x16& acc, ldsp_t A, int lda_b, ldsp_t Bt, int ldb_b, int ksteps, int lane) {
    ldsp_t ap = A + (lane & 31) * lda_b + (lane >> 5) * 16;
    ldsp_t bp = Bt + (lane & 31) * ldb_b + (lane >> 5) * 16;
    for (int ks = 0; ks < ksteps; ++ks) {
        const bf16x8 a = *(const LAS bf16x8*)(ap + ks * 32), b = *(const LAS bf16x8*)(bp + ks * 32);
        acc = __builtin_amdgcn_mfma_f32_32x32x16_bf16(a, b, acc, 0, 0, 0);
    }
}
template <int KS>
__device__ __forceinline__ void mma32t(f32x16& acc, ldsp_t A, int lda_b, ldsp_t Bt, int ldb_b, int lane) {
    ldsp_t ap = A + (lane & 31) * lda_b + (lane >> 5) * 16;
    ldsp_t bp = Bt + (lane & 31) * ldb_b + (lane >> 5) * 16;
    bf16x8 av[KS], bv[KS];
#pragma unroll
    for (int ks = 0; ks < KS; ++ks) { av[ks] = *(const LAS bf16x8*)(ap + ks * 32); bv[ks] = *(const LAS bf16x8*)(bp + ks * 32); }
#pragma unroll
    for (int ks = 0; ks < KS; ++ks) acc = __builtin_amdgcn_mfma_f32_32x32x16_bf16(av[ks], bv[ks], acc, 0, 0, 0);
}
#define ZERO16 ((f32x16){0.f,0.f,0.f,0.f,0.f,0.f,0.f,0.f,0.f,0.f,0.f,0.f,0.f,0.f,0.f,0.f})

constexpr int R_QS = 0, R_KS = 18432, R_VS = 43008, R_SS = 83968, R_RST = 118784, R_ST = 137216;
constexpr int LD64 = 144, LDK = 192, LDV = 320, LD128 = 272;
typedef short v4i16_t __attribute__((ext_vector_type(4)));
__device__ __forceinline__ bf16x8 frag_tr(ldsp_t X, int stride_b, int c0, int k0, int lane) {
    const int h = lane >> 5, blk = (lane >> 4) & 1, q = (lane & 15) >> 2, p = lane & 3;
    ldsp_t a = X + (k0 + 8 * h + q) * stride_b + (c0 + 16 * blk + 4 * p) * 2;
    const v4i16_t lo = __builtin_amdgcn_ds_read_tr16_b64_v4i16((LAS v4i16_t*)a), hi = __builtin_amdgcn_ds_read_tr16_b64_v4i16((LAS v4i16_t*)(a + 4 * stride_b));
    return (bf16x8){lo[0], lo[1], lo[2], lo[3], hi[0], hi[1], hi[2], hi[3]};
}
__device__ __forceinline__ bf16x8 frag_row(ldsp_t X, int stride_b, int r0, int k0, int lane) { return *(const LAS bf16x8*)(X + (r0 + (lane & 31)) * stride_b + (k0 + 8 * (lane >> 5)) * 2); }

__device__ __forceinline__ void ret_prompt_unit(const Args& a, Frame& F, int l, int b, int h) {
    const int tid = F.tid, lane = F.lane, w = F.wave, hi = lane >> 5, l31 = lane & 31;
    ldsp_t lds = F.lds;
    const bf16_t* P = (const bf16_t*)(a.ws + WS_P);
    bf16_t* ARET = (bf16_t*)(a.ws + WS_ARET);
    const float lg = logg_of(h), G = __expf(128.0f * lg);
    f32x16 racc = ZERO16;
    const int db = w >> 2, eb = w & 3;
    u32x4 pq[2], pk[2], pv[4], pg[4];
#define RET_FETCH(nn) do { const bf16_t* _b = P + ((size_t)b * SEQ + (nn) * CH) * LDP + h * 64; \
        _Pragma("unroll") for (int i = 0; i < 2; ++i) { const int p = tid + 512 * i; const bf16_t* _r = _b + (size_t)(p >> 3) * LDP + (p & 7) * 8; pq[i] = *(const u32x4*)(_r + PC_Q); pk[i] = *(const u32x4*)(_r + PC_K); } \
        _Pragma("unroll") for (int i = 0; i < 4; ++i) { const int p = tid + 512 * i; const bf16_t* _r = _b + h * 64 + (size_t)(p >> 4) * LDP + (p & 15) * 8; pv[i] = *(const u32x4*)(_r + PC_V); } } while (0)
#define RET_FETCH_G(nn) do { const bf16_t* _b = P + ((size_t)b * SEQ + (nn) * CH) * LDP + h * 128 + PC_GR; \
        _Pragma("unroll") for (int i = 0; i < 4; ++i) { const int p = tid + 512 * i; pg[i] = *(const u32x4*)(_b + (size_t)(p >> 4) * LDP + (p & 15) * 8); } } while (0)
    RET_FETCH(0);
    for (int n = 0; n < 16; ++n) {
        const size_t tok0 = (size_t)b * SEQ + n * CH;
#pragma unroll
        for (int i = 0; i < 2; ++i) { const int p = tid + 512 * i; *(LAS u32x4*)(lds + R_QS + (p >> 3) * LD64 + (p & 7) * 16) = pq[i]; *(LAS u32x4*)(lds + R_KS + (p >> 3) * LDK + (p & 7) * 16) = pk[i]; }
#pragma unroll
        for (int i = 0; i < 4; ++i) { const int p = tid + 512 * i; *(LAS u32x4*)(lds + R_VS + (p >> 4) * LDV + (p & 15) * 16) = pv[i]; }
#pragma unroll
        for (int g = 0; g < 4; ++g) { u32x2 wv; wv.x = pk2(racc[4 * g], racc[4 * g + 1]); wv.y = pk2(racc[4 * g + 2], racc[4 * g + 3]);
            *(LAS u32x2*)(lds + R_RST + (32 * eb + l31) * LD64 + (32 * db + 8 * g + 4 * hi) * 2) = wv; }
        if (n + 1 < 16) RET_FETCH(n + 1);
        RET_FETCH_G(n);
        LBAR();
#pragma unroll
        for (int t2 = 0; t2 < 2; ++t2) { const int t = 2 * w + t2, mb = t >> 2, jb = t & 3;
            if (mb <= jb) { f32x16 sacc = ZERO16;
                bf16x8 af[4], bf[4];
#pragma unroll
                for (int ks = 0; ks < 4; ++ks) { af[ks] = frag_row(lds + R_KS, LDK, 32 * mb, 16 * ks, lane); bf[ks] = frag_row(lds + R_QS, LD64, 32 * jb, 16 * ks, lane); }
#pragma unroll
                for (int ks = 0; ks < 4; ++ks) sacc = __builtin_amdgcn_mfma_f32_32x32x16_bf16(af[ks], bf[ks], sacc, 0, 0, 0);
                const int j = 32 * jb + l31;
#pragma unroll
                for (int g = 0; g < 4; ++g) { const int m0 = 32 * mb + 8 * g + 4 * hi; float v[4];
#pragma unroll
                    for (int q = 0; q < 4; ++q) v[q] = (j >= m0 + q) ? sacc[4 * g + q] : 0.f;
                    u32x2 wv; wv.x = pk2(v[0], v[1]); wv.y = pk2(v[2], v[3]);
                    *(LAS u32x2*)(lds + R_SS + j * LD128 + m0 * 2) = wv; } } }
        LBAR();
        const int jb = w >> 1, eh = w & 1;
        f32x16 oacc[2];
        oacc[0] = ZERO16; oacc[1] = ZERO16;
        { bf16x8 a0[4], a1[4], bf[4];
#pragma unroll
          for (int ks = 0; ks < 4; ++ks) { a0[ks] = frag_row(lds + R_RST, LD64, 32 * (2 * eh), 16 * ks, lane); a1[ks] = frag_row(lds + R_RST, LD64, 32 * (2 * eh + 1), 16 * ks, lane); bf[ks] = frag_row(lds + R_QS, LD64, 32 * jb, 16 * ks, lane); }
#pragma unroll
          for (int ks = 0; ks < 4; ++ks) { oacc[0] = __builtin_amdgcn_mfma_f32_32x32x16_bf16(a0[ks], bf[ks], oacc[0], 0, 0, 0); oacc[1] = __builtin_amdgcn_mfma_f32_32x32x16_bf16(a1[ks], bf[ks], oacc[1], 0, 0, 0); } }
        for (int mbk = 0; mbk <= jb; ++mbk) {
            bf16x8 a0[2], a1[2], bf[2];
#pragma unroll
            for (int ks = 0; ks < 2; ++ks) { const int k0 = 32 * mbk + 16 * ks; a0[ks] = frag_tr(lds + R_VS, LDV, 32 * (2 * eh), k0, lane); a1[ks] = frag_tr(lds + R_VS, LDV, 32 * (2 * eh + 1), k0, lane); bf[ks] = frag_row(lds + R_SS, LD128, 32 * jb, k0, lane); }
#pragma unroll
            for (int ks = 0; ks < 2; ++ks) { oacc[0] = __builtin_amdgcn_mfma_f32_32x32x16_bf16(a0[ks], bf[ks], oacc[0], 0, 0, 0); oacc[1] = __builtin_amdgcn_mfma_f32_32x32x16_bf16(a1[ks], bf[ks], oacc[1], 0, 0, 0); }
        }
        float s1 = 0.f, s2 = 0.f;
#pragma unroll
        for (int t = 0; t < 2; ++t)
#pragma unroll
            for (int r = 0; r < 16; ++r) { s1 += oacc[t][r]; s2 += oacc[t][r] * oacc[t][r]; }
        s1 += __shfl_xor(s1, 32); s2 += __shfl_xor(s2, 32);
        if (hi == 0) *(LAS f32x2*)(lds + R_ST + (eh * 128 + 32 * jb + l31) * 8) = (f32x2){s1, s2};
        LBAR();
        { const int j = 32 * jb + l31;
          const f32x2 sa = *(const LAS f32x2*)(lds + R_ST + j * 8), sb = *(const LAS f32x2*)(lds + R_ST + (128 + j) * 8);
          const float mu = (sa.x + sb.x) * (1.0f / DV), var = (sa.y + sb.y) * (1.0f / DV) - mu * mu, rstd = rsqrtf(fmaxf(var, 0.f) + EPS);
#pragma unroll
          for (int t = 0; t < 2; ++t)
#pragma unroll
              for (int g = 0; g < 4; ++g) { const int e0 = 32 * (2 * eh + t) + 8 * g + 4 * hi;
                  u32x2 wv; wv.x = pk2((oacc[t][4 * g] - mu) * rstd, (oacc[t][4 * g + 1] - mu) * rstd); wv.y = pk2((oacc[t][4 * g + 2] - mu) * rstd, (oacc[t][4 * g + 3] - mu) * rstd);
                  *(LAS u32x2*)(lds + R_SS + j * LD128 + e0 * 2) = wv; } }
#pragma unroll
        for (int kh = 0; kh < 2; ++kh) { bf16x8 af[4], bf[4];
#pragma unroll
          for (int ks = 0; ks < 4; ++ks) { af[ks] = frag_tr(lds + R_KS, LDK, 32 * db, 64 * kh + 16 * ks, lane); bf[ks] = frag_tr(lds + R_VS, LDV, 32 * eb, 64 * kh + 16 * ks, lane); }
#pragma unroll
          for (int ks = 0; ks < 4; ++ks) racc = __builtin_amdgcn_mfma_f32_32x32x16_bf16(af[ks], bf[ks], racc, 0, 0, 0); }
#pragma unroll
        for (int r = 0; r < 16; ++r) racc[r] *= G;
        LBAR();
#pragma unroll
        for (int i = 0; i < 4; ++i) { const int p = tid + 512 * i, row = p >> 4, c = p & 15;
            const u32x4 ov = *(const LAS u32x4*)(lds + R_SS + row * LD128 + c * 16), gv = pg[i];
            u32x4 wv; wv.x = pk2(bflo(ov.x) * bflo(gv.x), bfhi(ov.x) * bfhi(gv.x)); wv.y = pk2(bflo(ov.y) * bflo(gv.y), bfhi(ov.y) * bfhi(gv.y));
            wv.z = pk2(bflo(ov.z) * bflo(gv.z), bfhi(ov.z) * bfhi(gv.z)); wv.w = pk2(bflo(ov.w) * bflo(gv.w), bfhi(ov.w) * bfhi(gv.w));
            *(u32x4*)(ARET + (tok0 + row) * DM + h * 128 + c * 8) = wv; }
    }
    float* so = a.out + O_SRP + ((((size_t)l * NBATCH + b) * HR + h) * DK) * DV;
#pragma unroll
    for (int r = 0; r < 16; ++r) { const int d = 32 * db + (r & 3) + 8 * (r >> 2) + 4 * hi; so[(size_t)d * DV + 32 * eb + l31] = racc[r]; }
#undef RET_FETCH
#undef RET_FETCH_G
}

__device__ __forceinline__ void ret_sample_unit(const Args& a, Frame& F, int l, int bs, int h) {
    const int tid = F.tid, lane = F.lane, w = F.wave;
    LAS float* qd = (LAS float*)F.lds; LAS float* ku = qd + 512; LAS float* vv = ku + 512; LAS float* S = vv + 1024; LAS float* crossp = S + 64; LAS float* red = crossp + 4096;
    bf16_t* P = (bf16_t*)(a.ws + WS_P);
    const size_t tok0 = (size_t)M_P + bs * DECT;
    { const int j = tid >> 6, d = tid & 63; const bf16_t* src = P + (tok0 + j) * LDP + h * 64 + d; qd[tid] = bf1(src[PC_Q]); ku[tid] = bf1(src[PC_K]); }
#pragma unroll
    for (int i = 0; i < 2; ++i) { const int idx = tid + 512 * i, m = idx >> 7, e = idx & 127; vv[idx] = bf1(P[(tok0 + m) * LDP + PC_V + h * 128 + e]); }
    LBAR();
    const int dg = tid >> 7, e = tid & 127;
    const size_t soff = ((((size_t)l * DECB + bs) * HR + h) * DK) * DV;
    const float* r0 = a.in[2] + soff; float* rn = a.out + O_SRS + soff;
    const float lg = logg_of(h), G8 = __expf(8.0f * lg);
    float cross[8];
#pragma unroll
    for (int j = 0; j < 8; ++j) cross[j] = 0.f;
    float rv[16];
#pragma unroll
    for (int dd = 0; dd < 16; ++dd) rv[dd] = r0[(size_t)(dg * 16 + dd) * DV + e];
#pragma unroll
    for (int dd = 0; dd < 16; ++dd) { const int d = dg * 16 + dd; const float r = rv[dd]; float kvs = 0.f;
#pragma unroll
        for (int m = 0; m < 8; ++m) kvs += ku[m * 64 + d] * vv[m * 128 + e];
        rn[(size_t)d * DV + e] = G8 * (r + kvs);
#pragma unroll
        for (int j = 0; j < 8; ++j) cross[j] += qd[j * 64 + d] * r; }
#pragma unroll
    for (int j = 0; j < 8; ++j) crossp[(dg * 8 + j) * 128 + e] = cross[j];
    { const int pr = tid >> 3, part = tid & 7, j = pr >> 3, m = pr & 7; float sp = 0.f;
#pragma unroll
      for (int d = 0; d < 8; ++d) sp += qd[j * 64 + part * 8 + d] * ku[m * 64 + part * 8 + d];
      sp += __shfl_xor(sp, 1); sp += __shfl_xor(sp, 2); sp += __shfl_xor(sp, 4);
      if (part == 0) S[pr] = (j >= m) ? sp : 0.f; }
    LBAR();
    float o[2];
#pragma unroll
    for (int jj = 0; jj < 2; ++jj) { const int j = dg + 4 * jj; float s = 0.f;
#pragma unroll
        for (int g = 0; g < 4; ++g) s += crossp[(g * 8 + j) * 128 + e];
#pragma unroll
        for (int m = 0; m < 8; ++m) s += S[j * 8 + m] * vv[m * 128 + e];
        o[jj] = s;
        const float t1 = wave_sum(s), t2 = wave_sum(s * s);
        if (lane == 0) { red[(jj * 8 + w) * 2] = t1; red[(jj * 8 + w) * 2 + 1] = t2; } }
    LBAR();
#pragma unroll
    for (int jj = 0; jj < 2; ++jj) { const int j = dg + 4 * jj, w0 = 2 * dg;
        const float t1 = red[(jj * 8 + w0) * 2] + red[(jj * 8 + w0 + 1) * 2], t2 = red[(jj * 8 + w0) * 2 + 1] + red[(jj * 8 + w0 + 1) * 2 + 1];
        const float mu = t1 * (1.0f / DV), var = t2 * (1.0f / DV) - mu * mu, rstd = rsqrtf(fmaxf(var, 0.f) + EPS);
        const bf16_t* prow = P + (tok0 + j) * LDP + h * 128 + e;
        ((bf16_t*)(a.ws + WS_ARET))[(tok0 + j) * DM + h * 128 + e] = (bf16_t)f2bf((o[jj] - mu) * rstd * bf1(prow[PC_GR])); }
    LBAR();
}

constexpr int N_XRL = 0, N_XCF = 33536, N_XCB = 66304, N_WGT = 84736, N_CAR = 103168, N_BUF = 107264;
__device__ __forceinline__ void rnn_unit(const Args& a, Frame& F, int l, bool sample, int bg, int nb) {
    const int tid = F.tid, lane = F.lane, w = F.wave, hi = lane >> 5, l31 = lane & 31;
    ldsp_t lds = F.lds;
    LAS float* xrl = (LAS float*)(lds + N_XRL); LAS float* xcf = (LAS float*)(lds + N_XCF); LAS float* car = (LAS float*)(lds + N_CAR); LAS float* bufl = (LAS float*)(lds + N_BUF);
    LAS float* aa = xrl; LAS float* uu = xcf;
    bf16_t* P = (bf16_t*)(a.ws + WS_P);
    const int ch0 = nb * BS;
    { const bf16_t* wg = (const bf16_t*)(a.ws + WS_WG) + ((size_t)l * NBLK + nb) * 2 * BS * BS;
#pragma unroll
      for (int i = 0; i < 2; ++i) { const int p = tid + 512 * i, row = p >> 3, c8 = p & 7; *(LAS u32x4*)(lds + N_WGT + row * LD64 + c8 * 16) = *(const u32x4*)(wg + row * 64 + c8 * 8); } }
    const int cc = tid & 63;
    const float* cwp = a.in[11] + (size_t)l * 4 * DM + ch0 + cc;
    const float cw0 = cwp[0], cw1 = cwp[DM], cw2 = cwp[2 * DM], cw3 = cwp[3 * DM], cbv = a.in[12][l * DM + ch0 + cc];
    const int rb = w >> 1, cb = w & 1, dcol = 32 * cb + l31;
    const float bav = a.in[14][l * DM + ch0 + dcol], bxv = a.in[16][l * DM + ch0 + dcol];
    const float spl = log1pf(__expf(-a.in[17][l * DM + ch0 + dcol]));
    const int ntiles = sample ? 1 : 16;
    float hcar = 0.f;
    if (sample) {
        for (int i = tid; i < 16 * 3 * 64; i += NTHREADS) { const int s = i / 192, r = (i / 64) % 3, c = i & 63;
            bufl[i] = a.in[4][(((size_t)l * DECB + bg * 16 + s) * 3 + r) * DM + ch0 + c]; }
    }
    u32x4 pre[3];
#define RNN_FETCH(nn) do { const size_t _t0 = sample ? (size_t)M_P + bg * 128 : (size_t)bg * SEQ + (nn) * 128; _Pragma("unroll") for (int k = 0; k < 3; ++k) { \
        const int p = tid + 512 * k, row = p >> 3, c8 = p & 7; pre[k] = (u32x4){0u, 0u, 0u, 0u}; \
        if (p < 131 * 8 && (row >= 3 || (!sample && (nn) > 0))) pre[k] = *(const u32x4*)(P + (_t0 + row - 3) * LDP + PC_XR + ch0 + c8 * 8); } } while (0)
    RNN_FETCH(0);
    for (int n = 0; n < ntiles; ++n) {
        const size_t tok0 = sample ? (size_t)M_P + bg * 128 : (size_t)bg * SEQ + n * 128;
        unsigned short gl[16];
#pragma unroll
        for (int i = 0; i < 16; ++i) gl[i] = P[(tok0 + 16 * w + i) * LDP + PC_GN + ch0 + cc];
#pragma unroll
        for (int k = 0; k < 3; ++k) { const int p = tid + 512 * k, row = p >> 3, c8 = p & 7;
            if (p < 131 * 8) { const u32x4 v = pre[k]; LAS float* d = xrl + row * 64 + c8 * 8;
                *(LAS f32x4*)d = (f32x4){bflo(v.x), bfhi(v.x), bflo(v.y), bfhi(v.y)}; *(LAS f32x4*)(d + 4) = (f32x4){bflo(v.z), bfhi(v.z), bflo(v.w), bfhi(v.w)}; } }
        LBAR();
        if (n + 1 < ntiles) RNN_FETCH(n + 1);
        { const int tg = tid >> 6;
#pragma unroll 4
          for (int i = 0; i < 16; ++i) { const int t = tg * 16 + i; float x0, x1, x2;
              const float x3 = xrl[(t + 3) * 64 + cc];
              if (sample) { const int s = t >> 3, j = t & 7;
                  x0 = j >= 3 ? xrl[t * 64 + cc] : bufl[(s * 3 + j) * 64 + cc];
                  x1 = j >= 2 ? xrl[(t + 1) * 64 + cc] : bufl[(s * 3 + j + 1) * 64 + cc];
                  x2 = j >= 1 ? xrl[(t + 2) * 64 + cc] : bufl[(s * 3 + j + 2) * 64 + cc];
              } else { x0 = xrl[t * 64 + cc]; x1 = xrl[(t + 1) * 64 + cc]; x2 = xrl[(t + 2) * 64 + cc]; }
              const float xc = cbv + cw0 * x0 + cw1 * x1 + cw2 * x2 + cw3 * x3;
              xcf[t * 64 + cc] = xc; *(LAS bf16_t*)(lds + N_XCB + t * LD64 + cc * 2) = (bf16_t)f2bf(xc); } }
        if (sample) { if (tid < 192) { }     }
        if (sample) { for (int i = tid; i < 16 * 3 * 64; i += NTHREADS) { const int s = i / 192, r = (i / 64) % 3, c = i & 63;
                a.out[O_SCS + (((size_t)l * DECB + bg * 16 + s) * 3 + r) * DM + ch0 + c] = xrl[(3 + s * 8 + 5 + r) * 64 + c]; } }
        else if (n == 15) { if (tid < 192) { const int r = tid >> 6, c = tid & 63; a.out[O_SCP + (((size_t)l * NBATCH + bg) * 3 + r) * DM + ch0 + c] = xrl[(3 + 125 + r) * 64 + c]; } }
        LBAR();
        { f32x16 ar = ZERO16, ai = ZERO16;
          mma32t<4>(ar, lds + N_XCB + rb * 32 * LD64, LD64, lds + N_WGT + (32 * cb) * LD64, LD64, lane);
          mma32t<4>(ai, lds + N_XCB + rb * 32 * LD64, LD64, lds + N_WGT + (64 + 32 * cb) * LD64, LD64, lane);
#pragma unroll
          for (int r = 0; r < 16; ++r) { const int t = 32 * rb + (r & 3) + 8 * (r >> 2) + 4 * hi;
              const float rg = sigmoidf_(ar[r] + bav), ig = sigmoidf_(ai[r] + bxv);
              const float la = -8.0f * rg * spl, av = __expf(la), mult = sqrtf(fmaxf(-expm1f(2.0f * la), 0.f));
              const float xc = xcf[t * 64 + dcol];
              aa[t * 64 + dcol] = av; uu[t * 64 + dcol] = mult * ig * xc; } }
        LBAR();
        if (!sample) {
            float Ap = 1.f, Hl = 0.f;
#pragma unroll 4
            for (int i = 0; i < 16; ++i) { const int t = 16 * w + i; const float av = aa[t * 64 + cc], uv = uu[t * 64 + cc]; Hl = av * Hl + uv; Ap *= av; }
            car[w * 64 + cc] = Ap; car[512 + w * 64 + cc] = Hl;
            LBAR();
            float hin = hcar, hnext = hcar;
#pragma unroll
            for (int w2 = 0; w2 < 8; ++w2) { const float A2 = car[w2 * 64 + cc], H2 = car[512 + w2 * 64 + cc]; hnext = A2 * hnext + H2; if (w2 < w) hin = hnext; }
            float hh = hin;
#pragma unroll
            for (int i = 0; i < 16; ++i) { const int t = 16 * w + i; hh = aa[t * 64 + cc] * hh + uu[t * 64 + cc];
                ((bf16_t*)(a.ws + WS_ARNN))[(tok0 + t) * DM + ch0 + cc] = (bf16_t)f2bf(hh * bf1(gl[i])); }
            hcar = hnext;
        } else {
#pragma unroll
            for (int s2 = 0; s2 < 2; ++s2) { const int s = 2 * w + s2, bs = bg * 16 + s;
                float hh = a.in[3][((size_t)l * DECB + bs) * DM + ch0 + cc];
#pragma unroll
                for (int j = 0; j < 8; ++j) { const int t = s * 8 + j; hh = aa[t * 64 + cc] * hh + uu[t * 64 + cc];
                    ((bf16_t*)(a.ws + WS_ARNN))[(tok0 + t) * DM + ch0 + cc] = (bf16_t)f2bf(hh * bf1(gl[s2 * 8 + j])); }
                a.out[O_SHS + ((size_t)l * DECB + bs) * DM + ch0 + cc] = hh; }
        }
        LBAR();
    }
    if (!sample && w == 0) a.out[O_SHP + ((size_t)l * NBATCH + bg) * DM + ch0 + cc] = hcar;
#undef RNN_FETCH
}

__device__ __forceinline__ unsigned ord_of(float f) { const unsigned u = __builtin_bit_cast(unsigned, f); return u ^ ((u >> 31) ? 0xFFFFFFFFu : 0x80000000u); }
__device__ __forceinline__ float ord_inv(unsigned o) { const unsigned u = (o >> 31) ? (o ^ 0x80000000u) : ~o; return __builtin_bit_cast(float, u); }
__host__ __device__ constexpr bool cand_ok(int a, int b) { return (a + 1) * (b + 1) <= 16; }

#define CEX(a, b) do { const unsigned _x = (a), _y = (b); (a) = _x > _y ? _x : _y; (b) = _x > _y ? _y : _x; } while (0)
__device__ __forceinline__ void sort16_desc(unsigned (&v)[16]) {
#pragma unroll
    for (int k = 2; k <= 16; k <<= 1)
#pragma unroll
        for (int j = k >> 1; j > 0; j >>= 1)
#pragma unroll
            for (int i = 0; i < 16; ++i) { const int p = i ^ j; if (p > i) { if ((i & k) == 0) CEX(v[i], v[p]); else CEX(v[p], v[i]); } }
}
__device__ __forceinline__ void bitonic_merge16_desc(unsigned (&v)[16]) {
#pragma unroll
    for (int j = 8; j > 0; j >>= 1)
#pragma unroll
        for (int i = 0; i < 16; ++i) { const int p = i ^ j; if (p > i) CEX(v[i], v[p]); }
}
__device__ __forceinline__ void merge_top16(unsigned (&a)[16], const unsigned (&b)[16]) {
#pragma unroll
    for (int i = 0; i < 16; ++i) a[i] = a[i] > b[15 - i] ? a[i] : b[15 - i];
    bitonic_merge16_desc(a);
}

__device__ __forceinline__ void route_unit(const Args& a, int l, int tb, int h, int lane) {
    const int hi = lane >> 5, l31 = lane & 31, token = tb * 32 + l31;
    const bf16_t* P = (const bf16_t*)(a.ws + WS_P);
    const bf16_t* qrow = P + (size_t)token * LDP + PC_QP + h * 256 + hi * 8;
    const bf16_t* kbase = (const bf16_t*)(a.ws + WS_KEYS) + ((size_t)(l * PH + h) * 2) * NKEY * HK + (size_t)l31 * HK + hi * 8;
    unsigned L[2][16];
#pragma unroll
    for (int p = 0; p < 2; ++p) {
        f32x16 acc[4];
#pragma unroll
        for (int kb = 0; kb < 4; ++kb) acc[kb] = ZERO16;
#pragma unroll 2
        for (int ks = 0; ks < 8; ++ks) {
            const bf16x8 bq = *(const bf16x8*)(qrow + p * 128 + ks * 16);
#pragma unroll
            for (int kb = 0; kb < 4; ++kb) { const bf16x8 ak = *(const bf16x8*)(kbase + ((size_t)p * NKEY + kb * 32) * HK + ks * 16);
                acc[kb] = __builtin_amdgcn_mfma_f32_32x32x16_bf16(ak, bq, acc[kb], 0, 0, 0); }
        }
        unsigned g0[16], g1[16];
#pragma unroll
        for (int r = 0; r < 16; ++r) { const int key = (r & 3) + 8 * (r >> 2) + 4 * hi; g0[r] = (ord_of(acc[0][r]) & ~127u) | (unsigned)(127 - key); g1[r] = (ord_of(acc[1][r]) & ~127u) | (unsigned)(127 - (32 + key)); }
        sort16_desc(g0); sort16_desc(g1); merge_top16(g0, g1);
        unsigned g2[16];
#pragma unroll
        for (int r = 0; r < 16; ++r) { const int key = (r & 3) + 8 * (r >> 2) + 4 * hi; g1[r] = (ord_of(acc[2][r]) & ~127u) | (unsigned)(127 - (64 + key)); g2[r] = (ord_of(acc[3][r]) & ~127u) | (unsigned)(127 - (96 + key)); }
        sort16_desc(g1); sort16_desc(g2); merge_top16(g1, g2); merge_top16(g0, g1);
#pragma unroll
        for (int i = 0; i < 16; ++i) g1[i] = (unsigned)__shfl_xor((int)g0[i], 32);
        merge_top16(g0, g1);
#pragma unroll
        for (int i = 0; i < 16; ++i) L[p][i] = g0[i];
    }
    float sa[16], sb[16];
#pragma unroll
    for (int i = 0; i < 16; ++i) { sa[i] = ord_inv(L[0][i] & ~127u); sb[i] = ord_inv(L[1][i] & ~127u); }
#define CKEY(x, y) ((ord_of(sa[x] + sb[y]) & ~255u) | (unsigned)(255 - ((x) * 16 + (y))))
    unsigned best[16], t1[16];
#pragma unroll
    for (int y = 0; y < 16; ++y) { best[y] = CKEY(0, y); t1[y] = y < 8 ? CKEY(1, y) : 0u; }
    merge_top16(best, t1);
    { int n = 0;
#pragma unroll
      for (int x = 2; x < 7; ++x)
#pragma unroll
          for (int y = 0; y < 16; ++y) if (cand_ok(x, y)) { t1[n] = CKEY(x, y); ++n; }
    }
    sort16_desc(t1); merge_top16(best, t1);
    { int n = 0;
#pragma unroll
      for (int x = 7; x < 16; ++x)
#pragma unroll
          for (int y = 0; y < 16; ++y) if (cand_ok(x, y)) { t1[n] = CKEY(x, y); ++n; }
#pragma unroll
      for (int i = 10; i < 16; ++i) t1[i] = 0u;
    }
    sort16_desc(t1); merge_top16(best, t1);
#undef CKEY
    float sc[16], ssum = 0.f; const float mx = ord_inv(best[0] & ~255u);
#pragma unroll
    for (int it = 0; it < 16; ++it) { sc[it] = __expf(ord_inv(best[it] & ~255u) - mx); ssum += sc[it]; }
    const float inv = 1.0f / ssum;
    unsigned* eo = (unsigned*)(a.ws + WS_EIDX) + (size_t)token * 128 + h * 16 + hi * 8;
    float* go = (float*)(a.ws + WS_GATE) + (size_t)token * 128 + h * 16 + hi * 8;
#pragma unroll
    for (int it = 0; it < 8; ++it) {
        unsigned b0 = best[it], b1 = best[it + 8]; float g0 = sc[it], g1 = sc[it + 8];
        asm volatile("" : "+v"(b0), "+v"(b1), "+v"(g0), "+v"(g1));
        const unsigned bsel = hi ? b1 : b0; const float gsel = (hi ? g1 : g0) * inv;
        const unsigned c = 255u - (bsel & 255u), ca = c >> 4, cb = c & 15u;
        unsigned k1 = 0u, k2 = 0u;
#pragma unroll
        for (int i = 0; i < 16; ++i) { k1 = (ca == (unsigned)i) ? (127u - (L[0][i] & 127u)) : k1; k2 = (cb == (unsigned)i) ? (127u - (L[1][i] & 127u)) : k2; }
        eo[it] = k1 * 128u + k2; go[it] = gsel;
    }
}
#undef CEX

constexpr int MAXT = 9;
#define DPPF(v, ctrl) __builtin_bit_cast(float, __builtin_amdgcn_update_dpp(0, __builtin_bit_cast(int, (v)), (ctrl), 0xf, 0xf, true))
constexpr int DPP_XOR1 = 0xB1, DPP_XOR2 = 0x4E, DPP_HMIRROR = 0x141, DPP_ROR8 = 0x128;
__device__ __forceinline__ void dec16p(const u32x4 r, f32x2 (&f)[8]) {
    f[0] = __builtin_amdgcn_cvt_pk_f32_fp8((int)r.x, false); f[1] = __builtin_amdgcn_cvt_pk_f32_fp8((int)r.x, true);
    f[2] = __builtin_amdgcn_cvt_pk_f32_fp8((int)r.y, false); f[3] = __builtin_amdgcn_cvt_pk_f32_fp8((int)r.y, true);
    f[4] = __builtin_amdgcn_cvt_pk_f32_fp8((int)r.z, false); f[5] = __builtin_amdgcn_cvt_pk_f32_fp8((int)r.z, true);
    f[6] = __builtin_amdgcn_cvt_pk_f32_fp8((int)r.w, false); f[7] = __builtin_amdgcn_cvt_pk_f32_fp8((int)r.w, true);
}
__device__ __forceinline__ void peer_phase(const Args& a, Frame& F, int l, bool lastlayer) {
    const int lane = F.lane, l7 = lane & 7, lg3 = lane >> 3;
    const int gw = F.vcu * NWAVES + F.wave, NGW = F.G * NWAVES;
    const unsigned char* TU = a.ws + WS_TAB + ((size_t)l * 2) * 16 * MiB;
    const unsigned char* TV = a.ws + WS_TAB + ((size_t)l * 2 + 1) * 16 * MiB;
    const float* SCU = (const float*)(a.ws + WS_TSC) + ((size_t)l * 2) * NEXP; const float* SCV = SCU + NEXP;
    bf16_t* XB = (bf16_t*)(a.ws + WS_XB); float* X = a.out;
    const unsigned* EI = (const unsigned*)(a.ws + WS_EIDX); const float* GT = (const float*)(a.ws + WS_GATE);
    const float* g2 = a.in[6] + (size_t)l * DM;
    ldsp_t wl = F.lds + F.wave * 16384;
    constexpr int O_ET = 0, O_HT = 2304, O_HA = 6912, O_SQ = 11520;
#define ET_ROW(i) (wl + O_ET + (i) * 256)
#define HT_ROW(i) (wl + O_HT + (i) * 512)
#define HACC(i) (*(LAS f32x2*)(wl + O_HA + (i) * 512 + lane * 8))
#define SSQ(i) (*(LAS float*)(wl + O_SQ + (i) * 256 + lane * 4))
    const int ntok = (MTOT - gw + NGW - 1) / NGW;
    for (int i = 0; i < ntok; ++i) { const int t = gw + NGW * i; const unsigned e0 = EI[(size_t)t * 128 + lane], e1 = EI[(size_t)t * 128 + 64 + lane];
        *(LAS bf16_t*)(ET_ROW(i) + (l7 * 16 + lg3) * 2) = (bf16_t)e0; *(LAS bf16_t*)(ET_ROW(i) + (l7 * 16 + 8 + lg3) * 2) = (bf16_t)e1;
        HACC(i) = (f32x2){0.f, 0.f}; SSQ(i) = 0.f; }
    LDS_WAIT();
    const unsigned lane_off = 16u * (unsigned)l7;
#define PEER_ISSUE(R, TAB, ss, ii, qh) do { const u32x4 _e = *(const LAS u32x4*)(ET_ROW(ii) + lg3 * 32 + (qh) * 16); const unsigned char* _b = (TAB) + (size_t)(ss) * (NEXP * 128); \
        const unsigned _w[4] = {_e.x, _e.y, _e.z, _e.w}; _Pragma("unroll") for (int q = 0; q < 8; ++q) { const unsigned idx = (q & 1) ? (_w[q >> 1] >> 16) : (_w[q >> 1] & 0xffffu); \
            R[q] = *(const u32x4*)(_b + (idx * 128u + lane_off)); } } while (0)
    for (int urep = 0; urep < REPS(7); ++urep) {
    if (urep) { for (int i = 0; i < ntok; ++i) HACC(i) = (f32x2){0.f, 0.f}; }
    {
        u32x4 RA[8], RB[8];
        PEER_ISSUE(RA, TU, 0, 0, 0);
        u32x4 xa = *(const u32x4*)(XB + (size_t)gw * DM + 16 * l7), xb = *(const u32x4*)(XB + (size_t)gw * DM + 16 * l7 + 8);
#pragma unroll 1
        for (int s = 0; s < 8; ++s) {
            f32x2 gv[8];
#pragma unroll
            for (int j = 0; j < 4; ++j) { const f32x4 g = *(const f32x4*)(g2 + 128 * s + 16 * l7 + 4 * j); gv[2 * j] = (f32x2){g[0], g[1]}; gv[2 * j + 1] = (f32x2){g[2], g[3]}; }
#pragma unroll 1
            for (int i = 0; i < ntok; ++i) {
                PEER_ISSUE(RB, TU, s, i, 1);
                int sn = s, in = i + 1; if (in == ntok) { in = 0; sn = s + 1; } if (sn == 8) { sn = 7; in = ntok - 1; }
                const int tn = gw + NGW * in;
                const u32x4 xan = *(const u32x4*)(XB + (size_t)tn * DM + 128 * sn + 16 * l7), xbn = *(const u32x4*)(XB + (size_t)tn * DM + 128 * sn + 16 * l7 + 8);
                f32x2 xg[8];
                { const unsigned xw[8] = {xa.x, xa.y, xa.z, xa.w, xb.x, xb.y, xb.z, xb.w};
#pragma unroll
                  for (int j = 0; j < 8; ++j) xg[j] = (f32x2){bflo(xw[j]), bfhi(xw[j])} * gv[j]; }
                float p[16];
#pragma unroll
                for (int q = 0; q < 8; ++q) { f32x2 f[8]; dec16p(RA[q], f); f32x2 s0 = f[0] * xg[0], s1 = f[1] * xg[1];
#pragma unroll
                    for (int j = 2; j < 8; j += 2) { s0 += f[j] * xg[j]; s1 += f[j + 1] * xg[j + 1]; }
                    s0 += s1; p[q] = s0.x + s0.y;
                    if (q < 7) asm volatile("" : "+v"(RA[q + 1].x), "+v"(RA[q + 1].y), "+v"(RA[q + 1].z), "+v"(RA[q + 1].w) : "v"(p[q])); }
                asm volatile("" :: "v"(p[7]));
                PEER_ISSUE(RA, TU, sn, in, 0);
#pragma unroll
                for (int q = 0; q < 8; ++q) { f32x2 f[8]; dec16p(RB[q], f); f32x2 s0 = f[0] * xg[0], s1 = f[1] * xg[1];
#pragma unroll
                    for (int j = 2; j < 8; j += 2) { s0 += f[j] * xg[j]; s1 += f[j + 1] * xg[j + 1]; }
                    s0 += s1; p[8 + q] = s0.x + s0.y;
                    if (q < 7) asm volatile("" : "+v"(RB[q + 1].x), "+v"(RB[q + 1].y), "+v"(RB[q + 1].z), "+v"(RB[q + 1].w) : "v"(p[8 + q])); }
                float p8[8], p4[4]; f32x2 p2;
#pragma unroll
                for (int q = 0; q < 8; ++q) { const float keep = (lane & 4) ? p[q + 8] : p[q], send = (lane & 4) ? p[q] : p[q + 8]; p8[q] = keep + DPPF(send, DPP_HMIRROR); }
#pragma unroll
                for (int q = 0; q < 4; ++q) { const float keep = (lane & 2) ? p8[q + 4] : p8[q], send = (lane & 2) ? p8[q] : p8[q + 4]; p4[q] = keep + DPPF(send, DPP_XOR2); }
                { const float k0 = (lane & 1) ? p4[2] : p4[0], s0 = (lane & 1) ? p4[0] : p4[2], k1 = (lane & 1) ? p4[3] : p4[1], s1 = (lane & 1) ? p4[1] : p4[3];
                  p2.x = k0 + DPPF(s0, DPP_XOR1); p2.y = k1 + DPPF(s1, DPP_XOR1); }
                HACC(i) += p2;
                xa = xan; xb = xbn;
            }
        }
    } }
    for (int i = 0; i < ntok; ++i) { const int t = gw + NGW * i;
        const float rstd = rsqrtf(((const float*)(a.ws + WS_RSS2))[t] * (1.0f / DM) + EPS);
        const unsigned ew = *(const LAS unsigned*)(ET_ROW(i) + (lg3 * 16 + 2 * l7) * 2); const unsigned e0 = ew & 0xffffu, e1 = ew >> 16;
        const int k0 = 16 * l7 + lg3, k1 = k0 + 8; const f32x2 hs = HACC(i);
        f32x2 hv; hv.x = geluf_(hs.x * rstd * SCU[e0]) * GT[(size_t)t * 128 + k0] * SCV[e0]; hv.y = geluf_(hs.y * rstd * SCU[e1]) * GT[(size_t)t * 128 + k1] * SCV[e1];
        *(LAS f32x2*)(HT_ROW(i) + (lg3 * 16 + 2 * l7) * 4) = hv; }
    LDS_WAIT();
    {
        u32x4 RA[8], RB[8];
        PEER_ISSUE(RA, TV, 0, 0, 0);
#pragma unroll 1
        for (int s = 0; s < 8; ++s) {
#pragma unroll 1
            for (int i = 0; i < ntok; ++i) { const int t = gw + NGW * i;
                PEER_ISSUE(RB, TV, s, i, 1);
                int sn = s, in = i + 1; if (in == ntok) { in = 0; sn = s + 1; } if (sn == 8) { sn = 7; in = ntok - 1; }
                const int col = 128 * s + 16 * l7 + 8 * ((lane >> 3) & 1) + 4 * ((lane >> 5) & 1) + 2 * ((lane >> 4) & 1);
                f32x2 xv = *(const f32x2*)(X + (size_t)t * DM + col);
                const f32x4 h0 = *(const LAS f32x4*)(HT_ROW(i) + lg3 * 64), h1 = *(const LAS f32x4*)(HT_ROW(i) + lg3 * 64 + 16), h2 = *(const LAS f32x4*)(HT_ROW(i) + lg3 * 64 + 32), h3 = *(const LAS f32x4*)(HT_ROW(i) + lg3 * 64 + 48);
                const float hA[8] = {h0[0], h0[1], h0[2], h0[3], h1[0], h1[1], h1[2], h1[3]}, hB[8] = {h2[0], h2[1], h2[2], h2[3], h3[0], h3[1], h3[2], h3[3]};
                f32x2 o[8];
#pragma unroll
                for (int j = 0; j < 8; ++j) o[j] = (f32x2){0.f, 0.f};
#pragma unroll
                for (int q = 0; q < 8; ++q) { f32x2 f[8]; dec16p(RA[q], f); const f32x2 hq = (f32x2){hA[q], hA[q]};
#pragma unroll
                    for (int j = 0; j < 8; ++j) o[j] += hq * f[j];
                    if (q < 7) asm volatile("" : "+v"(RA[q + 1].x), "+v"(RA[q + 1].y), "+v"(RA[q + 1].z), "+v"(RA[q + 1].w) : "v"(o[7].y)); }
                asm volatile("" :: "v"(o[7].y));
                PEER_ISSUE(RA, TV, sn, in, 0);
#pragma unroll
                for (int q = 0; q < 8; ++q) { f32x2 f[8]; dec16p(RB[q], f); const f32x2 hq = (f32x2){hB[q], hB[q]};
#pragma unroll
                    for (int j = 0; j < 8; ++j) o[j] += hq * f[j];
                    if (q < 7) asm volatile("" : "+v"(RB[q + 1].x), "+v"(RB[q + 1].y), "+v"(RB[q + 1].z), "+v"(RB[q + 1].w) : "v"(o[7].y)); }
                f32x2 o4[4], o2[2], o1;
#pragma unroll
                for (int q = 0; q < 4; ++q) { const f32x2 keep = (lane & 8) ? o[q + 4] : o[q], send = (lane & 8) ? o[q] : o[q + 4];
                    o4[q].x = keep.x + __shfl_xor(send.x, 8); o4[q].y = keep.y + __shfl_xor(send.y, 8); }
#pragma unroll
                for (int q = 0; q < 2; ++q) { const f32x2 keep = (lane & 32) ? o4[q + 2] : o4[q], send = (lane & 32) ? o4[q] : o4[q + 2];
                    o2[q].x = keep.x + __shfl_xor(send.x, 32); o2[q].y = keep.y + __shfl_xor(send.y, 32); }
                { const f32x2 keep = (lane & 16) ? o2[1] : o2[0], send = (lane & 16) ? o2[0] : o2[1];
                  o1.x = keep.x + __shfl_xor(send.x, 16); o1.y = keep.y + __shfl_xor(send.y, 16); }
                xv += o1;
                *(f32x2*)(X + (size_t)t * DM + col) = xv; *(unsigned*)(XB + (size_t)t * DM + col) = pk2(xv.x, xv.y); SSQ(i) += xv.x * xv.x + xv.y * xv.y;
            }
        }
    }
#undef PEER_ISSUE
    float* RSS = (float*)(a.ws + WS_RSS);
    if (lastlayer) __threadfence();
    for (int i = 0; i < ntok; ++i) { const int t = gw + NGW * i; const float ss = wave_sum(SSQ(i)); if (lane == 0) RSS[t] = ss;
        if (lastlayer) { const float* gf = a.in[7]; const float rstd = rsqrtf(ss * (1.0f / DM) + EPS); f32x4* xr = (f32x4*)(X + (size_t)t * DM) + lane;
#pragma unroll
            for (int j = 0; j < 4; ++j) { const f32x4 g = *((const f32x4*)gf + lane + 64 * j); f32x4 v = xr[64 * j]; v = v * rstd * g; xr[64 * j] = v; } } }
#undef ET_ROW
#undef HT_ROW
#undef HACC
#undef SSQ
}

constexpr int PROBE_A = PROBE_SEL == 99 ? -1 : PROBE_SEL == 16 ? 15 : PROBE_SEL >= 200 ? 64 + (PROBE_SEL - 200) : PROBE_SEL >= 100 ? (PROBE_SEL - 100) : PROBE_SEL >= 32 ? PROBE_SEL : PROBE_SEL == 1 ? 0 : PROBE_SEL - 1;
constexpr int PROBE_B = PROBE_SEL == 99 ? -1 : PROBE_SEL == 16 ? 130 : PROBE_SEL >= 200 ? (PROBE_SEL - 200) : PROBE_SEL >= 100 ? 64 + (PROBE_SEL - 101) : PROBE_SEL >= 32 ? 1 : PROBE_SEL == 1 ? 130 : PROBE_SEL - 2;
constexpr int N_PHASES = 1 + 7 * DEPTH;
__global__ void __launch_bounds__(NTHREADS, 2) hybrid_fwd(Args args) {
    extern __shared__ __attribute__((aligned(16))) unsigned char lds_raw[];
    Frame F;
    F.lds = (ldsp_t)lds_raw;
    F.MISC = (volatile LAS unsigned*)(F.lds + MISC_OFF);
    F.tid = threadIdx.x; F.lane = F.tid & 63; F.wave = __builtin_amdgcn_readfirstlane(F.tid >> 6);
    F.G = gridDim.x; { const int bx = blockIdx.x; F.vcu = (F.G % 8 == 0) ? (bx % 8) * (F.G / 8) + bx / 8 : bx; }
    F.ctl = (unsigned*)(args.ws + WS_CTL); F.ws = args.ws; F.out = args.out;
    for (int u = F.tid; u < (LDS_BYTES - MISC_OFF) / 4; u += NTHREADS) ((LAS unsigned*)(F.lds + MISC_OFF))[u] = 0u;
    __syncthreads();
#if MK_N_LAUNCHES == 1
    constexpr int lo = 0, hi = N_PHASES;
#else
    const int lo = args.ph_lo, hi = args.ph_hi;
#endif
    if (PROBE_SEL && blockIdx.x == 0 && F.tid == 0) F.ctl[CW_TS + 130] = (unsigned)__builtin_amdgcn_s_memrealtime();
    XcdBarrier bar; bar.bar = F.ctl + CW_BAR; bar.x = 0; bar.st = nullptr;
    if (hi - lo > 1) bar = xcd_barrier_post(F.ctl + CW_BAR, F.MISC + 8);
#ifndef PH_MASK
#define PH_MASK 0x7FF
#endif
#define IN(k) (lo <= (k) && (k) < hi)
#define PHM(b) ((PH_MASK >> (b)) & 1)
#define REPBAR() do { if (rep) xcd_barrier(bar); } while (0)
#define LAUNDER() do { asm volatile("" : "+v"(F.tid)); F.lane = F.tid & 63; F.wave = __builtin_amdgcn_readfirstlane(F.tid >> 6); bxl = (int)blockIdx.x; asm volatile("" : "+s"(bxl)); } while (0)
#define STAMP(k) do { if (PROBE_SEL && ((k) == PROBE_A || (k) == PROBE_B) && F.tid == 0) atomicMax(F.ctl + CW_TS + (k), (unsigned)__builtin_amdgcn_s_memrealtime()); } while (0)
#define SEAM(k) do { STAMP(k); if (IN(k) && IN((k) + 1)) xcd_barrier(bar); STAMP(64 + (k)); } while (0)
    unsigned char* ws = args.ws;
    bf16_t* P = (bf16_t*)(ws + WS_P); bf16_t* XB = (bf16_t*)(ws + WS_XB);
    int bxl = (int)blockIdx.x;

    for (int rep = 0; rep < REPS(0); ++rep) { REPBAR(); if (PHM(0) && IN(0)) { LAUNDER(); p0_prologue(args, F); } } SEAM(0);

    for (int l = 0; l < DEPTH; ++l) {
        const int pb = 1 + 7 * l;
        for (int rep = 0; rep < REPS(1); ++rep) { REPBAR();
        if (PHM(1) && IN(pb)) { LAUNDER();
            pg8::Gemm g{XB, (const bf16_t*)(ws + WS_WIN) + (size_t)l * NIN * DM, DM, DM, 0, 0};
            pg8::StaticOrder S; S.init(MTOT, NIN, F.G, bxl, 1);
            pg8::EpiIn E{P, (const float*)(ws + WS_RSS), (const float*)(ws + WS_ROT)};
            pg8::gemm_phase<pg8::EpiIn, pg8::StaticOrder, true>(F.lds, g, S, E, F.tid);
        } }
        SEAM(pb);
        if (PHM(2) && IN(pb + 1)) { LAUNDER();
            for (int u = (int)blockIdx.x; u < 192; u += F.G) {
                LAUNDER();
                if (u < 64) { if (PHM(8)) ret_prompt_unit(args, F, l, u >> 3, u & 7); if (l == 0) STAMP(32); }
                else { if (PHM(9)) rnn_unit(args, F, l, false, (u - 64) >> 4, (u - 64) & 15); if (l == 0) STAMP(33); }
            }
            unsigned* qh = F.ctl + CW_QUEUE + 64 * l;
            for (;;) {
                __syncthreads();
                if (F.tid == 0) F.MISC[0] = xb_add(qh, 1u);
                __syncthreads();
                const unsigned q = F.MISC[0];
                LAUNDER();
                if (PROBE_SEL && l == 0 && q >= 1152u && q < 1152u + 256u) STAMP(34);
                if (q >= 1024u + 128u + 256u) break;
                if (q < 1024u) { if (PHM(10)) ret_sample_unit(args, F, l, (int)(q >> 3), (int)(q & 7)); }
                else if (q < 1152u) { if (PHM(9)) rnn_unit(args, F, l, true, (int)((q - 1024u) >> 4), (int)((q - 1024u) & 15)); }
                else tab_unit(args, F, l, (int)(q - 1152u));
            }
        }
        SEAM(pb + 1);
        for (int rep = 0; rep < REPS(3); ++rep) { REPBAR();
        if (PHM(3) && IN(pb + 2)) { LAUNDER();
            pg8::Gemm g{(const bf16_t*)(ws + WS_ARET), (const bf16_t*)(ws + WS_WMIX + (size_t)l * 6 * MiB), DM, DM, (size_t)(WS_ARNN - WS_ARET), (size_t)(2 * MiB)};
            pg8::StaticOrder S; S.init(MTOT, DM, F.G, bxl, 2);
            pg8::EpiMerge E{P, (bf16_t*)(ws + WS_MRG)};
            pg8::gemm_phase<pg8::EpiMerge, pg8::StaticOrder, true>(F.lds, g, S, E, F.tid);
        } }
        SEAM(pb + 2);
        if (PHM(4) && IN(pb + 3)) { LAUNDER();
            pg8::Gemm g{(const bf16_t*)(ws + WS_MRG), (const bf16_t*)(ws + WS_WMIX + (size_t)l * 6 * MiB + 4 * MiB), DM, DM, 0, 0};
            pg8::StaticOrder S; S.init(MTOT, DM, F.G, bxl, 1);
            pg8::EpiWo E{l == 0 ? args.in[0] : args.out, l == 0 ? args.in[1] : args.out + (size_t)M_P * DM, args.out, XB, (float*)(ws + WS_RSSP)};
            pg8::gemm_phase<pg8::EpiWo, pg8::StaticOrder, true>(F.lds, g, S, E, F.tid);
        }
        SEAM(pb + 3);
        for (int rep = 0; rep < REPS(5); ++rep) { REPBAR();
        if (PHM(5) && IN(pb + 4)) { LAUNDER();
            pg8::Gemm g{XB, (const bf16_t*)(ws + WS_WQ) + (size_t)l * 2048 * DM, DM, DM, 0, 0};
            pg8::StaticOrder S; S.init(MTOT, 2048, F.G, bxl, 1);
            pg8::EpiQ E{P, (const float*)(ws + WS_RSSP), (float*)(ws + WS_RSS2)};
            pg8::gemm_phase<pg8::EpiQ, pg8::StaticOrder, true>(F.lds, g, S, E, F.tid);
        } }
        SEAM(pb + 4);
        for (int rep = 0; rep < 1; ++rep) {
        if (PHM(6) && IN(pb + 5)) { LAUNDER();
            const int gw = F.vcu * NWAVES + F.wave, NGW = F.G * NWAVES;
            for (int u = gw; u < (MTOT / 32) * PH; u += NGW) { for (int rr = 0; rr < REPS(6); ++rr) { int ln = F.lane; asm volatile("" : "+v"(ln)); route_unit(args, l, u >> 3, u & 7, ln); } }
        } }
        SEAM(pb + 5);
        if (PHM(7) && IN(pb + 6)) { LAUNDER(); peer_phase(args, F, l, l == DEPTH - 1); }
        if (l + 1 < DEPTH) SEAM(pb + 6); else STAMP(pb + 6);
    }
    STAMP(15);
#undef IN
#undef SEAM
}


__global__ void probe_report(float* out, const unsigned* ts) {
    unsigned ta, tb;
    if (PROBE_SEL == 99) { ta = 10000u; tb = 0u; }
    else { ta = ts[PROBE_A < 0 ? 0 : PROBE_A]; tb = ts[PROBE_B < 0 ? 0 : PROBE_B]; if (PROBE_SEL == 16) ta = tb + (ta - tb) / 16u; }
    const float dl = sqrtf((float)(ta - tb)) * 1e-2f;
    for (int i = blockIdx.x * blockDim.x + threadIdx.x; i < DEPTH * NBATCH * DM; i += gridDim.x * blockDim.x) out[O_SHP + i] += dl;
}
extern "C" void kernel_launch(void* const* d_in, const int* in_sizes, int n_in, void* d_out, int out_size, void* d_ws, size_t ws_size, hipStream_t stream) {
    static int grid = 0;
    if (grid == 0) {
        if (n_in != 24 || out_size != (int)O_END || ws_size < WS_END) { fprintf(stderr, "kernel_launch: unexpected shapes (n_in %d, out %d, ws %zu)\n", n_in, out_size, ws_size); grid = -1; return; }
        int dev = 0, cus = 0, per_cu = 0;
        if (hipGetDevice(&dev) != hipSuccess || hipDeviceGetAttribute(&cus, hipDeviceAttributeMultiprocessorCount, dev) != hipSuccess) { grid = -1; return; }
        if (hipFuncSetAttribute((const void*)hybrid_fwd, hipFuncAttributeMaxDynamicSharedMemorySize, LDS_BYTES) != hipSuccess) { fprintf(stderr, "kernel_launch: hipFuncSetAttribute failed\n"); grid = -1; return; }
        if (hipOccupancyMaxActiveBlocksPerMultiprocessor(&per_cu, (const void*)hybrid_fwd, NTHREADS, LDS_BYTES) != hipSuccess || per_cu < 1) { fprintf(stderr, "kernel_launch: occupancy query reports %d blocks per CU\n", per_cu); (void)hipGetLastError(); grid = -1; return; }
        grid = cus;
        if (grid != 256) fprintf(stderr, "kernel_launch: %d CUs; the PEER phase assumes 256 workgroups\n", grid);
    }
    if (grid < 0) return;
    (void)hipMemsetAsync((char*)d_ws + WS_CTL, 0, CTL_ZERO_BYTES, stream);
    Args a{};
    for (int i = 0; i < 24; ++i) a.in[i] = (const float*)d_in[i];
    a.out = (float*)d_out; a.ws = (unsigned char*)d_ws;
#if MK_N_LAUNCHES == 1
    a.ph_lo = 0; a.ph_hi = N_PHASES;
    void* kargs[] = {&a};
    hipError_t e = hipLaunchCooperativeKernel((const void*)hybrid_fwd, dim3(grid), dim3(NTHREADS), kargs, LDS_BYTES, stream);
    if (e != hipSuccess) fprintf(stderr, "kernel_launch: cooperative launch failed: %s (grid %d)\n", hipGetErrorString(e), grid);
#if PROBE_SEL
    hipLaunchKernelGGL(probe_report, dim3(16), dim3(256), 0, stream, (float*)d_out, (const unsigned*)((char*)d_ws + WS_CTL) + CW_TS);
#endif
#else
    for (int p = 0; p < N_PHASES; ++p) { a.ph_lo = p; a.ph_hi = p + 1; hipLaunchKernelGGL(hybrid_fwd, dim3(grid), dim3(NTHREADS), LDS_BYTES, stream, a); }
#endif
}
```

```cpp
#include <hip/hip_runtime.h>
#include <cstdio>
#include <cstdint>

#define LAS __attribute__((address_space(3)))
#define GAS __attribute__((address_space(1)))
typedef unsigned short bf16_t;
typedef short bf16x8 __attribute__((ext_vector_type(8)));
typedef float f32x2 __attribute__((ext_vector_type(2)));
typedef float f32x4 __attribute__((ext_vector_type(4)));
typedef float f32x16 __attribute__((ext_vector_type(16)));
typedef unsigned u32x2 __attribute__((ext_vector_type(2)));
typedef unsigned u32x4 __attribute__((ext_vector_type(4)));
typedef LAS unsigned char* ldsp_t;

#ifndef REP_MASK
#define REP_MASK 0
#endif
#define REPS(k) (((REP_MASK >> (k)) & 1) ? 2 : 1)
#ifndef PROBE_SEL
#define PROBE_SEL 0
#endif
#ifndef MK_N_LAUNCHES
#define MK_N_LAUNCHES 1
#endif

constexpr int DM = 1024, NIN = 7168, M_P = 16384, M_S = 1024, MTOT = 17408, DEPTH = 2;
constexpr int SEQ = 2048, NBATCH = 8, DECB = 128, DECT = 8, PAST = 16384;
constexpr int HR = 8, DK = 64, DV = 128, CH = 128;
constexpr int NBLK = 16, BS = 64;
constexpr int PH = 8, NKEY = 128, NEXP = 16384, TOPK = 16, HK = 128;
constexpr float EPS = 1e-6f;
constexpr int LDP = 7168;
constexpr int PC_Q = 0, PC_K = 512, PC_V = 1024, PC_GR = 2048, PC_XR = 3072, PC_GN = 4096, PC_GA = 5120, PC_GB = 6144;
constexpr int PC_MRG = 0, PC_ARET = 1024, PC_ARNN = 4096, PC_QP = 2048;

constexpr size_t MiB = 1u << 20;
constexpr size_t WS_CTL = 0, CTL_ZERO_BYTES = 1 * MiB;
constexpr size_t WS_ROT = 1 * MiB;
constexpr size_t WS_RSS = 2 * MiB;
constexpr size_t WS_RSS2 = 2 * MiB + 128 * 1024;
constexpr size_t WS_RSSP = 2 * MiB + 256 * 1024;
constexpr size_t WS_TSC = 3 * MiB + 512 * 1024;
constexpr size_t WS_EIDX = 4 * MiB;
constexpr size_t WS_GATE = 13 * MiB;
constexpr size_t WS_KEYS = 22 * MiB;
constexpr size_t WS_WG = 23 * MiB;
constexpr size_t WS_WIN = 24 * MiB;
constexpr size_t WS_WMIX = 52 * MiB;
constexpr size_t WS_WQ = 64 * MiB;
constexpr size_t WS_XB = 72 * MiB;
constexpr size_t WS_P = 106 * MiB;
constexpr size_t WS_TAB = 344 * MiB;
constexpr size_t WS_ARET = 408 * MiB, WS_ARNN = 442 * MiB, WS_MRG = 476 * MiB;
constexpr size_t WS_END = 510 * MiB;
static_assert(WS_P + (size_t)MTOT * LDP * 2 <= WS_TAB, "ws map");

constexpr size_t O_Y = 0, O_SRP = 17825792, O_SHP = 18874368, O_SCP = 18890752, O_SRS = 18939904, O_SHS = 35717120, O_SCS = 35979264, O_END = 36765696;

constexpr int CW_BAR = 4096;
constexpr int CW_QUEUE = 16384;
constexpr int CW_TS = 20480;

constexpr int RING_BYTES = 131072;
constexpr int LDS_BYTES = 155648;
constexpr int MISC_OFF = 153600;
constexpr int NWAVES = 8, NTHREADS = 512;

#define LDS_WAIT() asm volatile("s_waitcnt lgkmcnt(0)" ::: "memory")
#define VM_WAIT() asm volatile("s_waitcnt vmcnt(0)" ::: "memory")
#define LBAR() do { asm volatile("s_waitcnt lgkmcnt(0)" ::: "memory"); __builtin_amdgcn_s_barrier(); asm volatile("" ::: "memory"); } while (0)
#define RLX_AGENT __ATOMIC_RELAXED, __HIP_MEMORY_SCOPE_AGENT

__device__ __forceinline__ unsigned f2bf(float f) { unsigned u = __builtin_bit_cast(unsigned, f); return (u + 0x7fffu + ((u >> 16) & 1u)) >> 16; }
typedef __bf16 bf16x2_t __attribute__((ext_vector_type(2)));
__device__ __forceinline__ unsigned pk2(float lo, float hi) { const f32x2 v = {lo, hi}; const bf16x2_t b = __builtin_convertvector(v, bf16x2_t); return __builtin_bit_cast(unsigned, b); }
__device__ __forceinline__ float bflo(unsigned w) { return __builtin_bit_cast(float, w << 16); }
__device__ __forceinline__ float bfhi(unsigned w) { return __builtin_bit_cast(float, w & 0xffff0000u); }
__device__ __forceinline__ float bf1(bf16_t h) { return __builtin_bit_cast(float, (unsigned)h << 16); }
__device__ __forceinline__ float sigmoidf_(float x) { return __builtin_amdgcn_rcpf(1.0f + __expf(-x)); }
__device__ __forceinline__ float siluf_(float x) { return x * sigmoidf_(x); }
__device__ __forceinline__ float geluf_(float x) { return x * sigmoidf_(1.5957691216057308f * (x + 0.044715f * x * x * x)); }
__device__ __forceinline__ float logg_of(int h) {
    float r = -0.0317486983145803f;
    r = h == 1 ? -0.015748356968139168f : r; r = h == 2 ? -0.007843177461025893f : r; r = h == 3 ? -0.003913899321136329f : r;
    r = h == 4 ? -0.0019550348358033506f : r; r = h == 5 ? -0.0009770396478266127f : r; r = h == 6 ? -0.0004884004981088745f : r; r = h == 7 ? -0.0002441704321739145f : r;
    return r;
}

namespace pg8 {
constexpr int BM = 256, BK = 64, HALF = 128, HTB = HALF * BK * 2, STAGE_BYTES = 8 * HTB, NXCD = 8, WGM = 8;
__host__ __device__ __forceinline__ int lds_byte(int r, int c) { const int st = (r >> 4) * 2 + (c >> 5), rr = r & 15, cc = c & 31, ob = rr * 64 + cc * 2; return st * 1024 + (ob ^ (((ob >> 9) & 1) << 5)); }
__host__ __device__ __forceinline__ void stage_rc(int b, int& R, int& C) { const int st = b / 1024, sb = b % 1024, swz = sb ^ (((sb >> 9) & 1) << 5); R = (st >> 1) * 16 + swz / 64; C = (st & 1) * 32 + (swz % 64) / 2; }
__host__ __device__ __forceinline__ int perm32(int rho) { const int n = rho >> 4, i = rho & 15; return 8 * (i >> 2) + 4 * n + (i & 3); }

struct Unit { int pm, pn, half; };
struct Gemm { const bf16_t* A; const bf16_t* Bt; int lda, K; size_t aoff2, boff2; };

struct StaticOrder {
    int nM, nN, nwg, G, c, pairs;
    __device__ void init(int M, int N, int G_, int c_, int pairs_) { nM = M / BM; nN = N / BM; nwg = nM * nN; G = G_; c = c_; pairs = pairs_; }
    __device__ bool next(int i, Unit& u) const {
        const int it = (pairs == 2) ? (i >> 1) : i;
        const long L = (long)it * G + c; if (L >= nwg) return false;
        int wgid = (int)L; { const int q = nwg / NXCD, r = nwg % NXCD, xcd = wgid % NXCD, off = wgid / NXCD; wgid = (xcd < r ? xcd * (q + 1) : r * (q + 1) + (xcd - r) * q) + off; }
        const int nig = WGM * nN, gid = wgid / nig, fm = gid * WGM, gsz = (nM - fm) < WGM ? (nM - fm) : WGM;
        u.pm = fm + ((wgid % nig) % gsz); u.pn = (wgid % nig) / gsz; u.half = (pairs == 2) ? (i & 1) : 0; return true;
    }
};

template <class Epi, class Sched, bool ALIGN_EPI>
__device__ __forceinline__ void gemm_phase(ldsp_t lds, const Gemm g, const Sched& S, const Epi& E, const int tid) {
    const int wid = __builtin_amdgcn_readfirstlane(tid >> 6), lane = tid & 63, wr = wid >> 2, wc = wid & 3, fr = lane & 15, fq = lane >> 4;
    const int K = g.K, nt = K / BK;
    unsigned voffA[2], voffB[2];
#pragma unroll
    for (int i = 0; i < 2; ++i) { int R, C; stage_rc(tid * 16 + i * 8192, R, C); const int Rb = Epi::PERM ? ((R & ~31) + perm32(R & 31)) : R;
        voffA[i] = (unsigned)(R * g.lda + C) * 2u; voffB[i] = (unsigned)(Rb * K + C) * 2u; }
    const size_t kstep = (size_t)(BK * 2);
    const size_t hstepA = (size_t)HALF * g.lda * 2, hstepB = (size_t)HALF * K * 2;
    const size_t tstepA = 2 * hstepA, tstepB = 2 * hstepB;
    const unsigned ldsw = (unsigned)wid * 1024u;
    const int aoff = lds_byte(wr * 64 + fr, fq * 8), boff = lds_byte(wc * 32 + fr, fq * 8);
#define PG8_SA(b, h) (((b) * 2 + (h)) * HTB)
#define PG8_SB(b, h) ((4 + (b) * 2 + (h)) * HTB)
#define PG8_STAGE(bufoff, gbase, voff) do { _Pragma("unroll") for (int _i = 0; _i < 2; ++_i) \
        __builtin_amdgcn_global_load_lds((const unsigned*)((const char*)(gbase) + (voff)[_i]), (LAS unsigned*)(lds + (bufoff) + ldsw + _i * 8192), 16, 0, 0); } while (0)
#define PG8_LDA(dst, b, h) do { _Pragma("unroll") for (int m = 0; m < 4; ++m) _Pragma("unroll") for (int k = 0; k < 2; ++k) dst[m][k] = *(const LAS bf16x8*)(lds + PG8_SA(b, h) + aoff + m * 2048 + k * 1024); } while (0)
#define PG8_LDB(dst, b, h) do { _Pragma("unroll") for (int n = 0; n < 2; ++n) _Pragma("unroll") for (int k = 0; k < 2; ++k) dst[n][k] = *(const LAS bf16x8*)(lds + PG8_SB(b, h) + boff + n * 2048 + k * 1024); } while (0)
#define PG8_MMA(ai, bj, At, Bt) do { __builtin_amdgcn_s_setprio(1); _Pragma("unroll") for (int m = 0; m < 4; ++m) _Pragma("unroll") for (int n = 0; n < 2; ++n) _Pragma("unroll") for (int k = 0; k < 2; ++k) \
        acc[ai][bj][m][n] = __builtin_amdgcn_mfma_f32_16x16x32_bf16(Bt[n][k], At[m][k], acc[ai][bj][m][n], 0, 0, 0); __builtin_amdgcn_s_setprio(0); } while (0)
#define PG8_WAIT_V(n) asm volatile("s_waitcnt vmcnt(" #n ")" ::: "memory")
#define PG8_WAIT_L(n) asm volatile("s_waitcnt lgkmcnt(" #n ")" ::: "memory")
#define PG8_BAR __builtin_amdgcn_s_barrier()
#define PG8_SCHED __builtin_amdgcn_sched_barrier(0)
    Unit cur, nxt; int ui = 0;
    if (!S.next(0, cur)) return;
    f32x4 acc[2][2][4][2];
#pragma unroll
    for (int a = 0; a < 2; ++a)
#pragma unroll
        for (int b = 0; b < 2; ++b)
#pragma unroll
            for (int m = 0; m < 4; ++m)
#pragma unroll
                for (int n = 0; n < 2; ++n) acc[a][b][m][n] = (f32x4){0.f, 0.f, 0.f, 0.f};
    bf16x8 At[4][2], B0[2][2], B1[2][2];
    const char* cA = (const char*)g.A + (size_t)cur.pm * tstepA + (cur.half ? g.aoff2 : 0); const char* cB = (const char*)g.Bt + (size_t)cur.pn * tstepB + (cur.half ? g.boff2 : 0);
    PG8_STAGE(PG8_SB(0, 0), cB, voffB); PG8_STAGE(PG8_SB(0, 1), cB + hstepB, voffB); PG8_STAGE(PG8_SA(0, 0), cA, voffA); PG8_STAGE(PG8_SA(0, 1), cA + hstepA, voffA);
    if (wr == 1) PG8_BAR;
    PG8_WAIT_V(2); PG8_BAR;
    PG8_STAGE(PG8_SB(1, 0), cB + kstep, voffB); PG8_STAGE(PG8_SA(1, 0), cA + kstep, voffA); PG8_STAGE(PG8_SB(1, 1), cB + hstepB + kstep, voffB);
    PG8_WAIT_V(6); PG8_BAR;
    for (;;) {
        const bool has_next = S.next(ui + 1, nxt);
        const char* nA = has_next ? (const char*)g.A + (size_t)nxt.pm * tstepA + (nxt.half ? g.aoff2 : 0) : cA;
        const char* nB = has_next ? (const char*)g.Bt + (size_t)nxt.pn * tstepB + (nxt.half ? g.boff2 : 0) : cB;
        for (int t = 0; t < nt; t += 2) {
            const bool last = (t == nt - 2);
            const char* a1 = cA + (size_t)(t + 1) * kstep;
            const char* a2 = last ? nA : cA + (size_t)(t + 2) * kstep; const char* b2 = last ? nB : cB + (size_t)(t + 2) * kstep;
            const char* a3 = a2 + kstep; const char* b3 = b2 + kstep;
            PG8_LDB(B0, 0, 0); PG8_LDB(B1, 0, 1); PG8_SCHED; PG8_LDA(At, 0, 0); PG8_STAGE(PG8_SA(1, 1), a1 + hstepA, voffA);
            PG8_WAIT_V(8); PG8_WAIT_L(0); PG8_BAR; PG8_MMA(0, 0, At, B0); PG8_MMA(0, 1, At, B1); PG8_BAR; PG8_SCHED;
            PG8_LDA(At, 0, 1); PG8_STAGE(PG8_SB(0, 0), b2, voffB); PG8_STAGE(PG8_SB(0, 1), b2 + hstepB, voffB); PG8_STAGE(PG8_SA(0, 0), a2, voffA);
            PG8_WAIT_V(8); PG8_WAIT_L(0); PG8_BAR; PG8_MMA(1, 0, At, B0); PG8_MMA(1, 1, At, B1); PG8_BAR; PG8_SCHED;
            PG8_LDB(B0, 1, 0); PG8_LDB(B1, 1, 1); PG8_SCHED; PG8_LDA(At, 1, 0); PG8_STAGE(PG8_SA(0, 1), a2 + hstepA, voffA);
            PG8_WAIT_V(8); PG8_WAIT_L(0); PG8_BAR; PG8_MMA(0, 0, At, B0); PG8_MMA(0, 1, At, B1); PG8_BAR; PG8_SCHED;
            PG8_LDA(At, 1, 1); PG8_STAGE(PG8_SB(1, 0), b3, voffB); PG8_STAGE(PG8_SB(1, 1), b3 + hstepB, voffB); PG8_STAGE(PG8_SA(1, 0), a3, voffA);
            PG8_WAIT_V(8); PG8_WAIT_L(0); PG8_BAR; PG8_MMA(1, 0, At, B0); PG8_MMA(1, 1, At, B1); PG8_BAR; PG8_SCHED;
        }
        if constexpr (ALIGN_EPI) { if (wr == 0) PG8_BAR; }
        E(acc, cur, wr, wc, fr, fq);
        if (!has_next) break;
#pragma unroll
        for (int a = 0; a < 2; ++a)
#pragma unroll
            for (int b = 0; b < 2; ++b)
#pragma unroll
                for (int m = 0; m < 4; ++m)
#pragma unroll
                    for (int n = 0; n < 2; ++n) acc[a][b][m][n] = (f32x4){0.f, 0.f, 0.f, 0.f};
        cur = nxt; cA = nA; cB = nB; ++ui;
        if constexpr (ALIGN_EPI) { if (wr == 1) PG8_BAR; }
    }
    PG8_WAIT_V(0);
    if constexpr (!ALIGN_EPI) { if (wr == 0) PG8_BAR; }
    PG8_BAR;
#undef PG8_SA
#undef PG8_SB
#undef PG8_STAGE
#undef PG8_LDA
#undef PG8_LDB
#undef PG8_MMA
#undef PG8_WAIT_V
#undef PG8_WAIT_L
#undef PG8_BAR
#undef PG8_SCHED
}
}

typedef GAS unsigned gu32;
#define XB_TMO      128
#define XB_XCNT(j)  (256  + 64 * (j))
#define XB_XSUB(j)  (1280 + 64 * (j))
#define XB_XGEN(j)  (2304 + 64 * (j))
#define XB_TOP      3328
#define XB_TOPGEN   3392
#define XCD_BAR_WORDS 3456
#define XB_SPIN_CAP (1u << 18)
__device__ __forceinline__ unsigned xb_ld(unsigned* p)              { return __hip_atomic_load(p, __ATOMIC_RELAXED, __HIP_MEMORY_SCOPE_AGENT); }
__device__ __forceinline__ unsigned xb_add(unsigned* p, unsigned v) { return __hip_atomic_fetch_add(p, v, __ATOMIC_RELAXED, __HIP_MEMORY_SCOPE_AGENT); }
__device__ __forceinline__ unsigned xb_xcc_id() { return (unsigned)__builtin_amdgcn_s_getreg((3 << 11) | 20) & 0xFu; }
#define XB_SPIN(cond, bar) do { unsigned _sp = 0; while (cond) { __builtin_amdgcn_s_sleep(1); \
    if ((++_sp & 255u) == 0u) { if (xb_ld(&(bar)[XB_TMO])) break; if (_sp > XB_SPIN_CAP) { atomicAdd(&(bar)[XB_TMO], 1u); break; } } } } while (0)
struct XcdBarrier { unsigned* bar; unsigned x; volatile LAS unsigned* st; };
__device__ __forceinline__ XcdBarrier xcd_barrier_post(unsigned* bar, volatile LAS unsigned* st) {
    XcdBarrier b; b.bar = bar; b.x = (unsigned)__builtin_amdgcn_readfirstlane((int)xb_xcc_id()); b.st = st;
    if (threadIdx.x == 0) (void)xb_add(&bar[XB_XCNT(b.x)], 1u);
    return b;
}
__device__ __forceinline__ void xcd_barrier_complete(unsigned* bar, unsigned x, unsigned& nloc, unsigned& nx) {
    const unsigned G = gridDim.x * gridDim.y * gridDim.z;
    unsigned sum, cnt, mine, sp = 0u;
    for (;;) {
        sum = 0u; cnt = 0u; mine = 0u;
#pragma unroll
        for (unsigned j = 0; j < 16; ++j) { const unsigned c = xb_ld(&bar[XB_XCNT(j)]); sum += c; cnt += (c > 0u) ? 1u : 0u; mine = (j == x) ? c : mine; }
        if (sum == G) break;
        __builtin_amdgcn_s_sleep(1);
        if ((++sp & 255u) == 0u) { if (xb_ld(&bar[XB_TMO])) break; if (sp > XB_SPIN_CAP) { atomicAdd(&bar[XB_TMO], 1u); break; } }
    }
    nloc = mine > 0u ? mine : 1u; nx = cnt > 0u ? cnt : 1u;
}
__device__ __forceinline__ void xcd_barrier(const XcdBarrier& b) {
    asm volatile("s_waitcnt vmcnt(0)" ::: "memory");
    __syncthreads();
    if (threadIdx.x == 0) {
        unsigned* bar = b.bar; const unsigned bx = (unsigned)__builtin_amdgcn_readfirstlane((int)b.x);
        __builtin_amdgcn_s_waitcnt(0);
        unsigned nloc = b.st[0], nx = b.st[1];
        if (nloc == 0u) { xcd_barrier_complete(bar, bx, nloc, nx); b.st[0] = nloc; b.st[1] = nx; }
        const unsigned old = xb_add(&bar[XB_XSUB(bx)], 1u);
        const unsigned gen = old / nloc;
        if (old + 1u == (gen + 1u) * nloc) {
            __builtin_amdgcn_fence(__ATOMIC_RELEASE, "agent");
            asm volatile("s_waitcnt vmcnt(0)" ::: "memory");
            const unsigned og = xb_add(&bar[XB_TOP], 1u);
            const unsigned tg = og / nx;
            if (og + 1u == (tg + 1u) * nx) xb_add(&bar[XB_TOPGEN], 1u);
            else XB_SPIN(xb_ld(&bar[XB_TOPGEN]) == tg, bar);
            __builtin_amdgcn_fence(__ATOMIC_ACQUIRE, "agent");
            xb_add(&bar[XB_XGEN(bx)], 1u);
            asm volatile("s_waitcnt vmcnt(0)" ::: "memory");
        } else {
            XB_SPIN(xb_ld(&bar[XB_XGEN(bx)]) == gen, bar);
            __builtin_amdgcn_fence(__ATOMIC_ACQUIRE, "agent");
            asm volatile("s_waitcnt vmcnt(0)" ::: "memory");
        }
    }
    __syncthreads();
}

struct Frame {
    ldsp_t lds;
    volatile LAS unsigned* MISC;
    unsigned* ctl;
    int tid, lane, wave, vcu, G;
    const float* const* in;
    unsigned char* ws;
    float* out;
};
struct Args { const float* in[24]; float* out; unsigned char* ws; int ph_lo, ph_hi; };

__device__ __forceinline__ float wave_sum(float v) {
#pragma unroll
    for (int o = 1; o < 64; o <<= 1) v += __shfl_xor(v, o);
    return v;
}

__device__ __forceinline__ void p0_transpose_item(const float* W, int K, int N, bf16_t* WT, int ldk, const float* rowscale, float colscale, bool qkperm, LAS float* scr, int item, int lane) {
    const int nblk = N / 32, kb = item / nblk, nb = item % nblk, k0 = 64 * kb, n0 = 32 * nb;
    int srcn = n0 + (lane & 31);
    if (qkperm) { const int p = srcn & 63; srcn = (srcn & ~63) + ((p & 1) ? 32 + (p >> 1) : (p >> 1)); }
#pragma unroll 16
    for (int i = 0; i < 32; ++i) { const int kk = 2 * i + (lane >> 5); float v = W[(size_t)(k0 + kk) * N + srcn] * colscale; if (rowscale) v *= rowscale[k0 + kk]; scr[kk * 33 + (lane & 31)] = v; }
    LDS_WAIT(); asm volatile("" ::: "memory");
    const int c = lane & 7;
#pragma unroll
    for (int j = 0; j < 4; ++j) { const int n = (lane >> 3) + 8 * j; const LAS float* s = scr + (8 * c) * 33 + n;
        u32x4 o; o.x = pk2(s[0 * 33], s[1 * 33]); o.y = pk2(s[2 * 33], s[3 * 33]); o.z = pk2(s[4 * 33], s[5 * 33]); o.w = pk2(s[6 * 33], s[7 * 33]);
        *(u32x4*)(WT + (size_t)(n0 + n) * ldk + k0 + 8 * c) = o; }
    LDS_WAIT(); asm volatile("" ::: "memory");
}

__device__ __forceinline__ void p0_xrow(const float* xrow, bf16_t* orow, float* rss, int lane) {
    const f32x4* xr = (const f32x4*)xrow + lane;
    f32x4 v[4]; float s = 0.f;
#pragma unroll
    for (int j = 0; j < 4; ++j) { v[j] = xr[64 * j]; s += (v[j].x * v[j].x + v[j].y * v[j].y) + (v[j].z * v[j].z + v[j].w * v[j].w); }
    s = wave_sum(s);
    u32x2* o8 = (u32x2*)orow + lane;
#pragma unroll
    for (int j = 0; j < 4; ++j) { u32x2 w; w.x = pk2(v[j].x, v[j].y); w.y = pk2(v[j].z, v[j].w); o8[64 * j] = w; }
    if (lane == 0) *rss = s;
}

__device__ __forceinline__ void p0_tabrow(const float* row, unsigned char* img, float* isc, int e, int lane) {
    const f32x4* xr = (const f32x4*)row + lane;
    f32x4 v[4]; float am = 0.f;
#pragma unroll
    for (int j = 0; j < 4; ++j) { v[j] = xr[64 * j]; am = fmaxf(am, fmaxf(fmaxf(fabsf(v[j].x), fabsf(v[j].y)), fmaxf(fabsf(v[j].z), fabsf(v[j].w)))); }
#pragma unroll
    for (int o = 1; o < 64; o <<= 1) am = fmaxf(am, __shfl_xor(am, o));
    const float sc = am > 0.f ? exp2f(floorf(log2f(224.0f / am))) : 1.0f;
#pragma unroll
    for (int j = 0; j < 4; ++j) { const int col = 256 * j + 4 * lane, sl = col >> 7, w = col & 127;
        int pk = __builtin_amdgcn_cvt_pk_fp8_f32(v[j].x * sc, v[j].y * sc, 0, false);
        pk = __builtin_amdgcn_cvt_pk_fp8_f32(v[j].z * sc, v[j].w * sc, pk, true);
        *(int*)(img + ((size_t)sl * NEXP + e) * 128 + w) = pk; }
    if (lane == 0) isc[e] = 1.0f / sc;
}

__device__ __forceinline__ void p0_prologue(const Args& a, Frame& F) {
    unsigned char* ws = a.ws;
    LAS float* scr = (LAS float*)(F.lds + F.wave * 16384);
    const int gw = F.vcu * NWAVES + F.wave, NGW = F.G * NWAVES, lane = F.lane;
    constexpr int I_IN = (DM / 64) * (NIN / 32), I_SQ = (DM / 64) * (DM / 32), I_Q = (DM / 64) * (2048 / 32), I_G = 2;
    constexpr int PER_L = I_IN + 3 * I_SQ + I_Q + 32 * I_G;
    for (int it = gw; it < DEPTH * PER_L; it += NGW) {
        const int l = it / PER_L; int r = it % PER_L;
        if (r < I_IN) { const int nb = r % (NIN / 32), n0 = nb * 32; const int seg = n0 >> 9;
            p0_transpose_item(a.in[8] + (size_t)l * DM * NIN, DM, NIN, (bf16_t*)(ws + WS_WIN) + (size_t)l * NIN * DM, DM, a.in[5] + l * DM, seg == 1 ? 0.125f : 1.0f, seg <= 1, scr, r, lane); continue; }
        r -= I_IN;
        if (r < I_SQ) { p0_transpose_item(a.in[10] + (size_t)l * DM * DM, DM, DM, (bf16_t*)(ws + WS_WMIX + (size_t)l * 6 * MiB), DM, a.in[9] + l * DM, 1.0f, false, scr, r, lane); continue; }
        r -= I_SQ;
        if (r < I_SQ) { p0_transpose_item(a.in[18] + (size_t)l * DM * DM, DM, DM, (bf16_t*)(ws + WS_WMIX + (size_t)l * 6 * MiB + 2 * MiB), DM, nullptr, 1.0f, false, scr, r, lane); continue; }
        r -= I_SQ;
        if (r < I_SQ) { p0_transpose_item(a.in[19] + (size_t)l * DM * DM, DM, DM, (bf16_t*)(ws + WS_WMIX + (size_t)l * 6 * MiB + 4 * MiB), DM, nullptr, 1.0f, false, scr, r, lane); continue; }
        r -= I_SQ;
        if (r < I_Q) { p0_transpose_item(a.in[20] + (size_t)l * DM * 2048, DM, 2048, (bf16_t*)(ws + WS_WQ) + (size_t)l * 2048 * DM, DM, a.in[6] + l * DM, 1.0f, false, scr, r, lane); continue; }
        r -= I_Q;
        { const int mat = r >> 1, sub = r & 1, nb = mat >> 1, gsel = mat & 1;
          const float* W = (gsel ? a.in[15] : a.in[13]) + ((size_t)l * NBLK + nb) * BS * BS;
          bf16_t* WT = (bf16_t*)(ws + WS_WG) + (((size_t)l * NBLK + nb) * 2 + gsel) * BS * BS;
          p0_transpose_item(W, BS, BS, WT, BS, nullptr, 1.0f, false, scr, sub, lane); }
    }
    { const float* ksrc = a.in[21]; bf16_t* kdst = (bf16_t*)(ws + WS_KEYS); const int n4 = DEPTH * PH * 2 * NKEY * HK / 4;
      for (int i = gw * 64 + lane; i < n4; i += NGW * 64) { const f32x4 v = ((const f32x4*)ksrc)[i]; u32x2 o; o.x = pk2(v.x, v.y); o.y = pk2(v.z, v.w); ((u32x2*)kdst)[i] = o; } }
    for (int m = gw; m < MTOT; m += 2 * NGW) {
        const int m2 = m + NGW; const bool v2 = m2 < MTOT; const int mm2 = v2 ? m2 : m;
        const f32x4* x1 = (const f32x4*)(m < M_P ? a.in[0] + (size_t)m * DM : a.in[1] + (size_t)(m - M_P) * DM) + lane;
        const f32x4* x2 = (const f32x4*)(mm2 < M_P ? a.in[0] + (size_t)mm2 * DM : a.in[1] + (size_t)(mm2 - M_P) * DM) + lane;
        f32x4 v[8]; float s1 = 0.f, s2 = 0.f;
#pragma unroll
        for (int j = 0; j < 4; ++j) { v[j] = x1[64 * j]; v[4 + j] = x2[64 * j]; }
#pragma unroll
        for (int j = 0; j < 4; ++j) { s1 += (v[j].x * v[j].x + v[j].y * v[j].y) + (v[j].z * v[j].z + v[j].w * v[j].w); s2 += (v[4 + j].x * v[4 + j].x + v[4 + j].y * v[4 + j].y) + (v[4 + j].z * v[4 + j].z + v[4 + j].w * v[4 + j].w); }
        s1 = wave_sum(s1); s2 = wave_sum(s2);
        u32x2* o1 = (u32x2*)((bf16_t*)(ws + WS_XB) + (size_t)m * DM) + lane; u32x2* o2 = (u32x2*)((bf16_t*)(ws + WS_XB) + (size_t)mm2 * DM) + lane;
#pragma unroll
        for (int j = 0; j < 4; ++j) { u32x2 w; w.x = pk2(v[j].x, v[j].y); w.y = pk2(v[j].z, v[j].w); o1[64 * j] = w; }
        if (v2) {
#pragma unroll
            for (int j = 0; j < 4; ++j) { u32x2 w; w.x = pk2(v[4 + j].x, v[4 + j].y); w.y = pk2(v[4 + j].z, v[4 + j].w); o2[64 * j] = w; } }
        if (lane == 0) { ((float*)(ws + WS_RSS))[m] = s1; if (v2) ((float*)(ws + WS_RSS))[m2] = s2; }
    }
    { float* rot = (float*)(ws + WS_ROT);
      for (int i = gw * 64 + lane; i < 2056 * 32; i += NGW * 64) {
          const int pi = i >> 5, fi = i & 31; const double pos = pi < 2048 ? (double)pi : (double)(PAST + pi - 2048);
          const double f8[8] = {1.0, 0.7498942093324559, 0.5623413251903491, 0.4216965034285822, 0.31622776601683794, 0.23713737056616552, 0.1778279410038923, 0.1333521432163324};
          double fr = 1.0; switch (fi >> 3) { case 1: fr = 0.1; break; case 2: fr = 0.01; break; case 3: fr = 0.001; break; default: break; }
          double fsel = f8[0];
#pragma unroll
          for (int q = 1; q < 8; ++q) fsel = ((fi & 7) == q) ? f8[q] : fsel;
          const double ang = pos * (fr * fsel);
          const double n = __builtin_rint(ang * 0.15915494309189535);
          double rr = __builtin_fma(-n, 6.283185307179586, ang); rr = __builtin_fma(-n, 2.4492935982947064e-16, rr);
          const float rf = (float)rr;
          rot[(size_t)pi * 64 + fi] = cosf(rf); rot[(size_t)pi * 64 + 32 + fi] = sinf(rf);
      } }
}

__device__ __forceinline__ void tab_unit(const Args& a, Frame& F, int l, int cu) {
    unsigned char* ws = a.ws;
#pragma unroll 2
    for (int j = 0; j < 16; ++j) { const int r = cu * 128 + F.wave * 16 + j, t = r >> 14, e = r & (NEXP - 1);
        const float* src = (t ? a.in[23] : a.in[22]) + ((size_t)l * NEXP + e) * DM;
        p0_tabrow(src, ws + WS_TAB + ((size_t)l * 2 + t) * 16 * MiB, (float*)(ws + WS_TSC) + ((size_t)l * 2 + t) * NEXP, e, F.lane); }
}

namespace pg8 {
struct EpiIn {
    static constexpr bool PERM = true;
    bf16_t* P; const float* rss; const float* rot;
    __device__ __forceinline__ void operator()(const f32x4 (&acc)[2][2][4][2], const Unit& u, int wr, int wc, int fr, int fq) const {
        const int seg = u.pn < 4 ? (u.pn >> 1) : (u.pn >> 2) + 1;
        const int row0 = u.pm * BM + wr * 64 + fr;
#if 0
        const float* rstdv = rss + row0;
#define RSTD_AT(ai, m) rstdv[(ai) * HALF + (m) * 16]
#else
        float rstdv[8];
#pragma unroll
        for (int i = 0; i < 8; ++i) rstdv[i] = rss[row0 + (i >> 2) * HALF + (i & 3) * 16];
#define RSTD_AT(ai, m) rstdv[(ai) * 4 + (m)]
#endif
        if (seg <= 1) {
            float lg[2];
#pragma unroll
            for (int bj = 0; bj < 2; ++bj) { const int hh = 4 * (u.pn & 1) + 2 * bj + (wc >> 1); lg[bj] = logg_of(hh); }
            const int i0 = 16 * (wc & 1) + 4 * fq;
#pragma unroll
            for (int ai = 0; ai < 2; ++ai)
#pragma unroll
                for (int m = 0; m < 4; ++m) {
                    const int row = row0 + ai * HALF + m * 16;
                    const float rstd = rsqrtf(RSTD_AT(ai, m) * (1.0f / DM) + EPS);
                    asm volatile("" ::: "memory");
                    const int pi = row < M_P ? (row & (SEQ - 1)) : SEQ + ((row - M_P) & (DECT - 1));
                    const float jj1 = (float)((row < M_P ? (row & (CH - 1)) : ((row - M_P) & (DECT - 1))) + 1);
                    const float* rp = rot + (size_t)pi * 64 + i0;
#pragma unroll
                    for (int bj = 0; bj < 2; ++bj) {
                        const int hh = 4 * (u.pn & 1) + 2 * bj + (wc >> 1);
                        const float f = __expf(seg == 0 ? jj1 * lg[bj] : -jj1 * lg[bj]) * rstd;
                        bf16_t* dst = P + (size_t)row * LDP + seg * 512 + hh * 64 + i0;
#pragma unroll
                        for (int n = 0; n < 2; ++n) {
                            const f32x2 c2 = *(const f32x2*)(rp + 2 * n), s2 = *(const f32x2*)(rp + 32 + 2 * n);
                            const f32x4 v = acc[ai][bj][m][n];
                            const float a0 = (v[0] * c2.x - v[1] * s2.x) * f, a1 = (v[2] * c2.y - v[3] * s2.y) * f;
                            const float b0 = (v[0] * s2.x + v[1] * c2.x) * f, b1 = (v[2] * s2.y + v[3] * c2.y) * f;
                            *(unsigned*)(dst + 2 * n) = pk2(a0, a1); *(unsigned*)(dst + 32 + 2 * n) = pk2(b0, b1);
                        }
                    }
                    if (m & 1) asm volatile("" ::: "memory");
                }
        } else {
            const int col0 = u.pn * BM + wc * 32 + 8 * fq;
            const bool has_act = (seg == 3) || (seg >= 5), is_sig = seg >= 6;
            const float c1 = (seg == 5) ? 1.5957691216057308f : 1.0f, c3 = (seg == 5) ? 1.5957691216057308f * 0.044715f : 0.0f;
#pragma unroll
            for (int ai = 0; ai < 2; ++ai)
#pragma unroll
                for (int m = 0; m < 4; ++m) {
                    const int row = row0 + ai * HALF + m * 16;
                    const float rstd = rsqrtf(RSTD_AT(ai, m) * (1.0f / DM) + EPS);
                    bf16_t* rowp = P + (size_t)row * LDP + col0;
#pragma unroll
                    for (int bj = 0; bj < 2; ++bj) {
                        f32x4 v0 = acc[ai][bj][m][0] * rstd, v1 = acc[ai][bj][m][1] * rstd;
                        if (has_act) {
#pragma unroll
                            for (int j = 0; j < 4; ++j) { const float a0 = v0[j], a1 = v1[j];
                                const float s0 = sigmoidf_(a0 * (c1 + c3 * a0 * a0)), s1 = sigmoidf_(a1 * (c1 + c3 * a1 * a1));
                                v0[j] = (is_sig ? 1.0f : a0) * s0; v1[j] = (is_sig ? 1.0f : a1) * s1; }
                        }
                        u32x4 w; w.x = pk2(v0[0], v0[1]); w.y = pk2(v0[2], v0[3]); w.z = pk2(v1[0], v1[1]); w.w = pk2(v1[2], v1[3]);
                        *(u32x4*)(rowp + bj * HALF) = w;
                    }
                }
        }
    }
};

struct EpiMerge {
    static constexpr bool PERM = true;
    bf16_t* P; bf16_t* MRG;
    __device__ __forceinline__ void operator()(const f32x4 (&acc)[2][2][4][2], const Unit& u, int wr, int wc, int fr, int fq) const {
        const int row0 = u.pm * BM + wr * 64 + fr, col0 = u.pn * BM + wc * 32 + 8 * fq;
        const int gc = u.half ? PC_GB : PC_GA;
#pragma unroll
        for (int ai = 0; ai < 2; ++ai)
#pragma unroll
            for (int m = 0; m < 4; ++m) {
                bf16_t* rowp = P + (size_t)(row0 + ai * HALF + m * 16) * LDP; bf16_t* mrow = MRG + (size_t)(row0 + ai * HALF + m * 16) * DM;
#pragma unroll
                for (int bj = 0; bj < 2; ++bj) {
                    const int c = col0 + bj * HALF;
                    const u32x4 g = *(const u32x4*)(rowp + gc + c);
                    f32x4 v0 = acc[ai][bj][m][0], v1 = acc[ai][bj][m][1];
                    v0[0] *= bflo(g.x); v0[1] *= bfhi(g.x); v0[2] *= bflo(g.y); v0[3] *= bfhi(g.y);
                    v1[0] *= bflo(g.z); v1[1] *= bfhi(g.z); v1[2] *= bflo(g.w); v1[3] *= bfhi(g.w);
                    if (u.half) { const u32x4 p = *(const u32x4*)(mrow + c);
                        v0[0] += bflo(p.x); v0[1] += bfhi(p.x); v0[2] += bflo(p.y); v0[3] += bfhi(p.y);
                        v1[0] += bflo(p.z); v1[1] += bfhi(p.z); v1[2] += bflo(p.w); v1[3] += bfhi(p.w); }
                    u32x4 w; w.x = pk2(v0[0], v0[1]); w.y = pk2(v0[2], v0[3]); w.z = pk2(v1[0], v1[1]); w.w = pk2(v1[2], v1[3]);
                    *(u32x4*)(mrow + c) = w;
                }
                if (m == 3) asm volatile("" ::: "memory");
            }
    }
};

struct EpiWo {
    static constexpr bool PERM = false;
    const float* xp; const float* xs;
    float* X; bf16_t* XB; float* rssp;
    __device__ __forceinline__ void operator()(const f32x4 (&acc)[2][2][4][2], const Unit& u, int wr, int wc, int fr, int fq) const {
        const int row0 = u.pm * BM + wr * 64 + fr, col0 = u.pn * BM + wc * 32 + 4 * fq;
#pragma unroll
        for (int ai = 0; ai < 2; ++ai)
#pragma unroll
            for (int m = 0; m < 4; ++m) {
                const int row = row0 + ai * HALF + m * 16;
                const float* src = (row < M_P ? xp + (size_t)row * DM : xs + (size_t)(row - M_P) * DM) + col0;
                float* dst = X + (size_t)row * DM + col0; bf16_t* dstb = XB + (size_t)row * DM + col0;
                float ss = 0.f;
#pragma unroll
                for (int bj = 0; bj < 2; ++bj)
#pragma unroll
                    for (int n = 0; n < 2; ++n) {
                        const f32x4 o = *(const f32x4*)(src + bj * HALF + n * 16) + acc[ai][bj][m][n];
                        *(f32x4*)(dst + bj * HALF + n * 16) = o;
                        u32x2 w; w.x = pk2(o[0], o[1]); w.y = pk2(o[2], o[3]); *(u32x2*)(dstb + bj * HALF + n * 16) = w;
                        ss += (o[0] * o[0] + o[1] * o[1]) + (o[2] * o[2] + o[3] * o[3]);
                    }
                ss += __shfl_xor(ss, 16); ss += __shfl_xor(ss, 32);
                if (fq == 0) rssp[(size_t)(u.pn * 4 + wc) * MTOT + row] = ss;
                if (m == 3) asm volatile("" ::: "memory");
            }
    }
};

struct EpiQ {
    static constexpr bool PERM = true;
    bf16_t* P; const float* rssp; float* rss2;
    __device__ __forceinline__ void operator()(const f32x4 (&acc)[2][2][4][2], const Unit& u, int wr, int wc, int fr, int fq) const {
        const int row0 = u.pm * BM + wr * 64 + fr, col0 = u.pn * BM + wc * 32 + 8 * fq;
        float rstdv[8];
#pragma unroll
        for (int i = 0; i < 8; ++i) { const int row = row0 + (i >> 2) * HALF + (i & 3) * 16; float s = 0.f;
#pragma unroll
            for (int j = 0; j < 16; ++j) s += rssp[(size_t)j * MTOT + row];
            if (u.pn == 0 && wc == 0 && fq == 0) rss2[row] = s;
            rstdv[i] = rsqrtf(s * (1.0f / DM) + EPS);
            if ((i & 3) == 3) asm volatile("" ::: "memory"); }
#pragma unroll
        for (int ai = 0; ai < 2; ++ai)
#pragma unroll
            for (int m = 0; m < 4; ++m) {
                const int row = row0 + ai * HALF + m * 16;
                const float rstd = rstdv[ai * 4 + m];
                bf16_t* rowp = P + (size_t)row * LDP + PC_QP + col0;
#pragma unroll
                for (int bj = 0; bj < 2; ++bj) {
                    const f32x4 v0 = acc[ai][bj][m][0] * rstd, v1 = acc[ai][bj][m][1] * rstd;
                    u32x4 w; w.x = pk2(v0[0], v0[1]); w.y = pk2(v0[2], v0[3]); w.z = pk2(v1[0], v1[1]); w.w = pk2(v1[2], v1[3]);
                    *(u32x4*)(rowp + bj * HALF) = w;
                }
            }
    }
};
}

__device__ __forceinline__ void mma32(f32x16& acc, ldsp_t A, int lda_b, ldsp_t Bt, int ldb_b, int ksteps, int lane) {
    ldsp_t ap = A + (lane & 31) * lda_b + (lane >> 5) * 16;
    ldsp_t bp = Bt + (lane & 31) * ldb_b + (lane >> 5) * 16;
    for (int ks = 0; ks < ksteps; ++ks) {
        const bf16x8 a = *(const LAS bf16x8*)(ap + ks * 32), b = *(const LAS bf16x8*)(bp + ks * 32);
        acc = __builtin_amdgcn_mfma_f32_32x32x16_bf16(a, b, acc, 0, 0, 0);
    }
}
template <int KS>
__device__ __forceinline__ void mma32t(f32x16& acc, ldsp_t A, int lda_b, ldsp_t Bt, int ldb_b, int lane) {
    ldsp_t ap = A + (lane & 31) * lda_b + (lane >> 5) * 16;
    ldsp_t bp = Bt + (lane & 31) * ldb_b + (lane >> 5) * 16;
    bf16x8 av[KS], bv[KS];
#pragma unroll
    for (int ks = 0; ks < KS; ++ks) { av[ks] = *(const LAS bf16x8*)(ap + ks * 32); bv[ks] = *(const LAS bf16x8*)(bp + ks * 32); }
#pragma unroll
    for (int ks = 0; ks < KS; ++ks) acc = __builtin_amdgcn_mfma_f32_32x32x16_bf16(av[ks], bv[ks], acc, 0, 0, 0);
}
#define ZERO16 ((f32x16){0.f,0.f,0.f,0.f,0.f,0.f,0.f,0.f,0.f,0.f,0.f,0.f,0.f,0.f,0.f,0.f})

constexpr int R_QS = 0, R_KS = 18432, R_VS = 43008, R_SS = 83968, R_RST = 118784, R_ST = 137216;
constexpr int LD64 = 144, LDK = 192, LDV = 320, LD128 = 272;
typedef short v4i16_t __attribute__((ext_vector_type(4)));
__device__ __forceinline__ bf16x8 frag_tr(ldsp_t X, int stride_b, int c0, int k0, int lane) {
    const int h = lane >> 5, blk = (lane >> 4) & 1, q = (lane & 15) >> 2, p = lane & 3;
    ldsp_t a = X + (k0 + 8 * h + q) * stride_b + (c0 + 16 * blk + 4 * p) * 2;
    const v4i16_t lo = __builtin_amdgcn_ds_read_tr16_b64_v4i16((LAS v4i16_t*)a), hi = __builtin_amdgcn_ds_read_tr16_b64_v4i16((LAS v4i16_t*)(a + 4 * stride_b));
    return (bf16x8){lo[0], lo[1], lo[2], lo[3], hi[0], hi[1], hi[2], hi[3]};
}
__device__ __forceinline__ bf16x8 frag_row(ldsp_t X, int stride_b, int r0, int k0, int lane) { return *(const LAS bf16x8*)(X + (r0 + (lane & 31)) * stride_b + (k0 + 8 * (lane >> 5)) * 2); }

__device__ __forceinline__ void ret_prompt_unit(const Args& a, Frame& F, int l, int b, int h) {
    const int tid = F.tid, lane = F.lane, w = F.wave, hi = lane >> 5, l31 = lane & 31;
    ldsp_t lds = F.lds;
    const bf16_t* P = (const bf16_t*)(a.ws + WS_P);
    bf16_t* ARET = (bf16_t*)(a.ws + WS_ARET);
    const float lg = logg_of(h), G = __expf(128.0f * lg);
    f32x16 racc = ZERO16;
    const int db = w >> 2, eb = w & 3;
    u32x4 pq[2], pk[2], pv[4], pg[4];
#define RET_FETCH(nn) do { const bf16_t* _b = P + ((size_t)b * SEQ + (nn) * CH) * LDP + h * 64; \
        _Pragma("unroll") for (int i = 0; i < 2; ++i) { const int p = tid + 512 * i; const bf16_t* _r = _b + (size_t)(p >> 3) * LDP + (p & 7) * 8; pq[i] = *(const u32x4*)(_r + PC_Q); pk[i] = *(const u32x4*)(_r + PC_K); } \
        _Pragma("unroll") for (int i = 0; i < 4; ++i) { const int p = tid + 512 * i; const bf16_t* _r = _b + h * 64 + (size_t)(p >> 4) * LDP + (p & 15) * 8; pv[i] = *(const u32x4*)(_r + PC_V); } } while (0)
#define RET_FETCH_G(nn) do { const bf16_t* _b = P + ((size_t)b * SEQ + (nn) * CH) * LDP + h * 128 + PC_GR; \
        _Pragma("unroll") for (int i = 0; i < 4; ++i) { const int p = tid + 512 * i; pg[i] = *(const u32x4*)(_b + (size_t)(p >> 4) * LDP + (p & 15) * 8); } } while (0)
    RET_FETCH(0);
    for (int n = 0; n < 16; ++n) {
        const size_t tok0 = (size_t)b * SEQ + n * CH;
#pragma unroll
        for (int i = 0; i < 2; ++i) { const int p = tid + 512 * i; *(LAS u32x4*)(lds + R_QS + (p >> 3) * LD64 + (p & 7) * 16) = pq[i]; *(LAS u32x4*)(lds + R_KS + (p >> 3) * LDK + (p & 7) * 16) = pk[i]; }
#pragma unroll
        for (int i = 0; i < 4; ++i) { const int p = tid + 512 * i; *(LAS u32x4*)(lds + R_VS + (p >> 4) * LDV + (p & 15) * 16) = pv[i]; }
#pragma unroll
        for (int g = 0; g < 4; ++g) { u32x2 wv; wv.x = pk2(racc[4 * g], racc[4 * g + 1]); wv.y = pk2(racc[4 * g + 2], racc[4 * g + 3]);
            *(LAS u32x2*)(lds + R_RST + (32 * eb + l31) * LD64 + (32 * db + 8 * g + 4 * hi) * 2) = wv; }
        if (n + 1 < 16) RET_FETCH(n + 1);
        RET_FETCH_G(n);
        LBAR();
#pragma unroll
        for (int t2 = 0; t2 < 2; ++t2) { const int t = 2 * w + t2, mb = t >> 2, jb = t & 3;
            if (mb <= jb) { f32x16 sacc = ZERO16;
                bf16x8 af[4], bf[4];
#pragma unroll
                for (int ks = 0; ks < 4; ++ks) { af[ks] = frag_row(lds + R_KS, LDK, 32 * mb, 16 * ks, lane); bf[ks] = frag_row(lds + R_QS, LD64, 32 * jb, 16 * ks, lane); }
#pragma unroll
                for (int ks = 0; ks < 4; ++ks) sacc = __builtin_amdgcn_mfma_f32_32x32x16_bf16(af[ks], bf[ks], sacc, 0, 0, 0);
                const int j = 32 * jb + l31;
#pragma unroll
                for (int g = 0; g < 4; ++g) { const int m0 = 32 * mb + 8 * g + 4 * hi; float v[4];
#pragma unroll
                    for (int q = 0; q < 4; ++q) v[q] = (j >= m0 + q) ? sacc[4 * g + q] : 0.f;
                    u32x2 wv; wv.x = pk2(v[0], v[1]); wv.y = pk2(v[2], v[3]);
                    *(LAS u32x2*)(lds + R_SS + j * LD128 + m0 * 2) = wv; } } }
        LBAR();
        const int jb = w >> 1, eh = w & 1;
        f32x16 oacc[2];
        oacc[0] = ZERO16; oacc[1] = ZERO16;
        { bf16x8 a0[4], a1[4], bf[4];
#pragma unroll
          for (int ks = 0; ks < 4; ++ks) { a0[ks] = frag_row(lds + R_RST, LD64, 32 * (2 * eh), 16 * ks, lane); a1[ks] = frag_row(lds + R_RST, LD64, 32 * (2 * eh + 1), 16 * ks, lane); bf[ks] = frag_row(lds + R_QS, LD64, 32 * jb, 16 * ks, lane); }
#pragma unroll
          for (int ks = 0; ks < 4; ++ks) { oacc[0] = __builtin_amdgcn_mfma_f32_32x32x16_bf16(a0[ks], bf[ks], oacc[0], 0, 0, 0); oacc[1] = __builtin_amdgcn_mfma_f32_32x32x16_bf16(a1[ks], bf[ks], oacc[1], 0, 0, 0); } }
        for (int mbk = 0; mbk <= jb; ++mbk) {
            bf16x8 a0[2], a1[2], bf[2];
#pragma unroll
            for (int ks = 0; ks < 2; ++ks) { const int k0 = 32 * mbk + 16 * ks; a0[ks] = frag_tr(lds + R_VS, LDV, 32 * (2 * eh), k0, lane); a1[ks] = frag_tr(lds + R_VS, LDV, 32 * (2 * eh + 1), k0, lane); bf[ks] = frag_row(lds + R_SS, LD128, 32 * jb, k0, lane); }
#pragma unroll
            for (int ks = 0; ks < 2; ++ks) { oacc[0] = __builtin_amdgcn_mfma_f32_32x32x16_bf16(a0[ks], bf[ks], oacc[0], 0, 0, 0); oacc[1] = __builtin_amdgcn_mfma_f32_32x32x16_bf16(a1[ks], bf[ks], oacc[1], 0, 0, 0); }
        }
        float s1 = 0.f, s2 = 0.f;
#pragma unroll
        for (int t = 0; t < 2; ++t)
#pragma unroll
            for (int r = 0; r < 16; ++r) { s1 += oacc[t][r]; s2 += oacc[t][r] * oacc[t][r]; }
        s1 += __shfl_xor(s1, 32); s2 += __shfl_xor(s2, 32);
        if (hi == 0) *(LAS f32x2*)(lds + R_ST + (eh * 128 + 32 * jb + l31) * 8) = (f32x2){s1, s2};
        LBAR();
        { const int j = 32 * jb + l31;
          const f32x2 sa = *(const LAS f32x2*)(lds + R_ST + j * 8), sb = *(const LAS f32x2*)(lds + R_ST + (128 + j) * 8);
          const float mu = (sa.x + sb.x) * (1.0f / DV), var = (sa.y + sb.y) * (1.0f / DV) - mu * mu, rstd = rsqrtf(fmaxf(var, 0.f) + EPS);
#pragma unroll
          for (int t = 0; t < 2; ++t)
#pragma unroll
              for (int g = 0; g < 4; ++g) { const int e0 = 32 * (2 * eh + t) + 8 * g + 4 * hi;
                  u32x2 wv; wv.x = pk2((oacc[t][4 * g] - mu) * rstd, (oacc[t][4 * g + 1] - mu) * rstd); wv.y = pk2((oacc[t][4 * g + 2] - mu) * rstd, (oacc[t][4 * g + 3] - mu) * rstd);
                  *(LAS u32x2*)(lds + R_SS + j * LD128 + e0 * 2) = wv; } }
#pragma unroll
        for (int kh = 0; kh < 2; ++kh) { bf16x8 af[4], bf[4];
#pragma unroll
          for (int ks = 0; ks < 4; ++ks) { af[ks] = frag_tr(lds + R_KS, LDK, 32 * db, 64 * kh + 16 * ks, lane); bf[ks] = frag_tr(lds + R_VS, LDV, 32 * eb, 64 * kh + 16 * ks, lane); }
#pragma unroll
          for (int ks = 0; ks < 4; ++ks) racc = __builtin_amdgcn_mfma_f32_32x32x16_bf16(af[ks], bf[ks], racc, 0, 0, 0); }
#pragma unroll
        for (int r = 0; r < 16; ++r) racc[r] *= G;
        LBAR();
#pragma unroll
        for (int i = 0; i < 4; ++i) { const int p = tid + 512 * i, row = p >> 4, c = p & 15;
            const u32x4 ov = *(const LAS u32x4*)(lds + R_SS + row * LD128 + c * 16), gv = pg[i];
            u32x4 wv; wv.x = pk2(bflo(ov.x) * bflo(gv.x), bfhi(ov.x) * bfhi(gv.x)); wv.y = pk2(bflo(ov.y) * bflo(gv.y), bfhi(ov.y) * bfhi(gv.y));
            wv.z = pk2(bflo(ov.z) * bflo(gv.z), bfhi(ov.z) * bfhi(gv.z)); wv.w = pk2(bflo(ov.w) * bflo(gv.w), bfhi(ov.w) * bfhi(gv.w));
            *(u32x4*)(ARET + (tok0 + row) * DM + h * 128 + c * 8) = wv; }
    }
    float* so = a.out + O_SRP + ((((size_t)l * NBATCH + b) * HR + h) * DK) * DV;
#pragma unroll
    for (int r = 0; r < 16; ++r) { const int d = 32 * db + (r & 3) + 8 * (r >> 2) + 4 * hi; so[(size_t)d * DV + 32 * eb + l31] = racc[r]; }
#undef RET_FETCH
#undef RET_FETCH_G
}

__device__ __forceinline__ void ret_sample_unit(const Args& a, Frame& F, int l, int bs, int h) {
    const int tid = F.tid, lane = F.lane, w = F.wave;
    LAS float* qd = (LAS float*)F.lds; LAS float* ku = qd + 512; LAS float* vv = ku + 512; LAS float* S = vv + 1024; LAS float* crossp = S + 64; LAS float* red = crossp + 4096;
    bf16_t* P = (bf16_t*)(a.ws + WS_P);
    const size_t tok0 = (size_t)M_P + bs * DECT;
    { const int j = tid >> 6, d = tid & 63; const bf16_t* src = P + (tok0 + j) * LDP + h * 64 + d; qd[tid] = bf1(src[PC_Q]); ku[tid] = bf1(src[PC_K]); }
#pragma unroll
    for (int i = 0; i < 2; ++i) { const int idx = tid + 512 * i, m = idx >> 7, e = idx & 127; vv[idx] = bf1(P[(tok0 + m) * LDP + PC_V + h * 128 + e]); }
    LBAR();
    const int dg = tid >> 7, e = tid & 127;
    const size_t soff = ((((size_t)l * DECB + bs) * HR + h) * DK) * DV;
    const float* r0 = a.in[2] + soff; float* rn = a.out + O_SRS + soff;
    const float lg = logg_of(h), G8 = __expf(8.0f * lg);
    float cross[8];
#pragma unroll
    for (int j = 0; j < 8; ++j) cross[j] = 0.f;
    float rv[16];
#pragma unroll
    for (int dd = 0; dd < 16; ++dd) rv[dd] = r0[(size_t)(dg * 16 + dd) * DV + e];
#pragma unroll
    for (int dd = 0; dd < 16; ++dd) { const int d = dg * 16 + dd; const float r = rv[dd]; float kvs = 0.f;
#pragma unroll
        for (int m = 0; m < 8; ++m) kvs += ku[m * 64 + d] * vv[m * 128 + e];
        rn[(size_t)d * DV + e] = G8 * (r + kvs);
#pragma unroll
        for (int j = 0; j < 8; ++j) cross[j] += qd[j * 64 + d] * r; }
#pragma unroll
    for (int j = 0; j < 8; ++j) crossp[(dg * 8 + j) * 128 + e] = cross[j];
    { const int pr = tid >> 3, part = tid & 7, j = pr >> 3, m = pr & 7; float sp = 0.f;
#pragma unroll
      for (int d = 0; d < 8; ++d) sp += qd[j * 64 + part * 8 + d] * ku[m * 64 + part * 8 + d];
      sp += __shfl_xor(sp, 1); sp += __shfl_xor(sp, 2); sp += __shfl_xor(sp, 4);
      if (part == 0) S[pr] = (j >= m) ? sp : 0.f; }
    LBAR();
    float o[2];
#pragma unroll
    for (int jj = 0; jj < 2; ++jj) { const int j = dg + 4 * jj; float s = 0.f;
#pragma unroll
        for (int g = 0; g < 4; ++g) s += crossp[(g * 8 + j) * 128 + e];
#pragma unroll
        for (int m = 0; m < 8; ++m) s += S[j * 8 + m] * vv[m * 128 + e];
        o[jj] = s;
        const float t1 = wave_sum(s), t2 = wave_sum(s * s);
        if (lane == 0) { red[(jj * 8 + w) * 2] = t1; red[(jj * 8 + w) * 2 + 1] = t2; } }
    LBAR();
#pragma unroll
    for (int jj = 0; jj < 2; ++jj) { const int j = dg + 4 * jj, w0 = 2 * dg;
        const float t1 = red[(jj * 8 + w0) * 2] + red[(jj * 8 + w0 + 1) * 2], t2 = red[(jj * 8 + w0) * 2 + 1] + red[(jj * 8 + w0 + 1) * 2 + 1];
        const float mu = t1 * (1.0f / DV), var = t2 * (1.0f / DV) - mu * mu, rstd = rsqrtf(fmaxf(var, 0.f) + EPS);
        const bf16_t* prow = P + (tok0 + j) * LDP + h * 128 + e;
        ((bf16_t*)(a.ws + WS_ARET))[(tok0 + j) * DM + h * 128 + e] = (bf16_t)f2bf((o[jj] - mu) * rstd * bf1(prow[PC_GR])); }
    LBAR();
}

constexpr int N_XRL = 0, N_XCF = 33536, N_XCB = 66304, N_WGT = 84736, N_CAR = 103168, N_BUF = 107264;
__device__ __forceinline__ void rnn_unit(const Args& a, Frame& F, int l, bool sample, int bg, int nb) {
    const int tid = F.tid, lane = F.lane, w = F.wave, hi = lane >> 5, l31 = lane & 31;
    ldsp_t lds = F.lds;
    LAS float* xrl = (LAS float*)(lds + N_XRL); LAS float* xcf = (LAS float*)(lds + N_XCF); LAS float* car = (LAS float*)(lds + N_CAR); LAS float* bufl = (LAS float*)(lds + N_BUF);
    LAS float* aa = xrl; LAS float* uu = xcf;
    bf16_t* P = (bf16_t*)(a.ws + WS_P);
    const int ch0 = nb * BS;
    { const bf16_t* wg = (const bf16_t*)(a.ws + WS_WG) + ((size_t)l * NBLK + nb) * 2 * BS * BS;
#pragma unroll
      for (int i = 0; i < 2; ++i) { const int p = tid + 512 * i, row = p >> 3, c8 = p & 7; *(LAS u32x4*)(lds + N_WGT + row * LD64 + c8 * 16) = *(const u32x4*)(wg + row * 64 + c8 * 8); } }
    const int cc = tid & 63;
    const float* cwp = a.in[11] + (size_t)l * 4 * DM + ch0 + cc;
    const float cw0 = cwp[0], cw1 = cwp[DM], cw2 = cwp[2 * DM], cw3 = cwp[3 * DM], cbv = a.in[12][l * DM + ch0 + cc];
    const int rb = w >> 1, cb = w & 1, dcol = 32 * cb + l31;
    const float bav = a.in[14][l * DM + ch0 + dcol], bxv = a.in[16][l * DM + ch0 + dcol];
    const float spe = __expf(-a.in[17][l * DM + ch0 + dcol]);
    const float spl = spe > 0.05f ? __logf(1.0f + spe) : spe * (1.0f - spe * (0.5f - spe * (1.0f / 3.0f - 0.25f * spe)));
    const int ntiles = sample ? 1 : 16;
    float hcar = 0.f;
    if (sample) {
        for (int i = tid; i < 16 * 3 * 64; i += NTHREADS) { const int s = i / 192, r = (i / 64) % 3, c = i & 63;
            bufl[i] = a.in[4][(((size_t)l * DECB + bg * 16 + s) * 3 + r) * DM + ch0 + c]; }
    }
    u32x4 pre[3];
#define RNN_FETCH(nn) do { const size_t _t0 = sample ? (size_t)M_P + bg * 128 : (size_t)bg * SEQ + (nn) * 128; _Pragma("unroll") for (int k = 0; k < 3; ++k) { \
        const int p = tid + 512 * k, row = p >> 3, c8 = p & 7; pre[k] = (u32x4){0u, 0u, 0u, 0u}; \
        if (p < 131 * 8 && (row >= 3 || (!sample && (nn) > 0))) pre[k] = *(const u32x4*)(P + (_t0 + row - 3) * LDP + PC_XR + ch0 + c8 * 8); } } while (0)
    RNN_FETCH(0);
    for (int n = 0; n < ntiles; ++n) {
        const size_t tok0 = sample ? (size_t)M_P + bg * 128 : (size_t)bg * SEQ + n * 128;
        unsigned short gl[16];
#pragma unroll
        for (int i = 0; i < 16; ++i) gl[i] = P[(tok0 + 16 * w + i) * LDP + PC_GN + ch0 + cc];
#pragma unroll
        for (int k = 0; k < 3; ++k) { const int p = tid + 512 * k, row = p >> 3, c8 = p & 7;
            if (p < 131 * 8) { const u32x4 v = pre[k]; LAS float* d = xrl + row * 64 + c8 * 8;
                *(LAS f32x4*)d = (f32x4){bflo(v.x), bfhi(v.x), bflo(v.y), bfhi(v.y)}; *(LAS f32x4*)(d + 4) = (f32x4){bflo(v.z), bfhi(v.z), bflo(v.w), bfhi(v.w)}; } }
        LBAR();
        if (n + 1 < ntiles) RNN_FETCH(n + 1);
        { const int tg = tid >> 6;
#pragma unroll 4
          for (int i = 0; i < 16; ++i) { const int t = tg * 16 + i; float x0, x1, x2;
              const float x3 = xrl[(t + 3) * 64 + cc];
              if (sample) { const int s = t >> 3, j = t & 7;
                  x0 = j >= 3 ? xrl[t * 64 + cc] : bufl[(s * 3 + j) * 64 + cc];
                  x1 = j >= 2 ? xrl[(t + 1) * 64 + cc] : bufl[(s * 3 + j + 1) * 64 + cc];
                  x2 = j >= 1 ? xrl[(t + 2) * 64 + cc] : bufl[(s * 3 + j + 2) * 64 + cc];
              } else { x0 = xrl[t * 64 + cc]; x1 = xrl[(t + 1) * 64 + cc]; x2 = xrl[(t + 2) * 64 + cc]; }
              const float xc = cbv + cw0 * x0 + cw1 * x1 + cw2 * x2 + cw3 * x3;
              xcf[t * 64 + cc] = xc; *(LAS bf16_t*)(lds + N_XCB + t * LD64 + cc * 2) = (bf16_t)f2bf(xc); } }
        if (sample) { if (tid < 192) { }     }
        if (sample) { for (int i = tid; i < 16 * 3 * 64; i += NTHREADS) { const int s = i / 192, r = (i / 64) % 3, c = i & 63;
                a.out[O_SCS + (((size_t)l * DECB + bg * 16 + s) * 3 + r) * DM + ch0 + c] = xrl[(3 + s * 8 + 5 + r) * 64 + c]; } }
        else if (n == 15) { if (tid < 192) { const int r = tid >> 6, c = tid & 63; a.out[O_SCP + (((size_t)l * NBATCH + bg) * 3 + r) * DM + ch0 + c] = xrl[(3 + 125 + r) * 64 + c]; } }
        LBAR();
        { f32x16 ar = ZERO16, ai = ZERO16;
          mma32t<4>(ar, lds + N_XCB + rb * 32 * LD64, LD64, lds + N_WGT + (32 * cb) * LD64, LD64, lane);
          mma32t<4>(ai, lds + N_XCB + rb * 32 * LD64, LD64, lds + N_WGT + (64 + 32 * cb) * LD64, LD64, lane);
#pragma unroll
          for (int r = 0; r < 16; ++r) { const int t = 32 * rb + (r & 3) + 8 * (r >> 2) + 4 * hi;
              const float rg = sigmoidf_(ar[r] + bav), ig = sigmoidf_(ai[r] + bxv);
              const float la = -8.0f * rg * spl, av = __expf(la), y2 = 2.0f * la;
              const float om = y2 < -0.3f ? 1.0f - av * av : -y2 * (1.0f + y2 * (0.5f + y2 * (1.0f / 6.0f + y2 * (1.0f / 24.0f + y2 * (1.0f / 120.0f)))));
              const float mult = sqrtf(fmaxf(om, 0.f));
              const float xc = xcf[t * 64 + dcol];
              aa[t * 64 + dcol] = av; uu[t * 64 + dcol] = mult * ig * xc; } }
        LBAR();
        if (!sample) {
            float Ap = 1.f, Hl = 0.f;
#pragma unroll 4
            for (int i = 0; i < 16; ++i) { const int t = 16 * w + i; const float av = aa[t * 64 + cc], uv = uu[t * 64 + cc]; Hl = av * Hl + uv; Ap *= av; }
            car[w * 64 + cc] = Ap; car[512 + w * 64 + cc] = Hl;
            LBAR();
            float hin = hcar, hnext = hcar;
#pragma unroll
            for (int w2 = 0; w2 < 8; ++w2) { const float A2 = car[w2 * 64 + cc], H2 = car[512 + w2 * 64 + cc]; hnext = A2 * hnext + H2; if (w2 < w) hin = hnext; }
            float hh = hin;
#pragma unroll
            for (int i = 0; i < 16; ++i) { const int t = 16 * w + i; hh = aa[t * 64 + cc] * hh + uu[t * 64 + cc];
                ((bf16_t*)(a.ws + WS_ARNN))[(tok0 + t) * DM + ch0 + cc] = (bf16_t)f2bf(hh * bf1(gl[i])); }
            hcar = hnext;
        } else {
#pragma unroll
            for (int s2 = 0; s2 < 2; ++s2) { const int s = 2 * w + s2, bs = bg * 16 + s;
                float hh = a.in[3][((size_t)l * DECB + bs) * DM + ch0 + cc];
#pragma unroll
                for (int j = 0; j < 8; ++j) { const int t = s * 8 + j; hh = aa[t * 64 + cc] * hh + uu[t * 64 + cc];
                    ((bf16_t*)(a.ws + WS_ARNN))[(tok0 + t) * DM + ch0 + cc] = (bf16_t)f2bf(hh * bf1(gl[s2 * 8 + j])); }
                a.out[O_SHS + ((size_t)l * DECB + bs) * DM + ch0 + cc] = hh; }
        }
        LBAR();
    }
    if (!sample && w == 0) a.out[O_SHP + ((size_t)l * NBATCH + bg) * DM + ch0 + cc] = hcar;
#undef RNN_FETCH
}

__device__ __forceinline__ unsigned ord_of(float f) { const unsigned u = __builtin_bit_cast(unsigned, f); return u ^ ((u >> 31) ? 0xFFFFFFFFu : 0x80000000u); }
__device__ __forceinline__ float ord_inv(unsigned o) { const unsigned u = (o >> 31) ? (o ^ 0x80000000u) : ~o; return __builtin_bit_cast(float, u); }
__host__ __device__ constexpr bool cand_ok(int a, int b) { return (a + 1) * (b + 1) <= 16; }

#define CEX(a, b) do { const unsigned _x = (a), _y = (b); (a) = _x > _y ? _x : _y; (b) = _x > _y ? _y : _x; } while (0)
__device__ __forceinline__ void sort16_desc(unsigned (&v)[16]) {
#pragma unroll
    for (int k = 2; k <= 16; k <<= 1)
#pragma unroll
        for (int j = k >> 1; j > 0; j >>= 1)
#pragma unroll
            for (int i = 0; i < 16; ++i) { const int p = i ^ j; if (p > i) { if ((i & k) == 0) CEX(v[i], v[p]); else CEX(v[p], v[i]); } }
}
__device__ __forceinline__ void bitonic_merge16_desc(unsigned (&v)[16]) {
#pragma unroll
    for (int j = 8; j > 0; j >>= 1)
#pragma unroll
        for (int i = 0; i < 16; ++i) { const int p = i ^ j; if (p > i) CEX(v[i], v[p]); }
}
__device__ __forceinline__ void merge_top16(unsigned (&a)[16], const unsigned (&b)[16]) {
#pragma unroll
    for (int i = 0; i < 16; ++i) a[i] = a[i] > b[15 - i] ? a[i] : b[15 - i];
    bitonic_merge16_desc(a);
}

__device__ __forceinline__ void route_unit(const Args& a, int l, int tb, int h, int lane) {
    const int hi = lane >> 5, l31 = lane & 31, token = tb * 32 + l31;
    const bf16_t* P = (const bf16_t*)(a.ws + WS_P);
    const bf16_t* qrow = P + (size_t)token * LDP + PC_QP + h * 256 + hi * 8;
    const bf16_t* kbase = (const bf16_t*)(a.ws + WS_KEYS) + ((size_t)(l * PH + h) * 2) * NKEY * HK + (size_t)l31 * HK + hi * 8;
    unsigned L[2][16];
#pragma unroll
    for (int p = 0; p < 2; ++p) {
        f32x16 acc[4];
#pragma unroll
        for (int kb = 0; kb < 4; ++kb) acc[kb] = ZERO16;
#pragma unroll 2
        for (int ks = 0; ks < 8; ++ks) {
            const bf16x8 bq = *(const bf16x8*)(qrow + p * 128 + ks * 16);
#pragma unroll
            for (int kb = 0; kb < 4; ++kb) { const bf16x8 ak = *(const bf16x8*)(kbase + ((size_t)p * NKEY + kb * 32) * HK + ks * 16);
                acc[kb] = __builtin_amdgcn_mfma_f32_32x32x16_bf16(ak, bq, acc[kb], 0, 0, 0); }
        }
        unsigned g0[16], g1[16];
#pragma unroll
        for (int r = 0; r < 16; ++r) { const int key = (r & 3) + 8 * (r >> 2) + 4 * hi; g0[r] = (ord_of(acc[0][r]) & ~127u) | (unsigned)(127 - key); g1[r] = (ord_of(acc[1][r]) & ~127u) | (unsigned)(127 - (32 + key)); }
        sort16_desc(g0); sort16_desc(g1); merge_top16(g0, g1);
        unsigned g2[16];
#pragma unroll
        for (int r = 0; r < 16; ++r) { const int key = (r & 3) + 8 * (r >> 2) + 4 * hi; g1[r] = (ord_of(acc[2][r]) & ~127u) | (unsigned)(127 - (64 + key)); g2[r] = (ord_of(acc[3][r]) & ~127u) | (unsigned)(127 - (96 + key)); }
        sort16_desc(g1); sort16_desc(g2); merge_top16(g1, g2); merge_top16(g0, g1);
#pragma unroll
        for (int i = 0; i < 16; ++i) g1[i] = (unsigned)__shfl_xor((int)g0[i], 32);
        merge_top16(g0, g1);
#pragma unroll
        for (int i = 0; i < 16; ++i) L[p][i] = g0[i];
    }
    float sa[16], sb[16];
#pragma unroll
    for (int i = 0; i < 16; ++i) { sa[i] = ord_inv(L[0][i] & ~127u); sb[i] = ord_inv(L[1][i] & ~127u); }
#define CKEY(x, y) ((ord_of(sa[x] + sb[y]) & ~255u) | (unsigned)(255 - ((x) * 16 + (y))))
    unsigned best[16], t1[16];
#pragma unroll
    for (int y = 0; y < 16; ++y) { best[y] = CKEY(0, y); t1[y] = y < 8 ? CKEY(1, y) : 0u; }
    merge_top16(best, t1);
    { int n = 0;
#pragma unroll
      for (int x = 2; x < 7; ++x)
#pragma unroll
          for (int y = 0; y < 16; ++y) if (cand_ok(x, y)) { t1[n] = CKEY(x, y); ++n; }
    }
    sort16_desc(t1); merge_top16(best, t1);
    { int n = 0;
#pragma unroll
      for (int x = 7; x < 16; ++x)
#pragma unroll
          for (int y = 0; y < 16; ++y) if (cand_ok(x, y)) { t1[n] = CKEY(x, y); ++n; }
#pragma unroll
      for (int i = 10; i < 16; ++i) t1[i] = 0u;
    }
    sort16_desc(t1); merge_top16(best, t1);
#undef CKEY
    float sc[16], ssum = 0.f; const float mx = ord_inv(best[0] & ~255u);
#pragma unroll
    for (int it = 0; it < 16; ++it) { sc[it] = __expf(ord_inv(best[it] & ~255u) - mx); ssum += sc[it]; }
    const float inv = 1.0f / ssum;
    unsigned* eo = (unsigned*)(a.ws + WS_EIDX) + (size_t)token * 128 + h * 16 + hi * 8;
    float* go = (float*)(a.ws + WS_GATE) + (size_t)token * 128 + h * 16 + hi * 8;
#pragma unroll
    for (int it = 0; it < 8; ++it) {
        unsigned b0 = best[it], b1 = best[it + 8]; float g0 = sc[it], g1 = sc[it + 8];
        asm volatile("" : "+v"(b0), "+v"(b1), "+v"(g0), "+v"(g1));
        const unsigned bsel = hi ? b1 : b0; const float gsel = (hi ? g1 : g0) * inv;
        const unsigned c = 255u - (bsel & 255u), ca = c >> 4, cb = c & 15u;
        unsigned k1 = 0u, k2 = 0u;
#pragma unroll
        for (int i = 0; i < 16; ++i) { k1 = (ca == (unsigned)i) ? (127u - (L[0][i] & 127u)) : k1; k2 = (cb == (unsigned)i) ? (127u - (L[1][i] & 127u)) : k2; }
        eo[it] = k1 * 128u + k2; go[it] = gsel;
    }
}
#undef CEX

constexpr int MAXT = 9;
#define DPPF(v, ctrl) __builtin_bit_cast(float, __builtin_amdgcn_update_dpp(0, __builtin_bit_cast(int, (v)), (ctrl), 0xf, 0xf, true))
constexpr int DPP_XOR1 = 0xB1, DPP_XOR2 = 0x4E, DPP_HMIRROR = 0x141, DPP_ROR8 = 0x128;
__device__ __forceinline__ void dec16p(const u32x4 r, f32x2 (&f)[8]) {
    f[0] = __builtin_amdgcn_cvt_pk_f32_fp8((int)r.x, false); f[1] = __builtin_amdgcn_cvt_pk_f32_fp8((int)r.x, true);
    f[2] = __builtin_amdgcn_cvt_pk_f32_fp8((int)r.y, false); f[3] = __builtin_amdgcn_cvt_pk_f32_fp8((int)r.y, true);
    f[4] = __builtin_amdgcn_cvt_pk_f32_fp8((int)r.z, false); f[5] = __builtin_amdgcn_cvt_pk_f32_fp8((int)r.z, true);
    f[6] = __builtin_amdgcn_cvt_pk_f32_fp8((int)r.w, false); f[7] = __builtin_amdgcn_cvt_pk_f32_fp8((int)r.w, true);
}
__device__ __forceinline__ void peer_phase(const Args& a, Frame& F, int l, bool lastlayer) {
    const int lane = F.lane, l7 = lane & 7, lg3 = lane >> 3;
    const int gw = F.vcu * NWAVES + F.wave, NGW = F.G * NWAVES;
    const unsigned char* TU = a.ws + WS_TAB + ((size_t)l * 2) * 16 * MiB;
    const unsigned char* TV = a.ws + WS_TAB + ((size_t)l * 2 + 1) * 16 * MiB;
    const float* SCU = (const float*)(a.ws + WS_TSC) + ((size_t)l * 2) * NEXP; const float* SCV = SCU + NEXP;
    bf16_t* XB = (bf16_t*)(a.ws + WS_XB); float* X = a.out;
    const unsigned* EI = (const unsigned*)(a.ws + WS_EIDX); const float* GT = (const float*)(a.ws + WS_GATE);
    const float* g2 = a.in[6] + (size_t)l * DM;
    ldsp_t wl = F.lds + F.wave * 16384;
    constexpr int O_ET = 0, O_HT = 2304, O_HA = 6912, O_SQ = 11520;
#define ET_ROW(i) (wl + O_ET + (i) * 256)
#define HT_ROW(i) (wl + O_HT + (i) * 512)
#define HACC(i) (*(LAS f32x2*)(wl + O_HA + (i) * 512 + lane * 8))
#define SSQ(i) (*(LAS float*)(wl + O_SQ + (i) * 256 + lane * 4))
    const int ntok = (MTOT - gw + NGW - 1) / NGW;
    for (int i = 0; i < ntok; ++i) { const int t = gw + NGW * i; const unsigned e0 = EI[(size_t)t * 128 + lane], e1 = EI[(size_t)t * 128 + 64 + lane];
        *(LAS bf16_t*)(ET_ROW(i) + (l7 * 16 + lg3) * 2) = (bf16_t)e0; *(LAS bf16_t*)(ET_ROW(i) + (l7 * 16 + 8 + lg3) * 2) = (bf16_t)e1;
        HACC(i) = (f32x2){0.f, 0.f}; SSQ(i) = 0.f; }
    LDS_WAIT();
    const unsigned lane_off = 16u * (unsigned)l7;
#define PEER_ISSUE(R, TAB, ss, ii, qh) do { const u32x4 _e = *(const LAS u32x4*)(ET_ROW(ii) + lg3 * 32 + (qh) * 16); const unsigned char* _b = (TAB) + (size_t)(ss) * (NEXP * 128); \
        const unsigned _w[4] = {_e.x, _e.y, _e.z, _e.w}; _Pragma("unroll") for (int q = 0; q < 8; ++q) { const unsigned idx = (q & 1) ? (_w[q >> 1] >> 16) : (_w[q >> 1] & 0xffffu); \
            R[q] = *(const u32x4*)(_b + (idx * 128u + lane_off)); } } while (0)
    for (int urep = 0; urep < REPS(7); ++urep) {
    if (urep) { for (int i = 0; i < ntok; ++i) HACC(i) = (f32x2){0.f, 0.f}; }
    {
        u32x4 RA[8], RB[8];
        PEER_ISSUE(RA, TU, 0, 0, 0);
        u32x4 xa = *(const u32x4*)(XB + (size_t)gw * DM + 16 * l7), xb = *(const u32x4*)(XB + (size_t)gw * DM + 16 * l7 + 8);
#pragma unroll 1
        for (int s = 0; s < 8; ++s) {
            f32x2 gv[8];
#pragma unroll
            for (int j = 0; j < 4; ++j) { const f32x4 g = *(const f32x4*)(g2 + 128 * s + 16 * l7 + 4 * j); gv[2 * j] = (f32x2){g[0], g[1]}; gv[2 * j + 1] = (f32x2){g[2], g[3]}; }
#pragma unroll 1
            for (int i = 0; i < ntok; ++i) {
                PEER_ISSUE(RB, TU, s, i, 1);
                int sn = s, in = i + 1; if (in == ntok) { in = 0; sn = s + 1; } if (sn == 8) { sn = 7; in = ntok - 1; }
                const int tn = gw + NGW * in;
                const u32x4 xan = *(const u32x4*)(XB + (size_t)tn * DM + 128 * sn + 16 * l7), xbn = *(const u32x4*)(XB + (size_t)tn * DM + 128 * sn + 16 * l7 + 8);
                f32x2 xg[8];
                { const unsigned xw[8] = {xa.x, xa.y, xa.z, xa.w, xb.x, xb.y, xb.z, xb.w};
#pragma unroll
                  for (int j = 0; j < 8; ++j) xg[j] = (f32x2){bflo(xw[j]), bfhi(xw[j])} * gv[j]; }
                float p[16];
#pragma unroll
                for (int q = 0; q < 8; q += 2) { f32x2 f[8], g[8]; dec16p(RA[q], f); dec16p(RA[q + 1], g); f32x2 s0 = f[0] * xg[0], t0 = g[0] * xg[0];
#pragma unroll
                    for (int j = 1; j < 8; ++j) { s0 += f[j] * xg[j]; t0 += g[j] * xg[j]; }
                    p[q] = s0.x + s0.y; p[q + 1] = t0.x + t0.y;
                    if (q < 6) asm volatile("" : "+v"(RA[q + 2].x), "+v"(RA[q + 2].y), "+v"(RA[q + 2].z), "+v"(RA[q + 2].w), "+v"(RA[q + 3].x), "+v"(RA[q + 3].y), "+v"(RA[q + 3].z), "+v"(RA[q + 3].w) : "v"(p[q]), "v"(p[q + 1])); }
                asm volatile("" :: "v"(p[6]), "v"(p[7]));
                PEER_ISSUE(RA, TU, sn, in, 0);
#pragma unroll
                for (int q = 0; q < 8; q += 2) { f32x2 f[8], g[8]; dec16p(RB[q], f); dec16p(RB[q + 1], g); f32x2 s0 = f[0] * xg[0], t0 = g[0] * xg[0];
#pragma unroll
                    for (int j = 1; j < 8; ++j) { s0 += f[j] * xg[j]; t0 += g[j] * xg[j]; }
                    p[8 + q] = s0.x + s0.y; p[9 + q] = t0.x + t0.y;
                    if (q < 6) asm volatile("" : "+v"(RB[q + 2].x), "+v"(RB[q + 2].y), "+v"(RB[q + 2].z), "+v"(RB[q + 2].w), "+v"(RB[q + 3].x), "+v"(RB[q + 3].y), "+v"(RB[q + 3].z), "+v"(RB[q + 3].w) : "v"(p[8 + q]), "v"(p[9 + q])); }
                float p8[8], p4[4]; f32x2 p2;
#pragma unroll
                for (int q = 0; q < 8; ++q) { const float keep = (lane & 4) ? p[q + 8] : p[q], send = (lane & 4) ? p[q] : p[q + 8]; p8[q] = keep + DPPF(send, DPP_HMIRROR); }
#pragma unroll
                for (int q = 0; q < 4; ++q) { const float keep = (lane & 2) ? p8[q + 4] : p8[q], send = (lane & 2) ? p8[q] : p8[q + 4]; p4[q] = keep + DPPF(send, DPP_XOR2); }
                { const float k0 = (lane & 1) ? p4[2] : p4[0], s0 = (lane & 1) ? p4[0] : p4[2], k1 = (lane & 1) ? p4[3] : p4[1], s1 = (lane & 1) ? p4[1] : p4[3];
                  float r0 = DPPF(s0, DPP_XOR1); asm volatile("" : "+v"(r0)); float r1 = DPPF(s1, DPP_XOR1); asm volatile("" : "+v"(r1));
                  p2.x = k0 + r0; p2.y = k1 + r1; }
                HACC(i) += p2;
                xa = xan; xb = xbn;
            }
        }
    } }
    for (int i = 0; i < ntok; ++i) { const int t = gw + NGW * i;
        const float rstd = rsqrtf(((const float*)(a.ws + WS_RSS2))[t] * (1.0f / DM) + EPS);
        const unsigned ew = *(const LAS unsigned*)(ET_ROW(i) + (lg3 * 16 + 2 * l7) * 2); const unsigned e0 = ew & 0xffffu, e1 = ew >> 16;
        const int k0 = 16 * l7 + lg3, k1 = k0 + 8; const f32x2 hs = HACC(i);
        f32x2 hv; hv.x = geluf_(hs.x * rstd * SCU[e0]) * GT[(size_t)t * 128 + k0] * SCV[e0]; hv.y = geluf_(hs.y * rstd * SCU[e1]) * GT[(size_t)t * 128 + k1] * SCV[e1];
        *(LAS f32x2*)(HT_ROW(i) + (lg3 * 16 + 2 * l7) * 4) = hv; }
    LDS_WAIT();
    {
        u32x4 RA[8], RB[8];
        PEER_ISSUE(RA, TV, 0, 0, 0);
#pragma unroll 1
        for (int s = 0; s < 8; ++s) {
#pragma unroll 1
            for (int i = 0; i < ntok; ++i) { const int t = gw + NGW * i;
                PEER_ISSUE(RB, TV, s, i, 1);
                int sn = s, in = i + 1; if (in == ntok) { in = 0; sn = s + 1; } if (sn == 8) { sn = 7; in = ntok - 1; }
                const int col = 128 * s + 16 * l7 + 8 * ((lane >> 3) & 1) + 4 * ((lane >> 5) & 1) + 2 * ((lane >> 4) & 1);
                f32x2 xv = *(const f32x2*)(X + (size_t)t * DM + col);
                const f32x4 h0 = *(const LAS f32x4*)(HT_ROW(i) + lg3 * 64), h1 = *(const LAS f32x4*)(HT_ROW(i) + lg3 * 64 + 16), h2 = *(const LAS f32x4*)(HT_ROW(i) + lg3 * 64 + 32), h3 = *(const LAS f32x4*)(HT_ROW(i) + lg3 * 64 + 48);
                const float hA[8] = {h0[0], h0[1], h0[2], h0[3], h1[0], h1[1], h1[2], h1[3]}, hB[8] = {h2[0], h2[1], h2[2], h2[3], h3[0], h3[1], h3[2], h3[3]};
                f32x2 o[8];
#pragma unroll
                for (int j = 0; j < 8; ++j) o[j] = (f32x2){0.f, 0.f};
#pragma unroll
                for (int q = 0; q < 8; ++q) { f32x2 f[8]; dec16p(RA[q], f); const f32x2 hq = (f32x2){hA[q], hA[q]};
#pragma unroll
                    for (int j = 0; j < 8; ++j) o[j] += hq * f[j];
                    if (q < 7) asm volatile("" : "+v"(RA[q + 1].x), "+v"(RA[q + 1].y), "+v"(RA[q + 1].z), "+v"(RA[q + 1].w) : "v"(o[7].y)); }
                asm volatile("" :: "v"(o[7].y));
                PEER_ISSUE(RA, TV, sn, in, 0);
#pragma unroll
                for (int q = 0; q < 8; ++q) { f32x2 f[8]; dec16p(RB[q], f); const f32x2 hq = (f32x2){hB[q], hB[q]};
#pragma unroll
                    for (int j = 0; j < 8; ++j) o[j] += hq * f[j];
                    if (q < 7) asm volatile("" : "+v"(RB[q + 1].x), "+v"(RB[q + 1].y), "+v"(RB[q + 1].z), "+v"(RB[q + 1].w) : "v"(o[7].y)); }
                f32x2 o4[4], o2[2], o1;
#pragma unroll
                for (int q = 0; q < 4; ++q) { const f32x2 keep = (lane & 8) ? o[q + 4] : o[q], send = (lane & 8) ? o[q] : o[q + 4];
                    float sx = send.x, sy = send.y; asm volatile("" : "+v"(sx)); asm volatile("" : "+v"(sy));
                    float rx = DPPF(sx, DPP_ROR8); asm volatile("" : "+v"(rx)); float ry = DPPF(sy, DPP_ROR8); asm volatile("" : "+v"(ry));
                    o4[q].x = keep.x + rx; o4[q].y = keep.y + ry; }
#pragma unroll
                for (int q = 0; q < 2; ++q) { const f32x2 keep = (lane & 32) ? o4[q + 2] : o4[q], send = (lane & 32) ? o4[q] : o4[q + 2];
                    o2[q].x = keep.x + __shfl_xor(send.x, 32); o2[q].y = keep.y + __shfl_xor(send.y, 32); }
                { const f32x2 keep = (lane & 16) ? o2[1] : o2[0], send = (lane & 16) ? o2[0] : o2[1];
                  float sx = send.x, sy = send.y; asm volatile("" : "+v"(sx)); asm volatile("" : "+v"(sy));
                  float rx = __builtin_bit_cast(float, __builtin_amdgcn_ds_swizzle(__builtin_bit_cast(int, sx), 0x401F)); asm volatile("" : "+v"(rx));
                  float ry = __builtin_bit_cast(float, __builtin_amdgcn_ds_swizzle(__builtin_bit_cast(int, sy), 0x401F)); asm volatile("" : "+v"(ry));
                  o1.x = keep.x + rx; o1.y = keep.y + ry; }
                xv += o1;
                *(f32x2*)(X + (size_t)t * DM + col) = xv; *(unsigned*)(XB + (size_t)t * DM + col) = pk2(xv.x, xv.y); SSQ(i) += xv.x * xv.x + xv.y * xv.y;
            }
        }
    }
#undef PEER_ISSUE
    float* RSS = (float*)(a.ws + WS_RSS);
    if (lastlayer) __threadfence();
    for (int i = 0; i < ntok; ++i) { const int t = gw + NGW * i; const float ss = wave_sum(SSQ(i)); if (lane == 0) RSS[t] = ss;
        if (lastlayer) { const float* gf = a.in[7]; const float rstd = rsqrtf(ss * (1.0f / DM) + EPS); f32x4* xr = (f32x4*)(X + (size_t)t * DM) + lane;
#pragma unroll
            for (int j = 0; j < 4; ++j) { const f32x4 g = *((const f32x4*)gf + lane + 64 * j); f32x4 v = xr[64 * j]; v = v * rstd * g; xr[64 * j] = v; } } }
#undef ET_ROW
#undef HT_ROW
#undef HACC
#undef SSQ
}

constexpr int PROBE_A = PROBE_SEL == 99 ? -1 : PROBE_SEL == 16 ? 15 : PROBE_SEL >= 200 ? 64 + (PROBE_SEL - 200) : PROBE_SEL >= 100 ? (PROBE_SEL - 100) : PROBE_SEL >= 32 ? PROBE_SEL : PROBE_SEL == 1 ? 0 : PROBE_SEL - 1;
constexpr int PROBE_B = PROBE_SEL == 99 ? -1 : PROBE_SEL == 16 ? 130 : PROBE_SEL >= 200 ? (PROBE_SEL - 200) : PROBE_SEL >= 100 ? 64 + (PROBE_SEL - 101) : PROBE_SEL >= 32 ? 1 : PROBE_SEL == 1 ? 130 : PROBE_SEL - 2;
constexpr int N_PHASES = 1 + 7 * DEPTH;
__global__ void __launch_bounds__(NTHREADS, 2) hybrid_fwd(Args args) {
    extern __shared__ __attribute__((aligned(16))) unsigned char lds_raw[];
    Frame F;
    F.lds = (ldsp_t)lds_raw;
    F.MISC = (volatile LAS unsigned*)(F.lds + MISC_OFF);
    F.tid = threadIdx.x; F.lane = F.tid & 63; F.wave = __builtin_amdgcn_readfirstlane(F.tid >> 6);
    F.G = gridDim.x; { const int bx = blockIdx.x; F.vcu = (F.G % 8 == 0) ? (bx % 8) * (F.G / 8) + bx / 8 : bx; }
    F.ctl = (unsigned*)(args.ws + WS_CTL); F.ws = args.ws; F.out = args.out;
    for (int u = F.tid; u < (LDS_BYTES - MISC_OFF) / 4; u += NTHREADS) ((LAS unsigned*)(F.lds + MISC_OFF))[u] = 0u;
    __syncthreads();
#if MK_N_LAUNCHES == 1
    constexpr int lo = 0, hi = N_PHASES;
#else
    const int lo = args.ph_lo, hi = args.ph_hi;
#endif
    if (PROBE_SEL && blockIdx.x == 0 && F.tid == 0) F.ctl[CW_TS + 130] = (unsigned)__builtin_amdgcn_s_memrealtime();
    XcdBarrier bar; bar.bar = F.ctl + CW_BAR; bar.x = 0; bar.st = nullptr;
    if (hi - lo > 1) bar = xcd_barrier_post(F.ctl + CW_BAR, F.MISC + 8);
#ifndef PH_MASK
#define PH_MASK 0x7FF
#endif
#define IN(k) (lo <= (k) && (k) < hi)
#define PHM(b) ((PH_MASK >> (b)) & 1)
#define REPBAR() do { if (rep) xcd_barrier(bar); } while (0)
#define LAUNDER() do { asm volatile("" : "+v"(F.tid)); F.lane = F.tid & 63; F.wave = __builtin_amdgcn_readfirstlane(F.tid >> 6); bxl = (int)blockIdx.x; asm volatile("" : "+s"(bxl)); } while (0)
#define STAMP(k) do { if (PROBE_SEL && ((k) == PROBE_A || (k) == PROBE_B) && F.tid == 0) atomicMax(F.ctl + CW_TS + (k), (unsigned)__builtin_amdgcn_s_memrealtime()); } while (0)
#define SEAM(k) do { STAMP(k); if (IN(k) && IN((k) + 1)) xcd_barrier(bar); STAMP(64 + (k)); } while (0)
    unsigned char* ws = args.ws;
    bf16_t* P = (bf16_t*)(ws + WS_P); bf16_t* XB = (bf16_t*)(ws + WS_XB);
    int bxl = (int)blockIdx.x;

    for (int rep = 0; rep < REPS(0); ++rep) { REPBAR(); if (PHM(0) && IN(0)) { LAUNDER(); p0_prologue(args, F); } } SEAM(0);

    for (int l = 0; l < DEPTH; ++l) {
        const int pb = 1 + 7 * l;
        for (int rep = 0; rep < REPS(1); ++rep) { REPBAR();
        if (PHM(1) && IN(pb)) { LAUNDER();
            pg8::Gemm g{XB, (const bf16_t*)(ws + WS_WIN) + (size_t)l * NIN * DM, DM, DM, 0, 0};
            pg8::StaticOrder S; S.init(MTOT, NIN, F.G, bxl, 1);
            pg8::EpiIn E{P, (const float*)(ws + WS_RSS), (const float*)(ws + WS_ROT)};
            pg8::gemm_phase<pg8::EpiIn, pg8::StaticOrder, true>(F.lds, g, S, E, F.tid);
        } }
        SEAM(pb);
        if (PHM(2) && IN(pb + 1)) { LAUNDER();
            for (int u = (int)blockIdx.x; u < 192; u += F.G) {
                LAUNDER();
                if (u < 64) { if (PHM(8)) ret_prompt_unit(args, F, l, u >> 3, u & 7); if (l == 0) STAMP(32); }
                else { if (PHM(9)) rnn_unit(args, F, l, false, (u - 64) >> 4, (u - 64) & 15); if (l == 0) STAMP(33); }
            }
            unsigned* qh = F.ctl + CW_QUEUE + 64 * l;
            for (;;) {
                __syncthreads();
                if (F.tid == 0) F.MISC[0] = xb_add(qh, 1u);
                __syncthreads();
                const unsigned q = F.MISC[0];
                LAUNDER();
                if (PROBE_SEL && l == 0 && q >= 1152u && q < 1152u + 256u) STAMP(34);
                if (q >= 1024u + 128u + 256u) break;
                if (q < 1024u) { if (PHM(10)) ret_sample_unit(args, F, l, (int)(q >> 3), (int)(q & 7)); }
                else if (q < 1152u) { if (PHM(9)) rnn_unit(args, F, l, true, (int)((q - 1024u) >> 4), (int)((q - 1024u) & 15)); }
                else tab_unit(args, F, l, (int)(q - 1152u));
            }
        }
        SEAM(pb + 1);
        for (int rep = 0; rep < REPS(3); ++rep) { REPBAR();
        if (PHM(3) && IN(pb + 2)) { LAUNDER();
            pg8::Gemm g{(const bf16_t*)(ws + WS_ARET), (const bf16_t*)(ws + WS_WMIX + (size_t)l * 6 * MiB), DM, DM, (size_t)(WS_ARNN - WS_ARET), (size_t)(2 * MiB)};
            pg8::StaticOrder S; S.init(MTOT, DM, F.G, bxl, 2);
            pg8::EpiMerge E{P, (bf16_t*)(ws + WS_MRG)};
            pg8::gemm_phase<pg8::EpiMerge, pg8::StaticOrder, true>(F.lds, g, S, E, F.tid);
        } }
        SEAM(pb + 2);
        if (PHM(4) && IN(pb + 3)) { LAUNDER();
            pg8::Gemm g{(const bf16_t*)(ws + WS_MRG), (const bf16_t*)(ws + WS_WMIX + (size_t)l * 6 * MiB + 4 * MiB), DM, DM, 0, 0};
            pg8::StaticOrder S; S.init(MTOT, DM, F.G, bxl, 1);
            pg8::EpiWo E{l == 0 ? args.in[0] : args.out, l == 0 ? args.in[1] : args.out + (size_t)M_P * DM, args.out, XB, (float*)(ws + WS_RSSP)};
            pg8::gemm_phase<pg8::EpiWo, pg8::StaticOrder, true>(F.lds, g, S, E, F.tid);
        }
        SEAM(pb + 3);
        for (int rep = 0; rep < REPS(5); ++rep) { REPBAR();
        if (PHM(5) && IN(pb + 4)) { LAUNDER();
            pg8::Gemm g{XB, (const bf16_t*)(ws + WS_WQ) + (size_t)l * 2048 * DM, DM, DM, 0, 0};
            pg8::StaticOrder S; S.init(MTOT, 2048, F.G, bxl, 1);
            pg8::EpiQ E{P, (const float*)(ws + WS_RSSP), (float*)(ws + WS_RSS2)};
            pg8::gemm_phase<pg8::EpiQ, pg8::StaticOrder, true>(F.lds, g, S, E, F.tid);
        } }
        SEAM(pb + 4);
        for (int rep = 0; rep < 1; ++rep) {
        if (PHM(6) && IN(pb + 5)) { LAUNDER();
            const int gw = F.vcu * NWAVES + F.wave, NGW = F.G * NWAVES;
            for (int u = gw; u < (MTOT / 32) * PH; u += NGW) { for (int rr = 0; rr < REPS(6); ++rr) { int ln = F.lane; asm volatile("" : "+v"(ln)); route_unit(args, l, u >> 3, u & 7, ln); } }
        } }
        SEAM(pb + 5);
        if (PHM(7) && IN(pb + 6)) { LAUNDER(); peer_phase(args, F, l, l == DEPTH - 1); }
        if (l + 1 < DEPTH) SEAM(pb + 6); else STAMP(pb + 6);
    }
    STAMP(15);
#undef IN
#undef SEAM
}


__global__ void probe_report(float* out, const unsigned* ts) {
    unsigned ta, tb;
    if (PROBE_SEL == 99) { ta = 10000u; tb = 0u; }
    else { ta = ts[PROBE_A < 0 ? 0 : PROBE_A]; tb = ts[PROBE_B < 0 ? 0 : PROBE_B]; if (PROBE_SEL == 16) ta = tb + (ta - tb) / 16u; }
    const float dl = sqrtf((float)(ta - tb)) * 1e-2f;
    for (int i = blockIdx.x * blockDim.x + threadIdx.x; i < DEPTH * NBATCH * DM; i += gridDim.x * blockDim.x) out[O_SHP + i] += dl;
}
extern "C" void kernel_launch(void* const* d_in, const int* in_sizes, int n_in, void* d_out, int out_size, void* d_ws, size_t ws_size, hipStream_t stream) {
    static int grid = 0;
    if (grid == 0) {
        if (n_in != 24 || out_size != (int)O_END || ws_size < WS_END) { fprintf(stderr, "kernel_launch: unexpected shapes (n_in %d, out %d, ws %zu)\n", n_in, out_size, ws_size); grid = -1; return; }
        int dev = 0, cus = 0, per_cu = 0;
        if (hipGetDevice(&dev) != hipSuccess || hipDeviceGetAttribute(&cus, hipDeviceAttributeMultiprocessorCount, dev) != hipSuccess) { grid = -1; return; }
        if (hipFuncSetAttribute((const void*)hybrid_fwd, hipFuncAttributeMaxDynamicSharedMemorySize, LDS_BYTES) != hipSuccess) { fprintf(stderr, "kernel_launch: hipFuncSetAttribute failed\n"); grid = -1; return; }
        if (hipOccupancyMaxActiveBlocksPerMultiprocessor(&per_cu, (const void*)hybrid_fwd, NTHREADS, LDS_BYTES) != hipSuccess || per_cu < 1) { fprintf(stderr, "kernel_launch: occupancy query reports %d blocks per CU\n", per_cu); (void)hipGetLastError(); grid = -1; return; }
        grid = cus;
        if (grid != 256) fprintf(stderr, "kernel_launch: %d CUs; the PEER phase assumes 256 workgroups\n", grid);
    }
    if (grid < 0) return;
    (void)hipMemsetAsync((char*)d_ws + WS_CTL, 0, CTL_ZERO_BYTES, stream);
    Args a{};
    for (int i = 0; i < 24; ++i) a.in[i] = (const float*)d_in[i];
    a.out = (float*)d_out; a.ws = (unsigned char*)d_ws;
#if MK_N_LAUNCHES == 1
    a.ph_lo = 0; a.ph_hi = N_PHASES;
    void* kargs[] = {&a};
    hipError_t e = hipLaunchCooperativeKernel((const void*)hybrid_fwd, dim3(grid), dim3(NTHREADS), kargs, LDS_BYTES, stream);
    if (e != hipSuccess) fprintf(stderr, "kernel_launch: cooperative launch failed: %s (grid %d)\n", hipGetErrorString(e), grid);
#if PROBE_SEL
    hipLaunchKernelGGL(probe_report, dim3(16), dim3(256), 0, stream, (float*)d_out, (const unsigned*)((char*)d_ws + WS_CTL) + CW_TS);
#endif
#else
    for (int p = 0; p < N_PHASES; ++p) { a.ph_lo = p; a.ph_hi = p + 1; hipLaunchKernelGGL(hybrid_fwd, dim3(grid), dim3(NTHREADS), LDS_BYTES, stream, a); }
#endif
}
```

```cpp
#include <hip/hip_runtime.h>
#include <cstdio>
#include <cstdint>

#define LAS __attribute__((address_space(3)))
#define GAS __attribute__((address_space(1)))
typedef unsigned short bf16_t;
typedef short bf16x8 __attribute__((ext_vector_type(8)));
typedef float f32x2 __attribute__((ext_vector_type(2)));
typedef float f32x4 __attribute__((ext_vector_type(4)));
typedef float f32x16 __attribute__((ext_vector_type(16)));
typedef unsigned u32x2 __attribute__((ext_vector_type(2)));
typedef unsigned u32x4 __attribute__((ext_vector_type(4)));
typedef LAS unsigned char* ldsp_t;

#ifndef REP_MASK
#define REP_MASK 0
#endif
#define REPS(k) (((REP_MASK >> (k)) & 1) ? 2 : 1)
#ifndef PROBE_SEL
#define PROBE_SEL 0
#endif
#ifndef MK_N_LAUNCHES
#define MK_N_LAUNCHES 1
#endif

constexpr int DM = 1024, NIN = 7168, M_P = 16384, M_S = 1024, MTOT = 17408, DEPTH = 2;
constexpr int SEQ = 2048, NBATCH = 8, DECB = 128, DECT = 8, PAST = 16384;
constexpr int HR = 8, DK = 64, DV = 128, CH = 128;
constexpr int NBLK = 16, BS = 64;
constexpr int PH = 8, NKEY = 128, NEXP = 16384, TOPK = 16, HK = 128;
constexpr float EPS = 1e-6f;
constexpr int LDP = 7168;
constexpr int PC_Q = 0, PC_K = 512, PC_V = 1024, PC_GR = 2048, PC_XR = 3072, PC_GN = 4096, PC_GA = 5120, PC_GB = 6144;
constexpr int PC_MRG = 0, PC_ARET = 1024, PC_ARNN = 4096, PC_QP = 2048;

constexpr size_t MiB = 1u << 20;
constexpr size_t WS_CTL = 0, CTL_ZERO_BYTES = 1 * MiB;
constexpr size_t WS_ROT = 1 * MiB;
constexpr size_t WS_RSS = 2 * MiB;
constexpr size_t WS_RSS2 = 2 * MiB + 128 * 1024;
constexpr size_t WS_RSSP = 2 * MiB + 256 * 1024;
constexpr size_t WS_TSC = 3 * MiB + 512 * 1024;
constexpr size_t WS_EIDX = 4 * MiB;
constexpr size_t WS_GATE = 13 * MiB;
constexpr size_t WS_KEYS = 22 * MiB;
constexpr size_t WS_WG = 23 * MiB;
constexpr size_t WS_WIN = 24 * MiB;
constexpr size_t WS_WMIX = 52 * MiB;
constexpr size_t WS_WQ = 64 * MiB;
constexpr size_t WS_XB = 72 * MiB;
constexpr size_t WS_P = 106 * MiB;
constexpr size_t WS_TAB = 344 * MiB;
constexpr size_t WS_ARET = 408 * MiB, WS_ARNN = 442 * MiB, WS_MRG = 476 * MiB;
constexpr size_t WS_END = 510 * MiB;
static_assert(WS_P + (size_t)MTOT * LDP * 2 <= WS_TAB, "ws map");

constexpr size_t O_Y = 0, O_SRP = 17825792, O_SHP = 18874368, O_SCP = 18890752, O_SRS = 18939904, O_SHS = 35717120, O_SCS = 35979264, O_END = 36765696;

constexpr int CW_BAR = 4096;
constexpr int CW_QUEUE = 16384;
constexpr int CW_TS = 20480;

constexpr int RING_BYTES = 131072;
constexpr int LDS_BYTES = 155648;
constexpr int MISC_OFF = 153600;
constexpr int NWAVES = 8, NTHREADS = 512;

#define LDS_WAIT() asm volatile("s_waitcnt lgkmcnt(0)" ::: "memory")
#define VM_WAIT() asm volatile("s_waitcnt vmcnt(0)" ::: "memory")
#define LBAR() do { asm volatile("s_waitcnt lgkmcnt(0)" ::: "memory"); __builtin_amdgcn_s_barrier(); asm volatile("" ::: "memory"); } while (0)
#define RLX_AGENT __ATOMIC_RELAXED, __HIP_MEMORY_SCOPE_AGENT

__device__ __forceinline__ unsigned f2bf(float f) { unsigned u = __builtin_bit_cast(unsigned, f); return (u + 0x7fffu + ((u >> 16) & 1u)) >> 16; }
typedef __bf16 bf16x2_t __attribute__((ext_vector_type(2)));
__device__ __forceinline__ unsigned pk2(float lo, float hi) { const f32x2 v = {lo, hi}; const bf16x2_t b = __builtin_convertvector(v, bf16x2_t); return __builtin_bit_cast(unsigned, b); }
__device__ __forceinline__ float bflo(unsigned w) { return __builtin_bit_cast(float, w << 16); }
__device__ __forceinline__ float bfhi(unsigned w) { return __builtin_bit_cast(float, w & 0xffff0000u); }
__device__ __forceinline__ float bf1(bf16_t h) { return __builtin_bit_cast(float, (unsigned)h << 16); }
__device__ __forceinline__ float sigmoidf_(float x) { return __builtin_amdgcn_rcpf(1.0f + __expf(-x)); }
__device__ __forceinline__ float siluf_(float x) { return x * sigmoidf_(x); }
__device__ __forceinline__ float geluf_(float x) { return x * sigmoidf_(1.5957691216057308f * (x + 0.044715f * x * x * x)); }
__device__ __forceinline__ float logg_of(int h) {
    float r = -0.0317486983145803f;
    r = h == 1 ? -0.015748356968139168f : r; r = h == 2 ? -0.007843177461025893f : r; r = h == 3 ? -0.003913899321136329f : r;
    r = h == 4 ? -0.0019550348358033506f : r; r = h == 5 ? -0.0009770396478266127f : r; r = h == 6 ? -0.0004884004981088745f : r; r = h == 7 ? -0.0002441704321739145f : r;
    return r;
}

namespace pg8 {
constexpr int BM = 256, BK = 64, HALF = 128, HTB = HALF * BK * 2, STAGE_BYTES = 8 * HTB, NXCD = 8, WGM = 8;
__host__ __device__ __forceinline__ int lds_byte(int r, int c) { const int st = (r >> 4) * 2 + (c >> 5), rr = r & 15, cc = c & 31, ob = rr * 64 + cc * 2; return st * 1024 + (ob ^ (((ob >> 9) & 1) << 5)); }
__host__ __device__ __forceinline__ void stage_rc(int b, int& R, int& C) { const int st = b / 1024, sb = b % 1024, swz = sb ^ (((sb >> 9) & 1) << 5); R = (st >> 1) * 16 + swz / 64; C = (st & 1) * 32 + (swz % 64) / 2; }
__host__ __device__ __forceinline__ int perm32(int rho) { const int n = rho >> 4, i = rho & 15; return 8 * (i >> 2) + 4 * n + (i & 3); }

struct Unit { int pm, pn, half; };
struct Gemm { const bf16_t* A; const bf16_t* Bt; int lda, K; size_t aoff2, boff2; };

struct StaticOrder {
    int nM, nN, nwg, G, c, pairs;
    __device__ void init(int M, int N, int G_, int c_, int pairs_) { nM = M / BM; nN = N / BM; nwg = nM * nN; G = G_; c = c_; pairs = pairs_; }
    __device__ bool next(int i, Unit& u) const {
        const int it = (pairs == 2) ? (i >> 1) : i;
        const long L = (long)it * G + c; if (L >= nwg) return false;
        int wgid = (int)L; { const int q = nwg / NXCD, r = nwg % NXCD, xcd = wgid % NXCD, off = wgid / NXCD; wgid = (xcd < r ? xcd * (q + 1) : r * (q + 1) + (xcd - r) * q) + off; }
        const int nig = WGM * nN, gid = wgid / nig, fm = gid * WGM, gsz = (nM - fm) < WGM ? (nM - fm) : WGM;
        u.pm = fm + ((wgid % nig) % gsz); u.pn = (wgid % nig) / gsz; u.half = (pairs == 2) ? (i & 1) : 0; return true;
    }
};

template <class Epi, class Sched, bool ALIGN_EPI>
__device__ __forceinline__ void gemm_phase(ldsp_t lds, const Gemm g, const Sched& S, const Epi& E, const int tid) {
    const int wid = __builtin_amdgcn_readfirstlane(tid >> 6), lane = tid & 63, wr = wid >> 2, wc = wid & 3, fr = lane & 15, fq = lane >> 4;
    const int K = g.K, nt = K / BK;
    unsigned voffA[2], voffB[2];
#pragma unroll
    for (int i = 0; i < 2; ++i) { int R, C; stage_rc(tid * 16 + i * 8192, R, C); const int Rb = Epi::PERM ? ((R & ~31) + perm32(R & 31)) : R;
        voffA[i] = (unsigned)(R * g.lda + C) * 2u; voffB[i] = (unsigned)(Rb * K + C) * 2u; }
    const size_t kstep = (size_t)(BK * 2);
    const size_t hstepA = (size_t)HALF * g.lda * 2, hstepB = (size_t)HALF * K * 2;
    const size_t tstepA = 2 * hstepA, tstepB = 2 * hstepB;
    const unsigned ldsw = (unsigned)wid * 1024u;
    const int aoff = lds_byte(wr * 64 + fr, fq * 8), boff = lds_byte(wc * 32 + fr, fq * 8);
#define PG8_SA(b, h) (((b) * 2 + (h)) * HTB)
#define PG8_SB(b, h) ((4 + (b) * 2 + (h)) * HTB)
#define PG8_STAGE(bufoff, gbase, voff) do { _Pragma("unroll") for (int _i = 0; _i < 2; ++_i) \
        __builtin_amdgcn_global_load_lds((const unsigned*)((const char*)(gbase) + (voff)[_i]), (LAS unsigned*)(lds + (bufoff) + ldsw + _i * 8192), 16, 0, 0); } while (0)
#define PG8_LDA(dst, b, h) do { _Pragma("unroll") for (int m = 0; m < 4; ++m) _Pragma("unroll") for (int k = 0; k < 2; ++k) dst[m][k] = *(const LAS bf16x8*)(lds + PG8_SA(b, h) + aoff + m * 2048 + k * 1024); } while (0)
#define PG8_LDB(dst, b, h) do { _Pragma("unroll") for (int n = 0; n < 2; ++n) _Pragma("unroll") for (int k = 0; k < 2; ++k) dst[n][k] = *(const LAS bf16x8*)(lds + PG8_SB(b, h) + boff + n * 2048 + k * 1024); } while (0)
#define PG8_MMA(ai, bj, At, Bt) do { __builtin_amdgcn_s_setprio(1); _Pragma("unroll") for (int m = 0; m < 4; ++m) _Pragma("unroll") for (int n = 0; n < 2; ++n) _Pragma("unroll") for (int k = 0; k < 2; ++k) \
        acc[ai][bj][m][n] = __builtin_amdgcn_mfma_f32_16x16x32_bf16(Bt[n][k], At[m][k], acc[ai][bj][m][n], 0, 0, 0); __builtin_amdgcn_s_setprio(0); } while (0)
#define PG8_WAIT_V(n) asm volatile("s_waitcnt vmcnt(" #n ")" ::: "memory")
#define PG8_WAIT_L(n) asm volatile("s_waitcnt lgkmcnt(" #n ")" ::: "memory")
#define PG8_BAR __builtin_amdgcn_s_barrier()
#define PG8_SCHED __builtin_amdgcn_sched_barrier(0)
    Unit cur, nxt; int ui = 0;
    if (!S.next(0, cur)) return;
    f32x4 acc[2][2][4][2];
#pragma unroll
    for (int a = 0; a < 2; ++a)
#pragma unroll
        for (int b = 0; b < 2; ++b)
#pragma unroll
            for (int m = 0; m < 4; ++m)
#pragma unroll
                for (int n = 0; n < 2; ++n) acc[a][b][m][n] = (f32x4){0.f, 0.f, 0.f, 0.f};
    bf16x8 At[4][2], B0[2][2], B1[2][2];
    const char* cA = (const char*)g.A + (size_t)cur.pm * tstepA + (cur.half ? g.aoff2 : 0); const char* cB = (const char*)g.Bt + (size_t)cur.pn * tstepB + (cur.half ? g.boff2 : 0);
    PG8_STAGE(PG8_SB(0, 0), cB, voffB); PG8_STAGE(PG8_SB(0, 1), cB + hstepB, voffB); PG8_STAGE(PG8_SA(0, 0), cA, voffA); PG8_STAGE(PG8_SA(0, 1), cA + hstepA, voffA);
    if (wr == 1) PG8_BAR;
    PG8_WAIT_V(2); PG8_BAR;
    PG8_STAGE(PG8_SB(1, 0), cB + kstep, voffB); PG8_STAGE(PG8_SA(1, 0), cA + kstep, voffA); PG8_STAGE(PG8_SB(1, 1), cB + hstepB + kstep, voffB);
    PG8_WAIT_V(6); PG8_BAR;
    for (;;) {
        const bool has_next = S.next(ui + 1, nxt);
        const char* nA = has_next ? (const char*)g.A + (size_t)nxt.pm * tstepA + (nxt.half ? g.aoff2 : 0) : cA;
        const char* nB = has_next ? (const char*)g.Bt + (size_t)nxt.pn * tstepB + (nxt.half ? g.boff2 : 0) : cB;
        for (int t = 0; t < nt; t += 2) {
            const bool last = (t == nt - 2);
            const char* a1 = cA + (size_t)(t + 1) * kstep;
            const char* a2 = last ? nA : cA + (size_t)(t + 2) * kstep; const char* b2 = last ? nB : cB + (size_t)(t + 2) * kstep;
            const char* a3 = a2 + kstep; const char* b3 = b2 + kstep;
            PG8_LDB(B0, 0, 0); PG8_LDB(B1, 0, 1); PG8_SCHED; PG8_LDA(At, 0, 0); PG8_STAGE(PG8_SA(1, 1), a1 + hstepA, voffA);
            PG8_WAIT_V(8); PG8_WAIT_L(0); PG8_BAR; PG8_MMA(0, 0, At, B0); PG8_MMA(0, 1, At, B1); PG8_BAR; PG8_SCHED;
            PG8_LDA(At, 0, 1); PG8_STAGE(PG8_SB(0, 0), b2, voffB); PG8_STAGE(PG8_SB(0, 1), b2 + hstepB, voffB); PG8_STAGE(PG8_SA(0, 0), a2, voffA);
            PG8_WAIT_V(8); PG8_WAIT_L(0); PG8_BAR; PG8_MMA(1, 0, At, B0); PG8_MMA(1, 1, At, B1); PG8_BAR; PG8_SCHED;
            PG8_LDB(B0, 1, 0); PG8_LDB(B1, 1, 1); PG8_SCHED; PG8_LDA(At, 1, 0); PG8_STAGE(PG8_SA(0, 1), a2 + hstepA, voffA);
            PG8_WAIT_V(8); PG8_WAIT_L(0); PG8_BAR; PG8_MMA(0, 0, At, B0); PG8_MMA(0, 1, At, B1); PG8_BAR; PG8_SCHED;
            PG8_LDA(At, 1, 1); PG8_STAGE(PG8_SB(1, 0), b3, voffB); PG8_STAGE(PG8_SB(1, 1), b3 + hstepB, voffB); PG8_STAGE(PG8_SA(1, 0), a3, voffA);
            PG8_WAIT_V(8); PG8_WAIT_L(0); PG8_BAR; PG8_MMA(1, 0, At, B0); PG8_MMA(1, 1, At, B1); PG8_BAR; PG8_SCHED;
        }
        if constexpr (ALIGN_EPI) { if (wr == 0) PG8_BAR; }
        E(acc, cur, wr, wc, fr, fq);
        if (!has_next) break;
#pragma unroll
        for (int a = 0; a < 2; ++a)
#pragma unroll
            for (int b = 0; b < 2; ++b)
#pragma unroll
                for (int m = 0; m < 4; ++m)
#pragma unroll
                    for (int n = 0; n < 2; ++n) acc[a][b][m][n] = (f32x4){0.f, 0.f, 0.f, 0.f};
        cur = nxt; cA = nA; cB = nB; ++ui;
        if constexpr (ALIGN_EPI) { if (wr == 1) PG8_BAR; }
    }
    PG8_WAIT_V(0);
    if constexpr (!ALIGN_EPI) { if (wr == 0) PG8_BAR; }
    PG8_BAR;
#undef PG8_SA
#undef PG8_SB
#undef PG8_STAGE
#undef PG8_LDA
#undef PG8_LDB
#undef PG8_MMA
#undef PG8_WAIT_V
#undef PG8_WAIT_L
#undef PG8_BAR
#undef PG8_SCHED
}
}

typedef GAS unsigned gu32;
#define XB_TMO      128
#define XB_XCNT(j)  (256  + 64 * (j))
#define XB_XSUB(j)  (1280 + 64 * (j))
#define XB_XGEN(j)  (2304 + 64 * (j))
#define XB_TOP      3328
#define XB_TOPGEN   3392
#define XCD_BAR_WORDS 3456
#define XB_SPIN_CAP (1u << 18)
__device__ __forceinline__ unsigned xb_ld(unsigned* p)              { return __hip_atomic_load(p, __ATOMIC_RELAXED, __HIP_MEMORY_SCOPE_AGENT); }
__device__ __forceinline__ unsigned xb_add(unsigned* p, unsigned v) { return __hip_atomic_fetch_add(p, v, __ATOMIC_RELAXED, __HIP_MEMORY_SCOPE_AGENT); }
__device__ __forceinline__ unsigned xb_xcc_id() { return (unsigned)__builtin_amdgcn_s_getreg((3 << 11) | 20) & 0xFu; }
#define XB_SPIN(cond, bar) do { unsigned _sp = 0; while (cond) { __builtin_amdgcn_s_sleep(1); \
    if ((++_sp & 255u) == 0u) { if (xb_ld(&(bar)[XB_TMO])) break; if (_sp > XB_SPIN_CAP) { atomicAdd(&(bar)[XB_TMO], 1u); break; } } } } while (0)
struct XcdBarrier { unsigned* bar; unsigned x; volatile LAS unsigned* st; };
__device__ __forceinline__ XcdBarrier xcd_barrier_post(unsigned* bar, volatile LAS unsigned* st) {
    XcdBarrier b; b.bar = bar; b.x = (unsigned)__builtin_amdgcn_readfirstlane((int)xb_xcc_id()); b.st = st;
    if (threadIdx.x == 0) (void)xb_add(&bar[XB_XCNT(b.x)], 1u);
    return b;
}
__device__ __forceinline__ void xcd_barrier_complete(unsigned* bar, unsigned x, unsigned& nloc, unsigned& nx) {
    const unsigned G = gridDim.x * gridDim.y * gridDim.z;
    unsigned sum, cnt, mine, sp = 0u;
    for (;;) {
        sum = 0u; cnt = 0u; mine = 0u;
#pragma unroll
        for (unsigned j = 0; j < 16; ++j) { const unsigned c = xb_ld(&bar[XB_XCNT(j)]); sum += c; cnt += (c > 0u) ? 1u : 0u; mine = (j == x) ? c : mine; }
        if (sum == G) break;
        __builtin_amdgcn_s_sleep(1);
        if ((++sp & 255u) == 0u) { if (xb_ld(&bar[XB_TMO])) break; if (sp > XB_SPIN_CAP) { atomicAdd(&bar[XB_TMO], 1u); break; } }
    }
    nloc = mine > 0u ? mine : 1u; nx = cnt > 0u ? cnt : 1u;
}
__device__ __forceinline__ void xcd_barrier(const XcdBarrier& b) {
    asm volatile("s_waitcnt vmcnt(0)" ::: "memory");
    __syncthreads();
    if (threadIdx.x == 0) {
        unsigned* bar = b.bar; const unsigned bx = (unsigned)__builtin_amdgcn_readfirstlane((int)b.x);
        __builtin_amdgcn_s_waitcnt(0);
        unsigned nloc = b.st[0], nx = b.st[1];
        if (nloc == 0u) { xcd_barrier_complete(bar, bx, nloc, nx); b.st[0] = nloc; b.st[1] = nx; }
        const unsigned old = xb_add(&bar[XB_XSUB(bx)], 1u);
        const unsigned gen = old / nloc;
        if (old + 1u == (gen + 1u) * nloc) {
            __builtin_amdgcn_fence(__ATOMIC_RELEASE, "agent");
            asm volatile("s_waitcnt vmcnt(0)" ::: "memory");
            const unsigned og = xb_add(&bar[XB_TOP], 1u);
            const unsigned tg = og / nx;
            if (og + 1u == (tg + 1u) * nx) xb_add(&bar[XB_TOPGEN], 1u);
            else XB_SPIN(xb_ld(&bar[XB_TOPGEN]) == tg, bar);
            __builtin_amdgcn_fence(__ATOMIC_ACQUIRE, "agent");
            xb_add(&bar[XB_XGEN(bx)], 1u);
            asm volatile("s_waitcnt vmcnt(0)" ::: "memory");
        } else {
            XB_SPIN(xb_ld(&bar[XB_XGEN(bx)]) == gen, bar);
            __builtin_amdgcn_fence(__ATOMIC_ACQUIRE, "agent");
            asm volatile("s_waitcnt vmcnt(0)" ::: "memory");
        }
    }
    __syncthreads();
}

struct Frame {
    ldsp_t lds;
    volatile LAS unsigned* MISC;
    unsigned* ctl;
    int tid, lane, wave, vcu, G;
    const float* const* in;
    unsigned char* ws;
    float* out;
};
struct Args { const float* in[24]; float* out; unsigned char* ws; int ph_lo, ph_hi; };

__device__ __forceinline__ float wave_sum(float v) {
#pragma unroll
    for (int o = 1; o < 64; o <<= 1) v += __shfl_xor(v, o);
    return v;
}

__device__ __forceinline__ void p0_transpose_item(const float* W, int K, int N, bf16_t* WT, int ldk, const float* rowscale, float colscale, bool qkperm, LAS float* scr, int item, int lane) {
    const int nblk = N / 32, kb = item / nblk, nb = item % nblk, k0 = 64 * kb, n0 = 32 * nb;
    int srcn = n0 + (lane & 31);
    if (qkperm) { const int p = srcn & 63; srcn = (srcn & ~63) + ((p & 1) ? 32 + (p >> 1) : (p >> 1)); }
#pragma unroll 16
    for (int i = 0; i < 32; ++i) { const int kk = 2 * i + (lane >> 5); float v = W[(size_t)(k0 + kk) * N + srcn] * colscale; if (rowscale) v *= rowscale[k0 + kk]; scr[kk * 33 + (lane & 31)] = v; }
    LDS_WAIT(); asm volatile("" ::: "memory");
    const int c = lane & 7;
#pragma unroll
    for (int j = 0; j < 4; ++j) { const int n = (lane >> 3) + 8 * j; const LAS float* s = scr + (8 * c) * 33 + n;
        u32x4 o; o.x = pk2(s[0 * 33], s[1 * 33]); o.y = pk2(s[2 * 33], s[3 * 33]); o.z = pk2(s[4 * 33], s[5 * 33]); o.w = pk2(s[6 * 33], s[7 * 33]);
        *(u32x4*)(WT + (size_t)(n0 + n) * ldk + k0 + 8 * c) = o; }
    LDS_WAIT(); asm volatile("" ::: "memory");
}

__device__ __forceinline__ void p0_xrow(const float* xrow, bf16_t* orow, float* rss, int lane) {
    const f32x4* xr = (const f32x4*)xrow + lane;
    f32x4 v[4]; float s = 0.f;
#pragma unroll
    for (int j = 0; j < 4; ++j) { v[j] = xr[64 * j]; s += (v[j].x * v[j].x + v[j].y * v[j].y) + (v[j].z * v[j].z + v[j].w * v[j].w); }
    s = wave_sum(s);
    u32x2* o8 = (u32x2*)orow + lane;
#pragma unroll
    for (int j = 0; j < 4; ++j) { u32x2 w; w.x = pk2(v[j].x, v[j].y); w.y = pk2(v[j].z, v[j].w); o8[64 * j] = w; }
    if (lane == 0) *rss = s;
}

__device__ __forceinline__ void p0_tabrow(const float* row, unsigned char* img, float* isc, int e, int lane) {
    const f32x4* xr = (const f32x4*)row + lane;
    f32x4 v[4]; float am = 0.f;
#pragma unroll
    for (int j = 0; j < 4; ++j) { v[j] = xr[64 * j]; am = fmaxf(am, fmaxf(fmaxf(fabsf(v[j].x), fabsf(v[j].y)), fmaxf(fabsf(v[j].z), fabsf(v[j].w)))); }
#pragma unroll
    for (int o = 1; o < 64; o <<= 1) am = fmaxf(am, __shfl_xor(am, o));
    const float sc = am > 0.f ? exp2f(floorf(log2f(224.0f / am))) : 1.0f;
#pragma unroll
    for (int j = 0; j < 4; ++j) { const int col = 256 * j + 4 * lane, sl = col >> 7, w = col & 127;
        int pk = __builtin_amdgcn_cvt_pk_fp8_f32(v[j].x * sc, v[j].y * sc, 0, false);
        pk = __builtin_amdgcn_cvt_pk_fp8_f32(v[j].z * sc, v[j].w * sc, pk, true);
        *(int*)(img + ((size_t)sl * NEXP + e) * 128 + w) = pk; }
    if (lane == 0) isc[e] = 1.0f / sc;
}

__device__ __forceinline__ void p0_prologue(const Args& a, Frame& F) {
    unsigned char* ws = a.ws;
    LAS float* scr = (LAS float*)(F.lds + F.wave * 16384);
    const int gw = F.vcu * NWAVES + F.wave, NGW = F.G * NWAVES, lane = F.lane;
    constexpr int I_IN = (DM / 64) * (NIN / 32), I_SQ = (DM / 64) * (DM / 32), I_Q = (DM / 64) * (2048 / 32), I_G = 2;
    constexpr int PER_L = I_IN + 3 * I_SQ + I_Q + 32 * I_G;
    for (int it = gw; it < DEPTH * PER_L; it += NGW) {
        const int l = it / PER_L; int r = it % PER_L;
        if (r < I_IN) { const int nb = r % (NIN / 32), n0 = nb * 32; const int seg = n0 >> 9;
            p0_transpose_item(a.in[8] + (size_t)l * DM * NIN, DM, NIN, (bf16_t*)(ws + WS_WIN) + (size_t)l * NIN * DM, DM, a.in[5] + l * DM, seg == 1 ? 0.125f : 1.0f, seg <= 1, scr, r, lane); continue; }
        r -= I_IN;
        if (r < I_SQ) { p0_transpose_item(a.in[10] + (size_t)l * DM * DM, DM, DM, (bf16_t*)(ws + WS_WMIX + (size_t)l * 6 * MiB), DM, a.in[9] + l * DM, 1.0f, false, scr, r, lane); continue; }
        r -= I_SQ;
        if (r < I_SQ) { p0_transpose_item(a.in[18] + (size_t)l * DM * DM, DM, DM, (bf16_t*)(ws + WS_WMIX + (size_t)l * 6 * MiB + 2 * MiB), DM, nullptr, 1.0f, false, scr, r, lane); continue; }
        r -= I_SQ;
        if (r < I_SQ) { p0_transpose_item(a.in[19] + (size_t)l * DM * DM, DM, DM, (bf16_t*)(ws + WS_WMIX + (size_t)l * 6 * MiB + 4 * MiB), DM, nullptr, 1.0f, false, scr, r, lane); continue; }
        r -= I_SQ;
        if (r < I_Q) { p0_transpose_item(a.in[20] + (size_t)l * DM * 2048, DM, 2048, (bf16_t*)(ws + WS_WQ) + (size_t)l * 2048 * DM, DM, a.in[6] + l * DM, 1.0f, false, scr, r, lane); continue; }
        r -= I_Q;
        { const int mat = r >> 1, sub = r & 1, nb = mat >> 1, gsel = mat & 1;
          const float* W = (gsel ? a.in[15] : a.in[13]) + ((size_t)l * NBLK + nb) * BS * BS;
          bf16_t* WT = (bf16_t*)(ws + WS_WG) + (((size_t)l * NBLK + nb) * 2 + gsel) * BS * BS;
          p0_transpose_item(W, BS, BS, WT, BS, nullptr, 1.0f, false, scr, sub, lane); }
    }
    { const float* ksrc = a.in[21]; bf16_t* kdst = (bf16_t*)(ws + WS_KEYS); const int n4 = DEPTH * PH * 2 * NKEY * HK / 4;
      for (int i = gw * 64 + lane; i < n4; i += NGW * 64) { const f32x4 v = ((const f32x4*)ksrc)[i]; u32x2 o; o.x = pk2(v.x, v.y); o.y = pk2(v.z, v.w); ((u32x2*)kdst)[i] = o; } }
    for (int m = gw; m < MTOT; m += 2 * NGW) {
        const int m2 = m + NGW; const bool v2 = m2 < MTOT; const int mm2 = v2 ? m2 : m;
        const f32x4* x1 = (const f32x4*)(m < M_P ? a.in[0] + (size_t)m * DM : a.in[1] + (size_t)(m - M_P) * DM) + lane;
        const f32x4* x2 = (const f32x4*)(mm2 < M_P ? a.in[0] + (size_t)mm2 * DM : a.in[1] + (size_t)(mm2 - M_P) * DM) + lane;
        f32x4 v[8]; float s1 = 0.f, s2 = 0.f;
#pragma unroll
        for (int j = 0; j < 4; ++j) { v[j] = x1[64 * j]; v[4 + j] = x2[64 * j]; }
#pragma unroll
        for (int j = 0; j < 4; ++j) { s1 += (v[j].x * v[j].x + v[j].y * v[j].y) + (v[j].z * v[j].z + v[j].w * v[j].w); s2 += (v[4 + j].x * v[4 + j].x + v[4 + j].y * v[4 + j].y) + (v[4 + j].z * v[4 + j].z + v[4 + j].w * v[4 + j].w); }
        s1 = wave_sum(s1); s2 = wave_sum(s2);
        u32x2* o1 = (u32x2*)((bf16_t*)(ws + WS_XB) + (size_t)m * DM) + lane; u32x2* o2 = (u32x2*)((bf16_t*)(ws + WS_XB) + (size_t)mm2 * DM) + lane;
#pragma unroll
        for (int j = 0; j < 4; ++j) { u32x2 w; w.x = pk2(v[j].x, v[j].y); w.y = pk2(v[j].z, v[j].w); o1[64 * j] = w; }
        if (v2) {
#pragma unroll
            for (int j = 0; j < 4; ++j) { u32x2 w; w.x = pk2(v[4 + j].x, v[4 + j].y); w.y = pk2(v[4 + j].z, v[4 + j].w); o2[64 * j] = w; } }
        if (lane == 0) { ((float*)(ws + WS_RSS))[m] = s1; if (v2) ((float*)(ws + WS_RSS))[m2] = s2; }
    }
    { float* rot = (float*)(ws + WS_ROT);
      for (int i = gw * 64 + lane; i < 2056 * 32; i += NGW * 64) {
          const int pi = i >> 5, fi = i & 31; const double pos = pi < 2048 ? (double)pi : (double)(PAST + pi - 2048);
          const double f8[8] = {1.0, 0.7498942093324559, 0.5623413251903491, 0.4216965034285822, 0.31622776601683794, 0.23713737056616552, 0.1778279410038923, 0.1333521432163324};
          double fr = 1.0; switch (fi >> 3) { case 1: fr = 0.1; break; case 2: fr = 0.01; break; case 3: fr = 0.001; break; default: break; }
          double fsel = f8[0];
#pragma unroll
          for (int q = 1; q < 8; ++q) fsel = ((fi & 7) == q) ? f8[q] : fsel;
          const double ang = pos * (fr * fsel);
          const double n = __builtin_rint(ang * 0.15915494309189535);
          double rr = __builtin_fma(-n, 6.283185307179586, ang); rr = __builtin_fma(-n, 2.4492935982947064e-16, rr);
          const float rf = (float)rr;
          rot[(size_t)pi * 64 + fi] = cosf(rf); rot[(size_t)pi * 64 + 32 + fi] = sinf(rf);
      } }
}

__device__ __forceinline__ void tab_unit(const Args& a, Frame& F, int l, int cu) {
    unsigned char* ws = a.ws;
#pragma unroll 2
    for (int j = 0; j < 16; ++j) { const int r = cu * 128 + F.wave * 16 + j, t = r >> 14, e = r & (NEXP - 1);
        const float* src = (t ? a.in[23] : a.in[22]) + ((size_t)l * NEXP + e) * DM;
        p0_tabrow(src, ws + WS_TAB + ((size_t)l * 2 + t) * 16 * MiB, (float*)(ws + WS_TSC) + ((size_t)l * 2 + t) * NEXP, e, F.lane); }
}

namespace pg8 {
struct EpiIn {
    static constexpr bool PERM = true;
    bf16_t* P; const float* rss; const float* rot;
    __device__ __forceinline__ void operator()(const f32x4 (&acc)[2][2][4][2], const Unit& u, int wr, int wc, int fr, int fq) const {
        const int seg = u.pn < 4 ? (u.pn >> 1) : (u.pn >> 2) + 1;
        const int row0 = u.pm * BM + wr * 64 + fr;
#if 0
        const float* rstdv = rss + row0;
#define RSTD_AT(ai, m) rstdv[(ai) * HALF + (m) * 16]
#else
        float rstdv[8];
#pragma unroll
        for (int i = 0; i < 8; ++i) rstdv[i] = rss[row0 + (i >> 2) * HALF + (i & 3) * 16];
#define RSTD_AT(ai, m) rstdv[(ai) * 4 + (m)]
#endif
        if (seg <= 1) {
            float lg[2];
#pragma unroll
            for (int bj = 0; bj < 2; ++bj) { const int hh = 4 * (u.pn & 1) + 2 * bj + (wc >> 1); lg[bj] = logg_of(hh); }
            const int i0 = 16 * (wc & 1) + 4 * fq;
#pragma unroll
            for (int ai = 0; ai < 2; ++ai)
#pragma unroll
                for (int m = 0; m < 4; ++m) {
                    const int row = row0 + ai * HALF + m * 16;
                    const float rstd = rsqrtf(RSTD_AT(ai, m) * (1.0f / DM) + EPS);
                    asm volatile("" ::: "memory");
                    const int pi = row < M_P ? (row & (SEQ - 1)) : SEQ + ((row - M_P) & (DECT - 1));
                    const float jj1 = (float)((row < M_P ? (row & (CH - 1)) : ((row - M_P) & (DECT - 1))) + 1);
                    const float* rp = rot + (size_t)pi * 64 + i0;
#pragma unroll
                    for (int bj = 0; bj < 2; ++bj) {
                        const int hh = 4 * (u.pn & 1) + 2 * bj + (wc >> 1);
                        const float f = __expf(seg == 0 ? jj1 * lg[bj] : -jj1 * lg[bj]) * rstd;
                        bf16_t* dst = P + (size_t)row * LDP + seg * 512 + hh * 64 + i0;
#pragma unroll
                        for (int n = 0; n < 2; ++n) {
                            const f32x2 c2 = *(const f32x2*)(rp + 2 * n), s2 = *(const f32x2*)(rp + 32 + 2 * n);
                            const f32x4 v = acc[ai][bj][m][n];
                            const float a0 = (v[0] * c2.x - v[1] * s2.x) * f, a1 = (v[2] * c2.y - v[3] * s2.y) * f;
                            const float b0 = (v[0] * s2.x + v[1] * c2.x) * f, b1 = (v[2] * s2.y + v[3] * c2.y) * f;
                            *(unsigned*)(dst + 2 * n) = pk2(a0, a1); *(unsigned*)(dst + 32 + 2 * n) = pk2(b0, b1);
                        }
                    }
                    if (m & 1) asm volatile("" ::: "memory");
                }
        } else {
            const int col0 = u.pn * BM + wc * 32 + 8 * fq;
            const bool has_act = (seg == 3) || (seg >= 5), is_sig = seg >= 6;
            const float c1 = (seg == 5) ? 1.5957691216057308f : 1.0f, c3 = (seg == 5) ? 1.5957691216057308f * 0.044715f : 0.0f;
#pragma unroll
            for (int ai = 0; ai < 2; ++ai)
#pragma unroll
                for (int m = 0; m < 4; ++m) {
                    const int row = row0 + ai * HALF + m * 16;
                    const float rstd = rsqrtf(RSTD_AT(ai, m) * (1.0f / DM) + EPS);
                    bf16_t* rowp = P + (size_t)row * LDP + col0;
#pragma unroll
                    for (int bj = 0; bj < 2; ++bj) {
                        f32x4 v0 = acc[ai][bj][m][0] * rstd, v1 = acc[ai][bj][m][1] * rstd;
                        if (has_act) {
#pragma unroll
                            for (int j = 0; j < 4; ++j) { const float a0 = v0[j], a1 = v1[j];
                                const float s0 = sigmoidf_(a0 * (c1 + c3 * a0 * a0)), s1 = sigmoidf_(a1 * (c1 + c3 * a1 * a1));
                                v0[j] = (is_sig ? 1.0f : a0) * s0; v1[j] = (is_sig ? 1.0f : a1) * s1; }
                        }
                        u32x4 w; w.x = pk2(v0[0], v0[1]); w.y = pk2(v0[2], v0[3]); w.z = pk2(v1[0], v1[1]); w.w = pk2(v1[2], v1[3]);
                        *(u32x4*)(rowp + bj * HALF) = w;
                    }
                }
        }
    }
};

struct EpiMerge {
    static constexpr bool PERM = true;
    bf16_t* P; bf16_t* MRG;
    __device__ __forceinline__ void operator()(const f32x4 (&acc)[2][2][4][2], const Unit& u, int wr, int wc, int fr, int fq) const {
        const int row0 = u.pm * BM + wr * 64 + fr, col0 = u.pn * BM + wc * 32 + 8 * fq;
        const int gc = u.half ? PC_GB : PC_GA;
#pragma unroll
        for (int ai = 0; ai < 2; ++ai)
#pragma unroll
            for (int m = 0; m < 4; ++m) {
                bf16_t* rowp = P + (size_t)(row0 + ai * HALF + m * 16) * LDP; bf16_t* mrow = MRG + (size_t)(row0 + ai * HALF + m * 16) * DM;
#pragma unroll
                for (int bj = 0; bj < 2; ++bj) {
                    const int c = col0 + bj * HALF;
                    const u32x4 g = *(const u32x4*)(rowp + gc + c);
                    f32x4 v0 = acc[ai][bj][m][0], v1 = acc[ai][bj][m][1];
                    v0[0] *= bflo(g.x); v0[1] *= bfhi(g.x); v0[2] *= bflo(g.y); v0[3] *= bfhi(g.y);
                    v1[0] *= bflo(g.z); v1[1] *= bfhi(g.z); v1[2] *= bflo(g.w); v1[3] *= bfhi(g.w);
                    if (u.half) { const u32x4 p = *(const u32x4*)(mrow + c);
                        v0[0] += bflo(p.x); v0[1] += bfhi(p.x); v0[2] += bflo(p.y); v0[3] += bfhi(p.y);
                        v1[0] += bflo(p.z); v1[1] += bfhi(p.z); v1[2] += bflo(p.w); v1[3] += bfhi(p.w); }
                    u32x4 w; w.x = pk2(v0[0], v0[1]); w.y = pk2(v0[2], v0[3]); w.z = pk2(v1[0], v1[1]); w.w = pk2(v1[2], v1[3]);
                    *(u32x4*)(mrow + c) = w;
                }
                if (m == 3) asm volatile("" ::: "memory");
            }
    }
};

struct EpiWo {
    static constexpr bool PERM = false;
    const float* xp; const float* xs;
    float* X; bf16_t* XB; float* rssp;
    __device__ __forceinline__ void operator()(const f32x4 (&acc)[2][2][4][2], const Unit& u, int wr, int wc, int fr, int fq) const {
        const int row0 = u.pm * BM + wr * 64 + fr, col0 = u.pn * BM + wc * 32 + 4 * fq;
#pragma unroll
        for (int ai = 0; ai < 2; ++ai)
#pragma unroll
            for (int m = 0; m < 4; ++m) {
                const int row = row0 + ai * HALF + m * 16;
                const float* src = (row < M_P ? xp + (size_t)row * DM : xs + (size_t)(row - M_P) * DM) + col0;
                float* dst = X + (size_t)row * DM + col0; bf16_t* dstb = XB + (size_t)row * DM + col0;
                float ss = 0.f;
#pragma unroll
                for (int bj = 0; bj < 2; ++bj)
#pragma unroll
                    for (int n = 0; n < 2; ++n) {
                        const f32x4 o = *(const f32x4*)(src + bj * HALF + n * 16) + acc[ai][bj][m][n];
                        *(f32x4*)(dst + bj * HALF + n * 16) = o;
                        u32x2 w; w.x = pk2(o[0], o[1]); w.y = pk2(o[2], o[3]); *(u32x2*)(dstb + bj * HALF + n * 16) = w;
                        ss += (o[0] * o[0] + o[1] * o[1]) + (o[2] * o[2] + o[3] * o[3]);
                    }
                ss += __shfl_xor(ss, 16); ss += __shfl_xor(ss, 32);
                if (fq == 0) rssp[(size_t)(u.pn * 4 + wc) * MTOT + row] = ss;
                if (m == 3) asm volatile("" ::: "memory");
            }
    }
};

struct EpiQ {
    static constexpr bool PERM = true;
    bf16_t* P; const float* rssp; float* rss2;
    __device__ __forceinline__ void operator()(const f32x4 (&acc)[2][2][4][2], const Unit& u, int wr, int wc, int fr, int fq) const {
        const int row0 = u.pm * BM + wr * 64 + fr, col0 = u.pn * BM + wc * 32 + 8 * fq;
        float rstdv[8];
#pragma unroll
        for (int i = 0; i < 8; ++i) { const int row = row0 + (i >> 2) * HALF + (i & 3) * 16; float s = 0.f;
#pragma unroll
            for (int j = 0; j < 16; ++j) s += rssp[(size_t)j * MTOT + row];
            if (u.pn == 0 && wc == 0 && fq == 0) rss2[row] = s;
            rstdv[i] = rsqrtf(s * (1.0f / DM) + EPS);
            if ((i & 3) == 3) asm volatile("" ::: "memory"); }
#pragma unroll
        for (int ai = 0; ai < 2; ++ai)
#pragma unroll
            for (int m = 0; m < 4; ++m) {
                const int row = row0 + ai * HALF + m * 16;
                const float rstd = rstdv[ai * 4 + m];
                bf16_t* rowp = P + (size_t)row * LDP + PC_QP + col0;
#pragma unroll
                for (int bj = 0; bj < 2; ++bj) {
                    const f32x4 v0 = acc[ai][bj][m][0] * rstd, v1 = acc[ai][bj][m][1] * rstd;
                    u32x4 w; w.x = pk2(v0[0], v0[1]); w.y = pk2(v0[2], v0[3]); w.z = pk2(v1[0], v1[1]); w.w = pk2(v1[2], v1[3]);
                    *(u32x4*)(rowp + bj * HALF) = w;
                }
            }
    }
};
}

__device__ __forceinline__ void mma32(f32x16& acc, ldsp_t A, int lda_b, ldsp_t Bt, int ldb_b, int ksteps, int lane) {
    ldsp_t ap = A + (lane & 31) * lda_b + (lane >> 5) * 16;
    ldsp_t bp = Bt + (lane & 31) * ldb_b + (lane >> 5) * 16;
    for (int ks = 0; ks < ksteps; ++ks) {
        const bf16x8 a = *(const LAS bf16x8*)(ap + ks * 32), b = *(const LAS bf16x8*)(bp + ks * 32);
        acc = __builtin_amdgcn_mfma_f32_32x32x16_bf16(a, b, acc, 0, 0, 0);
    }
}
template <int KS>
__device__ __forceinline__ void mma32t(f32x16& acc, ldsp_t A, int lda_b, ldsp_t Bt, int ldb_b, int lane) {
    ldsp_t ap = A + (lane & 31) * lda_b + (lane >> 5) * 16;
    ldsp_t bp = Bt + (lane & 31) * ldb_b + (lane >> 5) * 16;
    bf16x8 av[KS], bv[KS];
#pragma unroll
    for (int ks = 0; ks < KS; ++ks) { av[ks] = *(const LAS bf16x8*)(ap + ks * 32); bv[ks] = *(const LAS bf16x8*)(bp + ks * 32); }
#pragma unroll
    for (int ks = 0; ks < KS; ++ks) acc = __builtin_amdgcn_mfma_f32_32x32x16_bf16(av[ks], bv[ks], acc, 0, 0, 0);
}
#define ZERO16 ((f32x16){0.f,0.f,0.f,0.f,0.f,0.f,0.f,0.f,0.f,0.f,0.f,0.f,0.f,0.f,0.f,0.f})

constexpr int R_QS = 0, R_KS = 18432, R_VS = 43008, R_SS = 83968, R_RST = 118784, R_ST = 137216;
constexpr int LD64 = 144, LDK = 192, LDV = 320, LD128 = 272;
typedef short v4i16_t __attribute__((ext_vector_type(4)));
__device__ __forceinline__ bf16x8 frag_tr(ldsp_t X, int stride_b, int c0, int k0, int lane) {
    const int h = lane >> 5, blk = (lane >> 4) & 1, q = (lane & 15) >> 2, p = lane & 3;
    ldsp_t a = X + (k0 + 8 * h + q) * stride_b + (c0 + 16 * blk + 4 * p) * 2;
    const v4i16_t lo = __builtin_amdgcn_ds_read_tr16_b64_v4i16((LAS v4i16_t*)a), hi = __builtin_amdgcn_ds_read_tr16_b64_v4i16((LAS v4i16_t*)(a + 4 * stride_b));
    return (bf16x8){lo[0], lo[1], lo[2], lo[3], hi[0], hi[1], hi[2], hi[3]};
}
__device__ __forceinline__ bf16x8 frag_row(ldsp_t X, int stride_b, int r0, int k0, int lane) { return *(const LAS bf16x8*)(X + (r0 + (lane & 31)) * stride_b + (k0 + 8 * (lane >> 5)) * 2); }

__device__ __forceinline__ void ret_prompt_unit(const Args& a, Frame& F, int l, int b, int h) {
    const int tid = F.tid, lane = F.lane, w = F.wave, hi = lane >> 5, l31 = lane & 31;
    ldsp_t lds = F.lds;
    const bf16_t* P = (const bf16_t*)(a.ws + WS_P);
    bf16_t* ARET = (bf16_t*)(a.ws + WS_ARET);
    const float lg = logg_of(h), G = __expf(128.0f * lg);
    f32x16 racc = ZERO16;
    const int db = w >> 2, eb = w & 3;
    u32x4 pq[2], pk[2], pv[4], pg[4];
#define RET_FETCH(nn) do { const bf16_t* _b = P + ((size_t)b * SEQ + (nn) * CH) * LDP + h * 64; \
        _Pragma("unroll") for (int i = 0; i < 2; ++i) { const int p = tid + 512 * i; const bf16_t* _r = _b + (size_t)(p >> 3) * LDP + (p & 7) * 8; pq[i] = *(const u32x4*)(_r + PC_Q); pk[i] = *(const u32x4*)(_r + PC_K); } \
        _Pragma("unroll") for (int i = 0; i < 4; ++i) { const int p = tid + 512 * i; const bf16_t* _r = _b + h * 64 + (size_t)(p >> 4) * LDP + (p & 15) * 8; pv[i] = *(const u32x4*)(_r + PC_V); } } while (0)
#define RET_FETCH_G(nn) do { const bf16_t* _b = P + ((size_t)b * SEQ + (nn) * CH) * LDP + h * 128 + PC_GR; \
        _Pragma("unroll") for (int i = 0; i < 4; ++i) { const int p = tid + 512 * i; pg[i] = *(const u32x4*)(_b + (size_t)(p >> 4) * LDP + (p & 15) * 8); } } while (0)
    RET_FETCH(0);
    for (int n = 0; n < 16; ++n) {
        const size_t tok0 = (size_t)b * SEQ + n * CH;
#pragma unroll
        for (int i = 0; i < 2; ++i) { const int p = tid + 512 * i; *(LAS u32x4*)(lds + R_QS + (p >> 3) * LD64 + (p & 7) * 16) = pq[i]; *(LAS u32x4*)(lds + R_KS + (p >> 3) * LDK + (p & 7) * 16) = pk[i]; }
#pragma unroll
        for (int i = 0; i < 4; ++i) { const int p = tid + 512 * i; *(LAS u32x4*)(lds + R_VS + (p >> 4) * LDV + (p & 15) * 16) = pv[i]; }
#pragma unroll
        for (int g = 0; g < 4; ++g) { u32x2 wv; wv.x = pk2(racc[4 * g], racc[4 * g + 1]); wv.y = pk2(racc[4 * g + 2], racc[4 * g + 3]);
            *(LAS u32x2*)(lds + R_RST + (32 * eb + l31) * LD64 + (32 * db + 8 * g + 4 * hi) * 2) = wv; }
        if (n + 1 < 16) RET_FETCH(n + 1);
        RET_FETCH_G(n);
        LBAR();
#pragma unroll
        for (int t2 = 0; t2 < 2; ++t2) { const int t = 2 * w + t2, mb = t >> 2, jb = t & 3;
            if (mb <= jb) { f32x16 sacc = ZERO16;
                bf16x8 af[4], bf[4];
#pragma unroll
                for (int ks = 0; ks < 4; ++ks) { af[ks] = frag_row(lds + R_KS, LDK, 32 * mb, 16 * ks, lane); bf[ks] = frag_row(lds + R_QS, LD64, 32 * jb, 16 * ks, lane); }
#pragma unroll
                for (int ks = 0; ks < 4; ++ks) sacc = __builtin_amdgcn_mfma_f32_32x32x16_bf16(af[ks], bf[ks], sacc, 0, 0, 0);
                const int j = 32 * jb + l31;
#pragma unroll
                for (int g = 0; g < 4; ++g) { const int m0 = 32 * mb + 8 * g + 4 * hi; float v[4];
#pragma unroll
                    for (int q = 0; q < 4; ++q) v[q] = (j >= m0 + q) ? sacc[4 * g + q] : 0.f;
                    u32x2 wv; wv.x = pk2(v[0], v[1]); wv.y = pk2(v[2], v[3]);
                    *(LAS u32x2*)(lds + R_SS + j * LD128 + m0 * 2) = wv; } } }
        LBAR();
        const int jb = w >> 1, eh = w & 1;
        f32x16 oacc[2];
        oacc[0] = ZERO16; oacc[1] = ZERO16;
        { bf16x8 a0[4], a1[4], bf[4];
#pragma unroll
          for (int ks = 0; ks < 4; ++ks) { a0[ks] = frag_row(lds + R_RST, LD64, 32 * (2 * eh), 16 * ks, lane); a1[ks] = frag_row(lds + R_RST, LD64, 32 * (2 * eh + 1), 16 * ks, lane); bf[ks] = frag_row(lds + R_QS, LD64, 32 * jb, 16 * ks, lane); }
#pragma unroll
          for (int ks = 0; ks < 4; ++ks) { oacc[0] = __builtin_amdgcn_mfma_f32_32x32x16_bf16(a0[ks], bf[ks], oacc[0], 0, 0, 0); oacc[1] = __builtin_amdgcn_mfma_f32_32x32x16_bf16(a1[ks], bf[ks], oacc[1], 0, 0, 0); } }
        for (int mbk = 0; mbk <= jb; ++mbk) {
            bf16x8 a0[2], a1[2], bf[2];
#pragma unroll
            for (int ks = 0; ks < 2; ++ks) { const int k0 = 32 * mbk + 16 * ks; a0[ks] = frag_tr(lds + R_VS, LDV, 32 * (2 * eh), k0, lane); a1[ks] = frag_tr(lds + R_VS, LDV, 32 * (2 * eh + 1), k0, lane); bf[ks] = frag_row(lds + R_SS, LD128, 32 * jb, k0, lane); }
#pragma unroll
            for (int ks = 0; ks < 2; ++ks) { oacc[0] = __builtin_amdgcn_mfma_f32_32x32x16_bf16(a0[ks], bf[ks], oacc[0], 0, 0, 0); oacc[1] = __builtin_amdgcn_mfma_f32_32x32x16_bf16(a1[ks], bf[ks], oacc[1], 0, 0, 0); }
        }
        float s1 = 0.f, s2 = 0.f;
#pragma unroll
        for (int t = 0; t < 2; ++t)
#pragma unroll
            for (int r = 0; r < 16; ++r) { s1 += oacc[t][r]; s2 += oacc[t][r] * oacc[t][r]; }
        s1 += __shfl_xor(s1, 32); s2 += __shfl_xor(s2, 32);
        if (hi == 0) *(LAS f32x2*)(lds + R_ST + (eh * 128 + 32 * jb + l31) * 8) = (f32x2){s1, s2};
        LBAR();
        { const int j = 32 * jb + l31;
          const f32x2 sa = *(const LAS f32x2*)(lds + R_ST + j * 8), sb = *(const LAS f32x2*)(lds + R_ST + (128 + j) * 8);
          const float mu = (sa.x + sb.x) * (1.0f / DV), var = (sa.y + sb.y) * (1.0f / DV) - mu * mu, rstd = rsqrtf(fmaxf(var, 0.f) + EPS);
#pragma unroll
          for (int t = 0; t < 2; ++t)
#pragma unroll
              for (int g = 0; g < 4; ++g) { const int e0 = 32 * (2 * eh + t) + 8 * g + 4 * hi;
                  u32x2 wv; wv.x = pk2((oacc[t][4 * g] - mu) * rstd, (oacc[t][4 * g + 1] - mu) * rstd); wv.y = pk2((oacc[t][4 * g + 2] - mu) * rstd, (oacc[t][4 * g + 3] - mu) * rstd);
                  *(LAS u32x2*)(lds + R_SS + j * LD128 + e0 * 2) = wv; } }
#pragma unroll
        for (int kh = 0; kh < 2; ++kh) { bf16x8 af[4], bf[4];
#pragma unroll
          for (int ks = 0; ks < 4; ++ks) { af[ks] = frag_tr(lds + R_KS, LDK, 32 * db, 64 * kh + 16 * ks, lane); bf[ks] = frag_tr(lds + R_VS, LDV, 32 * eb, 64 * kh + 16 * ks, lane); }
#pragma unroll
          for (int ks = 0; ks < 4; ++ks) racc = __builtin_amdgcn_mfma_f32_32x32x16_bf16(af[ks], bf[ks], racc, 0, 0, 0); }
#pragma unroll
        for (int r = 0; r < 16; ++r) racc[r] *= G;
        LBAR();
#pragma unroll
        for (int i = 0; i < 4; ++i) { const int p = tid + 512 * i, row = p >> 4, c = p & 15;
            const u32x4 ov = *(const LAS u32x4*)(lds + R_SS + row * LD128 + c * 16), gv = pg[i];
            u32x4 wv; wv.x = pk2(bflo(ov.x) * bflo(gv.x), bfhi(ov.x) * bfhi(gv.x)); wv.y = pk2(bflo(ov.y) * bflo(gv.y), bfhi(ov.y) * bfhi(gv.y));
            wv.z = pk2(bflo(ov.z) * bflo(gv.z), bfhi(ov.z) * bfhi(gv.z)); wv.w = pk2(bflo(ov.w) * bflo(gv.w), bfhi(ov.w) * bfhi(gv.w));
            *(u32x4*)(ARET + (tok0 + row) * DM + h * 128 + c * 8) = wv; }
    }
    float* so = a.out + O_SRP + ((((size_t)l * NBATCH + b) * HR + h) * DK) * DV;
#pragma unroll
    for (int r = 0; r < 16; ++r) { const int d = 32 * db + (r & 3) + 8 * (r >> 2) + 4 * hi; so[(size_t)d * DV + 32 * eb + l31] = racc[r]; }
#undef RET_FETCH
#undef RET_FETCH_G
}

__device__ __forceinline__ void ret_sample_unit(const Args& a, Frame& F, int l, int bs, int h) {
    const int tid = F.tid, lane = F.lane, w = F.wave;
    LAS float* qd = (LAS float*)F.lds; LAS float* ku = qd + 512; LAS float* vv = ku + 512; LAS float* S = vv + 1024; LAS float* crossp = S + 64; LAS float* red = crossp + 4096;
    bf16_t* P = (bf16_t*)(a.ws + WS_P);
    const size_t tok0 = (size_t)M_P + bs * DECT;
    { const int j = tid >> 6, d = tid & 63; const bf16_t* src = P + (tok0 + j) * LDP + h * 64 + d; qd[tid] = bf1(src[PC_Q]); ku[tid] = bf1(src[PC_K]); }
#pragma unroll
    for (int i = 0; i < 2; ++i) { const int idx = tid + 512 * i, m = idx >> 7, e = idx & 127; vv[idx] = bf1(P[(tok0 + m) * LDP + PC_V + h * 128 + e]); }
    LBAR();
    const int dg = tid >> 7, e = tid & 127;
    const size_t soff = ((((size_t)l * DECB + bs) * HR + h) * DK) * DV;
    const float* r0 = a.in[2] + soff; float* rn = a.out + O_SRS + soff;
    const float lg = logg_of(h), G8 = __expf(8.0f * lg);
    float cross[8];
#pragma unroll
    for (int j = 0; j < 8; ++j) cross[j] = 0.f;
    float rv[16];
#pragma unroll
    for (int dd = 0; dd < 16; ++dd) rv[dd] = r0[(size_t)(dg * 16 + dd) * DV + e];
#pragma unroll
    for (int dd = 0; dd < 16; ++dd) { const int d = dg * 16 + dd; const float r = rv[dd]; float kvs = 0.f;
#pragma unroll
        for (int m = 0; m < 8; ++m) kvs += ku[m * 64 + d] * vv[m * 128 + e];
        rn[(size_t)d * DV + e] = G8 * (r + kvs);
#pragma unroll
        for (int j = 0; j < 8; ++j) cross[j] += qd[j * 64 + d] * r; }
#pragma unroll
    for (int j = 0; j < 8; ++j) crossp[(dg * 8 + j) * 128 + e] = cross[j];
    { const int pr = tid >> 3, part = tid & 7, j = pr >> 3, m = pr & 7; float sp = 0.f;
#pragma unroll
      for (int d = 0; d < 8; ++d) sp += qd[j * 64 + part * 8 + d] * ku[m * 64 + part * 8 + d];
      sp += __shfl_xor(sp, 1); sp += __shfl_xor(sp, 2); sp += __shfl_xor(sp, 4);
      if (part == 0) S[pr] = (j >= m) ? sp : 0.f; }
    LBAR();
    float o[2];
#pragma unroll
    for (int jj = 0; jj < 2; ++jj) { const int j = dg + 4 * jj; float s = 0.f;
#pragma unroll
        for (int g = 0; g < 4; ++g) s += crossp[(g * 8 + j) * 128 + e];
#pragma unroll
        for (int m = 0; m < 8; ++m) s += S[j * 8 + m] * vv[m * 128 + e];
        o[jj] = s;
        const float t1 = wave_sum(s), t2 = wave_sum(s * s);
        if (lane == 0) { red[(jj * 8 + w) * 2] = t1; red[(jj * 8 + w) * 2 + 1] = t2; } }
    LBAR();
#pragma unroll
    for (int jj = 0; jj < 2; ++jj) { const int j = dg + 4 * jj, w0 = 2 * dg;
        const float t1 = red[(jj * 8 + w0) * 2] + red[(jj * 8 + w0 + 1) * 2], t2 = red[(jj * 8 + w0) * 2 + 1] + red[(jj * 8 + w0 + 1) * 2 + 1];
        const float mu = t1 * (1.0f / DV), var = t2 * (1.0f / DV) - mu * mu, rstd = rsqrtf(fmaxf(var, 0.f) + EPS);
        const bf16_t* prow = P + (tok0 + j) * LDP + h * 128 + e;
        ((bf16_t*)(a.ws + WS_ARET))[(tok0 + j) * DM + h * 128 + e] = (bf16_t)f2bf((o[jj] - mu) * rstd * bf1(prow[PC_GR])); }
    LBAR();
}

constexpr int N_XRL = 0, N_XCF = 33536, N_XCB = 66304, N_WGT = 84736, N_CAR = 103168, N_BUF = 107264;
__device__ __forceinline__ void rnn_unit(const Args& a, Frame& F, int l, bool sample, int bg, int nb) {
    const int tid = F.tid, lane = F.lane, w = F.wave, hi = lane >> 5, l31 = lane & 31;
    ldsp_t lds = F.lds;
    LAS float* xrl = (LAS float*)(lds + N_XRL); LAS float* xcf = (LAS float*)(lds + N_XCF); LAS float* car = (LAS float*)(lds + N_CAR); LAS float* bufl = (LAS float*)(lds + N_BUF);
    LAS float* aa = xrl; LAS float* uu = xcf;
    bf16_t* P = (bf16_t*)(a.ws + WS_P);
    const int ch0 = nb * BS;
    { const bf16_t* wg = (const bf16_t*)(a.ws + WS_WG) + ((size_t)l * NBLK + nb) * 2 * BS * BS;
#pragma unroll
      for (int i = 0; i < 2; ++i) { const int p = tid + 512 * i, row = p >> 3, c8 = p & 7; *(LAS u32x4*)(lds + N_WGT + row * LD64 + c8 * 16) = *(const u32x4*)(wg + row * 64 + c8 * 8); } }
    const int cc = tid & 63;
    const float* cwp = a.in[11] + (size_t)l * 4 * DM + ch0 + cc;
    const float cw0 = cwp[0], cw1 = cwp[DM], cw2 = cwp[2 * DM], cw3 = cwp[3 * DM], cbv = a.in[12][l * DM + ch0 + cc];
    const int rb = w >> 1, cb = w & 1, dcol = 32 * cb + l31;
    const float bav = a.in[14][l * DM + ch0 + dcol], bxv = a.in[16][l * DM + ch0 + dcol];
    const float spe = __expf(-a.in[17][l * DM + ch0 + dcol]);
    const float spl = spe > 0.05f ? __logf(1.0f + spe) : spe * (1.0f - spe * (0.5f - spe * (1.0f / 3.0f - 0.25f * spe)));
    const int ntiles = sample ? 1 : 16;
    float hcar = 0.f;
    if (sample) {
        for (int i = tid; i < 16 * 3 * 64; i += NTHREADS) { const int s = i / 192, r = (i / 64) % 3, c = i & 63;
            bufl[i] = a.in[4][(((size_t)l * DECB + bg * 16 + s) * 3 + r) * DM + ch0 + c]; }
    }
    u32x4 pre[3];
#define RNN_FETCH(nn) do { const size_t _t0 = sample ? (size_t)M_P + bg * 128 : (size_t)bg * SEQ + (nn) * 128; _Pragma("unroll") for (int k = 0; k < 3; ++k) { \
        const int p = tid + 512 * k, row = p >> 3, c8 = p & 7; pre[k] = (u32x4){0u, 0u, 0u, 0u}; \
        if (p < 131 * 8 && (row >= 3 || (!sample && (nn) > 0))) pre[k] = *(const u32x4*)(P + (_t0 + row - 3) * LDP + PC_XR + ch0 + c8 * 8); } } while (0)
    RNN_FETCH(0);
    for (int n = 0; n < ntiles; ++n) {
        const size_t tok0 = sample ? (size_t)M_P + bg * 128 : (size_t)bg * SEQ + n * 128;
        unsigned short gl[16];
#pragma unroll
        for (int i = 0; i < 16; ++i) gl[i] = P[(tok0 + 16 * w + i) * LDP + PC_GN + ch0 + cc];
#pragma unroll
        for (int k = 0; k < 3; ++k) { const int p = tid + 512 * k, row = p >> 3, c8 = p & 7;
            if (p < 131 * 8) { const u32x4 v = pre[k]; LAS float* d = xrl + row * 64 + c8 * 8;
                *(LAS f32x4*)d = (f32x4){bflo(v.x), bfhi(v.x), bflo(v.y), bfhi(v.y)}; *(LAS f32x4*)(d + 4) = (f32x4){bflo(v.z), bfhi(v.z), bflo(v.w), bfhi(v.w)}; } }
        LBAR();
        if (n + 1 < ntiles) RNN_FETCH(n + 1);
        { const int tg = tid >> 6;
#pragma unroll 4
          for (int i = 0; i < 16; ++i) { const int t = tg * 16 + i; float x0, x1, x2;
              const float x3 = xrl[(t + 3) * 64 + cc];
              if (sample) { const int s = t >> 3, j = t & 7;
                  x0 = j >= 3 ? xrl[t * 64 + cc] : bufl[(s * 3 + j) * 64 + cc];
                  x1 = j >= 2 ? xrl[(t + 1) * 64 + cc] : bufl[(s * 3 + j + 1) * 64 + cc];
                  x2 = j >= 1 ? xrl[(t + 2) * 64 + cc] : bufl[(s * 3 + j + 2) * 64 + cc];
              } else { x0 = xrl[t * 64 + cc]; x1 = xrl[(t + 1) * 64 + cc]; x2 = xrl[(t + 2) * 64 + cc]; }
              const float xc = cbv + cw0 * x0 + cw1 * x1 + cw2 * x2 + cw3 * x3;
              xcf[t * 64 + cc] = xc; *(LAS bf16_t*)(lds + N_XCB + t * LD64 + cc * 2) = (bf16_t)f2bf(xc); } }
        if (sample) { if (tid < 192) { }     }
        if (sample) { for (int i = tid; i < 16 * 3 * 64; i += NTHREADS) { const int s = i / 192, r = (i / 64) % 3, c = i & 63;
                a.out[O_SCS + (((size_t)l * DECB + bg * 16 + s) * 3 + r) * DM + ch0 + c] = xrl[(3 + s * 8 + 5 + r) * 64 + c]; } }
        else if (n == 15) { if (tid < 192) { const int r = tid >> 6, c = tid & 63; a.out[O_SCP + (((size_t)l * NBATCH + bg) * 3 + r) * DM + ch0 + c] = xrl[(3 + 125 + r) * 64 + c]; } }
        LBAR();
        { f32x16 ar = ZERO16, ai = ZERO16;
          mma32t<4>(ar, lds + N_XCB + rb * 32 * LD64, LD64, lds + N_WGT + (32 * cb) * LD64, LD64, lane);
          mma32t<4>(ai, lds + N_XCB + rb * 32 * LD64, LD64, lds + N_WGT + (64 + 32 * cb) * LD64, LD64, lane);
#pragma unroll
          for (int r = 0; r < 16; ++r) { const int t = 32 * rb + (r & 3) + 8 * (r >> 2) + 4 * hi;
              const float rg = sigmoidf_(ar[r] + bav), ig = sigmoidf_(ai[r] + bxv);
              const float la = -8.0f * rg * spl, av = __expf(la), y2 = 2.0f * la;
              const float om = y2 < -0.3f ? 1.0f - av * av : -y2 * (1.0f + y2 * (0.5f + y2 * (1.0f / 6.0f + y2 * (1.0f / 24.0f + y2 * (1.0f / 120.0f)))));
              const float mult = sqrtf(fmaxf(om, 0.f));
              const float xc = xcf[t * 64 + dcol];
              aa[t * 64 + dcol] = av; uu[t * 64 + dcol] = mult * ig * xc; } }
        LBAR();
        if (!sample) {
            float Ap = 1.f, Hl = 0.f;
#pragma unroll 4
            for (int i = 0; i < 16; ++i) { const int t = 16 * w + i; const float av = aa[t * 64 + cc], uv = uu[t * 64 + cc]; Hl = av * Hl + uv; Ap *= av; }
            car[w * 64 + cc] = Ap; car[512 + w * 64 + cc] = Hl;
            LBAR();
            float hin = hcar, hnext = hcar;
#pragma unroll
            for (int w2 = 0; w2 < 8; ++w2) { const float A2 = car[w2 * 64 + cc], H2 = car[512 + w2 * 64 + cc]; hnext = A2 * hnext + H2; if (w2 < w) hin = hnext; }
            float hh = hin;
#pragma unroll
            for (int i = 0; i < 16; ++i) { const int t = 16 * w + i; hh = aa[t * 64 + cc] * hh + uu[t * 64 + cc];
                ((bf16_t*)(a.ws + WS_ARNN))[(tok0 + t) * DM + ch0 + cc] = (bf16_t)f2bf(hh * bf1(gl[i])); }
            hcar = hnext;
        } else {
#pragma unroll
            for (int s2 = 0; s2 < 2; ++s2) { const int s = 2 * w + s2, bs = bg * 16 + s;
                float hh = a.in[3][((size_t)l * DECB + bs) * DM + ch0 + cc];
#pragma unroll
                for (int j = 0; j < 8; ++j) { const int t = s * 8 + j; hh = aa[t * 64 + cc] * hh + uu[t * 64 + cc];
                    ((bf16_t*)(a.ws + WS_ARNN))[(tok0 + t) * DM + ch0 + cc] = (bf16_t)f2bf(hh * bf1(gl[s2 * 8 + j])); }
                a.out[O_SHS + ((size_t)l * DECB + bs) * DM + ch0 + cc] = hh; }
        }
        LBAR();
    }
    if (!sample && w == 0) a.out[O_SHP + ((size_t)l * NBATCH + bg) * DM + ch0 + cc] = hcar;
#undef RNN_FETCH
}

__device__ __forceinline__ unsigned ord_of(float f) { const unsigned u = __builtin_bit_cast(unsigned, f); return u ^ ((u >> 31) ? 0xFFFFFFFFu : 0x80000000u); }
__device__ __forceinline__ float ord_inv(unsigned o) { const unsigned u = (o >> 31) ? (o ^ 0x80000000u) : ~o; return __builtin_bit_cast(float, u); }
__host__ __device__ constexpr bool cand_ok(int a, int b) { return (a + 1) * (b + 1) <= 16; }

#define CEX(a, b) do { const unsigned _x = (a), _y = (b); (a) = _x > _y ? _x : _y; (b) = _x > _y ? _y : _x; } while (0)
__device__ __forceinline__ void sort16_desc(unsigned (&v)[16]) {
#pragma unroll
    for (int k = 2; k <= 16; k <<= 1)
#pragma unroll
        for (int j = k >> 1; j > 0; j >>= 1)
#pragma unroll
            for (int i = 0; i < 16; ++i) { const int p = i ^ j; if (p > i) { if ((i & k) == 0) CEX(v[i], v[p]); else CEX(v[p], v[i]); } }
}
__device__ __forceinline__ void bitonic_merge16_desc(unsigned (&v)[16]) {
#pragma unroll
    for (int j = 8; j > 0; j >>= 1)
#pragma unroll
        for (int i = 0; i < 16; ++i) { const int p = i ^ j; if (p > i) CEX(v[i], v[p]); }
}
__device__ __forceinline__ void merge_top16(unsigned (&a)[16], const unsigned (&b)[16]) {
#pragma unroll
    for (int i = 0; i < 16; ++i) a[i] = a[i] > b[15 - i] ? a[i] : b[15 - i];
    bitonic_merge16_desc(a);
}

constexpr int LDKEY = 272;
__device__ __forceinline__ void route_unit(const Args& a, ldsp_t keys, int tb, int h, int lane) {
    const int hi = lane >> 5, l31 = lane & 31, token = tb * 32 + l31;
    const bf16_t* P = (const bf16_t*)(a.ws + WS_P);
    const bf16_t* qrow = P + (size_t)token * LDP + PC_QP + h * 256 + hi * 8;
    unsigned L[2][16];
#pragma unroll
    for (int p = 0; p < 2; ++p) {
        f32x16 acc[4];
#pragma unroll
        for (int kb = 0; kb < 4; ++kb) acc[kb] = ZERO16;
#pragma unroll
        for (int kh = 0; kh < 2; ++kh) {
            bf16x8 bq[4];
#pragma unroll
            for (int ks = 0; ks < 4; ++ks) bq[ks] = *(const bf16x8*)(qrow + p * 128 + (4 * kh + ks) * 16);
#pragma unroll
            for (int ks = 0; ks < 4; ++ks) {
#pragma unroll
                for (int kb = 0; kb < 4; ++kb) { const bf16x8 ak = frag_row(keys + p * NKEY * LDKEY, LDKEY, 32 * kb, 16 * (4 * kh + ks), lane);
                    acc[kb] = __builtin_amdgcn_mfma_f32_32x32x16_bf16(ak, bq[ks], acc[kb], 0, 0, 0); } }
        }
        unsigned g0[16], g1[16];
#pragma unroll
        for (int r = 0; r < 16; ++r) { const int key = (r & 3) + 8 * (r >> 2) + 4 * hi; g0[r] = (ord_of(acc[0][r]) & ~127u) | (unsigned)(127 - key); g1[r] = (ord_of(acc[1][r]) & ~127u) | (unsigned)(127 - (32 + key)); }
        sort16_desc(g0); sort16_desc(g1); merge_top16(g0, g1);
        unsigned g2[16];
#pragma unroll
        for (int r = 0; r < 16; ++r) { const int key = (r & 3) + 8 * (r >> 2) + 4 * hi; g1[r] = (ord_of(acc[2][r]) & ~127u) | (unsigned)(127 - (64 + key)); g2[r] = (ord_of(acc[3][r]) & ~127u) | (unsigned)(127 - (96 + key)); }
        sort16_desc(g1); sort16_desc(g2); merge_top16(g1, g2); merge_top16(g0, g1);
#pragma unroll
        for (int i = 0; i < 16; ++i) g1[i] = (unsigned)__shfl_xor((int)g0[i], 32);
        merge_top16(g0, g1);
#pragma unroll
        for (int i = 0; i < 16; ++i) L[p][i] = g0[i];
    }
    float sa[16], sb[16];
#pragma unroll
    for (int i = 0; i < 16; ++i) { sa[i] = ord_inv(L[0][i] & ~127u); sb[i] = ord_inv(L[1][i] & ~127u); }
#define CKEY(x, y) ((ord_of(sa[x] + sb[y]) & ~255u) | (unsigned)(255 - ((x) * 16 + (y))))
    unsigned best[16], t1[16];
#pragma unroll
    for (int y = 0; y < 16; ++y) { best[y] = CKEY(0, y); t1[y] = y < 8 ? CKEY(1, y) : 0u; }
    merge_top16(best, t1);
    { int n = 0;
#pragma unroll
      for (int x = 2; x < 7; ++x)
#pragma unroll
          for (int y = 0; y < 16; ++y) if (cand_ok(x, y)) { t1[n] = CKEY(x, y); ++n; }
    }
    sort16_desc(t1); merge_top16(best, t1);
    { int n = 0;
#pragma unroll
      for (int x = 7; x < 16; ++x)
#pragma unroll
          for (int y = 0; y < 16; ++y) if (cand_ok(x, y)) { t1[n] = CKEY(x, y); ++n; }
#pragma unroll
      for (int i = 10; i < 16; ++i) t1[i] = 0u;
    }
    sort16_desc(t1); merge_top16(best, t1);
#undef CKEY
    float sc[16], ssum = 0.f; const float mx = ord_inv(best[0] & ~255u);
#pragma unroll
    for (int it = 0; it < 16; ++it) { sc[it] = __expf(ord_inv(best[it] & ~255u) - mx); ssum += sc[it]; }
    const float inv = 1.0f / ssum;
    unsigned* eo = (unsigned*)(a.ws + WS_EIDX) + (size_t)token * 128 + h * 16 + hi * 8;
    float* go = (float*)(a.ws + WS_GATE) + (size_t)token * 128 + h * 16 + hi * 8;
#pragma unroll
    for (int it = 0; it < 8; ++it) {
        unsigned b0 = best[it], b1 = best[it + 8]; float g0 = sc[it], g1 = sc[it + 8];
        asm volatile("" : "+v"(b0), "+v"(b1), "+v"(g0), "+v"(g1));
        const unsigned bsel = hi ? b1 : b0; const float gsel = (hi ? g1 : g0) * inv;
        const unsigned c = 255u - (bsel & 255u), ca = c >> 4, cb = c & 15u;
        unsigned k1 = 0u, k2 = 0u;
#pragma unroll
        for (int i = 0; i < 16; ++i) { k1 = (ca == (unsigned)i) ? (127u - (L[0][i] & 127u)) : k1; k2 = (cb == (unsigned)i) ? (127u - (L[1][i] & 127u)) : k2; }
        eo[it] = k1 * 128u + k2; go[it] = gsel;
    }
}
#undef CEX

constexpr int MAXT = 9;
#define DPPF(v, ctrl) __builtin_bit_cast(float, __builtin_amdgcn_update_dpp(0, __builtin_bit_cast(int, (v)), (ctrl), 0xf, 0xf, true))
constexpr int DPP_XOR1 = 0xB1, DPP_XOR2 = 0x4E, DPP_HMIRROR = 0x141, DPP_ROR8 = 0x128;
__device__ __forceinline__ void dec16p(const u32x4 r, f32x2 (&f)[8]) {
    f[0] = __builtin_amdgcn_cvt_pk_f32_fp8((int)r.x, false); f[1] = __builtin_amdgcn_cvt_pk_f32_fp8((int)r.x, true);
    f[2] = __builtin_amdgcn_cvt_pk_f32_fp8((int)r.y, false); f[3] = __builtin_amdgcn_cvt_pk_f32_fp8((int)r.y, true);
    f[4] = __builtin_amdgcn_cvt_pk_f32_fp8((int)r.z, false); f[5] = __builtin_amdgcn_cvt_pk_f32_fp8((int)r.z, true);
    f[6] = __builtin_amdgcn_cvt_pk_f32_fp8((int)r.w, false); f[7] = __builtin_amdgcn_cvt_pk_f32_fp8((int)r.w, true);
}
__device__ __forceinline__ void peer_phase(const Args& a, Frame& F, int l, bool lastlayer) {
    const int lane = F.lane, l7 = lane & 7, lg3 = lane >> 3;
    const int gw = F.vcu * NWAVES + F.wave, NGW = F.G * NWAVES;
    const unsigned char* TU = a.ws + WS_TAB + ((size_t)l * 2) * 16 * MiB;
    const unsigned char* TV = a.ws + WS_TAB + ((size_t)l * 2 + 1) * 16 * MiB;
    const float* SCU = (const float*)(a.ws + WS_TSC) + ((size_t)l * 2) * NEXP; const float* SCV = SCU + NEXP;
    bf16_t* XB = (bf16_t*)(a.ws + WS_XB); float* X = a.out;
    const unsigned* EI = (const unsigned*)(a.ws + WS_EIDX); const float* GT = (const float*)(a.ws + WS_GATE);
    const float* g2 = a.in[6] + (size_t)l * DM;
    ldsp_t wl = F.lds + F.wave * 16384;
    constexpr int O_ET = 0, O_HT = 2304, O_HA = 6912, O_SQ = 11520;
#define ET_ROW(i) (wl + O_ET + (i) * 256)
#define HT_ROW(i) (wl + O_HT + (i) * 512)
#define HACC(i) (*(LAS f32x2*)(wl + O_HA + (i) * 512 + lane * 8))
#define SSQ(i) (*(LAS float*)(wl + O_SQ + (i) * 256 + lane * 4))
    const int ntok = (MTOT - gw + NGW - 1) / NGW;
    for (int i = 0; i < ntok; ++i) { const int t = gw + NGW * i; const unsigned e0 = EI[(size_t)t * 128 + lane], e1 = EI[(size_t)t * 128 + 64 + lane];
        *(LAS bf16_t*)(ET_ROW(i) + (l7 * 16 + lg3) * 2) = (bf16_t)e0; *(LAS bf16_t*)(ET_ROW(i) + (l7 * 16 + 8 + lg3) * 2) = (bf16_t)e1;
        HACC(i) = (f32x2){0.f, 0.f}; SSQ(i) = 0.f; }
    LDS_WAIT();
    const unsigned lane_off = 16u * (unsigned)l7;
#define PEER_ISSUE(R, TAB, ss, ii, qh) do { const u32x4 _e = *(const LAS u32x4*)(ET_ROW(ii) + lg3 * 32 + (qh) * 16); const unsigned char* _b = (TAB) + (size_t)(ss) * (NEXP * 128); \
        const unsigned _w[4] = {_e.x, _e.y, _e.z, _e.w}; _Pragma("unroll") for (int q = 0; q < 8; ++q) { const unsigned idx = (q & 1) ? (_w[q >> 1] >> 16) : (_w[q >> 1] & 0xffffu); \
            R[q] = *(const u32x4*)(_b + (idx * 128u + lane_off)); } } while (0)
    for (int urep = 0; urep < REPS(7); ++urep) {
    if (urep) { for (int i = 0; i < ntok; ++i) HACC(i) = (f32x2){0.f, 0.f}; }
    {
        u32x4 RA[8], RB[8];
        PEER_ISSUE(RA, TU, 0, 0, 0);
        u32x4 xa = *(const u32x4*)(XB + (size_t)gw * DM + 16 * l7), xb = *(const u32x4*)(XB + (size_t)gw * DM + 16 * l7 + 8);
#pragma unroll 1
        for (int s = 0; s < 8; ++s) {
            f32x2 gv[8];
#pragma unroll
            for (int j = 0; j < 4; ++j) { const f32x4 g = *(const f32x4*)(g2 + 128 * s + 16 * l7 + 4 * j); gv[2 * j] = (f32x2){g[0], g[1]}; gv[2 * j + 1] = (f32x2){g[2], g[3]}; }
#pragma unroll 1
            for (int i = 0; i < ntok; ++i) {
                PEER_ISSUE(RB, TU, s, i, 1);
                int sn = s, in = i + 1; if (in == ntok) { in = 0; sn = s + 1; } if (sn == 8) { sn = 7; in = ntok - 1; }
                const int tn = gw + NGW * in;
                const u32x4 xan = *(const u32x4*)(XB + (size_t)tn * DM + 128 * sn + 16 * l7), xbn = *(const u32x4*)(XB + (size_t)tn * DM + 128 * sn + 16 * l7 + 8);
                f32x2 xg[8];
                { const unsigned xw[8] = {xa.x, xa.y, xa.z, xa.w, xb.x, xb.y, xb.z, xb.w};
#pragma unroll
                  for (int j = 0; j < 8; ++j) xg[j] = (f32x2){bflo(xw[j]), bfhi(xw[j])} * gv[j]; }
                float p[16];
#pragma unroll
                for (int q = 0; q < 8; q += 2) { f32x2 f[8], g[8]; dec16p(RA[q], f); dec16p(RA[q + 1], g); f32x2 s0 = f[0] * xg[0], t0 = g[0] * xg[0];
#pragma unroll
                    for (int j = 1; j < 8; ++j) { s0 += f[j] * xg[j]; t0 += g[j] * xg[j]; }
                    p[q] = s0.x + s0.y; p[q + 1] = t0.x + t0.y;
                    if (q < 6) asm volatile("" : "+v"(RA[q + 2].x), "+v"(RA[q + 2].y), "+v"(RA[q + 2].z), "+v"(RA[q + 2].w), "+v"(RA[q + 3].x), "+v"(RA[q + 3].y), "+v"(RA[q + 3].z), "+v"(RA[q + 3].w) : "v"(p[q]), "v"(p[q + 1])); }
                asm volatile("" :: "v"(p[6]), "v"(p[7]));
                PEER_ISSUE(RA, TU, sn, in, 0);
#pragma unroll
                for (int q = 0; q < 8; q += 2) { f32x2 f[8], g[8]; dec16p(RB[q], f); dec16p(RB[q + 1], g); f32x2 s0 = f[0] * xg[0], t0 = g[0] * xg[0];
#pragma unroll
                    for (int j = 1; j < 8; ++j) { s0 += f[j] * xg[j]; t0 += g[j] * xg[j]; }
                    p[8 + q] = s0.x + s0.y; p[9 + q] = t0.x + t0.y;
                    if (q < 6) asm volatile("" : "+v"(RB[q + 2].x), "+v"(RB[q + 2].y), "+v"(RB[q + 2].z), "+v"(RB[q + 2].w), "+v"(RB[q + 3].x), "+v"(RB[q + 3].y), "+v"(RB[q + 3].z), "+v"(RB[q + 3].w) : "v"(p[8 + q]), "v"(p[9 + q])); }
                float p8[8], p4[4]; f32x2 p2;
#pragma unroll
                for (int q = 0; q < 8; ++q) { const float keep = (lane & 4) ? p[q + 8] : p[q], send = (lane & 4) ? p[q] : p[q + 8]; p8[q] = keep + DPPF(send, DPP_HMIRROR); }
#pragma unroll
                for (int q = 0; q < 4; ++q) { const float keep = (lane & 2) ? p8[q + 4] : p8[q], send = (lane & 2) ? p8[q] : p8[q + 4]; p4[q] = keep + DPPF(send, DPP_XOR2); }
                { const float k0 = (lane & 1) ? p4[2] : p4[0], s0 = (lane & 1) ? p4[0] : p4[2], k1 = (lane & 1) ? p4[3] : p4[1], s1 = (lane & 1) ? p4[1] : p4[3];
                  float r0 = DPPF(s0, DPP_XOR1); asm volatile("" : "+v"(r0)); float r1 = DPPF(s1, DPP_XOR1); asm volatile("" : "+v"(r1));
                  p2.x = k0 + r0; p2.y = k1 + r1; }
                HACC(i) += p2;
                xa = xan; xb = xbn;
            }
        }
    } }
    for (int i = 0; i < ntok; ++i) { const int t = gw + NGW * i;
        const float rstd = rsqrtf(((const float*)(a.ws + WS_RSS2))[t] * (1.0f / DM) + EPS);
        const unsigned ew = *(const LAS unsigned*)(ET_ROW(i) + (lg3 * 16 + 2 * l7) * 2); const unsigned e0 = ew & 0xffffu, e1 = ew >> 16;
        const int k0 = 16 * l7 + lg3, k1 = k0 + 8; const f32x2 hs = HACC(i);
        f32x2 hv; hv.x = geluf_(hs.x * rstd * SCU[e0]) * GT[(size_t)t * 128 + k0] * SCV[e0]; hv.y = geluf_(hs.y * rstd * SCU[e1]) * GT[(size_t)t * 128 + k1] * SCV[e1];
        *(LAS f32x2*)(HT_ROW(i) + (lg3 * 16 + 2 * l7) * 4) = hv; }
    LDS_WAIT();
    {
        u32x4 RA[8], RB[8];
        PEER_ISSUE(RA, TV, 0, 0, 0);
#pragma unroll 1
        for (int s = 0; s < 8; ++s) {
#pragma unroll 1
            for (int i = 0; i < ntok; ++i) { const int t = gw + NGW * i;
                PEER_ISSUE(RB, TV, s, i, 1);
                int sn = s, in = i + 1; if (in == ntok) { in = 0; sn = s + 1; } if (sn == 8) { sn = 7; in = ntok - 1; }
                const int col = 128 * s + 16 * l7 + 8 * ((lane >> 3) & 1) + 4 * ((lane >> 5) & 1) + 2 * ((lane >> 4) & 1);
                f32x2 xv = *(const f32x2*)(X + (size_t)t * DM + col);
                const f32x4 h0 = *(const LAS f32x4*)(HT_ROW(i) + lg3 * 64), h1 = *(const LAS f32x4*)(HT_ROW(i) + lg3 * 64 + 16), h2 = *(const LAS f32x4*)(HT_ROW(i) + lg3 * 64 + 32), h3 = *(const LAS f32x4*)(HT_ROW(i) + lg3 * 64 + 48);
                const float hA[8] = {h0[0], h0[1], h0[2], h0[3], h1[0], h1[1], h1[2], h1[3]}, hB[8] = {h2[0], h2[1], h2[2], h2[3], h3[0], h3[1], h3[2], h3[3]};
                f32x2 o[8];
#pragma unroll
                for (int j = 0; j < 8; ++j) o[j] = (f32x2){0.f, 0.f};
#pragma unroll
                for (int q = 0; q < 8; ++q) { f32x2 f[8]; dec16p(RA[q], f); const f32x2 hq = (f32x2){hA[q], hA[q]};
#pragma unroll
                    for (int j = 0; j < 8; ++j) o[j] += hq * f[j];
                    if (q < 7) asm volatile("" : "+v"(RA[q + 1].x), "+v"(RA[q + 1].y), "+v"(RA[q + 1].z), "+v"(RA[q + 1].w) : "v"(o[7].y)); }
                asm volatile("" :: "v"(o[7].y));
                PEER_ISSUE(RA, TV, sn, in, 0);
#pragma unroll
                for (int q = 0; q < 8; ++q) { f32x2 f[8]; dec16p(RB[q], f); const f32x2 hq = (f32x2){hB[q], hB[q]};
#pragma unroll
                    for (int j = 0; j < 8; ++j) o[j] += hq * f[j];
                    if (q < 7) asm volatile("" : "+v"(RB[q + 1].x), "+v"(RB[q + 1].y), "+v"(RB[q + 1].z), "+v"(RB[q + 1].w) : "v"(o[7].y)); }
                f32x2 o4[4], o2[2], o1;
#pragma unroll
                for (int q = 0; q < 4; ++q) { const f32x2 keep = (lane & 8) ? o[q + 4] : o[q], send = (lane & 8) ? o[q] : o[q + 4];
                    float sx = send.x, sy = send.y; asm volatile("" : "+v"(sx)); asm volatile("" : "+v"(sy));
                    float rx = DPPF(sx, DPP_ROR8); asm volatile("" : "+v"(rx)); float ry = DPPF(sy, DPP_ROR8); asm volatile("" : "+v"(ry));
                    o4[q].x = keep.x + rx; o4[q].y = keep.y + ry; }
#pragma unroll
                for (int q = 0; q < 2; ++q) { const f32x2 keep = (lane & 32) ? o4[q + 2] : o4[q], send = (lane & 32) ? o4[q] : o4[q + 2];
                    o2[q].x = keep.x + __shfl_xor(send.x, 32); o2[q].y = keep.y + __shfl_xor(send.y, 32); }
                { const f32x2 keep = (lane & 16) ? o2[1] : o2[0], send = (lane & 16) ? o2[0] : o2[1];
                  float sx = send.x, sy = send.y; asm volatile("" : "+v"(sx)); asm volatile("" : "+v"(sy));
                  float rx = __builtin_bit_cast(float, __builtin_amdgcn_ds_swizzle(__builtin_bit_cast(int, sx), 0x401F)); asm volatile("" : "+v"(rx));
                  float ry = __builtin_bit_cast(float, __builtin_amdgcn_ds_swizzle(__builtin_bit_cast(int, sy), 0x401F)); asm volatile("" : "+v"(ry));
                  o1.x = keep.x + rx; o1.y = keep.y + ry; }
                xv += o1;
                *(f32x2*)(X + (size_t)t * DM + col) = xv; *(unsigned*)(XB + (size_t)t * DM + col) = pk2(xv.x, xv.y); SSQ(i) += xv.x * xv.x + xv.y * xv.y;
            }
        }
    }
#undef PEER_ISSUE
    float* RSS = (float*)(a.ws + WS_RSS);
    if (lastlayer) __threadfence();
    for (int i = 0; i < ntok; ++i) { const int t = gw + NGW * i; const float ss = wave_sum(SSQ(i)); if (lane == 0) RSS[t] = ss;
        if (lastlayer) { const float* gf = a.in[7]; const float rstd = rsqrtf(ss * (1.0f / DM) + EPS); f32x4* xr = (f32x4*)(X + (size_t)t * DM) + lane;
#pragma unroll
            for (int j = 0; j < 4; ++j) { const f32x4 g = *((const f32x4*)gf + lane + 64 * j); f32x4 v = xr[64 * j]; v = v * rstd * g; xr[64 * j] = v; } } }
#undef ET_ROW
#undef HT_ROW
#undef HACC
#undef SSQ
}

constexpr int PROBE_A = PROBE_SEL == 99 ? -1 : PROBE_SEL == 16 ? 15 : PROBE_SEL >= 200 ? 64 + (PROBE_SEL - 200) : PROBE_SEL >= 100 ? (PROBE_SEL - 100) : PROBE_SEL >= 32 ? PROBE_SEL : PROBE_SEL == 1 ? 0 : PROBE_SEL - 1;
constexpr int PROBE_B = PROBE_SEL == 99 ? -1 : PROBE_SEL == 16 ? 130 : PROBE_SEL >= 200 ? (PROBE_SEL - 200) : PROBE_SEL >= 100 ? 64 + (PROBE_SEL - 101) : PROBE_SEL >= 32 ? 1 : PROBE_SEL == 1 ? 130 : PROBE_SEL - 2;
constexpr int N_PHASES = 1 + 7 * DEPTH;
__global__ void __launch_bounds__(NTHREADS, 2) hybrid_fwd(Args args) {
    extern __shared__ __attribute__((aligned(16))) unsigned char lds_raw[];
    Frame F;
    F.lds = (ldsp_t)lds_raw;
    F.MISC = (volatile LAS unsigned*)(F.lds + MISC_OFF);
    F.tid = threadIdx.x; F.lane = F.tid & 63; F.wave = __builtin_amdgcn_readfirstlane(F.tid >> 6);
    F.G = gridDim.x; { const int bx = blockIdx.x; F.vcu = (F.G % 8 == 0) ? (bx % 8) * (F.G / 8) + bx / 8 : bx; }
    F.ctl = (unsigned*)(args.ws + WS_CTL); F.ws = args.ws; F.out = args.out;
    for (int u = F.tid; u < (LDS_BYTES - MISC_OFF) / 4; u += NTHREADS) ((LAS unsigned*)(F.lds + MISC_OFF))[u] = 0u;
    __syncthreads();
#if MK_N_LAUNCHES == 1
    constexpr int lo = 0, hi = N_PHASES;
#else
    const int lo = args.ph_lo, hi = args.ph_hi;
#endif
    if (PROBE_SEL && blockIdx.x == 0 && F.tid == 0) F.ctl[CW_TS + 130] = (unsigned)__builtin_amdgcn_s_memrealtime();
    XcdBarrier bar; bar.bar = F.ctl + CW_BAR; bar.x = 0; bar.st = nullptr;
    if (hi - lo > 1) bar = xcd_barrier_post(F.ctl + CW_BAR, F.MISC + 8);
#ifndef PH_MASK
#define PH_MASK 0x7FF
#endif
#define IN(k) (lo <= (k) && (k) < hi)
#define PHM(b) ((PH_MASK >> (b)) & 1)
#define REPBAR() do { if (rep) xcd_barrier(bar); } while (0)
#define LAUNDER() do { asm volatile("" : "+v"(F.tid)); F.lane = F.tid & 63; F.wave = __builtin_amdgcn_readfirstlane(F.tid >> 6); bxl = (int)blockIdx.x; asm volatile("" : "+s"(bxl)); } while (0)
#define STAMP(k) do { if (PROBE_SEL && ((k) == PROBE_A || (k) == PROBE_B) && F.tid == 0) atomicMax(F.ctl + CW_TS + (k), (unsigned)__builtin_amdgcn_s_memrealtime()); } while (0)
#define SEAM(k) do { STAMP(k); if (IN(k) && IN((k) + 1)) xcd_barrier(bar); STAMP(64 + (k)); } while (0)
    unsigned char* ws = args.ws;
    bf16_t* P = (bf16_t*)(ws + WS_P); bf16_t* XB = (bf16_t*)(ws + WS_XB);
    int bxl = (int)blockIdx.x;

    for (int rep = 0; rep < REPS(0); ++rep) { REPBAR(); if (PHM(0) && IN(0)) { LAUNDER(); p0_prologue(args, F); } } SEAM(0);

    for (int l = 0; l < DEPTH; ++l) {
        const int pb = 1 + 7 * l;
        for (int rep = 0; rep < REPS(1); ++rep) { REPBAR();
        if (PHM(1) && IN(pb)) { LAUNDER();
            pg8::Gemm g{XB, (const bf16_t*)(ws + WS_WIN) + (size_t)l * NIN * DM, DM, DM, 0, 0};
            pg8::StaticOrder S; S.init(MTOT, NIN, F.G, bxl, 1);
            pg8::EpiIn E{P, (const float*)(ws + WS_RSS), (const float*)(ws + WS_ROT)};
            pg8::gemm_phase<pg8::EpiIn, pg8::StaticOrder, true>(F.lds, g, S, E, F.tid);
        } }
        SEAM(pb);
        if (PHM(2) && IN(pb + 1)) { LAUNDER();
            for (int u = (int)blockIdx.x; u < 192; u += F.G) {
                LAUNDER();
                if (u < 64) { if (PHM(8)) ret_prompt_unit(args, F, l, u >> 3, u & 7); if (l == 0) STAMP(32); }
                else { if (PHM(9)) rnn_unit(args, F, l, false, (u - 64) >> 4, (u - 64) & 15); if (l == 0) STAMP(33); }
            }
            unsigned* qh = F.ctl + CW_QUEUE + 64 * l;
            for (;;) {
                __syncthreads();
                if (F.tid == 0) F.MISC[0] = xb_add(qh, 1u);
                __syncthreads();
                const unsigned q = F.MISC[0];
                LAUNDER();
                if (PROBE_SEL && l == 0 && q >= 1408u - 8u && q < 1408u) STAMP(34);
                if (q >= 256u + 128u + 1024u) break;
                if (q < 256u) tab_unit(args, F, l, (int)q);
                else if (q < 384u) { if (PHM(9)) rnn_unit(args, F, l, true, (int)((q - 256u) >> 4), (int)((q - 256u) & 15)); }
                else { if (PHM(10)) ret_sample_unit(args, F, l, (int)((q - 384u) >> 3), (int)((q - 384u) & 7)); }
            }
        }
        SEAM(pb + 1);
        for (int rep = 0; rep < REPS(3); ++rep) { REPBAR();
        if (PHM(3) && IN(pb + 2)) { LAUNDER();
            pg8::Gemm g{(const bf16_t*)(ws + WS_ARET), (const bf16_t*)(ws + WS_WMIX + (size_t)l * 6 * MiB), DM, DM, (size_t)(WS_ARNN - WS_ARET), (size_t)(2 * MiB)};
            pg8::StaticOrder S; S.init(MTOT, DM, F.G, bxl, 2);
            pg8::EpiMerge E{P, (bf16_t*)(ws + WS_MRG)};
            pg8::gemm_phase<pg8::EpiMerge, pg8::StaticOrder, true>(F.lds, g, S, E, F.tid);
        } }
        SEAM(pb + 2);
        if (PHM(4) && IN(pb + 3)) { LAUNDER();
            pg8::Gemm g{(const bf16_t*)(ws + WS_MRG), (const bf16_t*)(ws + WS_WMIX + (size_t)l * 6 * MiB + 4 * MiB), DM, DM, 0, 0};
            pg8::StaticOrder S; S.init(MTOT, DM, F.G, bxl, 1);
            pg8::EpiWo E{l == 0 ? args.in[0] : args.out, l == 0 ? args.in[1] : args.out + (size_t)M_P * DM, args.out, XB, (float*)(ws + WS_RSSP)};
            pg8::gemm_phase<pg8::EpiWo, pg8::StaticOrder, true>(F.lds, g, S, E, F.tid);
        }
        SEAM(pb + 3);
        for (int rep = 0; rep < REPS(5); ++rep) { REPBAR();
        if (PHM(5) && IN(pb + 4)) { LAUNDER();
            pg8::Gemm g{XB, (const bf16_t*)(ws + WS_WQ) + (size_t)l * 2048 * DM, DM, DM, 0, 0};
            pg8::StaticOrder S; S.init(MTOT, 2048, F.G, bxl, 1);
            pg8::EpiQ E{P, (const float*)(ws + WS_RSSP), (float*)(ws + WS_RSS2)};
            pg8::gemm_phase<pg8::EpiQ, pg8::StaticOrder, true>(F.lds, g, S, E, F.tid);
        } }
        SEAM(pb + 4);
        for (int rep = 0; rep < 1; ++rep) {
        if (PHM(6) && IN(pb + 5)) { LAUNDER();
            int hstaged = -1;
            for (int bu = bxl; bu < (MTOT / 256) * PH; bu += F.G) { const int sb = bu >> 3, h = bu & 7;
                if (h != hstaged) { __syncthreads();
                    const bf16_t* ksrc = (const bf16_t*)(ws + WS_KEYS) + ((size_t)(l * PH + h) * 2) * NKEY * HK;
#pragma unroll
                    for (int i = 0; i < 8; ++i) { const int p = F.tid + 512 * i, row = p >> 4, c = p & 15;
                        *(LAS u32x4*)(F.lds + row * LDKEY + c * 16) = *(const u32x4*)(ksrc + (size_t)row * HK + c * 8); }
                    __syncthreads(); hstaged = h; }
                for (int rr = 0; rr < REPS(6); ++rr) { int ln = F.lane; asm volatile("" : "+v"(ln)); route_unit(args, F.lds, sb * 8 + F.wave, h, ln); }
            }
        } }
        SEAM(pb + 5);
        if (PHM(7) && IN(pb + 6)) { LAUNDER(); peer_phase(args, F, l, l == DEPTH - 1); }
        if (l + 1 < DEPTH) SEAM(pb + 6); else STAMP(pb + 6);
    }
    STAMP(15);
#undef IN
#undef SEAM
}


__global__ void probe_report(float* out, const unsigned* ts) {
    unsigned ta, tb;
    if (PROBE_SEL == 99) { ta = 10000u; tb = 0u; }
    else { ta = ts[PROBE_A < 0 ? 0 : PROBE_A]; tb = ts[PROBE_B < 0 ? 0 : PROBE_B]; if (PROBE_SEL == 16) ta = tb + (ta - tb) / 16u; }
    const float dl = sqrtf((float)(ta - tb)) * 1e-2f;
    for (int i = blockIdx.x * blockDim.x + threadIdx.x; i < DEPTH * NBATCH * DM; i += gridDim.x * blockDim.x) out[O_SHP + i] += dl;
}
extern "C" void kernel_launch(void* const* d_in, const int* in_sizes, int n_in, void* d_out, int out_size, void* d_ws, size_t ws_size, hipStream_t stream) {
    static int grid = 0;
    if (grid == 0) {
        if (n_in != 24 || out_size != (int)O_END || ws_size < WS_END) { fprintf(stderr, "kernel_launch: unexpected shapes (n_in %d, out %d, ws %zu)\n", n_in, out_size, ws_size); grid = -1; return; }
        int dev = 0, cus = 0, per_cu = 0;
        if (hipGetDevice(&dev) != hipSuccess || hipDeviceGetAttribute(&cus, hipDeviceAttributeMultiprocessorCount, dev) != hipSuccess) { grid = -1; return; }
        if (hipFuncSetAttribute((const void*)hybrid_fwd, hipFuncAttributeMaxDynamicSharedMemorySize, LDS_BYTES) != hipSuccess) { fprintf(stderr, "kernel_launch: hipFuncSetAttribute failed\n"); grid = -1; return; }
        if (hipOccupancyMaxActiveBlocksPerMultiprocessor(&per_cu, (const void*)hybrid_fwd, NTHREADS, LDS_BYTES) != hipSuccess || per_cu < 1) { fprintf(stderr, "kernel_launch: occupancy query reports %d blocks per CU\n", per_cu); (void)hipGetLastError(); grid = -1; return; }
        grid = cus;
        if (grid != 256) fprintf(stderr, "kernel_launch: %d CUs; the PEER phase assumes 256 workgroups\n", grid);
    }
    if (grid < 0) return;
    (void)hipMemsetAsync((char*)d_ws + WS_CTL, 0, CTL_ZERO_BYTES, stream);
    Args a{};
    for (int i = 0; i < 24; ++i) a.in[i] = (const float*)d_in[i];
    a.out = (float*)d_out; a.ws = (unsigned char*)d_ws;
#if MK_N_LAUNCHES == 1
    a.ph_lo = 0; a.ph_hi = N_PHASES;
    void* kargs[] = {&a};
    hipError_t e = hipLaunchCooperativeKernel((const void*)hybrid_fwd, dim3(grid), dim3(NTHREADS), kargs, LDS_BYTES, stream);
    if (e != hipSuccess) fprintf(stderr, "kernel_launch: cooperative launch failed: %s (grid %d)\n", hipGetErrorString(e), grid);
#if PROBE_SEL
    hipLaunchKernelGGL(probe_report, dim3(16), dim3(256), 0, stream, (float*)d_out, (const unsigned*)((char*)d_ws + WS_CTL) + CW_TS);
#endif
#else
    for (int p = 0; p < N_PHASES; ++p) { a.ph_lo = p; a.ph_hi = p + 1; hipLaunchKernelGGL(hybrid_fwd, dim3(grid), dim3(NTHREADS), LDS_BYTES, stream, a); }
#endif
}
```

```cpp
#include <hip/hip_runtime.h>
#include <cstdio>
#include <cstdint>

#define LAS __attribute__((address_space(3)))
#define GAS __attribute__((address_space(1)))
typedef unsigned short bf16_t;
typedef short bf16x8 __attribute__((ext_vector_type(8)));
typedef float f32x2 __attribute__((ext_vector_type(2)));
typedef float f32x4 __attribute__((ext_vector_type(4)));
typedef float f32x16 __attribute__((ext_vector_type(16)));
typedef unsigned u32x2 __attribute__((ext_vector_type(2)));
typedef unsigned u32x4 __attribute__((ext_vector_type(4)));
typedef LAS unsigned char* ldsp_t;

#ifndef REP_MASK
#define REP_MASK 0
#endif
#define REPS(k) (((REP_MASK >> (k)) & 1) ? 2 : 1)
#ifndef PROBE_SEL
#define PROBE_SEL 0
#endif
#ifndef MK_N_LAUNCHES
#define MK_N_LAUNCHES 1
#endif

constexpr int DM = 1024, NIN = 7168, M_P = 16384, M_S = 1024, MTOT = 17408, DEPTH = 2;
constexpr int SEQ = 2048, NBATCH = 8, DECB = 128, DECT = 8, PAST = 16384;
constexpr int HR = 8, DK = 64, DV = 128, CH = 128;
constexpr int NBLK = 16, BS = 64;
constexpr int PH = 8, NKEY = 128, NEXP = 16384, TOPK = 16, HK = 128;
constexpr float EPS = 1e-6f;
constexpr int LDP = 7168;
constexpr int PC_Q = 0, PC_K = 512, PC_V = 1024, PC_GR = 2048, PC_XR = 3072, PC_GN = 4096, PC_GA = 5120, PC_GB = 6144;
constexpr int PC_MRG = 0, PC_ARET = 1024, PC_ARNN = 4096, PC_QP = 2048;

constexpr size_t MiB = 1u << 20;
constexpr size_t WS_CTL = 0, CTL_ZERO_BYTES = 1 * MiB;
constexpr size_t WS_ROT = 1 * MiB;
constexpr size_t WS_RSS = 2 * MiB;
constexpr size_t WS_RSS2 = 2 * MiB + 128 * 1024;
constexpr size_t WS_RSSP = 2 * MiB + 256 * 1024;
constexpr size_t WS_TSC = 3 * MiB + 512 * 1024;
constexpr size_t WS_EIDX = 4 * MiB;
constexpr size_t WS_GATE = 13 * MiB;
constexpr size_t WS_KEYS = 22 * MiB;
constexpr size_t WS_WG = 23 * MiB;
constexpr size_t WS_WIN = 24 * MiB;
constexpr size_t WS_WMIX = 52 * MiB;
constexpr size_t WS_WQ = 64 * MiB;
constexpr size_t WS_XB = 72 * MiB;
constexpr size_t WS_P = 106 * MiB;
constexpr size_t WS_TAB = 344 * MiB;
constexpr size_t WS_ARET = 408 * MiB, WS_ARNN = 442 * MiB, WS_MRG = 476 * MiB;
constexpr size_t WS_END = 510 * MiB;
static_assert(WS_P + (size_t)MTOT * LDP * 2 <= WS_TAB, "ws map");

constexpr size_t O_Y = 0, O_SRP = 17825792, O_SHP = 18874368, O_SCP = 18890752, O_SRS = 18939904, O_SHS = 35717120, O_SCS = 35979264, O_END = 36765696;

constexpr int CW_BAR = 4096;
constexpr int CW_QUEUE = 16384;
constexpr int CW_TS = 20480;

constexpr int RING_BYTES = 131072;
constexpr int LDS_BYTES = 155648;
constexpr int MISC_OFF = 153600;
constexpr int NWAVES = 8, NTHREADS = 512;

#define LDS_WAIT() asm volatile("s_waitcnt lgkmcnt(0)" ::: "memory")
#define VM_WAIT() asm volatile("s_waitcnt vmcnt(0)" ::: "memory")
#define LBAR() do { asm volatile("s_waitcnt lgkmcnt(0)" ::: "memory"); __builtin_amdgcn_s_barrier(); asm volatile("" ::: "memory"); } while (0)
#define RLX_AGENT __ATOMIC_RELAXED, __HIP_MEMORY_SCOPE_AGENT

__device__ __forceinline__ unsigned f2bf(float f) { unsigned u = __builtin_bit_cast(unsigned, f); return (u + 0x7fffu + ((u >> 16) & 1u)) >> 16; }
typedef __bf16 bf16x2_t __attribute__((ext_vector_type(2)));
__device__ __forceinline__ unsigned pk2(float lo, float hi) { const f32x2 v = {lo, hi}; const bf16x2_t b = __builtin_convertvector(v, bf16x2_t); return __builtin_bit_cast(unsigned, b); }
__device__ __forceinline__ float bflo(unsigned w) { return __builtin_bit_cast(float, w << 16); }
__device__ __forceinline__ float bfhi(unsigned w) { return __builtin_bit_cast(float, w & 0xffff0000u); }
__device__ __forceinline__ float bf1(bf16_t h) { return __builtin_bit_cast(float, (unsigned)h << 16); }
__device__ __forceinline__ float sigmoidf_(float x) { return __builtin_amdgcn_rcpf(1.0f + __expf(-x)); }
__device__ __forceinline__ float siluf_(float x) { return x * sigmoidf_(x); }
__device__ __forceinline__ float geluf_(float x) { return x * sigmoidf_(1.5957691216057308f * (x + 0.044715f * x * x * x)); }
__device__ __forceinline__ float logg_of(int h) {
    float r = -0.0317486983145803f;
    r = h == 1 ? -0.015748356968139168f : r; r = h == 2 ? -0.007843177461025893f : r; r = h == 3 ? -0.003913899321136329f : r;
    r = h == 4 ? -0.0019550348358033506f : r; r = h == 5 ? -0.0009770396478266127f : r; r = h == 6 ? -0.0004884004981088745f : r; r = h == 7 ? -0.0002441704321739145f : r;
    return r;
}

namespace pg8 {
constexpr int BM = 256, BK = 64, HALF = 128, HTB = HALF * BK * 2, STAGE_BYTES = 8 * HTB, NXCD = 8, WGM = 8;
__host__ __device__ __forceinline__ int lds_byte(int r, int c) { const int st = (r >> 4) * 2 + (c >> 5), rr = r & 15, cc = c & 31, ob = rr * 64 + cc * 2; return st * 1024 + (ob ^ (((ob >> 9) & 1) << 5)); }
__host__ __device__ __forceinline__ void stage_rc(int b, int& R, int& C) { const int st = b / 1024, sb = b % 1024, swz = sb ^ (((sb >> 9) & 1) << 5); R = (st >> 1) * 16 + swz / 64; C = (st & 1) * 32 + (swz % 64) / 2; }
__host__ __device__ __forceinline__ int perm32(int rho) { const int n = rho >> 4, i = rho & 15; return 8 * (i >> 2) + 4 * n + (i & 3); }

struct Unit { int pm, pn, half; };
struct Gemm { const bf16_t* A; const bf16_t* Bt; int lda, K; size_t aoff2, boff2; };

struct StaticOrder {
    int nM, nN, nwg, G, c, pairs;
    __device__ void init(int M, int N, int G_, int c_, int pairs_) { nM = M / BM; nN = N / BM; nwg = nM * nN; G = G_; c = c_; pairs = pairs_; }
    __device__ bool next(int i, Unit& u) const {
        const int it = (pairs == 2) ? (i >> 1) : i;
        const long L = (long)it * G + c; if (L >= nwg) return false;
        int wgid = (int)L; { const int q = nwg / NXCD, r = nwg % NXCD, xcd = wgid % NXCD, off = wgid / NXCD; wgid = (xcd < r ? xcd * (q + 1) : r * (q + 1) + (xcd - r) * q) + off; }
        const int nig = WGM * nN, gid = wgid / nig, fm = gid * WGM, gsz = (nM - fm) < WGM ? (nM - fm) : WGM;
        u.pm = fm + ((wgid % nig) % gsz); u.pn = (wgid % nig) / gsz; u.half = (pairs == 2) ? (i & 1) : 0; return true;
    }
};

template <class Epi, class Sched, bool ALIGN_EPI>
__device__ __forceinline__ void gemm_phase(ldsp_t lds, const Gemm g, const Sched& S, const Epi& E, const int tid) {
    const int wid = __builtin_amdgcn_readfirstlane(tid >> 6), lane = tid & 63, wr = wid >> 2, wc = wid & 3, fr = lane & 15, fq = lane >> 4;
    const int K = g.K, nt = K / BK;
    unsigned voffA[2], voffB[2];
#pragma unroll
    for (int i = 0; i < 2; ++i) { int R, C; stage_rc(tid * 16 + i * 8192, R, C); const int Rb = Epi::PERM ? ((R & ~31) + perm32(R & 31)) : R;
        voffA[i] = (unsigned)(R * g.lda + C) * 2u; voffB[i] = (unsigned)(Rb * K + C) * 2u; }
    const size_t kstep = (size_t)(BK * 2);
    const size_t hstepA = (size_t)HALF * g.lda * 2, hstepB = (size_t)HALF * K * 2;
    const size_t tstepA = 2 * hstepA, tstepB = 2 * hstepB;
    const unsigned ldsw = (unsigned)wid * 1024u;
    const int aoff = lds_byte(wr * 64 + fr, fq * 8), boff = lds_byte(wc * 32 + fr, fq * 8);
#define PG8_SA(b, h) (((b) * 2 + (h)) * HTB)
#define PG8_SB(b, h) ((4 + (b) * 2 + (h)) * HTB)
#define PG8_STAGE(bufoff, gbase, voff) do { _Pragma("unroll") for (int _i = 0; _i < 2; ++_i) \
        __builtin_amdgcn_global_load_lds((const unsigned*)((const char*)(gbase) + (voff)[_i]), (LAS unsigned*)(lds + (bufoff) + ldsw + _i * 8192), 16, 0, 0); } while (0)
#define PG8_LDA(dst, b, h) do { _Pragma("unroll") for (int m = 0; m < 4; ++m) _Pragma("unroll") for (int k = 0; k < 2; ++k) dst[m][k] = *(const LAS bf16x8*)(lds + PG8_SA(b, h) + aoff + m * 2048 + k * 1024); } while (0)
#define PG8_LDB(dst, b, h) do { _Pragma("unroll") for (int n = 0; n < 2; ++n) _Pragma("unroll") for (int k = 0; k < 2; ++k) dst[n][k] = *(const LAS bf16x8*)(lds + PG8_SB(b, h) + boff + n * 2048 + k * 1024); } while (0)
#define PG8_MMA(ai, bj, At, Bt) do { __builtin_amdgcn_s_setprio(1); _Pragma("unroll") for (int m = 0; m < 4; ++m) _Pragma("unroll") for (int n = 0; n < 2; ++n) _Pragma("unroll") for (int k = 0; k < 2; ++k) \
        acc[ai][bj][m][n] = __builtin_amdgcn_mfma_f32_16x16x32_bf16(Bt[n][k], At[m][k], acc[ai][bj][m][n], 0, 0, 0); __builtin_amdgcn_s_setprio(0); } while (0)
#define PG8_WAIT_V(n) asm volatile("s_waitcnt vmcnt(" #n ")" ::: "memory")
#define PG8_WAIT_L(n) asm volatile("s_waitcnt lgkmcnt(" #n ")" ::: "memory")
#define PG8_BAR __builtin_amdgcn_s_barrier()
#define PG8_SCHED __builtin_amdgcn_sched_barrier(0)
    Unit cur, nxt; int ui = 0;
    if (!S.next(0, cur)) return;
    f32x4 acc[2][2][4][2];
#pragma unroll
    for (int a = 0; a < 2; ++a)
#pragma unroll
        for (int b = 0; b < 2; ++b)
#pragma unroll
            for (int m = 0; m < 4; ++m)
#pragma unroll
                for (int n = 0; n < 2; ++n) acc[a][b][m][n] = (f32x4){0.f, 0.f, 0.f, 0.f};
    bf16x8 At[4][2], B0[2][2], B1[2][2];
    const char* cA = (const char*)g.A + (size_t)cur.pm * tstepA + (cur.half ? g.aoff2 : 0); const char* cB = (const char*)g.Bt + (size_t)cur.pn * tstepB + (cur.half ? g.boff2 : 0);
    PG8_STAGE(PG8_SB(0, 0), cB, voffB); PG8_STAGE(PG8_SB(0, 1), cB + hstepB, voffB); PG8_STAGE(PG8_SA(0, 0), cA, voffA); PG8_STAGE(PG8_SA(0, 1), cA + hstepA, voffA);
    if (wr == 1) PG8_BAR;
    PG8_WAIT_V(2); PG8_BAR;
    PG8_STAGE(PG8_SB(1, 0), cB + kstep, voffB); PG8_STAGE(PG8_SA(1, 0), cA + kstep, voffA); PG8_STAGE(PG8_SB(1, 1), cB + hstepB + kstep, voffB);
    PG8_WAIT_V(6); PG8_BAR;
    for (;;) {
        const bool has_next = S.next(ui + 1, nxt);
        const char* nA = has_next ? (const char*)g.A + (size_t)nxt.pm * tstepA + (nxt.half ? g.aoff2 : 0) : cA;
        const char* nB = has_next ? (const char*)g.Bt + (size_t)nxt.pn * tstepB + (nxt.half ? g.boff2 : 0) : cB;
        for (int t = 0; t < nt; t += 2) {
            const bool last = (t == nt - 2);
            const char* a1 = cA + (size_t)(t + 1) * kstep;
            const char* a2 = last ? nA : cA + (size_t)(t + 2) * kstep; const char* b2 = last ? nB : cB + (size_t)(t + 2) * kstep;
            const char* a3 = a2 + kstep; const char* b3 = b2 + kstep;
            PG8_LDB(B0, 0, 0); PG8_LDB(B1, 0, 1); PG8_SCHED; PG8_LDA(At, 0, 0); PG8_STAGE(PG8_SA(1, 1), a1 + hstepA, voffA);
            PG8_WAIT_V(8); PG8_WAIT_L(0); PG8_BAR; PG8_MMA(0, 0, At, B0); PG8_MMA(0, 1, At, B1); PG8_BAR; PG8_SCHED;
            PG8_LDA(At, 0, 1); PG8_STAGE(PG8_SB(0, 0), b2, voffB); PG8_STAGE(PG8_SB(0, 1), b2 + hstepB, voffB); PG8_STAGE(PG8_SA(0, 0), a2, voffA);
            PG8_WAIT_V(8); PG8_WAIT_L(0); PG8_BAR; PG8_MMA(1, 0, At, B0); PG8_MMA(1, 1, At, B1); PG8_BAR; PG8_SCHED;
            PG8_LDB(B0, 1, 0); PG8_LDB(B1, 1, 1); PG8_SCHED; PG8_LDA(At, 1, 0); PG8_STAGE(PG8_SA(0, 1), a2 + hstepA, voffA);
            PG8_WAIT_V(8); PG8_WAIT_L(0); PG8_BAR; PG8_MMA(0, 0, At, B0); PG8_MMA(0, 1, At, B1); PG8_BAR; PG8_SCHED;
            PG8_LDA(At, 1, 1); PG8_STAGE(PG8_SB(1, 0), b3, voffB); PG8_STAGE(PG8_SB(1, 1), b3 + hstepB, voffB); PG8_STAGE(PG8_SA(1, 0), a3, voffA);
            PG8_WAIT_V(8); PG8_WAIT_L(0); PG8_BAR; PG8_MMA(1, 0, At, B0); PG8_MMA(1, 1, At, B1); PG8_BAR; PG8_SCHED;
        }
        if constexpr (ALIGN_EPI) { if (wr == 0) PG8_BAR; }
        E(acc, cur, wr, wc, fr, fq);
        if (!has_next) break;
#pragma unroll
        for (int a = 0; a < 2; ++a)
#pragma unroll
            for (int b = 0; b < 2; ++b)
#pragma unroll
                for (int m = 0; m < 4; ++m)
#pragma unroll
                    for (int n = 0; n < 2; ++n) acc[a][b][m][n] = (f32x4){0.f, 0.f, 0.f, 0.f};
        cur = nxt; cA = nA; cB = nB; ++ui;
        if constexpr (ALIGN_EPI) { if (wr == 1) PG8_BAR; }
    }
    PG8_WAIT_V(0);
    if constexpr (!ALIGN_EPI) { if (wr == 0) PG8_BAR; }
    PG8_BAR;
#undef PG8_SA
#undef PG8_SB
#undef PG8_STAGE
#undef PG8_LDA
#undef PG8_LDB
#undef PG8_MMA
#undef PG8_WAIT_V
#undef PG8_WAIT_L
#undef PG8_BAR
#undef PG8_SCHED
}
}

typedef GAS unsigned gu32;
#define XB_TMO      128
#define XB_XCNT(j)  (256  + 64 * (j))
#define XB_XSUB(j)  (1280 + 64 * (j))
#define XB_XGEN(j)  (2304 + 64 * (j))
#define XB_TOP      3328
#define XB_TOPGEN   3392
#define XCD_BAR_WORDS 3456
#define XB_SPIN_CAP (1u << 18)
__device__ __forceinline__ unsigned xb_ld(unsigned* p)              { return __hip_atomic_load(p, __ATOMIC_RELAXED, __HIP_MEMORY_SCOPE_AGENT); }
__device__ __forceinline__ unsigned xb_add(unsigned* p, unsigned v) { return __hip_atomic_fetch_add(p, v, __ATOMIC_RELAXED, __HIP_MEMORY_SCOPE_AGENT); }
__device__ __forceinline__ unsigned xb_xcc_id() { return (unsigned)__builtin_amdgcn_s_getreg((3 << 11) | 20) & 0xFu; }
#define XB_SPIN(cond, bar) do { unsigned _sp = 0; while (cond) { __builtin_amdgcn_s_sleep(1); \
    if ((++_sp & 255u) == 0u) { if (xb_ld(&(bar)[XB_TMO])) break; if (_sp > XB_SPIN_CAP) { atomicAdd(&(bar)[XB_TMO], 1u); break; } } } } while (0)
struct XcdBarrier { unsigned* bar; unsigned x; volatile LAS unsigned* st; };
__device__ __forceinline__ XcdBarrier xcd_barrier_post(unsigned* bar, volatile LAS unsigned* st) {
    XcdBarrier b; b.bar = bar; b.x = (unsigned)__builtin_amdgcn_readfirstlane((int)xb_xcc_id()); b.st = st;
    if (threadIdx.x == 0) (void)xb_add(&bar[XB_XCNT(b.x)], 1u);
    return b;
}
__device__ __forceinline__ void xcd_barrier_complete(unsigned* bar, unsigned x, unsigned& nloc, unsigned& nx) {
    const unsigned G = gridDim.x * gridDim.y * gridDim.z;
    unsigned sum, cnt, mine, sp = 0u;
    for (;;) {
        sum = 0u; cnt = 0u; mine = 0u;
#pragma unroll
        for (unsigned j = 0; j < 16; ++j) { const unsigned c = xb_ld(&bar[XB_XCNT(j)]); sum += c; cnt += (c > 0u) ? 1u : 0u; mine = (j == x) ? c : mine; }
        if (sum == G) break;
        __builtin_amdgcn_s_sleep(1);
        if ((++sp & 255u) == 0u) { if (xb_ld(&bar[XB_TMO])) break; if (sp > XB_SPIN_CAP) { atomicAdd(&bar[XB_TMO], 1u); break; } }
    }
    nloc = mine > 0u ? mine : 1u; nx = cnt > 0u ? cnt : 1u;
}
__device__ __forceinline__ void xcd_barrier(const XcdBarrier& b) {
    asm volatile("s_waitcnt vmcnt(0)" ::: "memory");
    __syncthreads();
    if (threadIdx.x == 0) {
        unsigned* bar = b.bar; const unsigned bx = (unsigned)__builtin_amdgcn_readfirstlane((int)b.x);
        __builtin_amdgcn_s_waitcnt(0);
        unsigned nloc = b.st[0], nx = b.st[1];
        if (nloc == 0u) { xcd_barrier_complete(bar, bx, nloc, nx); b.st[0] = nloc; b.st[1] = nx; }
        const unsigned old = xb_add(&bar[XB_XSUB(bx)], 1u);
        const unsigned gen = old / nloc;
        if (old + 1u == (gen + 1u) * nloc) {
            __builtin_amdgcn_fence(__ATOMIC_RELEASE, "agent");
            asm volatile("s_waitcnt vmcnt(0)" ::: "memory");
            const unsigned og = xb_add(&bar[XB_TOP], 1u);
            const unsigned tg = og / nx;
            if (og + 1u == (tg + 1u) * nx) xb_add(&bar[XB_TOPGEN], 1u);
            else XB_SPIN(xb_ld(&bar[XB_TOPGEN]) == tg, bar);
            __builtin_amdgcn_fence(__ATOMIC_ACQUIRE, "agent");
            xb_add(&bar[XB_XGEN(bx)], 1u);
            asm volatile("s_waitcnt vmcnt(0)" ::: "memory");
        } else {
            XB_SPIN(xb_ld(&bar[XB_XGEN(bx)]) == gen, bar);
            __builtin_amdgcn_fence(__ATOMIC_ACQUIRE, "agent");
            asm volatile("s_waitcnt vmcnt(0)" ::: "memory");
        }
    }
    __syncthreads();
}

struct Frame {
    ldsp_t lds;
    volatile LAS unsigned* MISC;
    unsigned* ctl;
    int tid, lane, wave, vcu, G;
    const float* const* in;
    unsigned char* ws;
    float* out;
};
struct Args { const float* in[24]; float* out; unsigned char* ws; int ph_lo, ph_hi; };

__device__ __forceinline__ float wave_sum(float v) {
#pragma unroll
    for (int o = 1; o < 64; o <<= 1) v += __shfl_xor(v, o);
    return v;
}

__device__ __forceinline__ void p0_transpose_item(const float* W, int K, int N, bf16_t* WT, int ldk, const float* rowscale, float colscale, bool qkperm, LAS float* scr, int item, int lane) {
    const int nblk = N / 32, kb = item / nblk, nb = item % nblk, k0 = 64 * kb, n0 = 32 * nb;
    const int j4 = lane & 7, kl = lane >> 3;
    f32x4 v[8];
    if (qkperm) {
        const int pb = (n0 & 63) + 4 * j4, hb = n0 & ~63; const int s0 = hb + (pb >> 1);
#pragma unroll
        for (int i = 0; i < 8; ++i) { const float* r = W + (size_t)(k0 + 8 * i + kl) * N + s0; const f32x2 a = *(const f32x2*)r, b = *(const f32x2*)(r + 32); v[i] = (f32x4){a.x, b.x, a.y, b.y}; }
    } else {
#pragma unroll
        for (int i = 0; i < 8; ++i) v[i] = *(const f32x4*)(W + (size_t)(k0 + 8 * i + kl) * N + n0 + 4 * j4);
    }
#pragma unroll
    for (int i = 0; i < 8; ++i) { const int kk = 8 * i + kl; const float sc = colscale * (rowscale ? rowscale[k0 + kk] : 1.0f); LAS float* d = scr + kk * 33 + 4 * j4;
        d[0] = v[i].x * sc; d[1] = v[i].y * sc; d[2] = v[i].z * sc; d[3] = v[i].w * sc; }
    LDS_WAIT(); asm volatile("" ::: "memory");
    const int c = lane & 7;
#pragma unroll
    for (int j = 0; j < 4; ++j) { const int n = (lane >> 3) + 8 * j; const LAS float* sp = scr + (8 * c) * 33 + n;
        u32x4 o; o.x = pk2(sp[0 * 33], sp[1 * 33]); o.y = pk2(sp[2 * 33], sp[3 * 33]); o.z = pk2(sp[4 * 33], sp[5 * 33]); o.w = pk2(sp[6 * 33], sp[7 * 33]);
        *(u32x4*)(WT + (size_t)(n0 + n) * ldk + k0 + 8 * c) = o; }
    LDS_WAIT(); asm volatile("" ::: "memory");
}

__device__ __forceinline__ void p0_xrow(const float* xrow, bf16_t* orow, float* rss, int lane) {
    const f32x4* xr = (const f32x4*)xrow + lane;
    f32x4 v[4]; float s = 0.f;
#pragma unroll
    for (int j = 0; j < 4; ++j) { v[j] = xr[64 * j]; s += (v[j].x * v[j].x + v[j].y * v[j].y) + (v[j].z * v[j].z + v[j].w * v[j].w); }
    s = wave_sum(s);
    u32x2* o8 = (u32x2*)orow + lane;
#pragma unroll
    for (int j = 0; j < 4; ++j) { u32x2 w; w.x = pk2(v[j].x, v[j].y); w.y = pk2(v[j].z, v[j].w); o8[64 * j] = w; }
    if (lane == 0) *rss = s;
}

__device__ __forceinline__ void p0_tabrow(const float* row, unsigned char* img, float* isc, int e, int lane) {
    const f32x4* xr = (const f32x4*)row + lane;
    f32x4 v[4]; float am = 0.f;
#pragma unroll
    for (int j = 0; j < 4; ++j) { v[j] = xr[64 * j]; am = fmaxf(am, fmaxf(fmaxf(fabsf(v[j].x), fabsf(v[j].y)), fmaxf(fabsf(v[j].z), fabsf(v[j].w)))); }
#pragma unroll
    for (int o = 1; o < 64; o <<= 1) am = fmaxf(am, __shfl_xor(am, o));
    const float sc = am > 0.f ? exp2f(floorf(log2f(224.0f / am))) : 1.0f;
#pragma unroll
    for (int j = 0; j < 4; ++j) { const int col = 256 * j + 4 * lane, sl = col >> 7, w = col & 127;
        int pk = __builtin_amdgcn_cvt_pk_fp8_f32(v[j].x * sc, v[j].y * sc, 0, false);
        pk = __builtin_amdgcn_cvt_pk_fp8_f32(v[j].z * sc, v[j].w * sc, pk, true);
        *(int*)(img + ((size_t)sl * NEXP + e) * 128 + w) = pk; }
    if (lane == 0) isc[e] = 1.0f / sc;
}

__device__ __forceinline__ void p0_prologue(const Args& a, Frame& F) {
    unsigned char* ws = a.ws;
    LAS float* scr = (LAS float*)(F.lds + F.wave * 16384);
    const int gw = F.vcu * NWAVES + F.wave, NGW = F.G * NWAVES, lane = F.lane;
    constexpr int I_IN = (DM / 64) * (NIN / 32), I_SQ = (DM / 64) * (DM / 32), I_Q = (DM / 64) * (2048 / 32), I_G = 2;
    constexpr int PER_L = I_IN + 3 * I_SQ + I_Q + 32 * I_G;
    for (int it = gw; it < DEPTH * PER_L; it += NGW) {
        const int l = it / PER_L; int r = it % PER_L;
        if (r < I_IN) { const int nb = r % (NIN / 32), n0 = nb * 32; const int seg = n0 >> 9;
            p0_transpose_item(a.in[8] + (size_t)l * DM * NIN, DM, NIN, (bf16_t*)(ws + WS_WIN) + (size_t)l * NIN * DM, DM, a.in[5] + l * DM, seg == 1 ? 0.125f : 1.0f, seg <= 1, scr, r, lane); continue; }
        r -= I_IN;
        if (r < I_SQ) { p0_transpose_item(a.in[10] + (size_t)l * DM * DM, DM, DM, (bf16_t*)(ws + WS_WMIX + (size_t)l * 6 * MiB), DM, a.in[9] + l * DM, 1.0f, false, scr, r, lane); continue; }
        r -= I_SQ;
        if (r < I_SQ) { p0_transpose_item(a.in[18] + (size_t)l * DM * DM, DM, DM, (bf16_t*)(ws + WS_WMIX + (size_t)l * 6 * MiB + 2 * MiB), DM, nullptr, 1.0f, false, scr, r, lane); continue; }
        r -= I_SQ;
        if (r < I_SQ) { p0_transpose_item(a.in[19] + (size_t)l * DM * DM, DM, DM, (bf16_t*)(ws + WS_WMIX + (size_t)l * 6 * MiB + 4 * MiB), DM, nullptr, 1.0f, false, scr, r, lane); continue; }
        r -= I_SQ;
        if (r < I_Q) { p0_transpose_item(a.in[20] + (size_t)l * DM * 2048, DM, 2048, (bf16_t*)(ws + WS_WQ) + (size_t)l * 2048 * DM, DM, a.in[6] + l * DM, 1.0f, false, scr, r, lane); continue; }
        r -= I_Q;
        { const int mat = r >> 1, sub = r & 1, nb = mat >> 1, gsel = mat & 1;
          const float* W = (gsel ? a.in[15] : a.in[13]) + ((size_t)l * NBLK + nb) * BS * BS;
          bf16_t* WT = (bf16_t*)(ws + WS_WG) + (((size_t)l * NBLK + nb) * 2 + gsel) * BS * BS;
          p0_transpose_item(W, BS, BS, WT, BS, nullptr, 1.0f, false, scr, sub, lane); }
    }
    { const float* ksrc = a.in[21]; bf16_t* kdst = (bf16_t*)(ws + WS_KEYS); const int n4 = DEPTH * PH * 2 * NKEY * HK / 4;
      for (int i = gw * 64 + lane; i < n4; i += NGW * 64) { const f32x4 v = ((const f32x4*)ksrc)[i]; u32x2 o; o.x = pk2(v.x, v.y); o.y = pk2(v.z, v.w); ((u32x2*)kdst)[i] = o; } }
    for (int m = gw; m < MTOT; m += 2 * NGW) {
        const int m2 = m + NGW; const bool v2 = m2 < MTOT; const int mm2 = v2 ? m2 : m;
        const f32x4* x1 = (const f32x4*)(m < M_P ? a.in[0] + (size_t)m * DM : a.in[1] + (size_t)(m - M_P) * DM) + lane;
        const f32x4* x2 = (const f32x4*)(mm2 < M_P ? a.in[0] + (size_t)mm2 * DM : a.in[1] + (size_t)(mm2 - M_P) * DM) + lane;
        f32x4 v[8]; float s1 = 0.f, s2 = 0.f;
#pragma unroll
        for (int j = 0; j < 4; ++j) { v[j] = x1[64 * j]; v[4 + j] = x2[64 * j]; }
#pragma unroll
        for (int j = 0; j < 4; ++j) { s1 += (v[j].x * v[j].x + v[j].y * v[j].y) + (v[j].z * v[j].z + v[j].w * v[j].w); s2 += (v[4 + j].x * v[4 + j].x + v[4 + j].y * v[4 + j].y) + (v[4 + j].z * v[4 + j].z + v[4 + j].w * v[4 + j].w); }
        s1 = wave_sum(s1); s2 = wave_sum(s2);
        u32x2* o1 = (u32x2*)((bf16_t*)(ws + WS_XB) + (size_t)m * DM) + lane; u32x2* o2 = (u32x2*)((bf16_t*)(ws + WS_XB) + (size_t)mm2 * DM) + lane;
#pragma unroll
        for (int j = 0; j < 4; ++j) { u32x2 w; w.x = pk2(v[j].x, v[j].y); w.y = pk2(v[j].z, v[j].w); o1[64 * j] = w; }
        if (v2) {
#pragma unroll
            for (int j = 0; j < 4; ++j) { u32x2 w; w.x = pk2(v[4 + j].x, v[4 + j].y); w.y = pk2(v[4 + j].z, v[4 + j].w); o2[64 * j] = w; } }
        if (lane == 0) { ((float*)(ws + WS_RSS))[m] = s1; if (v2) ((float*)(ws + WS_RSS))[m2] = s2; }
    }
    { float* rot = (float*)(ws + WS_ROT);
      for (int i = gw * 64 + lane; i < 2056 * 32; i += NGW * 64) {
          const int pi = i >> 5, fi = i & 31; const double pos = pi < 2048 ? (double)pi : (double)(PAST + pi - 2048);
          const double f8[8] = {1.0, 0.7498942093324559, 0.5623413251903491, 0.4216965034285822, 0.31622776601683794, 0.23713737056616552, 0.1778279410038923, 0.1333521432163324};
          double fr = 1.0; switch (fi >> 3) { case 1: fr = 0.1; break; case 2: fr = 0.01; break; case 3: fr = 0.001; break; default: break; }
          double fsel = f8[0];
#pragma unroll
          for (int q = 1; q < 8; ++q) fsel = ((fi & 7) == q) ? f8[q] : fsel;
          const double ang = pos * (fr * fsel);
          const double n = __builtin_rint(ang * 0.15915494309189535);
          double rr = __builtin_fma(-n, 6.283185307179586, ang); rr = __builtin_fma(-n, 2.4492935982947064e-16, rr);
          const float rf = (float)rr;
          rot[(size_t)pi * 64 + fi] = cosf(rf); rot[(size_t)pi * 64 + 32 + fi] = sinf(rf);
      } }
}

__device__ __forceinline__ void tab_unit(const Args& a, Frame& F, int l, int cu) {
    unsigned char* ws = a.ws;
#pragma unroll 2
    for (int j = 0; j < 16; ++j) { const int r = cu * 128 + F.wave * 16 + j, t = r >> 14, e = r & (NEXP - 1);
        const float* src = (t ? a.in[23] : a.in[22]) + ((size_t)l * NEXP + e) * DM;
        p0_tabrow(src, ws + WS_TAB + ((size_t)l * 2 + t) * 16 * MiB, (float*)(ws + WS_TSC) + ((size_t)l * 2 + t) * NEXP, e, F.lane); }
}

namespace pg8 {
struct EpiIn {
    static constexpr bool PERM = true;
    bf16_t* P; const float* rss; const float* rot;
    __device__ __forceinline__ void operator()(const f32x4 (&acc)[2][2][4][2], const Unit& u, int wr, int wc, int fr, int fq) const {
        const int seg = u.pn < 4 ? (u.pn >> 1) : (u.pn >> 2) + 1;
        const int row0 = u.pm * BM + wr * 64 + fr;
#if 0
        const float* rstdv = rss + row0;
#define RSTD_AT(ai, m) rstdv[(ai) * HALF + (m) * 16]
#else
        float rstdv[8];
#pragma unroll
        for (int i = 0; i < 8; ++i) rstdv[i] = rss[row0 + (i >> 2) * HALF + (i & 3) * 16];
#define RSTD_AT(ai, m) rstdv[(ai) * 4 + (m)]
#endif
        if (seg <= 1) {
            float lg[2];
#pragma unroll
            for (int bj = 0; bj < 2; ++bj) { const int hh = 4 * (u.pn & 1) + 2 * bj + (wc >> 1); lg[bj] = logg_of(hh); }
            const int i0 = 16 * (wc & 1) + 4 * fq;
#pragma unroll
            for (int ai = 0; ai < 2; ++ai)
#pragma unroll
                for (int m = 0; m < 4; ++m) {
                    const int row = row0 + ai * HALF + m * 16;
                    const float rstd = rsqrtf(RSTD_AT(ai, m) * (1.0f / DM) + EPS);
                    asm volatile("" ::: "memory");
                    const int pi = row < M_P ? (row & (SEQ - 1)) : SEQ + ((row - M_P) & (DECT - 1));
                    const float jj1 = (float)((row < M_P ? (row & (CH - 1)) : ((row - M_P) & (DECT - 1))) + 1);
                    const float* rp = rot + (size_t)pi * 64 + i0;
#pragma unroll
                    for (int bj = 0; bj < 2; ++bj) {
                        const int hh = 4 * (u.pn & 1) + 2 * bj + (wc >> 1);
                        const float f = __expf(seg == 0 ? jj1 * lg[bj] : -jj1 * lg[bj]) * rstd;
                        bf16_t* dst = P + (size_t)row * LDP + seg * 512 + hh * 64 + i0;
#pragma unroll
                        for (int n = 0; n < 2; ++n) {
                            const f32x2 c2 = *(const f32x2*)(rp + 2 * n), s2 = *(const f32x2*)(rp + 32 + 2 * n);
                            const f32x4 v = acc[ai][bj][m][n];
                            const float a0 = (v[0] * c2.x - v[1] * s2.x) * f, a1 = (v[2] * c2.y - v[3] * s2.y) * f;
                            const float b0 = (v[0] * s2.x + v[1] * c2.x) * f, b1 = (v[2] * s2.y + v[3] * c2.y) * f;
                            *(unsigned*)(dst + 2 * n) = pk2(a0, a1); *(unsigned*)(dst + 32 + 2 * n) = pk2(b0, b1);
                        }
                    }
                    if (m & 1) asm volatile("" ::: "memory");
                }
        } else {
            const int col0 = u.pn * BM + wc * 32 + 8 * fq;
            const bool has_act = (seg == 3) || (seg >= 5), is_sig = seg >= 6;
            const float c1 = (seg == 5) ? 1.5957691216057308f : 1.0f, c3 = (seg == 5) ? 1.5957691216057308f * 0.044715f : 0.0f;
#pragma unroll
            for (int ai = 0; ai < 2; ++ai)
#pragma unroll
                for (int m = 0; m < 4; ++m) {
                    const int row = row0 + ai * HALF + m * 16;
                    const float rstd = rsqrtf(RSTD_AT(ai, m) * (1.0f / DM) + EPS);
                    bf16_t* rowp = P + (size_t)row * LDP + col0;
#pragma unroll
                    for (int bj = 0; bj < 2; ++bj) {
                        f32x4 v0 = acc[ai][bj][m][0] * rstd, v1 = acc[ai][bj][m][1] * rstd;
                        if (has_act) {
#pragma unroll
                            for (int j = 0; j < 4; ++j) { const float a0 = v0[j], a1 = v1[j];
                                const float s0 = sigmoidf_(a0 * (c1 + c3 * a0 * a0)), s1 = sigmoidf_(a1 * (c1 + c3 * a1 * a1));
                                v0[j] = (is_sig ? 1.0f : a0) * s0; v1[j] = (is_sig ? 1.0f : a1) * s1; }
                        }
                        u32x4 w; w.x = pk2(v0[0], v0[1]); w.y = pk2(v0[2], v0[3]); w.z = pk2(v1[0], v1[1]); w.w = pk2(v1[2], v1[3]);
                        *(u32x4*)(rowp + bj * HALF) = w;
                    }
                }
        }
    }
};

struct EpiMerge {
    static constexpr bool PERM = true;
    bf16_t* P; bf16_t* MRG;
    __device__ __forceinline__ void operator()(const f32x4 (&acc)[2][2][4][2], const Unit& u, int wr, int wc, int fr, int fq) const {
        const int row0 = u.pm * BM + wr * 64 + fr, col0 = u.pn * BM + wc * 32 + 8 * fq;
        const int gc = u.half ? PC_GB : PC_GA;
#pragma unroll
        for (int ai = 0; ai < 2; ++ai)
#pragma unroll
            for (int m = 0; m < 4; ++m) {
                bf16_t* rowp = P + (size_t)(row0 + ai * HALF + m * 16) * LDP; bf16_t* mrow = MRG + (size_t)(row0 + ai * HALF + m * 16) * DM;
#pragma unroll
                for (int bj = 0; bj < 2; ++bj) {
                    const int c = col0 + bj * HALF;
                    const u32x4 g = *(const u32x4*)(rowp + gc + c);
                    f32x4 v0 = acc[ai][bj][m][0], v1 = acc[ai][bj][m][1];
                    v0[0] *= bflo(g.x); v0[1] *= bfhi(g.x); v0[2] *= bflo(g.y); v0[3] *= bfhi(g.y);
                    v1[0] *= bflo(g.z); v1[1] *= bfhi(g.z); v1[2] *= bflo(g.w); v1[3] *= bfhi(g.w);
                    if (u.half) { const u32x4 p = *(const u32x4*)(mrow + c);
                        v0[0] += bflo(p.x); v0[1] += bfhi(p.x); v0[2] += bflo(p.y); v0[3] += bfhi(p.y);
                        v1[0] += bflo(p.z); v1[1] += bfhi(p.z); v1[2] += bflo(p.w); v1[3] += bfhi(p.w); }
                    u32x4 w; w.x = pk2(v0[0], v0[1]); w.y = pk2(v0[2], v0[3]); w.z = pk2(v1[0], v1[1]); w.w = pk2(v1[2], v1[3]);
                    *(u32x4*)(mrow + c) = w;
                }
                if (m == 3) asm volatile("" ::: "memory");
            }
    }
};

struct EpiWo {
    static constexpr bool PERM = false;
    const float* xp; const float* xs;
    float* X; bf16_t* XB; float* rssp;
    __device__ __forceinline__ void operator()(const f32x4 (&acc)[2][2][4][2], const Unit& u, int wr, int wc, int fr, int fq) const {
        const int row0 = u.pm * BM + wr * 64 + fr, col0 = u.pn * BM + wc * 32 + 4 * fq;
#pragma unroll
        for (int ai = 0; ai < 2; ++ai)
#pragma unroll
            for (int m = 0; m < 4; ++m) {
                const int row = row0 + ai * HALF + m * 16;
                const float* src = (row < M_P ? xp + (size_t)row * DM : xs + (size_t)(row - M_P) * DM) + col0;
                float* dst = X + (size_t)row * DM + col0; bf16_t* dstb = XB + (size_t)row * DM + col0;
                float ss = 0.f;
#pragma unroll
                for (int bj = 0; bj < 2; ++bj)
#pragma unroll
                    for (int n = 0; n < 2; ++n) {
                        const f32x4 o = *(const f32x4*)(src + bj * HALF + n * 16) + acc[ai][bj][m][n];
                        *(f32x4*)(dst + bj * HALF + n * 16) = o;
                        u32x2 w; w.x = pk2(o[0], o[1]); w.y = pk2(o[2], o[3]); *(u32x2*)(dstb + bj * HALF + n * 16) = w;
                        ss += (o[0] * o[0] + o[1] * o[1]) + (o[2] * o[2] + o[3] * o[3]);
                    }
                ss += __shfl_xor(ss, 16); ss += __shfl_xor(ss, 32);
                if (fq == 0) rssp[(size_t)(u.pn * 4 + wc) * MTOT + row] = ss;
                if (m == 3) asm volatile("" ::: "memory");
            }
    }
};

struct EpiQ {
    static constexpr bool PERM = true;
    bf16_t* P; const float* rssp; float* rss2;
    __device__ __forceinline__ void operator()(const f32x4 (&acc)[2][2][4][2], const Unit& u, int wr, int wc, int fr, int fq) const {
        const int row0 = u.pm * BM + wr * 64 + fr, col0 = u.pn * BM + wc * 32 + 8 * fq;
        float rstdv[8];
#pragma unroll
        for (int i = 0; i < 8; ++i) { const int row = row0 + (i >> 2) * HALF + (i & 3) * 16; float s = 0.f;
#pragma unroll
            for (int j = 0; j < 16; ++j) s += rssp[(size_t)j * MTOT + row];
            if (u.pn == 0 && wc == 0 && fq == 0) rss2[row] = s;
            rstdv[i] = rsqrtf(s * (1.0f / DM) + EPS);
            if ((i & 3) == 3) asm volatile("" ::: "memory"); }
#pragma unroll
        for (int ai = 0; ai < 2; ++ai)
#pragma unroll
            for (int m = 0; m < 4; ++m) {
                const int row = row0 + ai * HALF + m * 16;
                const float rstd = rstdv[ai * 4 + m];
                bf16_t* rowp = P + (size_t)row * LDP + PC_QP + col0;
#pragma unroll
                for (int bj = 0; bj < 2; ++bj) {
                    const f32x4 v0 = acc[ai][bj][m][0] * rstd, v1 = acc[ai][bj][m][1] * rstd;
                    u32x4 w; w.x = pk2(v0[0], v0[1]); w.y = pk2(v0[2], v0[3]); w.z = pk2(v1[0], v1[1]); w.w = pk2(v1[2], v1[3]);
                    *(u32x4*)(rowp + bj * HALF) = w;
                }
            }
    }
};
}

__device__ __forceinline__ void mma32(f32x16& acc, ldsp_t A, int lda_b, ldsp_t Bt, int ldb_b, int ksteps, int lane) {
    ldsp_t ap = A + (lane & 31) * lda_b + (lane >> 5) * 16;
    ldsp_t bp = Bt + (lane & 31) * ldb_b + (lane >> 5) * 16;
    for (int ks = 0; ks < ksteps; ++ks) {
        const bf16x8 a = *(const LAS bf16x8*)(ap + ks * 32), b = *(const LAS bf16x8*)(bp + ks * 32);
        acc = __builtin_amdgcn_mfma_f32_32x32x16_bf16(a, b, acc, 0, 0, 0);
    }
}
template <int KS>
__device__ __forceinline__ void mma32t(f32x16& acc, ldsp_t A, int lda_b, ldsp_t Bt, int ldb_b, int lane) {
    ldsp_t ap = A + (lane & 31) * lda_b + (lane >> 5) * 16;
    ldsp_t bp = Bt + (lane & 31) * ldb_b + (lane >> 5) * 16;
    bf16x8 av[KS], bv[KS];
#pragma unroll
    for (int ks = 0; ks < KS; ++ks) { av[ks] = *(const LAS bf16x8*)(ap + ks * 32); bv[ks] = *(const LAS bf16x8*)(bp + ks * 32); }
#pragma unroll
    for (int ks = 0; ks < KS; ++ks) acc = __builtin_amdgcn_mfma_f32_32x32x16_bf16(av[ks], bv[ks], acc, 0, 0, 0);
}
#define ZERO16 ((f32x16){0.f,0.f,0.f,0.f,0.f,0.f,0.f,0.f,0.f,0.f,0.f,0.f,0.f,0.f,0.f,0.f})

constexpr int R_QS = 0, R_KS = 18432, R_VS = 43008, R_SS = 83968, R_RST = 118784, R_ST = 137216;
constexpr int LD64 = 144, LDK = 192, LDV = 320, LD128 = 272;
typedef short v4i16_t __attribute__((ext_vector_type(4)));
__device__ __forceinline__ bf16x8 frag_tr(ldsp_t X, int stride_b, int c0, int k0, int lane) {
    const int h = lane >> 5, blk = (lane >> 4) & 1, q = (lane & 15) >> 2, p = lane & 3;
    ldsp_t a = X + (k0 + 8 * h + q) * stride_b + (c0 + 16 * blk + 4 * p) * 2;
    const v4i16_t lo = __builtin_amdgcn_ds_read_tr16_b64_v4i16((LAS v4i16_t*)a), hi = __builtin_amdgcn_ds_read_tr16_b64_v4i16((LAS v4i16_t*)(a + 4 * stride_b));
    return (bf16x8){lo[0], lo[1], lo[2], lo[3], hi[0], hi[1], hi[2], hi[3]};
}
__device__ __forceinline__ bf16x8 frag_row(ldsp_t X, int stride_b, int r0, int k0, int lane) { return *(const LAS bf16x8*)(X + (r0 + (lane & 31)) * stride_b + (k0 + 8 * (lane >> 5)) * 2); }

__device__ __forceinline__ void ret_prompt_unit(const Args& a, Frame& F, int l, int b, int h) {
    const int tid = F.tid, lane = F.lane, w = F.wave, hi = lane >> 5, l31 = lane & 31;
    ldsp_t lds = F.lds;
    const bf16_t* P = (const bf16_t*)(a.ws + WS_P);
    bf16_t* ARET = (bf16_t*)(a.ws + WS_ARET);
    const float lg = logg_of(h), G = __expf(128.0f * lg);
    f32x16 racc = ZERO16;
    const int db = w >> 2, eb = w & 3;
    u32x4 pq[2], pk[2], pv[4], pg[4];
#define RET_FETCH(nn) do { const bf16_t* _b = P + ((size_t)b * SEQ + (nn) * CH) * LDP + h * 64; \
        _Pragma("unroll") for (int i = 0; i < 2; ++i) { const int p = tid + 512 * i; const bf16_t* _r = _b + (size_t)(p >> 3) * LDP + (p & 7) * 8; pq[i] = *(const u32x4*)(_r + PC_Q); pk[i] = *(const u32x4*)(_r + PC_K); } \
        _Pragma("unroll") for (int i = 0; i < 4; ++i) { const int p = tid + 512 * i; const bf16_t* _r = _b + h * 64 + (size_t)(p >> 4) * LDP + (p & 15) * 8; pv[i] = *(const u32x4*)(_r + PC_V); } } while (0)
#define RET_FETCH_G(nn) do { const bf16_t* _b = P + ((size_t)b * SEQ + (nn) * CH) * LDP + h * 128 + PC_GR; \
        _Pragma("unroll") for (int i = 0; i < 4; ++i) { const int p = tid + 512 * i; pg[i] = *(const u32x4*)(_b + (size_t)(p >> 4) * LDP + (p & 15) * 8); } } while (0)
    RET_FETCH(0);
    for (int n = 0; n < 16; ++n) {
        const size_t tok0 = (size_t)b * SEQ + n * CH;
#pragma unroll
        for (int i = 0; i < 2; ++i) { const int p = tid + 512 * i; *(LAS u32x4*)(lds + R_QS + (p >> 3) * LD64 + (p & 7) * 16) = pq[i]; *(LAS u32x4*)(lds + R_KS + (p >> 3) * LDK + (p & 7) * 16) = pk[i]; }
#pragma unroll
        for (int i = 0; i < 4; ++i) { const int p = tid + 512 * i; *(LAS u32x4*)(lds + R_VS + (p >> 4) * LDV + (p & 15) * 16) = pv[i]; }
#pragma unroll
        for (int g = 0; g < 4; ++g) { u32x2 wv; wv.x = pk2(racc[4 * g], racc[4 * g + 1]); wv.y = pk2(racc[4 * g + 2], racc[4 * g + 3]);
            *(LAS u32x2*)(lds + R_RST + (32 * eb + l31) * LD64 + (32 * db + 8 * g + 4 * hi) * 2) = wv; }
        if (n + 1 < 16) RET_FETCH(n + 1);
        RET_FETCH_G(n);
        LBAR();
#pragma unroll
        for (int t2 = 0; t2 < 2; ++t2) { const int t = 2 * w + t2, mb = t >> 2, jb = t & 3;
            if (mb <= jb) { f32x16 sacc = ZERO16;
                bf16x8 af[4], bf[4];
#pragma unroll
                for (int ks = 0; ks < 4; ++ks) { af[ks] = frag_row(lds + R_KS, LDK, 32 * mb, 16 * ks, lane); bf[ks] = frag_row(lds + R_QS, LD64, 32 * jb, 16 * ks, lane); }
#pragma unroll
                for (int ks = 0; ks < 4; ++ks) sacc = __builtin_amdgcn_mfma_f32_32x32x16_bf16(af[ks], bf[ks], sacc, 0, 0, 0);
                const int j = 32 * jb + l31;
#pragma unroll
                for (int g = 0; g < 4; ++g) { const int m0 = 32 * mb + 8 * g + 4 * hi; float v[4];
#pragma unroll
                    for (int q = 0; q < 4; ++q) v[q] = (j >= m0 + q) ? sacc[4 * g + q] : 0.f;
                    u32x2 wv; wv.x = pk2(v[0], v[1]); wv.y = pk2(v[2], v[3]);
                    *(LAS u32x2*)(lds + R_SS + j * LD128 + m0 * 2) = wv; } } }
        LBAR();
        const int jb = w >> 1, eh = w & 1;
        f32x16 oacc[2];
        oacc[0] = ZERO16; oacc[1] = ZERO16;
        { bf16x8 a0[4], a1[4], bf[4];
#pragma unroll
          for (int ks = 0; ks < 4; ++ks) { a0[ks] = frag_row(lds + R_RST, LD64, 32 * (2 * eh), 16 * ks, lane); a1[ks] = frag_row(lds + R_RST, LD64, 32 * (2 * eh + 1), 16 * ks, lane); bf[ks] = frag_row(lds + R_QS, LD64, 32 * jb, 16 * ks, lane); }
#pragma unroll
          for (int ks = 0; ks < 4; ++ks) { oacc[0] = __builtin_amdgcn_mfma_f32_32x32x16_bf16(a0[ks], bf[ks], oacc[0], 0, 0, 0); oacc[1] = __builtin_amdgcn_mfma_f32_32x32x16_bf16(a1[ks], bf[ks], oacc[1], 0, 0, 0); } }
        for (int mbk = 0; mbk <= jb; ++mbk) {
            bf16x8 a0[2], a1[2], bf[2];
#pragma unroll
            for (int ks = 0; ks < 2; ++ks) { const int k0 = 32 * mbk + 16 * ks; a0[ks] = frag_tr(lds + R_VS, LDV, 32 * (2 * eh), k0, lane); a1[ks] = frag_tr(lds + R_VS, LDV, 32 * (2 * eh + 1), k0, lane); bf[ks] = frag_row(lds + R_SS, LD128, 32 * jb, k0, lane); }
#pragma unroll
            for (int ks = 0; ks < 2; ++ks) { oacc[0] = __builtin_amdgcn_mfma_f32_32x32x16_bf16(a0[ks], bf[ks], oacc[0], 0, 0, 0); oacc[1] = __builtin_amdgcn_mfma_f32_32x32x16_bf16(a1[ks], bf[ks], oacc[1], 0, 0, 0); }
        }
        float s1 = 0.f, s2 = 0.f;
#pragma unroll
        for (int t = 0; t < 2; ++t)
#pragma unroll
            for (int r = 0; r < 16; ++r) { s1 += oacc[t][r]; s2 += oacc[t][r] * oacc[t][r]; }
        s1 += __shfl_xor(s1, 32); s2 += __shfl_xor(s2, 32);
        if (hi == 0) *(LAS f32x2*)(lds + R_ST + (eh * 128 + 32 * jb + l31) * 8) = (f32x2){s1, s2};
        LBAR();
        { const int j = 32 * jb + l31;
          const f32x2 sa = *(const LAS f32x2*)(lds + R_ST + j * 8), sb = *(const LAS f32x2*)(lds + R_ST + (128 + j) * 8);
          const float mu = (sa.x + sb.x) * (1.0f / DV), var = (sa.y + sb.y) * (1.0f / DV) - mu * mu, rstd = rsqrtf(fmaxf(var, 0.f) + EPS);
#pragma unroll
          for (int t = 0; t < 2; ++t)
#pragma unroll
              for (int g = 0; g < 4; ++g) { const int e0 = 32 * (2 * eh + t) + 8 * g + 4 * hi;
                  u32x2 wv; wv.x = pk2((oacc[t][4 * g] - mu) * rstd, (oacc[t][4 * g + 1] - mu) * rstd); wv.y = pk2((oacc[t][4 * g + 2] - mu) * rstd, (oacc[t][4 * g + 3] - mu) * rstd);
                  *(LAS u32x2*)(lds + R_SS + j * LD128 + e0 * 2) = wv; } }
#pragma unroll
        for (int kh = 0; kh < 2; ++kh) { bf16x8 af[4], bf[4];
#pragma unroll
          for (int ks = 0; ks < 4; ++ks) { af[ks] = frag_tr(lds + R_KS, LDK, 32 * db, 64 * kh + 16 * ks, lane); bf[ks] = frag_tr(lds + R_VS, LDV, 32 * eb, 64 * kh + 16 * ks, lane); }
#pragma unroll
          for (int ks = 0; ks < 4; ++ks) racc = __builtin_amdgcn_mfma_f32_32x32x16_bf16(af[ks], bf[ks], racc, 0, 0, 0); }
#pragma unroll
        for (int r = 0; r < 16; ++r) racc[r] *= G;
        LBAR();
#pragma unroll
        for (int i = 0; i < 4; ++i) { const int p = tid + 512 * i, row = p >> 4, c = p & 15;
            const u32x4 ov = *(const LAS u32x4*)(lds + R_SS + row * LD128 + c * 16), gv = pg[i];
            u32x4 wv; wv.x = pk2(bflo(ov.x) * bflo(gv.x), bfhi(ov.x) * bfhi(gv.x)); wv.y = pk2(bflo(ov.y) * bflo(gv.y), bfhi(ov.y) * bfhi(gv.y));
            wv.z = pk2(bflo(ov.z) * bflo(gv.z), bfhi(ov.z) * bfhi(gv.z)); wv.w = pk2(bflo(ov.w) * bflo(gv.w), bfhi(ov.w) * bfhi(gv.w));
            *(u32x4*)(ARET + (tok0 + row) * DM + h * 128 + c * 8) = wv; }
    }
    float* so = a.out + O_SRP + ((((size_t)l * NBATCH + b) * HR + h) * DK) * DV;
#pragma unroll
    for (int r = 0; r < 16; ++r) { const int d = 32 * db + (r & 3) + 8 * (r >> 2) + 4 * hi; so[(size_t)d * DV + 32 * eb + l31] = racc[r]; }
#undef RET_FETCH
#undef RET_FETCH_G
}

__device__ __forceinline__ void ret_sample_unit(const Args& a, Frame& F, int l, int bs, int h) {
    const int tid = F.tid, lane = F.lane, w = F.wave;
    LAS float* qd = (LAS float*)F.lds; LAS float* ku = qd + 512; LAS float* vv = ku + 512; LAS float* S = vv + 1024; LAS float* crossp = S + 64; LAS float* red = crossp + 4096;
    bf16_t* P = (bf16_t*)(a.ws + WS_P);
    const size_t tok0 = (size_t)M_P + bs * DECT;
    { const int j = tid >> 6, d = tid & 63; const bf16_t* src = P + (tok0 + j) * LDP + h * 64 + d; qd[tid] = bf1(src[PC_Q]); ku[tid] = bf1(src[PC_K]); }
#pragma unroll
    for (int i = 0; i < 2; ++i) { const int idx = tid + 512 * i, m = idx >> 7, e = idx & 127; vv[idx] = bf1(P[(tok0 + m) * LDP + PC_V + h * 128 + e]); }
    LBAR();
    const int dg = tid >> 7, e = tid & 127;
    const size_t soff = ((((size_t)l * DECB + bs) * HR + h) * DK) * DV;
    const float* r0 = a.in[2] + soff; float* rn = a.out + O_SRS + soff;
    const float lg = logg_of(h), G8 = __expf(8.0f * lg);
    float cross[8];
#pragma unroll
    for (int j = 0; j < 8; ++j) cross[j] = 0.f;
    float rv[16];
#pragma unroll
    for (int dd = 0; dd < 16; ++dd) rv[dd] = r0[(size_t)(dg * 16 + dd) * DV + e];
#pragma unroll
    for (int dd = 0; dd < 16; ++dd) { const int d = dg * 16 + dd; const float r = rv[dd]; float kvs = 0.f;
#pragma unroll
        for (int m = 0; m < 8; ++m) kvs += ku[m * 64 + d] * vv[m * 128 + e];
        rn[(size_t)d * DV + e] = G8 * (r + kvs);
#pragma unroll
        for (int j = 0; j < 8; ++j) cross[j] += qd[j * 64 + d] * r; }
#pragma unroll
    for (int j = 0; j < 8; ++j) crossp[(dg * 8 + j) * 128 + e] = cross[j];
    { const int pr = tid >> 3, part = tid & 7, j = pr >> 3, m = pr & 7; float sp = 0.f;
#pragma unroll
      for (int d = 0; d < 8; ++d) sp += qd[j * 64 + part * 8 + d] * ku[m * 64 + part * 8 + d];
      sp += __shfl_xor(sp, 1); sp += __shfl_xor(sp, 2); sp += __shfl_xor(sp, 4);
      if (part == 0) S[pr] = (j >= m) ? sp : 0.f; }
    LBAR();
    float o[2];
#pragma unroll
    for (int jj = 0; jj < 2; ++jj) { const int j = dg + 4 * jj; float s = 0.f;
#pragma unroll
        for (int g = 0; g < 4; ++g) s += crossp[(g * 8 + j) * 128 + e];
#pragma unroll
        for (int m = 0; m < 8; ++m) s += S[j * 8 + m] * vv[m * 128 + e];
        o[jj] = s;
        const float t1 = wave_sum(s), t2 = wave_sum(s * s);
        if (lane == 0) { red[(jj * 8 + w) * 2] = t1; red[(jj * 8 + w) * 2 + 1] = t2; } }
    LBAR();
#pragma unroll
    for (int jj = 0; jj < 2; ++jj) { const int j = dg + 4 * jj, w0 = 2 * dg;
        const float t1 = red[(jj * 8 + w0) * 2] + red[(jj * 8 + w0 + 1) * 2], t2 = red[(jj * 8 + w0) * 2 + 1] + red[(jj * 8 + w0 + 1) * 2 + 1];
        const float mu = t1 * (1.0f / DV), var = t2 * (1.0f / DV) - mu * mu, rstd = rsqrtf(fmaxf(var, 0.f) + EPS);
        const bf16_t* prow = P + (tok0 + j) * LDP + h * 128 + e;
        ((bf16_t*)(a.ws + WS_ARET))[(tok0 + j) * DM + h * 128 + e] = (bf16_t)f2bf((o[jj] - mu) * rstd * bf1(prow[PC_GR])); }
    LBAR();
}

constexpr int N_XRL = 0, N_XCF = 33536, N_XCB = 66304, N_WGT = 84736, N_CAR = 103168, N_BUF = 107264;
__device__ __forceinline__ void rnn_unit(const Args& a, Frame& F, int l, bool sample, int bg, int nb) {
    const int tid = F.tid, lane = F.lane, w = F.wave, hi = lane >> 5, l31 = lane & 31;
    ldsp_t lds = F.lds;
    LAS float* xrl = (LAS float*)(lds + N_XRL); LAS float* xcf = (LAS float*)(lds + N_XCF); LAS float* car = (LAS float*)(lds + N_CAR); LAS float* bufl = (LAS float*)(lds + N_BUF);
    LAS float* aa = xrl; LAS float* uu = xcf;
    bf16_t* P = (bf16_t*)(a.ws + WS_P);
    const int ch0 = nb * BS;
    { const bf16_t* wg = (const bf16_t*)(a.ws + WS_WG) + ((size_t)l * NBLK + nb) * 2 * BS * BS;
#pragma unroll
      for (int i = 0; i < 2; ++i) { const int p = tid + 512 * i, row = p >> 3, c8 = p & 7; *(LAS u32x4*)(lds + N_WGT + row * LD64 + c8 * 16) = *(const u32x4*)(wg + row * 64 + c8 * 8); } }
    const int cc = tid & 63;
    const float* cwp = a.in[11] + (size_t)l * 4 * DM + ch0 + cc;
    const float cw0 = cwp[0], cw1 = cwp[DM], cw2 = cwp[2 * DM], cw3 = cwp[3 * DM], cbv = a.in[12][l * DM + ch0 + cc];
    const int rb = w >> 1, cb = w & 1, dcol = 32 * cb + l31;
    const float bav = a.in[14][l * DM + ch0 + dcol], bxv = a.in[16][l * DM + ch0 + dcol];
    const float spe = __expf(-a.in[17][l * DM + ch0 + dcol]);
    const float spl = spe > 0.05f ? __logf(1.0f + spe) : spe * (1.0f - spe * (0.5f - spe * (1.0f / 3.0f - 0.25f * spe)));
    const int ntiles = sample ? 1 : 16;
    float hcar = 0.f;
    if (sample) {
        for (int i = tid; i < 16 * 3 * 64; i += NTHREADS) { const int s = i / 192, r = (i / 64) % 3, c = i & 63;
            bufl[i] = a.in[4][(((size_t)l * DECB + bg * 16 + s) * 3 + r) * DM + ch0 + c]; }
    }
    u32x4 pre[3];
#define RNN_FETCH(nn) do { const size_t _t0 = sample ? (size_t)M_P + bg * 128 : (size_t)bg * SEQ + (nn) * 128; _Pragma("unroll") for (int k = 0; k < 3; ++k) { \
        const int p = tid + 512 * k, row = p >> 3, c8 = p & 7; pre[k] = (u32x4){0u, 0u, 0u, 0u}; \
        if (p < 131 * 8 && (row >= 3 || (!sample && (nn) > 0))) pre[k] = *(const u32x4*)(P + (_t0 + row - 3) * LDP + PC_XR + ch0 + c8 * 8); } } while (0)
    RNN_FETCH(0);
    for (int n = 0; n < ntiles; ++n) {
        const size_t tok0 = sample ? (size_t)M_P + bg * 128 : (size_t)bg * SEQ + n * 128;
        unsigned short gl[16];
#pragma unroll
        for (int i = 0; i < 16; ++i) gl[i] = P[(tok0 + 16 * w + i) * LDP + PC_GN + ch0 + cc];
#pragma unroll
        for (int k = 0; k < 3; ++k) { const int p = tid + 512 * k, row = p >> 3, c8 = p & 7;
            if (p < 131 * 8) { const u32x4 v = pre[k]; LAS float* d = xrl + row * 64 + c8 * 8;
                *(LAS f32x4*)d = (f32x4){bflo(v.x), bfhi(v.x), bflo(v.y), bfhi(v.y)}; *(LAS f32x4*)(d + 4) = (f32x4){bflo(v.z), bfhi(v.z), bflo(v.w), bfhi(v.w)}; } }
        LBAR();
        if (n + 1 < ntiles) RNN_FETCH(n + 1);
        { const int tg = tid >> 6;
#pragma unroll 4
          for (int i = 0; i < 16; ++i) { const int t = tg * 16 + i; float x0, x1, x2;
              const float x3 = xrl[(t + 3) * 64 + cc];
              if (sample) { const int s = t >> 3, j = t & 7;
                  x0 = j >= 3 ? xrl[t * 64 + cc] : bufl[(s * 3 + j) * 64 + cc];
                  x1 = j >= 2 ? xrl[(t + 1) * 64 + cc] : bufl[(s * 3 + j + 1) * 64 + cc];
                  x2 = j >= 1 ? xrl[(t + 2) * 64 + cc] : bufl[(s * 3 + j + 2) * 64 + cc];
              } else { x0 = xrl[t * 64 + cc]; x1 = xrl[(t + 1) * 64 + cc]; x2 = xrl[(t + 2) * 64 + cc]; }
              const float xc = cbv + cw0 * x0 + cw1 * x1 + cw2 * x2 + cw3 * x3;
              xcf[t * 64 + cc] = xc; *(LAS bf16_t*)(lds + N_XCB + t * LD64 + cc * 2) = (bf16_t)f2bf(xc); } }
        if (sample) { if (tid < 192) { }     }
        if (sample) { for (int i = tid; i < 16 * 3 * 64; i += NTHREADS) { const int s = i / 192, r = (i / 64) % 3, c = i & 63;
                a.out[O_SCS + (((size_t)l * DECB + bg * 16 + s) * 3 + r) * DM + ch0 + c] = xrl[(3 + s * 8 + 5 + r) * 64 + c]; } }
        else if (n == 15) { if (tid < 192) { const int r = tid >> 6, c = tid & 63; a.out[O_SCP + (((size_t)l * NBATCH + bg) * 3 + r) * DM + ch0 + c] = xrl[(3 + 125 + r) * 64 + c]; } }
        LBAR();
        { f32x16 ar = ZERO16, ai = ZERO16;
          mma32t<4>(ar, lds + N_XCB + rb * 32 * LD64, LD64, lds + N_WGT + (32 * cb) * LD64, LD64, lane);
          mma32t<4>(ai, lds + N_XCB + rb * 32 * LD64, LD64, lds + N_WGT + (64 + 32 * cb) * LD64, LD64, lane);
#pragma unroll
          for (int r = 0; r < 16; ++r) { const int t = 32 * rb + (r & 3) + 8 * (r >> 2) + 4 * hi;
              const float rg = sigmoidf_(ar[r] + bav), ig = sigmoidf_(ai[r] + bxv);
              const float la = -8.0f * rg * spl, av = __expf(la), y2 = 2.0f * la;
              const float om = y2 < -0.3f ? 1.0f - av * av : -y2 * (1.0f + y2 * (0.5f + y2 * (1.0f / 6.0f + y2 * (1.0f / 24.0f + y2 * (1.0f / 120.0f)))));
              const float mult = sqrtf(fmaxf(om, 0.f));
              const float xc = xcf[t * 64 + dcol];
              aa[t * 64 + dcol] = av; uu[t * 64 + dcol] = mult * ig * xc; } }
        LBAR();
        if (!sample) {
            float Ap = 1.f, Hl = 0.f;
#pragma unroll 4
            for (int i = 0; i < 16; ++i) { const int t = 16 * w + i; const float av = aa[t * 64 + cc], uv = uu[t * 64 + cc]; Hl = av * Hl + uv; Ap *= av; }
            car[w * 64 + cc] = Ap; car[512 + w * 64 + cc] = Hl;
            LBAR();
            float hin = hcar, hnext = hcar;
#pragma unroll
            for (int w2 = 0; w2 < 8; ++w2) { const float A2 = car[w2 * 64 + cc], H2 = car[512 + w2 * 64 + cc]; hnext = A2 * hnext + H2; if (w2 < w) hin = hnext; }
            float hh = hin;
#pragma unroll
            for (int i = 0; i < 16; ++i) { const int t = 16 * w + i; hh = aa[t * 64 + cc] * hh + uu[t * 64 + cc];
                ((bf16_t*)(a.ws + WS_ARNN))[(tok0 + t) * DM + ch0 + cc] = (bf16_t)f2bf(hh * bf1(gl[i])); }
            hcar = hnext;
        } else {
#pragma unroll
            for (int s2 = 0; s2 < 2; ++s2) { const int s = 2 * w + s2, bs = bg * 16 + s;
                float hh = a.in[3][((size_t)l * DECB + bs) * DM + ch0 + cc];
#pragma unroll
                for (int j = 0; j < 8; ++j) { const int t = s * 8 + j; hh = aa[t * 64 + cc] * hh + uu[t * 64 + cc];
                    ((bf16_t*)(a.ws + WS_ARNN))[(tok0 + t) * DM + ch0 + cc] = (bf16_t)f2bf(hh * bf1(gl[s2 * 8 + j])); }
                a.out[O_SHS + ((size_t)l * DECB + bs) * DM + ch0 + cc] = hh; }
        }
        LBAR();
    }
    if (!sample && w == 0) a.out[O_SHP + ((size_t)l * NBATCH + bg) * DM + ch0 + cc] = hcar;
#undef RNN_FETCH
}

__device__ __forceinline__ unsigned ord_of(float f) { const unsigned u = __builtin_bit_cast(unsigned, f); return u ^ ((u >> 31) ? 0xFFFFFFFFu : 0x80000000u); }
__device__ __forceinline__ float ord_inv(unsigned o) { const unsigned u = (o >> 31) ? (o ^ 0x80000000u) : ~o; return __builtin_bit_cast(float, u); }
__host__ __device__ constexpr bool cand_ok(int a, int b) { return (a + 1) * (b + 1) <= 16; }

#define CEX(a, b) do { const unsigned _x = (a), _y = (b); (a) = _x > _y ? _x : _y; (b) = _x > _y ? _y : _x; } while (0)
__device__ __forceinline__ void sort16_desc(unsigned (&v)[16]) {
#pragma unroll
    for (int k = 2; k <= 16; k <<= 1)
#pragma unroll
        for (int j = k >> 1; j > 0; j >>= 1)
#pragma unroll
            for (int i = 0; i < 16; ++i) { const int p = i ^ j; if (p > i) { if ((i & k) == 0) CEX(v[i], v[p]); else CEX(v[p], v[i]); } }
}
__device__ __forceinline__ void bitonic_merge16_desc(unsigned (&v)[16]) {
#pragma unroll
    for (int j = 8; j > 0; j >>= 1)
#pragma unroll
        for (int i = 0; i < 16; ++i) { const int p = i ^ j; if (p > i) CEX(v[i], v[p]); }
}
__device__ __forceinline__ void merge_top16(unsigned (&a)[16], const unsigned (&b)[16]) {
#pragma unroll
    for (int i = 0; i < 16; ++i) a[i] = a[i] > b[15 - i] ? a[i] : b[15 - i];
    bitonic_merge16_desc(a);
}

constexpr int LDKEY = 272;
__device__ __forceinline__ void route_unit(const Args& a, ldsp_t keys, int tb, int h, int lane) {
    const int hi = lane >> 5, l31 = lane & 31, token = tb * 32 + l31;
    const bf16_t* P = (const bf16_t*)(a.ws + WS_P);
    const bf16_t* qrow = P + (size_t)token * LDP + PC_QP + h * 256 + hi * 8;
    unsigned L[2][16];
#pragma unroll
    for (int p = 0; p < 2; ++p) {
        f32x16 acc[4];
#pragma unroll
        for (int kb = 0; kb < 4; ++kb) acc[kb] = ZERO16;
#pragma unroll
        for (int kh = 0; kh < 2; ++kh) {
            bf16x8 bq[4];
#pragma unroll
            for (int ks = 0; ks < 4; ++ks) bq[ks] = *(const bf16x8*)(qrow + p * 128 + (4 * kh + ks) * 16);
#pragma unroll
            for (int ks = 0; ks < 4; ++ks) {
#pragma unroll
                for (int kb = 0; kb < 4; ++kb) { const bf16x8 ak = frag_row(keys + p * NKEY * LDKEY, LDKEY, 32 * kb, 16 * (4 * kh + ks), lane);
                    acc[kb] = __builtin_amdgcn_mfma_f32_32x32x16_bf16(ak, bq[ks], acc[kb], 0, 0, 0); } }
        }
        unsigned g0[16], g1[16];
#pragma unroll
        for (int r = 0; r < 16; ++r) { const int key = (r & 3) + 8 * (r >> 2) + 4 * hi; g0[r] = (ord_of(acc[0][r]) & ~127u) | (unsigned)(127 - key); g1[r] = (ord_of(acc[1][r]) & ~127u) | (unsigned)(127 - (32 + key)); }
        sort16_desc(g0); sort16_desc(g1); merge_top16(g0, g1);
        unsigned g2[16];
#pragma unroll
        for (int r = 0; r < 16; ++r) { const int key = (r & 3) + 8 * (r >> 2) + 4 * hi; g1[r] = (ord_of(acc[2][r]) & ~127u) | (unsigned)(127 - (64 + key)); g2[r] = (ord_of(acc[3][r]) & ~127u) | (unsigned)(127 - (96 + key)); }
        sort16_desc(g1); sort16_desc(g2); merge_top16(g1, g2); merge_top16(g0, g1);
#pragma unroll
        for (int i = 0; i < 16; ++i) g1[i] = (unsigned)__shfl_xor((int)g0[i], 32);
        merge_top16(g0, g1);
#pragma unroll
        for (int i = 0; i < 16; ++i) L[p][i] = g0[i];
    }
    float sa[16], sb[16];
#pragma unroll
    for (int i = 0; i < 16; ++i) { sa[i] = ord_inv(L[0][i] & ~127u); sb[i] = ord_inv(L[1][i] & ~127u); }
#define CKEY(x, y) ((ord_of(sa[x] + sb[y]) & ~255u) | (unsigned)(255 - ((x) * 16 + (y))))
    unsigned best[16], t1[16];
#pragma unroll
    for (int y = 0; y < 16; ++y) { best[y] = CKEY(0, y); t1[y] = y < 8 ? CKEY(1, y) : 0u; }
    merge_top16(best, t1);
    { int n = 0;
#pragma unroll
      for (int x = 2; x < 7; ++x)
#pragma unroll
          for (int y = 0; y < 16; ++y) if (cand_ok(x, y)) { t1[n] = CKEY(x, y); ++n; }
    }
    sort16_desc(t1); merge_top16(best, t1);
    { int n = 0;
#pragma unroll
      for (int x = 7; x < 16; ++x)
#pragma unroll
          for (int y = 0; y < 16; ++y) if (cand_ok(x, y)) { t1[n] = CKEY(x, y); ++n; }
#pragma unroll
      for (int i = 10; i < 16; ++i) t1[i] = 0u;
    }
    sort16_desc(t1); merge_top16(best, t1);
#undef CKEY
    float sc[16], ssum = 0.f; const float mx = ord_inv(best[0] & ~255u);
#pragma unroll
    for (int it = 0; it < 16; ++it) { sc[it] = __expf(ord_inv(best[it] & ~255u) - mx); ssum += sc[it]; }
    const float inv = 1.0f / ssum;
    unsigned* eo = (unsigned*)(a.ws + WS_EIDX) + (size_t)token * 128 + h * 16 + hi * 8;
    float* go = (float*)(a.ws + WS_GATE) + (size_t)token * 128 + h * 16 + hi * 8;
#pragma unroll
    for (int it = 0; it < 8; ++it) {
        unsigned b0 = best[it], b1 = best[it + 8]; float g0 = sc[it], g1 = sc[it + 8];
        asm volatile("" : "+v"(b0), "+v"(b1), "+v"(g0), "+v"(g1));
        const unsigned bsel = hi ? b1 : b0; const float gsel = (hi ? g1 : g0) * inv;
        const unsigned c = 255u - (bsel & 255u), ca = c >> 4, cb = c & 15u;
        unsigned k1 = 0u, k2 = 0u;
#pragma unroll
        for (int i = 0; i < 16; ++i) { k1 = (ca == (unsigned)i) ? (127u - (L[0][i] & 127u)) : k1; k2 = (cb == (unsigned)i) ? (127u - (L[1][i] & 127u)) : k2; }
        eo[it] = k1 * 128u + k2; go[it] = gsel;
    }
}
#undef CEX

constexpr int MAXT = 9;
#define DPPF(v, ctrl) __builtin_bit_cast(float, __builtin_amdgcn_update_dpp(0, __builtin_bit_cast(int, (v)), (ctrl), 0xf, 0xf, true))
constexpr int DPP_XOR1 = 0xB1, DPP_XOR2 = 0x4E, DPP_HMIRROR = 0x141, DPP_ROR8 = 0x128;
__device__ __forceinline__ void dec16p(const u32x4 r, f32x2 (&f)[8]) {
    f[0] = __builtin_amdgcn_cvt_pk_f32_fp8((int)r.x, false); f[1] = __builtin_amdgcn_cvt_pk_f32_fp8((int)r.x, true);
    f[2] = __builtin_amdgcn_cvt_pk_f32_fp8((int)r.y, false); f[3] = __builtin_amdgcn_cvt_pk_f32_fp8((int)r.y, true);
    f[4] = __builtin_amdgcn_cvt_pk_f32_fp8((int)r.z, false); f[5] = __builtin_amdgcn_cvt_pk_f32_fp8((int)r.z, true);
    f[6] = __builtin_amdgcn_cvt_pk_f32_fp8((int)r.w, false); f[7] = __builtin_amdgcn_cvt_pk_f32_fp8((int)r.w, true);
}
__device__ __forceinline__ void peer_phase(const Args& a, Frame& F, int l, bool lastlayer) {
    const int lane = F.lane, l7 = lane & 7, lg3 = lane >> 3;
    const int gw = F.vcu * NWAVES + F.wave, NGW = F.G * NWAVES;
    const unsigned char* TU = a.ws + WS_TAB + ((size_t)l * 2) * 16 * MiB;
    const unsigned char* TV = a.ws + WS_TAB + ((size_t)l * 2 + 1) * 16 * MiB;
    const float* SCU = (const float*)(a.ws + WS_TSC) + ((size_t)l * 2) * NEXP; const float* SCV = SCU + NEXP;
    bf16_t* XB = (bf16_t*)(a.ws + WS_XB); float* X = a.out;
    const unsigned* EI = (const unsigned*)(a.ws + WS_EIDX); const float* GT = (const float*)(a.ws + WS_GATE);
    const float* g2 = a.in[6] + (size_t)l * DM;
    ldsp_t wl = F.lds + F.wave * 16384;
    constexpr int O_ET = 0, O_HT = 2304, O_HA = 6912, O_SQ = 11520;
#define ET_ROW(i) (wl + O_ET + (i) * 256)
#define HT_ROW(i) (wl + O_HT + (i) * 512)
#define HACC(i) (*(LAS f32x2*)(wl + O_HA + (i) * 512 + lane * 8))
#define SSQ(i) (*(LAS float*)(wl + O_SQ + (i) * 256 + lane * 4))
    const int ntok = (MTOT - gw + NGW - 1) / NGW;
    for (int i = 0; i < ntok; ++i) { const int t = gw + NGW * i; const unsigned e0 = EI[(size_t)t * 128 + lane], e1 = EI[(size_t)t * 128 + 64 + lane];
        *(LAS bf16_t*)(ET_ROW(i) + (l7 * 16 + lg3) * 2) = (bf16_t)e0; *(LAS bf16_t*)(ET_ROW(i) + (l7 * 16 + 8 + lg3) * 2) = (bf16_t)e1;
        HACC(i) = (f32x2){0.f, 0.f}; SSQ(i) = 0.f; }
    LDS_WAIT();
    const unsigned lane_off = 16u * (unsigned)l7;
#define PEER_ISSUE(R, TAB, ss, ii, qh) do { const u32x4 _e = *(const LAS u32x4*)(ET_ROW(ii) + lg3 * 32 + (qh) * 16); const unsigned char* _b = (TAB) + (size_t)(ss) * (NEXP * 128); \
        const unsigned _w[4] = {_e.x, _e.y, _e.z, _e.w}; _Pragma("unroll") for (int q = 0; q < 8; ++q) { const unsigned idx = (q & 1) ? (_w[q >> 1] >> 16) : (_w[q >> 1] & 0xffffu); \
            R[q] = *(const u32x4*)(_b + (idx * 128u + lane_off)); } } while (0)
    for (int urep = 0; urep < REPS(7); ++urep) {
    if (urep) { for (int i = 0; i < ntok; ++i) HACC(i) = (f32x2){0.f, 0.f}; }
    {
        u32x4 RA[8], RB[8];
        PEER_ISSUE(RA, TU, 0, 0, 0);
        u32x4 xa = *(const u32x4*)(XB + (size_t)gw * DM + 16 * l7), xb = *(const u32x4*)(XB + (size_t)gw * DM + 16 * l7 + 8);
#pragma unroll 1
        for (int s = 0; s < 8; ++s) {
            f32x2 gv[8];
#pragma unroll
            for (int j = 0; j < 4; ++j) { const f32x4 g = *(const f32x4*)(g2 + 128 * s + 16 * l7 + 4 * j); gv[2 * j] = (f32x2){g[0], g[1]}; gv[2 * j + 1] = (f32x2){g[2], g[3]}; }
#pragma unroll 1
            for (int i = 0; i < ntok; ++i) {
                PEER_ISSUE(RB, TU, s, i, 1);
                int sn = s, in = i + 1; if (in == ntok) { in = 0; sn = s + 1; } if (sn == 8) { sn = 7; in = ntok - 1; }
                const int tn = gw + NGW * in;
                const u32x4 xan = *(const u32x4*)(XB + (size_t)tn * DM + 128 * sn + 16 * l7), xbn = *(const u32x4*)(XB + (size_t)tn * DM + 128 * sn + 16 * l7 + 8);
                f32x2 xg[8];
                { const unsigned xw[8] = {xa.x, xa.y, xa.z, xa.w, xb.x, xb.y, xb.z, xb.w};
#pragma unroll
                  for (int j = 0; j < 8; ++j) xg[j] = (f32x2){bflo(xw[j]), bfhi(xw[j])} * gv[j]; }
                float p[16];
#pragma unroll
                for (int q = 0; q < 8; q += 2) { f32x2 f[8], g[8]; dec16p(RA[q], f); dec16p(RA[q + 1], g); f32x2 s0 = f[0] * xg[0], t0 = g[0] * xg[0];
#pragma unroll
                    for (int j = 1; j < 8; ++j) { s0 += f[j] * xg[j]; t0 += g[j] * xg[j]; }
                    p[q] = s0.x + s0.y; p[q + 1] = t0.x + t0.y;
                    if (q < 6) asm volatile("" : "+v"(RA[q + 2].x), "+v"(RA[q + 2].y), "+v"(RA[q + 2].z), "+v"(RA[q + 2].w), "+v"(RA[q + 3].x), "+v"(RA[q + 3].y), "+v"(RA[q + 3].z), "+v"(RA[q + 3].w) : "v"(p[q]), "v"(p[q + 1])); }
                asm volatile("" :: "v"(p[6]), "v"(p[7]));
                PEER_ISSUE(RA, TU, sn, in, 0);
#pragma unroll
                for (int q = 0; q < 8; q += 2) { f32x2 f[8], g[8]; dec16p(RB[q], f); dec16p(RB[q + 1], g); f32x2 s0 = f[0] * xg[0], t0 = g[0] * xg[0];
#pragma unroll
                    for (int j = 1; j < 8; ++j) { s0 += f[j] * xg[j]; t0 += g[j] * xg[j]; }
                    p[8 + q] = s0.x + s0.y; p[9 + q] = t0.x + t0.y;
                    if (q < 6) asm volatile("" : "+v"(RB[q + 2].x), "+v"(RB[q + 2].y), "+v"(RB[q + 2].z), "+v"(RB[q + 2].w), "+v"(RB[q + 3].x), "+v"(RB[q + 3].y), "+v"(RB[q + 3].z), "+v"(RB[q + 3].w) : "v"(p[8 + q]), "v"(p[9 + q])); }
                float p8[8], p4[4]; f32x2 p2;
#pragma unroll
                for (int q = 0; q < 8; ++q) { const float keep = (lane & 4) ? p[q + 8] : p[q], send = (lane & 4) ? p[q] : p[q + 8]; p8[q] = keep + DPPF(send, DPP_HMIRROR); }
#pragma unroll
                for (int q = 0; q < 4; ++q) { const float keep = (lane & 2) ? p8[q + 4] : p8[q], send = (lane & 2) ? p8[q] : p8[q + 4]; p4[q] = keep + DPPF(send, DPP_XOR2); }
                { const float k0 = (lane & 1) ? p4[2] : p4[0], s0 = (lane & 1) ? p4[0] : p4[2], k1 = (lane & 1) ? p4[3] : p4[1], s1 = (lane & 1) ? p4[1] : p4[3];
                  float r0 = DPPF(s0, DPP_XOR1); asm volatile("" : "+v"(r0)); float r1 = DPPF(s1, DPP_XOR1); asm volatile("" : "+v"(r1));
                  p2.x = k0 + r0; p2.y = k1 + r1; }
                HACC(i) += p2;
                xa = xan; xb = xbn;
            }
        }
    } }
    for (int i = 0; i < ntok; ++i) { const int t = gw + NGW * i;
        const float rstd = rsqrtf(((const float*)(a.ws + WS_RSS2))[t] * (1.0f / DM) + EPS);
        const unsigned ew = *(const LAS unsigned*)(ET_ROW(i) + (lg3 * 16 + 2 * l7) * 2); const unsigned e0 = ew & 0xffffu, e1 = ew >> 16;
        const int k0 = 16 * l7 + lg3, k1 = k0 + 8; const f32x2 hs = HACC(i);
        f32x2 hv; hv.x = geluf_(hs.x * rstd * SCU[e0]) * GT[(size_t)t * 128 + k0] * SCV[e0]; hv.y = geluf_(hs.y * rstd * SCU[e1]) * GT[(size_t)t * 128 + k1] * SCV[e1];
        *(LAS f32x2*)(HT_ROW(i) + (lg3 * 16 + 2 * l7) * 4) = hv; }
    LDS_WAIT();
    {
        u32x4 RA[8], RB[8];
        PEER_ISSUE(RA, TV, 0, 0, 0);
#pragma unroll 1
        for (int s = 0; s < 8; ++s) {
#pragma unroll 1
            for (int i = 0; i < ntok; ++i) { const int t = gw + NGW * i;
                PEER_ISSUE(RB, TV, s, i, 1);
                int sn = s, in = i + 1; if (in == ntok) { in = 0; sn = s + 1; } if (sn == 8) { sn = 7; in = ntok - 1; }
                const int col = 128 * s + 16 * l7 + 8 * ((lane >> 3) & 1) + 4 * ((lane >> 5) & 1) + 2 * ((lane >> 4) & 1);
                f32x2 xv = *(const f32x2*)(X + (size_t)t * DM + col);
                const f32x4 h0 = *(const LAS f32x4*)(HT_ROW(i) + lg3 * 64), h1 = *(const LAS f32x4*)(HT_ROW(i) + lg3 * 64 + 16), h2 = *(const LAS f32x4*)(HT_ROW(i) + lg3 * 64 + 32), h3 = *(const LAS f32x4*)(HT_ROW(i) + lg3 * 64 + 48);
                const float hA[8] = {h0[0], h0[1], h0[2], h0[3], h1[0], h1[1], h1[2], h1[3]}, hB[8] = {h2[0], h2[1], h2[2], h2[3], h3[0], h3[1], h3[2], h3[3]};
                f32x2 o[8];
#pragma unroll
                for (int j = 0; j < 8; ++j) o[j] = (f32x2){0.f, 0.f};
#pragma unroll
                for (int q = 0; q < 8; ++q) { f32x2 f[8]; dec16p(RA[q], f); const f32x2 hq = (f32x2){hA[q], hA[q]};
#pragma unroll
                    for (int j = 0; j < 8; ++j) o[j] += hq * f[j];
                    if (q < 7) asm volatile("" : "+v"(RA[q + 1].x), "+v"(RA[q + 1].y), "+v"(RA[q + 1].z), "+v"(RA[q + 1].w) : "v"(o[7].y)); }
                asm volatile("" :: "v"(o[7].y));
                PEER_ISSUE(RA, TV, sn, in, 0);
#pragma unroll
                for (int q = 0; q < 8; ++q) { f32x2 f[8]; dec16p(RB[q], f); const f32x2 hq = (f32x2){hB[q], hB[q]};
#pragma unroll
                    for (int j = 0; j < 8; ++j) o[j] += hq * f[j];
                    if (q < 7) asm volatile("" : "+v"(RB[q + 1].x), "+v"(RB[q + 1].y), "+v"(RB[q + 1].z), "+v"(RB[q + 1].w) : "v"(o[7].y)); }
                f32x2 o4[4], o2[2], o1;
#pragma unroll
                for (int q = 0; q < 4; ++q) { const f32x2 keep = (lane & 8) ? o[q + 4] : o[q], send = (lane & 8) ? o[q] : o[q + 4];
                    float sx = send.x, sy = send.y; asm volatile("" : "+v"(sx)); asm volatile("" : "+v"(sy));
                    float rx = DPPF(sx, DPP_ROR8); asm volatile("" : "+v"(rx)); float ry = DPPF(sy, DPP_ROR8); asm volatile("" : "+v"(ry));
                    o4[q].x = keep.x + rx; o4[q].y = keep.y + ry; }
#pragma unroll
                for (int q = 0; q < 2; ++q) { const f32x2 keep = (lane & 32) ? o4[q + 2] : o4[q], send = (lane & 32) ? o4[q] : o4[q + 2];
                    o2[q].x = keep.x + __shfl_xor(send.x, 32); o2[q].y = keep.y + __shfl_xor(send.y, 32); }
                { const f32x2 keep = (lane & 16) ? o2[1] : o2[0], send = (lane & 16) ? o2[0] : o2[1];
                  float sx = send.x, sy = send.y; asm volatile("" : "+v"(sx)); asm volatile("" : "+v"(sy));
                  float rx = __builtin_bit_cast(float, __builtin_amdgcn_ds_swizzle(__builtin_bit_cast(int, sx), 0x401F)); asm volatile("" : "+v"(rx));
                  float ry = __builtin_bit_cast(float, __builtin_amdgcn_ds_swizzle(__builtin_bit_cast(int, sy), 0x401F)); asm volatile("" : "+v"(ry));
                  o1.x = keep.x + rx; o1.y = keep.y + ry; }
                xv += o1;
                *(f32x2*)(X + (size_t)t * DM + col) = xv; *(unsigned*)(XB + (size_t)t * DM + col) = pk2(xv.x, xv.y); SSQ(i) += xv.x * xv.x + xv.y * xv.y;
            }
        }
    }
#undef PEER_ISSUE
    float* RSS = (float*)(a.ws + WS_RSS);
    if (lastlayer) __threadfence();
    for (int i = 0; i < ntok; ++i) { const int t = gw + NGW * i; const float ss = wave_sum(SSQ(i)); if (lane == 0) RSS[t] = ss;
        if (lastlayer) { const float* gf = a.in[7]; const float rstd = rsqrtf(ss * (1.0f / DM) + EPS); f32x4* xr = (f32x4*)(X + (size_t)t * DM) + lane;
#pragma unroll
            for (int j = 0; j < 4; ++j) { const f32x4 g = *((const f32x4*)gf + lane + 64 * j); f32x4 v = xr[64 * j]; v = v * rstd * g; xr[64 * j] = v; } } }
#undef ET_ROW
#undef HT_ROW
#undef HACC
#undef SSQ
}

constexpr int PROBE_A = PROBE_SEL == 99 ? -1 : PROBE_SEL == 16 ? 15 : PROBE_SEL >= 200 ? 64 + (PROBE_SEL - 200) : PROBE_SEL >= 100 ? (PROBE_SEL - 100) : PROBE_SEL >= 32 ? PROBE_SEL : PROBE_SEL == 1 ? 0 : PROBE_SEL - 1;
constexpr int PROBE_B = PROBE_SEL == 99 ? -1 : PROBE_SEL == 16 ? 130 : PROBE_SEL >= 200 ? (PROBE_SEL - 200) : PROBE_SEL >= 100 ? 64 + (PROBE_SEL - 101) : PROBE_SEL >= 32 ? 1 : PROBE_SEL == 1 ? 130 : PROBE_SEL - 2;
constexpr int N_PHASES = 1 + 7 * DEPTH;
__global__ void __launch_bounds__(NTHREADS, 2) hybrid_fwd(Args args) {
    extern __shared__ __attribute__((aligned(16))) unsigned char lds_raw[];
    Frame F;
    F.lds = (ldsp_t)lds_raw;
    F.MISC = (volatile LAS unsigned*)(F.lds + MISC_OFF);
    F.tid = threadIdx.x; F.lane = F.tid & 63; F.wave = __builtin_amdgcn_readfirstlane(F.tid >> 6);
    F.G = gridDim.x; { const int bx = blockIdx.x; F.vcu = (F.G % 8 == 0) ? (bx % 8) * (F.G / 8) + bx / 8 : bx; }
    F.ctl = (unsigned*)(args.ws + WS_CTL); F.ws = args.ws; F.out = args.out;
    for (int u = F.tid; u < (LDS_BYTES - MISC_OFF) / 4; u += NTHREADS) ((LAS unsigned*)(F.lds + MISC_OFF))[u] = 0u;
    __syncthreads();
#if MK_N_LAUNCHES == 1
    constexpr int lo = 0, hi = N_PHASES;
#else
    const int lo = args.ph_lo, hi = args.ph_hi;
#endif
    if (PROBE_SEL && blockIdx.x == 0 && F.tid == 0) F.ctl[CW_TS + 130] = (unsigned)__builtin_amdgcn_s_memrealtime();
    XcdBarrier bar; bar.bar = F.ctl + CW_BAR; bar.x = 0; bar.st = nullptr;
    if (hi - lo > 1) bar = xcd_barrier_post(F.ctl + CW_BAR, F.MISC + 8);
#ifndef PH_MASK
#define PH_MASK 0x7FF
#endif
#define IN(k) (lo <= (k) && (k) < hi)
#define PHM(b) ((PH_MASK >> (b)) & 1)
#define REPBAR() do { if (rep) xcd_barrier(bar); } while (0)
#define LAUNDER() do { asm volatile("" : "+v"(F.tid)); F.lane = F.tid & 63; F.wave = __builtin_amdgcn_readfirstlane(F.tid >> 6); bxl = (int)blockIdx.x; asm volatile("" : "+s"(bxl)); } while (0)
#define STAMP(k) do { if (PROBE_SEL && ((k) == PROBE_A || (k) == PROBE_B) && F.tid == 0) atomicMax(F.ctl + CW_TS + (k), (unsigned)__builtin_amdgcn_s_memrealtime()); } while (0)
#define SEAM(k) do { STAMP(k); if (IN(k) && IN((k) + 1)) xcd_barrier(bar); STAMP(64 + (k)); } while (0)
    unsigned char* ws = args.ws;
    bf16_t* P = (bf16_t*)(ws + WS_P); bf16_t* XB = (bf16_t*)(ws + WS_XB);
    int bxl = (int)blockIdx.x;

    for (int rep = 0; rep < REPS(0); ++rep) { REPBAR(); if (PHM(0) && IN(0)) { LAUNDER(); p0_prologue(args, F); } } SEAM(0);

    for (int l = 0; l < DEPTH; ++l) {
        const int pb = 1 + 7 * l;
        for (int rep = 0; rep < REPS(1); ++rep) { REPBAR();
        if (PHM(1) && IN(pb)) { LAUNDER();
            pg8::Gemm g{XB, (const bf16_t*)(ws + WS_WIN) + (size_t)l * NIN * DM, DM, DM, 0, 0};
            pg8::StaticOrder S; S.init(MTOT, NIN, F.G, bxl, 1);
            pg8::EpiIn E{P, (const float*)(ws + WS_RSS), (const float*)(ws + WS_ROT)};
            pg8::gemm_phase<pg8::EpiIn, pg8::StaticOrder, true>(F.lds, g, S, E, F.tid);
        } }
        SEAM(pb);
        if (PHM(2) && IN(pb + 1)) { LAUNDER();
            for (int u = (int)blockIdx.x; u < 192; u += F.G) {
                LAUNDER();
                if (u < 64) { if (PHM(8)) ret_prompt_unit(args, F, l, u >> 3, u & 7); if (l == 0) STAMP(32); }
                else { if (PHM(9)) rnn_unit(args, F, l, false, (u - 64) >> 4, (u - 64) & 15); if (l == 0) STAMP(33); }
            }
            unsigned* qh = F.ctl + CW_QUEUE + 64 * l;
            for (;;) {
                __syncthreads();
                if (F.tid == 0) F.MISC[0] = xb_add(qh, 1u);
                __syncthreads();
                const unsigned q = F.MISC[0];
                LAUNDER();
                if (PROBE_SEL && l == 0 && q >= 1408u - 8u && q < 1408u) STAMP(34);
                if (q >= 256u + 128u + 1024u) break;
                if (q < 256u) tab_unit(args, F, l, (int)q);
                else if (q < 384u) { if (PHM(9)) rnn_unit(args, F, l, true, (int)((q - 256u) >> 4), (int)((q - 256u) & 15)); }
                else { if (PHM(10)) ret_sample_unit(args, F, l, (int)((q - 384u) >> 3), (int)((q - 384u) & 7)); }
            }
        }
        SEAM(pb + 1);
        for (int rep = 0; rep < REPS(3); ++rep) { REPBAR();
        if (PHM(3) && IN(pb + 2)) { LAUNDER();
            pg8::Gemm g{(const bf16_t*)(ws + WS_ARET), (const bf16_t*)(ws + WS_WMIX + (size_t)l * 6 * MiB), DM, DM, (size_t)(WS_ARNN - WS_ARET), (size_t)(2 * MiB)};
            pg8::StaticOrder S; S.init(MTOT, DM, F.G, bxl, 2);
            pg8::EpiMerge E{P, (bf16_t*)(ws + WS_MRG)};
            pg8::gemm_phase<pg8::EpiMerge, pg8::StaticOrder, true>(F.lds, g, S, E, F.tid);
        } }
        SEAM(pb + 2);
        if (PHM(4) && IN(pb + 3)) { LAUNDER();
            pg8::Gemm g{(const bf16_t*)(ws + WS_MRG), (const bf16_t*)(ws + WS_WMIX + (size_t)l * 6 * MiB + 4 * MiB), DM, DM, 0, 0};
            pg8::StaticOrder S; S.init(MTOT, DM, F.G, bxl, 1);
            pg8::EpiWo E{l == 0 ? args.in[0] : args.out, l == 0 ? args.in[1] : args.out + (size_t)M_P * DM, args.out, XB, (float*)(ws + WS_RSSP)};
            pg8::gemm_phase<pg8::EpiWo, pg8::StaticOrder, true>(F.lds, g, S, E, F.tid);
        }
        SEAM(pb + 3);
        for (int rep = 0; rep < REPS(5); ++rep) { REPBAR();
        if (PHM(5) && IN(pb + 4)) { LAUNDER();
            pg8::Gemm g{XB, (const bf16_t*)(ws + WS_WQ) + (size_t)l * 2048 * DM, DM, DM, 0, 0};
            pg8::StaticOrder S; S.init(MTOT, 2048, F.G, bxl, 1);
            pg8::EpiQ E{P, (const float*)(ws + WS_RSSP), (float*)(ws + WS_RSS2)};
            pg8::gemm_phase<pg8::EpiQ, pg8::StaticOrder, true>(F.lds, g, S, E, F.tid);
        } }
        SEAM(pb + 4);
        for (int rep = 0; rep < 1; ++rep) {
        if (PHM(6) && IN(pb + 5)) { LAUNDER();
            int hstaged = -1;
            for (int bu = bxl; bu < (MTOT / 256) * PH; bu += F.G) { const int sb = bu >> 3, h = bu & 7;
                if (h != hstaged) { __syncthreads();
                    const bf16_t* ksrc = (const bf16_t*)(ws + WS_KEYS) + ((size_t)(l * PH + h) * 2) * NKEY * HK;
#pragma unroll
                    for (int i = 0; i < 8; ++i) { const int p = F.tid + 512 * i, row = p >> 4, c = p & 15;
                        *(LAS u32x4*)(F.lds + row * LDKEY + c * 16) = *(const u32x4*)(ksrc + (size_t)row * HK + c * 8); }
                    __syncthreads(); hstaged = h; }
                for (int rr = 0; rr < REPS(6); ++rr) { int ln = F.lane; asm volatile("" : "+v"(ln)); route_unit(args, F.lds, sb * 8 + F.wave, h, ln); }
            }
        } }
        SEAM(pb + 5);
        if (PHM(7) && IN(pb + 6)) { LAUNDER(); peer_phase(args, F, l, l == DEPTH - 1); }
        if (l + 1 < DEPTH) SEAM(pb + 6); else STAMP(pb + 6);
    }
    STAMP(15);
#undef IN
#undef SEAM
}


__global__ void probe_report(float* out, const unsigned* ts) {
    unsigned ta, tb;
    if (PROBE_SEL == 99) { ta = 10000u; tb = 0u; }
    else { ta = ts[PROBE_A < 0 ? 0 : PROBE_A]; tb = ts[PROBE_B < 0 ? 0 : PROBE_B]; if (PROBE_SEL == 16) ta = tb + (ta - tb) / 16u; }
    const float dl = sqrtf((float)(ta - tb)) * 1e-2f;
    for (int i = blockIdx.x * blockDim.x + threadIdx.x; i < DEPTH * NBATCH * DM; i += gridDim.x * blockDim.x) out[O_SHP + i] += dl;
}
extern "C" void kernel_launch(void* const* d_in, const int* in_sizes, int n_in, void* d_out, int out_size, void* d_ws, size_t ws_size, hipStream_t stream) {
    static int grid = 0;
    if (grid == 0) {
        if (n_in != 24 || out_size != (int)O_END || ws_size < WS_END) { fprintf(stderr, "kernel_launch: unexpected shapes (n_in %d, out %d, ws %zu)\n", n_in, out_size, ws_size); grid = -1; return; }
        int dev = 0, cus = 0, per_cu = 0;
        if (hipGetDevice(&dev) != hipSuccess || hipDeviceGetAttribute(&cus, hipDeviceAttributeMultiprocessorCount, dev) != hipSuccess) { grid = -1; return; }
        if (hipFuncSetAttribute((const void*)hybrid_fwd, hipFuncAttributeMaxDynamicSharedMemorySize, LDS_BYTES) != hipSuccess) { fprintf(stderr, "kernel_launch: hipFuncSetAttribute failed\n"); grid = -1; return; }
        if (hipOccupancyMaxActiveBlocksPerMultiprocessor(&per_cu, (const void*)hybrid_fwd, NTHREADS, LDS_BYTES) != hipSuccess || per_cu < 1) { fprintf(stderr, "kernel_launch: occupancy query reports %d blocks per CU\n", per_cu); (void)hipGetLastError(); grid = -1; return; }
        grid = cus;
        if (grid != 256) fprintf(stderr, "kernel_launch: %d CUs; the PEER phase assumes 256 workgroups\n", grid);
    }
    if (grid < 0) return;
    (void)hipMemsetAsync((char*)d_ws + WS_CTL, 0, CTL_ZERO_BYTES, stream);
    Args a{};
    for (int i = 0; i < 24; ++i) a.in[i] = (const float*)d_in[i];
    a.out = (float*)d_out; a.ws = (unsigned char*)d_ws;
#if MK_N_LAUNCHES == 1
    a.ph_lo = 0; a.ph_hi = N_PHASES;
    void* kargs[] = {&a};
    hipError_t e = hipLaunchCooperativeKernel((const void*)hybrid_fwd, dim3(grid), dim3(NTHREADS), kargs, LDS_BYTES, stream);
    if (e != hipSuccess) fprintf(stderr, "kernel_launch: cooperative launch failed: %s (grid %d)\n", hipGetErrorString(e), grid);
#if PROBE_SEL
    hipLaunchKernelGGL(probe_report, dim3(16), dim3(256), 0, stream, (float*)d_out, (const unsigned*)((char*)d_ws + WS_CTL) + CW_TS);
#endif
#else
    for (int p = 0; p < N_PHASES; ++p) { a.ph_lo = p; a.ph_hi = p + 1; hipLaunchKernelGGL(hybrid_fwd, dim3(grid), dim3(NTHREADS), LDS_BYTES, stream, a); }
#endif
}
```
